# Optimizing an MI355X kernel written in HIP

```python
import math
import jax, jax.numpy as jnp
from jax import lax
import numpy as np

D_MODEL = 1024
BATCH = 4
SEQ = 8192
DEPTH = 2

GRID_W = 64
CTX_LEN = 256
N_MIXERS = 2
N_MOD = 6
NORM_EPS = 1e-6

NA_HEADS = 16
NA_HEAD_DIM = D_MODEL // NA_HEADS
NA_WIN_H = 8
NA_WIN_W = 16

HY_FILTER_WIDTH = 64
HY_EMB_DIM = 33
HY_BANDS = (HY_EMB_DIM - 1) // 2
HY_SHORT_WIDTH = 3
HY_DECAY_TARGET = 1e-2
HY_SHORT_DECAY_PCT = 0.3
HY_LONG_DECAY_PCT = 1.5

D_FF = 2816
FFN_CONV_WIDTH = 3

kernel_name = 'hybrid_na_hyena_diffusion_block'


def rms_norm(x, gain):
    xf = x.astype(jnp.float32)
    y = xf * lax.rsqrt(jnp.mean(xf * xf, axis=-1, keepdims=True) + NORM_EPS)
    return (y * gain.astype(jnp.float32)).astype(x.dtype)


def adaln(cond, w_mod, b_mod):
    return jnp.split(jax.nn.silu(cond) @ w_mod + b_mod, N_MOD, axis=-1)


def modulate(h, shift, scale):
    return h * (1.0 + scale) + shift


def dwconv_centred(x, w, b):
    k = w.shape[0]
    L = x.shape[1]
    pad = k // 2
    xp = jnp.pad(x, ((0, 0), (pad, k - 1 - pad), (0, 0)))
    out = xp[:, 0:L] * w[0]
    for i in range(1, k):
        out = out + xp[:, i:i + L] * w[i]
    return out + b


def split_heads(t):
    return t.reshape(t.shape[0], t.shape[1], NA_HEADS, NA_HEAD_DIM)


def neighbourhood_attention(q, k, v, k_ctx, v_ctx, rpb):
    B, L, H, Dh = q.shape
    rows = L // GRID_W
    kh = min(NA_WIN_H, rows)
    kw = NA_WIN_W
    scale = Dh ** -0.5
    cols = np.arange(GRID_W)
    col_idx = (np.clip(cols - kw // 2, 0, GRID_W - kw)[:, None] + np.arange(kw)[None, :]).astype(np.int32)
    dc_idx = (col_idx - cols[:, None] + (NA_WIN_W - 1)).astype(np.int32)
    qg = jnp.moveaxis(q.reshape(B, rows, GRID_W, H, Dh), 1, 0)
    kg = k.reshape(B, rows, GRID_W, H, Dh)
    vg = v.reshape(B, rows, GRID_W, H, Dh)

    def one_row(args):
        r, q_row = args
        r0 = jnp.clip(r - kh // 2, 0, rows - kh)
        k_win = lax.dynamic_slice_in_dim(kg, r0, kh, axis=1)[:, :, col_idx]
        v_win = lax.dynamic_slice_in_dim(vg, r0, kh, axis=1)[:, :, col_idx]
        dr_idx = r0 + jnp.arange(kh, dtype=jnp.int32) - r + (NA_WIN_H - 1)
        bias = rpb[:, dr_idx[:, None, None], dc_idx[None, :, :]]
        s_loc = jnp.einsum('bqhd,biqjhd->bhqij', q_row, k_win) * scale + jnp.transpose(bias, (0, 2, 1, 3))[None]
        s_ctx = jnp.einsum('bqhd,bkhd->bhqk', q_row, k_ctx) * scale
        s = jnp.concatenate([s_loc.reshape(B, H, GRID_W, kh * kw), s_ctx], axis=-1)
        p = jax.nn.softmax(s.astype(jnp.float32), axis=-1).astype(v.dtype)
        p_loc = p[..., :kh * kw].reshape(B, H, GRID_W, kh, kw)
        return (jnp.einsum('bhqij,biqjhd->bqhd', p_loc, v_win)
                + jnp.einsum('bhqk,bkhd->bqhd', p[..., kh * kw:], v_ctx))

    out = lax.map(one_row, (jnp.arange(rows, dtype=jnp.int32), qg))
    return jnp.moveaxis(out, 0, 1).reshape(B, L, H * Dh)


def context_attention(q, k, v):
    s = jnp.einsum('bqhd,bkhd->bhqk', q, k) * (q.shape[-1] ** -0.5)
    p = jax.nn.softmax(s.astype(jnp.float32), axis=-1).astype(v.dtype)
    o = jnp.einsum('bhqk,bkhd->bqhd', p, v)
    return o.reshape(o.shape[0], o.shape[1], -1)


def hyena_filters(L, w1, b1, w2, b2, w3, b3, w_out, sin_freq):
    f32 = jnp.float32
    t = jnp.linspace(0.0, 1.0, L, dtype=f32)[:, None]
    w = (2.0 * math.pi / L) * jnp.arange(L, dtype=f32)[:, None]
    bands = jnp.linspace(1e-4, HY_BANDS - 1, HY_BANDS, dtype=f32)[None, :]
    z = jnp.concatenate([t, jnp.cos(bands * w), -jnp.sin(bands * w)], axis=-1)
    freq = sin_freq.astype(f32)
    hdn = jnp.sin(freq * (z @ w1.astype(f32) + b1.astype(f32)))
    hdn = jnp.sin(freq * (hdn @ w2.astype(f32) + b2.astype(f32)))
    hdn = jnp.sin(freq * (hdn @ w3.astype(f32) + b3.astype(f32)))
    h = (hdn @ w_out.astype(f32)).reshape(L, 2, D_MODEL)
    deltas = jnp.abs(jnp.linspace(math.log(HY_DECAY_TARGET) / HY_SHORT_DECAY_PCT,
                                  math.log(HY_DECAY_TARGET) / HY_LONG_DECAY_PCT, D_MODEL, dtype=f32))
    h = h * jnp.exp(-t * deltas)[:, None, :]
    h = h * lax.rsqrt(jnp.sum(h * h, axis=(0, 1), keepdims=True) + NORM_EPS)
    return jnp.concatenate([h[:, 0], jnp.zeros((1, D_MODEL), f32), h[:0:-1, 1]], axis=0)


def hyena_mixer(h, w_in, b_in, short_w, short_b, f_w1, f_b1, f_w2, f_b2, f_w3, f_b3, f_wout, f_freq,
                d_bias, w_out, b_out):
    L = h.shape[1]
    u = dwconv_centred(h @ w_in + b_in, short_w, short_b)
    x0, x1, v = jnp.split(u, 3, axis=-1)
    filt = hyena_filters(L, f_w1, f_b1, f_w2, f_b2, f_w3, f_b3, f_wout, f_freq)
    z = (v * x1).astype(jnp.float32)
    zf = jnp.fft.rfft(z, n=2 * L, axis=1)
    ff = jnp.fft.rfft(filt, n=2 * L, axis=0)
    y = jnp.fft.irfft(zf * ff[None], n=2 * L, axis=1)[:, :L] + z * d_bias.astype(jnp.float32)
    return (x0 * y.astype(h.dtype)) @ w_out + b_out


def conv_ffn(h, w_up, conv_w, conv_b, w_down):
    a, g = jnp.split(h @ w_up, 2, axis=-1)
    return (a * jax.nn.gelu(dwconv_centred(g, conv_w, conv_b), approximate=False)) @ w_down


def setup_inputs(seed: int = 0) -> dict:
    key = jax.random.key(seed)
    ks = iter(jax.random.split(key, 48))

    def nrm(shape, scale):
        return scale * jax.random.normal(next(ks), shape, jnp.float32)

    D = D_MODEL
    inp = {}
    inp['x'] = nrm((BATCH, SEQ, D), 1.0)
    inp['c'] = nrm((BATCH, D), 1.0)
    inp['ctx'] = nrm((BATCH, CTX_LEN, D), 1.0)
    inp['c_ctx'] = nrm((D,), 1.0)
    inp['l0_w_mod'] = nrm((D, N_MOD * D), D ** -0.5)
    inp['l0_b_mod'] = nrm((N_MOD * D,), 0.02)
    inp['l0_norm1'] = 1.0 + nrm((D,), 0.05)
    inp['l0_norm2'] = 1.0 + nrm((D,), 0.05)
    inp['l0_na_w_qkv'] = nrm((D, 3 * D), D ** -0.5)
    inp['l0_na_q_gain'] = 1.0 + nrm((NA_HEAD_DIM,), 0.05)
    inp['l0_na_k_gain'] = 1.0 + nrm((NA_HEAD_DIM,), 0.05)
    inp['l0_na_rpb'] = nrm((NA_HEADS, 2 * NA_WIN_H - 1, 2 * NA_WIN_W - 1), 0.1)
    inp['l0_na_w_o'] = nrm((D, D), D ** -0.5)
    inp['l0_ffn_w_up'] = nrm((D, 2 * D_FF), D ** -0.5)
    inp['l0_ffn_conv_w'] = nrm((FFN_CONV_WIDTH, D_FF), FFN_CONV_WIDTH ** -0.5)
    inp['l0_ffn_conv_b'] = nrm((D_FF,), 0.02)
    inp['l0_ffn_w_down'] = nrm((D_FF, D), D_FF ** -0.5)
    inp['l1_w_mod'] = nrm((D, N_MOD * D), D ** -0.5)
    inp['l1_b_mod'] = nrm((N_MOD * D,), 0.02)
    inp['l1_norm1'] = 1.0 + nrm((D,), 0.05)
    inp['l1_norm2'] = 1.0 + nrm((D,), 0.05)
    inp['l1_hy_w_in'] = nrm((D, 3 * D), D ** -0.5)
    inp['l1_hy_b_in'] = nrm((3 * D,), 0.02)
    inp['l1_hy_short_w'] = nrm((HY_SHORT_WIDTH, 3 * D), HY_SHORT_WIDTH ** -0.5)
    inp['l1_hy_short_b'] = nrm((3 * D,), 0.02)
    inp['l1_hy_f_w1'] = nrm((HY_EMB_DIM, HY_FILTER_WIDTH), HY_EMB_DIM ** -0.5)
    inp['l1_hy_f_b1'] = nrm((HY_FILTER_WIDTH,), 0.1)
    inp['l1_hy_f_w2'] = nrm((HY_FILTER_WIDTH, HY_FILTER_WIDTH), HY_FILTER_WIDTH ** -0.5)
    inp['l1_hy_f_b2'] = nrm((HY_FILTER_WIDTH,), 0.1)
    inp['l1_hy_f_w3'] = nrm((HY_FILTER_WIDTH, HY_FILTER_WIDTH), HY_FILTER_WIDTH ** -0.5)
    inp['l1_hy_f_b3'] = nrm((HY_FILTER_WIDTH,), 0.1)
    inp['l1_hy_f_wout'] = nrm((HY_FILTER_WIDTH, 2 * D), HY_FILTER_WIDTH ** -0.5)
    inp['l1_hy_f_freq'] = 1.0 + nrm((HY_FILTER_WIDTH,), 0.05)
    inp['l1_hy_d_bias'] = nrm((D,), 1.0)
    inp['l1_hy_w_out'] = nrm((D, D), D ** -0.5)
    inp['l1_hy_b_out'] = nrm((D,), 0.02)
    inp['l1_ffn_w_up'] = nrm((D, 2 * D_FF), D ** -0.5)
    inp['l1_ffn_conv_w'] = nrm((FFN_CONV_WIDTH, D_FF), FFN_CONV_WIDTH ** -0.5)
    inp['l1_ffn_conv_b'] = nrm((D_FF,), 0.02)
    inp['l1_ffn_w_down'] = nrm((D_FF, D), D_FF ** -0.5)
    return inp


def reference(x, c, ctx, c_ctx,
              l0_w_mod, l0_b_mod, l0_norm1, l0_norm2, l0_na_w_qkv, l0_na_q_gain, l0_na_k_gain, l0_na_rpb,
              l0_na_w_o, l0_ffn_w_up, l0_ffn_conv_w, l0_ffn_conv_b, l0_ffn_w_down,
              l1_w_mod, l1_b_mod, l1_norm1, l1_norm2, l1_hy_w_in, l1_hy_b_in, l1_hy_short_w, l1_hy_short_b,
              l1_hy_f_w1, l1_hy_f_b1, l1_hy_f_w2, l1_hy_f_b2, l1_hy_f_w3, l1_hy_f_b3, l1_hy_f_wout, l1_hy_f_freq,
              l1_hy_d_bias, l1_hy_w_out, l1_hy_b_out, l1_ffn_w_up, l1_ffn_conv_w, l1_ffn_conv_b, l1_ffn_w_down):
    layers = [
        dict(w_mod=l0_w_mod, b_mod=l0_b_mod, norm1=l0_norm1, norm2=l0_norm2,
             mixer=(l0_na_w_qkv, l0_na_q_gain, l0_na_k_gain, l0_na_rpb, l0_na_w_o),
             ffn=(l0_ffn_w_up, l0_ffn_conv_w, l0_ffn_conv_b, l0_ffn_w_down)),
        dict(w_mod=l1_w_mod, b_mod=l1_b_mod, norm1=l1_norm1, norm2=l1_norm2,
             mixer=(l1_hy_w_in, l1_hy_b_in, l1_hy_short_w, l1_hy_short_b, l1_hy_f_w1, l1_hy_f_b1,
                    l1_hy_f_w2, l1_hy_f_b2, l1_hy_f_w3, l1_hy_f_b3, l1_hy_f_wout, l1_hy_f_freq,
                    l1_hy_d_bias, l1_hy_w_out, l1_hy_b_out),
             ffn=(l1_ffn_w_up, l1_ffn_conv_w, l1_ffn_conv_b, l1_ffn_w_down)),
    ]
    xc = ctx
    for i in range(DEPTH):
        p = layers[i]
        ctx_read_later = any(j % N_MIXERS == 0 for j in range(i + 1, DEPTH))
        sh1, sc1, g1, sh2, sc2, g2 = adaln(c[:, None, :], p['w_mod'], p['b_mod'])
        csh1, csc1, cg1, csh2, csc2, cg2 = adaln(c_ctx[None, None, :], p['w_mod'], p['b_mod'])
        h = modulate(rms_norm(x, p['norm1']), sh1, sc1)
        hc = modulate(rms_norm(xc, p['norm1']), csh1, csc1)
        if i % N_MIXERS == 0:
            w_qkv, q_gain, k_gain, rpb, w_o = p['mixer']
            w_q, w_k, w_v = jnp.split(w_qkv, 3, axis=1)
            q = rms_norm(split_heads(h @ w_q), q_gain)
            k = rms_norm(split_heads(h @ w_k), k_gain)
            v = split_heads(h @ w_v)
            kc = rms_norm(split_heads(hc @ w_k), k_gain)
            vc = split_heads(hc @ w_v)
            y = neighbourhood_attention(q, k, v, kc, vc, rpb) @ w_o
            if ctx_read_later:
                qc = rms_norm(split_heads(hc @ w_q), q_gain)
                yc = context_attention(qc, kc, vc) @ w_o
        else:
            y = hyena_mixer(h, *p['mixer'])
            if ctx_read_later:
                yc = hyena_mixer(hc, *p['mixer'])
        x = x + g1 * y
        x = x + g2 * conv_ffn(modulate(rms_norm(x, p['norm2']), sh2, sc2), *p['ffn'])
        if ctx_read_later:
            xc = xc + cg1 * yc
            xc = xc + cg2 * conv_ffn(modulate(rms_norm(xc, p['norm2']), csh2, csc2), *p['ffn'])
    return x
```

```cpp
#include <hip/hip_runtime.h>
#include <cstdio>
#include <cstdint>

#ifndef PH_END
#define PH_END 16
#endif
#ifndef MK_ONE_LAUNCH
#define MK_ONE_LAUNCH 1
#endif

namespace pg8 {
#define PG8_LAS __attribute__((address_space(3)))
typedef unsigned short bf16_t;
typedef short bf16x8 __attribute__((ext_vector_type(8)));
typedef float f32x4 __attribute__((ext_vector_type(4)));
typedef unsigned u32x4 __attribute__((ext_vector_type(4)));
constexpr int BM = 256, BK = 64, HALF = 128, HTB = HALF * BK * 2, STAGE_BYTES = 8 * HTB, NXCD = 8, WGM = 8;

__host__ __device__ __forceinline__ int lds_byte(int r, int c) { const int st = (r >> 4) * 2 + (c >> 5), rr = r & 15, cc = c & 31, ob = rr * 64 + cc * 2; return st * 1024 + (ob ^ (((ob >> 9) & 1) << 5)); }
__host__ __device__ __forceinline__ void stage_rc(int b, int& R, int& C) { const int st = b / 1024, sb = b % 1024, swz = sb ^ (((sb >> 9) & 1) << 5); R = (st >> 1) * 16 + swz / 64; C = (st & 1) * 32 + (swz % 64) / 2; }
__host__ __device__ __forceinline__ int perm32(int rho) { const int n = rho >> 4, i = rho & 15; return 8 * (i >> 2) + 4 * n + (i & 3); }

struct Unit { int pm, pn; };
struct Gemm { const bf16_t* A; const bf16_t* Bt; int M, N, K, lda; };

struct StaticOrder {
    int nM, nN, nwg, G, c;
    __host__ __device__ void init(int M, int N, int G_, int c_) { nM = M / BM; nN = N / BM; nwg = nM * nN; G = G_; c = c_; }
    __host__ __device__ bool next(int i, Unit& u) const {
        const long L = (long)i * G + c; if (L >= nwg) return false;
        int wgid = (int)L; { const int q = nwg / NXCD, r = nwg % NXCD, xcd = wgid % NXCD, off = wgid / NXCD; wgid = (xcd < r ? xcd * (q + 1) : r * (q + 1) + (xcd - r) * q) + off; }
        const int nig = WGM * nN, gid = wgid / nig, fm = gid * WGM, gsz = (nM - fm) < WGM ? (nM - fm) : WGM;
        u.pm = fm + ((wgid % nig) % gsz); u.pn = (wgid % nig) / gsz; return true;
    }
    __device__ __forceinline__ void a_ready(const Unit&) const {}
    __device__ __forceinline__ void done(const Unit&) const {}
};

__device__ __forceinline__ unsigned cvt_pk_bf16(float lo, float hi) { unsigned r; asm volatile("v_cvt_pk_bf16_f32 %0, %1, %2" : "=v"(r) : "v"(lo), "v"(hi)); return r; }

template <class Epi, class Sched, bool ALIGN_EPI = false, bool SP2 = false>
__device__ __forceinline__ void gemm_phase(PG8_LAS unsigned char* lds, const Gemm g, const Sched& S, const Epi& E) {
    const int tid = threadIdx.x, wid = __builtin_amdgcn_readfirstlane(tid >> 6), lane = tid & 63, wr = wid >> 2, wc = wid & 3, fr = lane & 15, fq = lane >> 4;
    const int K = g.K, nt = K / BK, lda = g.lda;
    unsigned voffA[2], voffB[2];
#pragma unroll
    for (int i = 0; i < 2; ++i) { int R, C; stage_rc(tid * 16 + i * 8192, R, C); const int Rb = Epi::PERM ? ((R & ~31) + perm32(R & 31)) : R;
        voffA[i] = (unsigned)(R * lda + C) * 2u; voffB[i] = (unsigned)(Rb * K + C) * 2u; }
    const size_t kstep = (size_t)(BK * 2);
    const size_t hstepA = (size_t)HALF * lda * 2, hstepB = (size_t)HALF * K * 2;
    const size_t tstepA = 2 * hstepA, tstepB = 2 * hstepB;
    const unsigned ldsw = (unsigned)wid * 1024u;
    const int aoff = lds_byte(wr * 64 + fr, fq * 8), boff = lds_byte(wc * 32 + fr, fq * 8);
#define PG8_SA(b, h) (((b) * 2 + (h)) * HTB)
#define PG8_SB(b, h) ((4 + (b) * 2 + (h)) * HTB)
#define PG8_STAGE(bufoff, gbase, voff) do { _Pragma("unroll") for (int _i = 0; _i < 2; ++_i) \
        __builtin_amdgcn_global_load_lds((const unsigned*)((const char*)(gbase) + (voff)[_i]), (PG8_LAS unsigned*)(lds + (bufoff) + ldsw + _i * 8192), 16, 0, 0); } while (0)
#define PG8_LDA(dst, b, h) do { _Pragma("unroll") for (int m = 0; m < 4; ++m) _Pragma("unroll") for (int k = 0; k < 2; ++k) dst[m][k] = *(const PG8_LAS bf16x8*)(lds + PG8_SA(b, h) + aoff + m * 2048 + k * 1024); } while (0)
#define PG8_LDB(dst, b, h) do { _Pragma("unroll") for (int n = 0; n < 2; ++n) _Pragma("unroll") for (int k = 0; k < 2; ++k) dst[n][k] = *(const PG8_LAS bf16x8*)(lds + PG8_SB(b, h) + boff + n * 2048 + k * 1024); } while (0)
#define PG8_MMA(ai, bj, At, Bt) do { __builtin_amdgcn_s_setprio(1); _Pragma("unroll") for (int m = 0; m < 4; ++m) _Pragma("unroll") for (int n = 0; n < 2; ++n) _Pragma("unroll") for (int k = 0; k < 2; ++k) \
        acc[ai][bj][m][n] = __builtin_amdgcn_mfma_f32_16x16x32_bf16(Bt[n][k], At[m][k], acc[ai][bj][m][n], 0, 0, 0); __builtin_amdgcn_s_setprio(0); } while (0)
#define PG8_WAIT_V(n) asm volatile("s_waitcnt vmcnt(" #n ")" ::: "memory")
#define PG8_WAIT_L(n) asm volatile("s_waitcnt lgkmcnt(" #n ")" ::: "memory")
#define PG8_BAR __builtin_amdgcn_s_barrier()
#define PG8_SCHED __builtin_amdgcn_sched_barrier(0)
    Unit cur, nxt; int ui = 0;
    if (!S.next(0, cur)) return;
    f32x4 acc[2][2][4][2];
#pragma unroll
    for (int a = 0; a < 2; ++a)
#pragma unroll
        for (int b = 0; b < 2; ++b)
#pragma unroll
            for (int m = 0; m < 4; ++m)
#pragma unroll
                for (int n = 0; n < 2; ++n) acc[a][b][m][n] = (f32x4){0.f, 0.f, 0.f, 0.f};
    bf16x8 At[4][2], B0[2][2], B1[2][2];
    const char* cA = (const char*)g.A + (size_t)cur.pm * tstepA; const char* cB = (const char*)g.Bt + (size_t)cur.pn * tstepB;
    S.a_ready(cur);
    if constexpr (SP2) {
        PG8_STAGE(PG8_SB(0, 0), cB, voffB); PG8_STAGE(PG8_SB(0, 1), cB + hstepB, voffB); PG8_STAGE(PG8_SA(0, 0), cA, voffA); PG8_STAGE(PG8_SA(0, 1), cA + hstepA, voffA);
        if (wr == 1) PG8_BAR;
        PG8_WAIT_V(2); PG8_BAR;
        PG8_STAGE(PG8_SB(1, 0), cB + kstep, voffB); PG8_STAGE(PG8_SA(1, 0), cA + kstep, voffA); PG8_STAGE(PG8_SB(1, 1), cB + hstepB + kstep, voffB);
        PG8_WAIT_V(6); PG8_BAR;
    } else {
        PG8_STAGE(PG8_SB(0, 0), cB, voffB); PG8_STAGE(PG8_SA(0, 0), cA, voffA); PG8_STAGE(PG8_SB(0, 1), cB + hstepB, voffB); PG8_STAGE(PG8_SA(0, 1), cA + hstepA, voffA);
        if (wr == 1) PG8_BAR;
        PG8_WAIT_V(4); PG8_BAR;
        PG8_STAGE(PG8_SB(1, 0), cB + kstep, voffB); PG8_STAGE(PG8_SA(1, 0), cA + kstep, voffA); PG8_STAGE(PG8_SB(1, 1), cB + hstepB + kstep, voffB);
        PG8_WAIT_V(6); PG8_BAR;
    }
    for (;;) {
        const bool has_next = S.next(ui + 1, nxt);
        const char* nA = has_next ? (const char*)g.A + (size_t)nxt.pm * tstepA : cA; const char* nB = has_next ? (const char*)g.Bt + (size_t)nxt.pn * tstepB : cB;
        for (int t = 0; t < nt; t += 2) {
            const bool last = (t == nt - 2);
            const char* a1 = cA + (size_t)(t + 1) * kstep;
            const char* a2 = last ? nA : cA + (size_t)(t + 2) * kstep; const char* b2 = last ? nB : cB + (size_t)(t + 2) * kstep;
            const char* a3 = a2 + kstep; const char* b3 = b2 + kstep;
            if (last && has_next) S.a_ready(nxt);
            if constexpr (SP2) {
            PG8_LDB(B0, 0, 0); PG8_LDB(B1, 0, 1); PG8_SCHED; PG8_LDA(At, 0, 0); PG8_STAGE(PG8_SA(1, 1), a1 + hstepA, voffA);
            PG8_WAIT_V(8); PG8_WAIT_L(0); PG8_BAR; PG8_MMA(0, 0, At, B0); PG8_MMA(0, 1, At, B1); PG8_BAR; PG8_SCHED;
            PG8_LDA(At, 0, 1); PG8_STAGE(PG8_SB(0, 0), b2, voffB); PG8_STAGE(PG8_SB(0, 1), b2 + hstepB, voffB); PG8_STAGE(PG8_SA(0, 0), a2, voffA);
            PG8_WAIT_V(8); PG8_WAIT_L(0); PG8_BAR; PG8_MMA(1, 0, At, B0); PG8_MMA(1, 1, At, B1); PG8_BAR; PG8_SCHED;
            PG8_LDB(B0, 1, 0); PG8_LDB(B1, 1, 1); PG8_SCHED; PG8_LDA(At, 1, 0); PG8_STAGE(PG8_SA(0, 1), a2 + hstepA, voffA);
            PG8_WAIT_V(8); PG8_WAIT_L(0); PG8_BAR; PG8_MMA(0, 0, At, B0); PG8_MMA(0, 1, At, B1); PG8_BAR; PG8_SCHED;
            PG8_LDA(At, 1, 1); PG8_STAGE(PG8_SB(1, 0), b3, voffB); PG8_STAGE(PG8_SB(1, 1), b3 + hstepB, voffB); PG8_STAGE(PG8_SA(1, 0), a3, voffA);
            PG8_WAIT_V(8); PG8_WAIT_L(0); PG8_BAR; PG8_MMA(1, 0, At, B0); PG8_MMA(1, 1, At, B1); PG8_BAR; PG8_SCHED;
            } else {
            PG8_LDB(B0, 0, 0); PG8_SCHED; PG8_LDA(At, 0, 0); PG8_STAGE(PG8_SA(1, 1), a1 + hstepA, voffA);
            PG8_WAIT_L(8); PG8_BAR; PG8_WAIT_L(0); PG8_MMA(0, 0, At, B0); PG8_BAR; PG8_SCHED;
            PG8_LDB(B1, 0, 1); PG8_STAGE(PG8_SB(0, 0), b2, voffB);
            PG8_BAR; PG8_WAIT_L(0); PG8_MMA(0, 1, At, B1); PG8_BAR;
            PG8_LDA(At, 0, 1); PG8_STAGE(PG8_SA(0, 0), a2, voffA);
            PG8_BAR; PG8_WAIT_L(0); PG8_MMA(1, 0, At, B0); PG8_BAR; PG8_SCHED;
            PG8_STAGE(PG8_SB(0, 1), b2 + hstepB, voffB);
            PG8_WAIT_V(6); PG8_BAR; PG8_MMA(1, 1, At, B1); PG8_BAR;
            PG8_LDB(B0, 1, 0); PG8_SCHED; PG8_LDA(At, 1, 0); PG8_STAGE(PG8_SA(0, 1), a2 + hstepA, voffA);
            PG8_WAIT_L(8); PG8_BAR; PG8_WAIT_L(0); PG8_MMA(0, 0, At, B0); PG8_BAR; PG8_SCHED;
            PG8_LDB(B1, 1, 1); PG8_STAGE(PG8_SB(1, 0), b3, voffB);
            PG8_BAR; PG8_WAIT_L(0); PG8_MMA(0, 1, At, B1); PG8_BAR;
            PG8_LDA(At, 1, 1); PG8_STAGE(PG8_SA(1, 0), a3, voffA);
            PG8_BAR; PG8_WAIT_L(0); PG8_MMA(1, 0, At, B0); PG8_BAR; PG8_SCHED;
            PG8_STAGE(PG8_SB(1, 1), b3 + hstepB, voffB);
            PG8_WAIT_V(6); PG8_BAR; PG8_MMA(1, 1, At, B1); PG8_BAR;
            }
        }
        if constexpr (ALIGN_EPI) { if (wr == 0) PG8_BAR; }
        E(acc, cur, wr, wc, fr, fq); S.done(cur);
        if (!has_next) break;
#pragma unroll
        for (int a = 0; a < 2; ++a)
#pragma unroll
            for (int b = 0; b < 2; ++b)
#pragma unroll
                for (int m = 0; m < 4; ++m)
#pragma unroll
                    for (int n = 0; n < 2; ++n) acc[a][b][m][n] = (f32x4){0.f, 0.f, 0.f, 0.f};
        cur = nxt; cA = nA; cB = nB; ++ui;
        if constexpr (ALIGN_EPI) { if (wr == 1) PG8_BAR; }
    }
    PG8_WAIT_V(0);
    if constexpr (!ALIGN_EPI) { if (wr == 0) PG8_BAR; }
    PG8_BAR;
#undef PG8_SA
#undef PG8_SB
#undef PG8_STAGE
#undef PG8_LDA
#undef PG8_LDB
#undef PG8_MMA
#undef PG8_WAIT_V
#undef PG8_WAIT_L
#undef PG8_BAR
#undef PG8_SCHED
}
}

constexpr int NB = 4, SEQ = 8192, DM = 1024, TT = NB * SEQ, CTXL = 256, TC = NB * CTXL, FF = 2816, NH = 16, HD = 64, GW = 64, GROWS = SEQ / GW;
constexpr int WH = 8, WW = 16;
constexpr float EPS = 1e-6f;
constexpr int NWAVES = 8;

constexpr size_t MiB = 1u << 20;
constexpr size_t WS_CTL = 0, CTL_ZERO_BYTES = 64 * 1024;
constexpr size_t CT_BAR = 16384;
constexpr size_t CT_MODS = 64 * 1024;
constexpr size_t CT_BQKV = CT_MODS + 2 * 5 * 6144 * 4;
constexpr size_t CT_BUP0 = CT_BQKV + 5 * 3072 * 4;
constexpr size_t CT_BIN  = CT_BUP0 + 4 * 5632 * 4;
constexpr size_t CT_BUP1 = CT_BIN + 4 * 3072 * 4;
constexpr size_t CT_END  = CT_BUP1 + 4 * 5632 * 4;
static_assert(CT_END <= 1 * MiB, "ctl region");
constexpr size_t SM_SSQ0 = 1 * MiB, SM_SSQC = SM_SSQ0 + 32768 * 4, SM_GN = SM_SSQC + 1024 * 4;
constexpr size_t WS_SSQP = 2 * MiB;
constexpr size_t WS_FSQP = 448 * MiB;
constexpr size_t WS_WQKV = 8 * MiB, WS_WO = 14 * MiB, WS_WUP0 = 16 * MiB, WS_WDN0 = 27 * MiB, WS_WIN = 33 * MiB, WS_WOUT = 39 * MiB, WS_WUP1 = 41 * MiB, WS_WDN1 = 52 * MiB;
constexpr size_t WS_XSC = 58 * MiB, WS_KC = 60 * MiB, WS_VC = 62 * MiB;
constexpr size_t WS_XS = 64 * MiB;
constexpr size_t WS_Q = 128 * MiB, WS_K = 192 * MiB, WS_V = 256 * MiB, WS_O = 320 * MiB;
constexpr size_t WS_AG = 128 * MiB;
constexpr size_t WS_UT = 128 * MiB;
constexpr size_t WS_HT = 320 * MiB;
constexpr size_t WS_P = 384 * MiB;
constexpr size_t WS_END = 480 * MiB;

constexpr int RING_BYTES = 131072;
constexpr int LDSCTL_OFF = RING_BYTES, MISC_OFF = LDSCTL_OFF + 320;
constexpr int LDS_BYTES = 147456;

#define GAS __attribute__((address_space(1)))
#define LAS __attribute__((address_space(3)))
typedef unsigned short bf16;
typedef unsigned v4u __attribute__((ext_vector_type(4)));
typedef unsigned v2u __attribute__((ext_vector_type(2)));
typedef float f32x4 __attribute__((ext_vector_type(4)));
typedef GAS unsigned gu32;
#define RLX_AGENT __ATOMIC_RELAXED, __HIP_MEMORY_SCOPE_AGENT
#define LDS_WAIT() asm volatile("s_waitcnt lgkmcnt(0)" ::: "memory")
#define VM_WAIT() asm volatile("s_waitcnt vmcnt(0)" ::: "memory")
__device__ __forceinline__ unsigned f2bf(float f) { unsigned u = __builtin_bit_cast(unsigned, f); return (u + 0x7fffu + ((u >> 16) & 1u)) >> 16; }
__device__ __forceinline__ unsigned pk2(float lo, float hi) { return f2bf(lo) | (f2bf(hi) << 16); }
__device__ __forceinline__ float bf2f(unsigned short h) { return __builtin_bit_cast(float, (unsigned)h << 16); }
__device__ __forceinline__ float bflo(unsigned w) { return __builtin_bit_cast(float, w << 16); }
__device__ __forceinline__ float bfhi(unsigned w) { return __builtin_bit_cast(float, w & 0xffff0000u); }

#define XB_TMO      128
#define XB_XCNT(j)  (256  + 64 * (j))
#define XB_XSUB(j)  (1280 + 64 * (j))
#define XB_XGEN(j)  (2304 + 64 * (j))
#define XB_TOP      3328
#define XB_TOPGEN   3392
#define XCD_BAR_WORDS 3456
#define XB_SPIN_CAP (1u << 18)
__device__ __forceinline__ unsigned xb_ld(unsigned* p)              { return __hip_atomic_load(p, __ATOMIC_RELAXED, __HIP_MEMORY_SCOPE_AGENT); }
__device__ __forceinline__ unsigned xb_add(unsigned* p, unsigned v) { return __hip_atomic_fetch_add(p, v, __ATOMIC_RELAXED, __HIP_MEMORY_SCOPE_AGENT); }
__device__ __forceinline__ unsigned xb_xcc_id() { return (unsigned)__builtin_amdgcn_s_getreg((3 << 11) | 20) & 0xFu; }
#define XB_SPIN(cond, bar) do { unsigned _sp = 0; while (cond) { __builtin_amdgcn_s_sleep(1); \
    if ((++_sp & 255u) == 0u) { if (xb_ld(&(bar)[XB_TMO])) break; if (_sp > XB_SPIN_CAP) { atomicAdd(&(bar)[XB_TMO], 1u); break; } } } } while (0)
struct XcdBarrier { unsigned* bar; unsigned x; volatile LAS unsigned* st; };
__device__ __forceinline__ XcdBarrier xcd_barrier_post(unsigned* bar, volatile LAS unsigned* st) {
    XcdBarrier b; b.bar = bar; b.x = xb_xcc_id(); b.st = st;
    if (threadIdx.x == 0) (void)xb_add(&bar[XB_XCNT(b.x)], 1u);
    return b;
}
__device__ __forceinline__ void xcd_barrier_complete(unsigned* bar, unsigned x, unsigned& nloc, unsigned& nx) {
    const unsigned G = gridDim.x * gridDim.y * gridDim.z;
    unsigned sum, cnt, mine, sp = 0u;
    for (;;) {
        sum = 0u; cnt = 0u; mine = 0u;
#pragma unroll
        for (unsigned j = 0; j < 16; ++j) { const unsigned c = xb_ld(&bar[XB_XCNT(j)]); sum += c; cnt += (c > 0u) ? 1u : 0u; mine = (j == x) ? c : mine; }
        if (sum == G) break;
        __builtin_amdgcn_s_sleep(1);
        if ((++sp & 255u) == 0u) { if (xb_ld(&bar[XB_TMO])) break; if (sp > XB_SPIN_CAP) { atomicAdd(&bar[XB_TMO], 1u); break; } }
    }
    nloc = mine > 0u ? mine : 1u; nx = cnt > 0u ? cnt : 1u;
}
__device__ __forceinline__ void xcd_barrier(const XcdBarrier& b) {
    asm volatile("s_waitcnt vmcnt(0)" ::: "memory");
    __syncthreads();
    if (threadIdx.x == 0) {
        unsigned* bar = b.bar;
        __builtin_amdgcn_s_waitcnt(0);
        unsigned nloc = b.st[0], nx = b.st[1];
        if (nloc == 0u) { xcd_barrier_complete(bar, b.x, nloc, nx); b.st[0] = nloc; b.st[1] = nx; }
        const unsigned old = xb_add(&bar[XB_XSUB(b.x)], 1u);
        const unsigned gen = old / nloc;
        if (old + 1u == (gen + 1u) * nloc) {
            __builtin_amdgcn_fence(__ATOMIC_RELEASE, "agent");
            asm volatile("s_waitcnt vmcnt(0)" ::: "memory");
            const unsigned og = xb_add(&bar[XB_TOP], 1u);
            const unsigned tg = og / nx;
            if (og + 1u == (tg + 1u) * nx) xb_add(&bar[XB_TOPGEN], 1u);
            else XB_SPIN(xb_ld(&bar[XB_TOPGEN]) == tg, bar);
            __builtin_amdgcn_fence(__ATOMIC_ACQUIRE, "agent");
            xb_add(&bar[XB_XGEN(b.x)], 1u);
            asm volatile("s_waitcnt vmcnt(0)" ::: "memory");
        } else {
            XB_SPIN(xb_ld(&bar[XB_XGEN(b.x)]) == gen, bar);
            __builtin_amdgcn_fence(__ATOMIC_ACQUIRE, "agent");
            asm volatile("s_waitcnt vmcnt(0)" ::: "memory");
        }
    }
    __syncthreads();
}

struct Args { const float* in[40]; float* out; unsigned char* ws; int ph_lo, ph_hi; };
struct Frame {
    LAS unsigned char* lds;
    int tid, lane, wave, vcu, G;
    const float* const* in; float* out; unsigned char* ws;
};
__device__ __forceinline__ float wave_sum(float v) {
#pragma unroll
    for (int o = 1; o < 64; o <<= 1) v += __shfl_xor(v, o);
    return v;
}
__device__ __forceinline__ float silu_f(float x) { return x / (1.f + __expf(-x)); }

__device__ __forceinline__ float gelu_f(float v) { return 0.5f * v * (1.f + erff(v * 0.70710678118654752f)); }

__device__ __forceinline__ void transpose_item(const float* W, int K, int N, bf16* WT, int src_col0, int dst_row0, int k0, LAS float* scr, int lane) {
#pragma unroll 8
    for (int i = 0; i < 32; ++i) { const int kk = 2 * i + (lane >> 5); scr[kk * 33 + (lane & 31)] = W[(size_t)(k0 + kk) * N + src_col0 + (lane & 31)]; }
    LDS_WAIT(); asm volatile("" ::: "memory");
    const int c = lane & 7;
#pragma unroll
    for (int j = 0; j < 4; ++j) { const int n = (lane >> 3) + 8 * j; const LAS float* s = scr + (8 * c) * 33 + n;
        v4u o; o.x = pk2(s[0 * 33], s[1 * 33]); o.y = pk2(s[2 * 33], s[3 * 33]); o.z = pk2(s[4 * 33], s[5 * 33]); o.w = pk2(s[6 * 33], s[7 * 33]);
        *(GAS v4u*)(WT + (size_t)(dst_row0 + n) * K + k0 + 8 * c) = o; }
    LDS_WAIT(); asm volatile("" ::: "memory");
}
__device__ __forceinline__ int qkv_slot_to_col(int slot) {
    const int part = slot >> 10, cc = slot & 1023, pnl = cc >> 8, s = cc & 255, bj = s >> 7, wc = (s & 127) >> 5, j = s & 31;
    return part * 1024 + (4 * pnl + wc) * 64 + 32 * bj + j;
}
__device__ __forceinline__ void cvt_weight_item(const float* W, int K, int N, bf16* WT, int item, LAS float* scr, int lane, bool qkvperm) {
    const int nblk = N / 32, kb = item / nblk, nb = item % nblk;
    const int dst = 32 * nb, src = qkvperm ? qkv_slot_to_col(dst) : dst;
    transpose_item(W, K, N, WT, src, dst, 64 * kb, scr, lane);
}

template <int R, class VF>
__device__ __forceinline__ void gemv_det_item(const float* W, int N, int n0, float* out, int ostride, const float* addbias, const VF& vf, int tid, LAS float* scr) {
    const int col = tid & 63, ks = tid >> 6;
    float acc[R];
#pragma unroll
    for (int r = 0; r < R; ++r) acc[r] = 0.f;
    const float* wp = W + (size_t)(ks * 128) * N + n0 + col;
#pragma unroll 8
    for (int k = 0; k < 128; ++k) { const float w = wp[(size_t)k * N];
#pragma unroll
        for (int r = 0; r < R; ++r) acc[r] += vf(r, ks * 128 + k) * w; }
    __syncthreads();
#pragma unroll
    for (int r = 0; r < R; ++r) scr[(ks * R + r) * 64 + col] = acc[r];
    __syncthreads();
    if (tid < R * 64) { const int r = tid >> 6; float s = 0.f;
#pragma unroll
        for (int k2 = 0; k2 < 8; ++k2) s += scr[(k2 * R + r) * 64 + col];
        if (addbias) s += addbias[n0 + col];
        out[(size_t)r * ostride + n0 + col] = s; }
}

__device__ __forceinline__ void phase0a(Frame& F) {
    const float* const* in = F.in;
    float* mods = (float*)(F.ws + CT_MODS);
    {
        const float* c = in[1]; const float* cctx = in[3];
        auto vf = [&](int r, int k) -> float { const float v = (r < 4) ? c[r * DM + k] : cctx[k]; return silu_f(v); };
        const int nitems = 2 * 96;
        for (int it = F.vcu; it < nitems; it += F.G) {
            const int l = it / 96, cg = it % 96;
            gemv_det_item<5>(in[l ? 17 : 4], 6144, cg * 64, mods + l * 5 * 6144, 6144, in[l ? 18 : 5], vf, F.tid, (LAS float*)F.lds);
        }
        __syncthreads();
    }
    LAS float* scr = (LAS float*)(F.lds + F.wave * 16384);
    const int gw = F.vcu * NWAVES + F.wave, NGW = F.G * NWAVES;
    constexpr int I_QKV = 16 * 96, I_O = 16 * 32, I_UP = 16 * 176, I_DN = 44 * 32;
    constexpr int NITEMS = 2 * I_QKV + 2 * I_O + 2 * I_UP + 2 * I_DN;
    for (int it = gw; it < NITEMS; it += NGW) {
        int r = it;
        if (r < I_QKV) { cvt_weight_item(in[8], DM, 3 * DM, (bf16*)(F.ws + WS_WQKV), r, scr, F.lane, true); continue; } r -= I_QKV;
        if (r < I_O) { cvt_weight_item(in[12], DM, DM, (bf16*)(F.ws + WS_WO), r, scr, F.lane, false); continue; } r -= I_O;
        if (r < I_UP) { cvt_weight_item(in[13], DM, 2 * FF, (bf16*)(F.ws + WS_WUP0), r, scr, F.lane, false); continue; } r -= I_UP;
        if (r < I_DN) { cvt_weight_item(in[16], FF, DM, (bf16*)(F.ws + WS_WDN0), r, scr, F.lane, false); continue; } r -= I_DN;
        if (r < I_QKV) { cvt_weight_item(in[21], DM, 3 * DM, (bf16*)(F.ws + WS_WIN), r, scr, F.lane, false); continue; } r -= I_QKV;
        if (r < I_O) { cvt_weight_item(in[34], DM, DM, (bf16*)(F.ws + WS_WOUT), r, scr, F.lane, false); continue; } r -= I_O;
        if (r < I_UP) { cvt_weight_item(in[36], DM, 2 * FF, (bf16*)(F.ws + WS_WUP1), r, scr, F.lane, false); continue; } r -= I_UP;
        cvt_weight_item(in[39], FF, DM, (bf16*)(F.ws + WS_WDN1), r, scr, F.lane, false);
    }
}

__device__ __forceinline__ void row_prescale(const float* xrow, const float* gain, const float* sc, bf16* orow, float* ssq_out, int lane) {
    const GAS f32x4* xr = (const GAS f32x4*)xrow + lane;
    const GAS f32x4* gr = (const GAS f32x4*)gain + lane;
    const GAS f32x4* sr = (const GAS f32x4*)sc + lane;
    f32x4 v[4]; float s = 0.f;
#pragma unroll
    for (int j = 0; j < 4; ++j) { v[j] = xr[64 * j]; s += (v[j].x * v[j].x + v[j].y * v[j].y) + (v[j].z * v[j].z + v[j].w * v[j].w); }
    s = wave_sum(s);
    if (lane == 0) *ssq_out = s;
    GAS unsigned long long* o8 = (GAS unsigned long long*)orow + lane;
#pragma unroll
    for (int j = 0; j < 4; ++j) { const f32x4 g = gr[64 * j], c = sr[64 * j]; const f32x4 w = v[j] * g * (c + 1.0f);
        o8[64 * j] = (unsigned long long)pk2(w.x, w.y) | ((unsigned long long)pk2(w.z, w.w) << 32); }
}
__device__ __forceinline__ void phase0b(Frame& F) {
    const float* const* in = F.in;
    const float* mods = (const float*)(F.ws + CT_MODS);
    const int gw = F.vcu * NWAVES + F.wave, NGW = F.G * NWAVES;
    for (int m = gw; m < TT + TC; m += NGW) {
        if (m < TT) { const int b = m / SEQ; row_prescale(in[0] + (size_t)m * DM, in[6], mods + b * 6144 + 1024, (bf16*)(F.ws + WS_XS) + (size_t)m * DM, (float*)(F.ws + SM_SSQ0) + m, F.lane); }
        else { const int mc = m - TT; row_prescale(in[2] + (size_t)mc * DM, in[6], mods + 4 * 6144 + 1024, (bf16*)(F.ws + WS_XSC) + (size_t)mc * DM, (float*)(F.ws + SM_SSQC) + mc, F.lane); }
    }
    {
        float* gn = (float*)(F.ws + SM_GN);
        for (int e = F.vcu * 512 + F.tid; e < 3 * 4 * 1024; e += F.G * 512) {
            const int i = e / 4096, b = (e / 1024) & 3, k = e & 1023;
            const float* g = in[i == 0 ? 7 : (i == 1 ? 19 : 20)];
            const float sc = mods[(i == 0 ? 0 : 1) * 5 * 6144 + b * 6144 + (i == 1 ? 1024 : 4096) + k];
            gn[e] = g[k] * (1.f + sc);
        }
    }
    {
        const int n_qkv = 48, n_up = 88, n_in = 48;
        const int nitems = n_qkv + n_up + n_in + n_up;
        LAS float* gs = (LAS float*)F.lds;
        for (int it0 = F.vcu; it0 < nitems; it0 += F.G) {
            int it = it0;
            if (it < n_qkv) { auto vf = [&](int r, int k) -> float { return mods[r * 6144 + k]; };
                gemv_det_item<5>(in[8], 3072, it * 64, (float*)(F.ws + CT_BQKV), 3072, nullptr, vf, F.tid, gs); continue; } it -= n_qkv;
            if (it < n_up) { auto vf = [&](int r, int k) -> float { return mods[r * 6144 + 3072 + k]; };
                gemv_det_item<4>(in[13], 5632, it * 64, (float*)(F.ws + CT_BUP0), 5632, nullptr, vf, F.tid, gs); continue; } it -= n_up;
            if (it < n_in) { auto vf = [&](int r, int k) -> float { return mods[5 * 6144 + r * 6144 + k]; };
                gemv_det_item<4>(in[21], 3072, it * 64, (float*)(F.ws + CT_BIN), 3072, in[22], vf, F.tid, gs); continue; } it -= n_in;
            { auto vf = [&](int r, int k) -> float { return mods[5 * 6144 + r * 6144 + 3072 + k]; };
                gemv_det_item<4>(in[36], 5632, it * 64, (float*)(F.ws + CT_BUP1), 5632, nullptr, vf, F.tid, gs); }
        }
        __syncthreads();
    }
}

using pg8::f32x4; using pg8::Unit;
__device__ __forceinline__ float row_rs(const float* ssq, int np, int row) {
    float s = 0.f;
    for (int i = 0; i < np; ++i) s += ssq[(size_t)i * TT + row];
    return 1.0f / sqrtf(s * (1.0f / 1024.0f) + EPS);
}
struct EpiQKV {
    static constexpr bool PERM = true;
    bf16* obase; size_t pstride; const float* ssq; int np; const float* bias; int bias_bstride; const float *qg, *kg; int pn_off;
    __device__ __forceinline__ void operator()(const f32x4 (&acc)[2][2][4][2], const Unit& u, int wr, int wc, int fr, int fq) const {
        const int png = u.pn + pn_off, part = png >> 2, pnl = png & 3, head = 4 * pnl + wc;
        const int b = (u.pm * 256) / SEQ;
        const float* bp = bias + (size_t)b * bias_bstride + part * 1024 + head * 64;
        bf16* dst = obase + (size_t)part * pstride;
        const float* gp = part == 0 ? qg : kg;
        f32x4 bv[2][2], gv[2][2];
#pragma unroll
        for (int bj = 0; bj < 2; ++bj)
#pragma unroll
            for (int n = 0; n < 2; ++n) { const int d0 = 32 * bj + 8 * fq + 4 * n; bv[bj][n] = *(const f32x4*)(bp + d0); gv[bj][n] = *(const f32x4*)(gp + d0); }
#pragma unroll
        for (int ai = 0; ai < 2; ++ai)
#pragma unroll
            for (int m = 0; m < 4; ++m) {
                const int row = u.pm * 256 + ai * 128 + wr * 64 + m * 16 + fr;
                const float rs = row_rs(ssq, np, row);
                f32x4 v[2][2]; float ss = 0.f;
#pragma unroll
                for (int bj = 0; bj < 2; ++bj)
#pragma unroll
                    for (int n = 0; n < 2; ++n) { v[bj][n] = acc[ai][bj][m][n] * rs + bv[bj][n]; const f32x4 t = v[bj][n]; ss += (t.x * t.x + t.y * t.y) + (t.z * t.z + t.w * t.w); }
                if (part < 2) {
                    ss += __shfl_xor(ss, 16); ss += __shfl_xor(ss, 32);
                    const float rn = 1.0f / sqrtf(ss * (1.0f / 64.0f) + EPS);
#pragma unroll
                    for (int bj = 0; bj < 2; ++bj)
#pragma unroll
                        for (int n = 0; n < 2; ++n) v[bj][n] = v[bj][n] * rn * gv[bj][n];
                }
                bf16* rowp = dst + (size_t)row * DM + head * 64 + 8 * fq;
#pragma unroll
                for (int bj = 0; bj < 2; ++bj) { v4u w; w.x = pk2(v[bj][0].x, v[bj][0].y); w.y = pk2(v[bj][0].z, v[bj][0].w); w.z = pk2(v[bj][1].x, v[bj][1].y); w.w = pk2(v[bj][1].z, v[bj][1].w);
                    *(v4u*)(rowp + 32 * bj) = w; }
            }
    }
};
struct EpiRes {
    static constexpr bool PERM = true;
    const float* base; float* out; const float* gate; const float* bias; const float* gn; bf16* xs; float* ssq;
    __device__ __forceinline__ void operator()(const f32x4 (&acc)[2][2][4][2], const Unit& u, int wr, int wc, int fr, int fq) const {
        const int b = (u.pm * 256) / SEQ;
        const int col0 = u.pn * 256 + wc * 32 + 8 * fq;
        f32x4 gt[2][2], bv[2][2], gv[2][2];
#pragma unroll
        for (int bj = 0; bj < 2; ++bj)
#pragma unroll
            for (int n = 0; n < 2; ++n) { const int c = col0 + 128 * bj + 4 * n; gt[bj][n] = *(const f32x4*)(gate + (size_t)b * 6144 + c);
                bv[bj][n] = bias ? *(const f32x4*)(bias + c) : (f32x4){0.f, 0.f, 0.f, 0.f};
                gv[bj][n] = gn ? *(const f32x4*)(gn + (size_t)b * 1024 + c) : (f32x4){0.f, 0.f, 0.f, 0.f}; }
#pragma unroll
        for (int ai = 0; ai < 2; ++ai)
#pragma unroll
            for (int m = 0; m < 4; ++m) {
                const int row = u.pm * 256 + ai * 128 + wr * 64 + m * 16 + fr;
                const size_t off = (size_t)row * DM + col0;
                float ss = 0.f;
#pragma unroll
                for (int bj = 0; bj < 2; ++bj) {
                    f32x4 xn[2];
#pragma unroll
                    for (int n = 0; n < 2; ++n) { const f32x4 bs = *(const f32x4*)(base + off + 128 * bj + 4 * n);
                        xn[n] = bs + gt[bj][n] * (acc[ai][bj][m][n] + bv[bj][n]);
                        *(f32x4*)(out + off + 128 * bj + 4 * n) = xn[n];
                        ss += (xn[n].x * xn[n].x + xn[n].y * xn[n].y) + (xn[n].z * xn[n].z + xn[n].w * xn[n].w); }
                    if (xs) { const f32x4 a0 = xn[0] * gv[bj][0], a1 = xn[1] * gv[bj][1];
                        v4u w; w.x = pk2(a0.x, a0.y); w.y = pk2(a0.z, a0.w); w.z = pk2(a1.x, a1.y); w.w = pk2(a1.z, a1.w);
                        *(v4u*)(xs + off + 128 * bj) = w; }
                }
                if (ssq) { ss += __shfl_xor(ss, 16); ss += __shfl_xor(ss, 32); if (fq == 0) ssq[(size_t)(u.pn * 4 + wc) * TT + row] = ss; }
                asm volatile("" ::: "memory");
            }
    }
};
struct EpiScaleBias {
    static constexpr bool PERM = true;
    bf16* O; int ldc; const float* ssq; int np; const float* bias; int bias_bstride;
    __device__ __forceinline__ void operator()(const f32x4 (&acc)[2][2][4][2], const Unit& u, int wr, int wc, int fr, int fq) const {
        const int b = (u.pm * 256) / SEQ;
        const int col0 = u.pn * 256 + wc * 32 + 8 * fq;
        f32x4 bv[2][2];
#pragma unroll
        for (int bj = 0; bj < 2; ++bj)
#pragma unroll
            for (int n = 0; n < 2; ++n) bv[bj][n] = *(const f32x4*)(bias + (size_t)b * bias_bstride + col0 + 128 * bj + 4 * n);
#pragma unroll
        for (int ai = 0; ai < 2; ++ai)
#pragma unroll
            for (int m = 0; m < 4; ++m) {
                const int row = u.pm * 256 + ai * 128 + wr * 64 + m * 16 + fr;
                const float rs = row_rs(ssq, np, row);
                bf16* rowp = O + (size_t)row * ldc + col0;
#pragma unroll
                for (int bj = 0; bj < 2; ++bj) { const f32x4 v0 = acc[ai][bj][m][0] * rs + bv[bj][0], v1 = acc[ai][bj][m][1] * rs + bv[bj][1];
                    v4u w; w.x = pk2(v0.x, v0.y); w.y = pk2(v0.z, v0.w); w.z = pk2(v1.x, v1.y); w.w = pk2(v1.z, v1.w);
                    *(v4u*)(rowp + 128 * bj) = w; }
            }
    }
};
struct EpiInT {
    static constexpr bool PERM = true;
    bf16* UT; const float* ssq; int np; const float* bias;
    __device__ __forceinline__ void operator()(const f32x4 (&acc)[2][2][4][2], const Unit& u, int wr, int wc, int fr, int fq) const {
        const int b = (u.pm * 256) / SEQ;
        const int col0 = u.pn * 256 + wc * 32 + 8 * fq;
        f32x4 bv[2][2];
#pragma unroll
        for (int bj = 0; bj < 2; ++bj)
#pragma unroll
            for (int n = 0; n < 2; ++n) bv[bj][n] = *(const f32x4*)(bias + (size_t)b * 3072 + col0 + 128 * bj + 4 * n);
#pragma unroll
        for (int ai = 0; ai < 2; ++ai)
#pragma unroll
            for (int m = 0; m < 4; ++m) {
                const int row = u.pm * 256 + ai * 128 + wr * 64 + m * 16 + fr;
                const int t = row - b * SEQ;
                const float rs = row_rs(ssq, np, row);
#pragma unroll
                for (int bj = 0; bj < 2; ++bj)
#pragma unroll
                    for (int n = 0; n < 2; ++n) { const f32x4 v = acc[ai][bj][m][n] * rs + bv[bj][n];
                        bf16* p = UT + ((size_t)b * 3072 + col0 + 128 * bj + 4 * n) * SEQ + t;
                        p[0] = (bf16)f2bf(v.x); p[SEQ] = (bf16)f2bf(v.y); p[2 * SEQ] = (bf16)f2bf(v.z); p[3 * SEQ] = (bf16)f2bf(v.w); }
            }
    }
};

__device__ __forceinline__ float dot8(const v4u w, const float* q) {
    return q[0] * bflo(w.x) + q[1] * bfhi(w.x) + q[2] * bflo(w.y) + q[3] * bfhi(w.y) + q[4] * bflo(w.z) + q[5] * bfhi(w.z) + q[6] * bflo(w.w) + q[7] * bfhi(w.w);
}
__device__ __forceinline__ void attn_naive_phase(Frame& F) {
    const bf16* Q = (const bf16*)(F.ws + WS_Q); const bf16* Kb = (const bf16*)(F.ws + WS_K); const bf16* Vb = (const bf16*)(F.ws + WS_V);
    const bf16* Kc = (const bf16*)(F.ws + WS_KC); const bf16* Vc = (const bf16*)(F.ws + WS_VC);
    bf16* O = (bf16*)(F.ws + WS_O);
    const float* rpb = F.in[11];
    LAS float* sl = (LAS float*)(F.lds) + F.tid;
    const int gw = F.vcu * NWAVES + F.wave, NGW = F.G * NWAVES;
    const int c = F.lane;
    for (int unit = gw; unit < NB * GROWS * NH; unit += NGW) {
        const int h = unit % NH, r = (unit / NH) % GROWS, b = unit / (NH * GROWS);
        const int r0 = min(max(r - WH / 2, 0), GROWS - WH), c0 = min(max(c - WW / 2, 0), GW - WW);
        const size_t tok = (size_t)b * SEQ + r * GW + c;
        float q[64];
        {
            const v4u* qp = (const v4u*)(Q + tok * DM + h * HD);
#pragma unroll
            for (int i = 0; i < 8; ++i) { const v4u w = qp[i];
                q[8 * i + 0] = bflo(w.x) * 0.125f; q[8 * i + 1] = bfhi(w.x) * 0.125f; q[8 * i + 2] = bflo(w.y) * 0.125f; q[8 * i + 3] = bfhi(w.y) * 0.125f;
                q[8 * i + 4] = bflo(w.z) * 0.125f; q[8 * i + 5] = bfhi(w.z) * 0.125f; q[8 * i + 6] = bflo(w.w) * 0.125f; q[8 * i + 7] = bfhi(w.w) * 0.125f; }
        }
        float o[64];
#pragma unroll
        for (int d = 0; d < 64; ++d) o[d] = 0.f;
        float mrun = -1e30f, lrun = 0.f;
        for (int ch = 0; ch < 24; ++ch) {
            const bf16* kbase; const bf16* vbase;
            if (ch < 8) { const size_t kt = (size_t)b * SEQ + (size_t)(r0 + ch) * GW + c0; kbase = Kb + kt * DM + h * HD; vbase = Vb + kt * DM + h * HD; }
            else { const size_t kt = (size_t)b * CTXL + (size_t)(ch - 8) * 16; kbase = Kc + kt * DM + h * HD; vbase = Vc + kt * DM + h * HD; }
            float mx = -1e30f;
#pragma unroll 1
            for (int j = 0; j < 16; ++j) {
                const v4u* kp = (const v4u*)(kbase + (size_t)j * DM);
                float a = 0.f;
#pragma unroll
                for (int i = 0; i < 8; ++i) a += dot8(kp[i], q + 8 * i);
                if (ch < 8) a += rpb[(h * 15 + (r0 + ch - r + WH - 1)) * 31 + (c0 + j - c + WW - 1)];
                sl[j * 512] = a; mx = fmaxf(mx, a);
            }
            const float mnew = fmaxf(mrun, mx);
            const float alpha = __expf(mrun - mnew);
            mrun = mnew; lrun *= alpha;
#pragma unroll
            for (int d = 0; d < 64; ++d) o[d] *= alpha;
#pragma unroll 1
            for (int j = 0; j < 16; ++j) {
                const float p = __expf(sl[j * 512] - mnew); lrun += p;
                const v4u* vp = (const v4u*)(vbase + (size_t)j * DM);
#pragma unroll
                for (int i = 0; i < 8; ++i) { const v4u w = vp[i];
                    o[8 * i + 0] += p * bflo(w.x); o[8 * i + 1] += p * bfhi(w.x); o[8 * i + 2] += p * bflo(w.y); o[8 * i + 3] += p * bfhi(w.y);
                    o[8 * i + 4] += p * bflo(w.z); o[8 * i + 5] += p * bfhi(w.z); o[8 * i + 6] += p * bflo(w.w); o[8 * i + 7] += p * bfhi(w.w); }
            }
        }
        const float inv = 1.0f / lrun;
        v4u* op = (v4u*)(O + tok * DM + h * HD);
#pragma unroll
        for (int i = 0; i < 8; ++i) { v4u w; w.x = pk2(o[8 * i] * inv, o[8 * i + 1] * inv); w.y = pk2(o[8 * i + 2] * inv, o[8 * i + 3] * inv); w.z = pk2(o[8 * i + 4] * inv, o[8 * i + 5] * inv); w.w = pk2(o[8 * i + 6] * inv, o[8 * i + 7] * inv); op[i] = w; }
    }
}

__device__ __forceinline__ void convglu_phase(Frame& F, const float* cw, const float* cb) {
    bf16* ag = (bf16*)(F.ws + WS_AG);
    const long nvec = (long)TT * (FF / 8);
    for (long e = (long)F.vcu * 512 + F.tid; e < nvec; e += (long)F.G * 512) {
        const int t = (int)(e / (FF / 8)), j0 = (int)(e % (FF / 8)) * 8;
        const int tl = t % SEQ;
        const bf16* rowp = ag + (size_t)t * (2 * FF);
        const v4u a = *(const v4u*)(rowp + j0);
        const v4u g0 = *(const v4u*)(rowp + FF + j0);
        v4u gm = (v4u){0u, 0u, 0u, 0u}, gp = (v4u){0u, 0u, 0u, 0u};
        if (tl > 0) gm = *(const v4u*)(rowp - 2 * FF + FF + j0);
        if (tl < SEQ - 1) gp = *(const v4u*)(rowp + 2 * FF + FF + j0);
        float av[8], g0v[8], gmv[8], gpv[8];
        av[0] = bflo(a.x); av[1] = bfhi(a.x); av[2] = bflo(a.y); av[3] = bfhi(a.y); av[4] = bflo(a.z); av[5] = bfhi(a.z); av[6] = bflo(a.w); av[7] = bfhi(a.w);
        g0v[0] = bflo(g0.x); g0v[1] = bfhi(g0.x); g0v[2] = bflo(g0.y); g0v[3] = bfhi(g0.y); g0v[4] = bflo(g0.z); g0v[5] = bfhi(g0.z); g0v[6] = bflo(g0.w); g0v[7] = bfhi(g0.w);
        gmv[0] = bflo(gm.x); gmv[1] = bfhi(gm.x); gmv[2] = bflo(gm.y); gmv[3] = bfhi(gm.y); gmv[4] = bflo(gm.z); gmv[5] = bfhi(gm.z); gmv[6] = bflo(gm.w); gmv[7] = bfhi(gm.w);
        gpv[0] = bflo(gp.x); gpv[1] = bfhi(gp.x); gpv[2] = bflo(gp.y); gpv[3] = bfhi(gp.y); gpv[4] = bflo(gp.z); gpv[5] = bfhi(gp.z); gpv[6] = bflo(gp.w); gpv[7] = bfhi(gp.w);
        float r[8];
#pragma unroll
        for (int i = 0; i < 8; ++i) { const int j = j0 + i; const float cv = cw[j] * gmv[i] + cw[FF + j] * g0v[i] + cw[2 * FF + j] * gpv[i] + cb[j]; r[i] = av[i] * gelu_f(cv); }
        v4u w; w.x = pk2(r[0], r[1]); w.y = pk2(r[2], r[3]); w.z = pk2(r[4], r[5]); w.w = pk2(r[6], r[7]);
        *(v4u*)(ag + (size_t)t * (2 * FF) + j0) = w;
    }
}

__device__ __forceinline__ void filtgen_phase(Frame& F) {
    const float* const* in = F.in;
    const float *w1 = in[25], *b1 = in[26], *w2 = in[27], *b2 = in[28], *w3 = in[29], *b3 = in[30], *wout = in[31], *freq = in[32];
    float* hT = (float*)(F.ws + WS_HT); float* fsqp = (float*)(F.ws + WS_FSQP);
    LAS float* zf = (LAS float*)(F.lds);
    LAS float* ha = zf + 16 * 36;
    LAS float* hb = ha + 16 * 64;
    const int tid = F.tid;
    for (int item = F.vcu; item < SEQ / 16; item += F.G) {
        const int l0 = item * 16;
        __syncthreads();
        for (int e = tid; e < 16 * 33; e += 512) {
            const int p = e / 33, i = e % 33, l = l0 + p;
            float v;
            if (i == 0) v = (float)l / 8191.0f;
            else { const int bi = (i - 1) & 15; const float band = 1e-4f + (float)bi * ((15.0f - 1e-4f) / 15.0f);
                const float w = (float)(2.0 * 3.14159265358979323846 / 8192.0) * (float)l; const float arg = band * w;
                v = (i <= 16) ? cosf(arg) : -sinf(arg); }
            zf[p * 36 + i] = v;
        }
        __syncthreads();
        for (int e = tid; e < 16 * 64; e += 512) { const int p = e >> 6, j = e & 63; float a = b1[j];
            for (int i = 0; i < 33; ++i) a += zf[p * 36 + i] * w1[i * 64 + j];
            ha[p * 64 + j] = sinf(freq[j] * a); }
        __syncthreads();
        for (int e = tid; e < 16 * 64; e += 512) { const int p = e >> 6, j = e & 63; float a = b2[j];
            for (int i = 0; i < 64; ++i) a += ha[p * 64 + i] * w2[i * 64 + j];
            hb[p * 64 + j] = sinf(freq[j] * a); }
        __syncthreads();
        for (int e = tid; e < 16 * 64; e += 512) { const int p = e >> 6, j = e & 63; float a = b3[j];
            for (int i = 0; i < 64; ++i) a += hb[p * 64 + i] * w3[i * 64 + j];
            ha[p * 64 + j] = sinf(freq[j] * a); }
        __syncthreads();
        float sq[2] = {0.f, 0.f};
#pragma unroll
        for (int q = 0; q < 4; ++q) {
            const int n = tid + 512 * q, dir = n >> 10, c = n & 1023;
            float acc[16];
#pragma unroll
            for (int p = 0; p < 16; ++p) acc[p] = 0.f;
            for (int j = 0; j < 64; ++j) { const float w = wout[j * 2048 + n];
#pragma unroll
                for (int p = 0; p < 16; ++p) acc[p] += ha[p * 64 + j] * w; }
            const float la = -15.350567286626973f, lb = -3.0701134573253946f;
            const float delta = fabsf(la + (float)c * ((lb - la) / 1023.0f));
            float* op = hT + ((size_t)dir * 1024 + c) * SEQ + l0;
#pragma unroll
            for (int p = 0; p < 16; ++p) { const float tpos = (float)(l0 + p) / 8191.0f; const float v = acc[p] * expf(-tpos * delta); op[p] = v; sq[q & 1] += v * v; }
        }
        fsqp[(size_t)item * 1024 + tid] = sq[0]; fsqp[(size_t)item * 1024 + tid + 512] = sq[1];
    }
    __syncthreads();
}

__device__ __forceinline__ void hyena_naive_phase(Frame& F) {
    const float* const* in = F.in;
    const float* sw = in[23]; const float* sb = in[24]; const float* dbias = in[33];
    bf16* UT = (bf16*)(F.ws + WS_UT); const float* hT = (const float*)(F.ws + WS_HT); const float* fsqp = (const float*)(F.ws + WS_FSQP);
    LAS float* zl = (LAS float*)(F.lds);
    LAS float* fl = zl + SEQ;
    const int tid = F.tid;
    for (int unit = F.vcu; unit < NB * DM; unit += F.G) {
        const int b = unit / DM, c = unit % DM;
        __syncthreads();
        const bf16* x0r = UT + ((size_t)b * 3072 + c) * SEQ;
        const bf16* x1r = UT + ((size_t)b * 3072 + 1024 + c) * SEQ;
        const bf16* vr = UT + ((size_t)b * 3072 + 2048 + c) * SEQ;
        const float w10 = sw[1024 + c], w11 = sw[3072 + 1024 + c], w12 = sw[6144 + 1024 + c], bb1 = sb[1024 + c];
        const float wv0 = sw[2048 + c], wv1 = sw[3072 + 2048 + c], wv2 = sw[6144 + 2048 + c], bbv = sb[2048 + c];
        const float w00 = sw[c], w01 = sw[3072 + c], w02 = sw[6144 + c], bb0 = sb[c];
        float x0c[16];
#pragma unroll
        for (int i = 0; i < 16; ++i) {
            const int t = tid + 512 * i;
            const float x1m = t > 0 ? bf2f(x1r[t - 1]) : 0.f, x1z = bf2f(x1r[t]), x1p = t < SEQ - 1 ? bf2f(x1r[t + 1]) : 0.f;
            const float vm = t > 0 ? bf2f(vr[t - 1]) : 0.f, vz = bf2f(vr[t]), vp = t < SEQ - 1 ? bf2f(vr[t + 1]) : 0.f;
            const float x0m = t > 0 ? bf2f(x0r[t - 1]) : 0.f, x0z = bf2f(x0r[t]), x0p = t < SEQ - 1 ? bf2f(x0r[t + 1]) : 0.f;
            const float x1c = w10 * x1m + w11 * x1z + w12 * x1p + bb1;
            const float vc = wv0 * vm + wv1 * vz + wv2 * vp + bbv;
            x0c[i] = w00 * x0m + w01 * x0z + w02 * x0p + bb0;
            zl[t] = vc * x1c;
        }
        {   LAS float* red = fl;
            red[tid] = fsqp[(size_t)tid * 1024 + c];
            __syncthreads();
            for (int st = 256; st > 0; st >>= 1) { if (tid < st) red[tid] += red[tid + st]; __syncthreads(); }
        }
        const float nrm = 1.0f / sqrtf(fl[0] + EPS);
        __syncthreads();
        const float* hf = hT + (size_t)c * SEQ; const float* hb = hT + ((size_t)1024 + c) * SEQ;
        for (int n = tid; n < 2 * SEQ; n += 512) {
            float v;
            if (n < SEQ) v = hf[n] * nrm; else if (n == SEQ) v = 0.f; else v = hb[2 * SEQ - n] * nrm;
            fl[n] = v;
        }
        __syncthreads();
        float y[16];
#pragma unroll
        for (int i = 0; i < 16; ++i) y[i] = 0.f;
        for (int s = 0; s < SEQ; ++s) {
            const float zs = zl[s];
#pragma unroll
            for (int i = 0; i < 16; ++i) y[i] += zs * fl[(tid + 512 * i - s) & (2 * SEQ - 1)];
        }
        const float db = dbias[c];
        bf16* pr = UT + ((size_t)b * 3072 + c) * SEQ;
#pragma unroll
        for (int i = 0; i < 16; ++i) { const int t = tid + 512 * i; pr[t] = (bf16)f2bf(x0c[i] * (y[i] + zl[t] * db)); }
    }
    __syncthreads();
}
__device__ __forceinline__ void transpose_p_phase(Frame& F) {
    const bf16* UT = (const bf16*)(F.ws + WS_UT); bf16* P = (bf16*)(F.ws + WS_P);
    LAS unsigned short* scr = (LAS unsigned short*)(F.lds + F.wave * 16384);
    const int gw = F.vcu * NWAVES + F.wave, NGW = F.G * NWAVES, lane = F.lane;
    const int ntile = NB * (DM / 64) * (SEQ / 64);
    for (int it = gw; it < ntile; it += NGW) {
        const int tb = it % (SEQ / 64), cb = (it / (SEQ / 64)) % (DM / 64), b = it / ((SEQ / 64) * (DM / 64));
        for (int rr = 0; rr < 64; ++rr) scr[rr * 66 + lane] = UT[((size_t)b * 3072 + cb * 64 + rr) * SEQ + tb * 64 + lane];
        LDS_WAIT(); asm volatile("" ::: "memory");
        for (int tt = 0; tt < 64; ++tt) P[((size_t)b * SEQ + tb * 64 + tt) * DM + cb * 64 + lane] = scr[lane * 66 + tt];
        LDS_WAIT(); asm volatile("" ::: "memory");
    }
}

constexpr int NPH = 16;
__global__ void __launch_bounds__(NWAVES * 64, 2) hybrid_fwd(Args args) {
    extern __shared__ __attribute__((aligned(16))) unsigned char lds[];
    Frame F;
    F.lds = (LAS unsigned char*)lds;
    F.tid = threadIdx.x; F.lane = F.tid & 63; F.wave = __builtin_amdgcn_readfirstlane(F.tid >> 6);
    F.G = gridDim.x; { const int bx = blockIdx.x; F.vcu = (F.G % 8 == 0) ? (bx % 8) * (F.G / 8) + bx / 8 : bx; }
    F.in = args.in; F.out = args.out; F.ws = args.ws;
    unsigned char* ws = args.ws;
    volatile LAS unsigned* MISC = (volatile LAS unsigned*)(F.lds + MISC_OFF);
    for (int u = F.tid; u < (LDS_BYTES - LDSCTL_OFF) / 4; u += NWAVES * 64) ((LAS unsigned*)(F.lds + LDSCTL_OFF))[u] = 0u;
    __syncthreads();
    XcdBarrier bar; bar.bar = (unsigned*)(ws + CT_BAR); bar.x = 0; bar.st = nullptr;
    const int lo = args.ph_lo, hi = args.ph_hi;
    if (hi - lo > 1) bar = xcd_barrier_post((unsigned*)(ws + CT_BAR), MISC + 8);
#ifndef PH_MASK
#define PH_MASK 0xFFFF
#endif
#define IN(k) ((((PH_MASK) >> (k)) & 1) && lo <= (k) && (k) < hi)
#define SEAM(k) do { if (IN(k) && IN((k) + 1)) xcd_barrier(bar); } while (0)
    const float* mods = (const float*)(ws + CT_MODS);
    const float* gnt = (const float*)(ws + SM_GN);
    float* ssqa = (float*)(ws + WS_SSQP);
    bf16* XS = (bf16*)(ws + WS_XS);

    if (IN(0)) { phase0a(F); } SEAM(0);
    if (IN(1)) { phase0b(F); } SEAM(1);
    if (IN(2)) {
        { pg8::Gemm g{XS, (const bf16*)(ws + WS_WQKV), TT, 3 * DM, DM, DM}; pg8::StaticOrder S; S.init(TT, 3 * DM, F.G, (int)blockIdx.x);
          EpiQKV E{(bf16*)(ws + WS_Q), (WS_K - WS_Q) / 2, (const float*)(ws + SM_SSQ0), 1, (const float*)(ws + CT_BQKV), 3072, args.in[9], args.in[10], 0};
          pg8::gemm_phase<EpiQKV, pg8::StaticOrder, true, true>(F.lds, g, S, E); }
        { pg8::Gemm g{(const bf16*)(ws + WS_XSC), (const bf16*)(ws + WS_WQKV) + (size_t)1024 * DM, TC, 2 * DM, DM, DM}; pg8::StaticOrder S; S.init(TC, 2 * DM, F.G, (int)blockIdx.x);
          EpiQKV E{(bf16*)(ws + WS_KC) - (WS_VC - WS_KC) / 2, (WS_VC - WS_KC) / 2, (const float*)(ws + SM_SSQC), 1, (const float*)(ws + CT_BQKV) + 4 * 3072, 0, args.in[9], args.in[10], 4};
          pg8::gemm_phase<EpiQKV, pg8::StaticOrder, true, true>(F.lds, g, S, E); }
    } SEAM(2);
    if (IN(3)) { attn_naive_phase(F); } SEAM(3);
    if (IN(4)) {
        pg8::Gemm g{(const bf16*)(ws + WS_O), (const bf16*)(ws + WS_WO), TT, DM, DM, DM}; pg8::StaticOrder S; S.init(TT, DM, F.G, (int)blockIdx.x);
        EpiRes E{args.in[0], args.out, mods + 2048, nullptr, gnt, XS, ssqa};
        pg8::gemm_phase<EpiRes, pg8::StaticOrder, true, true>(F.lds, g, S, E);
    } SEAM(4);
    if (IN(5)) {
        pg8::Gemm g{XS, (const bf16*)(ws + WS_WUP0), TT, 2 * FF, DM, DM}; pg8::StaticOrder S; S.init(TT, 2 * FF, F.G, (int)blockIdx.x);
        EpiScaleBias E{(bf16*)(ws + WS_AG), 2 * FF, ssqa, 16, (const float*)(ws + CT_BUP0), 5632};
        pg8::gemm_phase<EpiScaleBias, pg8::StaticOrder, true, true>(F.lds, g, S, E);
    } SEAM(5);
    if (IN(6)) { convglu_phase(F, args.in[14], args.in[15]); } SEAM(6);
    if (IN(7)) {
        pg8::Gemm g{(const bf16*)(ws + WS_AG), (const bf16*)(ws + WS_WDN0), TT, DM, FF, 2 * FF}; pg8::StaticOrder S; S.init(TT, DM, F.G, (int)blockIdx.x);
        EpiRes E{args.out, args.out, mods + 5120, nullptr, gnt + 4096, XS, ssqa + 16 * TT};
        pg8::gemm_phase<EpiRes, pg8::StaticOrder, true, true>(F.lds, g, S, E);
    } SEAM(7);
    if (IN(8)) { filtgen_phase(F); } SEAM(8);
    if (IN(9)) {
        pg8::Gemm g{XS, (const bf16*)(ws + WS_WIN), TT, 3 * DM, DM, DM}; pg8::StaticOrder S; S.init(TT, 3 * DM, F.G, (int)blockIdx.x);
#ifdef EXP_P9
        EpiScaleBias E{(bf16*)(ws + WS_UT), 3 * DM, ssqa + 16 * TT, 16, (const float*)(ws + CT_BIN), 3072};
        pg8::gemm_phase<EpiScaleBias, pg8::StaticOrder, true, true>(F.lds, g, S, E);
#else
        EpiInT E{(bf16*)(ws + WS_UT), ssqa + 16 * TT, 16, (const float*)(ws + CT_BIN)};
        pg8::gemm_phase<EpiInT, pg8::StaticOrder, true, true>(F.lds, g, S, E);
#endif
    } SEAM(9);
    if (IN(10)) { hyena_naive_phase(F); } SEAM(10);
    if (IN(11)) { transpose_p_phase(F); } SEAM(11);
    if (IN(12)) {
        pg8::Gemm g{(const bf16*)(ws + WS_P), (const bf16*)(ws + WS_WOUT), TT, DM, DM, DM}; pg8::StaticOrder S; S.init(TT, DM, F.G, (int)blockIdx.x);
        EpiRes E{args.out, args.out, mods + 5 * 6144 + 2048, args.in[35], gnt + 2 * 4096, XS, ssqa + 32 * TT};
        pg8::gemm_phase<EpiRes, pg8::StaticOrder, true, true>(F.lds, g, S, E);
    } SEAM(12);
    if (IN(13)) {
        pg8::Gemm g{XS, (const bf16*)(ws + WS_WUP1), TT, 2 * FF, DM, DM}; pg8::StaticOrder S; S.init(TT, 2 * FF, F.G, (int)blockIdx.x);
        EpiScaleBias E{(bf16*)(ws + WS_AG), 2 * FF, ssqa + 32 * TT, 16, (const float*)(ws + CT_BUP1), 5632};
        pg8::gemm_phase<EpiScaleBias, pg8::StaticOrder, true, true>(F.lds, g, S, E);
    } SEAM(13);
    if (IN(14)) { convglu_phase(F, args.in[37], args.in[38]); } SEAM(14);
    if (IN(15)) {
        pg8::Gemm g{(const bf16*)(ws + WS_AG), (const bf16*)(ws + WS_WDN1), TT, DM, FF, 2 * FF}; pg8::StaticOrder S; S.init(TT, DM, F.G, (int)blockIdx.x);
        EpiRes E{args.out, args.out, mods + 5 * 6144 + 5120, nullptr, nullptr, nullptr, nullptr};
        pg8::gemm_phase<EpiRes, pg8::StaticOrder, true, true>(F.lds, g, S, E);
    }
#ifdef DUMP_SEL
    if (lo == 99) {
        float* o = args.out; const size_t n = (size_t)TT * DM;
        for (size_t e = (size_t)blockIdx.x * 512 + F.tid; e < n; e += (size_t)F.G * 512) {
            float v;
            if (DUMP_SEL == 1) { const float* h = (const float*)(ws + WS_HT); v = (e < (size_t)2 * 1024 * SEQ) ? h[e] : ((const float*)(ws + WS_FSQP))[e & 1023]; }
            else if (DUMP_SEL == 2) { const bf16* u = (const bf16*)(ws + WS_UT); v = bf2f(u[e]); }
            else if (DUMP_SEL == 3) { const bf16* u = (const bf16*)(ws + WS_UT); v = bf2f(u[e + (size_t)TT * DM]); }
            else if (DUMP_SEL == 4) { const bf16* u = (const bf16*)(ws + WS_UT); v = bf2f(u[e + (size_t)2 * TT * DM]); }
            else { const bf16* u = (const bf16*)(ws + WS_P); v = bf2f(u[e]); }
            o[e] = v;
        }
    }
#endif
#undef IN
#undef SEAM
}

extern "C" void kernel_launch(void* const* d_in, const int* in_sizes, int n_in, void* d_out, int out_size, void* d_ws, size_t ws_size, hipStream_t stream) {
    static int grid = 0;
    if (grid == 0) {
        if (n_in != 40 || out_size != TT * DM || ws_size < WS_END) { fprintf(stderr, "kernel_launch: unexpected shapes n_in %d out %d ws %zu\n", n_in, out_size, ws_size); grid = -1; return; }
        int dev = 0, cus = 0;
        if (hipGetDevice(&dev) != hipSuccess || hipDeviceGetAttribute(&cus, hipDeviceAttributeMultiprocessorCount, dev) != hipSuccess) { grid = -1; return; }
        if (hipFuncSetAttribute((const void*)hybrid_fwd, hipFuncAttributeMaxDynamicSharedMemorySize, LDS_BYTES) != hipSuccess) { fprintf(stderr, "kernel_launch: hipFuncSetAttribute failed\n"); grid = -1; return; }
        int per_cu = 0;
        if (hipOccupancyMaxActiveBlocksPerMultiprocessor(&per_cu, (const void*)hybrid_fwd, NWAVES * 64, LDS_BYTES) != hipSuccess || per_cu < 1) { fprintf(stderr, "kernel_launch: occupancy query says %d\n", per_cu); }
        (void)hipGetLastError();
        grid = cus;
    }
    if (grid < 0) return;
    (void)hipMemsetAsync((char*)d_ws + WS_CTL, 0, CTL_ZERO_BYTES, stream);
    Args a{};
    for (int i = 0; i < 40; ++i) a.in[i] = (const float*)d_in[i];
    a.out = (float*)d_out; a.ws = (unsigned char*)d_ws;
#if MK_ONE_LAUNCH
    a.ph_lo = 0; a.ph_hi = NPH;
    hipLaunchKernelGGL(hybrid_fwd, dim3(grid), dim3(NWAVES * 64), LDS_BYTES, stream, a);
#else
    for (int p = 0; p < PH_END; ++p) { a.ph_lo = p; a.ph_hi = p + 1; hipLaunchKernelGGL(hybrid_fwd, dim3(grid), dim3(NWAVES * 64), LDS_BYTES, stream, a); }
#ifdef DUMP_SEL
    a.ph_lo = 99; a.ph_hi = 100; hipLaunchKernelGGL(hybrid_fwd, dim3(grid), dim3(NWAVES * 64), LDS_BYTES, stream, a);
#endif
#endif
}
```

```cpp
#include <hip/hip_runtime.h>
#include <cstdio>
#include <cstdint>

#ifndef PH_END
#define PH_END 17
#endif
#ifndef MK_ONE_LAUNCH
#define MK_ONE_LAUNCH 1
#endif

namespace pg8 {
#define PG8_LAS __attribute__((address_space(3)))
typedef unsigned short bf16_t;
typedef short bf16x8 __attribute__((ext_vector_type(8)));
typedef float f32x4 __attribute__((ext_vector_type(4)));
typedef unsigned u32x4 __attribute__((ext_vector_type(4)));
constexpr int BM = 256, BK = 64, HALF = 128, HTB = HALF * BK * 2, STAGE_BYTES = 8 * HTB, NXCD = 8, WGM = 8;

__host__ __device__ __forceinline__ int lds_byte(int r, int c) { const int st = (r >> 4) * 2 + (c >> 5), rr = r & 15, cc = c & 31, ob = rr * 64 + cc * 2; return st * 1024 + (ob ^ (((ob >> 9) & 1) << 5)); }
__host__ __device__ __forceinline__ void stage_rc(int b, int& R, int& C) { const int st = b / 1024, sb = b % 1024, swz = sb ^ (((sb >> 9) & 1) << 5); R = (st >> 1) * 16 + swz / 64; C = (st & 1) * 32 + (swz % 64) / 2; }
__host__ __device__ __forceinline__ int perm32(int rho) { const int n = rho >> 4, i = rho & 15; return 8 * (i >> 2) + 4 * n + (i & 3); }

struct Unit { int pm, pn; };
struct Gemm { const bf16_t* A; const bf16_t* Bt; int M, N, K, lda; };

struct StaticOrder {
    int nM, nN, nwg, G, c;
    __host__ __device__ void init(int M, int N, int G_, int c_) { nM = M / BM; nN = N / BM; nwg = nM * nN; G = G_; c = c_; }
    __host__ __device__ bool next(int i, Unit& u) const {
        const long L = (long)i * G + c; if (L >= nwg) return false;
        int wgid = (int)L; { const int q = nwg / NXCD, r = nwg % NXCD, xcd = wgid % NXCD, off = wgid / NXCD; wgid = (xcd < r ? xcd * (q + 1) : r * (q + 1) + (xcd - r) * q) + off; }
        const int nig = WGM * nN, gid = wgid / nig, fm = gid * WGM, gsz = (nM - fm) < WGM ? (nM - fm) : WGM;
        u.pm = fm + ((wgid % nig) % gsz); u.pn = (wgid % nig) / gsz; return true;
    }
    __device__ __forceinline__ void a_ready(const Unit&) const {}
    __device__ __forceinline__ void done(const Unit&) const {}
};

__device__ __forceinline__ unsigned cvt_pk_bf16(float lo, float hi) { unsigned r; asm volatile("v_cvt_pk_bf16_f32 %0, %1, %2" : "=v"(r) : "v"(lo), "v"(hi)); return r; }

template <class Epi, class Sched, bool ALIGN_EPI = false, bool SP2 = false>
__device__ __forceinline__ void gemm_phase(PG8_LAS unsigned char* lds, const Gemm g, const Sched& S, const Epi& E) {
    const int tid = threadIdx.x, wid = __builtin_amdgcn_readfirstlane(tid >> 6), lane = tid & 63, wr = wid >> 2, wc = wid & 3, fr = lane & 15, fq = lane >> 4;
    const int K = g.K, nt = K / BK, lda = g.lda;
    unsigned voffA[2], voffB[2];
#pragma unroll
    for (int i = 0; i < 2; ++i) { int R, C; stage_rc(tid * 16 + i * 8192, R, C); const int Rb = Epi::PERM ? ((R & ~31) + perm32(R & 31)) : R;
        voffA[i] = (unsigned)(R * lda + C) * 2u; voffB[i] = (unsigned)(Rb * K + C) * 2u; }
    const size_t kstep = (size_t)(BK * 2);
    const size_t hstepA = (size_t)HALF * lda * 2, hstepB = (size_t)HALF * K * 2;
    const size_t tstepA = 2 * hstepA, tstepB = 2 * hstepB;
    const unsigned ldsw = (unsigned)wid * 1024u;
    const int aoff = lds_byte(wr * 64 + fr, fq * 8), boff = lds_byte(wc * 32 + fr, fq * 8);
#define PG8_SA(b, h) (((b) * 2 + (h)) * HTB)
#define PG8_SB(b, h) ((4 + (b) * 2 + (h)) * HTB)
#define PG8_STAGE(bufoff, gbase, voff) do { _Pragma("unroll") for (int _i = 0; _i < 2; ++_i) \
        __builtin_amdgcn_global_load_lds((const unsigned*)((const char*)(gbase) + (voff)[_i]), (PG8_LAS unsigned*)(lds + (bufoff) + ldsw + _i * 8192), 16, 0, 0); } while (0)
#define PG8_LDA(dst, b, h) do { _Pragma("unroll") for (int m = 0; m < 4; ++m) _Pragma("unroll") for (int k = 0; k < 2; ++k) dst[m][k] = *(const PG8_LAS bf16x8*)(lds + PG8_SA(b, h) + aoff + m * 2048 + k * 1024); } while (0)
#define PG8_LDB(dst, b, h) do { _Pragma("unroll") for (int n = 0; n < 2; ++n) _Pragma("unroll") for (int k = 0; k < 2; ++k) dst[n][k] = *(const PG8_LAS bf16x8*)(lds + PG8_SB(b, h) + boff + n * 2048 + k * 1024); } while (0)
#define PG8_MMA(ai, bj, At, Bt) do { __builtin_amdgcn_s_setprio(1); _Pragma("unroll") for (int m = 0; m < 4; ++m) _Pragma("unroll") for (int n = 0; n < 2; ++n) _Pragma("unroll") for (int k = 0; k < 2; ++k) \
        acc[ai][bj][m][n] = __builtin_amdgcn_mfma_f32_16x16x32_bf16(Bt[n][k], At[m][k], acc[ai][bj][m][n], 0, 0, 0); __builtin_amdgcn_s_setprio(0); } while (0)
#define PG8_WAIT_V(n) asm volatile("s_waitcnt vmcnt(" #n ")" ::: "memory")
#define PG8_WAIT_L(n) asm volatile("s_waitcnt lgkmcnt(" #n ")" ::: "memory")
#define PG8_BAR __builtin_amdgcn_s_barrier()
#define PG8_SCHED __builtin_amdgcn_sched_barrier(0)
    Unit cur, nxt; int ui = 0;
    if (!S.next(0, cur)) return;
    f32x4 acc[2][2][4][2];
#pragma unroll
    for (int a = 0; a < 2; ++a)
#pragma unroll
        for (int b = 0; b < 2; ++b)
#pragma unroll
            for (int m = 0; m < 4; ++m)
#pragma unroll
                for (int n = 0; n < 2; ++n) acc[a][b][m][n] = (f32x4){0.f, 0.f, 0.f, 0.f};
    bf16x8 At[4][2], B0[2][2], B1[2][2];
    const char* cA = (const char*)g.A + (size_t)cur.pm * tstepA; const char* cB = (const char*)g.Bt + (size_t)cur.pn * tstepB;
    S.a_ready(cur);
    if constexpr (SP2) {
        PG8_STAGE(PG8_SB(0, 0), cB, voffB); PG8_STAGE(PG8_SB(0, 1), cB + hstepB, voffB); PG8_STAGE(PG8_SA(0, 0), cA, voffA); PG8_STAGE(PG8_SA(0, 1), cA + hstepA, voffA);
        if (wr == 1) PG8_BAR;
        PG8_WAIT_V(2); PG8_BAR;
        PG8_STAGE(PG8_SB(1, 0), cB + kstep, voffB); PG8_STAGE(PG8_SA(1, 0), cA + kstep, voffA); PG8_STAGE(PG8_SB(1, 1), cB + hstepB + kstep, voffB);
        PG8_WAIT_V(6); PG8_BAR;
    } else {
        PG8_STAGE(PG8_SB(0, 0), cB, voffB); PG8_STAGE(PG8_SA(0, 0), cA, voffA); PG8_STAGE(PG8_SB(0, 1), cB + hstepB, voffB); PG8_STAGE(PG8_SA(0, 1), cA + hstepA, voffA);
        if (wr == 1) PG8_BAR;
        PG8_WAIT_V(4); PG8_BAR;
        PG8_STAGE(PG8_SB(1, 0), cB + kstep, voffB); PG8_STAGE(PG8_SA(1, 0), cA + kstep, voffA); PG8_STAGE(PG8_SB(1, 1), cB + hstepB + kstep, voffB);
        PG8_WAIT_V(6); PG8_BAR;
    }
    for (;;) {
        const bool has_next = S.next(ui + 1, nxt);
        const char* nA = has_next ? (const char*)g.A + (size_t)nxt.pm * tstepA : cA; const char* nB = has_next ? (const char*)g.Bt + (size_t)nxt.pn * tstepB : cB;
        for (int t = 0; t < nt; t += 2) {
            const bool last = (t == nt - 2);
            const char* a1 = cA + (size_t)(t + 1) * kstep;
            const char* a2 = last ? nA : cA + (size_t)(t + 2) * kstep; const char* b2 = last ? nB : cB + (size_t)(t + 2) * kstep;
            const char* a3 = a2 + kstep; const char* b3 = b2 + kstep;
            if (last && has_next) S.a_ready(nxt);
            if constexpr (SP2) {
            PG8_LDB(B0, 0, 0); PG8_LDB(B1, 0, 1); PG8_SCHED; PG8_LDA(At, 0, 0); PG8_STAGE(PG8_SA(1, 1), a1 + hstepA, voffA);
            PG8_WAIT_V(8); PG8_WAIT_L(0); PG8_BAR; PG8_MMA(0, 0, At, B0); PG8_MMA(0, 1, At, B1); PG8_BAR; PG8_SCHED;
            PG8_LDA(At, 0, 1); PG8_STAGE(PG8_SB(0, 0), b2, voffB); PG8_STAGE(PG8_SB(0, 1), b2 + hstepB, voffB); PG8_STAGE(PG8_SA(0, 0), a2, voffA);
            PG8_WAIT_V(8); PG8_WAIT_L(0); PG8_BAR; PG8_MMA(1, 0, At, B0); PG8_MMA(1, 1, At, B1); PG8_BAR; PG8_SCHED;
            PG8_LDB(B0, 1, 0); PG8_LDB(B1, 1, 1); PG8_SCHED; PG8_LDA(At, 1, 0); PG8_STAGE(PG8_SA(0, 1), a2 + hstepA, voffA);
            PG8_WAIT_V(8); PG8_WAIT_L(0); PG8_BAR; PG8_MMA(0, 0, At, B0); PG8_MMA(0, 1, At, B1); PG8_BAR; PG8_SCHED;
            PG8_LDA(At, 1, 1); PG8_STAGE(PG8_SB(1, 0), b3, voffB); PG8_STAGE(PG8_SB(1, 1), b3 + hstepB, voffB); PG8_STAGE(PG8_SA(1, 0), a3, voffA);
            PG8_WAIT_V(8); PG8_WAIT_L(0); PG8_BAR; PG8_MMA(1, 0, At, B0); PG8_MMA(1, 1, At, B1); PG8_BAR; PG8_SCHED;
            } else {
            PG8_LDB(B0, 0, 0); PG8_SCHED; PG8_LDA(At, 0, 0); PG8_STAGE(PG8_SA(1, 1), a1 + hstepA, voffA);
            PG8_WAIT_L(8); PG8_BAR; PG8_WAIT_L(0); PG8_MMA(0, 0, At, B0); PG8_BAR; PG8_SCHED;
            PG8_LDB(B1, 0, 1); PG8_STAGE(PG8_SB(0, 0), b2, voffB);
            PG8_BAR; PG8_WAIT_L(0); PG8_MMA(0, 1, At, B1); PG8_BAR;
            PG8_LDA(At, 0, 1); PG8_STAGE(PG8_SA(0, 0), a2, voffA);
            PG8_BAR; PG8_WAIT_L(0); PG8_MMA(1, 0, At, B0); PG8_BAR; PG8_SCHED;
            PG8_STAGE(PG8_SB(0, 1), b2 + hstepB, voffB);
            PG8_WAIT_V(6); PG8_BAR; PG8_MMA(1, 1, At, B1); PG8_BAR;
            PG8_LDB(B0, 1, 0); PG8_SCHED; PG8_LDA(At, 1, 0); PG8_STAGE(PG8_SA(0, 1), a2 + hstepA, voffA);
            PG8_WAIT_L(8); PG8_BAR; PG8_WAIT_L(0); PG8_MMA(0, 0, At, B0); PG8_BAR; PG8_SCHED;
            PG8_LDB(B1, 1, 1); PG8_STAGE(PG8_SB(1, 0), b3, voffB);
            PG8_BAR; PG8_WAIT_L(0); PG8_MMA(0, 1, At, B1); PG8_BAR;
            PG8_LDA(At, 1, 1); PG8_STAGE(PG8_SA(1, 0), a3, voffA);
            PG8_BAR; PG8_WAIT_L(0); PG8_MMA(1, 0, At, B0); PG8_BAR; PG8_SCHED;
            PG8_STAGE(PG8_SB(1, 1), b3 + hstepB, voffB);
            PG8_WAIT_V(6); PG8_BAR; PG8_MMA(1, 1, At, B1); PG8_BAR;
            }
        }
        if constexpr (ALIGN_EPI) { if (wr == 0) PG8_BAR; }
        E(acc, cur, wr, wc, fr, fq); S.done(cur);
        if (!has_next) break;
#pragma unroll
        for (int a = 0; a < 2; ++a)
#pragma unroll
            for (int b = 0; b < 2; ++b)
#pragma unroll
                for (int m = 0; m < 4; ++m)
#pragma unroll
                    for (int n = 0; n < 2; ++n) acc[a][b][m][n] = (f32x4){0.f, 0.f, 0.f, 0.f};
        cur = nxt; cA = nA; cB = nB; ++ui;
        if constexpr (ALIGN_EPI) { if (wr == 1) PG8_BAR; }
    }
    PG8_WAIT_V(0);
    if constexpr (!ALIGN_EPI) { if (wr == 0) PG8_BAR; }
    PG8_BAR;
#undef PG8_SA
#undef PG8_SB
#undef PG8_STAGE
#undef PG8_LDA
#undef PG8_LDB
#undef PG8_MMA
#undef PG8_WAIT_V
#undef PG8_WAIT_L
#undef PG8_BAR
#undef PG8_SCHED
}
}

constexpr int NB = 4, SEQ = 8192, DM = 1024, TT = NB * SEQ, CTXL = 256, TC = NB * CTXL, FF = 2816, NH = 16, HD = 64, GW = 64, GROWS = SEQ / GW;
constexpr int WH = 8, WW = 16;
constexpr float EPS = 1e-6f;
constexpr int NWAVES = 8;

constexpr size_t MiB = 1u << 20;
constexpr size_t WS_CTL = 0, CTL_ZERO_BYTES = 64 * 1024;
constexpr size_t CT_BAR = 16384;
constexpr size_t CT_MODS = 64 * 1024;
constexpr size_t CT_BQKV = CT_MODS + 2 * 5 * 6144 * 4;
constexpr size_t CT_BUP0 = CT_BQKV + 5 * 3072 * 4;
constexpr size_t CT_BIN  = CT_BUP0 + 4 * 5632 * 4;
constexpr size_t CT_BUP1 = CT_BIN + 4 * 3072 * 4;
constexpr size_t CT_END  = CT_BUP1 + 4 * 5632 * 4;
static_assert(CT_END <= 1 * MiB, "ctl region");
constexpr size_t SM_SSQ0 = 1 * MiB, SM_SSQC = SM_SSQ0 + 32768 * 4, SM_GN = SM_SSQC + 1024 * 4;
constexpr size_t WS_SSQP = 2 * MiB;
constexpr size_t WS_FSQP = 448 * MiB;
constexpr size_t WS_WQKV = 8 * MiB, WS_WO = 14 * MiB, WS_WUP0 = 16 * MiB, WS_WDN0 = 27 * MiB, WS_WIN = 33 * MiB, WS_WOUT = 39 * MiB, WS_WUP1 = 41 * MiB, WS_WDN1 = 52 * MiB;
constexpr size_t WS_XSC = 58 * MiB, WS_KC = 60 * MiB, WS_VC = 62 * MiB;
constexpr size_t WS_XS = 64 * MiB;
constexpr size_t WS_Q = 128 * MiB, WS_K = 192 * MiB, WS_V = 256 * MiB, WS_O = 320 * MiB;
constexpr size_t WS_AG = 128 * MiB;
constexpr size_t WS_UT = 128 * MiB;
constexpr size_t WS_HT = 128 * MiB;
constexpr size_t WS_F = 320 * MiB;
constexpr size_t SM_TWM = 1536 * 1024, SM_TWN = SM_TWM + 65536;
constexpr size_t WS_P = 384 * MiB;
constexpr size_t WS_END = 480 * MiB;

constexpr int RING_BYTES = 131072;
constexpr int LDS_BYTES = 163840;
constexpr int LDSCTL_OFF = LDS_BYTES - 1024, MISC_OFF = LDSCTL_OFF + 320;

#define GAS __attribute__((address_space(1)))
#define LAS __attribute__((address_space(3)))
typedef unsigned short bf16;
typedef unsigned v4u __attribute__((ext_vector_type(4)));
typedef unsigned v2u __attribute__((ext_vector_type(2)));
typedef float f32x4 __attribute__((ext_vector_type(4)));
typedef GAS unsigned gu32;
#define RLX_AGENT __ATOMIC_RELAXED, __HIP_MEMORY_SCOPE_AGENT
#define LDS_WAIT() asm volatile("s_waitcnt lgkmcnt(0)" ::: "memory")
#define VM_WAIT() asm volatile("s_waitcnt vmcnt(0)" ::: "memory")
__device__ __forceinline__ unsigned f2bf(float f) { unsigned u = __builtin_bit_cast(unsigned, f); return (u + 0x7fffu + ((u >> 16) & 1u)) >> 16; }
__device__ __forceinline__ unsigned pk2(float lo, float hi) { return f2bf(lo) | (f2bf(hi) << 16); }
__device__ __forceinline__ float bf2f(unsigned short h) { return __builtin_bit_cast(float, (unsigned)h << 16); }
__device__ __forceinline__ float bflo(unsigned w) { return __builtin_bit_cast(float, w << 16); }
__device__ __forceinline__ float bfhi(unsigned w) { return __builtin_bit_cast(float, w & 0xffff0000u); }

#define FC_HD __device__ __forceinline__
struct cf { float x, y; };
FC_HD cf cmul(cf a, cf b) { cf r; r.x = a.x * b.x - a.y * b.y; r.y = a.x * b.y + a.y * b.x; return r; }
FC_HD cf cadd(cf a, cf b) { cf r; r.x = a.x + b.x; r.y = a.y + b.y; return r; }
FC_HD cf csub(cf a, cf b) { cf r; r.x = a.x - b.x; r.y = a.y - b.y; return r; }
FC_HD cf cconj(cf a) { cf r; r.x = a.x; r.y = -a.y; return r; }
FC_HD cf cmulnegi(cf a) { cf r; r.x = a.y; r.y = -a.x; return r; }
#define FC_OPAQUE(x) asm volatile("" : "+v"(x))
#define FC_PIDX(i) ((i) + (((i) >> 6) << 3))
#define FC_M 8192
#define FC_PADM (FC_M + FC_M / 8)
#define FC_S2 0.70710678118654752f
FC_HD void dft4(cf& a0, cf& a1, cf& a2, cf& a3) {
    const cf c0 = cadd(a0, a2), c1 = cadd(a1, a3), d0 = csub(a0, a2), d1 = cmulnegi(csub(a1, a3));
    a0 = cadd(c0, c1); a1 = cadd(d0, d1); a2 = csub(c0, c1); a3 = csub(d0, d1);
}
FC_HD void dft8(cf* v) {
    cf a0 = cadd(v[0], v[4]), a1 = cadd(v[1], v[5]), a2 = cadd(v[2], v[6]), a3 = cadd(v[3], v[7]);
    cf b0 = csub(v[0], v[4]), b1 = csub(v[1], v[5]), b2 = csub(v[2], v[6]), b3 = csub(v[3], v[7]);
    { cf t; t.x = (b1.x + b1.y) * FC_S2; t.y = (b1.y - b1.x) * FC_S2; b1 = t; }
    b2 = cmulnegi(b2);
    { cf t; t.x = (b3.y - b3.x) * FC_S2; t.y = (-b3.x - b3.y) * FC_S2; b3 = t; }
    dft4(a0, a1, a2, a3); dft4(b0, b1, b2, b3);
    v[0] = a0; v[2] = a1; v[4] = a2; v[6] = a3; v[1] = b0; v[3] = b1; v[5] = b2; v[7] = b3;
}
FC_HD void dft16(cf* v) {
    cf a[8], b[8];
    const float c1 = 0.92387953251128674f, s1 = 0.38268343236508977f;
#ifdef __HIP_DEVICE_COMPILE__
#pragma unroll
#endif
    for (int i = 0; i < 8; ++i) { a[i] = cadd(v[i], v[i + 8]); b[i] = csub(v[i], v[i + 8]); }
    { cf w; w.x = c1; w.y = -s1; b[1] = cmul(b[1], w); }
    { cf w; w.x = FC_S2; w.y = -FC_S2; b[2] = cmul(b[2], w); }
    { cf w; w.x = s1; w.y = -c1; b[3] = cmul(b[3], w); }
    b[4] = cmulnegi(b[4]);
    { cf w; w.x = -s1; w.y = -c1; b[5] = cmul(b[5], w); }
    { cf w; w.x = -FC_S2; w.y = -FC_S2; b[6] = cmul(b[6], w); }
    { cf w; w.x = -c1; w.y = -s1; b[7] = cmul(b[7], w); }
    dft8(a); dft8(b);
#ifdef __HIP_DEVICE_COMPILE__
#pragma unroll
#endif
    for (int i = 0; i < 8; ++i) { v[2 * i] = a[i]; v[2 * i + 1] = b[i]; }
}
template <int R> FC_HD void cpowers(cf w1, cf* w) {
    w[0].x = 1.f; w[0].y = 0.f; w[1] = w1;
#ifdef __HIP_DEVICE_COMPILE__
#pragma unroll
#endif
    for (int q = 2; q < R; ++q) w[q] = (q & 1) ? cmul(w[q - 1], w1) : cmul(w[q >> 1], w[q >> 1]);
}
template <class LP> FC_HD void fwd_pass1(cf* v, int tid, LP a, const cf* TWM) {
    dft16(v);
    FC_OPAQUE(tid);
    const cf w1 = TWM[tid]; cf cur = w1;
    const int pt = FC_PIDX(tid);
    a[pt] = v[0];
#ifdef __HIP_DEVICE_COMPILE__
#pragma unroll
#endif
    for (int q = 1; q < 16; ++q) { a[pt + 576 * q] = cmul(v[q], cur); cur = cmul(cur, w1); }
}
template <class LP> FC_HD void fwd_pass8(int tid, LP a, const cf* TWM, int s, int lgs) {
#pragma unroll 1
    for (int h = 0; h < 2; ++h) {
        FC_OPAQUE(tid);
        const int bf = tid + 512 * h, j = bf & (s - 1), base = (bf >> lgs) * 8 * s;
        const int pb = FC_PIDX(base + j), ps = (s == 64) ? 72 : 8;
        cf v[8];
#ifdef __HIP_DEVICE_COMPILE__
#pragma unroll
#endif
        for (int r = 0; r < 8; ++r) v[r] = a[pb + ps * r];
        dft8(v);
        const cf w1 = TWM[j * (FC_M / (8 * s))]; cf cur = w1;
        a[pb] = v[0];
#ifdef __HIP_DEVICE_COMPILE__
#pragma unroll
#endif
        for (int q = 1; q < 8; ++q) { a[pb + ps * q] = cmul(v[q], cur); cur = cmul(cur, w1); }
    }
}
template <class LP> FC_HD void mid_pass(int tid, LP a, const cf* F, cf* Fout, float fscale) {
#pragma unroll 1
    for (int h = 0; h < 2; ++h) {
        FC_OPAQUE(tid);
        const int bf = tid + 512 * h, base = bf * 8, pb = FC_PIDX(base);
        cf v[8];
#ifdef __HIP_DEVICE_COMPILE__
#pragma unroll
#endif
        for (int r = 0; r < 8; ++r) v[r] = a[pb + r];
        dft8(v);
        if (F) {
#ifdef __HIP_DEVICE_COMPILE__
#pragma unroll
#endif
            for (int r = 0; r < 8; ++r) v[r] = cconj(cmul(v[r], F[base + r]));
            dft8(v);
#ifdef __HIP_DEVICE_COMPILE__
#pragma unroll
#endif
            for (int r = 0; r < 8; ++r) a[pb + r] = v[r];
        } else {
#ifdef __HIP_DEVICE_COMPILE__
#pragma unroll
#endif
            for (int r = 0; r < 8; ++r) { cf o; o.x = v[r].x * fscale; o.y = v[r].y * fscale; Fout[base + r] = o; }
        }
    }
}
template <class LP> FC_HD void inv_pass8(int tid, LP a, const cf* TWM, int s, int lgs) {
#pragma unroll 1
    for (int h = 0; h < 2; ++h) {
        FC_OPAQUE(tid);
        const int bf = tid + 512 * h, j = bf & (s - 1), base = (bf >> lgs) * 8 * s;
        const int pb = FC_PIDX(base + j), ps = (s == 64) ? 72 : 8;
        cf v[8]; const cf w1 = TWM[j * (FC_M / (8 * s))]; cf cur = w1;
        v[0] = a[FC_PIDX(base + j)];
#ifdef __HIP_DEVICE_COMPILE__
#pragma unroll
#endif
        for (int q = 1; q < 8; ++q) { v[q] = cmul(a[pb + ps * q], cur); cur = cmul(cur, w1); }
        dft8(v);
#ifdef __HIP_DEVICE_COMPILE__
#pragma unroll
#endif
        for (int r = 0; r < 8; ++r) a[pb + ps * r] = v[r];
    }
}
template <class LP> FC_HD void inv_pass1(cf* v, int tid, LP a, const cf* TWM) {
    FC_OPAQUE(tid);
    const cf w1 = TWM[tid]; cf cur = w1;
    const int pt = FC_PIDX(tid);
    v[0] = a[pt];
#ifdef __HIP_DEVICE_COMPILE__
#pragma unroll
#endif
    for (int q = 1; q < 16; ++q) { v[q] = cmul(a[pt + 576 * q], cur); cur = cmul(cur, w1); }
    dft16(v);
}

#define XB_TMO      128
#define XB_XCNT(j)  (256  + 64 * (j))
#define XB_XSUB(j)  (1280 + 64 * (j))
#define XB_XGEN(j)  (2304 + 64 * (j))
#define XB_TOP      3328
#define XB_TOPGEN   3392
#define XCD_BAR_WORDS 3456
#define XB_SPIN_CAP (1u << 18)
__device__ __forceinline__ unsigned xb_ld(unsigned* p)              { return __hip_atomic_load(p, __ATOMIC_RELAXED, __HIP_MEMORY_SCOPE_AGENT); }
__device__ __forceinline__ unsigned xb_add(unsigned* p, unsigned v) { return __hip_atomic_fetch_add(p, v, __ATOMIC_RELAXED, __HIP_MEMORY_SCOPE_AGENT); }
__device__ __forceinline__ unsigned xb_xcc_id() { return (unsigned)__builtin_amdgcn_s_getreg((3 << 11) | 20) & 0xFu; }
#define XB_SPIN(cond, bar) do { unsigned _sp = 0; while (cond) { __builtin_amdgcn_s_sleep(1); \
    if ((++_sp & 255u) == 0u) { if (xb_ld(&(bar)[XB_TMO])) break; if (_sp > XB_SPIN_CAP) { atomicAdd(&(bar)[XB_TMO], 1u); break; } } } } while (0)
struct XcdBarrier { unsigned* bar; unsigned x; volatile LAS unsigned* st; };
__device__ __forceinline__ XcdBarrier xcd_barrier_post(unsigned* bar, volatile LAS unsigned* st) {
    XcdBarrier b; b.bar = bar; b.x = xb_xcc_id(); b.st = st;
    if (threadIdx.x == 0) (void)xb_add(&bar[XB_XCNT(b.x)], 1u);
    return b;
}
__device__ __forceinline__ void xcd_barrier_complete(unsigned* bar, unsigned x, unsigned& nloc, unsigned& nx) {
    const unsigned G = gridDim.x * gridDim.y * gridDim.z;
    unsigned sum, cnt, mine, sp = 0u;
    for (;;) {
        sum = 0u; cnt = 0u; mine = 0u;
#pragma unroll
        for (unsigned j = 0; j < 16; ++j) { const unsigned c = xb_ld(&bar[XB_XCNT(j)]); sum += c; cnt += (c > 0u) ? 1u : 0u; mine = (j == x) ? c : mine; }
        if (sum == G) break;
        __builtin_amdgcn_s_sleep(1);
        if ((++sp & 255u) == 0u) { if (xb_ld(&bar[XB_TMO])) break; if (sp > XB_SPIN_CAP) { atomicAdd(&bar[XB_TMO], 1u); break; } }
    }
    nloc = mine > 0u ? mine : 1u; nx = cnt > 0u ? cnt : 1u;
}
__device__ __forceinline__ void xcd_barrier(const XcdBarrier& b) {
    asm volatile("s_waitcnt vmcnt(0)" ::: "memory");
    __syncthreads();
    if (threadIdx.x == 0) {
        unsigned* bar = b.bar;
        __builtin_amdgcn_s_waitcnt(0);
        unsigned nloc = b.st[0], nx = b.st[1];
        if (nloc == 0u) { xcd_barrier_complete(bar, b.x, nloc, nx); b.st[0] = nloc; b.st[1] = nx; }
        const unsigned old = xb_add(&bar[XB_XSUB(b.x)], 1u);
        const unsigned gen = old / nloc;
        if (old + 1u == (gen + 1u) * nloc) {
            __builtin_amdgcn_fence(__ATOMIC_RELEASE, "agent");
            asm volatile("s_waitcnt vmcnt(0)" ::: "memory");
            const unsigned og = xb_add(&bar[XB_TOP], 1u);
            const unsigned tg = og / nx;
            if (og + 1u == (tg + 1u) * nx) xb_add(&bar[XB_TOPGEN], 1u);
            else XB_SPIN(xb_ld(&bar[XB_TOPGEN]) == tg, bar);
            __builtin_amdgcn_fence(__ATOMIC_ACQUIRE, "agent");
            xb_add(&bar[XB_XGEN(b.x)], 1u);
            asm volatile("s_waitcnt vmcnt(0)" ::: "memory");
        } else {
            XB_SPIN(xb_ld(&bar[XB_XGEN(b.x)]) == gen, bar);
            __builtin_amdgcn_fence(__ATOMIC_ACQUIRE, "agent");
            asm volatile("s_waitcnt vmcnt(0)" ::: "memory");
        }
    }
    __syncthreads();
}

struct Args { const float* in[40]; float* out; unsigned char* ws; int ph_lo, ph_hi; };
struct Frame {
    LAS unsigned char* lds;
    int tid, lane, wave, vcu, G;
    const float* const* in; float* out; unsigned char* ws;
};
__device__ __forceinline__ float wave_sum(float v) {
#pragma unroll
    for (int o = 1; o < 64; o <<= 1) v += __shfl_xor(v, o);
    return v;
}
__device__ __forceinline__ float silu_f(float x) { return x / (1.f + __expf(-x)); }

__device__ __forceinline__ float gelu_f(float v) { return 0.5f * v * (1.f + erff(v * 0.70710678118654752f)); }

__device__ __forceinline__ void transpose_item(const float* W, int K, int N, bf16* WT, int src_col0, int dst_row0, int k0, LAS float* scr, int lane) {
#pragma unroll 8
    for (int i = 0; i < 32; ++i) { const int kk = 2 * i + (lane >> 5); scr[kk * 33 + (lane & 31)] = W[(size_t)(k0 + kk) * N + src_col0 + (lane & 31)]; }
    LDS_WAIT(); asm volatile("" ::: "memory");
    const int c = lane & 7;
#pragma unroll
    for (int j = 0; j < 4; ++j) { const int n = (lane >> 3) + 8 * j; const LAS float* s = scr + (8 * c) * 33 + n;
        v4u o; o.x = pk2(s[0 * 33], s[1 * 33]); o.y = pk2(s[2 * 33], s[3 * 33]); o.z = pk2(s[4 * 33], s[5 * 33]); o.w = pk2(s[6 * 33], s[7 * 33]);
        *(GAS v4u*)(WT + (size_t)(dst_row0 + n) * K + k0 + 8 * c) = o; }
    LDS_WAIT(); asm volatile("" ::: "memory");
}
__device__ __forceinline__ int qkv_slot_to_col(int slot) {
    const int part = slot >> 10, cc = slot & 1023, pnl = cc >> 8, s = cc & 255, bj = s >> 7, wc = (s & 127) >> 5, j = s & 31;
    return part * 1024 + (4 * pnl + wc) * 64 + 32 * bj + j;
}
__device__ __forceinline__ void cvt_weight_item(const float* W, int K, int N, bf16* WT, int item, LAS float* scr, int lane, bool qkvperm) {
    const int nblk = N / 32, kb = item / nblk, nb = item % nblk;
    const int dst = 32 * nb, src = qkvperm ? qkv_slot_to_col(dst) : dst;
    transpose_item(W, K, N, WT, src, dst, 64 * kb, scr, lane);
}

template <int R, class VF>
__device__ __forceinline__ void gemv_det_item(const float* W, int N, int n0, float* out, int ostride, const float* addbias, const VF& vf, int tid, LAS float* scr) {
    const int col = tid & 63, ks = tid >> 6;
    float acc[R];
#pragma unroll
    for (int r = 0; r < R; ++r) acc[r] = 0.f;
    const float* wp = W + (size_t)(ks * 128) * N + n0 + col;
#pragma unroll 8
    for (int k = 0; k < 128; ++k) { const float w = wp[(size_t)k * N];
#pragma unroll
        for (int r = 0; r < R; ++r) acc[r] += vf(r, ks * 128 + k) * w; }
    __syncthreads();
#pragma unroll
    for (int r = 0; r < R; ++r) scr[(ks * R + r) * 64 + col] = acc[r];
    __syncthreads();
    if (tid < R * 64) { const int r = tid >> 6; float s = 0.f;
#pragma unroll
        for (int k2 = 0; k2 < 8; ++k2) s += scr[(k2 * R + r) * 64 + col];
        if (addbias) s += addbias[n0 + col];
        out[(size_t)r * ostride + n0 + col] = s; }
}

__device__ __forceinline__ void phase0a(Frame& F) {
    const float* const* in = F.in;
    float* mods = (float*)(F.ws + CT_MODS);
    {
        const float* c = in[1]; const float* cctx = in[3];
        auto vf = [&](int r, int k) -> float { const float v = (r < 4) ? c[r * DM + k] : cctx[k]; return silu_f(v); };
        const int nitems = 2 * 96;
        for (int it = F.vcu; it < nitems; it += F.G) {
            const int l = it / 96, cg = it % 96;
            gemv_det_item<5>(in[l ? 17 : 4], 6144, cg * 64, mods + l * 5 * 6144, 6144, in[l ? 18 : 5], vf, F.tid, (LAS float*)F.lds);
        }
        __syncthreads();
    }
    for (int e = F.vcu * 512 + F.tid; e < 16384; e += F.G * 512) {
        const int k = e & 8191; const bool isn = e >= 8192;
        float sn, cs; sincospif(isn ? (float)k * (1.0f / 8192.0f) : (float)k * (1.0f / 4096.0f), &sn, &cs);
        cf t; t.x = cs; t.y = -sn;
        ((cf*)(F.ws + (isn ? SM_TWN : SM_TWM)))[k] = t;
    }
    LAS float* scr = (LAS float*)(F.lds + F.wave * 16384);
    const int gw = F.vcu * NWAVES + F.wave, NGW = F.G * NWAVES;
    constexpr int I_QKV = 16 * 96, I_O = 16 * 32, I_UP = 16 * 176, I_DN = 44 * 32;
    constexpr int NITEMS = 2 * I_QKV + 2 * I_O + 2 * I_UP + 2 * I_DN;
    for (int it = gw; it < NITEMS; it += NGW) {
        int r = it;
        if (r < I_QKV) { cvt_weight_item(in[8], DM, 3 * DM, (bf16*)(F.ws + WS_WQKV), r, scr, F.lane, true); continue; } r -= I_QKV;
        if (r < I_O) { cvt_weight_item(in[12], DM, DM, (bf16*)(F.ws + WS_WO), r, scr, F.lane, false); continue; } r -= I_O;
        if (r < I_UP) { cvt_weight_item(in[13], DM, 2 * FF, (bf16*)(F.ws + WS_WUP0), r, scr, F.lane, false); continue; } r -= I_UP;
        if (r < I_DN) { cvt_weight_item(in[16], FF, DM, (bf16*)(F.ws + WS_WDN0), r, scr, F.lane, false); continue; } r -= I_DN;
        if (r < I_QKV) { cvt_weight_item(in[21], DM, 3 * DM, (bf16*)(F.ws + WS_WIN), r, scr, F.lane, false); continue; } r -= I_QKV;
        if (r < I_O) { cvt_weight_item(in[34], DM, DM, (bf16*)(F.ws + WS_WOUT), r, scr, F.lane, false); continue; } r -= I_O;
        if (r < I_UP) { cvt_weight_item(in[36], DM, 2 * FF, (bf16*)(F.ws + WS_WUP1), r, scr, F.lane, false); continue; } r -= I_UP;
        cvt_weight_item(in[39], FF, DM, (bf16*)(F.ws + WS_WDN1), r, scr, F.lane, false);
    }
}

__device__ __forceinline__ void row_prescale(const float* xrow, const float* gain, const float* sc, bf16* orow, float* ssq_out, int lane) {
    const GAS f32x4* xr = (const GAS f32x4*)xrow + lane;
    const GAS f32x4* gr = (const GAS f32x4*)gain + lane;
    const GAS f32x4* sr = (const GAS f32x4*)sc + lane;
    f32x4 v[4]; float s = 0.f;
#pragma unroll
    for (int j = 0; j < 4; ++j) { v[j] = xr[64 * j]; s += (v[j].x * v[j].x + v[j].y * v[j].y) + (v[j].z * v[j].z + v[j].w * v[j].w); }
    s = wave_sum(s);
    if (lane == 0) *ssq_out = s;
    GAS unsigned long long* o8 = (GAS unsigned long long*)orow + lane;
#pragma unroll
    for (int j = 0; j < 4; ++j) { const f32x4 g = gr[64 * j], c = sr[64 * j]; const f32x4 w = v[j] * g * (c + 1.0f);
        o8[64 * j] = (unsigned long long)pk2(w.x, w.y) | ((unsigned long long)pk2(w.z, w.w) << 32); }
}
__device__ __forceinline__ void phase0b(Frame& F) {
    const float* const* in = F.in;
    const float* mods = (const float*)(F.ws + CT_MODS);
    const int gw = F.vcu * NWAVES + F.wave, NGW = F.G * NWAVES;
    for (int m = gw; m < TT + TC; m += NGW) {
        if (m < TT) { const int b = m / SEQ; row_prescale(in[0] + (size_t)m * DM, in[6], mods + b * 6144 + 1024, (bf16*)(F.ws + WS_XS) + (size_t)m * DM, (float*)(F.ws + SM_SSQ0) + m, F.lane); }
        else { const int mc = m - TT; row_prescale(in[2] + (size_t)mc * DM, in[6], mods + 4 * 6144 + 1024, (bf16*)(F.ws + WS_XSC) + (size_t)mc * DM, (float*)(F.ws + SM_SSQC) + mc, F.lane); }
    }
    {
        float* gn = (float*)(F.ws + SM_GN);
        for (int e = F.vcu * 512 + F.tid; e < 3 * 4 * 1024; e += F.G * 512) {
            const int i = e / 4096, b = (e / 1024) & 3, k = e & 1023;
            const float* g = in[i == 0 ? 7 : (i == 1 ? 19 : 20)];
            const float sc = mods[(i == 0 ? 0 : 1) * 5 * 6144 + b * 6144 + (i == 1 ? 1024 : 4096) + k];
            gn[e] = g[k] * (1.f + sc);
        }
    }
    {
        const int n_qkv = 48, n_up = 88, n_in = 48;
        const int nitems = n_qkv + n_up + n_in + n_up;
        LAS float* gs = (LAS float*)F.lds;
        for (int it0 = F.vcu; it0 < nitems; it0 += F.G) {
            int it = it0;
            if (it < n_qkv) { auto vf = [&](int r, int k) -> float { return mods[r * 6144 + k]; };
                gemv_det_item<5>(in[8], 3072, it * 64, (float*)(F.ws + CT_BQKV), 3072, nullptr, vf, F.tid, gs); continue; } it -= n_qkv;
            if (it < n_up) { auto vf = [&](int r, int k) -> float { return mods[r * 6144 + 3072 + k]; };
                gemv_det_item<4>(in[13], 5632, it * 64, (float*)(F.ws + CT_BUP0), 5632, nullptr, vf, F.tid, gs); continue; } it -= n_up;
            if (it < n_in) { auto vf = [&](int r, int k) -> float { return mods[5 * 6144 + r * 6144 + k]; };
                gemv_det_item<4>(in[21], 3072, it * 64, (float*)(F.ws + CT_BIN), 3072, in[22], vf, F.tid, gs); continue; } it -= n_in;
            { auto vf = [&](int r, int k) -> float { return mods[5 * 6144 + r * 6144 + 3072 + k]; };
                gemv_det_item<4>(in[36], 5632, it * 64, (float*)(F.ws + CT_BUP1), 5632, nullptr, vf, F.tid, gs); }
        }
        __syncthreads();
    }
}

using pg8::f32x4; using pg8::Unit;
__device__ __forceinline__ float row_rs(const float* ssq, int np, int row) {
    float s = 0.f;
    for (int i = 0; i < np; ++i) s += ssq[(size_t)i * TT + row];
    return 1.0f / sqrtf(s * (1.0f / 1024.0f) + EPS);
}
struct EpiQKV {
    static constexpr bool PERM = true;
    bf16* obase; size_t pstride; const float* ssq; int np; const float* bias; int bias_bstride; const float *qg, *kg; int pn_off;
    __device__ __forceinline__ void operator()(const f32x4 (&acc)[2][2][4][2], const Unit& u, int wr, int wc, int fr, int fq) const {
        const int png = u.pn + pn_off, part = png >> 2, pnl = png & 3, head = 4 * pnl + wc;
        const int b = (u.pm * 256) / SEQ;
        const float* bp = bias + (size_t)b * bias_bstride + part * 1024 + head * 64;
        bf16* dst = obase + (size_t)part * pstride;
        const float* gp = part == 0 ? qg : kg;
        f32x4 bv[2][2], gv[2][2];
#pragma unroll
        for (int bj = 0; bj < 2; ++bj)
#pragma unroll
            for (int n = 0; n < 2; ++n) { const int d0 = 32 * bj + 8 * fq + 4 * n; bv[bj][n] = *(const f32x4*)(bp + d0); gv[bj][n] = *(const f32x4*)(gp + d0); }
#pragma unroll
        for (int ai = 0; ai < 2; ++ai)
#pragma unroll
            for (int m = 0; m < 4; ++m) {
                const int row = u.pm * 256 + ai * 128 + wr * 64 + m * 16 + fr;
                const float rs = row_rs(ssq, np, row);
                f32x4 v[2][2]; float ss = 0.f;
#pragma unroll
                for (int bj = 0; bj < 2; ++bj)
#pragma unroll
                    for (int n = 0; n < 2; ++n) { v[bj][n] = acc[ai][bj][m][n] * rs + bv[bj][n]; const f32x4 t = v[bj][n]; ss += (t.x * t.x + t.y * t.y) + (t.z * t.z + t.w * t.w); }
                if (part < 2) {
                    ss += __shfl_xor(ss, 16); ss += __shfl_xor(ss, 32);
                    const float rn = 1.0f / sqrtf(ss * (1.0f / 64.0f) + EPS);
#pragma unroll
                    for (int bj = 0; bj < 2; ++bj)
#pragma unroll
                        for (int n = 0; n < 2; ++n) v[bj][n] = v[bj][n] * rn * gv[bj][n];
                }
                bf16* rowp = dst + (size_t)row * DM + head * 64 + 8 * fq;
#pragma unroll
                for (int bj = 0; bj < 2; ++bj) { v4u w; w.x = pk2(v[bj][0].x, v[bj][0].y); w.y = pk2(v[bj][0].z, v[bj][0].w); w.z = pk2(v[bj][1].x, v[bj][1].y); w.w = pk2(v[bj][1].z, v[bj][1].w);
                    *(v4u*)(rowp + 32 * bj) = w; }
            }
    }
};
struct EpiRes {
    static constexpr bool PERM = true;
    const float* base; float* out; const float* gate; const float* bias; const float* gn; bf16* xs; float* ssq;
    __device__ __forceinline__ void operator()(const f32x4 (&acc)[2][2][4][2], const Unit& u, int wr, int wc, int fr, int fq) const {
        const int b = (u.pm * 256) / SEQ;
        const int col0 = u.pn * 256 + wc * 32 + 8 * fq;
        f32x4 gt[2][2], bv[2][2], gv[2][2];
#pragma unroll
        for (int bj = 0; bj < 2; ++bj)
#pragma unroll
            for (int n = 0; n < 2; ++n) { const int c = col0 + 128 * bj + 4 * n; gt[bj][n] = *(const f32x4*)(gate + (size_t)b * 6144 + c);
                bv[bj][n] = bias ? *(const f32x4*)(bias + c) : (f32x4){0.f, 0.f, 0.f, 0.f};
                gv[bj][n] = gn ? *(const f32x4*)(gn + (size_t)b * 1024 + c) : (f32x4){0.f, 0.f, 0.f, 0.f}; }
#pragma unroll
        for (int ai = 0; ai < 2; ++ai)
#pragma unroll
            for (int m = 0; m < 4; ++m) {
                const int row = u.pm * 256 + ai * 128 + wr * 64 + m * 16 + fr;
                const size_t off = (size_t)row * DM + col0;
                float ss = 0.f;
#pragma unroll
                for (int bj = 0; bj < 2; ++bj) {
                    f32x4 xn[2];
#pragma unroll
                    for (int n = 0; n < 2; ++n) { const f32x4 bs = *(const f32x4*)(base + off + 128 * bj + 4 * n);
                        xn[n] = bs + gt[bj][n] * (acc[ai][bj][m][n] + bv[bj][n]);
                        *(f32x4*)(out + off + 128 * bj + 4 * n) = xn[n];
                        ss += (xn[n].x * xn[n].x + xn[n].y * xn[n].y) + (xn[n].z * xn[n].z + xn[n].w * xn[n].w); }
                    if (xs) { const f32x4 a0 = xn[0] * gv[bj][0], a1 = xn[1] * gv[bj][1];
                        v4u w; w.x = pk2(a0.x, a0.y); w.y = pk2(a0.z, a0.w); w.z = pk2(a1.x, a1.y); w.w = pk2(a1.z, a1.w);
                        *(v4u*)(xs + off + 128 * bj) = w; }
                }
                if (ssq) { ss += __shfl_xor(ss, 16); ss += __shfl_xor(ss, 32); if (fq == 0) ssq[(size_t)(u.pn * 4 + wc) * TT + row] = ss; }
                asm volatile("" ::: "memory");
            }
    }
};
struct EpiScaleBias {
    static constexpr bool PERM = true;
    bf16* O; int ldc; const float* ssq; int np; const float* bias; int bias_bstride;
    __device__ __forceinline__ void operator()(const f32x4 (&acc)[2][2][4][2], const Unit& u, int wr, int wc, int fr, int fq) const {
        const int b = (u.pm * 256) / SEQ;
        const int col0 = u.pn * 256 + wc * 32 + 8 * fq;
        f32x4 bv[2][2];
#pragma unroll
        for (int bj = 0; bj < 2; ++bj)
#pragma unroll
            for (int n = 0; n < 2; ++n) bv[bj][n] = *(const f32x4*)(bias + (size_t)b * bias_bstride + col0 + 128 * bj + 4 * n);
#pragma unroll
        for (int ai = 0; ai < 2; ++ai)
#pragma unroll
            for (int m = 0; m < 4; ++m) {
                const int row = u.pm * 256 + ai * 128 + wr * 64 + m * 16 + fr;
                const float rs = row_rs(ssq, np, row);
                bf16* rowp = O + (size_t)row * ldc + col0;
#pragma unroll
                for (int bj = 0; bj < 2; ++bj) { const f32x4 v0 = acc[ai][bj][m][0] * rs + bv[bj][0], v1 = acc[ai][bj][m][1] * rs + bv[bj][1];
                    v4u w; w.x = pk2(v0.x, v0.y); w.y = pk2(v0.z, v0.w); w.z = pk2(v1.x, v1.y); w.w = pk2(v1.z, v1.w);
                    *(v4u*)(rowp + 128 * bj) = w; }
            }
    }
};
struct EpiInT {
    static constexpr bool PERM = true;
    bf16* UT; const float* ssq; int np; const float* bias;
    __device__ __forceinline__ void operator()(const f32x4 (&acc)[2][2][4][2], const Unit& u, int wr, int wc, int fr, int fq) const {
        const int b = (u.pm * 256) / SEQ;
        const int col0 = u.pn * 256 + wc * 32 + 8 * fq;
        f32x4 bv[2][2];
#pragma unroll
        for (int bj = 0; bj < 2; ++bj)
#pragma unroll
            for (int n = 0; n < 2; ++n) bv[bj][n] = *(const f32x4*)(bias + (size_t)b * 3072 + col0 + 128 * bj + 4 * n);
#pragma unroll
        for (int ai = 0; ai < 2; ++ai)
#pragma unroll
            for (int m = 0; m < 4; ++m) {
                const int row = u.pm * 256 + ai * 128 + wr * 64 + m * 16 + fr;
                const int t = row - b * SEQ;
                const float rs = row_rs(ssq, np, row);
#pragma unroll
                for (int bj = 0; bj < 2; ++bj)
#pragma unroll
                    for (int n = 0; n < 2; ++n) { const f32x4 v = acc[ai][bj][m][n] * rs + bv[bj][n];
                        bf16* p = UT + ((size_t)b * 3072 + col0 + 128 * bj + 4 * n) * SEQ + t;
                        p[0] = (bf16)f2bf(v.x); p[SEQ] = (bf16)f2bf(v.y); p[2 * SEQ] = (bf16)f2bf(v.z); p[3 * SEQ] = (bf16)f2bf(v.w); }
            }
    }
};

__device__ __forceinline__ float dot8(const v4u w, const float* q) {
    return q[0] * bflo(w.x) + q[1] * bfhi(w.x) + q[2] * bflo(w.y) + q[3] * bfhi(w.y) + q[4] * bflo(w.z) + q[5] * bfhi(w.z) + q[6] * bflo(w.w) + q[7] * bfhi(w.w);
}
__device__ __forceinline__ void attn_naive_phase(Frame& F) {
    const bf16* Q = (const bf16*)(F.ws + WS_Q); const bf16* Kb = (const bf16*)(F.ws + WS_K); const bf16* Vb = (const bf16*)(F.ws + WS_V);
    const bf16* Kc = (const bf16*)(F.ws + WS_KC); const bf16* Vc = (const bf16*)(F.ws + WS_VC);
    bf16* O = (bf16*)(F.ws + WS_O);
    const float* rpb = F.in[11];
    LAS float* sl = (LAS float*)(F.lds) + F.tid;
    const int gw = F.vcu * NWAVES + F.wave, NGW = F.G * NWAVES;
    const int c = F.lane;
    for (int unit = gw; unit < NB * GROWS * NH; unit += NGW) {
        const int h = unit % NH, r = (unit / NH) % GROWS, b = unit / (NH * GROWS);
        const int r0 = min(max(r - WH / 2, 0), GROWS - WH), c0 = min(max(c - WW / 2, 0), GW - WW);
        const size_t tok = (size_t)b * SEQ + r * GW + c;
        float q[64];
        {
            const v4u* qp = (const v4u*)(Q + tok * DM + h * HD);
#pragma unroll
            for (int i = 0; i < 8; ++i) { const v4u w = qp[i];
                q[8 * i + 0] = bflo(w.x) * 0.125f; q[8 * i + 1] = bfhi(w.x) * 0.125f; q[8 * i + 2] = bflo(w.y) * 0.125f; q[8 * i + 3] = bfhi(w.y) * 0.125f;
                q[8 * i + 4] = bflo(w.z) * 0.125f; q[8 * i + 5] = bfhi(w.z) * 0.125f; q[8 * i + 6] = bflo(w.w) * 0.125f; q[8 * i + 7] = bfhi(w.w) * 0.125f; }
        }
        float o[64];
#pragma unroll
        for (int d = 0; d < 64; ++d) o[d] = 0.f;
        float mrun = -1e30f, lrun = 0.f;
        for (int ch = 0; ch < 24; ++ch) {
            const bf16* kbase; const bf16* vbase;
            if (ch < 8) { const size_t kt = (size_t)b * SEQ + (size_t)(r0 + ch) * GW + c0; kbase = Kb + kt * DM + h * HD; vbase = Vb + kt * DM + h * HD; }
            else { const size_t kt = (size_t)b * CTXL + (size_t)(ch - 8) * 16; kbase = Kc + kt * DM + h * HD; vbase = Vc + kt * DM + h * HD; }
            float mx = -1e30f;
#pragma unroll 1
            for (int j = 0; j < 16; ++j) {
                const v4u* kp = (const v4u*)(kbase + (size_t)j * DM);
                float a = 0.f;
#pragma unroll
                for (int i = 0; i < 8; ++i) a += dot8(kp[i], q + 8 * i);
                if (ch < 8) a += rpb[(h * 15 + (r0 + ch - r + WH - 1)) * 31 + (c0 + j - c + WW - 1)];
                sl[j * 512] = a; mx = fmaxf(mx, a);
            }
            const float mnew = fmaxf(mrun, mx);
            const float alpha = __expf(mrun - mnew);
            mrun = mnew; lrun *= alpha;
#pragma unroll
            for (int d = 0; d < 64; ++d) o[d] *= alpha;
#pragma unroll 1
            for (int j = 0; j < 16; ++j) {
                const float p = __expf(sl[j * 512] - mnew); lrun += p;
                const v4u* vp = (const v4u*)(vbase + (size_t)j * DM);
#pragma unroll
                for (int i = 0; i < 8; ++i) { const v4u w = vp[i];
                    o[8 * i + 0] += p * bflo(w.x); o[8 * i + 1] += p * bfhi(w.x); o[8 * i + 2] += p * bflo(w.y); o[8 * i + 3] += p * bfhi(w.y);
                    o[8 * i + 4] += p * bflo(w.z); o[8 * i + 5] += p * bfhi(w.z); o[8 * i + 6] += p * bflo(w.w); o[8 * i + 7] += p * bfhi(w.w); }
            }
        }
        const float inv = 1.0f / lrun;
        v4u* op = (v4u*)(O + tok * DM + h * HD);
#pragma unroll
        for (int i = 0; i < 8; ++i) { v4u w; w.x = pk2(o[8 * i] * inv, o[8 * i + 1] * inv); w.y = pk2(o[8 * i + 2] * inv, o[8 * i + 3] * inv); w.z = pk2(o[8 * i + 4] * inv, o[8 * i + 5] * inv); w.w = pk2(o[8 * i + 6] * inv, o[8 * i + 7] * inv); op[i] = w; }
    }
}

__device__ __forceinline__ void convglu_phase(Frame& F, const float* cw, const float* cb) {
    bf16* ag = (bf16*)(F.ws + WS_AG);
    const long nvec = (long)TT * (FF / 8);
    for (long e = (long)F.vcu * 512 + F.tid; e < nvec; e += (long)F.G * 512) {
        const int t = (int)(e / (FF / 8)), j0 = (int)(e % (FF / 8)) * 8;
        const int tl = t % SEQ;
        const bf16* rowp = ag + (size_t)t * (2 * FF);
        const v4u a = *(const v4u*)(rowp + j0);
        const v4u g0 = *(const v4u*)(rowp + FF + j0);
        v4u gm = (v4u){0u, 0u, 0u, 0u}, gp = (v4u){0u, 0u, 0u, 0u};
        if (tl > 0) gm = *(const v4u*)(rowp - 2 * FF + FF + j0);
        if (tl < SEQ - 1) gp = *(const v4u*)(rowp + 2 * FF + FF + j0);
        float av[8], g0v[8], gmv[8], gpv[8];
        av[0] = bflo(a.x); av[1] = bfhi(a.x); av[2] = bflo(a.y); av[3] = bfhi(a.y); av[4] = bflo(a.z); av[5] = bfhi(a.z); av[6] = bflo(a.w); av[7] = bfhi(a.w);
        g0v[0] = bflo(g0.x); g0v[1] = bfhi(g0.x); g0v[2] = bflo(g0.y); g0v[3] = bfhi(g0.y); g0v[4] = bflo(g0.z); g0v[5] = bfhi(g0.z); g0v[6] = bflo(g0.w); g0v[7] = bfhi(g0.w);
        gmv[0] = bflo(gm.x); gmv[1] = bfhi(gm.x); gmv[2] = bflo(gm.y); gmv[3] = bfhi(gm.y); gmv[4] = bflo(gm.z); gmv[5] = bfhi(gm.z); gmv[6] = bflo(gm.w); gmv[7] = bfhi(gm.w);
        gpv[0] = bflo(gp.x); gpv[1] = bfhi(gp.x); gpv[2] = bflo(gp.y); gpv[3] = bfhi(gp.y); gpv[4] = bflo(gp.z); gpv[5] = bfhi(gp.z); gpv[6] = bflo(gp.w); gpv[7] = bfhi(gp.w);
        float r[8];
#pragma unroll
        for (int i = 0; i < 8; ++i) { const int j = j0 + i; const float cv = cw[j] * gmv[i] + cw[FF + j] * g0v[i] + cw[2 * FF + j] * gpv[i] + cb[j]; r[i] = av[i] * gelu_f(cv); }
        v4u w; w.x = pk2(r[0], r[1]); w.y = pk2(r[2], r[3]); w.z = pk2(r[4], r[5]); w.w = pk2(r[6], r[7]);
        *(v4u*)(ag + (size_t)t * (2 * FF) + j0) = w;
    }
}

__device__ __forceinline__ void filtgen_phase(Frame& F) {
    const float* const* in = F.in;
    const float *w1 = in[25], *b1 = in[26], *w2 = in[27], *b2 = in[28], *w3 = in[29], *b3 = in[30], *wout = in[31], *freq = in[32];
    float* hT = (float*)(F.ws + WS_HT); float* fsqp = (float*)(F.ws + WS_FSQP);
    LAS float* zf = (LAS float*)(F.lds);
    LAS float* ha = zf + 16 * 36;
    LAS float* hb = ha + 16 * 64;
    const int tid = F.tid;
    for (int item = F.vcu; item < SEQ / 16; item += F.G) {
        const int l0 = item * 16;
        __syncthreads();
        for (int e = tid; e < 16 * 33; e += 512) {
            const int p = e / 33, i = e % 33, l = l0 + p;
            float v;
            if (i == 0) v = (float)l / 8191.0f;
            else { const int bi = (i - 1) & 15; const float band = 1e-4f + (float)bi * ((15.0f - 1e-4f) / 15.0f);
                const float w = (float)(2.0 * 3.14159265358979323846 / 8192.0) * (float)l; const float arg = band * w;
                v = (i <= 16) ? cosf(arg) : -sinf(arg); }
            zf[p * 36 + i] = v;
        }
        __syncthreads();
        for (int e = tid; e < 16 * 64; e += 512) { const int p = e >> 6, j = e & 63; float a = b1[j];
            for (int i = 0; i < 33; ++i) a += zf[p * 36 + i] * w1[i * 64 + j];
            ha[p * 64 + j] = sinf(freq[j] * a); }
        __syncthreads();
        for (int e = tid; e < 16 * 64; e += 512) { const int p = e >> 6, j = e & 63; float a = b2[j];
            for (int i = 0; i < 64; ++i) a += ha[p * 64 + i] * w2[i * 64 + j];
            hb[p * 64 + j] = sinf(freq[j] * a); }
        __syncthreads();
        for (int e = tid; e < 16 * 64; e += 512) { const int p = e >> 6, j = e & 63; float a = b3[j];
            for (int i = 0; i < 64; ++i) a += hb[p * 64 + i] * w3[i * 64 + j];
            ha[p * 64 + j] = sinf(freq[j] * a); }
        __syncthreads();
        float sq[2] = {0.f, 0.f};
#pragma unroll
        for (int q = 0; q < 4; ++q) {
            const int n = tid + 512 * q, dir = n >> 10, c = n & 1023;
            float acc[16];
#pragma unroll
            for (int p = 0; p < 16; ++p) acc[p] = 0.f;
            for (int j = 0; j < 64; ++j) { const float w = wout[j * 2048 + n];
#pragma unroll
                for (int p = 0; p < 16; ++p) acc[p] += ha[p * 64 + j] * w; }
            const float la = -15.350567286626973f, lb = -3.0701134573253946f;
            const float delta = fabsf(la + (float)c * ((lb - la) / 1023.0f));
            float* op = hT + ((size_t)dir * 1024 + c) * SEQ + l0;
#pragma unroll
            for (int p = 0; p < 16; ++p) { const float tpos = (float)(l0 + p) / 8191.0f; const float v = acc[p] * expf(-tpos * delta); op[p] = v; sq[q & 1] += v * v; }
        }
        fsqp[(size_t)item * 1024 + tid] = sq[0]; fsqp[(size_t)item * 1024 + tid + 512] = sq[1];
    }
    __syncthreads();
}

__device__ __forceinline__ void filtfft_phase(Frame& F) {
    const float* hT = (const float*)(F.ws + WS_HT); const float* fsqp = (const float*)(F.ws + WS_FSQP);
    const cf* TWM = (const cf*)(F.ws + SM_TWM); const cf* TWN = (const cf*)(F.ws + SM_TWN);
    cf* Fsp = (cf*)(F.ws + WS_F);
    cf* a = (cf*)F.lds;
    float* red = (float*)(F.lds + 80 * 1024);
    for (int c = F.vcu; c < DM; c += F.G) {
        int tid = F.tid; FC_OPAQUE(tid);
        __syncthreads();
        red[tid] = fsqp[(size_t)tid * 1024 + c];
        __syncthreads();
        for (int st = 256; st > 0; st >>= 1) { if (tid < st) red[tid] += red[tid + st]; __syncthreads(); }
        const float nrm = 1.0f / sqrtf(red[0] + EPS);
        const float* hf = hT + (size_t)c * SEQ; const float* hb = hT + ((size_t)1024 + c) * SEQ;
#pragma unroll 1
        for (int path = 0; path < 2; ++path) {
            cf v[16];
            FC_OPAQUE(tid);
#pragma unroll
            for (int r = 0; r < 16; ++r) { const int n = tid + 512 * r; const float fa = hf[n] * nrm, fb = (n == 0) ? 0.f : hb[SEQ - n] * nrm;
                if (path == 0) { v[r].x = fa + fb; v[r].y = 0.f; } else { cf t; t.x = fa - fb; t.y = 0.f; v[r] = cmul(t, TWN[n]); }
                if ((r & 3) == 3) asm volatile("" ::: "memory"); }
            fwd_pass1(v, tid, a, TWM);
            __syncthreads();
            fwd_pass8(tid, a, TWM, 64, 6);
            __syncthreads();
            fwd_pass8(tid, a, TWM, 8, 3);
            __syncthreads();
            mid_pass(tid, a, (const cf*)nullptr, Fsp + ((size_t)c * 2 + path) * FC_M, 1.0f / 16384.0f);
            __syncthreads();
        }
    }
}

__device__ __forceinline__ void conv3_8(const v4u raw, float prev, float next, float w0, float w1, float w2, float bb, float* out) {
    float x[10]; x[0] = prev; x[9] = next;
    x[1] = bflo(raw.x); x[2] = bfhi(raw.x); x[3] = bflo(raw.y); x[4] = bfhi(raw.y); x[5] = bflo(raw.z); x[6] = bfhi(raw.z); x[7] = bflo(raw.w); x[8] = bfhi(raw.w);
#pragma unroll
    for (int i = 0; i < 8; ++i) out[i] = w0 * x[i] + w1 * x[i + 1] + w2 * x[i + 2] + bb;
}
__device__ __forceinline__ void hyena_fft_phase(Frame& F) {
    const float* const* in = F.in;
    const float* sw = in[23]; const float* sb = in[24]; const float* dbias = in[33];
    bf16* UT = (bf16*)(F.ws + WS_UT);
    const cf* TWM = (const cf*)(F.ws + SM_TWM); const cf* TWN = (const cf*)(F.ws + SM_TWN);
    const cf* Fsp = (const cf*)(F.ws + WS_F);
    cf* a = (cf*)F.lds;
    for (int unit = F.vcu; unit < 2 * DM; unit += F.G) {
        const int c = unit >> 1, b0 = (unit & 1) * 2;
        int tid = F.tid; FC_OPAQUE(tid);
        __syncthreads();
        {
            const float w10 = sw[1024 + c], w11 = sw[3072 + 1024 + c], w12 = sw[6144 + 1024 + c], bb1 = sb[1024 + c];
            const float wv0 = sw[2048 + c], wv1 = sw[3072 + 2048 + c], wv2 = sw[6144 + 2048 + c], bbv = sb[2048 + c];
#pragma unroll 1
            for (int h = 0; h < 2; ++h) {
                FC_OPAQUE(tid);
                const int t0 = (tid + 512 * h) * 8;
                float z[2][8];
#pragma unroll
                for (int bb = 0; bb < 2; ++bb) {
                    asm volatile("" ::: "memory");
                    const bf16* x1r = UT + ((size_t)(b0 + bb) * 3072 + 1024 + c) * SEQ;
                    const bf16* vr = UT + ((size_t)(b0 + bb) * 3072 + 2048 + c) * SEQ;
                    const v4u x1raw = *(const v4u*)(x1r + t0), vraw = *(const v4u*)(vr + t0);
                    const float x1p = t0 > 0 ? bf2f(x1r[t0 - 1]) : 0.f, x1n = t0 + 8 < SEQ ? bf2f(x1r[t0 + 8]) : 0.f;
                    const float vp = t0 > 0 ? bf2f(vr[t0 - 1]) : 0.f, vn = t0 + 8 < SEQ ? bf2f(vr[t0 + 8]) : 0.f;
                    float x1c[8], vc[8];
                    conv3_8(x1raw, x1p, x1n, w10, w11, w12, bb1, x1c);
                    conv3_8(vraw, vp, vn, wv0, wv1, wv2, bbv, vc);
#pragma unroll
                    for (int i = 0; i < 8; ++i) z[bb][i] = x1c[i] * vc[i];
                }
#pragma unroll
                for (int i = 0; i < 8; ++i) { cf t; t.x = z[0][i]; t.y = z[1][i]; a[FC_PIDX(t0 + i)] = t; }
            }
        }
        __syncthreads();
        cf wreg[16];
        FC_OPAQUE(tid);
        { const int pt = FC_PIDX(tid);
#pragma unroll
        for (int r = 0; r < 16; ++r) wreg[r] = a[pt + 576 * r]; }
        cf* e2 = (cf*)(F.lds + 73728);
#pragma unroll 1
        for (int path = 0; path < 2; ++path) {
            cf v[16];
            if (path == 0) {
#pragma unroll
                for (int r = 0; r < 16; ++r) v[r] = wreg[r];
            } else {
                FC_OPAQUE(tid);
#pragma unroll
                for (int r = 0; r < 16; ++r) { v[r] = cmul(wreg[r], TWN[tid + 512 * r]); if ((r & 3) == 3) asm volatile("" ::: "memory"); }
            }
            fwd_pass1(v, tid, a, TWM);
            __syncthreads();
            fwd_pass8(tid, a, TWM, 64, 6);
            __syncthreads();
            fwd_pass8(tid, a, TWM, 8, 3);
            __syncthreads();
            mid_pass(tid, a, Fsp + ((size_t)c * 2 + path) * FC_M, (cf*)nullptr, 0.f);
            __syncthreads();
            inv_pass8(tid, a, TWM, 8, 3);
            __syncthreads();
            inv_pass8(tid, a, TWM, 64, 6);
            __syncthreads();
            inv_pass1(v, tid, a, TWM);
            if (path == 0) {
#pragma unroll
                for (int r = 0; r < 16; ++r) e2[tid + 512 * r] = v[r];
            } else {
                const float db = dbias[c];
                FC_OPAQUE(tid);
#pragma unroll
                for (int r = 0; r < 16; ++r) { const int n = tid + 512 * r;
                    const cf y = cadd(cconj(e2[n]), cmul(cconj(TWN[n]), cconj(v[r])));
                    cf o; o.x = y.x + wreg[r].x * db; o.y = y.y + wreg[r].y * db; a[FC_PIDX(n)] = o; if ((r & 3) == 3) asm volatile("" ::: "memory"); }
            }
        }
        __syncthreads();
        {
            const float w00 = sw[c], w01 = sw[3072 + c], w02 = sw[6144 + c], bb0 = sb[c];
#pragma unroll 1
            for (int h = 0; h < 2; ++h) {
                FC_OPAQUE(tid);
                const int t0 = (tid + 512 * h) * 8;
                cf val[8];
#pragma unroll
                for (int i = 0; i < 8; ++i) val[i] = a[FC_PIDX(t0 + i)];
#pragma unroll
                for (int bb = 0; bb < 2; ++bb) {
                    const bf16* x0r = UT + ((size_t)(b0 + bb) * 3072 + c) * SEQ;
                    const v4u raw = *(const v4u*)(x0r + t0);
                    const float xp = t0 > 0 ? bf2f(x0r[t0 - 1]) : 0.f, xn = t0 + 8 < SEQ ? bf2f(x0r[t0 + 8]) : 0.f;
                    float x0c[8]; conv3_8(raw, xp, xn, w00, w01, w02, bb0, x0c);
                    float p[8];
#pragma unroll
                    for (int i = 0; i < 8; ++i) p[i] = x0c[i] * (bb == 0 ? val[i].x : val[i].y);
                    v4u o; o.x = pk2(p[0], p[1]); o.y = pk2(p[2], p[3]); o.z = pk2(p[4], p[5]); o.w = pk2(p[6], p[7]);
                    *(v4u*)(UT + ((size_t)(b0 + bb) * 3072 + 1024 + c) * SEQ + t0) = o;
                }
            }
        }
    }
    __syncthreads();
}
__device__ __forceinline__ void transpose_p_phase(Frame& F) {
    const bf16* UT = (const bf16*)(F.ws + WS_UT); bf16* P = (bf16*)(F.ws + WS_P);
    LAS unsigned short* scr = (LAS unsigned short*)(F.lds + F.wave * 16384);
    const int gw = F.vcu * NWAVES + F.wave, NGW = F.G * NWAVES, lane = F.lane;
    const int ntile = NB * (DM / 64) * (SEQ / 64);
    for (int it = gw; it < ntile; it += NGW) {
        const int tb = it % (SEQ / 64), cb = (it / (SEQ / 64)) % (DM / 64), b = it / ((SEQ / 64) * (DM / 64));
        for (int rr = 0; rr < 64; ++rr) scr[rr * 66 + lane] = UT[((size_t)b * 3072 + 1024 + cb * 64 + rr) * SEQ + tb * 64 + lane];
        LDS_WAIT(); asm volatile("" ::: "memory");
        for (int tt = 0; tt < 64; ++tt) P[((size_t)b * SEQ + tb * 64 + tt) * DM + cb * 64 + lane] = scr[lane * 66 + tt];
        LDS_WAIT(); asm volatile("" ::: "memory");
    }
}

constexpr int NPH = 17;
__global__ void __launch_bounds__(NWAVES * 64, 2) hybrid_fwd(Args args) {
    extern __shared__ __attribute__((aligned(16))) unsigned char lds[];
    Frame F;
    F.lds = (LAS unsigned char*)lds;
    F.tid = threadIdx.x; F.lane = F.tid & 63; F.wave = __builtin_amdgcn_readfirstlane(F.tid >> 6);
    F.G = gridDim.x; { const int bx = blockIdx.x; F.vcu = (F.G % 8 == 0) ? (bx % 8) * (F.G / 8) + bx / 8 : bx; }
    F.in = args.in; F.out = args.out; F.ws = args.ws;
    unsigned char* ws = args.ws;
    volatile LAS unsigned* MISC = (volatile LAS unsigned*)(F.lds + MISC_OFF);
    for (int u = F.tid; u < (LDS_BYTES - LDSCTL_OFF) / 4; u += NWAVES * 64) ((LAS unsigned*)(F.lds + LDSCTL_OFF))[u] = 0u;
    __syncthreads();
    XcdBarrier bar; bar.bar = (unsigned*)(ws + CT_BAR); bar.x = 0; bar.st = nullptr;
    const int lo = args.ph_lo, hi = args.ph_hi;
    if (hi - lo > 1) bar = xcd_barrier_post((unsigned*)(ws + CT_BAR), MISC + 8);
#ifndef PH_MASK
#define PH_MASK 0xFFFFFF
#endif
#define IN(k) ((((PH_MASK) >> (k)) & 1) && lo <= (k) && (k) < hi)
#define SEAM(k) do { if (IN(k) && IN((k) + 1)) xcd_barrier(bar); } while (0)
    const float* mods = (const float*)(ws + CT_MODS);
    const float* gnt = (const float*)(ws + SM_GN);
    float* ssqa = (float*)(ws + WS_SSQP);
    bf16* XS = (bf16*)(ws + WS_XS);

    if (IN(0)) { phase0a(F); } SEAM(0);
    if (IN(1)) { phase0b(F); } SEAM(1);
    if (IN(2)) {
        { pg8::Gemm g{XS, (const bf16*)(ws + WS_WQKV), TT, 3 * DM, DM, DM}; pg8::StaticOrder S; S.init(TT, 3 * DM, F.G, (int)blockIdx.x);
          EpiQKV E{(bf16*)(ws + WS_Q), (WS_K - WS_Q) / 2, (const float*)(ws + SM_SSQ0), 1, (const float*)(ws + CT_BQKV), 3072, args.in[9], args.in[10], 0};
          pg8::gemm_phase<EpiQKV, pg8::StaticOrder, true, true>(F.lds, g, S, E); }
        { pg8::Gemm g{(const bf16*)(ws + WS_XSC), (const bf16*)(ws + WS_WQKV) + (size_t)1024 * DM, TC, 2 * DM, DM, DM}; pg8::StaticOrder S; S.init(TC, 2 * DM, F.G, (int)blockIdx.x);
          EpiQKV E{(bf16*)(ws + WS_KC) - (WS_VC - WS_KC) / 2, (WS_VC - WS_KC) / 2, (const float*)(ws + SM_SSQC), 1, (const float*)(ws + CT_BQKV) + 4 * 3072, 0, args.in[9], args.in[10], 4};
          pg8::gemm_phase<EpiQKV, pg8::StaticOrder, true, true>(F.lds, g, S, E); }
    } SEAM(2);
    if (IN(3)) { attn_naive_phase(F); } SEAM(3);
    if (IN(4)) {
        pg8::Gemm g{(const bf16*)(ws + WS_O), (const bf16*)(ws + WS_WO), TT, DM, DM, DM}; pg8::StaticOrder S; S.init(TT, DM, F.G, (int)blockIdx.x);
        EpiRes E{args.in[0], args.out, mods + 2048, nullptr, gnt, XS, ssqa};
        pg8::gemm_phase<EpiRes, pg8::StaticOrder, true, true>(F.lds, g, S, E);
    } SEAM(4);
    if (IN(5)) {
        pg8::Gemm g{XS, (const bf16*)(ws + WS_WUP0), TT, 2 * FF, DM, DM}; pg8::StaticOrder S; S.init(TT, 2 * FF, F.G, (int)blockIdx.x);
        EpiScaleBias E{(bf16*)(ws + WS_AG), 2 * FF, ssqa, 16, (const float*)(ws + CT_BUP0), 5632};
        pg8::gemm_phase<EpiScaleBias, pg8::StaticOrder, true, true>(F.lds, g, S, E);
    } SEAM(5);
    if (IN(6)) { convglu_phase(F, args.in[14], args.in[15]); } SEAM(6);
    if (IN(7)) {
        pg8::Gemm g{(const bf16*)(ws + WS_AG), (const bf16*)(ws + WS_WDN0), TT, DM, FF, 2 * FF}; pg8::StaticOrder S; S.init(TT, DM, F.G, (int)blockIdx.x);
        EpiRes E{args.out, args.out, mods + 5120, nullptr, gnt + 4096, XS, ssqa + 16 * TT};
        pg8::gemm_phase<EpiRes, pg8::StaticOrder, true, true>(F.lds, g, S, E);
    } SEAM(7);
    if (IN(8)) { filtgen_phase(F); } SEAM(8);
    if (IN(9)) { filtfft_phase(F); } SEAM(9);
    if (IN(10)) {
        pg8::Gemm g{XS, (const bf16*)(ws + WS_WIN), TT, 3 * DM, DM, DM}; pg8::StaticOrder S; S.init(TT, 3 * DM, F.G, (int)blockIdx.x);
#ifdef EXP_P9
        EpiScaleBias E{(bf16*)(ws + WS_UT), 3 * DM, ssqa + 16 * TT, 16, (const float*)(ws + CT_BIN), 3072};
        pg8::gemm_phase<EpiScaleBias, pg8::StaticOrder, true, true>(F.lds, g, S, E);
#else
        EpiInT E{(bf16*)(ws + WS_UT), ssqa + 16 * TT, 16, (const float*)(ws + CT_BIN)};
        pg8::gemm_phase<EpiInT, pg8::StaticOrder, true, true>(F.lds, g, S, E);
#endif
    } SEAM(10);
    if (IN(11)) { hyena_fft_phase(F); } SEAM(11);
    if (IN(12)) { transpose_p_phase(F); } SEAM(12);
    if (IN(13)) {
        pg8::Gemm g{(const bf16*)(ws + WS_P), (const bf16*)(ws + WS_WOUT), TT, DM, DM, DM}; pg8::StaticOrder S; S.init(TT, DM, F.G, (int)blockIdx.x);
        EpiRes E{args.out, args.out, mods + 5 * 6144 + 2048, args.in[35], gnt + 2 * 4096, XS, ssqa + 32 * TT};
        pg8::gemm_phase<EpiRes, pg8::StaticOrder, true, true>(F.lds, g, S, E);
    } SEAM(13);
    if (IN(14)) {
        pg8::Gemm g{XS, (const bf16*)(ws + WS_WUP1), TT, 2 * FF, DM, DM}; pg8::StaticOrder S; S.init(TT, 2 * FF, F.G, (int)blockIdx.x);
        EpiScaleBias E{(bf16*)(ws + WS_AG), 2 * FF, ssqa + 32 * TT, 16, (const float*)(ws + CT_BUP1), 5632};
        pg8::gemm_phase<EpiScaleBias, pg8::StaticOrder, true, true>(F.lds, g, S, E);
    } SEAM(14);
    if (IN(15)) { convglu_phase(F, args.in[37], args.in[38]); } SEAM(15);
    if (IN(16)) {
        pg8::Gemm g{(const bf16*)(ws + WS_AG), (const bf16*)(ws + WS_WDN1), TT, DM, FF, 2 * FF}; pg8::StaticOrder S; S.init(TT, DM, F.G, (int)blockIdx.x);
        EpiRes E{args.out, args.out, mods + 5 * 6144 + 5120, nullptr, nullptr, nullptr, nullptr};
        pg8::gemm_phase<EpiRes, pg8::StaticOrder, true, true>(F.lds, g, S, E);
    }
#ifdef DUMP_SEL
    if (lo == 99) {
        float* o = args.out; const size_t n = (size_t)TT * DM;
        for (size_t e = (size_t)blockIdx.x * 512 + F.tid; e < n; e += (size_t)F.G * 512) {
            float v;
            if (DUMP_SEL == 1) { const float* h = (const float*)(ws + WS_HT); v = (e < (size_t)2 * 1024 * SEQ) ? h[e] : ((const float*)(ws + WS_FSQP))[e & 1023]; }
            else if (DUMP_SEL == 2) { const bf16* u = (const bf16*)(ws + WS_UT); v = bf2f(u[e]); }
            else if (DUMP_SEL == 3) { const bf16* u = (const bf16*)(ws + WS_UT); v = bf2f(u[e + (size_t)TT * DM]); }
            else if (DUMP_SEL == 4) { const bf16* u = (const bf16*)(ws + WS_UT); v = bf2f(u[e + (size_t)2 * TT * DM]); }
            else { const bf16* u = (const bf16*)(ws + WS_P); v = bf2f(u[e]); }
            o[e] = v;
        }
    }
#endif
#undef IN
#undef SEAM
}

extern "C" void kernel_launch(void* const* d_in, const int* in_sizes, int n_in, void* d_out, int out_size, void* d_ws, size_t ws_size, hipStream_t stream) {
    static int grid = 0;
    if (grid == 0) {
        if (n_in != 40 || out_size != TT * DM || ws_size < WS_END) { fprintf(stderr, "kernel_launch: unexpected shapes n_in %d out %d ws %zu\n", n_in, out_size, ws_size); grid = -1; return; }
        int dev = 0, cus = 0;
        if (hipGetDevice(&dev) != hipSuccess || hipDeviceGetAttribute(&cus, hipDeviceAttributeMultiprocessorCount, dev) != hipSuccess) { grid = -1; return; }
        if (hipFuncSetAttribute((const void*)hybrid_fwd, hipFuncAttributeMaxDynamicSharedMemorySize, LDS_BYTES) != hipSuccess) { fprintf(stderr, "kernel_launch: hipFuncSetAttribute failed\n"); grid = -1; return; }
        int per_cu = 0;
        if (hipOccupancyMaxActiveBlocksPerMultiprocessor(&per_cu, (const void*)hybrid_fwd, NWAVES * 64, LDS_BYTES) != hipSuccess || per_cu < 1) { fprintf(stderr, "kernel_launch: occupancy query says %d\n", per_cu); }
        (void)hipGetLastError();
        grid = cus;
    }
    if (grid < 0) return;
    (void)hipMemsetAsync((char*)d_ws + WS_CTL, 0, CTL_ZERO_BYTES, stream);
    Args a{};
    for (int i = 0; i < 40; ++i) a.in[i] = (const float*)d_in[i];
    a.out = (float*)d_out; a.ws = (unsigned char*)d_ws;
#if MK_ONE_LAUNCH
    a.ph_lo = 0; a.ph_hi = NPH;
    hipLaunchKernelGGL(hybrid_fwd, dim3(grid), dim3(NWAVES * 64), LDS_BYTES, stream, a);
#else
    for (int p = 0; p < PH_END; ++p) { a.ph_lo = p; a.ph_hi = p + 1; hipLaunchKernelGGL(hybrid_fwd, dim3(grid), dim3(NWAVES * 64), LDS_BYTES, stream, a); }
#ifdef DUMP_SEL
    a.ph_lo = 99; a.ph_hi = 100; hipLaunchKernelGGL(hybrid_fwd, dim3(grid), dim3(NWAVES * 64), LDS_BYTES, stream, a);
#endif
#endif
}
```

```cpp
#include <hip/hip_runtime.h>
#include <cstdio>
#include <cstdint>

#ifndef PH_END
#define PH_END 17
#endif
#ifndef MK_ONE_LAUNCH
#define MK_ONE_LAUNCH 1
#endif

namespace pg8 {
#define PG8_LAS __attribute__((address_space(3)))
typedef unsigned short bf16_t;
typedef short bf16x8 __attribute__((ext_vector_type(8)));
typedef float f32x4 __attribute__((ext_vector_type(4)));
typedef unsigned u32x4 __attribute__((ext_vector_type(4)));
constexpr int BM = 256, BK = 64, HALF = 128, HTB = HALF * BK * 2, STAGE_BYTES = 8 * HTB, NXCD = 8, WGM = 8;

__host__ __device__ __forceinline__ int lds_byte(int r, int c) { const int st = (r >> 4) * 2 + (c >> 5), rr = r & 15, cc = c & 31, ob = rr * 64 + cc * 2; return st * 1024 + (ob ^ (((ob >> 9) & 1) << 5)); }
__host__ __device__ __forceinline__ void stage_rc(int b, int& R, int& C) { const int st = b / 1024, sb = b % 1024, swz = sb ^ (((sb >> 9) & 1) << 5); R = (st >> 1) * 16 + swz / 64; C = (st & 1) * 32 + (swz % 64) / 2; }
__host__ __device__ __forceinline__ int perm32(int rho) { const int n = rho >> 4, i = rho & 15; return 8 * (i >> 2) + 4 * n + (i & 3); }

struct Unit { int pm, pn; };
struct Gemm { const bf16_t* A; const bf16_t* Bt; int M, N, K, lda; };

struct StaticOrder {
    int nM, nN, nwg, G, c;
    __host__ __device__ void init(int M, int N, int G_, int c_) { nM = M / BM; nN = N / BM; nwg = nM * nN; G = G_; c = c_; }
    __host__ __device__ bool next(int i, Unit& u) const {
        const long L = (long)i * G + c; if (L >= nwg) return false;
        int wgid = (int)L; { const int q = nwg / NXCD, r = nwg % NXCD, xcd = wgid % NXCD, off = wgid / NXCD; wgid = (xcd < r ? xcd * (q + 1) : r * (q + 1) + (xcd - r) * q) + off; }
        const int nig = WGM * nN, gid = wgid / nig, fm = gid * WGM, gsz = (nM - fm) < WGM ? (nM - fm) : WGM;
        u.pm = fm + ((wgid % nig) % gsz); u.pn = (wgid % nig) / gsz; return true;
    }
    __device__ __forceinline__ void a_ready(const Unit&) const {}
    __device__ __forceinline__ void done(const Unit&) const {}
};

__device__ __forceinline__ unsigned cvt_pk_bf16(float lo, float hi) { unsigned r; asm volatile("v_cvt_pk_bf16_f32 %0, %1, %2" : "=v"(r) : "v"(lo), "v"(hi)); return r; }

template <class Epi, class Sched, bool ALIGN_EPI = false, bool SP2 = false>
__device__ __forceinline__ void gemm_phase(PG8_LAS unsigned char* lds, const Gemm g, const Sched& S, const Epi& E) {
    const int tid = threadIdx.x, wid = __builtin_amdgcn_readfirstlane(tid >> 6), lane = tid & 63, wr = wid >> 2, wc = wid & 3, fr = lane & 15, fq = lane >> 4;
    const int K = g.K, nt = K / BK, lda = g.lda;
    unsigned voffA[2], voffB[2];
#pragma unroll
    for (int i = 0; i < 2; ++i) { int R, C; stage_rc(tid * 16 + i * 8192, R, C); const int Rb = Epi::PERM ? ((R & ~31) + perm32(R & 31)) : R;
        voffA[i] = (unsigned)(R * lda + C) * 2u; voffB[i] = (unsigned)(Rb * K + C) * 2u; }
    const size_t kstep = (size_t)(BK * 2);
    const size_t hstepA = (size_t)HALF * lda * 2, hstepB = (size_t)HALF * K * 2;
    const size_t tstepA = 2 * hstepA, tstepB = 2 * hstepB;
    const unsigned ldsw = (unsigned)wid * 1024u;
    const int aoff = lds_byte(wr * 64 + fr, fq * 8), boff = lds_byte(wc * 32 + fr, fq * 8);
#define PG8_SA(b, h) (((b) * 2 + (h)) * HTB)
#define PG8_SB(b, h) ((4 + (b) * 2 + (h)) * HTB)
#define PG8_STAGE(bufoff, gbase, voff) do { _Pragma("unroll") for (int _i = 0; _i < 2; ++_i) \
        __builtin_amdgcn_global_load_lds((const unsigned*)((const char*)(gbase) + (voff)[_i]), (PG8_LAS unsigned*)(lds + (bufoff) + ldsw + _i * 8192), 16, 0, 0); } while (0)
#define PG8_LDA(dst, b, h) do { _Pragma("unroll") for (int m = 0; m < 4; ++m) _Pragma("unroll") for (int k = 0; k < 2; ++k) dst[m][k] = *(const PG8_LAS bf16x8*)(lds + PG8_SA(b, h) + aoff + m * 2048 + k * 1024); } while (0)
#define PG8_LDB(dst, b, h) do { _Pragma("unroll") for (int n = 0; n < 2; ++n) _Pragma("unroll") for (int k = 0; k < 2; ++k) dst[n][k] = *(const PG8_LAS bf16x8*)(lds + PG8_SB(b, h) + boff + n * 2048 + k * 1024); } while (0)
#define PG8_MMA(ai, bj, At, Bt) do { __builtin_amdgcn_s_setprio(1); _Pragma("unroll") for (int m = 0; m < 4; ++m) _Pragma("unroll") for (int n = 0; n < 2; ++n) _Pragma("unroll") for (int k = 0; k < 2; ++k) \
        acc[ai][bj][m][n] = __builtin_amdgcn_mfma_f32_16x16x32_bf16(Bt[n][k], At[m][k], acc[ai][bj][m][n], 0, 0, 0); __builtin_amdgcn_s_setprio(0); } while (0)
#define PG8_WAIT_V(n) asm volatile("s_waitcnt vmcnt(" #n ")" ::: "memory")
#define PG8_WAIT_L(n) asm volatile("s_waitcnt lgkmcnt(" #n ")" ::: "memory")
#define PG8_BAR __builtin_amdgcn_s_barrier()
#define PG8_SCHED __builtin_amdgcn_sched_barrier(0)
    Unit cur, nxt; int ui = 0;
    if (!S.next(0, cur)) return;
    f32x4 acc[2][2][4][2];
#pragma unroll
    for (int a = 0; a < 2; ++a)
#pragma unroll
        for (int b = 0; b < 2; ++b)
#pragma unroll
            for (int m = 0; m < 4; ++m)
#pragma unroll
                for (int n = 0; n < 2; ++n) acc[a][b][m][n] = (f32x4){0.f, 0.f, 0.f, 0.f};
    bf16x8 At[4][2], B0[2][2], B1[2][2];
    const char* cA = (const char*)g.A + (size_t)cur.pm * tstepA; const char* cB = (const char*)g.Bt + (size_t)cur.pn * tstepB;
    S.a_ready(cur);
    if constexpr (SP2) {
        PG8_STAGE(PG8_SB(0, 0), cB, voffB); PG8_STAGE(PG8_SB(0, 1), cB + hstepB, voffB); PG8_STAGE(PG8_SA(0, 0), cA, voffA); PG8_STAGE(PG8_SA(0, 1), cA + hstepA, voffA);
        if (wr == 1) PG8_BAR;
        PG8_WAIT_V(2); PG8_BAR;
        PG8_STAGE(PG8_SB(1, 0), cB + kstep, voffB); PG8_STAGE(PG8_SA(1, 0), cA + kstep, voffA); PG8_STAGE(PG8_SB(1, 1), cB + hstepB + kstep, voffB);
        PG8_WAIT_V(6); PG8_BAR;
    } else {
        PG8_STAGE(PG8_SB(0, 0), cB, voffB); PG8_STAGE(PG8_SA(0, 0), cA, voffA); PG8_STAGE(PG8_SB(0, 1), cB + hstepB, voffB); PG8_STAGE(PG8_SA(0, 1), cA + hstepA, voffA);
        if (wr == 1) PG8_BAR;
        PG8_WAIT_V(4); PG8_BAR;
        PG8_STAGE(PG8_SB(1, 0), cB + kstep, voffB); PG8_STAGE(PG8_SA(1, 0), cA + kstep, voffA); PG8_STAGE(PG8_SB(1, 1), cB + hstepB + kstep, voffB);
        PG8_WAIT_V(6); PG8_BAR;
    }
    for (;;) {
        const bool has_next = S.next(ui + 1, nxt);
        const char* nA = has_next ? (const char*)g.A + (size_t)nxt.pm * tstepA : cA; const char* nB = has_next ? (const char*)g.Bt + (size_t)nxt.pn * tstepB : cB;
        for (int t = 0; t < nt; t += 2) {
            const bool last = (t == nt - 2);
            const char* a1 = cA + (size_t)(t + 1) * kstep;
            const char* a2 = last ? nA : cA + (size_t)(t + 2) * kstep; const char* b2 = last ? nB : cB + (size_t)(t + 2) * kstep;
            const char* a3 = a2 + kstep; const char* b3 = b2 + kstep;
            if (last && has_next) S.a_ready(nxt);
            if constexpr (SP2) {
            PG8_LDB(B0, 0, 0); PG8_LDB(B1, 0, 1); PG8_SCHED; PG8_LDA(At, 0, 0); PG8_STAGE(PG8_SA(1, 1), a1 + hstepA, voffA);
            PG8_WAIT_V(8); PG8_WAIT_L(0); PG8_BAR; PG8_MMA(0, 0, At, B0); PG8_MMA(0, 1, At, B1); PG8_BAR; PG8_SCHED;
            PG8_LDA(At, 0, 1); PG8_STAGE(PG8_SB(0, 0), b2, voffB); PG8_STAGE(PG8_SB(0, 1), b2 + hstepB, voffB); PG8_STAGE(PG8_SA(0, 0), a2, voffA);
            PG8_WAIT_V(8); PG8_WAIT_L(0); PG8_BAR; PG8_MMA(1, 0, At, B0); PG8_MMA(1, 1, At, B1); PG8_BAR; PG8_SCHED;
            PG8_LDB(B0, 1, 0); PG8_LDB(B1, 1, 1); PG8_SCHED; PG8_LDA(At, 1, 0); PG8_STAGE(PG8_SA(0, 1), a2 + hstepA, voffA);
            PG8_WAIT_V(8); PG8_WAIT_L(0); PG8_BAR; PG8_MMA(0, 0, At, B0); PG8_MMA(0, 1, At, B1); PG8_BAR; PG8_SCHED;
            PG8_LDA(At, 1, 1); PG8_STAGE(PG8_SB(1, 0), b3, voffB); PG8_STAGE(PG8_SB(1, 1), b3 + hstepB, voffB); PG8_STAGE(PG8_SA(1, 0), a3, voffA);
            PG8_WAIT_V(8); PG8_WAIT_L(0); PG8_BAR; PG8_MMA(1, 0, At, B0); PG8_MMA(1, 1, At, B1); PG8_BAR; PG8_SCHED;
            } else {
            PG8_LDB(B0, 0, 0); PG8_SCHED; PG8_LDA(At, 0, 0); PG8_STAGE(PG8_SA(1, 1), a1 + hstepA, voffA);
            PG8_WAIT_L(8); PG8_BAR; PG8_WAIT_L(0); PG8_MMA(0, 0, At, B0); PG8_BAR; PG8_SCHED;
            PG8_LDB(B1, 0, 1); PG8_STAGE(PG8_SB(0, 0), b2, voffB);
            PG8_BAR; PG8_WAIT_L(0); PG8_MMA(0, 1, At, B1); PG8_BAR;
            PG8_LDA(At, 0, 1); PG8_STAGE(PG8_SA(0, 0), a2, voffA);
            PG8_BAR; PG8_WAIT_L(0); PG8_MMA(1, 0, At, B0); PG8_BAR; PG8_SCHED;
            PG8_STAGE(PG8_SB(0, 1), b2 + hstepB, voffB);
            PG8_WAIT_V(6); PG8_BAR; PG8_MMA(1, 1, At, B1); PG8_BAR;
            PG8_LDB(B0, 1, 0); PG8_SCHED; PG8_LDA(At, 1, 0); PG8_STAGE(PG8_SA(0, 1), a2 + hstepA, voffA);
            PG8_WAIT_L(8); PG8_BAR; PG8_WAIT_L(0); PG8_MMA(0, 0, At, B0); PG8_BAR; PG8_SCHED;
            PG8_LDB(B1, 1, 1); PG8_STAGE(PG8_SB(1, 0), b3, voffB);
            PG8_BAR; PG8_WAIT_L(0); PG8_MMA(0, 1, At, B1); PG8_BAR;
            PG8_LDA(At, 1, 1); PG8_STAGE(PG8_SA(1, 0), a3, voffA);
            PG8_BAR; PG8_WAIT_L(0); PG8_MMA(1, 0, At, B0); PG8_BAR; PG8_SCHED;
            PG8_STAGE(PG8_SB(1, 1), b3 + hstepB, voffB);
            PG8_WAIT_V(6); PG8_BAR; PG8_MMA(1, 1, At, B1); PG8_BAR;
            }
        }
        if constexpr (ALIGN_EPI) { if (wr == 0) PG8_BAR; }
        E(acc, cur, wr, wc, fr, fq); S.done(cur);
        if (!has_next) break;
#pragma unroll
        for (int a = 0; a < 2; ++a)
#pragma unroll
            for (int b = 0; b < 2; ++b)
#pragma unroll
                for (int m = 0; m < 4; ++m)
#pragma unroll
                    for (int n = 0; n < 2; ++n) acc[a][b][m][n] = (f32x4){0.f, 0.f, 0.f, 0.f};
        cur = nxt; cA = nA; cB = nB; ++ui;
        if constexpr (ALIGN_EPI) { if (wr == 1) PG8_BAR; }
    }
    PG8_WAIT_V(0);
    if constexpr (!ALIGN_EPI) { if (wr == 0) PG8_BAR; }
    PG8_BAR;
#undef PG8_SA
#undef PG8_SB
#undef PG8_STAGE
#undef PG8_LDA
#undef PG8_LDB
#undef PG8_MMA
#undef PG8_WAIT_V
#undef PG8_WAIT_L
#undef PG8_BAR
#undef PG8_SCHED
}
}

constexpr int NB = 4, SEQ = 8192, DM = 1024, TT = NB * SEQ, CTXL = 256, TC = NB * CTXL, FF = 2816, NH = 16, HD = 64, GW = 64, GROWS = SEQ / GW;
constexpr int WH = 8, WW = 16;
constexpr float EPS = 1e-6f;
constexpr int NWAVES = 8;

constexpr size_t MiB = 1u << 20;
constexpr size_t WS_CTL = 0, CTL_ZERO_BYTES = 64 * 1024;
constexpr size_t CT_BAR = 16384;
constexpr size_t CT_MODS = 64 * 1024;
constexpr size_t CT_BQKV = CT_MODS + 2 * 5 * 6144 * 4;
constexpr size_t CT_BUP0 = CT_BQKV + 5 * 3072 * 4;
constexpr size_t CT_BIN  = CT_BUP0 + 4 * 5632 * 4;
constexpr size_t CT_BUP1 = CT_BIN + 4 * 3072 * 4;
constexpr size_t CT_END  = CT_BUP1 + 4 * 5632 * 4;
static_assert(CT_END <= 1 * MiB, "ctl region");
constexpr size_t SM_SSQ0 = 1 * MiB, SM_SSQC = SM_SSQ0 + 32768 * 4, SM_GN = SM_SSQC + 1024 * 4;
constexpr size_t WS_SSQP = 2 * MiB;
constexpr size_t WS_FSQP = 448 * MiB;
constexpr size_t WS_WQKV = 8 * MiB, WS_WO = 14 * MiB, WS_WUP0 = 16 * MiB, WS_WDN0 = 27 * MiB, WS_WIN = 33 * MiB, WS_WOUT = 39 * MiB, WS_WUP1 = 41 * MiB, WS_WDN1 = 52 * MiB;
constexpr size_t WS_XSC = 58 * MiB, WS_KC = 60 * MiB, WS_VC = 62 * MiB;
constexpr size_t WS_XS = 64 * MiB;
constexpr size_t WS_Q = 128 * MiB, WS_K = 192 * MiB, WS_V = 256 * MiB, WS_O = 320 * MiB;
constexpr size_t WS_AG = 128 * MiB;
constexpr size_t WS_HG = 384 * MiB, WS_HA = 392 * MiB;
constexpr size_t WS_UT = 128 * MiB;
constexpr size_t WS_HT = 128 * MiB;
constexpr size_t WS_F = 320 * MiB;
constexpr size_t SM_TWM = 1536 * 1024, SM_TWN = SM_TWM + 65536;
constexpr size_t WS_P = 384 * MiB;
constexpr size_t WS_END = 480 * MiB;

constexpr int RING_BYTES = 131072;
constexpr int LDS_BYTES = 163840;
constexpr int LDSCTL_OFF = LDS_BYTES - 1024, MISC_OFF = LDSCTL_OFF + 320;

#define GAS __attribute__((address_space(1)))
#define LAS __attribute__((address_space(3)))
typedef unsigned short bf16;
typedef unsigned v4u __attribute__((ext_vector_type(4)));
typedef unsigned v2u __attribute__((ext_vector_type(2)));
typedef float f32x4 __attribute__((ext_vector_type(4)));
typedef GAS unsigned gu32;
#define RLX_AGENT __ATOMIC_RELAXED, __HIP_MEMORY_SCOPE_AGENT
#define LDS_WAIT() asm volatile("s_waitcnt lgkmcnt(0)" ::: "memory")
#define VM_WAIT() asm volatile("s_waitcnt vmcnt(0)" ::: "memory")
__device__ __forceinline__ unsigned f2bf(float f) { unsigned u = __builtin_bit_cast(unsigned, f); return (u + 0x7fffu + ((u >> 16) & 1u)) >> 16; }
__device__ __forceinline__ unsigned pk2(float lo, float hi) { return f2bf(lo) | (f2bf(hi) << 16); }
__device__ __forceinline__ float bf2f(unsigned short h) { return __builtin_bit_cast(float, (unsigned)h << 16); }
__device__ __forceinline__ float bflo(unsigned w) { return __builtin_bit_cast(float, w << 16); }
__device__ __forceinline__ float bfhi(unsigned w) { return __builtin_bit_cast(float, w & 0xffff0000u); }

#define FC_HD __device__ __forceinline__
struct cf { float x, y; };
FC_HD cf cmul(cf a, cf b) { cf r; r.x = a.x * b.x - a.y * b.y; r.y = a.x * b.y + a.y * b.x; return r; }
FC_HD cf cadd(cf a, cf b) { cf r; r.x = a.x + b.x; r.y = a.y + b.y; return r; }
FC_HD cf csub(cf a, cf b) { cf r; r.x = a.x - b.x; r.y = a.y - b.y; return r; }
FC_HD cf cconj(cf a) { cf r; r.x = a.x; r.y = -a.y; return r; }
FC_HD cf cmulnegi(cf a) { cf r; r.x = a.y; r.y = -a.x; return r; }
#define FC_OPAQUE(x) asm volatile("" : "+v"(x))
#define FC_PIDX(i) ((i) + (((i) >> 6) << 3))
#define FC_M 8192
#define FC_PADM (FC_M + FC_M / 8)
#define FC_S2 0.70710678118654752f
FC_HD void dft4(cf& a0, cf& a1, cf& a2, cf& a3) {
    const cf c0 = cadd(a0, a2), c1 = cadd(a1, a3), d0 = csub(a0, a2), d1 = cmulnegi(csub(a1, a3));
    a0 = cadd(c0, c1); a1 = cadd(d0, d1); a2 = csub(c0, c1); a3 = csub(d0, d1);
}
FC_HD void dft8(cf* v) {
    cf a0 = cadd(v[0], v[4]), a1 = cadd(v[1], v[5]), a2 = cadd(v[2], v[6]), a3 = cadd(v[3], v[7]);
    cf b0 = csub(v[0], v[4]), b1 = csub(v[1], v[5]), b2 = csub(v[2], v[6]), b3 = csub(v[3], v[7]);
    { cf t; t.x = (b1.x + b1.y) * FC_S2; t.y = (b1.y - b1.x) * FC_S2; b1 = t; }
    b2 = cmulnegi(b2);
    { cf t; t.x = (b3.y - b3.x) * FC_S2; t.y = (-b3.x - b3.y) * FC_S2; b3 = t; }
    dft4(a0, a1, a2, a3); dft4(b0, b1, b2, b3);
    v[0] = a0; v[2] = a1; v[4] = a2; v[6] = a3; v[1] = b0; v[3] = b1; v[5] = b2; v[7] = b3;
}
FC_HD void dft16(cf* v) {
    cf a[8], b[8];
    const float c1 = 0.92387953251128674f, s1 = 0.38268343236508977f;
#ifdef __HIP_DEVICE_COMPILE__
#pragma unroll
#endif
    for (int i = 0; i < 8; ++i) { a[i] = cadd(v[i], v[i + 8]); b[i] = csub(v[i], v[i + 8]); }
    { cf w; w.x = c1; w.y = -s1; b[1] = cmul(b[1], w); }
    { cf w; w.x = FC_S2; w.y = -FC_S2; b[2] = cmul(b[2], w); }
    { cf w; w.x = s1; w.y = -c1; b[3] = cmul(b[3], w); }
    b[4] = cmulnegi(b[4]);
    { cf w; w.x = -s1; w.y = -c1; b[5] = cmul(b[5], w); }
    { cf w; w.x = -FC_S2; w.y = -FC_S2; b[6] = cmul(b[6], w); }
    { cf w; w.x = -c1; w.y = -s1; b[7] = cmul(b[7], w); }
    dft8(a); dft8(b);
#ifdef __HIP_DEVICE_COMPILE__
#pragma unroll
#endif
    for (int i = 0; i < 8; ++i) { v[2 * i] = a[i]; v[2 * i + 1] = b[i]; }
}
template <int R> FC_HD void cpowers(cf w1, cf* w) {
    w[0].x = 1.f; w[0].y = 0.f; w[1] = w1;
#ifdef __HIP_DEVICE_COMPILE__
#pragma unroll
#endif
    for (int q = 2; q < R; ++q) w[q] = (q & 1) ? cmul(w[q - 1], w1) : cmul(w[q >> 1], w[q >> 1]);
}
template <class LP> FC_HD void fwd_pass1(cf* v, int tid, LP a, const cf* TWM) {
    dft16(v);
    FC_OPAQUE(tid);
    const cf w1 = TWM[tid]; cf cur = w1;
    const int pt = FC_PIDX(tid);
    a[pt] = v[0];
#ifdef __HIP_DEVICE_COMPILE__
#pragma unroll
#endif
    for (int q = 1; q < 16; ++q) { a[pt + 576 * q] = cmul(v[q], cur); cur = cmul(cur, w1); }
}
template <class LP> FC_HD void fwd_pass8(int tid, LP a, const cf* TWM, int s, int lgs) {
#pragma unroll 1
    for (int h = 0; h < 2; ++h) {
        FC_OPAQUE(tid);
        const int bf = tid + 512 * h, j = bf & (s - 1), base = (bf >> lgs) * 8 * s;
        const int pb = FC_PIDX(base + j), ps = (s == 64) ? 72 : 8;
        cf v[8];
#ifdef __HIP_DEVICE_COMPILE__
#pragma unroll
#endif
        for (int r = 0; r < 8; ++r) v[r] = a[pb + ps * r];
        dft8(v);
        const cf w1 = TWM[j * (FC_M / (8 * s))]; cf cur = w1;
        a[pb] = v[0];
#ifdef __HIP_DEVICE_COMPILE__
#pragma unroll
#endif
        for (int q = 1; q < 8; ++q) { a[pb + ps * q] = cmul(v[q], cur); cur = cmul(cur, w1); }
    }
}
template <class LP> FC_HD void mid_pass(int tid, LP a, const cf* F, cf* Fout, float fscale) {
#pragma unroll 1
    for (int h = 0; h < 2; ++h) {
        FC_OPAQUE(tid);
        const int bf = tid + 512 * h, base = bf * 8, pb = FC_PIDX(base);
        cf v[8];
#ifdef __HIP_DEVICE_COMPILE__
#pragma unroll
#endif
        for (int r = 0; r < 8; ++r) v[r] = a[pb + r];
        dft8(v);
        if (F) {
#ifdef __HIP_DEVICE_COMPILE__
#pragma unroll
#endif
            for (int r = 0; r < 8; ++r) v[r] = cconj(cmul(v[r], F[base + r]));
            dft8(v);
#ifdef __HIP_DEVICE_COMPILE__
#pragma unroll
#endif
            for (int r = 0; r < 8; ++r) a[pb + r] = v[r];
        } else {
#ifdef __HIP_DEVICE_COMPILE__
#pragma unroll
#endif
            for (int r = 0; r < 8; ++r) { cf o; o.x = v[r].x * fscale; o.y = v[r].y * fscale; Fout[base + r] = o; }
        }
    }
}
template <class LP> FC_HD void inv_pass8(int tid, LP a, const cf* TWM, int s, int lgs) {
#pragma unroll 1
    for (int h = 0; h < 2; ++h) {
        FC_OPAQUE(tid);
        const int bf = tid + 512 * h, j = bf & (s - 1), base = (bf >> lgs) * 8 * s;
        const int pb = FC_PIDX(base + j), ps = (s == 64) ? 72 : 8;
        cf v[8]; const cf w1 = TWM[j * (FC_M / (8 * s))]; cf cur = w1;
        v[0] = a[FC_PIDX(base + j)];
#ifdef __HIP_DEVICE_COMPILE__
#pragma unroll
#endif
        for (int q = 1; q < 8; ++q) { v[q] = cmul(a[pb + ps * q], cur); cur = cmul(cur, w1); }
        dft8(v);
#ifdef __HIP_DEVICE_COMPILE__
#pragma unroll
#endif
        for (int r = 0; r < 8; ++r) a[pb + ps * r] = v[r];
    }
}
template <class LP> FC_HD void inv_pass1(cf* v, int tid, LP a, const cf* TWM) {
    FC_OPAQUE(tid);
    const cf w1 = TWM[tid]; cf cur = w1;
    const int pt = FC_PIDX(tid);
    v[0] = a[pt];
#ifdef __HIP_DEVICE_COMPILE__
#pragma unroll
#endif
    for (int q = 1; q < 16; ++q) { v[q] = cmul(a[pt + 576 * q], cur); cur = cmul(cur, w1); }
    dft16(v);
}

#define XB_TMO      128
#define XB_XCNT(j)  (256  + 64 * (j))
#define XB_XSUB(j)  (1280 + 64 * (j))
#define XB_XGEN(j)  (2304 + 64 * (j))
#define XB_TOP      3328
#define XB_TOPGEN   3392
#define XCD_BAR_WORDS 3456
#define XB_SPIN_CAP (1u << 18)
__device__ __forceinline__ unsigned xb_ld(unsigned* p)              { return __hip_atomic_load(p, __ATOMIC_RELAXED, __HIP_MEMORY_SCOPE_AGENT); }
__device__ __forceinline__ unsigned xb_add(unsigned* p, unsigned v) { return __hip_atomic_fetch_add(p, v, __ATOMIC_RELAXED, __HIP_MEMORY_SCOPE_AGENT); }
__device__ __forceinline__ unsigned xb_xcc_id() { return (unsigned)__builtin_amdgcn_s_getreg((3 << 11) | 20) & 0xFu; }
#define XB_SPIN(cond, bar) do { unsigned _sp = 0; while (cond) { __builtin_amdgcn_s_sleep(1); \
    if ((++_sp & 255u) == 0u) { if (xb_ld(&(bar)[XB_TMO])) break; if (_sp > XB_SPIN_CAP) { atomicAdd(&(bar)[XB_TMO], 1u); break; } } } } while (0)
struct XcdBarrier { unsigned* bar; unsigned x; volatile LAS unsigned* st; };
__device__ __forceinline__ XcdBarrier xcd_barrier_post(unsigned* bar, volatile LAS unsigned* st) {
    XcdBarrier b; b.bar = bar; b.x = xb_xcc_id(); b.st = st;
    if (threadIdx.x == 0) (void)xb_add(&bar[XB_XCNT(b.x)], 1u);
    return b;
}
__device__ __forceinline__ void xcd_barrier_complete(unsigned* bar, unsigned x, unsigned& nloc, unsigned& nx) {
    const unsigned G = gridDim.x * gridDim.y * gridDim.z;
    unsigned sum, cnt, mine, sp = 0u;
    for (;;) {
        sum = 0u; cnt = 0u; mine = 0u;
#pragma unroll
        for (unsigned j = 0; j < 16; ++j) { const unsigned c = xb_ld(&bar[XB_XCNT(j)]); sum += c; cnt += (c > 0u) ? 1u : 0u; mine = (j == x) ? c : mine; }
        if (sum == G) break;
        __builtin_amdgcn_s_sleep(1);
        if ((++sp & 255u) == 0u) { if (xb_ld(&bar[XB_TMO])) break; if (sp > XB_SPIN_CAP) { atomicAdd(&bar[XB_TMO], 1u); break; } }
    }
    nloc = mine > 0u ? mine : 1u; nx = cnt > 0u ? cnt : 1u;
}
__device__ __forceinline__ void xcd_barrier(const XcdBarrier& b) {
    asm volatile("s_waitcnt vmcnt(0)" ::: "memory");
    __syncthreads();
    if (threadIdx.x == 0) {
        unsigned* bar = b.bar;
        __builtin_amdgcn_s_waitcnt(0);
        unsigned nloc = b.st[0], nx = b.st[1];
        if (nloc == 0u) { xcd_barrier_complete(bar, b.x, nloc, nx); b.st[0] = nloc; b.st[1] = nx; }
        const unsigned old = xb_add(&bar[XB_XSUB(b.x)], 1u);
        const unsigned gen = old / nloc;
        if (old + 1u == (gen + 1u) * nloc) {
            __builtin_amdgcn_fence(__ATOMIC_RELEASE, "agent");
            asm volatile("s_waitcnt vmcnt(0)" ::: "memory");
            const unsigned og = xb_add(&bar[XB_TOP], 1u);
            const unsigned tg = og / nx;
            if (og + 1u == (tg + 1u) * nx) xb_add(&bar[XB_TOPGEN], 1u);
            else XB_SPIN(xb_ld(&bar[XB_TOPGEN]) == tg, bar);
            __builtin_amdgcn_fence(__ATOMIC_ACQUIRE, "agent");
            xb_add(&bar[XB_XGEN(b.x)], 1u);
            asm volatile("s_waitcnt vmcnt(0)" ::: "memory");
        } else {
            XB_SPIN(xb_ld(&bar[XB_XGEN(b.x)]) == gen, bar);
            __builtin_amdgcn_fence(__ATOMIC_ACQUIRE, "agent");
            asm volatile("s_waitcnt vmcnt(0)" ::: "memory");
        }
    }
    __syncthreads();
}

struct Args { const float* in[40]; float* out; unsigned char* ws; int ph_lo, ph_hi, repmask, pad; };
struct Frame {
    LAS unsigned char* lds;
    int tid, lane, wave, vcu, G;
    const float* const* in; float* out; unsigned char* ws;
};
__device__ __forceinline__ float wave_sum(float v) {
#pragma unroll
    for (int o = 1; o < 64; o <<= 1) v += __shfl_xor(v, o);
    return v;
}
__device__ __forceinline__ float silu_f(float x) { return x / (1.f + __expf(-x)); }

__device__ __forceinline__ float gelu_f(float v) { return 0.5f * v * (1.f + erff(v * 0.70710678118654752f)); }

__device__ __forceinline__ void transpose_item(const float* W, int K, int N, bf16* WT, int src_col0, int dst_row0, int k0, LAS float* scr, int lane) {
#pragma unroll 8
    for (int i = 0; i < 32; ++i) { const int kk = 2 * i + (lane >> 5); scr[kk * 33 + (lane & 31)] = W[(size_t)(k0 + kk) * N + src_col0 + (lane & 31)]; }
    LDS_WAIT(); asm volatile("" ::: "memory");
    const int c = lane & 7;
#pragma unroll
    for (int j = 0; j < 4; ++j) { const int n = (lane >> 3) + 8 * j; const LAS float* s = scr + (8 * c) * 33 + n;
        v4u o; o.x = pk2(s[0 * 33], s[1 * 33]); o.y = pk2(s[2 * 33], s[3 * 33]); o.z = pk2(s[4 * 33], s[5 * 33]); o.w = pk2(s[6 * 33], s[7 * 33]);
        *(GAS v4u*)(WT + (size_t)(dst_row0 + n) * K + k0 + 8 * c) = o; }
    LDS_WAIT(); asm volatile("" ::: "memory");
}
__device__ __forceinline__ int qkv_slot_to_col(int slot) {
    const int part = slot >> 10, cc = slot & 1023, pnl = cc >> 8, s = cc & 255, bj = s >> 7, wc = (s & 127) >> 5, j = s & 31;
    return part * 1024 + (4 * pnl + wc) * 64 + 32 * bj + j;
}
__device__ __forceinline__ int up_slot_to_col(int slot) { const int pn = slot >> 8, bj = (slot >> 7) & 1, cc = slot & 127; return bj * FF + pn * 128 + cc; }
__device__ __forceinline__ void cvt_weight_item(const float* W, int K, int N, bf16* WT, int item, LAS float* scr, int lane, int perm) {
    const int nblk = N / 32, kb = item / nblk, nb = item % nblk;
    const int dst = 32 * nb, src = perm == 1 ? qkv_slot_to_col(dst) : (perm == 2 ? up_slot_to_col(dst) : dst);
    transpose_item(W, K, N, WT, src, dst, 64 * kb, scr, lane);
}

template <int R, class VF>
__device__ __forceinline__ void gemv_det_item(const float* W, int N, int n0, float* out, int ostride, const float* addbias, const VF& vf, int tid, LAS float* scr) {
    const int col = tid & 63, ks = tid >> 6;
    float acc[R];
#pragma unroll
    for (int r = 0; r < R; ++r) acc[r] = 0.f;
    const float* wp = W + (size_t)(ks * 128) * N + n0 + col;
#pragma unroll 8
    for (int k = 0; k < 128; ++k) { const float w = wp[(size_t)k * N];
#pragma unroll
        for (int r = 0; r < R; ++r) acc[r] += vf(r, ks * 128 + k) * w; }
    __syncthreads();
#pragma unroll
    for (int r = 0; r < R; ++r) scr[(ks * R + r) * 64 + col] = acc[r];
    __syncthreads();
    if (tid < R * 64) { const int r = tid >> 6; float s = 0.f;
#pragma unroll
        for (int k2 = 0; k2 < 8; ++k2) s += scr[(k2 * R + r) * 64 + col];
        if (addbias) s += addbias[n0 + col];
        out[(size_t)r * ostride + n0 + col] = s; }
}

__device__ __forceinline__ void phase0a(Frame& F) {
    const float* const* in = F.in;
    float* mods = (float*)(F.ws + CT_MODS);
    {
        const float* c = in[1]; const float* cctx = in[3];
        auto vf = [&](int r, int k) -> float { const float v = (r < 4) ? c[r * DM + k] : cctx[k]; return silu_f(v); };
        const int nitems = 2 * 96;
        for (int it = F.vcu; it < nitems; it += F.G) {
            const int l = it / 96, cg = it % 96;
            gemv_det_item<5>(in[l ? 17 : 4], 6144, cg * 64, mods + l * 5 * 6144, 6144, in[l ? 18 : 5], vf, F.tid, (LAS float*)F.lds);
        }
        __syncthreads();
    }
    for (int e = F.vcu * 512 + F.tid; e < 16384; e += F.G * 512) {
        const int k = e & 8191; const bool isn = e >= 8192;
        float sn, cs; sincospif(isn ? (float)k * (1.0f / 8192.0f) : (float)k * (1.0f / 4096.0f), &sn, &cs);
        cf t; t.x = cs; t.y = -sn;
        ((cf*)(F.ws + (isn ? SM_TWN : SM_TWM)))[k] = t;
    }
    LAS float* scr = (LAS float*)(F.lds + F.wave * 16384);
    const int gw = F.vcu * NWAVES + F.wave, NGW = F.G * NWAVES;
    constexpr int I_QKV = 16 * 96, I_O = 16 * 32, I_UP = 16 * 176, I_DN = 44 * 32;
    constexpr int NITEMS = 2 * I_QKV + 2 * I_O + 2 * I_UP + 2 * I_DN;
    for (int it = gw; it < NITEMS; it += NGW) {
        int r = it;
        if (r < I_QKV) { cvt_weight_item(in[8], DM, 3 * DM, (bf16*)(F.ws + WS_WQKV), r, scr, F.lane, 1); continue; } r -= I_QKV;
        if (r < I_O) { cvt_weight_item(in[12], DM, DM, (bf16*)(F.ws + WS_WO), r, scr, F.lane, 0); continue; } r -= I_O;
        if (r < I_UP) { cvt_weight_item(in[13], DM, 2 * FF, (bf16*)(F.ws + WS_WUP0), r, scr, F.lane, 2); continue; } r -= I_UP;
        if (r < I_DN) { cvt_weight_item(in[16], FF, DM, (bf16*)(F.ws + WS_WDN0), r, scr, F.lane, 0); continue; } r -= I_DN;
        if (r < I_QKV) { cvt_weight_item(in[21], DM, 3 * DM, (bf16*)(F.ws + WS_WIN), r, scr, F.lane, 0); continue; } r -= I_QKV;
        if (r < I_O) { cvt_weight_item(in[34], DM, DM, (bf16*)(F.ws + WS_WOUT), r, scr, F.lane, 0); continue; } r -= I_O;
        if (r < I_UP) { cvt_weight_item(in[36], DM, 2 * FF, (bf16*)(F.ws + WS_WUP1), r, scr, F.lane, 2); continue; } r -= I_UP;
        cvt_weight_item(in[39], FF, DM, (bf16*)(F.ws + WS_WDN1), r, scr, F.lane, 0);
    }
}

__device__ __forceinline__ void row_prescale(const float* xrow, const float* gain, const float* sc, bf16* orow, float* ssq_out, int lane) {
    const GAS f32x4* xr = (const GAS f32x4*)xrow + lane;
    const GAS f32x4* gr = (const GAS f32x4*)gain + lane;
    const GAS f32x4* sr = (const GAS f32x4*)sc + lane;
    f32x4 v[4]; float s = 0.f;
#pragma unroll
    for (int j = 0; j < 4; ++j) { v[j] = xr[64 * j]; s += (v[j].x * v[j].x + v[j].y * v[j].y) + (v[j].z * v[j].z + v[j].w * v[j].w); }
    s = wave_sum(s);
    if (lane == 0) *ssq_out = s;
    GAS unsigned long long* o8 = (GAS unsigned long long*)orow + lane;
#pragma unroll
    for (int j = 0; j < 4; ++j) { const f32x4 g = gr[64 * j], c = sr[64 * j]; const f32x4 w = v[j] * g * (c + 1.0f);
        o8[64 * j] = (unsigned long long)pk2(w.x, w.y) | ((unsigned long long)pk2(w.z, w.w) << 32); }
}
__device__ __forceinline__ void phase0b(Frame& F) {
    const float* const* in = F.in;
    const float* mods = (const float*)(F.ws + CT_MODS);
    const int gw = F.vcu * NWAVES + F.wave, NGW = F.G * NWAVES;
    for (int m = gw; m < TT + TC; m += NGW) {
        if (m < TT) { const int b = m / SEQ; row_prescale(in[0] + (size_t)m * DM, in[6], mods + b * 6144 + 1024, (bf16*)(F.ws + WS_XS) + (size_t)m * DM, (float*)(F.ws + SM_SSQ0) + m, F.lane); }
        else { const int mc = m - TT; row_prescale(in[2] + (size_t)mc * DM, in[6], mods + 4 * 6144 + 1024, (bf16*)(F.ws + WS_XSC) + (size_t)mc * DM, (float*)(F.ws + SM_SSQC) + mc, F.lane); }
    }
    {
        float* gn = (float*)(F.ws + SM_GN);
        for (int e = F.vcu * 512 + F.tid; e < 3 * 4 * 1024; e += F.G * 512) {
            const int i = e / 4096, b = (e / 1024) & 3, k = e & 1023;
            const float* g = in[i == 0 ? 7 : (i == 1 ? 19 : 20)];
            const float sc = mods[(i == 0 ? 0 : 1) * 5 * 6144 + b * 6144 + (i == 1 ? 1024 : 4096) + k];
            gn[e] = g[k] * (1.f + sc);
        }
    }
    {
        const int n_qkv = 48, n_up = 88, n_in = 48;
        const int nitems = n_qkv + n_up + n_in + n_up;
        LAS float* gs = (LAS float*)F.lds;
        for (int it0 = F.vcu; it0 < nitems; it0 += F.G) {
            int it = it0;
            if (it < n_qkv) { auto vf = [&](int r, int k) -> float { return mods[r * 6144 + k]; };
                gemv_det_item<5>(in[8], 3072, it * 64, (float*)(F.ws + CT_BQKV), 3072, nullptr, vf, F.tid, gs); continue; } it -= n_qkv;
            if (it < n_up) { auto vf = [&](int r, int k) -> float { return mods[r * 6144 + 3072 + k]; };
                gemv_det_item<4>(in[13], 5632, it * 64, (float*)(F.ws + CT_BUP0), 5632, nullptr, vf, F.tid, gs); continue; } it -= n_up;
            if (it < n_in) { auto vf = [&](int r, int k) -> float { return mods[5 * 6144 + r * 6144 + k]; };
                gemv_det_item<4>(in[21], 3072, it * 64, (float*)(F.ws + CT_BIN), 3072, in[22], vf, F.tid, gs); continue; } it -= n_in;
            { auto vf = [&](int r, int k) -> float { return mods[5 * 6144 + r * 6144 + 3072 + k]; };
                gemv_det_item<4>(in[36], 5632, it * 64, (float*)(F.ws + CT_BUP1), 5632, nullptr, vf, F.tid, gs); }
        }
        __syncthreads();
    }
}

using pg8::f32x4; using pg8::Unit;
__device__ __forceinline__ float row_rs(const float* ssq, int np, int row) {
    float s = 0.f;
    for (int i = 0; i < np; ++i) s += ssq[(size_t)i * TT + row];
    return 1.0f / sqrtf(s * (1.0f / 1024.0f) + EPS);
}
constexpr float QSCALE = 0.125f * 1.4426950408889634f;
struct EpiQK {
    static constexpr bool PERM = true;
    bf16* obase; size_t pstride; const float* ssq; int np; const float* bias; int bias_bstride; const float *qg, *kg; int pn_off; int seqlen;
    __device__ __forceinline__ void operator()(const f32x4 (&acc)[2][2][4][2], const Unit& u, int wr, int wc, int fr, int fq) const {
        const int png = u.pn + pn_off, part = png >> 2, pnl = png & 3, head = 4 * pnl + wc;
        const int b = (u.pm * 256) / seqlen;
        const float* bp = bias + (size_t)b * bias_bstride + part * 1024 + head * 64 + 8 * fq;
        bf16* dst = obase + (size_t)part * pstride;
        const float* gp = (part == 0 ? qg : kg) + 8 * fq;
        const float osc = part == 0 ? QSCALE : 1.0f;
        f32x4 bv[2][2], gv[2][2];
#pragma unroll
        for (int bj = 0; bj < 2; ++bj)
#pragma unroll
            for (int n = 0; n < 2; ++n) { bv[bj][n] = *(const f32x4*)(bp + 32 * bj + 4 * n); gv[bj][n] = *(const f32x4*)(gp + 32 * bj + 4 * n) * osc; }
#pragma unroll
        for (int ai = 0; ai < 2; ++ai)
#pragma unroll
            for (int m = 0; m < 4; ++m) {
                const int row = u.pm * 256 + ai * 128 + wr * 64 + m * 16 + fr;
                const float rs = row_rs(ssq, np, row);
                f32x4 v[2][2]; float ss = 0.f;
#pragma unroll
                for (int bj = 0; bj < 2; ++bj)
#pragma unroll
                    for (int n = 0; n < 2; ++n) { v[bj][n] = acc[ai][bj][m][n] * rs + bv[bj][n]; const f32x4 t = v[bj][n]; ss += (t.x * t.x + t.y * t.y) + (t.z * t.z + t.w * t.w); }
                ss += __shfl_xor(ss, 16); ss += __shfl_xor(ss, 32);
                const float rn = 1.0f / sqrtf(ss * (1.0f / 64.0f) + EPS);
                bf16* rowp = dst + (size_t)row * DM + head * 64 + 8 * fq;
#pragma unroll
                for (int bj = 0; bj < 2; ++bj) { const f32x4 a0 = v[bj][0] * rn * gv[bj][0], a1 = v[bj][1] * rn * gv[bj][1];
                    v4u w; w.x = pk2(a0.x, a0.y); w.y = pk2(a0.z, a0.w); w.z = pk2(a1.x, a1.y); w.w = pk2(a1.z, a1.w);
                    *(v4u*)(rowp + 32 * bj) = w; }
            }
    }
};
struct EpiVT {
    static constexpr bool PERM = true;
    bf16* VTp; const float* ssq; int np; const float* bias; int bias_bstride; int seqlen;
    __device__ __forceinline__ void operator()(const f32x4 (&acc)[2][2][4][2], const Unit& u, int wr, int wc, int fr, int fq) const {
        const int head = 4 * u.pn + wc;
        const int b = (u.pm * 256) / seqlen;
        const float* bp = bias + (size_t)b * bias_bstride + 2048 + head * 64 + 8 * fq;
        const int odd = fr & 1;
        f32x4 bv[2][2];
#pragma unroll
        for (int bj = 0; bj < 2; ++bj)
#pragma unroll
            for (int n = 0; n < 2; ++n) bv[bj][n] = *(const f32x4*)(bp + 32 * bj + 4 * n);
#pragma unroll
        for (int ai = 0; ai < 2; ++ai)
#pragma unroll
            for (int m = 0; m < 4; ++m) {
                const int row = u.pm * 256 + ai * 128 + wr * 64 + m * 16 + fr;
                const float rs = row_rs(ssq, np, row);
                const int tl = row - b * seqlen;
                bf16* vb = VTp + ((size_t)(b * NH + head) * 64 + 8 * fq + odd) * seqlen + (tl & ~1);
#pragma unroll
                for (int bj = 0; bj < 2; ++bj)
#pragma unroll
                    for (int n = 0; n < 2; ++n) {
                        const f32x4 v = acc[ai][bj][m][n] * rs + bv[bj][n];
                        const unsigned w01 = pk2(v.x, v.y), w23 = pk2(v.z, v.w);
                        const unsigned p01 = (unsigned)__shfl_xor((int)w01, 1), p23 = (unsigned)__shfl_xor((int)w23, 1);
                        const unsigned o0 = odd ? ((w01 & 0xffff0000u) | (p01 >> 16)) : ((p01 << 16) | (w01 & 0xffffu));
                        const unsigned o1 = odd ? ((w23 & 0xffff0000u) | (p23 >> 16)) : ((p23 << 16) | (w23 & 0xffffu));
                        bf16* p = vb + (size_t)(32 * bj + 4 * n) * seqlen;
                        *(unsigned*)p = o0; *(unsigned*)(p + 2 * (size_t)seqlen) = o1;
                    }
            }
    }
};
struct EpiRes {
    static constexpr bool PERM = true;
    const float* base; float* out; const float* gate; const float* bias; const float* gn; bf16* xs; float* ssq; float* hs;
    __device__ __forceinline__ void operator()(const f32x4 (&acc)[2][2][4][2], const Unit& u, int wr, int wc, int fr, int fq) const {
        const int b = (u.pm * 256) / SEQ;
        const int col0 = u.pn * 256 + wc * 32 + 8 * fq;
        f32x4 gt[2][2], bv[2][2], gv[2][2];
#pragma unroll
        for (int bj = 0; bj < 2; ++bj)
#pragma unroll
            for (int n = 0; n < 2; ++n) { const int c = col0 + 128 * bj + 4 * n; gt[bj][n] = *(const f32x4*)(gate + (size_t)b * 6144 + c);
                bv[bj][n] = bias ? *(const f32x4*)(bias + c) : (f32x4){0.f, 0.f, 0.f, 0.f};
                gv[bj][n] = gn ? *(const f32x4*)(gn + (size_t)b * 1024 + c) : (f32x4){0.f, 0.f, 0.f, 0.f}; }
#pragma unroll
        for (int ai = 0; ai < 2; ++ai)
#pragma unroll
            for (int m = 0; m < 4; ++m) {
                const int row = u.pm * 256 + ai * 128 + wr * 64 + m * 16 + fr;
                const size_t off = (size_t)row * DM + col0;
                float ss = 0.f;
#pragma unroll
                for (int bj = 0; bj < 2; ++bj) {
                    f32x4 xn[2];
#pragma unroll
                    for (int n = 0; n < 2; ++n) { const f32x4 bs = *(const f32x4*)(base + off + 128 * bj + 4 * n);
                        xn[n] = bs + gt[bj][n] * (acc[ai][bj][m][n] + bv[bj][n]);
                        *(f32x4*)(out + off + 128 * bj + 4 * n) = xn[n];
                        ss += (xn[n].x * xn[n].x + xn[n].y * xn[n].y) + (xn[n].z * xn[n].z + xn[n].w * xn[n].w); }
                    if (xs) { const f32x4 a0 = xn[0] * gv[bj][0], a1 = xn[1] * gv[bj][1];
                        v4u w; w.x = pk2(a0.x, a0.y); w.y = pk2(a0.z, a0.w); w.z = pk2(a1.x, a1.y); w.w = pk2(a1.z, a1.w);
                        *(v4u*)(xs + off + 128 * bj) = w; }
                }
                if (ssq) { ss += __shfl_xor(ss, 16); ss += __shfl_xor(ss, 32); if (fq == 0) hs[(ai * 128 + wr * 64 + m * 16 + fr) * 4 + wc] = ss; }
                asm volatile("" ::: "memory");
            }
        if (ssq) {
            asm volatile("s_waitcnt lgkmcnt(0)" ::: "memory"); __builtin_amdgcn_s_barrier(); asm volatile("" ::: "memory");
            const int tid = threadIdx.x;
            if (tid < 256) { const f32x4 p = *(const f32x4*)(hs + tid * 4); ssq[(size_t)u.pn * TT + u.pm * 256 + tid] = ((p.x + p.y) + p.z) + p.w; }
        }
    }
};
struct EpiScaleBias {
    static constexpr bool PERM = true;
    bf16* O; int ldc; const float* ssq; int np; const float* bias; int bias_bstride;
    __device__ __forceinline__ void operator()(const f32x4 (&acc)[2][2][4][2], const Unit& u, int wr, int wc, int fr, int fq) const {
        const int b = (u.pm * 256) / SEQ;
        const int col0 = u.pn * 256 + wc * 32 + 8 * fq;
        f32x4 bv[2][2];
#pragma unroll
        for (int bj = 0; bj < 2; ++bj)
#pragma unroll
            for (int n = 0; n < 2; ++n) bv[bj][n] = *(const f32x4*)(bias + (size_t)b * bias_bstride + col0 + 128 * bj + 4 * n);
#pragma unroll
        for (int ai = 0; ai < 2; ++ai)
#pragma unroll
            for (int m = 0; m < 4; ++m) {
                const int row = u.pm * 256 + ai * 128 + wr * 64 + m * 16 + fr;
                const float rs = row_rs(ssq, np, row);
                bf16* rowp = O + (size_t)row * ldc + col0;
#pragma unroll
                for (int bj = 0; bj < 2; ++bj) { const f32x4 v0 = acc[ai][bj][m][0] * rs + bv[bj][0], v1 = acc[ai][bj][m][1] * rs + bv[bj][1];
                    v4u w; w.x = pk2(v0.x, v0.y); w.y = pk2(v0.z, v0.w); w.z = pk2(v1.x, v1.y); w.w = pk2(v1.z, v1.w);
                    *(v4u*)(rowp + 128 * bj) = w; }
            }
    }
};
__device__ __forceinline__ float gelu_as(float v) {
    const float av = fabsf(v), t = __builtin_amdgcn_rcpf(av * 0.2316418882f + 1.0f);
    float q = t * 0.5307027145f + (-0.7265760135f); q = q * t + 0.7107068705f; q = q * t + (-0.142248368f); q = q * t + 0.127414796f; q = q * t;
    const float e = __builtin_amdgcn_exp2f((v * v) * (-0.72134752044f));
    const float m = v * (q * e);
    return v < 0.f ? m : v - m;
}
template <int CTRL> __device__ __forceinline__ float dpp_f(float old, float src) {
    return __builtin_bit_cast(float, __builtin_amdgcn_update_dpp(__builtin_bit_cast(int, old), __builtin_bit_cast(int, src), CTRL, 0xf, 0xf, false));
}
struct EpiUpGlu {
    static constexpr bool PERM = true;
    bf16* act; const float* ssq; int np; const float* bias; const float* cw; const float* cb; float* Hg; float* Ha; float* hl;
    __device__ __forceinline__ void operator()(f32x4 (&acc)[2][2][4][2], const Unit& u, int wr, int wc, int fr, int fq) const {
        const int b = (u.pm * 256) / SEQ;
        const int j0 = u.pn * 128 + wc * 32 + 8 * fq;
        {
            f32x4 ba[2], bg[2];
#pragma unroll
            for (int n = 0; n < 2; ++n) { ba[n] = *(const f32x4*)(bias + (size_t)b * 5632 + j0 + 4 * n); bg[n] = *(const f32x4*)(bias + (size_t)b * 5632 + FF + j0 + 4 * n); }
#pragma unroll
            for (int ai = 0; ai < 2; ++ai)
#pragma unroll
                for (int m = 0; m < 4; ++m) { const int row = u.pm * 256 + ai * 128 + wr * 64 + m * 16 + fr; const float rs = row_rs(ssq, np, row);
#pragma unroll
                    for (int n = 0; n < 2; ++n) { acc[ai][0][m][n] = acc[ai][0][m][n] * rs + ba[n]; acc[ai][1][m][n] = acc[ai][1][m][n] * rs + bg[n]; }
                    if (m == 3) asm volatile("" ::: "memory"); }
        }
#pragma unroll
        for (int ai = 0; ai < 2; ++ai) { float* hp = hl + ((2 * ai + wr) * 2) * 128 + wc * 32 + 8 * fq;
            if (fr == 0) { *(f32x4*)(hp) = acc[ai][1][0][0]; *(f32x4*)(hp + 4) = acc[ai][1][0][1]; }
            if (fr == 15) { *(f32x4*)(hp + 128) = acc[ai][1][3][0]; *(f32x4*)(hp + 132) = acc[ai][1][3][1]; } }
        asm volatile("s_waitcnt lgkmcnt(0)" ::: "memory"); __builtin_amdgcn_s_barrier(); asm volatile("" ::: "memory");
        if (wr == 0 && fr < 2) { float* p = Hg + ((size_t)u.pm * 4 + fr) * FF + j0; *(f32x4*)p = acc[0][1][0][0]; *(f32x4*)(p + 4) = acc[0][1][0][1];
            if (fr == 0) { float* q = Ha + ((size_t)u.pm * 2) * FF + j0; *(f32x4*)q = acc[0][0][0][0]; *(f32x4*)(q + 4) = acc[0][0][0][1]; } }
        if (wr == 1 && fr >= 14) { float* p = Hg + ((size_t)u.pm * 4 + 2 + (fr - 14)) * FF + j0; *(f32x4*)p = acc[1][1][3][0]; *(f32x4*)(p + 4) = acc[1][1][3][1];
            if (fr == 15) { float* q = Ha + ((size_t)u.pm * 2 + 1) * FF + j0; *(f32x4*)q = acc[1][0][3][0]; *(f32x4*)(q + 4) = acc[1][0][3][1]; } }
#pragma unroll
        for (int n = 0; n < 2; ++n) {
            const f32x4 w0 = *(const f32x4*)(cw + j0 + 4 * n), w1 = *(const f32x4*)(cw + FF + j0 + 4 * n), w2 = *(const f32x4*)(cw + 2 * FF + j0 + 4 * n), cbv = *(const f32x4*)(cb + j0 + 4 * n);
#pragma unroll
            for (int ai = 0; ai < 2; ++ai) {
                const int gi = 2 * ai + wr;
                const f32x4 uph = *(const f32x4*)(hl + (((gi + 3) & 3) * 2 + 1) * 128 + wc * 32 + 8 * fq + 4 * n);
                const f32x4 dnh = *(const f32x4*)(hl + (((gi + 1) & 3) * 2) * 128 + wc * 32 + 8 * fq + 4 * n);
#pragma unroll
                for (int m = 0; m < 4; ++m) {
                    const int rowl = ai * 128 + wr * 64 + m * 16 + fr;
                    f32x4 r;
#pragma unroll
                    for (int e = 0; e < 4; ++e) {
                        const float g = acc[ai][1][m][n][e];
                        const float pu = (m > 0) ? dpp_f<0x121>(g, acc[ai][1][m > 0 ? m - 1 : 0][n][e]) : uph[e];
                        const float up = dpp_f<0x111>(pu, g);
                        const float pd = (m < 3) ? dpp_f<0x12f>(g, acc[ai][1][m < 3 ? m + 1 : 3][n][e]) : dnh[e];
                        const float dn = dpp_f<0x101>(pd, g);
                        const float cv = w0[e] * up + w1[e] * g + w2[e] * dn + cbv[e];
                        r[e] = acc[ai][0][m][n][e] * gelu_as(cv);
                    }
                    if (rowl != 0 && rowl != 255) { v2u w; w.x = pk2(r.x, r.y); w.y = pk2(r.z, r.w); *(v2u*)(act + (size_t)(u.pm * 256 + rowl) * FF + j0 + 4 * n) = w; }
                }
            }
        }
        asm volatile("s_waitcnt lgkmcnt(0)" ::: "memory"); __builtin_amdgcn_s_barrier(); asm volatile("" ::: "memory");
    }
};
__device__ __forceinline__ void glu_fix_phase(Frame& F, const float* cw, const float* cb) {
    const float* Hg = (const float*)(F.ws + WS_HG); const float* Ha = (const float*)(F.ws + WS_HA); bf16* act = (bf16*)(F.ws + WS_AG);
    const int total = (TT / 256) * 2 * FF;
    for (int e = F.vcu * 512 + F.tid; e < total; e += F.G * 512) {
        const int j = e % FF, which = (e / FF) & 1, pm = e / (2 * FF);
        const int t = pm * 256 + (which ? 255 : 0), tl = t % SEQ;
        float gm, g0, gp;
        if (which == 0) { gm = (tl == 0) ? 0.f : Hg[((size_t)(pm - 1) * 4 + 3) * FF + j]; g0 = Hg[((size_t)pm * 4 + 0) * FF + j]; gp = Hg[((size_t)pm * 4 + 1) * FF + j]; }
        else { gm = Hg[((size_t)pm * 4 + 2) * FF + j]; g0 = Hg[((size_t)pm * 4 + 3) * FF + j]; gp = (tl == SEQ - 1) ? 0.f : Hg[((size_t)(pm + 1) * 4 + 0) * FF + j]; }
        const float a = Ha[((size_t)pm * 2 + which) * FF + j];
        const float cv = cw[j] * gm + cw[FF + j] * g0 + cw[2 * FF + j] * gp + cb[j];
        act[(size_t)t * FF + j] = (bf16)f2bf(a * gelu_as(cv));
    }
}
struct EpiInT {
    static constexpr bool PERM = true;
    bf16* UT; const float* ssq; int np; const float* bias;
    __device__ __forceinline__ void operator()(const f32x4 (&acc)[2][2][4][2], const Unit& u, int wr, int wc, int fr, int fq) const {
        const int b = (u.pm * 256) / SEQ;
        const int col0 = u.pn * 256 + wc * 32 + 8 * fq;
        const int odd = fr & 1;
        f32x4 bv[2][2];
#pragma unroll
        for (int bj = 0; bj < 2; ++bj)
#pragma unroll
            for (int n = 0; n < 2; ++n) bv[bj][n] = *(const f32x4*)(bias + (size_t)b * 3072 + col0 + 128 * bj + 4 * n);
#pragma unroll
        for (int ai = 0; ai < 2; ++ai)
#pragma unroll
            for (int m = 0; m < 4; ++m) {
                const int row = u.pm * 256 + ai * 128 + wr * 64 + m * 16 + fr;
                const int t = row - b * SEQ;
                const float rs = row_rs(ssq, np, row);
#pragma unroll
                for (int bj = 0; bj < 2; ++bj)
#pragma unroll
                    for (int n = 0; n < 2; ++n) { const f32x4 v = acc[ai][bj][m][n] * rs + bv[bj][n];
                        const unsigned w01 = pk2(v.x, v.y), w23 = pk2(v.z, v.w);
                        const unsigned p01 = (unsigned)__shfl_xor((int)w01, 1), p23 = (unsigned)__shfl_xor((int)w23, 1);
                        const unsigned o0 = odd ? ((w01 & 0xffff0000u) | (p01 >> 16)) : ((p01 << 16) | (w01 & 0xffffu));
                        const unsigned o1 = odd ? ((w23 & 0xffff0000u) | (p23 >> 16)) : ((p23 << 16) | (w23 & 0xffffu));
                        bf16* p = UT + ((size_t)b * 3072 + col0 + 128 * bj + 4 * n + odd) * SEQ + (t & ~1);
                        *(unsigned*)p = o0; *(unsigned*)(p + 2 * (size_t)SEQ) = o1; }
            }
    }
};

typedef short bf16x8 __attribute__((ext_vector_type(8)));
typedef float f32x16 __attribute__((ext_vector_type(16)));
typedef short s16x4 __attribute__((ext_vector_type(4)));
__device__ __forceinline__ unsigned cvtpk(float lo, float hi) { typedef float f2 __attribute__((ext_vector_type(2))); typedef __bf16 b2 __attribute__((ext_vector_type(2)));
    f2 v = {lo, hi}; b2 r = __builtin_convertvector(v, b2); return __builtin_bit_cast(unsigned, r); }
constexpr int BT_OFF = 64, BT_HEAD = 15 * 31;
__device__ __forceinline__ void attn_mfma_phase(Frame& F) {
    const bf16* Q = (const bf16*)(F.ws + WS_Q); const bf16* Kb = (const bf16*)(F.ws + WS_K); const bf16* VT = (const bf16*)(F.ws + WS_V);
    const bf16* Kc = (const bf16*)(F.ws + WS_KC); const bf16* VcT = (const bf16*)(F.ws + WS_VC);
    bf16* O = (bf16*)(F.ws + WS_O);
    const float* rpb = F.in[11];
    float* bt = (float*)F.lds;
    for (int e = F.tid; e < NH * BT_HEAD; e += 512) bt[BT_OFF + e] = rpb[e] * 1.4426950408889634f;
    __syncthreads();
    const int lane = F.lane, q = lane & 31, hi = lane >> 5;
    const int hf = F.wave & 1, roff = F.wave >> 1;
    for (int g = F.vcu; g < NB * (GROWS / 4) * NH; g += F.G) {
        const int h = g & 15, rg = (g >> 4) & 31, b = g >> 9;
        const int r = rg * 4 + roff;
        const int r0 = min(max(r - WH / 2, 0), GROWS - WH), c = 32 * hf + q, c0 = min(max(c - WW / 2, 0), GW - WW);
        const size_t tok = (size_t)b * SEQ + r * GW + c;
        bf16x8 qf[4];
#pragma unroll
        for (int s4 = 0; s4 < 4; ++s4) qf[s4] = *(const bf16x8*)(Q + tok * DM + h * HD + 16 * s4 + 8 * hi);
        f32x16 o0 = {0.f, 0.f, 0.f, 0.f, 0.f, 0.f, 0.f, 0.f, 0.f, 0.f, 0.f, 0.f, 0.f, 0.f, 0.f, 0.f}, o1 = o0;
        float lsum = 0.f;
        const int lo = c0 - c + (WW - 1);
        const bf16* vth = VT + ((size_t)(b * NH + h) * 64 + q) * SEQ;
#pragma unroll 1
        for (int rp = 0; rp < 4; ++rp) {
#pragma unroll
            for (int cbi = 0; cbi < 3; ++cbi) {
                const int cb = cbi + hf;
                const int krow = r0 + 2 * rp;
                const size_t ktok = (size_t)b * SEQ + (size_t)(krow + (q >> 4)) * GW + cb * 16 + (q & 15);
                const bf16* kp = Kb + ktok * DM + h * HD + 8 * hi;
                bf16x8 kf[4];
#pragma unroll
                for (int s4 = 0; s4 < 4; ++s4) kf[s4] = *(const bf16x8*)(kp + 16 * s4);
                s16x4 vlo[2][2], vhi[2][2];
#pragma unroll
                for (int dh = 0; dh < 2; ++dh)
#pragma unroll
                    for (int s2 = 0; s2 < 2; ++s2) { const bf16* vp = vth + (size_t)dh * 32 * SEQ + (size_t)(krow + s2) * GW + cb * 16 + 4 * hi;
                        vlo[dh][s2] = *(const s16x4*)vp; vhi[dh][s2] = *(const s16x4*)(vp + 8); }
                f32x16 sacc = {0.f, 0.f, 0.f, 0.f, 0.f, 0.f, 0.f, 0.f, 0.f, 0.f, 0.f, 0.f, 0.f, 0.f, 0.f, 0.f};
#pragma unroll
                for (int s4 = 0; s4 < 4; ++s4) sacc = __builtin_amdgcn_mfma_f32_32x32x16_bf16(kf[s4], qf[s4], sacc, 0, 0, 0);
                const int dcb = cb * 16 + 4 * hi - c + (WW - 1);
                const int dcl = dcb - lo;
                float p[16];
#pragma unroll
                for (int rr = 0; rr < 16; ++rr) {
                    const int kc = (rr & 3) + 8 * ((rr >> 2) & 1), dr = krow + (rr >> 3) - r + (WH - 1);
                    const float bias = bt[BT_OFF + h * BT_HEAD + dr * 31 + dcb + kc];
                    const float e = __builtin_amdgcn_exp2f(sacc[rr] + bias);
                    p[rr] = ((unsigned)(dcl + kc) < (unsigned)WW) ? e : 0.f;
                    lsum += p[rr];
                }
                unsigned pw[8];
#pragma unroll
                for (int i = 0; i < 8; ++i) pw[i] = cvtpk(p[2 * i], p[2 * i + 1]);
#pragma unroll
                for (int s2 = 0; s2 < 2; ++s2) {
                    const bf16x8 pb = __builtin_bit_cast(bf16x8, (v4u){pw[4 * s2], pw[4 * s2 + 1], pw[4 * s2 + 2], pw[4 * s2 + 3]});
                    const bf16x8 va0 = (bf16x8){vlo[0][s2][0], vlo[0][s2][1], vlo[0][s2][2], vlo[0][s2][3], vhi[0][s2][0], vhi[0][s2][1], vhi[0][s2][2], vhi[0][s2][3]};
                    const bf16x8 va1 = (bf16x8){vlo[1][s2][0], vlo[1][s2][1], vlo[1][s2][2], vlo[1][s2][3], vhi[1][s2][0], vhi[1][s2][1], vhi[1][s2][2], vhi[1][s2][3]};
                    o0 = __builtin_amdgcn_mfma_f32_32x32x16_bf16(va0, pb, o0, 0, 0, 0);
                    o1 = __builtin_amdgcn_mfma_f32_32x32x16_bf16(va1, pb, o1, 0, 0, 0);
                }
            }
        }
        const bf16* vcth = VcT + ((size_t)(b * NH + h) * 64 + q) * CTXL;
#pragma unroll 2
        for (int j = 0; j < 8; ++j) {
            const bf16* kp = Kc + ((size_t)b * CTXL + 32 * j + q) * DM + h * HD + 8 * hi;
            bf16x8 kf[4];
#pragma unroll
            for (int s4 = 0; s4 < 4; ++s4) kf[s4] = *(const bf16x8*)(kp + 16 * s4);
            s16x4 vlo[2][2], vhi[2][2];
#pragma unroll
            for (int dh = 0; dh < 2; ++dh)
#pragma unroll
                for (int s2 = 0; s2 < 2; ++s2) { const bf16* vp = vcth + (size_t)dh * 32 * CTXL + 32 * j + 16 * s2 + 4 * hi;
                    vlo[dh][s2] = *(const s16x4*)vp; vhi[dh][s2] = *(const s16x4*)(vp + 8); }
            f32x16 sacc = {0.f, 0.f, 0.f, 0.f, 0.f, 0.f, 0.f, 0.f, 0.f, 0.f, 0.f, 0.f, 0.f, 0.f, 0.f, 0.f};
#pragma unroll
            for (int s4 = 0; s4 < 4; ++s4) sacc = __builtin_amdgcn_mfma_f32_32x32x16_bf16(kf[s4], qf[s4], sacc, 0, 0, 0);
            float p[16];
#pragma unroll
            for (int rr = 0; rr < 16; ++rr) { p[rr] = __builtin_amdgcn_exp2f(sacc[rr]); lsum += p[rr]; }
            unsigned pw[8];
#pragma unroll
            for (int i = 0; i < 8; ++i) pw[i] = cvtpk(p[2 * i], p[2 * i + 1]);
#pragma unroll
            for (int s2 = 0; s2 < 2; ++s2) {
                const bf16x8 pb = __builtin_bit_cast(bf16x8, (v4u){pw[4 * s2], pw[4 * s2 + 1], pw[4 * s2 + 2], pw[4 * s2 + 3]});
                const bf16x8 va0 = (bf16x8){vlo[0][s2][0], vlo[0][s2][1], vlo[0][s2][2], vlo[0][s2][3], vhi[0][s2][0], vhi[0][s2][1], vhi[0][s2][2], vhi[0][s2][3]};
                const bf16x8 va1 = (bf16x8){vlo[1][s2][0], vlo[1][s2][1], vlo[1][s2][2], vlo[1][s2][3], vhi[1][s2][0], vhi[1][s2][1], vhi[1][s2][2], vhi[1][s2][3]};
                o0 = __builtin_amdgcn_mfma_f32_32x32x16_bf16(va0, pb, o0, 0, 0, 0);
                o1 = __builtin_amdgcn_mfma_f32_32x32x16_bf16(va1, pb, o1, 0, 0, 0);
            }
        }
        lsum += __shfl_xor(lsum, 32);
        const float inv = 1.0f / lsum;
        bf16* op = O + tok * DM + h * HD + 4 * hi;
#pragma unroll
        for (int gq = 0; gq < 4; ++gq) {
            v2u w0; w0.x = pk2(o0[4 * gq] * inv, o0[4 * gq + 1] * inv); w0.y = pk2(o0[4 * gq + 2] * inv, o0[4 * gq + 3] * inv);
            v2u w1; w1.x = pk2(o1[4 * gq] * inv, o1[4 * gq + 1] * inv); w1.y = pk2(o1[4 * gq + 2] * inv, o1[4 * gq + 3] * inv);
            *(v2u*)(op + 8 * gq) = w0; *(v2u*)(op + 32 + 8 * gq) = w1;
        }
    }
    __syncthreads();
}

__device__ __forceinline__ void convglu_phase(Frame& F, const float* cw, const float* cb) {
    bf16* ag = (bf16*)(F.ws + WS_AG);
    const long nvec = (long)TT * (FF / 8);
    for (long e = (long)F.vcu * 512 + F.tid; e < nvec; e += (long)F.G * 512) {
        const int t = (int)(e / (FF / 8)), j0 = (int)(e % (FF / 8)) * 8;
        const int tl = t % SEQ;
        const bf16* rowp = ag + (size_t)t * (2 * FF);
        const v4u a = *(const v4u*)(rowp + j0);
        const v4u g0 = *(const v4u*)(rowp + FF + j0);
        v4u gm = (v4u){0u, 0u, 0u, 0u}, gp = (v4u){0u, 0u, 0u, 0u};
        if (tl > 0) gm = *(const v4u*)(rowp - 2 * FF + FF + j0);
        if (tl < SEQ - 1) gp = *(const v4u*)(rowp + 2 * FF + FF + j0);
        float av[8], g0v[8], gmv[8], gpv[8];
        av[0] = bflo(a.x); av[1] = bfhi(a.x); av[2] = bflo(a.y); av[3] = bfhi(a.y); av[4] = bflo(a.z); av[5] = bfhi(a.z); av[6] = bflo(a.w); av[7] = bfhi(a.w);
        g0v[0] = bflo(g0.x); g0v[1] = bfhi(g0.x); g0v[2] = bflo(g0.y); g0v[3] = bfhi(g0.y); g0v[4] = bflo(g0.z); g0v[5] = bfhi(g0.z); g0v[6] = bflo(g0.w); g0v[7] = bfhi(g0.w);
        gmv[0] = bflo(gm.x); gmv[1] = bfhi(gm.x); gmv[2] = bflo(gm.y); gmv[3] = bfhi(gm.y); gmv[4] = bflo(gm.z); gmv[5] = bfhi(gm.z); gmv[6] = bflo(gm.w); gmv[7] = bfhi(gm.w);
        gpv[0] = bflo(gp.x); gpv[1] = bfhi(gp.x); gpv[2] = bflo(gp.y); gpv[3] = bfhi(gp.y); gpv[4] = bflo(gp.z); gpv[5] = bfhi(gp.z); gpv[6] = bflo(gp.w); gpv[7] = bfhi(gp.w);
        float r[8];
#pragma unroll
        for (int i = 0; i < 8; ++i) { const int j = j0 + i; const float cv = cw[j] * gmv[i] + cw[FF + j] * g0v[i] + cw[2 * FF + j] * gpv[i] + cb[j]; r[i] = av[i] * gelu_f(cv); }
        v4u w; w.x = pk2(r[0], r[1]); w.y = pk2(r[2], r[3]); w.z = pk2(r[4], r[5]); w.w = pk2(r[6], r[7]);
        *(v4u*)(ag + (size_t)t * (2 * FF) + j0) = w;
    }
}

__device__ __forceinline__ void filtgen_phase(Frame& F) {
    const float* const* in = F.in;
    const float *w1 = in[25], *b1 = in[26], *w2 = in[27], *b2 = in[28], *w3 = in[29], *b3 = in[30], *wout = in[31], *freq = in[32];
    float* hT = (float*)(F.ws + WS_HT); float* fsqp = (float*)(F.ws + WS_FSQP);
    LAS float* zf = (LAS float*)(F.lds);
    LAS float* ha = zf + 16 * 36;
    LAS float* hb = ha + 16 * 64;
    const int tid = F.tid;
    for (int item = F.vcu; item < SEQ / 16; item += F.G) {
        const int l0 = item * 16;
        __syncthreads();
        for (int e = tid; e < 16 * 33; e += 512) {
            const int p = e / 33, i = e % 33, l = l0 + p;
            float v;
            if (i == 0) v = (float)l / 8191.0f;
            else { const int bi = (i - 1) & 15; const float band = 1e-4f + (float)bi * ((15.0f - 1e-4f) / 15.0f);
                const float w = (float)(2.0 * 3.14159265358979323846 / 8192.0) * (float)l; const float arg = band * w;
                v = (i <= 16) ? cosf(arg) : -sinf(arg); }
            zf[p * 36 + i] = v;
        }
        __syncthreads();
        for (int e = tid; e < 16 * 64; e += 512) { const int p = e >> 6, j = e & 63; float a = b1[j];
            for (int i = 0; i < 33; ++i) a += zf[p * 36 + i] * w1[i * 64 + j];
            ha[p * 64 + j] = sinf(freq[j] * a); }
        __syncthreads();
        for (int e = tid; e < 16 * 64; e += 512) { const int p = e >> 6, j = e & 63; float a = b2[j];
            for (int i = 0; i < 64; ++i) a += ha[p * 64 + i] * w2[i * 64 + j];
            hb[p * 64 + j] = sinf(freq[j] * a); }
        __syncthreads();
        for (int e = tid; e < 16 * 64; e += 512) { const int p = e >> 6, j = e & 63; float a = b3[j];
            for (int i = 0; i < 64; ++i) a += hb[p * 64 + i] * w3[i * 64 + j];
            ha[p * 64 + j] = sinf(freq[j] * a); }
        __syncthreads();
        float sq[2] = {0.f, 0.f};
#pragma unroll
        for (int q = 0; q < 4; ++q) {
            const int n = tid + 512 * q, dir = n >> 10, c = n & 1023;
            float acc[16];
#pragma unroll
            for (int p = 0; p < 16; ++p) acc[p] = 0.f;
            for (int j = 0; j < 64; ++j) { const float w = wout[j * 2048 + n];
#pragma unroll
                for (int p = 0; p < 16; ++p) acc[p] += ha[p * 64 + j] * w; }
            const float la = -15.350567286626973f, lb = -3.0701134573253946f;
            const float delta = fabsf(la + (float)c * ((lb - la) / 1023.0f));
            float* op = hT + ((size_t)dir * 1024 + c) * SEQ + l0;
#pragma unroll
            for (int p = 0; p < 16; ++p) { const float tpos = (float)(l0 + p) / 8191.0f; const float v = acc[p] * expf(-tpos * delta); op[p] = v; sq[q & 1] += v * v; }
        }
        fsqp[(size_t)item * 1024 + tid] = sq[0]; fsqp[(size_t)item * 1024 + tid + 512] = sq[1];
    }
    __syncthreads();
}

__device__ __forceinline__ void filtfft_phase(Frame& F) {
    const float* hT = (const float*)(F.ws + WS_HT); const float* fsqp = (const float*)(F.ws + WS_FSQP);
    const cf* TWM = (const cf*)(F.ws + SM_TWM); const cf* TWN = (const cf*)(F.ws + SM_TWN);
    cf* Fsp = (cf*)(F.ws + WS_F);
    cf* a = (cf*)F.lds;
    float* red = (float*)(F.lds + 80 * 1024);
    for (int c = F.vcu; c < DM; c += F.G) {
        int tid = F.tid; FC_OPAQUE(tid);
        __syncthreads();
        red[tid] = fsqp[(size_t)tid * 1024 + c];
        __syncthreads();
        for (int st = 256; st > 0; st >>= 1) { if (tid < st) red[tid] += red[tid + st]; __syncthreads(); }
        const float nrm = 1.0f / sqrtf(red[0] + EPS);
        const float* hf = hT + (size_t)c * SEQ; const float* hb = hT + ((size_t)1024 + c) * SEQ;
#pragma unroll 1
        for (int path = 0; path < 2; ++path) {
            cf v[16];
            FC_OPAQUE(tid);
#pragma unroll
            for (int r = 0; r < 16; ++r) { const int n = tid + 512 * r; const float fa = hf[n] * nrm, fb = (n == 0) ? 0.f : hb[SEQ - n] * nrm;
                if (path == 0) { v[r].x = fa + fb; v[r].y = 0.f; } else { cf t; t.x = fa - fb; t.y = 0.f; v[r] = cmul(t, TWN[n]); }
                if ((r & 3) == 3) asm volatile("" ::: "memory"); }
            fwd_pass1(v, tid, a, TWM);
            __syncthreads();
            fwd_pass8(tid, a, TWM, 64, 6);
            __syncthreads();
            fwd_pass8(tid, a, TWM, 8, 3);
            __syncthreads();
            mid_pass(tid, a, (const cf*)nullptr, Fsp + ((size_t)c * 2 + path) * FC_M, 1.0f / 16384.0f);
            __syncthreads();
        }
    }
}

__device__ __forceinline__ void conv3_8(const v4u raw, float prev, float next, float w0, float w1, float w2, float bb, float* out) {
    float x[10]; x[0] = prev; x[9] = next;
    x[1] = bflo(raw.x); x[2] = bfhi(raw.x); x[3] = bflo(raw.y); x[4] = bfhi(raw.y); x[5] = bflo(raw.z); x[6] = bfhi(raw.z); x[7] = bflo(raw.w); x[8] = bfhi(raw.w);
#pragma unroll
    for (int i = 0; i < 8; ++i) out[i] = w0 * x[i] + w1 * x[i + 1] + w2 * x[i + 2] + bb;
}
__device__ __forceinline__ void hyena_fft_phase(Frame& F) {
    const float* const* in = F.in;
    const float* sw = in[23]; const float* sb = in[24]; const float* dbias = in[33];
    bf16* UT = (bf16*)(F.ws + WS_UT);
    const cf* TWM = (const cf*)(F.ws + SM_TWM); const cf* TWN = (const cf*)(F.ws + SM_TWN);
    const cf* Fsp = (const cf*)(F.ws + WS_F);
    cf* a = (cf*)F.lds;
    for (int unit = F.vcu; unit < 2 * DM; unit += F.G) {
        const int c = unit >> 1, b0 = (unit & 1) * 2;
        int tid = F.tid; FC_OPAQUE(tid);
        __syncthreads();
        {
            const float w10 = sw[1024 + c], w11 = sw[3072 + 1024 + c], w12 = sw[6144 + 1024 + c], bb1 = sb[1024 + c];
            const float wv0 = sw[2048 + c], wv1 = sw[3072 + 2048 + c], wv2 = sw[6144 + 2048 + c], bbv = sb[2048 + c];
#pragma unroll 1
            for (int h = 0; h < 2; ++h) {
                FC_OPAQUE(tid);
                const int t0 = (tid + 512 * h) * 8;
                float z[2][8];
#pragma unroll
                for (int bb = 0; bb < 2; ++bb) {
                    asm volatile("" ::: "memory");
                    const bf16* x1r = UT + ((size_t)(b0 + bb) * 3072 + 1024 + c) * SEQ;
                    const bf16* vr = UT + ((size_t)(b0 + bb) * 3072 + 2048 + c) * SEQ;
                    const v4u x1raw = *(const v4u*)(x1r + t0), vraw = *(const v4u*)(vr + t0);
                    const float x1p = t0 > 0 ? bf2f(x1r[t0 - 1]) : 0.f, x1n = t0 + 8 < SEQ ? bf2f(x1r[t0 + 8]) : 0.f;
                    const float vp = t0 > 0 ? bf2f(vr[t0 - 1]) : 0.f, vn = t0 + 8 < SEQ ? bf2f(vr[t0 + 8]) : 0.f;
                    float x1c[8], vc[8];
                    conv3_8(x1raw, x1p, x1n, w10, w11, w12, bb1, x1c);
                    conv3_8(vraw, vp, vn, wv0, wv1, wv2, bbv, vc);
#pragma unroll
                    for (int i = 0; i < 8; ++i) z[bb][i] = x1c[i] * vc[i];
                }
#pragma unroll
                for (int i = 0; i < 8; ++i) { cf t; t.x = z[0][i]; t.y = z[1][i]; a[FC_PIDX(t0 + i)] = t; }
            }
        }
        __syncthreads();
        cf wreg[16];
        FC_OPAQUE(tid);
        { const int pt = FC_PIDX(tid);
#pragma unroll
        for (int r = 0; r < 16; ++r) wreg[r] = a[pt + 576 * r]; }
        cf* e2 = (cf*)(F.lds + 73728);
#pragma unroll 1
        for (int path = 0; path < 2; ++path) {
            cf v[16];
            if (path == 0) {
#pragma unroll
                for (int r = 0; r < 16; ++r) v[r] = wreg[r];
            } else {
                FC_OPAQUE(tid);
#pragma unroll
                for (int r = 0; r < 16; ++r) { v[r] = cmul(wreg[r], TWN[tid + 512 * r]); if ((r & 3) == 3) asm volatile("" ::: "memory"); }
            }
            fwd_pass1(v, tid, a, TWM);
            __syncthreads();
            fwd_pass8(tid, a, TWM, 64, 6);
            __syncthreads();
            fwd_pass8(tid, a, TWM, 8, 3);
            __syncthreads();
            mid_pass(tid, a, Fsp + ((size_t)c * 2 + path) * FC_M, (cf*)nullptr, 0.f);
            __syncthreads();
            inv_pass8(tid, a, TWM, 8, 3);
            __syncthreads();
            inv_pass8(tid, a, TWM, 64, 6);
            __syncthreads();
            inv_pass1(v, tid, a, TWM);
            if (path == 0) {
#pragma unroll
                for (int r = 0; r < 16; ++r) e2[tid + 512 * r] = v[r];
            } else {
                const float db = dbias[c];
                FC_OPAQUE(tid);
#pragma unroll
                for (int r = 0; r < 16; ++r) { const int n = tid + 512 * r;
                    const cf y = cadd(cconj(e2[n]), cmul(cconj(TWN[n]), cconj(v[r])));
                    cf o; o.x = y.x + wreg[r].x * db; o.y = y.y + wreg[r].y * db; a[FC_PIDX(n)] = o; if ((r & 3) == 3) asm volatile("" ::: "memory"); }
            }
        }
        __syncthreads();
        {
            const float w00 = sw[c], w01 = sw[3072 + c], w02 = sw[6144 + c], bb0 = sb[c];
#pragma unroll 1
            for (int h = 0; h < 2; ++h) {
                FC_OPAQUE(tid);
                const int t0 = (tid + 512 * h) * 8;
                cf val[8];
#pragma unroll
                for (int i = 0; i < 8; ++i) val[i] = a[FC_PIDX(t0 + i)];
#pragma unroll
                for (int bb = 0; bb < 2; ++bb) {
                    const bf16* x0r = UT + ((size_t)(b0 + bb) * 3072 + c) * SEQ;
                    const v4u raw = *(const v4u*)(x0r + t0);
                    const float xp = t0 > 0 ? bf2f(x0r[t0 - 1]) : 0.f, xn = t0 + 8 < SEQ ? bf2f(x0r[t0 + 8]) : 0.f;
                    float x0c[8]; conv3_8(raw, xp, xn, w00, w01, w02, bb0, x0c);
                    float p[8];
#pragma unroll
                    for (int i = 0; i < 8; ++i) p[i] = x0c[i] * (bb == 0 ? val[i].x : val[i].y);
                    v4u o; o.x = pk2(p[0], p[1]); o.y = pk2(p[2], p[3]); o.z = pk2(p[4], p[5]); o.w = pk2(p[6], p[7]);
                    *(v4u*)(UT + ((size_t)(b0 + bb) * 3072 + 1024 + c) * SEQ + t0) = o;
                }
            }
        }
    }
    __syncthreads();
}
__device__ __forceinline__ void transpose_p_phase(Frame& F) {
    const bf16* UT = (const bf16*)(F.ws + WS_UT); bf16* P = (bf16*)(F.ws + WS_P);
    LAS unsigned short* scr = (LAS unsigned short*)(F.lds + F.wave * 16384);
    const int gw = F.vcu * NWAVES + F.wave, NGW = F.G * NWAVES, lane = F.lane;
    const int ntile = NB * (DM / 64) * (SEQ / 64);
    for (int it = gw; it < ntile; it += NGW) {
        const int tb = it % (SEQ / 64), cb = (it / (SEQ / 64)) % (DM / 64), b = it / ((SEQ / 64) * (DM / 64));
        for (int rr = 0; rr < 64; ++rr) scr[rr * 66 + lane] = UT[((size_t)b * 3072 + 1024 + cb * 64 + rr) * SEQ + tb * 64 + lane];
        LDS_WAIT(); asm volatile("" ::: "memory");
        for (int tt = 0; tt < 64; ++tt) P[((size_t)b * SEQ + tb * 64 + tt) * DM + cb * 64 + lane] = scr[lane * 66 + tt];
        LDS_WAIT(); asm volatile("" ::: "memory");
    }
}

constexpr int NPH = 17;
__global__ void __launch_bounds__(NWAVES * 64, 2) hybrid_fwd(Args args) {
    extern __shared__ __attribute__((aligned(16))) unsigned char lds[];
    Frame F;
    F.lds = (LAS unsigned char*)lds;
    F.tid = threadIdx.x; F.lane = F.tid & 63; F.wave = __builtin_amdgcn_readfirstlane(F.tid >> 6);
    F.G = gridDim.x; { const int bx = blockIdx.x; F.vcu = (F.G % 8 == 0) ? (bx % 8) * (F.G / 8) + bx / 8 : bx; }
    F.in = args.in; F.out = args.out; F.ws = args.ws;
    unsigned char* ws = args.ws;
    volatile LAS unsigned* MISC = (volatile LAS unsigned*)(F.lds + MISC_OFF);
    for (int u = F.tid; u < (LDS_BYTES - LDSCTL_OFF) / 4; u += NWAVES * 64) ((LAS unsigned*)(F.lds + LDSCTL_OFF))[u] = 0u;
    __syncthreads();
    XcdBarrier bar; bar.bar = (unsigned*)(ws + CT_BAR); bar.x = 0; bar.st = nullptr;
    const int lo = args.ph_lo, hi = args.ph_hi;
    if (hi - lo > 1) bar = xcd_barrier_post((unsigned*)(ws + CT_BAR), MISC + 8);
#ifndef EXP_PAIR
#define EXP_PAIR 0
#endif
#ifndef REP_MASK
#define REP_MASK 0
#endif
#define REPS(k) ((((REP_MASK) >> (k)) & 1) ? 2 : 1)
#ifndef PH_MASK
#define PH_MASK 0xFFFFFF
#endif
#define IN(k) ((((PH_MASK) >> (k)) & 1) && lo <= (k) && (k) < hi)
#define SEAM(k) do { if (IN(k) && IN((k) + 1)) xcd_barrier(bar); } while (0)
    const float* mods = (const float*)(ws + CT_MODS);
    const float* gnt = (const float*)(ws + SM_GN);
    float* ssqa = (float*)(ws + WS_SSQP);
    bf16* XS = (bf16*)(ws + WS_XS);

    if (IN(0)) { for (int rep = 0; rep < REPS(0); ++rep) phase0a(F); } SEAM(0);
    if (IN(1)) { for (int rep = 0; rep < REPS(1); ++rep) phase0b(F); } SEAM(1);
    if (IN(2)) for (int rep = 0; rep < REPS(2); ++rep) {
        { pg8::Gemm g{XS, (const bf16*)(ws + WS_WQKV), TT, 2 * DM, DM, DM}; pg8::StaticOrder S; S.init(TT, 2 * DM, F.G, (int)blockIdx.x);
          EpiQK E{(bf16*)(ws + WS_Q), (WS_K - WS_Q) / 2, (const float*)(ws + SM_SSQ0), 1, (const float*)(ws + CT_BQKV), 3072, args.in[9], args.in[10], 0, SEQ};
          pg8::gemm_phase<EpiQK, pg8::StaticOrder, true, true>(F.lds, g, S, E); }
        { pg8::Gemm g{XS, (const bf16*)(ws + WS_WQKV) + (size_t)2048 * DM, TT, DM, DM, DM}; pg8::StaticOrder S; S.init(TT, DM, F.G, (int)blockIdx.x);
          EpiVT E{(bf16*)(ws + WS_V), (const float*)(ws + SM_SSQ0), 1, (const float*)(ws + CT_BQKV), 3072, SEQ};
          pg8::gemm_phase<EpiVT, pg8::StaticOrder, true, true>(F.lds, g, S, E); }
        { pg8::Gemm g{(const bf16*)(ws + WS_XSC), (const bf16*)(ws + WS_WQKV) + (size_t)1024 * DM, TC, DM, DM, DM}; pg8::StaticOrder S; S.init(TC, DM, F.G, (int)blockIdx.x);
          EpiQK E{(bf16*)(ws + WS_KC) - (size_t)DM * TC, (size_t)DM * TC, (const float*)(ws + SM_SSQC), 1, (const float*)(ws + CT_BQKV) + 4 * 3072, 0, args.in[9], args.in[10], 4, CTXL};
          pg8::gemm_phase<EpiQK, pg8::StaticOrder, true, true>(F.lds, g, S, E); }
        { pg8::Gemm g{(const bf16*)(ws + WS_XSC), (const bf16*)(ws + WS_WQKV) + (size_t)2048 * DM, TC, DM, DM, DM}; pg8::StaticOrder S; S.init(TC, DM, F.G, (int)blockIdx.x);
          EpiVT E{(bf16*)(ws + WS_VC), (const float*)(ws + SM_SSQC), 1, (const float*)(ws + CT_BQKV) + 4 * 3072, 0, CTXL};
          pg8::gemm_phase<EpiVT, pg8::StaticOrder, true, true>(F.lds, g, S, E); }
    } SEAM(2);
    if (IN(3)) { for (int rep = 0; rep < REPS(3); ++rep) attn_mfma_phase(F); } SEAM(3);
    if (IN(4)) {
        pg8::Gemm g{(const bf16*)(ws + WS_O), (const bf16*)(ws + WS_WO), TT, DM, DM, DM}; pg8::StaticOrder S; S.init(TT, DM, F.G, (int)blockIdx.x);
        EpiRes E{args.in[0], args.out, mods + 2048, nullptr, gnt, XS, ssqa, (float*)(lds + RING_BYTES + 8192)};
        pg8::gemm_phase<EpiRes, pg8::StaticOrder, true, true>(F.lds, g, S, E);
    } SEAM(4);
    if (IN(5)) for (int rep = 0; rep < REPS(5); ++rep) {
        pg8::Gemm g{XS, (const bf16*)(ws + WS_WUP0), TT, 2 * FF, DM, DM}; pg8::StaticOrder S; S.init(TT, 2 * FF, F.G, (int)blockIdx.x);
        EpiUpGlu E{(bf16*)(ws + WS_AG), ssqa, 4, (const float*)(ws + CT_BUP0), args.in[14], args.in[15], (float*)(ws + WS_HG), (float*)(ws + WS_HA), (float*)(lds + RING_BYTES)};
        pg8::gemm_phase<EpiUpGlu, pg8::StaticOrder, true, true>(F.lds, g, S, E);
    } SEAM(5);
    if (IN(6)) { glu_fix_phase(F, args.in[14], args.in[15]); } SEAM(6);

    if (IN(7)) {
        pg8::Gemm g{(const bf16*)(ws + WS_AG), (const bf16*)(ws + WS_WDN0), TT, DM, FF, FF}; pg8::StaticOrder S; S.init(TT, DM, F.G, (int)blockIdx.x);
        EpiRes E{args.out, args.out, mods + 5120, nullptr, gnt + 4096, XS, ssqa + 4 * TT, (float*)(lds + RING_BYTES + 8192)};
        pg8::gemm_phase<EpiRes, pg8::StaticOrder, true, true>(F.lds, g, S, E);
    } SEAM(7);
    if (IN(8)) { for (int rep = 0; rep < REPS(8); ++rep) filtgen_phase(F); } SEAM(8);
    if (IN(9)) { for (int rep = 0; rep < REPS(9); ++rep) filtfft_phase(F); } SEAM(9);
    if (IN(10)) for (int rep = 0; rep < REPS(10); ++rep) {
        pg8::Gemm g{XS, (const bf16*)(ws + WS_WIN), TT, 3 * DM, DM, DM}; pg8::StaticOrder S; S.init(TT, 3 * DM, F.G, (int)blockIdx.x);
#ifdef EXP_P9
        EpiScaleBias E{(bf16*)(ws + WS_UT), 3 * DM, ssqa + 4 * TT, 4, (const float*)(ws + CT_BIN), 3072};
        pg8::gemm_phase<EpiScaleBias, pg8::StaticOrder, true, true>(F.lds, g, S, E);
#else
        EpiInT E{(bf16*)(ws + WS_UT), ssqa + 4 * TT, 4, (const float*)(ws + CT_BIN)};
        pg8::gemm_phase<EpiInT, pg8::StaticOrder, true, true>(F.lds, g, S, E);
#endif
    } SEAM(10);
    if (IN(11)) { hyena_fft_phase(F); } SEAM(11);
#if EXP_PAIR == 2
    {   pg8::Gemm g{XS, (const bf16*)(ws + WS_WIN), TT, 3 * DM, DM, DM}; pg8::StaticOrder S; S.init(TT, 3 * DM, F.G, (int)blockIdx.x);
        EpiInT E{(bf16*)(ws + WS_UT), ssqa + 4 * TT, 4, (const float*)(ws + CT_BIN)};
        pg8::gemm_phase<EpiInT, pg8::StaticOrder, true, true>(F.lds, g, S, E);
        xcd_barrier(bar);
        hyena_fft_phase(F);
        xcd_barrier(bar); }
#endif
    if (IN(12)) { for (int rep = 0; rep < REPS(12); ++rep) transpose_p_phase(F); } SEAM(12);
    if (IN(13)) {
        pg8::Gemm g{(const bf16*)(ws + WS_P), (const bf16*)(ws + WS_WOUT), TT, DM, DM, DM}; pg8::StaticOrder S; S.init(TT, DM, F.G, (int)blockIdx.x);
        EpiRes E{args.out, args.out, mods + 5 * 6144 + 2048, args.in[35], gnt + 2 * 4096, XS, ssqa + 8 * TT, (float*)(lds + RING_BYTES + 8192)};
        pg8::gemm_phase<EpiRes, pg8::StaticOrder, true, true>(F.lds, g, S, E);
    } SEAM(13);
    if (IN(14)) {
        pg8::Gemm g{XS, (const bf16*)(ws + WS_WUP1), TT, 2 * FF, DM, DM}; pg8::StaticOrder S; S.init(TT, 2 * FF, F.G, (int)blockIdx.x);
        EpiUpGlu E{(bf16*)(ws + WS_AG), ssqa + 8 * TT, 4, (const float*)(ws + CT_BUP1), args.in[37], args.in[38], (float*)(ws + WS_HG), (float*)(ws + WS_HA), (float*)(lds + RING_BYTES)};
        pg8::gemm_phase<EpiUpGlu, pg8::StaticOrder, true, true>(F.lds, g, S, E);
    } SEAM(14);
    if (IN(15)) { glu_fix_phase(F, args.in[37], args.in[38]); } SEAM(15);
    if (IN(16)) {
        pg8::Gemm g{(const bf16*)(ws + WS_AG), (const bf16*)(ws + WS_WDN1), TT, DM, FF, FF}; pg8::StaticOrder S; S.init(TT, DM, F.G, (int)blockIdx.x);
        EpiRes E{args.out, args.out, mods + 5 * 6144 + 5120, nullptr, nullptr, nullptr, nullptr, nullptr};
        pg8::gemm_phase<EpiRes, pg8::StaticOrder, true, true>(F.lds, g, S, E);
    }
#ifdef DUMP_SEL
    if (lo == 99) {
        float* o = args.out; const size_t n = (size_t)TT * DM;
        for (size_t e = (size_t)blockIdx.x * 512 + F.tid; e < n; e += (size_t)F.G * 512) {
            float v;
            if (DUMP_SEL == 1) { const float* h = (const float*)(ws + WS_HT); v = (e < (size_t)2 * 1024 * SEQ) ? h[e] : ((const float*)(ws + WS_FSQP))[e & 1023]; }
            else if (DUMP_SEL == 2) { const bf16* u = (const bf16*)(ws + WS_UT); v = bf2f(u[e]); }
            else if (DUMP_SEL == 3) { const bf16* u = (const bf16*)(ws + WS_UT); v = bf2f(u[e + (size_t)TT * DM]); }
            else if (DUMP_SEL == 4) { const bf16* u = (const bf16*)(ws + WS_UT); v = bf2f(u[e + (size_t)2 * TT * DM]); }
            else { const bf16* u = (const bf16*)(ws + WS_P); v = bf2f(u[e]); }
            o[e] = v;
        }
    }
#endif
#undef IN
#undef SEAM
}

extern "C" void kernel_launch(void* const* d_in, const int* in_sizes, int n_in, void* d_out, int out_size, void* d_ws, size_t ws_size, hipStream_t stream) {
    static int grid = 0;
    if (grid == 0) {
        if (n_in != 40 || out_size != TT * DM || ws_size < WS_END) { fprintf(stderr, "kernel_launch: unexpected shapes n_in %d out %d ws %zu\n", n_in, out_size, ws_size); grid = -1; return; }
        int dev = 0, cus = 0;
        if (hipGetDevice(&dev) != hipSuccess || hipDeviceGetAttribute(&cus, hipDeviceAttributeMultiprocessorCount, dev) != hipSuccess) { grid = -1; return; }
        if (hipFuncSetAttribute((const void*)hybrid_fwd, hipFuncAttributeMaxDynamicSharedMemorySize, LDS_BYTES) != hipSuccess) { fprintf(stderr, "kernel_launch: hipFuncSetAttribute failed\n"); grid = -1; return; }
        int per_cu = 0;
        if (hipOccupancyMaxActiveBlocksPerMultiprocessor(&per_cu, (const void*)hybrid_fwd, NWAVES * 64, LDS_BYTES) != hipSuccess || per_cu < 1) { fprintf(stderr, "kernel_launch: occupancy query says %d\n", per_cu); }
        (void)hipGetLastError();
        grid = cus;
    }
    if (grid < 0) return;
    (void)hipMemsetAsync((char*)d_ws + WS_CTL, 0, CTL_ZERO_BYTES, stream);
    Args a{};
    for (int i = 0; i < 40; ++i) a.in[i] = (const float*)d_in[i];
    a.out = (float*)d_out; a.ws = (unsigned char*)d_ws; a.repmask = REP_MASK;
#if MK_ONE_LAUNCH
    a.ph_lo = 0; a.ph_hi = NPH;
    hipLaunchKernelGGL(hybrid_fwd, dim3(grid), dim3(NWAVES * 64), LDS_BYTES, stream, a);
#else
    for (int p = 0; p < PH_END; ++p) { a.ph_lo = p; a.ph_hi = p + 1; hipLaunchKernelGGL(hybrid_fwd, dim3(grid), dim3(NWAVES * 64), LDS_BYTES, stream, a); }
#ifdef DUMP_SEL
    a.ph_lo = 99; a.ph_hi = 100; hipLaunchKernelGGL(hybrid_fwd, dim3(grid), dim3(NWAVES * 64), LDS_BYTES, stream, a);
#endif
#endif
}
```

```cpp
#include <hip/hip_runtime.h>
#include <cstdio>
#include <cstdint>

#ifndef PH_END
#define PH_END 17
#endif
#ifndef MK_ONE_LAUNCH
#define MK_ONE_LAUNCH 1
#endif

namespace pg8 {
#define PG8_LAS __attribute__((address_space(3)))
typedef unsigned short bf16_t;
typedef short bf16x8 __attribute__((ext_vector_type(8)));
typedef float f32x4 __attribute__((ext_vector_type(4)));
typedef unsigned u32x4 __attribute__((ext_vector_type(4)));
constexpr int BM = 256, BK = 64, HALF = 128, HTB = HALF * BK * 2, STAGE_BYTES = 8 * HTB, NXCD = 8, WGM = 8;

__host__ __device__ __forceinline__ int lds_byte(int r, int c) { const int st = (r >> 4) * 2 + (c >> 5), rr = r & 15, cc = c & 31, ob = rr * 64 + cc * 2; return st * 1024 + (ob ^ (((ob >> 9) & 1) << 5)); }
__host__ __device__ __forceinline__ void stage_rc(int b, int& R, int& C) { const int st = b / 1024, sb = b % 1024, swz = sb ^ (((sb >> 9) & 1) << 5); R = (st >> 1) * 16 + swz / 64; C = (st & 1) * 32 + (swz % 64) / 2; }
__host__ __device__ __forceinline__ int perm32(int rho) { const int n = rho >> 4, i = rho & 15; return 8 * (i >> 2) + 4 * n + (i & 3); }

struct Unit { int pm, pn; };
struct Gemm { const bf16_t* A; const bf16_t* Bt; int M, N, K, lda; };

struct StaticOrder {
    int nM, nN, nwg, G, c;
    __host__ __device__ void init(int M, int N, int G_, int c_) { nM = M / BM; nN = N / BM; nwg = nM * nN; G = G_; c = c_; }
    __host__ __device__ bool next(int i, Unit& u) const {
        const long L = (long)i * G + c; if (L >= nwg) return false;
        int wgid = (int)L; { const int q = nwg / NXCD, r = nwg % NXCD, xcd = wgid % NXCD, off = wgid / NXCD; wgid = (xcd < r ? xcd * (q + 1) : r * (q + 1) + (xcd - r) * q) + off; }
        const int nig = WGM * nN, gid = wgid / nig, fm = gid * WGM, gsz = (nM - fm) < WGM ? (nM - fm) : WGM;
        u.pm = fm + ((wgid % nig) % gsz); u.pn = (wgid % nig) / gsz; return true;
    }
    __device__ __forceinline__ void a_ready(const Unit&) const {}
    __device__ __forceinline__ void done(const Unit&) const {}
};

__device__ __forceinline__ unsigned cvt_pk_bf16(float lo, float hi) { unsigned r; asm volatile("v_cvt_pk_bf16_f32 %0, %1, %2" : "=v"(r) : "v"(lo), "v"(hi)); return r; }

template <class Epi, class Sched, bool ALIGN_EPI = false, bool SP2 = false>
__device__ __forceinline__ void gemm_phase(PG8_LAS unsigned char* lds, const Gemm g, const Sched& S, const Epi& E) {
    const int tid = threadIdx.x, wid = __builtin_amdgcn_readfirstlane(tid >> 6), lane = tid & 63, wr = wid >> 2, wc = wid & 3, fr = lane & 15, fq = lane >> 4;
    const int K = g.K, nt = K / BK, lda = g.lda;
    unsigned voffA[2], voffB[2];
#pragma unroll
    for (int i = 0; i < 2; ++i) { int R, C; stage_rc(tid * 16 + i * 8192, R, C); const int Rb = Epi::PERM ? ((R & ~31) + perm32(R & 31)) : R;
        voffA[i] = (unsigned)(R * lda + C) * 2u; voffB[i] = (unsigned)(Rb * K + C) * 2u; }
    const size_t kstep = (size_t)(BK * 2);
    const size_t hstepA = (size_t)HALF * lda * 2, hstepB = (size_t)HALF * K * 2;
    const size_t tstepA = 2 * hstepA, tstepB = 2 * hstepB;
    const unsigned ldsw = (unsigned)wid * 1024u;
    const int aoff = lds_byte(wr * 64 + fr, fq * 8), boff = lds_byte(wc * 32 + fr, fq * 8);
#define PG8_SA(b, h) (((b) * 2 + (h)) * HTB)
#define PG8_SB(b, h) ((4 + (b) * 2 + (h)) * HTB)
#define PG8_STAGE(bufoff, gbase, voff) do { _Pragma("unroll") for (int _i = 0; _i < 2; ++_i) \
        __builtin_amdgcn_global_load_lds((const unsigned*)((const char*)(gbase) + (voff)[_i]), (PG8_LAS unsigned*)(lds + (bufoff) + ldsw + _i * 8192), 16, 0, 0); } while (0)
#define PG8_LDA(dst, b, h) do { _Pragma("unroll") for (int m = 0; m < 4; ++m) _Pragma("unroll") for (int k = 0; k < 2; ++k) dst[m][k] = *(const PG8_LAS bf16x8*)(lds + PG8_SA(b, h) + aoff + m * 2048 + k * 1024); } while (0)
#define PG8_LDB(dst, b, h) do { _Pragma("unroll") for (int n = 0; n < 2; ++n) _Pragma("unroll") for (int k = 0; k < 2; ++k) dst[n][k] = *(const PG8_LAS bf16x8*)(lds + PG8_SB(b, h) + boff + n * 2048 + k * 1024); } while (0)
#define PG8_MMA(ai, bj, At, Bt) do { __builtin_amdgcn_s_setprio(1); _Pragma("unroll") for (int m = 0; m < 4; ++m) _Pragma("unroll") for (int n = 0; n < 2; ++n) _Pragma("unroll") for (int k = 0; k < 2; ++k) \
        acc[ai][bj][m][n] = __builtin_amdgcn_mfma_f32_16x16x32_bf16(Bt[n][k], At[m][k], acc[ai][bj][m][n], 0, 0, 0); __builtin_amdgcn_s_setprio(0); } while (0)
#define PG8_WAIT_V(n) asm volatile("s_waitcnt vmcnt(" #n ")" ::: "memory")
#define PG8_WAIT_L(n) asm volatile("s_waitcnt lgkmcnt(" #n ")" ::: "memory")
#define PG8_BAR __builtin_amdgcn_s_barrier()
#define PG8_SCHED __builtin_amdgcn_sched_barrier(0)
    Unit cur, nxt; int ui = 0;
    if (!S.next(0, cur)) return;
    f32x4 acc[2][2][4][2];
#pragma unroll
    for (int a = 0; a < 2; ++a)
#pragma unroll
        for (int b = 0; b < 2; ++b)
#pragma unroll
            for (int m = 0; m < 4; ++m)
#pragma unroll
                for (int n = 0; n < 2; ++n) acc[a][b][m][n] = (f32x4){0.f, 0.f, 0.f, 0.f};
    bf16x8 At[4][2], B0[2][2], B1[2][2];
    const char* cA = (const char*)g.A + (size_t)cur.pm * tstepA; const char* cB = (const char*)g.Bt + (size_t)cur.pn * tstepB;
    S.a_ready(cur);
    if constexpr (SP2) {
        PG8_STAGE(PG8_SB(0, 0), cB, voffB); PG8_STAGE(PG8_SB(0, 1), cB + hstepB, voffB); PG8_STAGE(PG8_SA(0, 0), cA, voffA); PG8_STAGE(PG8_SA(0, 1), cA + hstepA, voffA);
        if (wr == 1) PG8_BAR;
        PG8_WAIT_V(2); PG8_BAR;
        PG8_STAGE(PG8_SB(1, 0), cB + kstep, voffB); PG8_STAGE(PG8_SA(1, 0), cA + kstep, voffA); PG8_STAGE(PG8_SB(1, 1), cB + hstepB + kstep, voffB);
        PG8_WAIT_V(6); PG8_BAR;
    } else {
        PG8_STAGE(PG8_SB(0, 0), cB, voffB); PG8_STAGE(PG8_SA(0, 0), cA, voffA); PG8_STAGE(PG8_SB(0, 1), cB + hstepB, voffB); PG8_STAGE(PG8_SA(0, 1), cA + hstepA, voffA);
        if (wr == 1) PG8_BAR;
        PG8_WAIT_V(4); PG8_BAR;
        PG8_STAGE(PG8_SB(1, 0), cB + kstep, voffB); PG8_STAGE(PG8_SA(1, 0), cA + kstep, voffA); PG8_STAGE(PG8_SB(1, 1), cB + hstepB + kstep, voffB);
        PG8_WAIT_V(6); PG8_BAR;
    }
    for (;;) {
        const bool has_next = S.next(ui + 1, nxt);
        const char* nA = has_next ? (const char*)g.A + (size_t)nxt.pm * tstepA : cA; const char* nB = has_next ? (const char*)g.Bt + (size_t)nxt.pn * tstepB : cB;
        for (int t = 0; t < nt; t += 2) {
            const bool last = (t == nt - 2);
            const char* a1 = cA + (size_t)(t + 1) * kstep;
            const char* a2 = last ? nA : cA + (size_t)(t + 2) * kstep; const char* b2 = last ? nB : cB + (size_t)(t + 2) * kstep;
            const char* a3 = a2 + kstep; const char* b3 = b2 + kstep;
            if (last && has_next) S.a_ready(nxt);
            if constexpr (SP2) {
            PG8_LDB(B0, 0, 0); PG8_LDB(B1, 0, 1); PG8_SCHED; PG8_LDA(At, 0, 0); PG8_STAGE(PG8_SA(1, 1), a1 + hstepA, voffA);
            PG8_WAIT_V(8); PG8_WAIT_L(0); PG8_BAR; PG8_MMA(0, 0, At, B0); PG8_MMA(0, 1, At, B1); PG8_BAR; PG8_SCHED;
            PG8_LDA(At, 0, 1); PG8_STAGE(PG8_SB(0, 0), b2, voffB); PG8_STAGE(PG8_SB(0, 1), b2 + hstepB, voffB); PG8_STAGE(PG8_SA(0, 0), a2, voffA);
            PG8_WAIT_V(8); PG8_WAIT_L(0); PG8_BAR; PG8_MMA(1, 0, At, B0); PG8_MMA(1, 1, At, B1); PG8_BAR; PG8_SCHED;
            PG8_LDB(B0, 1, 0); PG8_LDB(B1, 1, 1); PG8_SCHED; PG8_LDA(At, 1, 0); PG8_STAGE(PG8_SA(0, 1), a2 + hstepA, voffA);
            PG8_WAIT_V(8); PG8_WAIT_L(0); PG8_BAR; PG8_MMA(0, 0, At, B0); PG8_MMA(0, 1, At, B1); PG8_BAR; PG8_SCHED;
            PG8_LDA(At, 1, 1); PG8_STAGE(PG8_SB(1, 0), b3, voffB); PG8_STAGE(PG8_SB(1, 1), b3 + hstepB, voffB); PG8_STAGE(PG8_SA(1, 0), a3, voffA);
            PG8_WAIT_V(8); PG8_WAIT_L(0); PG8_BAR; PG8_MMA(1, 0, At, B0); PG8_MMA(1, 1, At, B1); PG8_BAR; PG8_SCHED;
            } else {
            PG8_LDB(B0, 0, 0); PG8_SCHED; PG8_LDA(At, 0, 0); PG8_STAGE(PG8_SA(1, 1), a1 + hstepA, voffA);
            PG8_WAIT_L(8); PG8_BAR; PG8_WAIT_L(0); PG8_MMA(0, 0, At, B0); PG8_BAR; PG8_SCHED;
            PG8_LDB(B1, 0, 1); PG8_STAGE(PG8_SB(0, 0), b2, voffB);
            PG8_BAR; PG8_WAIT_L(0); PG8_MMA(0, 1, At, B1); PG8_BAR;
            PG8_LDA(At, 0, 1); PG8_STAGE(PG8_SA(0, 0), a2, voffA);
            PG8_BAR; PG8_WAIT_L(0); PG8_MMA(1, 0, At, B0); PG8_BAR; PG8_SCHED;
            PG8_STAGE(PG8_SB(0, 1), b2 + hstepB, voffB);
            PG8_WAIT_V(6); PG8_BAR; PG8_MMA(1, 1, At, B1); PG8_BAR;
            PG8_LDB(B0, 1, 0); PG8_SCHED; PG8_LDA(At, 1, 0); PG8_STAGE(PG8_SA(0, 1), a2 + hstepA, voffA);
            PG8_WAIT_L(8); PG8_BAR; PG8_WAIT_L(0); PG8_MMA(0, 0, At, B0); PG8_BAR; PG8_SCHED;
            PG8_LDB(B1, 1, 1); PG8_STAGE(PG8_SB(1, 0), b3, voffB);
            PG8_BAR; PG8_WAIT_L(0); PG8_MMA(0, 1, At, B1); PG8_BAR;
            PG8_LDA(At, 1, 1); PG8_STAGE(PG8_SA(1, 0), a3, voffA);
            PG8_BAR; PG8_WAIT_L(0); PG8_MMA(1, 0, At, B0); PG8_BAR; PG8_SCHED;
            PG8_STAGE(PG8_SB(1, 1), b3 + hstepB, voffB);
            PG8_WAIT_V(6); PG8_BAR; PG8_MMA(1, 1, At, B1); PG8_BAR;
            }
        }
        if constexpr (ALIGN_EPI) { if (wr == 0) PG8_BAR; }
        E(acc, cur, wr, wc, fr, fq); S.done(cur);
        if (!has_next) break;
#pragma unroll
        for (int a = 0; a < 2; ++a)
#pragma unroll
            for (int b = 0; b < 2; ++b)
#pragma unroll
                for (int m = 0; m < 4; ++m)
#pragma unroll
                    for (int n = 0; n < 2; ++n) acc[a][b][m][n] = (f32x4){0.f, 0.f, 0.f, 0.f};
        cur = nxt; cA = nA; cB = nB; ++ui;
        if constexpr (ALIGN_EPI) { if (wr == 1) PG8_BAR; }
    }
    PG8_WAIT_V(0);
    if constexpr (!ALIGN_EPI) { if (wr == 0) PG8_BAR; }
    PG8_BAR;
#undef PG8_SA
#undef PG8_SB
#undef PG8_STAGE
#undef PG8_LDA
#undef PG8_LDB
#undef PG8_MMA
#undef PG8_WAIT_V
#undef PG8_WAIT_L
#undef PG8_BAR
#undef PG8_SCHED
}
}

constexpr int NB = 4, SEQ = 8192, DM = 1024, TT = NB * SEQ, CTXL = 256, TC = NB * CTXL, FF = 2816, NH = 16, HD = 64, GW = 64, GROWS = SEQ / GW;
constexpr int WH = 8, WW = 16;
constexpr float EPS = 1e-6f;
constexpr int NWAVES = 8;

constexpr size_t MiB = 1u << 20;
constexpr size_t WS_CTL = 0, CTL_ZERO_BYTES = 64 * 1024;
constexpr size_t CT_BAR = 4096;
constexpr size_t CT_MODS = 64 * 1024;
constexpr size_t CT_BQKV = CT_MODS + 2 * 5 * 6144 * 4;
constexpr size_t CT_BUP0 = CT_BQKV + 5 * 3072 * 4;
constexpr size_t CT_BIN  = CT_BUP0 + 4 * 5632 * 4;
constexpr size_t CT_BUP1 = CT_BIN + 4 * 3072 * 4;
constexpr size_t CT_END  = CT_BUP1 + 4 * 5632 * 4;
static_assert(CT_END <= 1 * MiB, "ctl region");
constexpr size_t SM_SSQ0 = 1 * MiB, SM_SSQC = SM_SSQ0 + 32768 * 4, SM_GN = SM_SSQC + 1024 * 4;
constexpr size_t WS_SSQP = 2 * MiB;
constexpr size_t WS_FSQP = 4 * MiB;
constexpr size_t WS_XB = 448 * MiB;
constexpr size_t WS_WQKV = 8 * MiB, WS_WO = 14 * MiB, WS_WUP0 = 16 * MiB, WS_WDN0 = 27 * MiB, WS_WIN = 33 * MiB, WS_WOUT = 39 * MiB, WS_WUP1 = 41 * MiB, WS_WDN1 = 52 * MiB;
constexpr size_t WS_XSC = 58 * MiB, WS_KC = 60 * MiB, WS_VC = 62 * MiB;
constexpr size_t WS_XS = 64 * MiB;
constexpr size_t WS_Q = 128 * MiB, WS_K = 192 * MiB, WS_V = 256 * MiB, WS_O = 320 * MiB;
constexpr size_t WS_AG = 128 * MiB;
constexpr size_t WS_HG = 384 * MiB, WS_HA = 392 * MiB;
constexpr size_t WS_UT = 128 * MiB;
constexpr size_t WS_HT = 128 * MiB;
constexpr size_t WS_F = 320 * MiB;
constexpr size_t SM_TWM = 1536 * 1024, SM_TWN = SM_TWM + 65536;
constexpr size_t WS_P = 384 * MiB;
constexpr size_t WS_END = 512 * MiB;

constexpr int RING_BYTES = 131072;
constexpr int LDS_BYTES = 163840;
constexpr int LDSCTL_OFF = LDS_BYTES - 1024, MISC_OFF = LDSCTL_OFF + 320;

#define GAS __attribute__((address_space(1)))
#define LAS __attribute__((address_space(3)))
typedef unsigned short bf16;
typedef unsigned v4u __attribute__((ext_vector_type(4)));
typedef unsigned v2u __attribute__((ext_vector_type(2)));
typedef float f32x4 __attribute__((ext_vector_type(4)));
typedef GAS unsigned gu32;
#define RLX_AGENT __ATOMIC_RELAXED, __HIP_MEMORY_SCOPE_AGENT
#define LDS_WAIT() asm volatile("s_waitcnt lgkmcnt(0)" ::: "memory")
#define VM_WAIT() asm volatile("s_waitcnt vmcnt(0)" ::: "memory")
__device__ __forceinline__ unsigned f2bf(float f) { unsigned u = __builtin_bit_cast(unsigned, f); return (u + 0x7fffu + ((u >> 16) & 1u)) >> 16; }
__device__ __forceinline__ unsigned pk2(float lo, float hi) { return f2bf(lo) | (f2bf(hi) << 16); }
__device__ __forceinline__ float bf2f(unsigned short h) { return __builtin_bit_cast(float, (unsigned)h << 16); }
__device__ __forceinline__ float bflo(unsigned w) { return __builtin_bit_cast(float, w << 16); }
__device__ __forceinline__ float bfhi(unsigned w) { return __builtin_bit_cast(float, w & 0xffff0000u); }

#define FC_HD __device__ __forceinline__
struct cf { float x, y; };
FC_HD cf cmul(cf a, cf b) { cf r; r.x = a.x * b.x - a.y * b.y; r.y = a.x * b.y + a.y * b.x; return r; }
FC_HD cf cadd(cf a, cf b) { cf r; r.x = a.x + b.x; r.y = a.y + b.y; return r; }
FC_HD cf csub(cf a, cf b) { cf r; r.x = a.x - b.x; r.y = a.y - b.y; return r; }
FC_HD cf cconj(cf a) { cf r; r.x = a.x; r.y = -a.y; return r; }
FC_HD cf cmulnegi(cf a) { cf r; r.x = a.y; r.y = -a.x; return r; }
#define FC_OPAQUE(x) asm volatile("" : "+v"(x))
#define FC_PIDX(i) ((i) + (((i) >> 6) << 3))
#define FC_M 8192
#define FC_PADM (FC_M + FC_M / 8)
#define FC_S2 0.70710678118654752f
FC_HD void dft4(cf& a0, cf& a1, cf& a2, cf& a3) {
    const cf c0 = cadd(a0, a2), c1 = cadd(a1, a3), d0 = csub(a0, a2), d1 = cmulnegi(csub(a1, a3));
    a0 = cadd(c0, c1); a1 = cadd(d0, d1); a2 = csub(c0, c1); a3 = csub(d0, d1);
}
FC_HD void dft8(cf* v) {
    cf a0 = cadd(v[0], v[4]), a1 = cadd(v[1], v[5]), a2 = cadd(v[2], v[6]), a3 = cadd(v[3], v[7]);
    cf b0 = csub(v[0], v[4]), b1 = csub(v[1], v[5]), b2 = csub(v[2], v[6]), b3 = csub(v[3], v[7]);
    { cf t; t.x = (b1.x + b1.y) * FC_S2; t.y = (b1.y - b1.x) * FC_S2; b1 = t; }
    b2 = cmulnegi(b2);
    { cf t; t.x = (b3.y - b3.x) * FC_S2; t.y = (-b3.x - b3.y) * FC_S2; b3 = t; }
    dft4(a0, a1, a2, a3); dft4(b0, b1, b2, b3);
    v[0] = a0; v[2] = a1; v[4] = a2; v[6] = a3; v[1] = b0; v[3] = b1; v[5] = b2; v[7] = b3;
}
FC_HD void dft16(cf* v) {
    cf a[8], b[8];
    const float c1 = 0.92387953251128674f, s1 = 0.38268343236508977f;
#ifdef __HIP_DEVICE_COMPILE__
#pragma unroll
#endif
    for (int i = 0; i < 8; ++i) { a[i] = cadd(v[i], v[i + 8]); b[i] = csub(v[i], v[i + 8]); }
    { cf w; w.x = c1; w.y = -s1; b[1] = cmul(b[1], w); }
    { cf w; w.x = FC_S2; w.y = -FC_S2; b[2] = cmul(b[2], w); }
    { cf w; w.x = s1; w.y = -c1; b[3] = cmul(b[3], w); }
    b[4] = cmulnegi(b[4]);
    { cf w; w.x = -s1; w.y = -c1; b[5] = cmul(b[5], w); }
    { cf w; w.x = -FC_S2; w.y = -FC_S2; b[6] = cmul(b[6], w); }
    { cf w; w.x = -c1; w.y = -s1; b[7] = cmul(b[7], w); }
    dft8(a); dft8(b);
#ifdef __HIP_DEVICE_COMPILE__
#pragma unroll
#endif
    for (int i = 0; i < 8; ++i) { v[2 * i] = a[i]; v[2 * i + 1] = b[i]; }
}
template <int R> FC_HD void cpowers(cf w1, cf* w) {
    w[0].x = 1.f; w[0].y = 0.f; w[1] = w1;
#ifdef __HIP_DEVICE_COMPILE__
#pragma unroll
#endif
    for (int q = 2; q < R; ++q) w[q] = (q & 1) ? cmul(w[q - 1], w1) : cmul(w[q >> 1], w[q >> 1]);
}
template <class LP> FC_HD void fwd_pass1(cf* v, int tid, LP a, const cf* TWM) {
    dft16(v);
    FC_OPAQUE(tid);
    const cf w1 = TWM[tid]; cf cur = w1;
    const int pt = FC_PIDX(tid);
    a[pt] = v[0];
#ifdef __HIP_DEVICE_COMPILE__
#pragma unroll
#endif
    for (int q = 1; q < 16; ++q) { a[pt + 576 * q] = cmul(v[q], cur); cur = cmul(cur, w1); }
}
template <class LP> FC_HD void fwd_pass8(int tid, LP a, const cf* TWM, int s, int lgs) {
#pragma unroll 1
    for (int h = 0; h < 2; ++h) {
        FC_OPAQUE(tid);
        const int bf = tid + 512 * h, j = bf & (s - 1), base = (bf >> lgs) * 8 * s;
        const int pb = FC_PIDX(base + j), ps = (s == 64) ? 72 : 8;
        cf v[8];
#ifdef __HIP_DEVICE_COMPILE__
#pragma unroll
#endif
        for (int r = 0; r < 8; ++r) v[r] = a[pb + ps * r];
        dft8(v);
        const cf w1 = TWM[j]; cf cur = w1;
        a[pb] = v[0];
#ifdef __HIP_DEVICE_COMPILE__
#pragma unroll
#endif
        for (int q = 1; q < 8; ++q) { a[pb + ps * q] = cmul(v[q], cur); cur = cmul(cur, w1); }
    }
}
template <class LP> FC_HD void mid_pass(int tid, LP a, const cf* F, cf* Fout, float fscale) {
#pragma unroll 1
    for (int h = 0; h < 2; ++h) {
        FC_OPAQUE(tid);
        const int bf = tid + 512 * h, base = bf * 8, pb = FC_PIDX(base);
        cf v[8];
#ifdef __HIP_DEVICE_COMPILE__
#pragma unroll
#endif
        for (int r = 0; r < 8; ++r) v[r] = a[pb + r];
        dft8(v);
        if (F) {
#ifdef __HIP_DEVICE_COMPILE__
#pragma unroll
#endif
            for (int r = 0; r < 8; ++r) v[r] = cconj(cmul(v[r], F[base + r]));
            dft8(v);
#ifdef __HIP_DEVICE_COMPILE__
#pragma unroll
#endif
            for (int r = 0; r < 8; ++r) a[pb + r] = v[r];
        } else {
#ifdef __HIP_DEVICE_COMPILE__
#pragma unroll
#endif
            for (int r = 0; r < 8; ++r) { cf o; o.x = v[r].x * fscale; o.y = v[r].y * fscale; Fout[base + r] = o; }
        }
    }
}
template <class LP> FC_HD void mid_pass_reg(int tid, LP a, const cf* fr) {
#ifdef __HIP_DEVICE_COMPILE__
#pragma unroll
#endif
    for (int h = 0; h < 2; ++h) {
        FC_OPAQUE(tid);
        const int bf = tid + 512 * h, base = bf * 8, pb = FC_PIDX(base);
        cf v[8];
#ifdef __HIP_DEVICE_COMPILE__
#pragma unroll
#endif
        for (int r = 0; r < 8; ++r) v[r] = a[pb + r];
        dft8(v);
#ifdef __HIP_DEVICE_COMPILE__
#pragma unroll
#endif
        for (int r = 0; r < 8; ++r) v[r] = cconj(cmul(v[r], fr[h * 8 + r]));
        dft8(v);
#ifdef __HIP_DEVICE_COMPILE__
#pragma unroll
#endif
        for (int r = 0; r < 8; ++r) a[pb + r] = v[r];
    }
}
template <class LP> FC_HD void inv_pass8(int tid, LP a, const cf* TWM, int s, int lgs) {
#pragma unroll 1
    for (int h = 0; h < 2; ++h) {
        FC_OPAQUE(tid);
        const int bf = tid + 512 * h, j = bf & (s - 1), base = (bf >> lgs) * 8 * s;
        const int pb = FC_PIDX(base + j), ps = (s == 64) ? 72 : 8;
        cf v[8]; const cf w1 = TWM[j]; cf cur = w1;
        v[0] = a[FC_PIDX(base + j)];
#ifdef __HIP_DEVICE_COMPILE__
#pragma unroll
#endif
        for (int q = 1; q < 8; ++q) { v[q] = cmul(a[pb + ps * q], cur); cur = cmul(cur, w1); }
        dft8(v);
#ifdef __HIP_DEVICE_COMPILE__
#pragma unroll
#endif
        for (int r = 0; r < 8; ++r) a[pb + ps * r] = v[r];
    }
}
template <class LP> FC_HD void inv_pass1(cf* v, int tid, LP a, const cf* TWM) {
    FC_OPAQUE(tid);
    const cf w1 = TWM[tid]; cf cur = w1;
    const int pt = FC_PIDX(tid);
    v[0] = a[pt];
#ifdef __HIP_DEVICE_COMPILE__
#pragma unroll
#endif
    for (int q = 1; q < 16; ++q) { v[q] = cmul(a[pt + 576 * q], cur); cur = cmul(cur, w1); }
    dft16(v);
}

#define XB_TMO      128
#define XB_XCNT(j)  (256  + 64 * (j))
#define XB_XSUB(j)  (1280 + 64 * (j))
#define XB_XGEN(j)  (2304 + 64 * (j))
#define XB_TOP      3328
#define XB_TOPGEN   3392
#define XCD_BAR_WORDS 3456
#define XB_SPIN_CAP (1u << 18)
__device__ __forceinline__ unsigned xb_ld(unsigned* p)              { return __hip_atomic_load(p, __ATOMIC_RELAXED, __HIP_MEMORY_SCOPE_AGENT); }
__device__ __forceinline__ unsigned xb_add(unsigned* p, unsigned v) { return __hip_atomic_fetch_add(p, v, __ATOMIC_RELAXED, __HIP_MEMORY_SCOPE_AGENT); }
__device__ __forceinline__ unsigned xb_xcc_id() { return (unsigned)__builtin_amdgcn_s_getreg((3 << 11) | 20) & 0xFu; }
#define XB_SPIN(cond, bar) do { unsigned _sp = 0; while (cond) { __builtin_amdgcn_s_sleep(1); \
    if ((++_sp & 255u) == 0u) { if (xb_ld(&(bar)[XB_TMO])) break; if (_sp > XB_SPIN_CAP) { atomicAdd(&(bar)[XB_TMO], 1u); break; } } } } while (0)
struct XcdBarrier { unsigned* bar; unsigned x; volatile LAS unsigned* st; };
__device__ __forceinline__ XcdBarrier xcd_barrier_post(unsigned* bar, volatile LAS unsigned* st) {
    XcdBarrier b; b.bar = bar; b.x = xb_xcc_id(); b.st = st;
    if (threadIdx.x == 0) (void)xb_add(&bar[XB_XCNT(b.x)], 1u);
    return b;
}
__device__ __forceinline__ void xcd_barrier_complete(unsigned* bar, unsigned x, unsigned& nloc, unsigned& nx) {
    const unsigned G = gridDim.x * gridDim.y * gridDim.z;
    unsigned sum, cnt, mine, sp = 0u;
    for (;;) {
        sum = 0u; cnt = 0u; mine = 0u;
#pragma unroll
        for (unsigned j = 0; j < 16; ++j) { const unsigned c = xb_ld(&bar[XB_XCNT(j)]); sum += c; cnt += (c > 0u) ? 1u : 0u; mine = (j == x) ? c : mine; }
        if (sum == G) break;
        __builtin_amdgcn_s_sleep(1);
        if ((++sp & 255u) == 0u) { if (xb_ld(&bar[XB_TMO])) break; if (sp > XB_SPIN_CAP) { atomicAdd(&bar[XB_TMO], 1u); break; } }
    }
    nloc = mine > 0u ? mine : 1u; nx = cnt > 0u ? cnt : 1u;
}
__device__ __forceinline__ void xcd_barrier(const XcdBarrier& b) {
    asm volatile("s_waitcnt vmcnt(0)" ::: "memory");
    __syncthreads();
    if (threadIdx.x == 0) {
        unsigned* bar = b.bar;
        __builtin_amdgcn_s_waitcnt(0);
        unsigned nloc = b.st[0], nx = b.st[1];
        if (nloc == 0u) { xcd_barrier_complete(bar, b.x, nloc, nx); b.st[0] = nloc; b.st[1] = nx; }
        const unsigned old = xb_add(&bar[XB_XSUB(b.x)], 1u);
        const unsigned gen = old / nloc;
        if (old + 1u == (gen + 1u) * nloc) {
            __builtin_amdgcn_fence(__ATOMIC_RELEASE, "agent");
            asm volatile("s_waitcnt vmcnt(0)" ::: "memory");
            const unsigned og = xb_add(&bar[XB_TOP], 1u);
            const unsigned tg = og / nx;
            if (og + 1u == (tg + 1u) * nx) xb_add(&bar[XB_TOPGEN], 1u);
            else XB_SPIN(xb_ld(&bar[XB_TOPGEN]) == tg, bar);
            __builtin_amdgcn_fence(__ATOMIC_ACQUIRE, "agent");
            xb_add(&bar[XB_XGEN(b.x)], 1u);
            asm volatile("s_waitcnt vmcnt(0)" ::: "memory");
        } else {
            XB_SPIN(xb_ld(&bar[XB_XGEN(b.x)]) == gen, bar);
            __builtin_amdgcn_fence(__ATOMIC_ACQUIRE, "agent");
            asm volatile("s_waitcnt vmcnt(0)" ::: "memory");
        }
    }
    __syncthreads();
}

struct Args { const float* in[40]; float* out; unsigned char* ws; int ph_lo, ph_hi, repmask, li; };
struct Frame {
    LAS unsigned char* lds;
    int tid, lane, wave, vcu, G;
    const float* const* in; float* out; unsigned char* ws;
};
__device__ __forceinline__ float wave_sum(float v) {
#pragma unroll
    for (int o = 1; o < 64; o <<= 1) v += __shfl_xor(v, o);
    return v;
}
__device__ __forceinline__ float silu_f(float x) { return x / (1.f + __expf(-x)); }

__device__ __forceinline__ float gelu_f(float v) { return 0.5f * v * (1.f + erff(v * 0.70710678118654752f)); }

__device__ __forceinline__ void transpose_item(const float* W, int K, int N, bf16* WT, int src_col0, int dst_row0, int k0, LAS float* scr, int lane) {
#pragma unroll 8
    for (int i = 0; i < 32; ++i) { const int kk = 2 * i + (lane >> 5); scr[kk * 33 + (lane & 31)] = W[(size_t)(k0 + kk) * N + src_col0 + (lane & 31)]; }
    LDS_WAIT(); asm volatile("" ::: "memory");
    const int c = lane & 7;
#pragma unroll
    for (int j = 0; j < 4; ++j) { const int n = (lane >> 3) + 8 * j; const LAS float* s = scr + (8 * c) * 33 + n;
        v4u o; o.x = pk2(s[0 * 33], s[1 * 33]); o.y = pk2(s[2 * 33], s[3 * 33]); o.z = pk2(s[4 * 33], s[5 * 33]); o.w = pk2(s[6 * 33], s[7 * 33]);
        *(GAS v4u*)(WT + (size_t)(dst_row0 + n) * K + k0 + 8 * c) = o; }
    LDS_WAIT(); asm volatile("" ::: "memory");
}
__device__ __forceinline__ int qkv_slot_to_col(int slot) {
    const int part = slot >> 10, cc = slot & 1023, pnl = cc >> 8, s = cc & 255, bj = s >> 7, wc = (s & 127) >> 5, j = s & 31;
    return part * 1024 + (4 * pnl + wc) * 64 + 32 * bj + j;
}
__device__ __forceinline__ int up_slot_to_col(int slot) { const int pn = slot >> 8, bj = (slot >> 7) & 1, cc = slot & 127; return bj * FF + pn * 128 + cc; }
__device__ __forceinline__ void cvt_weight_item(const float* W, int K, int N, bf16* WT, int item, LAS float* scr, int lane, int perm) {
    const int nblk = N / 32, kb = item / nblk, nb = item % nblk;
    const int dst = 32 * nb, src = perm == 1 ? qkv_slot_to_col(dst) : (perm == 2 ? up_slot_to_col(dst) : dst);
    transpose_item(W, K, N, WT, src, dst, 64 * kb, scr, lane);
}

template <int R, class VF>
__device__ __forceinline__ void gemv_det_item(const float* W, int N, int n0, float* out, int ostride, const float* addbias, const VF& vf, int tid, LAS float* scr) {
    const int col = tid & 63, ks = tid >> 6;
    float acc[R];
#pragma unroll
    for (int r = 0; r < R; ++r) acc[r] = 0.f;
    const float* wp = W + (size_t)(ks * 128) * N + n0 + col;
#pragma unroll 8
    for (int k = 0; k < 128; ++k) { const float w = wp[(size_t)k * N];
#pragma unroll
        for (int r = 0; r < R; ++r) acc[r] += vf(r, ks * 128 + k) * w; }
    __syncthreads();
#pragma unroll
    for (int r = 0; r < R; ++r) scr[(ks * R + r) * 64 + col] = acc[r];
    __syncthreads();
    if (tid < R * 64) { const int r = tid >> 6; float s = 0.f;
#pragma unroll
        for (int k2 = 0; k2 < 8; ++k2) s += scr[(k2 * R + r) * 64 + col];
        if (addbias) s += addbias[n0 + col];
        out[(size_t)r * ostride + n0 + col] = s; }
}

__device__ __forceinline__ void phase0a(Frame& F) {
    const float* const* in = F.in;
    float* mods = (float*)(F.ws + CT_MODS);
    {
        const float* c = in[1]; const float* cctx = in[3];
        auto vf = [&](int r, int k) -> float { const float v = (r < 4) ? c[r * DM + k] : cctx[k]; return silu_f(v); };
        const int nitems = 2 * 96;
        for (int it = F.vcu; it < nitems; it += F.G) {
            const int l = it / 96, cg = it % 96;
            gemv_det_item<5>(in[l ? 17 : 4], 6144, cg * 64, mods + l * 5 * 6144, 6144, in[l ? 18 : 5], vf, F.tid, (LAS float*)F.lds);
        }
        __syncthreads();
    }
    for (int e = F.vcu * 512 + F.tid; e < 16384; e += F.G * 512) {
        const int k = e & 8191; const bool isn = e >= 8192;
        float sn, cs; sincospif(isn ? (float)k * (1.0f / 8192.0f) : (float)k * (1.0f / 4096.0f), &sn, &cs);
        cf t; t.x = cs; t.y = -sn;
        ((cf*)(F.ws + (isn ? SM_TWN : SM_TWM)))[k] = t;
    }
    LAS float* scr = (LAS float*)(F.lds + F.wave * 16384);
    const int gw = F.vcu * NWAVES + F.wave, NGW = F.G * NWAVES;
    constexpr int I_QKV = 16 * 96, I_O = 16 * 32, I_UP = 16 * 176, I_DN = 44 * 32;
    constexpr int NITEMS = 2 * I_QKV + 2 * I_O + 2 * I_UP + 2 * I_DN;
    for (int it = gw; it < NITEMS; it += NGW) {
        int r = it;
        if (r < I_QKV) { cvt_weight_item(in[8], DM, 3 * DM, (bf16*)(F.ws + WS_WQKV), r, scr, F.lane, 1); continue; } r -= I_QKV;
        if (r < I_O) { cvt_weight_item(in[12], DM, DM, (bf16*)(F.ws + WS_WO), r, scr, F.lane, 0); continue; } r -= I_O;
        if (r < I_UP) { cvt_weight_item(in[13], DM, 2 * FF, (bf16*)(F.ws + WS_WUP0), r, scr, F.lane, 2); continue; } r -= I_UP;
        if (r < I_DN) { cvt_weight_item(in[16], FF, DM, (bf16*)(F.ws + WS_WDN0), r, scr, F.lane, 0); continue; } r -= I_DN;
        if (r < I_QKV) { cvt_weight_item(in[21], DM, 3 * DM, (bf16*)(F.ws + WS_WIN), r, scr, F.lane, 0); continue; } r -= I_QKV;
        if (r < I_O) { cvt_weight_item(in[34], DM, DM, (bf16*)(F.ws + WS_WOUT), r, scr, F.lane, 0); continue; } r -= I_O;
        if (r < I_UP) { cvt_weight_item(in[36], DM, 2 * FF, (bf16*)(F.ws + WS_WUP1), r, scr, F.lane, 2); continue; } r -= I_UP;
        cvt_weight_item(in[39], FF, DM, (bf16*)(F.ws + WS_WDN1), r, scr, F.lane, 0);
    }
}

__device__ __forceinline__ void row_prescale(const float* xrow, const float* gain, const float* sc, bf16* orow, float* ssq_out, int lane) {
    const GAS f32x4* xr = (const GAS f32x4*)xrow + lane;
    const GAS f32x4* gr = (const GAS f32x4*)gain + lane;
    const GAS f32x4* sr = (const GAS f32x4*)sc + lane;
    f32x4 v[4]; float s = 0.f;
#pragma unroll
    for (int j = 0; j < 4; ++j) { v[j] = xr[64 * j]; s += (v[j].x * v[j].x + v[j].y * v[j].y) + (v[j].z * v[j].z + v[j].w * v[j].w); }
    s = wave_sum(s);
    if (lane == 0) *ssq_out = s;
    GAS unsigned long long* o8 = (GAS unsigned long long*)orow + lane;
#pragma unroll
    for (int j = 0; j < 4; ++j) { const f32x4 g = gr[64 * j], c = sr[64 * j]; const f32x4 w = v[j] * g * (c + 1.0f);
        o8[64 * j] = (unsigned long long)pk2(w.x, w.y) | ((unsigned long long)pk2(w.z, w.w) << 32); }
}
__device__ __forceinline__ void phase0b(Frame& F) {
    const float* const* in = F.in;
    const float* mods = (const float*)(F.ws + CT_MODS);
    const int gw = F.vcu * NWAVES + F.wave, NGW = F.G * NWAVES;
    for (int m = gw; m < TT + TC; m += NGW) {
        if (m < TT) { const int b = m / SEQ; row_prescale(in[0] + (size_t)m * DM, in[6], mods + b * 6144 + 1024, (bf16*)(F.ws + WS_XS) + (size_t)m * DM, (float*)(F.ws + SM_SSQ0) + m, F.lane); }
        else { const int mc = m - TT; row_prescale(in[2] + (size_t)mc * DM, in[6], mods + 4 * 6144 + 1024, (bf16*)(F.ws + WS_XSC) + (size_t)mc * DM, (float*)(F.ws + SM_SSQC) + mc, F.lane); }
    }
    {
        float* gn = (float*)(F.ws + SM_GN);
        for (int e = F.vcu * 512 + F.tid; e < 3 * 4 * 1024; e += F.G * 512) {
            const int i = e / 4096, b = (e / 1024) & 3, k = e & 1023;
            const float* g = in[i == 0 ? 7 : (i == 1 ? 19 : 20)];
            const float sc = mods[(i == 0 ? 0 : 1) * 5 * 6144 + b * 6144 + (i == 1 ? 1024 : 4096) + k];
            gn[e] = g[k] * (1.f + sc);
        }
    }
    {
        const int n_qkv = 48, n_up = 88, n_in = 48;
        const int nitems = n_qkv + n_up + n_in + n_up;
        LAS float* gs = (LAS float*)F.lds;
        for (int it0 = F.vcu; it0 < nitems; it0 += F.G) {
            int it = it0;
            if (it < n_qkv) { auto vf = [&](int r, int k) -> float { return mods[r * 6144 + k]; };
                gemv_det_item<5>(in[8], 3072, it * 64, (float*)(F.ws + CT_BQKV), 3072, nullptr, vf, F.tid, gs); continue; } it -= n_qkv;
            if (it < n_up) { auto vf = [&](int r, int k) -> float { return mods[r * 6144 + 3072 + k]; };
                gemv_det_item<4>(in[13], 5632, it * 64, (float*)(F.ws + CT_BUP0), 5632, nullptr, vf, F.tid, gs); continue; } it -= n_up;
            if (it < n_in) { auto vf = [&](int r, int k) -> float { return mods[5 * 6144 + r * 6144 + k]; };
                gemv_det_item<4>(in[21], 3072, it * 64, (float*)(F.ws + CT_BIN), 3072, in[22], vf, F.tid, gs); continue; } it -= n_in;
            { auto vf = [&](int r, int k) -> float { return mods[5 * 6144 + r * 6144 + 3072 + k]; };
                gemv_det_item<4>(in[36], 5632, it * 64, (float*)(F.ws + CT_BUP1), 5632, nullptr, vf, F.tid, gs); }
        }
        __syncthreads();
    }
}

using pg8::f32x4; using pg8::Unit;
__device__ __forceinline__ float row_rs(const float* ssq, int np, int row) {
    float s = 0.f;
    for (int i = 0; i < np; ++i) s += ssq[(size_t)i * TT + row];
    return 1.0f / sqrtf(s * (1.0f / 1024.0f) + EPS);
}
constexpr float QSCALE = 0.125f * 1.4426950408889634f;
template <int PART>
struct EpiQK {
    static constexpr bool PERM = true;
    bf16* dst; const float* ssq; int np; const float* bias; int bias_bstride; const float* gain; int seqlen;
    __device__ __forceinline__ void operator()(const f32x4 (&acc)[2][2][4][2], const Unit& u, int wr, int wc, int fr, int fq) const {
        const int head = 4 * u.pn + wc;
        const int b = (u.pm * 256) / seqlen;
        const float* bp = bias + (size_t)b * bias_bstride + PART * 1024 + head * 64 + 8 * fq;
        const float* gp = gain + 8 * fq;
        const float osc = PART == 0 ? QSCALE : 1.0f;
#pragma unroll
        for (int ai = 0; ai < 2; ++ai)
#pragma unroll
            for (int m = 0; m < 4; ++m) {
                const int row = u.pm * 256 + ai * 128 + wr * 64 + m * 16 + fr;
                const float rs = row_rs(ssq, np, row);
                f32x4 v[2][2]; float ss = 0.f;
#pragma unroll
                for (int bj = 0; bj < 2; ++bj)
#pragma unroll
                    for (int n = 0; n < 2; ++n) { v[bj][n] = acc[ai][bj][m][n] * rs + *(const f32x4*)(bp + 32 * bj + 4 * n); const f32x4 t = v[bj][n]; ss += (t.x * t.x + t.y * t.y) + (t.z * t.z + t.w * t.w); }
                ss += __shfl_xor(ss, 16); ss += __shfl_xor(ss, 32);
                const float rn = osc / sqrtf(ss * (1.0f / 64.0f) + EPS);
                const int tl = row - b * seqlen;
                bf16* rowp = (PART == 0) ? dst + (size_t)row * DM + head * 64 + 8 * fq
                                         : dst + ((((size_t)(b * NH + head) * (seqlen / 16) + (tl >> 4)) * 8 + fq) * 16 + (tl & 15)) * 8;
                constexpr int bjstep = (PART == 0) ? 32 : 4 * 16 * 8;
#pragma unroll
                for (int bj = 0; bj < 2; ++bj) { const f32x4 a0 = v[bj][0] * rn * *(const f32x4*)(gp + 32 * bj), a1 = v[bj][1] * rn * *(const f32x4*)(gp + 32 * bj + 4);
                    v4u w; w.x = pk2(a0.x, a0.y); w.y = pk2(a0.z, a0.w); w.z = pk2(a1.x, a1.y); w.w = pk2(a1.z, a1.w);
                    *(v4u*)(rowp + bjstep * bj) = w; }
                asm volatile("" ::: "memory");
            }
    }
};
struct EpiVT {
    static constexpr bool PERM = true;
    bf16* VTp; const float* ssq; int np; const float* bias; int bias_bstride; int seqlen;
    __device__ __forceinline__ void operator()(const f32x4 (&acc)[2][2][4][2], const Unit& u, int wr, int wc, int fr, int fq) const {
        const int head = 4 * u.pn + wc;
        const int b = (u.pm * 256) / seqlen;
        const float* bp = bias + (size_t)b * bias_bstride + 2048 + head * 64 + 8 * fq;
        const int odd = fr & 1;
        f32x4 bv[2][2];
#pragma unroll
        for (int bj = 0; bj < 2; ++bj)
#pragma unroll
            for (int n = 0; n < 2; ++n) bv[bj][n] = *(const f32x4*)(bp + 32 * bj + 4 * n);
#pragma unroll
        for (int ai = 0; ai < 2; ++ai)
#pragma unroll
            for (int m = 0; m < 4; ++m) {
                const int row = u.pm * 256 + ai * 128 + wr * 64 + m * 16 + fr;
                const float rs = row_rs(ssq, np, row);
                const int tl = row - b * seqlen;
                const int c16 = tl & 14, cpos = (c16 & 3) | ((c16 & 8) >> 1) | ((c16 & 4) << 1);
                bf16* vb = VTp + (((size_t)(b * NH + head) * (seqlen / 16) + (tl >> 4)) * 64 + 8 * fq + odd) * 16 + cpos;
#pragma unroll
                for (int bj = 0; bj < 2; ++bj)
#pragma unroll
                    for (int n = 0; n < 2; ++n) {
                        const f32x4 v = acc[ai][bj][m][n] * rs + bv[bj][n];
                        const unsigned w01 = pk2(v.x, v.y), w23 = pk2(v.z, v.w);
                        const unsigned p01 = (unsigned)__shfl_xor((int)w01, 1), p23 = (unsigned)__shfl_xor((int)w23, 1);
                        const unsigned o0 = odd ? ((w01 & 0xffff0000u) | (p01 >> 16)) : ((p01 << 16) | (w01 & 0xffffu));
                        const unsigned o1 = odd ? ((w23 & 0xffff0000u) | (p23 >> 16)) : ((p23 << 16) | (w23 & 0xffffu));
                        bf16* p = vb + (32 * bj + 4 * n) * 16;
                        *(unsigned*)p = o0; *(unsigned*)(p + 2 * 16) = o1;
                    }
            }
    }
};
template <bool BASE_F32, bool OUT_F32>
struct EpiRes {
    static constexpr bool PERM = true;
    const void* base; void* out; const float* gate; const float* bias; const float* gn; bf16* xs; float* ssq; float* hs;
    __device__ __forceinline__ void operator()(const f32x4 (&acc)[2][2][4][2], const Unit& u, int wr, int wc, int fr, int fq) const {
        const int b = (u.pm * 256) / SEQ;
        const int col0 = u.pn * 256 + wc * 32 + 8 * fq;
        constexpr int MB = BASE_F32 ? 2 : 4;
#pragma unroll
        for (int ai = 0; ai < 2; ++ai)
#pragma unroll
        for (int mb = 0; mb < 4; mb += MB) {
            f32x4 bf[MB][2][2]; v4u bh[MB][2];
#pragma unroll
            for (int mi = 0; mi < MB; ++mi) { const size_t off = (size_t)(u.pm * 256 + ai * 128 + wr * 64 + (mb + mi) * 16 + fr) * DM + col0;
#pragma unroll
                for (int bj = 0; bj < 2; ++bj) {
                    if (BASE_F32) { bf[mi][bj][0] = *(const f32x4*)((const float*)base + off + 128 * bj); bf[mi][bj][1] = *(const f32x4*)((const float*)base + off + 128 * bj + 4); }
                    else bh[mi][bj] = *(const v4u*)((const bf16*)base + off + 128 * bj); } }
#pragma unroll
            for (int mi = 0; mi < MB; ++mi) {
                const int m = mb + mi;
                const int rowl = ai * 128 + wr * 64 + m * 16 + fr;
                const size_t off = (size_t)(u.pm * 256 + rowl) * DM + col0;
                float ss = 0.f;
#pragma unroll
                for (int bj = 0; bj < 2; ++bj) {
                    const int c = col0 + 128 * bj;
                    f32x4 b0, b1;
                    if (BASE_F32) { b0 = bf[mi][bj][0]; b1 = bf[mi][bj][1]; }
                    else { const v4u w = bh[mi][bj]; b0 = (f32x4){bflo(w.x), bfhi(w.x), bflo(w.y), bfhi(w.y)}; b1 = (f32x4){bflo(w.z), bfhi(w.z), bflo(w.w), bfhi(w.w)}; }
                    f32x4 a0 = acc[ai][bj][m][0], a1 = acc[ai][bj][m][1];
                    if (bias) { a0 += *(const f32x4*)(bias + c); a1 += *(const f32x4*)(bias + c + 4); }
                    const f32x4 x0 = b0 + *(const f32x4*)(gate + (size_t)b * 6144 + c) * a0, x1 = b1 + *(const f32x4*)(gate + (size_t)b * 6144 + c + 4) * a1;
                    if (OUT_F32) { *(f32x4*)((float*)out + off + 128 * bj) = x0; *(f32x4*)((float*)out + off + 128 * bj + 4) = x1; }
                    else {
                        v4u w; w.x = pk2(x0.x, x0.y); w.y = pk2(x0.z, x0.w); w.z = pk2(x1.x, x1.y); w.w = pk2(x1.z, x1.w);
                        *(v4u*)((bf16*)out + off + 128 * bj) = w;
                        const f32x4 r0 = (f32x4){bflo(w.x), bfhi(w.x), bflo(w.y), bfhi(w.y)}, r1 = (f32x4){bflo(w.z), bfhi(w.z), bflo(w.w), bfhi(w.w)};
                        ss += (r0.x * r0.x + r0.y * r0.y) + (r0.z * r0.z + r0.w * r0.w) + (r1.x * r1.x + r1.y * r1.y) + (r1.z * r1.z + r1.w * r1.w);
                        const f32x4 q0 = r0 * *(const f32x4*)(gn + (size_t)b * 1024 + c), q1 = r1 * *(const f32x4*)(gn + (size_t)b * 1024 + c + 4);
                        v4u ws2; ws2.x = pk2(q0.x, q0.y); ws2.y = pk2(q0.z, q0.w); ws2.z = pk2(q1.x, q1.y); ws2.w = pk2(q1.z, q1.w);
                        *(v4u*)(xs + off + 128 * bj) = ws2;
                    }
                }
                if (!OUT_F32) { ss += __shfl_xor(ss, 16); ss += __shfl_xor(ss, 32); if (fq == 0) hs[rowl * 4 + wc] = ss; }
            }
            asm volatile("" ::: "memory");
        }
        if (!OUT_F32) {
            asm volatile("s_waitcnt lgkmcnt(0)" ::: "memory"); __builtin_amdgcn_s_barrier(); asm volatile("" ::: "memory");
            const int tid = threadIdx.x;
            if (tid < 256) { const f32x4 p = *(const f32x4*)(hs + tid * 4); ssq[(size_t)u.pn * TT + u.pm * 256 + tid] = ((p.x + p.y) + p.z) + p.w; }
        }
    }
};
struct EpiScaleBias {
    static constexpr bool PERM = true;
    bf16* O; int ldc; const float* ssq; int np; const float* bias; int bias_bstride;
    __device__ __forceinline__ void operator()(const f32x4 (&acc)[2][2][4][2], const Unit& u, int wr, int wc, int fr, int fq) const {
        const int b = (u.pm * 256) / SEQ;
        const int col0 = u.pn * 256 + wc * 32 + 8 * fq;
        f32x4 bv[2][2];
#pragma unroll
        for (int bj = 0; bj < 2; ++bj)
#pragma unroll
            for (int n = 0; n < 2; ++n) bv[bj][n] = *(const f32x4*)(bias + (size_t)b * bias_bstride + col0 + 128 * bj + 4 * n);
#pragma unroll
        for (int ai = 0; ai < 2; ++ai)
#pragma unroll
            for (int m = 0; m < 4; ++m) {
                const int row = u.pm * 256 + ai * 128 + wr * 64 + m * 16 + fr;
                const float rs = row_rs(ssq, np, row);
                bf16* rowp = O + (size_t)row * ldc + col0;
#pragma unroll
                for (int bj = 0; bj < 2; ++bj) { const f32x4 v0 = acc[ai][bj][m][0] * rs + bv[bj][0], v1 = acc[ai][bj][m][1] * rs + bv[bj][1];
                    v4u w; w.x = pk2(v0.x, v0.y); w.y = pk2(v0.z, v0.w); w.z = pk2(v1.x, v1.y); w.w = pk2(v1.z, v1.w);
                    *(v4u*)(rowp + 128 * bj) = w; }
            }
    }
};
__device__ __forceinline__ float gelu_as(float v) {
    const float av = fabsf(v), t = __builtin_amdgcn_rcpf(av * 0.2316418882f + 1.0f);
    float q = t * 0.5307027145f + (-0.7265760135f); q = q * t + 0.7107068705f; q = q * t + (-0.142248368f); q = q * t + 0.127414796f; q = q * t;
    const float e = __builtin_amdgcn_exp2f((v * v) * (-0.72134752044f));
    const float m = v * (q * e);
    return v < 0.f ? m : v - m;
}
template <int CTRL> __device__ __forceinline__ float dpp_f(float old, float src) {
    return __builtin_bit_cast(float, __builtin_amdgcn_update_dpp(__builtin_bit_cast(int, old), __builtin_bit_cast(int, src), CTRL, 0xf, 0xf, false));
}
struct EpiUpGlu {
    static constexpr bool PERM = true;
    bf16* act; const float* ssq; int np; const float* bias; const float* cw; const float* cb; float* Hg; float* Ha; float* hl;
    __device__ __forceinline__ void operator()(f32x4 (&acc)[2][2][4][2], const Unit& u, int wr, int wc, int fr, int fq) const {
        const int b = (u.pm * 256) / SEQ;
        const int j0 = u.pn * 128 + wc * 32 + 8 * fq;
        {
            f32x4 ba[2], bg[2];
#pragma unroll
            for (int n = 0; n < 2; ++n) { ba[n] = *(const f32x4*)(bias + (size_t)b * 5632 + j0 + 4 * n); bg[n] = *(const f32x4*)(bias + (size_t)b * 5632 + FF + j0 + 4 * n); }
#pragma unroll
            for (int ai = 0; ai < 2; ++ai)
#pragma unroll
                for (int m = 0; m < 4; ++m) { const int row = u.pm * 256 + ai * 128 + wr * 64 + m * 16 + fr; const float rs = row_rs(ssq, np, row);
#pragma unroll
                    for (int n = 0; n < 2; ++n) { acc[ai][0][m][n] = acc[ai][0][m][n] * rs + ba[n]; acc[ai][1][m][n] = acc[ai][1][m][n] * rs + bg[n]; }
                    if (m == 3) asm volatile("" ::: "memory"); }
        }
#pragma unroll
        for (int ai = 0; ai < 2; ++ai) { float* hp = hl + ((2 * ai + wr) * 2) * 128 + wc * 32 + 8 * fq;
            if (fr == 0) { *(f32x4*)(hp) = acc[ai][1][0][0]; *(f32x4*)(hp + 4) = acc[ai][1][0][1]; }
            if (fr == 15) { *(f32x4*)(hp + 128) = acc[ai][1][3][0]; *(f32x4*)(hp + 132) = acc[ai][1][3][1]; } }
        asm volatile("s_waitcnt lgkmcnt(0)" ::: "memory"); __builtin_amdgcn_s_barrier(); asm volatile("" ::: "memory");
        if (wr == 0 && fr < 2) { float* p = Hg + ((size_t)u.pm * 4 + fr) * FF + j0; *(f32x4*)p = acc[0][1][0][0]; *(f32x4*)(p + 4) = acc[0][1][0][1];
            if (fr == 0) { float* q = Ha + ((size_t)u.pm * 2) * FF + j0; *(f32x4*)q = acc[0][0][0][0]; *(f32x4*)(q + 4) = acc[0][0][0][1]; } }
        if (wr == 1 && fr >= 14) { float* p = Hg + ((size_t)u.pm * 4 + 2 + (fr - 14)) * FF + j0; *(f32x4*)p = acc[1][1][3][0]; *(f32x4*)(p + 4) = acc[1][1][3][1];
            if (fr == 15) { float* q = Ha + ((size_t)u.pm * 2 + 1) * FF + j0; *(f32x4*)q = acc[1][0][3][0]; *(f32x4*)(q + 4) = acc[1][0][3][1]; } }
#pragma unroll
        for (int n = 0; n < 2; ++n) {
            const f32x4 w0 = *(const f32x4*)(cw + j0 + 4 * n), w1 = *(const f32x4*)(cw + FF + j0 + 4 * n), w2 = *(const f32x4*)(cw + 2 * FF + j0 + 4 * n), cbv = *(const f32x4*)(cb + j0 + 4 * n);
#pragma unroll
            for (int ai = 0; ai < 2; ++ai) {
                const int gi = 2 * ai + wr;
                const f32x4 uph = *(const f32x4*)(hl + (((gi + 3) & 3) * 2 + 1) * 128 + wc * 32 + 8 * fq + 4 * n);
                const f32x4 dnh = *(const f32x4*)(hl + (((gi + 1) & 3) * 2) * 128 + wc * 32 + 8 * fq + 4 * n);
#pragma unroll
                for (int m = 0; m < 4; ++m) {
                    const int rowl = ai * 128 + wr * 64 + m * 16 + fr;
                    f32x4 r;
#pragma unroll
                    for (int e = 0; e < 4; ++e) {
                        const float g = acc[ai][1][m][n][e];
                        const float pu = (m > 0) ? dpp_f<0x121>(g, acc[ai][1][m > 0 ? m - 1 : 0][n][e]) : uph[e];
                        const float up = dpp_f<0x111>(pu, g);
                        const float pd = (m < 3) ? dpp_f<0x12f>(g, acc[ai][1][m < 3 ? m + 1 : 3][n][e]) : dnh[e];
                        const float dn = dpp_f<0x101>(pd, g);
                        const float cv = w0[e] * up + w1[e] * g + w2[e] * dn + cbv[e];
                        r[e] = acc[ai][0][m][n][e] * gelu_as(cv);
                    }
                    if (rowl != 0 && rowl != 255) { v2u w; w.x = pk2(r.x, r.y); w.y = pk2(r.z, r.w); *(v2u*)(act + (size_t)(u.pm * 256 + rowl) * FF + j0 + 4 * n) = w; }
                }
            }
        }
        asm volatile("s_waitcnt lgkmcnt(0)" ::: "memory"); __builtin_amdgcn_s_barrier(); asm volatile("" ::: "memory");
    }
};
__device__ __forceinline__ void glu_fix_phase(Frame& F, const float* cw, const float* cb) {
    const float* Hg = (const float*)(F.ws + WS_HG); const float* Ha = (const float*)(F.ws + WS_HA); bf16* act = (bf16*)(F.ws + WS_AG);
    const int total = (TT / 256) * 2 * FF;
    for (int e = F.vcu * 512 + F.tid; e < total; e += F.G * 512) {
        const int j = e % FF, which = (e / FF) & 1, pm = e / (2 * FF);
        const int t = pm * 256 + (which ? 255 : 0), tl = t % SEQ;
        float gm, g0, gp;
        if (which == 0) { gm = (tl == 0) ? 0.f : Hg[((size_t)(pm - 1) * 4 + 3) * FF + j]; g0 = Hg[((size_t)pm * 4 + 0) * FF + j]; gp = Hg[((size_t)pm * 4 + 1) * FF + j]; }
        else { gm = Hg[((size_t)pm * 4 + 2) * FF + j]; g0 = Hg[((size_t)pm * 4 + 3) * FF + j]; gp = (tl == SEQ - 1) ? 0.f : Hg[((size_t)(pm + 1) * 4 + 0) * FF + j]; }
        const float a = Ha[((size_t)pm * 2 + which) * FF + j];
        const float cv = cw[j] * gm + cw[FF + j] * g0 + cw[2 * FF + j] * gp + cb[j];
        act[(size_t)t * FF + j] = (bf16)f2bf(a * gelu_as(cv));
    }
}
struct EpiNull {
    static constexpr bool PERM = true;
    float* sink;
    __device__ __forceinline__ void operator()(const f32x4 (&acc)[2][2][4][2], const Unit& u, int wr, int wc, int fr, int fq) const {
        f32x4 s = {0.f, 0.f, 0.f, 0.f};
#pragma unroll
        for (int ai = 0; ai < 2; ++ai)
#pragma unroll
            for (int bj = 0; bj < 2; ++bj)
#pragma unroll
                for (int m = 0; m < 4; ++m)
#pragma unroll
                    for (int n = 0; n < 2; ++n) s += acc[ai][bj][m][n];
        if (u.pm == 100000) *(f32x4*)(sink + fr) = s;
    }
};
struct EpiInT {
    static constexpr bool PERM = true;
    bf16* UT; const float* ssq; int np; const float* bias;
    __device__ __forceinline__ void operator()(const f32x4 (&acc)[2][2][4][2], const Unit& u, int wr, int wc, int fr, int fq) const {
        const int b = (u.pm * 256) / SEQ;
        const int col0 = u.pn * 256 + wc * 32 + 8 * fq;
        const int odd = fr & 1;
        f32x4 bv[2][2];
#pragma unroll
        for (int bj = 0; bj < 2; ++bj)
#pragma unroll
            for (int n = 0; n < 2; ++n) bv[bj][n] = *(const f32x4*)(bias + (size_t)b * 3072 + col0 + 128 * bj + 4 * n);
#pragma unroll
        for (int ai = 0; ai < 2; ++ai)
#pragma unroll
            for (int m = 0; m < 4; ++m) {
                const int row = u.pm * 256 + ai * 128 + wr * 64 + m * 16 + fr;
                const int t = row - b * SEQ;
                const float rs = row_rs(ssq, np, row);
#pragma unroll
                for (int bj = 0; bj < 2; ++bj)
#pragma unroll
                    for (int n = 0; n < 2; ++n) { const f32x4 v = acc[ai][bj][m][n] * rs + bv[bj][n];
                        const unsigned w01 = pk2(v.x, v.y), w23 = pk2(v.z, v.w);
                        const unsigned p01 = (unsigned)__shfl_xor((int)w01, 1), p23 = (unsigned)__shfl_xor((int)w23, 1);
                        const unsigned o0 = odd ? ((w01 & 0xffff0000u) | (p01 >> 16)) : ((p01 << 16) | (w01 & 0xffffu));
                        const unsigned o1 = odd ? ((w23 & 0xffff0000u) | (p23 >> 16)) : ((p23 << 16) | (w23 & 0xffffu));
                        bf16* p = UT + ((size_t)b * 3072 + col0 + 128 * bj + 4 * n + odd) * SEQ + (t & ~1);
                        *(unsigned*)p = o0; *(unsigned*)(p + 2 * (size_t)SEQ) = o1; }
            }
    }
};

typedef short bf16x8 __attribute__((ext_vector_type(8)));
typedef float f32x16 __attribute__((ext_vector_type(16)));
typedef short s16x4 __attribute__((ext_vector_type(4)));
__device__ __forceinline__ unsigned cvtpk(float lo, float hi) { typedef float f2 __attribute__((ext_vector_type(2))); typedef __bf16 b2 __attribute__((ext_vector_type(2)));
    f2 v = {lo, hi}; b2 r = __builtin_convertvector(v, b2); return __builtin_bit_cast(unsigned, r); }
constexpr int BT_OFF = 64, BT_HEAD = 15 * 31;
__device__ __forceinline__ void attn_mfma_phase(Frame& F) {
    const bf16* Q = (const bf16*)(F.ws + WS_Q); const bf16* Kb = (const bf16*)(F.ws + WS_K); const bf16* VT = (const bf16*)(F.ws + WS_V);
    const bf16* Kc = (const bf16*)(F.ws + WS_KC); const bf16* VcT = (const bf16*)(F.ws + WS_VC);
    bf16* O = (bf16*)(F.ws + WS_O);
    const float* rpb = F.in[11];
    float* bt = (float*)F.lds;
    for (int e = F.tid; e < NH * BT_HEAD; e += 512) bt[BT_OFF + e] = rpb[e] * 1.4426950408889634f;
    __syncthreads();
    const int lane = F.lane, q = lane & 31, hi = lane >> 5;
    const int hf = F.wave & 1, roff = F.wave >> 1;
    for (int g = F.vcu; g < NB * (GROWS / 4) * NH; g += F.G) {
        const int h = g & 15, rg = (g >> 4) & 31, b = g >> 9;
        const int r = rg * 4 + roff;
        const int r0 = min(max(r - WH / 2, 0), GROWS - WH), c = 32 * hf + q, c0 = min(max(c - WW / 2, 0), GW - WW);
        const size_t tok = (size_t)b * SEQ + r * GW + c;
        bf16x8 qf[4];
#pragma unroll
        for (int s4 = 0; s4 < 4; ++s4) qf[s4] = *(const bf16x8*)(Q + tok * DM + h * HD + 16 * s4 + 8 * hi);
        f32x16 o0 = {0.f, 0.f, 0.f, 0.f, 0.f, 0.f, 0.f, 0.f, 0.f, 0.f, 0.f, 0.f, 0.f, 0.f, 0.f, 0.f}, o1 = o0;
        float lsum = 0.f;
        const int lo = c0 - c + (WW - 1);
#define ATT_LOAD(i, kf, va) do { \
            const bf16* kp_; const bf16* vp_; int sstr_; \
            if ((i) < 12) { const int rp_ = (i) / 3, cb_ = (i) % 3 + hf, krow_ = r0 + 2 * rp_; \
                kp_ = Kb + ((((size_t)(b * NH + h) * (SEQ / 16) + (krow_ + (q >> 4)) * 4 + cb_) * 8 + hi) * 16 + (q & 15)) * 8; \
                vp_ = VT + (((size_t)(b * NH + h) * (SEQ / 16) + krow_ * 4 + cb_) * 64 + q) * 16 + 8 * hi; sstr_ = 4 * 64 * 16; } \
            else { const int j_ = (i) - 12; \
                kp_ = Kc + ((((size_t)(b * NH + h) * (CTXL / 16) + 2 * j_ + (q >> 4)) * 8 + hi) * 16 + (q & 15)) * 8; \
                vp_ = VcT + (((size_t)(b * NH + h) * (CTXL / 16) + 2 * j_) * 64 + q) * 16 + 8 * hi; sstr_ = 64 * 16; } \
            _Pragma("unroll") for (int s4 = 0; s4 < 4; ++s4) kf[s4] = *(const bf16x8*)(kp_ + s4 * (2 * 16 * 8)); \
            _Pragma("unroll") for (int dh = 0; dh < 2; ++dh) _Pragma("unroll") for (int s2 = 0; s2 < 2; ++s2) { const bf16* v_ = vp_ + dh * (32 * 16) + s2 * sstr_; \
                va[dh][s2] = *(const bf16x8*)v_; } } while (0)
#define ATT_COMPUTE(i, kf, va) do { \
            f32x16 sacc = {0.f, 0.f, 0.f, 0.f, 0.f, 0.f, 0.f, 0.f, 0.f, 0.f, 0.f, 0.f, 0.f, 0.f, 0.f, 0.f}; \
            _Pragma("unroll") for (int s4 = 0; s4 < 4; ++s4) sacc = __builtin_amdgcn_mfma_f32_32x32x16_bf16(kf[s4], qf[s4], sacc, 0, 0, 0); \
            float p[16]; \
            if ((i) < 12) { const int rp_ = (i) / 3, cb_ = (i) % 3 + hf, krow_ = r0 + 2 * rp_; \
                const int dcb = cb_ * 16 + 4 * hi - c + (WW - 1), dcl = dcb - lo; \
                const float* btp = bt + BT_OFF + h * BT_HEAD + (krow_ - r + (WH - 1)) * 31 + dcb; \
                _Pragma("unroll") for (int rr = 0; rr < 16; ++rr) { const int kc = (rr & 3) + 8 * ((rr >> 2) & 1); \
                    const float e_ = __builtin_amdgcn_exp2f(sacc[rr] + btp[(rr >> 3) * 31 + kc]); \
                    p[rr] = ((unsigned)(dcl + kc) < (unsigned)WW) ? e_ : 0.f; lsum += p[rr]; } } \
            else { _Pragma("unroll") for (int rr = 0; rr < 16; ++rr) { p[rr] = __builtin_amdgcn_exp2f(sacc[rr]); lsum += p[rr]; } } \
            unsigned pw[8]; \
            _Pragma("unroll") for (int ii = 0; ii < 8; ++ii) pw[ii] = cvtpk(p[2 * ii], p[2 * ii + 1]); \
            _Pragma("unroll") for (int s2 = 0; s2 < 2; ++s2) { \
                const bf16x8 pb = __builtin_bit_cast(bf16x8, (v4u){pw[4 * s2], pw[4 * s2 + 1], pw[4 * s2 + 2], pw[4 * s2 + 3]}); \
                o0 = __builtin_amdgcn_mfma_f32_32x32x16_bf16(va[0][s2], pb, o0, 0, 0, 0); \
                o1 = __builtin_amdgcn_mfma_f32_32x32x16_bf16(va[1][s2], pb, o1, 0, 0, 0); } } while (0)
        bf16x8 kfA[4], kfB[4], vaA[2][2], vaB[2][2];
        ATT_LOAD(0, kfA, vaA);
#pragma unroll 1
        for (int i = 0; i < 20; i += 2) {
            ATT_LOAD(i + 1, kfB, vaB);
            ATT_COMPUTE(i, kfA, vaA);
            { const int i2 = (i + 2 < 20) ? i + 2 : 19; ATT_LOAD(i2, kfA, vaA); }
            ATT_COMPUTE(i + 1, kfB, vaB);
        }
#undef ATT_LOAD
#undef ATT_COMPUTE
        lsum += __shfl_xor(lsum, 32);
        const float inv = 1.0f / lsum;
        bf16* op = O + tok * DM + h * HD + 4 * hi;
#pragma unroll
        for (int gq = 0; gq < 4; ++gq) {
            v2u w0; w0.x = pk2(o0[4 * gq] * inv, o0[4 * gq + 1] * inv); w0.y = pk2(o0[4 * gq + 2] * inv, o0[4 * gq + 3] * inv);
            v2u w1; w1.x = pk2(o1[4 * gq] * inv, o1[4 * gq + 1] * inv); w1.y = pk2(o1[4 * gq + 2] * inv, o1[4 * gq + 3] * inv);
            *(v2u*)(op + 8 * gq) = w0; *(v2u*)(op + 32 + 8 * gq) = w1;
        }
    }
    __syncthreads();
}

__device__ __forceinline__ void convglu_phase(Frame& F, const float* cw, const float* cb) {
    bf16* ag = (bf16*)(F.ws + WS_AG);
    const long nvec = (long)TT * (FF / 8);
    for (long e = (long)F.vcu * 512 + F.tid; e < nvec; e += (long)F.G * 512) {
        const int t = (int)(e / (FF / 8)), j0 = (int)(e % (FF / 8)) * 8;
        const int tl = t % SEQ;
        const bf16* rowp = ag + (size_t)t * (2 * FF);
        const v4u a = *(const v4u*)(rowp + j0);
        const v4u g0 = *(const v4u*)(rowp + FF + j0);
        v4u gm = (v4u){0u, 0u, 0u, 0u}, gp = (v4u){0u, 0u, 0u, 0u};
        if (tl > 0) gm = *(const v4u*)(rowp - 2 * FF + FF + j0);
        if (tl < SEQ - 1) gp = *(const v4u*)(rowp + 2 * FF + FF + j0);
        float av[8], g0v[8], gmv[8], gpv[8];
        av[0] = bflo(a.x); av[1] = bfhi(a.x); av[2] = bflo(a.y); av[3] = bfhi(a.y); av[4] = bflo(a.z); av[5] = bfhi(a.z); av[6] = bflo(a.w); av[7] = bfhi(a.w);
        g0v[0] = bflo(g0.x); g0v[1] = bfhi(g0.x); g0v[2] = bflo(g0.y); g0v[3] = bfhi(g0.y); g0v[4] = bflo(g0.z); g0v[5] = bfhi(g0.z); g0v[6] = bflo(g0.w); g0v[7] = bfhi(g0.w);
        gmv[0] = bflo(gm.x); gmv[1] = bfhi(gm.x); gmv[2] = bflo(gm.y); gmv[3] = bfhi(gm.y); gmv[4] = bflo(gm.z); gmv[5] = bfhi(gm.z); gmv[6] = bflo(gm.w); gmv[7] = bfhi(gm.w);
        gpv[0] = bflo(gp.x); gpv[1] = bfhi(gp.x); gpv[2] = bflo(gp.y); gpv[3] = bfhi(gp.y); gpv[4] = bflo(gp.z); gpv[5] = bfhi(gp.z); gpv[6] = bflo(gp.w); gpv[7] = bfhi(gp.w);
        float r[8];
#pragma unroll
        for (int i = 0; i < 8; ++i) { const int j = j0 + i; const float cv = cw[j] * gmv[i] + cw[FF + j] * g0v[i] + cw[2 * FF + j] * gpv[i] + cb[j]; r[i] = av[i] * gelu_f(cv); }
        v4u w; w.x = pk2(r[0], r[1]); w.y = pk2(r[2], r[3]); w.z = pk2(r[4], r[5]); w.w = pk2(r[6], r[7]);
        *(v4u*)(ag + (size_t)t * (2 * FF) + j0) = w;
    }
}

__device__ __forceinline__ void filtgen_phase(Frame& F) {
    const float* const* in = F.in;
    const float *w1 = in[25], *b1 = in[26], *w2 = in[27], *b2 = in[28], *w3 = in[29], *b3 = in[30], *wout = in[31], *freq = in[32];
    float* hT = (float*)(F.ws + WS_HT); float* fsqp = (float*)(F.ws + WS_FSQP);
    LAS float* zf = (LAS float*)(F.lds);
    LAS float* ha = zf + 16 * 36;
    LAS float* hb = ha + 16 * 64;
    const int tid = F.tid;
    for (int item = F.vcu; item < SEQ / 16; item += F.G) {
        const int l0 = item * 16;
        __syncthreads();
        for (int e = tid; e < 16 * 33; e += 512) {
            const int p = e / 33, i = e % 33, l = l0 + p;
            float v;
            if (i == 0) v = (float)l / 8191.0f;
            else { const int bi = (i - 1) & 15; const float band = 1e-4f + (float)bi * ((15.0f - 1e-4f) / 15.0f);
                const float w = (float)(2.0 * 3.14159265358979323846 / 8192.0) * (float)l; const float arg = band * w;
                v = (i <= 16) ? cosf(arg) : -sinf(arg); }
            zf[p * 36 + i] = v;
        }
        __syncthreads();
        for (int e = tid; e < 16 * 64; e += 512) { const int p = e >> 6, j = e & 63; float a = b1[j];
            for (int i = 0; i < 33; ++i) a += zf[p * 36 + i] * w1[i * 64 + j];
            ha[p * 64 + j] = sinf(freq[j] * a); }
        __syncthreads();
        for (int e = tid; e < 16 * 64; e += 512) { const int p = e >> 6, j = e & 63; float a = b2[j];
            for (int i = 0; i < 64; ++i) a += ha[p * 64 + i] * w2[i * 64 + j];
            hb[p * 64 + j] = sinf(freq[j] * a); }
        __syncthreads();
        for (int e = tid; e < 16 * 64; e += 512) { const int p = e >> 6, j = e & 63; float a = b3[j];
            for (int i = 0; i < 64; ++i) a += hb[p * 64 + i] * w3[i * 64 + j];
            ha[p * 64 + j] = sinf(freq[j] * a); }
        __syncthreads();
        float sq[2] = {0.f, 0.f};
        {
            float acc[4][16];
#pragma unroll
            for (int q = 0; q < 4; ++q)
#pragma unroll
                for (int p = 0; p < 16; ++p) acc[q][p] = 0.f;
#pragma unroll 2
            for (int j = 0; j < 64; ++j) {
                float w[4];
#pragma unroll
                for (int q = 0; q < 4; ++q) w[q] = wout[j * 2048 + tid + 512 * q];
#pragma unroll
                for (int p = 0; p < 16; ++p) { const float hv = ha[p * 64 + j];
#pragma unroll
                    for (int q = 0; q < 4; ++q) acc[q][p] += hv * w[q]; }
            }
            const float la = -15.350567286626973f, lb = -3.0701134573253946f;
#pragma unroll
            for (int q = 0; q < 4; ++q) {
                const int n = tid + 512 * q, dir = n >> 10, c = n & 1023;
                const float delta = fabsf(la + (float)c * ((lb - la) / 1023.0f));
                float* op = hT + ((size_t)dir * 1024 + c) * SEQ + l0;
                f32x4 ov[4];
#pragma unroll
                for (int p = 0; p < 16; ++p) { const float tpos = (float)(l0 + p) / 8191.0f; const float v = acc[q][p] * expf(-tpos * delta); ov[p >> 2][p & 3] = v; sq[q & 1] += v * v; }
#pragma unroll
                for (int p4 = 0; p4 < 4; ++p4) *(f32x4*)(op + 4 * p4) = ov[p4];
            }
        }
        fsqp[(size_t)item * 1024 + tid] = sq[0]; fsqp[(size_t)item * 1024 + tid + 512] = sq[1];
    }
    __syncthreads();
}

__device__ __forceinline__ void filtfft_phase(Frame& F) {
    const float* hT = (const float*)(F.ws + WS_HT); const float* fsqp = (const float*)(F.ws + WS_FSQP);
    const cf* TWM = (const cf*)(F.ws + SM_TWM); const cf* TWN = (const cf*)(F.ws + SM_TWN);
    cf* Fsp = (cf*)(F.ws + WS_F);
    cf* a = (cf*)F.lds;
    float* red = (float*)(F.lds + 80 * 1024);
    cf* tw1 = (cf*)(F.lds + 139264); cf* tw64 = tw1 + 512; cf* tw8 = tw64 + 64;
    for (int e = F.tid; e < 584; e += 512) tw1[e] = e < 512 ? TWM[e] : (e < 576 ? TWM[16 * (e - 512)] : TWM[128 * (e - 576)]);
    __syncthreads();
    for (int c = F.vcu; c < DM; c += F.G) {
        int tid = F.tid; FC_OPAQUE(tid);
        __syncthreads();
        red[tid] = fsqp[(size_t)tid * 1024 + c];
        __syncthreads();
        for (int st = 256; st > 0; st >>= 1) { if (tid < st) red[tid] += red[tid + st]; __syncthreads(); }
        const float nrm = 1.0f / sqrtf(red[0] + EPS);
        const float* hf = hT + (size_t)c * SEQ; const float* hb = hT + ((size_t)1024 + c) * SEQ;
#pragma unroll 1
        for (int path = 0; path < 2; ++path) {
            cf v[16];
            FC_OPAQUE(tid);
#pragma unroll
            for (int r = 0; r < 16; ++r) { const int n = tid + 512 * r; const float fa = hf[n] * nrm, fb = (n == 0) ? 0.f : hb[SEQ - n] * nrm;
                if (path == 0) { v[r].x = fa + fb; v[r].y = 0.f; } else { cf t; t.x = fa - fb; t.y = 0.f; v[r] = cmul(t, TWN[n]); }
                if ((r & 3) == 3) asm volatile("" ::: "memory"); }
            fwd_pass1(v, tid, a, tw1);
            __syncthreads();
            fwd_pass8(tid, a, tw64, 64, 6);
            __syncthreads();
            fwd_pass8(tid, a, tw8, 8, 3);
            __syncthreads();
            mid_pass(tid, a, (const cf*)nullptr, Fsp + ((size_t)c * 2 + path) * FC_M, 1.0f / 16384.0f);
            __syncthreads();
        }
    }
}

__device__ __forceinline__ void conv3_8(const v4u raw, float prev, float next, float w0, float w1, float w2, float bb, float* out) {
    float x[10]; x[0] = prev; x[9] = next;
    x[1] = bflo(raw.x); x[2] = bfhi(raw.x); x[3] = bflo(raw.y); x[4] = bfhi(raw.y); x[5] = bflo(raw.z); x[6] = bfhi(raw.z); x[7] = bflo(raw.w); x[8] = bfhi(raw.w);
#pragma unroll
    for (int i = 0; i < 8; ++i) out[i] = w0 * x[i] + w1 * x[i + 1] + w2 * x[i + 2] + bb;
}
__device__ __forceinline__ void hyena_fft_phase(Frame& F) {
    const float* const* in = F.in;
    const float* sw = in[23]; const float* sb = in[24]; const float* dbias = in[33];
    bf16* UT = (bf16*)(F.ws + WS_UT);
    const cf* TWM = (const cf*)(F.ws + SM_TWM); const cf* TWN = (const cf*)(F.ws + SM_TWN);
    const cf* Fsp = (const cf*)(F.ws + WS_F);
    cf* a = (cf*)F.lds;
    cf* tw1 = (cf*)(F.lds + 139264); cf* tw64 = tw1 + 512; cf* tw8 = tw64 + 64;
    for (int e = F.tid; e < 584; e += 512) tw1[e] = e < 512 ? TWM[e] : (e < 576 ? TWM[16 * (e - 512)] : TWM[128 * (e - 576)]);
    __syncthreads();
    for (int unit = F.vcu; unit < 2 * DM; unit += F.G) {
        const int c = unit >> 1, b0 = (unit & 1) * 2;
        int tid = F.tid; FC_OPAQUE(tid);
        __syncthreads();
        {
            const float w10 = sw[1024 + c], w11 = sw[3072 + 1024 + c], w12 = sw[6144 + 1024 + c], bb1 = sb[1024 + c];
            const float wv0 = sw[2048 + c], wv1 = sw[3072 + 2048 + c], wv2 = sw[6144 + 2048 + c], bbv = sb[2048 + c];
#pragma unroll 1
            for (int h = 0; h < 2; ++h) {
                FC_OPAQUE(tid);
                const int t0 = (tid + 512 * h) * 8;
                float z[2][8];
#pragma unroll
                for (int bb = 0; bb < 2; ++bb) {
                    asm volatile("" ::: "memory");
                    const bf16* x1r = UT + ((size_t)(b0 + bb) * 3072 + 1024 + c) * SEQ;
                    const bf16* vr = UT + ((size_t)(b0 + bb) * 3072 + 2048 + c) * SEQ;
                    const v4u x1raw = *(const v4u*)(x1r + t0), vraw = *(const v4u*)(vr + t0);
                    const float x1p = t0 > 0 ? bf2f(x1r[t0 - 1]) : 0.f, x1n = t0 + 8 < SEQ ? bf2f(x1r[t0 + 8]) : 0.f;
                    const float vp = t0 > 0 ? bf2f(vr[t0 - 1]) : 0.f, vn = t0 + 8 < SEQ ? bf2f(vr[t0 + 8]) : 0.f;
                    float x1c[8], vc[8];
                    conv3_8(x1raw, x1p, x1n, w10, w11, w12, bb1, x1c);
                    conv3_8(vraw, vp, vn, wv0, wv1, wv2, bbv, vc);
#pragma unroll
                    for (int i = 0; i < 8; ++i) z[bb][i] = x1c[i] * vc[i];
                }
#pragma unroll
                for (int i = 0; i < 8; ++i) { cf t; t.x = z[0][i]; t.y = z[1][i]; a[FC_PIDX(t0 + i)] = t; }
            }
        }
        __syncthreads();
        cf wreg[16];
        FC_OPAQUE(tid);
        { const int pt = FC_PIDX(tid);
#pragma unroll
        for (int r = 0; r < 16; ++r) wreg[r] = a[pt + 576 * r]; }
        cf* e2 = (cf*)(F.lds + 73728);
#pragma unroll 1
        for (int path = 0; path < 2; ++path) {
            cf v[16];
            if (path == 0) {
#pragma unroll
                for (int r = 0; r < 16; ++r) v[r] = wreg[r];
            } else {
                FC_OPAQUE(tid);
#pragma unroll
                for (int r = 0; r < 16; ++r) { v[r] = cmul(wreg[r], TWN[tid + 512 * r]); if ((r & 3) == 3) asm volatile("" ::: "memory"); }
            }
            cf freg[16];
            { const cf* Fp = Fsp + ((size_t)c * 2 + path) * FC_M;
#pragma unroll
              for (int h = 0; h < 2; ++h) { const f32x4* fp4 = (const f32x4*)(Fp + (size_t)(tid + 512 * h) * 8);
#pragma unroll
                for (int r2 = 0; r2 < 4; ++r2) { const f32x4 w = fp4[r2]; freg[h * 8 + 2 * r2].x = w[0]; freg[h * 8 + 2 * r2].y = w[1];
                    freg[h * 8 + 2 * r2 + 1].x = w[2]; freg[h * 8 + 2 * r2 + 1].y = w[3]; } } }
            fwd_pass1(v, tid, a, tw1);
            __syncthreads();
            fwd_pass8(tid, a, tw64, 64, 6);
            __syncthreads();
            fwd_pass8(tid, a, tw8, 8, 3);
            __syncthreads();
#ifdef NO_FREG
            mid_pass(tid, a, Fsp + ((size_t)c * 2 + path) * FC_M, (cf*)nullptr, 0.f);
#else
            mid_pass_reg(tid, a, freg);
#endif
            __syncthreads();
            inv_pass8(tid, a, tw8, 8, 3);
            __syncthreads();
            inv_pass8(tid, a, tw64, 64, 6);
            __syncthreads();
            inv_pass1(v, tid, a, tw1);
            if (path == 0) {
#pragma unroll
                for (int r = 0; r < 16; ++r) e2[tid + 512 * r] = v[r];
            } else {
                const float db = dbias[c];
                FC_OPAQUE(tid);
#pragma unroll
                for (int r = 0; r < 16; ++r) { const int n = tid + 512 * r;
                    const cf y = cadd(cconj(e2[n]), cmul(cconj(TWN[n]), cconj(v[r])));
                    cf o; o.x = y.x + wreg[r].x * db; o.y = y.y + wreg[r].y * db; a[FC_PIDX(n)] = o; if ((r & 3) == 3) asm volatile("" ::: "memory"); }
            }
        }
        __syncthreads();
        {
            const float w00 = sw[c], w01 = sw[3072 + c], w02 = sw[6144 + c], bb0 = sb[c];
#pragma unroll 1
            for (int h = 0; h < 2; ++h) {
                FC_OPAQUE(tid);
                const int t0 = (tid + 512 * h) * 8;
                cf val[8];
#pragma unroll
                for (int i = 0; i < 8; ++i) val[i] = a[FC_PIDX(t0 + i)];
#pragma unroll
                for (int bb = 0; bb < 2; ++bb) {
                    const bf16* x0r = UT + ((size_t)(b0 + bb) * 3072 + c) * SEQ;
                    const v4u raw = *(const v4u*)(x0r + t0);
                    const float xp = t0 > 0 ? bf2f(x0r[t0 - 1]) : 0.f, xn = t0 + 8 < SEQ ? bf2f(x0r[t0 + 8]) : 0.f;
                    float x0c[8]; conv3_8(raw, xp, xn, w00, w01, w02, bb0, x0c);
                    float p[8];
#pragma unroll
                    for (int i = 0; i < 8; ++i) p[i] = x0c[i] * (bb == 0 ? val[i].x : val[i].y);
                    v4u o; o.x = pk2(p[0], p[1]); o.y = pk2(p[2], p[3]); o.z = pk2(p[4], p[5]); o.w = pk2(p[6], p[7]);
                    *(v4u*)((bf16*)(F.ws + WS_XS) + ((size_t)(b0 + bb) * 1024 + c) * SEQ + t0) = o;
                }
            }
        }
    }
    __syncthreads();
}
__device__ __forceinline__ void transpose_p_phase(Frame& F) {
    const bf16* PT = (const bf16*)(F.ws + WS_XS); bf16* P = (bf16*)(F.ws + WS_P);
    LAS unsigned short* scr = (LAS unsigned short*)(F.lds + F.wave * 16384);
    const int gw = F.vcu * NWAVES + F.wave, NGW = F.G * NWAVES, lane = F.lane;
    const int ntile = NB * (DM / 64) * (SEQ / 64);
    for (int it = gw; it < ntile; it += NGW) {
        const int tb = it % (SEQ / 64), cb = (it / (SEQ / 64)) % (DM / 64), b = it / ((SEQ / 64) * (DM / 64));
        for (int rr = 0; rr < 64; ++rr) scr[rr * 66 + lane] = PT[((size_t)b * 1024 + cb * 64 + rr) * SEQ + tb * 64 + lane];
        LDS_WAIT(); asm volatile("" ::: "memory");
        for (int tt = 0; tt < 64; ++tt) P[((size_t)b * SEQ + tb * 64 + tt) * DM + cb * 64 + lane] = scr[lane * 66 + tt];
        LDS_WAIT(); asm volatile("" ::: "memory");
    }
}

constexpr int NPH = 17;
__global__ void __launch_bounds__(NWAVES * 64, 2) hybrid_fwd(Args args) {
    extern __shared__ __attribute__((aligned(16))) unsigned char lds[];
    Frame F;
    F.lds = (LAS unsigned char*)lds;
    F.tid = threadIdx.x; F.lane = F.tid & 63; F.wave = __builtin_amdgcn_readfirstlane(F.tid >> 6);
    F.G = gridDim.x; { const int bx = blockIdx.x; F.vcu = (F.G % 8 == 0) ? (bx % 8) * (F.G / 8) + bx / 8 : bx; }
    F.in = args.in; F.out = args.out; F.ws = args.ws;
    unsigned char* ws = args.ws;
    volatile LAS unsigned* MISC = (volatile LAS unsigned*)(F.lds + MISC_OFF);
    for (int u = F.tid; u < (LDS_BYTES - LDSCTL_OFF) / 4; u += NWAVES * 64) ((LAS unsigned*)(F.lds + LDSCTL_OFF))[u] = 0u;
    __syncthreads();
    XcdBarrier bar; bar.bar = (unsigned*)(ws + CT_BAR) + args.li * XCD_BAR_WORDS; bar.x = 0; bar.st = nullptr;
    const int lo = args.ph_lo, hi = args.ph_hi;
    if (hi - lo > 1) bar = xcd_barrier_post((unsigned*)(ws + CT_BAR) + args.li * XCD_BAR_WORDS, MISC + 8);
#ifndef EXP_PAIR
#define EXP_PAIR 0
#endif
#ifndef REP_MASK
#define REP_MASK 0
#endif
#define REPS(k) ((((REP_MASK) >> (k)) & 1) ? 2 : 1)
#ifndef PH_MASK
#define PH_MASK 0xFFFFFF
#endif
#define IN(k) ((((PH_MASK) >> (k)) & 1) && lo <= (k) && (k) < hi)
#define SEAM(k) do { if (IN(k) && IN((k) + 1)) xcd_barrier(bar); } while (0)
    const float* mods = (const float*)(ws + CT_MODS);
    const float* gnt = (const float*)(ws + SM_GN);
    float* ssqa = (float*)(ws + WS_SSQP);
    bf16* XS = (bf16*)(ws + WS_XS);

    if (IN(0)) { for (int rep = 0; rep < REPS(0); ++rep) phase0a(F); } SEAM(0);
    if (IN(1)) { for (int rep = 0; rep < REPS(1); ++rep) phase0b(F); } SEAM(1);
    if (IN(2)) for (int rep = 0; rep < REPS(2); ++rep) {
        { pg8::Gemm g{XS, (const bf16*)(ws + WS_WQKV), TT, DM, DM, DM}; pg8::StaticOrder S; S.init(TT, DM, F.G, (int)blockIdx.x);
          EpiQK<0> E{(bf16*)(ws + WS_Q), (const float*)(ws + SM_SSQ0), 1, (const float*)(ws + CT_BQKV), 3072, args.in[9], SEQ};
          pg8::gemm_phase<EpiQK<0>, pg8::StaticOrder, true, true>(F.lds, g, S, E); }
        { pg8::Gemm g{XS, (const bf16*)(ws + WS_WQKV) + (size_t)1024 * DM, TT, DM, DM, DM}; pg8::StaticOrder S; S.init(TT, DM, F.G, (int)blockIdx.x);
          EpiQK<1> E{(bf16*)(ws + WS_K), (const float*)(ws + SM_SSQ0), 1, (const float*)(ws + CT_BQKV), 3072, args.in[10], SEQ};
          pg8::gemm_phase<EpiQK<1>, pg8::StaticOrder, true, true>(F.lds, g, S, E); }
        { pg8::Gemm g{XS, (const bf16*)(ws + WS_WQKV) + (size_t)2048 * DM, TT, DM, DM, DM}; pg8::StaticOrder S; S.init(TT, DM, F.G, (int)blockIdx.x);
          EpiVT E{(bf16*)(ws + WS_V), (const float*)(ws + SM_SSQ0), 1, (const float*)(ws + CT_BQKV), 3072, SEQ};
          pg8::gemm_phase<EpiVT, pg8::StaticOrder, true, true>(F.lds, g, S, E); }
        { pg8::Gemm g{(const bf16*)(ws + WS_XSC), (const bf16*)(ws + WS_WQKV) + (size_t)1024 * DM, TC, DM, DM, DM}; pg8::StaticOrder S; S.init(TC, DM, F.G, (int)blockIdx.x);
          EpiQK<1> E{(bf16*)(ws + WS_KC), (const float*)(ws + SM_SSQC), 1, (const float*)(ws + CT_BQKV) + 4 * 3072, 0, args.in[10], CTXL};
          pg8::gemm_phase<EpiQK<1>, pg8::StaticOrder, true, true>(F.lds, g, S, E); }
        { pg8::Gemm g{(const bf16*)(ws + WS_XSC), (const bf16*)(ws + WS_WQKV) + (size_t)2048 * DM, TC, DM, DM, DM}; pg8::StaticOrder S; S.init(TC, DM, F.G, (int)blockIdx.x);
          EpiVT E{(bf16*)(ws + WS_VC), (const float*)(ws + SM_SSQC), 1, (const float*)(ws + CT_BQKV) + 4 * 3072, 0, CTXL};
          pg8::gemm_phase<EpiVT, pg8::StaticOrder, true, true>(F.lds, g, S, E); }
    } SEAM(2);
    if (IN(3)) { for (int rep = 0; rep < REPS(3); ++rep) attn_mfma_phase(F); } SEAM(3);
    if (IN(4)) for (int rep = 0; rep < REPS(4); ++rep) {
        pg8::Gemm g{(const bf16*)(ws + WS_O), (const bf16*)(ws + WS_WO), TT, DM, DM, DM}; pg8::StaticOrder S; S.init(TT, DM, F.G, (int)blockIdx.x);
        EpiRes<true, false> E{args.in[0], ws + WS_XB, mods + 2048, nullptr, gnt, XS, ssqa, (float*)(lds + RING_BYTES + 8192)};
        pg8::gemm_phase<EpiRes<true, false>, pg8::StaticOrder, true, true>(F.lds, g, S, E);
    } SEAM(4);
    if (IN(5)) for (int rep = 0; rep < REPS(5); ++rep) {
        pg8::Gemm g{XS, (const bf16*)(ws + WS_WUP0), TT, 2 * FF, DM, DM}; pg8::StaticOrder S; S.init(TT, 2 * FF, F.G, (int)blockIdx.x);
        EpiUpGlu E{(bf16*)(ws + WS_AG), ssqa, 4, (const float*)(ws + CT_BUP0), args.in[14], args.in[15], (float*)(ws + WS_HG), (float*)(ws + WS_HA), (float*)(lds + RING_BYTES)};
        pg8::gemm_phase<EpiUpGlu, pg8::StaticOrder, true, true>(F.lds, g, S, E);
    } SEAM(5);
    if (IN(6)) { for (int rep = 0; rep < REPS(6); ++rep) glu_fix_phase(F, args.in[14], args.in[15]); } SEAM(6);

    if (IN(7)) {
        pg8::Gemm g{(const bf16*)(ws + WS_AG), (const bf16*)(ws + WS_WDN0), TT, DM, FF, FF}; pg8::StaticOrder S; S.init(TT, DM, F.G, (int)blockIdx.x);
        EpiRes<false, false> E{ws + WS_XB, ws + WS_XB, mods + 5120, nullptr, gnt + 4096, XS, ssqa + 4 * TT, (float*)(lds + RING_BYTES + 8192)};
        pg8::gemm_phase<EpiRes<false, false>, pg8::StaticOrder, true, true>(F.lds, g, S, E);
    } SEAM(7);
    if (IN(8)) { for (int rep = 0; rep < REPS(8); ++rep) filtgen_phase(F); } SEAM(8);
    if (IN(9)) { for (int rep = 0; rep < REPS(9); ++rep) filtfft_phase(F); } SEAM(9);
    if (IN(10)) for (int rep = 0; rep < REPS(10); ++rep) {
        pg8::Gemm g{XS, (const bf16*)(ws + WS_WIN), TT, 3 * DM, DM, DM}; pg8::StaticOrder S; S.init(TT, 3 * DM, F.G, (int)blockIdx.x);
#ifdef EXP_P9
        EpiScaleBias E{(bf16*)(ws + WS_UT), 3 * DM, ssqa + 4 * TT, 4, (const float*)(ws + CT_BIN), 3072};
        pg8::gemm_phase<EpiScaleBias, pg8::StaticOrder, true, true>(F.lds, g, S, E);
#else
        EpiInT E{(bf16*)(ws + WS_UT), ssqa + 4 * TT, 4, (const float*)(ws + CT_BIN)};
        pg8::gemm_phase<EpiInT, pg8::StaticOrder, true, true>(F.lds, g, S, E);
#endif
    } SEAM(10);
    if (IN(11)) { for (int rep = 0; rep < REPS(11); ++rep) hyena_fft_phase(F); } SEAM(11);

    if (IN(12)) { for (int rep = 0; rep < REPS(12); ++rep) transpose_p_phase(F); } SEAM(12);
    if (IN(13)) {
        pg8::Gemm g{(const bf16*)(ws + WS_P), (const bf16*)(ws + WS_WOUT), TT, DM, DM, DM}; pg8::StaticOrder S; S.init(TT, DM, F.G, (int)blockIdx.x);
        EpiRes<false, false> E{ws + WS_XB, ws + WS_XB, mods + 5 * 6144 + 2048, args.in[35], gnt + 2 * 4096, XS, ssqa + 8 * TT, (float*)(lds + RING_BYTES + 8192)};
        pg8::gemm_phase<EpiRes<false, false>, pg8::StaticOrder, true, true>(F.lds, g, S, E);
    } SEAM(13);
    if (IN(14)) for (int rep = 0; rep < REPS(14); ++rep) {
        pg8::Gemm g{XS, (const bf16*)(ws + WS_WUP1), TT, 2 * FF, DM, DM}; pg8::StaticOrder S; S.init(TT, 2 * FF, F.G, (int)blockIdx.x);
        EpiUpGlu E{(bf16*)(ws + WS_AG), ssqa + 8 * TT, 4, (const float*)(ws + CT_BUP1), args.in[37], args.in[38], (float*)(ws + WS_HG), (float*)(ws + WS_HA), (float*)(lds + RING_BYTES)};
        pg8::gemm_phase<EpiUpGlu, pg8::StaticOrder, true, true>(F.lds, g, S, E);
    } SEAM(14);
    if (IN(15)) { glu_fix_phase(F, args.in[37], args.in[38]); } SEAM(15);
    if (IN(16)) {
        pg8::Gemm g{(const bf16*)(ws + WS_AG), (const bf16*)(ws + WS_WDN1), TT, DM, FF, FF}; pg8::StaticOrder S; S.init(TT, DM, F.G, (int)blockIdx.x);
        EpiRes<false, true> E{ws + WS_XB, args.out, mods + 5 * 6144 + 5120, nullptr, nullptr, nullptr, nullptr, nullptr};
        pg8::gemm_phase<EpiRes<false, true>, pg8::StaticOrder, true, true>(F.lds, g, S, E);
    }
#ifdef PROBE_NULL
    if (lo == 98) {
#if PROBE_NULL == 5
        pg8::Gemm g{XS, (const bf16*)(ws + WS_WUP0), TT, 2 * FF, DM, DM}; pg8::StaticOrder S; S.init(TT, 2 * FF, F.G, (int)blockIdx.x);
#elif PROBE_NULL == 4
        pg8::Gemm g{(const bf16*)(ws + WS_O), (const bf16*)(ws + WS_WO), TT, DM, DM, DM}; pg8::StaticOrder S; S.init(TT, DM, F.G, (int)blockIdx.x);
#elif PROBE_NULL == 7
        pg8::Gemm g{(const bf16*)(ws + WS_AG), (const bf16*)(ws + WS_WDN0), TT, DM, FF, FF}; pg8::StaticOrder S; S.init(TT, DM, F.G, (int)blockIdx.x);
#else
        pg8::Gemm g{XS, (const bf16*)(ws + WS_WQKV), TT, 3 * DM, DM, DM}; pg8::StaticOrder S; S.init(TT, 3 * DM, F.G, (int)blockIdx.x);
#endif
        EpiNull E{(float*)(ws + WS_FSQP)};
        pg8::gemm_phase<EpiNull, pg8::StaticOrder, true, true>(F.lds, g, S, E);
    }
#endif
#ifdef DUMP_SEL
    if (lo == 99) {
        float* o = args.out; const size_t n = (size_t)TT * DM;
        for (size_t e = (size_t)blockIdx.x * 512 + F.tid; e < n; e += (size_t)F.G * 512) {
            float v;
            if (DUMP_SEL == 1) { const float* h = (const float*)(ws + WS_HT); v = (e < (size_t)2 * 1024 * SEQ) ? h[e] : ((const float*)(ws + WS_FSQP))[e & 1023]; }
            else if (DUMP_SEL == 2) { const bf16* u = (const bf16*)(ws + WS_UT); v = bf2f(u[e]); }
            else if (DUMP_SEL == 3) { const bf16* u = (const bf16*)(ws + WS_UT); v = bf2f(u[e + (size_t)TT * DM]); }
            else if (DUMP_SEL == 4) { const bf16* u = (const bf16*)(ws + WS_UT); v = bf2f(u[e + (size_t)2 * TT * DM]); }
            else { const bf16* u = (const bf16*)(ws + WS_P); v = bf2f(u[e]); }
            o[e] = v;
        }
    }
#endif
#undef IN
#undef SEAM
}

extern "C" void kernel_launch(void* const* d_in, const int* in_sizes, int n_in, void* d_out, int out_size, void* d_ws, size_t ws_size, hipStream_t stream) {
    static int grid = 0;
    if (grid == 0) {
        if (n_in != 40 || out_size != TT * DM || ws_size < WS_END) { fprintf(stderr, "kernel_launch: unexpected shapes n_in %d out %d ws %zu\n", n_in, out_size, ws_size); grid = -1; return; }
        int dev = 0, cus = 0;
        if (hipGetDevice(&dev) != hipSuccess || hipDeviceGetAttribute(&cus, hipDeviceAttributeMultiprocessorCount, dev) != hipSuccess) { grid = -1; return; }
        if (hipFuncSetAttribute((const void*)hybrid_fwd, hipFuncAttributeMaxDynamicSharedMemorySize, LDS_BYTES) != hipSuccess) { fprintf(stderr, "kernel_launch: hipFuncSetAttribute failed\n"); grid = -1; return; }
        int per_cu = 0;
        if (hipOccupancyMaxActiveBlocksPerMultiprocessor(&per_cu, (const void*)hybrid_fwd, NWAVES * 64, LDS_BYTES) != hipSuccess || per_cu < 1) { fprintf(stderr, "kernel_launch: occupancy query says %d\n", per_cu); }
        (void)hipGetLastError();
        grid = cus;
    }
    if (grid < 0) return;
    (void)hipMemsetAsync((char*)d_ws + WS_CTL, 0, CTL_ZERO_BYTES, stream);
    Args a{};
    for (int i = 0; i < 40; ++i) a.in[i] = (const float*)d_in[i];
    a.out = (float*)d_out; a.ws = (unsigned char*)d_ws; a.repmask = REP_MASK;
#if defined(PROBE_NULL)
    {   const int k = PROBE_NULL; const int lo[3] = {0, 98, k}, hi[3] = {k, 99, NPH};
        for (int i = 0; i < 3; ++i) { a.ph_lo = lo[i]; a.ph_hi = hi[i]; a.li = i;
            hipLaunchKernelGGL(hybrid_fwd, dim3(grid), dim3(NWAVES * 64), LDS_BYTES, stream, a); } }
#elif defined(PROBE_PHASE)
    {   const int k = PROBE_PHASE; const int lo[4] = {0, k, k, k + 1}, hi[4] = {k, k + 1, k + 1, NPH};
        for (int i = 0; i < 4; ++i) { if (lo[i] >= hi[i]) continue; a.ph_lo = lo[i]; a.ph_hi = hi[i]; a.li = i;
            hipLaunchKernelGGL(hybrid_fwd, dim3(grid), dim3(NWAVES * 64), LDS_BYTES, stream, a); } }
#elif MK_ONE_LAUNCH
    a.ph_lo = 0; a.ph_hi = NPH;
    hipLaunchKernelGGL(hybrid_fwd, dim3(grid), dim3(NWAVES * 64), LDS_BYTES, stream, a);
#else
    for (int p = 0; p < PH_END; ++p) { a.ph_lo = p; a.ph_hi = p + 1; hipLaunchKernelGGL(hybrid_fwd, dim3(grid), dim3(NWAVES * 64), LDS_BYTES, stream, a); }
#ifdef DUMP_SEL
    a.ph_lo = 99; a.ph_hi = 100; hipLaunchKernelGGL(hybrid_fwd, dim3(grid), dim3(NWAVES * 64), LDS_BYTES, stream, a);
#endif
#endif
}
```

```cpp
#include <hip/hip_runtime.h>
#include <cstdio>
#include <cstdint>

#ifndef PH_END
#define PH_END 15
#endif
#ifndef MK_ONE_LAUNCH
#define MK_ONE_LAUNCH 1
#endif

namespace pg8 {
#define PG8_LAS __attribute__((address_space(3)))
typedef unsigned short bf16_t;
typedef short bf16x8 __attribute__((ext_vector_type(8)));
typedef float f32x4 __attribute__((ext_vector_type(4)));
typedef unsigned u32x4 __attribute__((ext_vector_type(4)));
constexpr int BM = 256, BK = 64, HALF = 128, HTB = HALF * BK * 2, STAGE_BYTES = 8 * HTB, NXCD = 8, WGM = 8;

__host__ __device__ __forceinline__ int lds_byte(int r, int c) { const int st = (r >> 4) * 2 + (c >> 5), rr = r & 15, cc = c & 31, ob = rr * 64 + cc * 2; return st * 1024 + (ob ^ (((ob >> 9) & 1) << 5)); }
__host__ __device__ __forceinline__ void stage_rc(int b, int& R, int& C) { const int st = b / 1024, sb = b % 1024, swz = sb ^ (((sb >> 9) & 1) << 5); R = (st >> 1) * 16 + swz / 64; C = (st & 1) * 32 + (swz % 64) / 2; }
__host__ __device__ __forceinline__ int perm32(int rho) { const int n = rho >> 4, i = rho & 15; return 8 * (i >> 2) + 4 * n + (i & 3); }

struct Unit { int pm, pn; };
struct Gemm { const bf16_t* A; const bf16_t* Bt; int M, N, K, lda; };

struct StaticOrder {
    int nM, nN, nwg, G, c;
    __host__ __device__ void init(int M, int N, int G_, int c_) { nM = M / BM; nN = N / BM; nwg = nM * nN; G = G_; c = c_; }
    __host__ __device__ bool next(int i, Unit& u) const {
        const long L = (long)i * G + c; if (L >= nwg) return false;
        int wgid = (int)L; { const int q = nwg / NXCD, r = nwg % NXCD, xcd = wgid % NXCD, off = wgid / NXCD; wgid = (xcd < r ? xcd * (q + 1) : r * (q + 1) + (xcd - r) * q) + off; }
        const int nig = WGM * nN, gid = wgid / nig, fm = gid * WGM, gsz = (nM - fm) < WGM ? (nM - fm) : WGM;
        u.pm = fm + ((wgid % nig) % gsz); u.pn = (wgid % nig) / gsz; return true;
    }
    __device__ __forceinline__ void a_ready(const Unit&) const {}
    __device__ __forceinline__ void done(const Unit&) const {}
};

__device__ __forceinline__ unsigned cvt_pk_bf16(float lo, float hi) { unsigned r; asm volatile("v_cvt_pk_bf16_f32 %0, %1, %2" : "=v"(r) : "v"(lo), "v"(hi)); return r; }

template <class Epi, class Sched, bool ALIGN_EPI = false, bool SP2 = false>
__device__ __forceinline__ void gemm_phase(PG8_LAS unsigned char* lds, const Gemm g, const Sched& S, const Epi& E) {
    const int tid = threadIdx.x, wid = __builtin_amdgcn_readfirstlane(tid >> 6), lane = tid & 63, wr = wid >> 2, wc = wid & 3, fr = lane & 15, fq = lane >> 4;
    const int K = g.K, nt = K / BK, lda = g.lda;
    unsigned voffA[2], voffB[2];
#pragma unroll
    for (int i = 0; i < 2; ++i) { int R, C; stage_rc(tid * 16 + i * 8192, R, C); const int Rb = Epi::PERM ? ((R & ~31) + perm32(R & 31)) : R;
        voffA[i] = (unsigned)(R * lda + C) * 2u; voffB[i] = (unsigned)(Rb * K + C) * 2u; }
    const size_t kstep = (size_t)(BK * 2);
    const size_t hstepA = (size_t)HALF * lda * 2, hstepB = (size_t)HALF * K * 2;
    const size_t tstepA = 2 * hstepA, tstepB = 2 * hstepB;
    const unsigned ldsw = (unsigned)wid * 1024u;
    const int aoff = lds_byte(wr * 64 + fr, fq * 8), boff = lds_byte(wc * 32 + fr, fq * 8);
#define PG8_SA(b, h) (((b) * 2 + (h)) * HTB)
#define PG8_SB(b, h) ((4 + (b) * 2 + (h)) * HTB)
#define PG8_STAGE(bufoff, gbase, voff) do { _Pragma("unroll") for (int _i = 0; _i < 2; ++_i) \
        __builtin_amdgcn_global_load_lds((const unsigned*)((const char*)(gbase) + (voff)[_i]), (PG8_LAS unsigned*)(lds + (bufoff) + ldsw + _i * 8192), 16, 0, 0); } while (0)
#define PG8_LDA(dst, b, h) do { _Pragma("unroll") for (int m = 0; m < 4; ++m) _Pragma("unroll") for (int k = 0; k < 2; ++k) dst[m][k] = *(const PG8_LAS bf16x8*)(lds + PG8_SA(b, h) + aoff + m * 2048 + k * 1024); } while (0)
#define PG8_LDB(dst, b, h) do { _Pragma("unroll") for (int n = 0; n < 2; ++n) _Pragma("unroll") for (int k = 0; k < 2; ++k) dst[n][k] = *(const PG8_LAS bf16x8*)(lds + PG8_SB(b, h) + boff + n * 2048 + k * 1024); } while (0)
#define PG8_MMA(ai, bj, At, Bt) do { __builtin_amdgcn_s_setprio(1); _Pragma("unroll") for (int m = 0; m < 4; ++m) _Pragma("unroll") for (int n = 0; n < 2; ++n) _Pragma("unroll") for (int k = 0; k < 2; ++k) \
        acc[ai][bj][m][n] = __builtin_amdgcn_mfma_f32_16x16x32_bf16(Bt[n][k], At[m][k], acc[ai][bj][m][n], 0, 0, 0); __builtin_amdgcn_s_setprio(0); } while (0)
#define PG8_WAIT_V(n) asm volatile("s_waitcnt vmcnt(" #n ")" ::: "memory")
#define PG8_WAIT_L(n) asm volatile("s_waitcnt lgkmcnt(" #n ")" ::: "memory")
#define PG8_BAR __builtin_amdgcn_s_barrier()
#define PG8_SCHED __builtin_amdgcn_sched_barrier(0)
    Unit cur, nxt; int ui = 0;
    if (!S.next(0, cur)) return;
    f32x4 acc[2][2][4][2];
#pragma unroll
    for (int a = 0; a < 2; ++a)
#pragma unroll
        for (int b = 0; b < 2; ++b)
#pragma unroll
            for (int m = 0; m < 4; ++m)
#pragma unroll
                for (int n = 0; n < 2; ++n) acc[a][b][m][n] = (f32x4){0.f, 0.f, 0.f, 0.f};
    bf16x8 At[4][2], B0[2][2], B1[2][2];
    const char* cA = (const char*)g.A + (size_t)cur.pm * tstepA; const char* cB = (const char*)g.Bt + (size_t)cur.pn * tstepB;
    S.a_ready(cur);
    if constexpr (SP2) {
        PG8_STAGE(PG8_SB(0, 0), cB, voffB); PG8_STAGE(PG8_SB(0, 1), cB + hstepB, voffB); PG8_STAGE(PG8_SA(0, 0), cA, voffA); PG8_STAGE(PG8_SA(0, 1), cA + hstepA, voffA);
        if (wr == 1) PG8_BAR;
        PG8_WAIT_V(2); PG8_BAR;
        PG8_STAGE(PG8_SB(1, 0), cB + kstep, voffB); PG8_STAGE(PG8_SA(1, 0), cA + kstep, voffA); PG8_STAGE(PG8_SB(1, 1), cB + hstepB + kstep, voffB);
        PG8_WAIT_V(6); PG8_BAR;
    } else {
        PG8_STAGE(PG8_SB(0, 0), cB, voffB); PG8_STAGE(PG8_SA(0, 0), cA, voffA); PG8_STAGE(PG8_SB(0, 1), cB + hstepB, voffB); PG8_STAGE(PG8_SA(0, 1), cA + hstepA, voffA);
        if (wr == 1) PG8_BAR;
        PG8_WAIT_V(4); PG8_BAR;
        PG8_STAGE(PG8_SB(1, 0), cB + kstep, voffB); PG8_STAGE(PG8_SA(1, 0), cA + kstep, voffA); PG8_STAGE(PG8_SB(1, 1), cB + hstepB + kstep, voffB);
        PG8_WAIT_V(6); PG8_BAR;
    }
    for (;;) {
        const bool has_next = S.next(ui + 1, nxt);
        const char* nA = has_next ? (const char*)g.A + (size_t)nxt.pm * tstepA : cA; const char* nB = has_next ? (const char*)g.Bt + (size_t)nxt.pn * tstepB : cB;
        for (int t = 0; t < nt; t += 2) {
            const bool last = (t == nt - 2);
            const char* a1 = cA + (size_t)(t + 1) * kstep;
            const char* a2 = last ? nA : cA + (size_t)(t + 2) * kstep; const char* b2 = last ? nB : cB + (size_t)(t + 2) * kstep;
            const char* a3 = a2 + kstep; const char* b3 = b2 + kstep;
            if (last && has_next) S.a_ready(nxt);
            if constexpr (SP2) {
            PG8_LDB(B0, 0, 0); PG8_LDB(B1, 0, 1); PG8_SCHED; PG8_LDA(At, 0, 0); PG8_STAGE(PG8_SA(1, 1), a1 + hstepA, voffA);
            PG8_WAIT_V(8); PG8_WAIT_L(0); PG8_BAR; PG8_MMA(0, 0, At, B0); PG8_MMA(0, 1, At, B1); PG8_BAR; PG8_SCHED;
            PG8_LDA(At, 0, 1); PG8_STAGE(PG8_SB(0, 0), b2, voffB); PG8_STAGE(PG8_SB(0, 1), b2 + hstepB, voffB); PG8_STAGE(PG8_SA(0, 0), a2, voffA);
            PG8_WAIT_V(8); PG8_WAIT_L(0); PG8_BAR; PG8_MMA(1, 0, At, B0); PG8_MMA(1, 1, At, B1); PG8_BAR; PG8_SCHED;
            PG8_LDB(B0, 1, 0); PG8_LDB(B1, 1, 1); PG8_SCHED; PG8_LDA(At, 1, 0); PG8_STAGE(PG8_SA(0, 1), a2 + hstepA, voffA);
            PG8_WAIT_V(8); PG8_WAIT_L(0); PG8_BAR; PG8_MMA(0, 0, At, B0); PG8_MMA(0, 1, At, B1); PG8_BAR; PG8_SCHED;
            PG8_LDA(At, 1, 1); PG8_STAGE(PG8_SB(1, 0), b3, voffB); PG8_STAGE(PG8_SB(1, 1), b3 + hstepB, voffB); PG8_STAGE(PG8_SA(1, 0), a3, voffA);
            PG8_WAIT_V(8); PG8_WAIT_L(0); PG8_BAR; PG8_MMA(1, 0, At, B0); PG8_MMA(1, 1, At, B1); PG8_BAR; PG8_SCHED;
            } else {
            PG8_LDB(B0, 0, 0); PG8_SCHED; PG8_LDA(At, 0, 0); PG8_STAGE(PG8_SA(1, 1), a1 + hstepA, voffA);
            PG8_WAIT_L(8); PG8_BAR; PG8_WAIT_L(0); PG8_MMA(0, 0, At, B0); PG8_BAR; PG8_SCHED;
            PG8_LDB(B1, 0, 1); PG8_STAGE(PG8_SB(0, 0), b2, voffB);
            PG8_BAR; PG8_WAIT_L(0); PG8_MMA(0, 1, At, B1); PG8_BAR;
            PG8_LDA(At, 0, 1); PG8_STAGE(PG8_SA(0, 0), a2, voffA);
            PG8_BAR; PG8_WAIT_L(0); PG8_MMA(1, 0, At, B0); PG8_BAR; PG8_SCHED;
            PG8_STAGE(PG8_SB(0, 1), b2 + hstepB, voffB);
            PG8_WAIT_V(6); PG8_BAR; PG8_MMA(1, 1, At, B1); PG8_BAR;
            PG8_LDB(B0, 1, 0); PG8_SCHED; PG8_LDA(At, 1, 0); PG8_STAGE(PG8_SA(0, 1), a2 + hstepA, voffA);
            PG8_WAIT_L(8); PG8_BAR; PG8_WAIT_L(0); PG8_MMA(0, 0, At, B0); PG8_BAR; PG8_SCHED;
            PG8_LDB(B1, 1, 1); PG8_STAGE(PG8_SB(1, 0), b3, voffB);
            PG8_BAR; PG8_WAIT_L(0); PG8_MMA(0, 1, At, B1); PG8_BAR;
            PG8_LDA(At, 1, 1); PG8_STAGE(PG8_SA(1, 0), a3, voffA);
            PG8_BAR; PG8_WAIT_L(0); PG8_MMA(1, 0, At, B0); PG8_BAR; PG8_SCHED;
            PG8_STAGE(PG8_SB(1, 1), b3 + hstepB, voffB);
            PG8_WAIT_V(6); PG8_BAR; PG8_MMA(1, 1, At, B1); PG8_BAR;
            }
        }
        if constexpr (ALIGN_EPI) { if (wr == 0) PG8_BAR; }
        E(acc, cur, wr, wc, fr, fq); S.done(cur);
        if (!has_next) break;
#pragma unroll
        for (int a = 0; a < 2; ++a)
#pragma unroll
            for (int b = 0; b < 2; ++b)
#pragma unroll
                for (int m = 0; m < 4; ++m)
#pragma unroll
                    for (int n = 0; n < 2; ++n) acc[a][b][m][n] = (f32x4){0.f, 0.f, 0.f, 0.f};
        cur = nxt; cA = nA; cB = nB; ++ui;
        if constexpr (ALIGN_EPI) { if (wr == 1) PG8_BAR; }
    }
    PG8_WAIT_V(0);
    if constexpr (!ALIGN_EPI) { if (wr == 0) PG8_BAR; }
    PG8_BAR;
#undef PG8_SA
#undef PG8_SB
#undef PG8_STAGE
#undef PG8_LDA
#undef PG8_LDB
#undef PG8_MMA
#undef PG8_WAIT_V
#undef PG8_WAIT_L
#undef PG8_BAR
#undef PG8_SCHED
}
}

constexpr int NB = 4, SEQ = 8192, DM = 1024, TT = NB * SEQ, CTXL = 256, TC = NB * CTXL, FF = 2816, NH = 16, HD = 64, GW = 64, GROWS = SEQ / GW;
constexpr int WH = 8, WW = 16;
constexpr float EPS = 1e-6f;
constexpr int NWAVES = 8;

constexpr size_t MiB = 1u << 20;
constexpr size_t WS_CTL = 0, CTL_ZERO_BYTES = 64 * 1024;
constexpr size_t CT_BAR = 4096;
constexpr size_t CT_MODS = 64 * 1024;
constexpr size_t CT_BQKV = CT_MODS + 2 * 5 * 6144 * 4;
constexpr size_t CT_BUP0 = CT_BQKV + 5 * 3072 * 4;
constexpr size_t CT_BIN  = CT_BUP0 + 4 * 5632 * 4;
constexpr size_t CT_BUP1 = CT_BIN + 4 * 3072 * 4;
constexpr size_t CT_END  = CT_BUP1 + 4 * 5632 * 4;
static_assert(CT_END <= 1 * MiB, "ctl region");
constexpr size_t SM_SSQ0 = 1 * MiB, SM_SSQC = SM_SSQ0 + 32768 * 4, SM_GN = SM_SSQC + 1024 * 4;
constexpr size_t WS_SSQP = 2 * MiB;
constexpr size_t WS_FSQP = 4 * MiB;
constexpr size_t WS_XB = 448 * MiB;
constexpr size_t WS_WQKV = 8 * MiB, WS_WO = 14 * MiB, WS_WUP0 = 16 * MiB, WS_WDN0 = 27 * MiB, WS_WIN = 33 * MiB, WS_WOUT = 39 * MiB, WS_WUP1 = 41 * MiB, WS_WDN1 = 52 * MiB;
constexpr size_t WS_XSC = 58 * MiB, WS_KC = 60 * MiB, WS_VC = 62 * MiB;
constexpr size_t WS_XS = 64 * MiB;
constexpr size_t WS_Q = 128 * MiB, WS_K = 192 * MiB, WS_V = 256 * MiB, WS_O = WS_Q;
constexpr size_t WS_AG = 128 * MiB;
constexpr size_t WS_HG = 308 * MiB, WS_HA = 314 * MiB;
constexpr size_t WS_UT = 128 * MiB;
constexpr size_t WS_HT = 128 * MiB;
constexpr size_t WS_F = 320 * MiB;
constexpr size_t SM_TWM = 1536 * 1024, SM_TWN = SM_TWM + 65536;
constexpr size_t WS_P = 384 * MiB;
constexpr size_t WS_END = 512 * MiB;

constexpr int RING_BYTES = 131072;
constexpr int LDS_BYTES = 163840;
constexpr int LDSCTL_OFF = LDS_BYTES - 1024, MISC_OFF = LDSCTL_OFF + 320;

#define GAS __attribute__((address_space(1)))
#define LAS __attribute__((address_space(3)))
typedef unsigned short bf16;
typedef unsigned v4u __attribute__((ext_vector_type(4)));
typedef unsigned v2u __attribute__((ext_vector_type(2)));
typedef float f32x4 __attribute__((ext_vector_type(4)));
typedef GAS unsigned gu32;
#define RLX_AGENT __ATOMIC_RELAXED, __HIP_MEMORY_SCOPE_AGENT
#define LDS_WAIT() asm volatile("s_waitcnt lgkmcnt(0)" ::: "memory")
#define VM_WAIT() asm volatile("s_waitcnt vmcnt(0)" ::: "memory")
__device__ __forceinline__ unsigned f2bf(float f) { unsigned u = __builtin_bit_cast(unsigned, f); return (u + 0x7fffu + ((u >> 16) & 1u)) >> 16; }
__device__ __forceinline__ unsigned pk2(float lo, float hi) { return f2bf(lo) | (f2bf(hi) << 16); }
__device__ __forceinline__ float bf2f(unsigned short h) { return __builtin_bit_cast(float, (unsigned)h << 16); }
__device__ __forceinline__ float bflo(unsigned w) { return __builtin_bit_cast(float, w << 16); }
__device__ __forceinline__ float bfhi(unsigned w) { return __builtin_bit_cast(float, w & 0xffff0000u); }

#define FC_HD __device__ __forceinline__
struct cf { float x, y; };
FC_HD cf cmul(cf a, cf b) { cf r; r.x = a.x * b.x - a.y * b.y; r.y = a.x * b.y + a.y * b.x; return r; }
FC_HD cf cadd(cf a, cf b) { cf r; r.x = a.x + b.x; r.y = a.y + b.y; return r; }
FC_HD cf csub(cf a, cf b) { cf r; r.x = a.x - b.x; r.y = a.y - b.y; return r; }
FC_HD cf cconj(cf a) { cf r; r.x = a.x; r.y = -a.y; return r; }
FC_HD cf cmulnegi(cf a) { cf r; r.x = a.y; r.y = -a.x; return r; }
#define FC_OPAQUE(x) asm volatile("" : "+v"(x))
#define FC_PIDX(i) ((i) + (((i) >> 6) << 3))
#define FC_M 8192
#define FC_PADM (FC_M + FC_M / 8)
#define FC_S2 0.70710678118654752f
FC_HD void dft4(cf& a0, cf& a1, cf& a2, cf& a3) {
    const cf c0 = cadd(a0, a2), c1 = cadd(a1, a3), d0 = csub(a0, a2), d1 = cmulnegi(csub(a1, a3));
    a0 = cadd(c0, c1); a1 = cadd(d0, d1); a2 = csub(c0, c1); a3 = csub(d0, d1);
}
FC_HD void dft8(cf* v) {
    cf a0 = cadd(v[0], v[4]), a1 = cadd(v[1], v[5]), a2 = cadd(v[2], v[6]), a3 = cadd(v[3], v[7]);
    cf b0 = csub(v[0], v[4]), b1 = csub(v[1], v[5]), b2 = csub(v[2], v[6]), b3 = csub(v[3], v[7]);
    { cf t; t.x = (b1.x + b1.y) * FC_S2; t.y = (b1.y - b1.x) * FC_S2; b1 = t; }
    b2 = cmulnegi(b2);
    { cf t; t.x = (b3.y - b3.x) * FC_S2; t.y = (-b3.x - b3.y) * FC_S2; b3 = t; }
    dft4(a0, a1, a2, a3); dft4(b0, b1, b2, b3);
    v[0] = a0; v[2] = a1; v[4] = a2; v[6] = a3; v[1] = b0; v[3] = b1; v[5] = b2; v[7] = b3;
}
FC_HD void dft16(cf* v) {
    cf a[8], b[8];
    const float c1 = 0.92387953251128674f, s1 = 0.38268343236508977f;
#ifdef __HIP_DEVICE_COMPILE__
#pragma unroll
#endif
    for (int i = 0; i < 8; ++i) { a[i] = cadd(v[i], v[i + 8]); b[i] = csub(v[i], v[i + 8]); }
    { cf w; w.x = c1; w.y = -s1; b[1] = cmul(b[1], w); }
    { cf w; w.x = FC_S2; w.y = -FC_S2; b[2] = cmul(b[2], w); }
    { cf w; w.x = s1; w.y = -c1; b[3] = cmul(b[3], w); }
    b[4] = cmulnegi(b[4]);
    { cf w; w.x = -s1; w.y = -c1; b[5] = cmul(b[5], w); }
    { cf w; w.x = -FC_S2; w.y = -FC_S2; b[6] = cmul(b[6], w); }
    { cf w; w.x = -c1; w.y = -s1; b[7] = cmul(b[7], w); }
    dft8(a); dft8(b);
#ifdef __HIP_DEVICE_COMPILE__
#pragma unroll
#endif
    for (int i = 0; i < 8; ++i) { v[2 * i] = a[i]; v[2 * i + 1] = b[i]; }
}
template <int R> FC_HD void cpowers(cf w1, cf* w) {
    w[0].x = 1.f; w[0].y = 0.f; w[1] = w1;
#ifdef __HIP_DEVICE_COMPILE__
#pragma unroll
#endif
    for (int q = 2; q < R; ++q) w[q] = (q & 1) ? cmul(w[q - 1], w1) : cmul(w[q >> 1], w[q >> 1]);
}
template <class LP> FC_HD void fwd_pass1(cf* v, int tid, LP a, const cf* TWM) {
    dft16(v);
    FC_OPAQUE(tid);
    const cf w1 = TWM[tid]; cf cur = w1;
    const int pt = FC_PIDX(tid);
    a[pt] = v[0];
#ifdef __HIP_DEVICE_COMPILE__
#pragma unroll
#endif
    for (int q = 1; q < 16; ++q) { a[pt + 576 * q] = cmul(v[q], cur); cur = cmul(cur, w1); }
}
template <class LP> FC_HD void fwd_pass8(int tid, LP a, const cf* TWM, int s, int lgs) {
#pragma unroll 1
    for (int h = 0; h < 2; ++h) {
        FC_OPAQUE(tid);
        const int bf = tid + 512 * h, j = bf & (s - 1), base = (bf >> lgs) * 8 * s;
        const int pb = FC_PIDX(base + j), ps = (s == 64) ? 72 : 8;
        cf v[8];
#ifdef __HIP_DEVICE_COMPILE__
#pragma unroll
#endif
        for (int r = 0; r < 8; ++r) v[r] = a[pb + ps * r];
        dft8(v);
        const cf w1 = TWM[j]; cf cur = w1;
        a[pb] = v[0];
#ifdef __HIP_DEVICE_COMPILE__
#pragma unroll
#endif
        for (int q = 1; q < 8; ++q) { a[pb + ps * q] = cmul(v[q], cur); cur = cmul(cur, w1); }
    }
}
template <class LP> FC_HD void mid_pass(int tid, LP a, const cf* F, cf* Fout, float fscale) {
#pragma unroll 1
    for (int h = 0; h < 2; ++h) {
        FC_OPAQUE(tid);
        const int bf = tid + 512 * h, base = bf * 8, pb = FC_PIDX(base);
        cf v[8];
#ifdef __HIP_DEVICE_COMPILE__
#pragma unroll
#endif
        for (int r = 0; r < 8; ++r) v[r] = a[pb + r];
        dft8(v);
        if (F) {
#ifdef __HIP_DEVICE_COMPILE__
#pragma unroll
#endif
            for (int r = 0; r < 8; ++r) v[r] = cconj(cmul(v[r], F[base + r]));
            dft8(v);
#ifdef __HIP_DEVICE_COMPILE__
#pragma unroll
#endif
            for (int r = 0; r < 8; ++r) a[pb + r] = v[r];
        } else {
#ifdef __HIP_DEVICE_COMPILE__
#pragma unroll
#endif
            for (int r = 0; r < 8; ++r) { cf o; o.x = v[r].x * fscale; o.y = v[r].y * fscale; Fout[base + r] = o; }
        }
    }
}
template <class LP> FC_HD void mid_pass_reg(int tid, LP a, const cf* fr) {
#ifdef __HIP_DEVICE_COMPILE__
#pragma unroll
#endif
    for (int h = 0; h < 2; ++h) {
        FC_OPAQUE(tid);
        const int bf = tid + 512 * h, base = bf * 8, pb = FC_PIDX(base);
        cf v[8];
#ifdef __HIP_DEVICE_COMPILE__
#pragma unroll
#endif
        for (int r = 0; r < 8; ++r) v[r] = a[pb + r];
        dft8(v);
#ifdef __HIP_DEVICE_COMPILE__
#pragma unroll
#endif
        for (int r = 0; r < 8; ++r) v[r] = cconj(cmul(v[r], fr[h * 8 + r]));
        dft8(v);
#ifdef __HIP_DEVICE_COMPILE__
#pragma unroll
#endif
        for (int r = 0; r < 8; ++r) a[pb + r] = v[r];
    }
}
template <class LP> FC_HD void inv_pass8(int tid, LP a, const cf* TWM, int s, int lgs) {
#pragma unroll 1
    for (int h = 0; h < 2; ++h) {
        FC_OPAQUE(tid);
        const int bf = tid + 512 * h, j = bf & (s - 1), base = (bf >> lgs) * 8 * s;
        const int pb = FC_PIDX(base + j), ps = (s == 64) ? 72 : 8;
        cf v[8]; const cf w1 = TWM[j]; cf cur = w1;
        v[0] = a[FC_PIDX(base + j)];
#ifdef __HIP_DEVICE_COMPILE__
#pragma unroll
#endif
        for (int q = 1; q < 8; ++q) { v[q] = cmul(a[pb + ps * q], cur); cur = cmul(cur, w1); }
        dft8(v);
#ifdef __HIP_DEVICE_COMPILE__
#pragma unroll
#endif
        for (int r = 0; r < 8; ++r) a[pb + ps * r] = v[r];
    }
}
template <class LP> FC_HD void inv_pass1(cf* v, int tid, LP a, const cf* TWM) {
    FC_OPAQUE(tid);
    const cf w1 = TWM[tid]; cf cur = w1;
    const int pt = FC_PIDX(tid);
    v[0] = a[pt];
#ifdef __HIP_DEVICE_COMPILE__
#pragma unroll
#endif
    for (int q = 1; q < 16; ++q) { v[q] = cmul(a[pt + 576 * q], cur); cur = cmul(cur, w1); }
    dft16(v);
}

#define F2_PIDX(i) ((i) + ((i) >> 5))
#define F2_PADM (8192 + 256)
FC_HD void dft32(cf* v) {
    const float c[16] = {1.0f, 0.98078528040323043f, 0.92387953251128674f, 0.83146961230254524f, 0.70710678118654752f, 0.55557023301960218f, 0.38268343236508977f, 0.19509032201612825f,
                         0.0f, -0.19509032201612825f, -0.38268343236508977f, -0.55557023301960218f, -0.70710678118654752f, -0.83146961230254524f, -0.92387953251128674f, -0.98078528040323043f};
    const float s[16] = {0.0f, 0.19509032201612825f, 0.38268343236508977f, 0.55557023301960218f, 0.70710678118654752f, 0.83146961230254524f, 0.92387953251128674f, 0.98078528040323043f,
                         1.0f, 0.98078528040323043f, 0.92387953251128674f, 0.83146961230254524f, 0.70710678118654752f, 0.55557023301960218f, 0.38268343236508977f, 0.19509032201612825f};
#ifdef __HIP_DEVICE_COMPILE__
#pragma unroll
#endif
    for (int i = 0; i < 16; ++i) { const cf a = cadd(v[i], v[i + 16]); cf b = csub(v[i], v[i + 16]);
        if (i == 8) b = cmulnegi(b); else if (i != 0) { cf w; w.x = c[i]; w.y = -s[i]; b = cmul(b, w); }
        v[i] = a; v[i + 16] = b; }
    dft16(v); dft16(v + 16);
}
#define F2_Q(k) (2 * ((k) & 15) + ((k) >> 4))
template <class LP> FC_HD void f2_fwd_p1(cf* v, int tid, LP a, const cf* tw1) {
    dft16(v);
    FC_OPAQUE(tid);
    const cf w1 = tw1[tid]; cf cur = w1;
    const int pt = F2_PIDX(tid);
    a[pt] = v[0];
#ifdef __HIP_DEVICE_COMPILE__
#pragma unroll
#endif
    for (int q = 1; q < 16; ++q) { a[pt + 528 * q] = cmul(v[q], cur); cur = cmul(cur, w1); }
}
template <class LP> FC_HD void f2_fwd_p2(int tid, LP a, const cf* tw32) {
    FC_OPAQUE(tid);
    const int j = tid & 31, pb = F2_PIDX((tid >> 5) * 512 + j);
    cf v[16];
#ifdef __HIP_DEVICE_COMPILE__
#pragma unroll
#endif
    for (int r = 0; r < 16; ++r) v[r] = a[pb + 33 * r];
    dft16(v);
    const cf w1 = tw32[j]; cf cur = w1;
    a[pb] = v[0];
#ifdef __HIP_DEVICE_COMPILE__
#pragma unroll
#endif
    for (int q = 1; q < 16; ++q) { a[pb + 33 * q] = cmul(v[q], cur); cur = cmul(cur, w1); }
}
template <class LP> FC_HD void f2_mid(int bf, LP a, const cf* fr, cf* Fout, float fscale) {
    FC_OPAQUE(bf);
    const int pb = 33 * bf;
    cf v[32];
#ifdef __HIP_DEVICE_COMPILE__
#pragma unroll
#endif
    for (int i = 0; i < 32; ++i) v[i] = a[pb + i];
    dft32(v);
    if (fr) {
        cf w[32];
#ifdef __HIP_DEVICE_COMPILE__
#pragma unroll
#endif
        for (int k = 0; k < 32; ++k) w[F2_Q(k)] = cconj(cmul(v[k], fr[F2_Q(k)]));
        dft32(w);
#ifdef __HIP_DEVICE_COMPILE__
#pragma unroll
#endif
        for (int k = 0; k < 32; ++k) a[pb + F2_Q(k)] = w[k];
    } else {
#ifdef __HIP_DEVICE_COMPILE__
#pragma unroll
#endif
        for (int k = 0; k < 32; ++k) { cf o; o.x = v[k].x * fscale; o.y = v[k].y * fscale; Fout[F2_Q(k) * 256 + bf] = o; }
    }
}
template <class LP> FC_HD void f2_inv_p2(int tid, LP a, const cf* tw32) {
    FC_OPAQUE(tid);
    const int j = tid & 31, pb = F2_PIDX((tid >> 5) * 512 + j);
    cf v[16]; const cf w1 = tw32[j]; cf cur = w1;
    v[0] = a[pb];
#ifdef __HIP_DEVICE_COMPILE__
#pragma unroll
#endif
    for (int q = 1; q < 16; ++q) { v[q] = cmul(a[pb + 33 * q], cur); cur = cmul(cur, w1); }
    dft16(v);
#ifdef __HIP_DEVICE_COMPILE__
#pragma unroll
#endif
    for (int r = 0; r < 16; ++r) a[pb + 33 * r] = v[r];
}
template <class LP> FC_HD void f2_inv_p1(cf* v, int tid, LP a, const cf* tw1) {
    FC_OPAQUE(tid);
    const cf w1 = tw1[tid]; cf cur = w1;
    const int pt = F2_PIDX(tid);
    v[0] = a[pt];
#ifdef __HIP_DEVICE_COMPILE__
#pragma unroll
#endif
    for (int q = 1; q < 16; ++q) { v[q] = cmul(a[pt + 528 * q], cur); cur = cmul(cur, w1); }
    dft16(v);
}

#define XB_TMO      128
#define XB_XCNT(j)  (256  + 64 * (j))
#define XB_XSUB(j)  (1280 + 64 * (j))
#define XB_XGEN(j)  (2304 + 64 * (j))
#define XB_TOP      3328
#define XB_TOPGEN   3392
#define XCD_BAR_WORDS 3456
#define XB_SPIN_CAP (1u << 18)
__device__ __forceinline__ unsigned xb_ld(unsigned* p)              { return __hip_atomic_load(p, __ATOMIC_RELAXED, __HIP_MEMORY_SCOPE_AGENT); }
__device__ __forceinline__ unsigned xb_add(unsigned* p, unsigned v) { return __hip_atomic_fetch_add(p, v, __ATOMIC_RELAXED, __HIP_MEMORY_SCOPE_AGENT); }
__device__ __forceinline__ unsigned xb_xcc_id() { return (unsigned)__builtin_amdgcn_s_getreg((3 << 11) | 20) & 0xFu; }
#define XB_SPIN(cond, bar) do { unsigned _sp = 0; while (cond) { __builtin_amdgcn_s_sleep(1); \
    if ((++_sp & 255u) == 0u) { if (xb_ld(&(bar)[XB_TMO])) break; if (_sp > XB_SPIN_CAP) { atomicAdd(&(bar)[XB_TMO], 1u); break; } } } } while (0)
struct XcdBarrier { unsigned* bar; unsigned x; volatile LAS unsigned* st; };
__device__ __forceinline__ XcdBarrier xcd_barrier_post(unsigned* bar, volatile LAS unsigned* st) {
    XcdBarrier b; b.bar = bar; b.x = xb_xcc_id(); b.st = st;
    if (threadIdx.x == 0) (void)xb_add(&bar[XB_XCNT(b.x)], 1u);
    return b;
}
__device__ __forceinline__ void xcd_barrier_complete(unsigned* bar, unsigned x, unsigned& nloc, unsigned& nx) {
    const unsigned G = gridDim.x * gridDim.y * gridDim.z;
    unsigned sum, cnt, mine, sp = 0u;
    for (;;) {
        sum = 0u; cnt = 0u; mine = 0u;
#pragma unroll
        for (unsigned j = 0; j < 16; ++j) { const unsigned c = xb_ld(&bar[XB_XCNT(j)]); sum += c; cnt += (c > 0u) ? 1u : 0u; mine = (j == x) ? c : mine; }
        if (sum == G) break;
        __builtin_amdgcn_s_sleep(1);
        if ((++sp & 255u) == 0u) { if (xb_ld(&bar[XB_TMO])) break; if (sp > XB_SPIN_CAP) { atomicAdd(&bar[XB_TMO], 1u); break; } }
    }
    nloc = mine > 0u ? mine : 1u; nx = cnt > 0u ? cnt : 1u;
}
__device__ __forceinline__ void xcd_barrier(const XcdBarrier& b) {
    asm volatile("s_waitcnt vmcnt(0)" ::: "memory");
    __syncthreads();
    if (threadIdx.x == 0) {
        unsigned* bar = b.bar;
        __builtin_amdgcn_s_waitcnt(0);
        unsigned nloc = b.st[0], nx = b.st[1];
        if (nloc == 0u) { xcd_barrier_complete(bar, b.x, nloc, nx); b.st[0] = nloc; b.st[1] = nx; }
        const unsigned old = xb_add(&bar[XB_XSUB(b.x)], 1u);
        const unsigned gen = old / nloc;
        if (old + 1u == (gen + 1u) * nloc) {
            __builtin_amdgcn_fence(__ATOMIC_RELEASE, "agent");
            asm volatile("s_waitcnt vmcnt(0)" ::: "memory");
            const unsigned og = xb_add(&bar[XB_TOP], 1u);
            const unsigned tg = og / nx;
            if (og + 1u == (tg + 1u) * nx) xb_add(&bar[XB_TOPGEN], 1u);
            else XB_SPIN(xb_ld(&bar[XB_TOPGEN]) == tg, bar);
            __builtin_amdgcn_fence(__ATOMIC_ACQUIRE, "agent");
            xb_add(&bar[XB_XGEN(b.x)], 1u);
            asm volatile("s_waitcnt vmcnt(0)" ::: "memory");
        } else {
            XB_SPIN(xb_ld(&bar[XB_XGEN(b.x)]) == gen, bar);
            __builtin_amdgcn_fence(__ATOMIC_ACQUIRE, "agent");
            asm volatile("s_waitcnt vmcnt(0)" ::: "memory");
        }
    }
    __syncthreads();
}

struct Args { const float* in[40]; float* out; unsigned char* ws; int ph_lo, ph_hi, repmask, li; };
struct Frame {
    LAS unsigned char* lds;
    int tid, lane, wave, vcu, G;
    const float* const* in; float* out; unsigned char* ws;
};
__device__ __forceinline__ float wave_sum(float v) {
#pragma unroll
    for (int o = 1; o < 64; o <<= 1) v += __shfl_xor(v, o);
    return v;
}
__device__ __forceinline__ float silu_f(float x) { return x / (1.f + __expf(-x)); }

__device__ __forceinline__ float gelu_f(float v) { return 0.5f * v * (1.f + erff(v * 0.70710678118654752f)); }

__device__ __forceinline__ void transpose_item(const float* W, int K, int N, bf16* WT, int src_col0, int dst_row0, int k0, LAS float* scr, int lane) {
#pragma unroll 8
    for (int i = 0; i < 32; ++i) { const int kk = 2 * i + (lane >> 5); scr[kk * 33 + (lane & 31)] = W[(size_t)(k0 + kk) * N + src_col0 + (lane & 31)]; }
    LDS_WAIT(); asm volatile("" ::: "memory");
    const int c = lane & 7;
#pragma unroll
    for (int j = 0; j < 4; ++j) { const int n = (lane >> 3) + 8 * j; const LAS float* s = scr + (8 * c) * 33 + n;
        v4u o; o.x = pk2(s[0 * 33], s[1 * 33]); o.y = pk2(s[2 * 33], s[3 * 33]); o.z = pk2(s[4 * 33], s[5 * 33]); o.w = pk2(s[6 * 33], s[7 * 33]);
        *(GAS v4u*)(WT + (size_t)(dst_row0 + n) * K + k0 + 8 * c) = o; }
    LDS_WAIT(); asm volatile("" ::: "memory");
}
__device__ __forceinline__ int qkv_slot_to_col(int slot) {
    const int part = slot >> 10, cc = slot & 1023, pnl = cc >> 8, s = cc & 255, bj = s >> 7, wc = (s & 127) >> 5, j = s & 31;
    return part * 1024 + (4 * pnl + wc) * 64 + 32 * bj + j;
}
__device__ __forceinline__ int up_slot_to_col(int slot) { const int pn = slot >> 8, bj = (slot >> 7) & 1, cc = slot & 127; return bj * FF + pn * 128 + cc; }
__device__ __forceinline__ void cvt_weight_item(const float* W, int K, int N, bf16* WT, int item, LAS float* scr, int lane, int perm) {
    const int nblk = N / 32, kb = item / nblk, nb = item % nblk;
    const int dst = 32 * nb, src = perm == 1 ? qkv_slot_to_col(dst) : (perm == 2 ? up_slot_to_col(dst) : dst);
    transpose_item(W, K, N, WT, src, dst, 64 * kb, scr, lane);
}

template <int R, class VF>
__device__ __forceinline__ void gemv_det_item(const float* W, int N, int n0, float* out, int ostride, const float* addbias, const VF& vf, int tid, LAS float* scr) {
    const int col = tid & 63, ks = tid >> 6;
    float acc[R];
#pragma unroll
    for (int r = 0; r < R; ++r) acc[r] = 0.f;
    const float* wp = W + (size_t)(ks * 128) * N + n0 + col;
#pragma unroll 8
    for (int k = 0; k < 128; ++k) { const float w = wp[(size_t)k * N];
#pragma unroll
        for (int r = 0; r < R; ++r) acc[r] += vf(r, ks * 128 + k) * w; }
    __syncthreads();
#pragma unroll
    for (int r = 0; r < R; ++r) scr[(ks * R + r) * 64 + col] = acc[r];
    __syncthreads();
    if (tid < R * 64) { const int r = tid >> 6; float s = 0.f;
#pragma unroll
        for (int k2 = 0; k2 < 8; ++k2) s += scr[(k2 * R + r) * 64 + col];
        if (addbias) s += addbias[n0 + col];
        out[(size_t)r * ostride + n0 + col] = s; }
}

__device__ __forceinline__ void phase0a(Frame& F) {
    const float* const* in = F.in;
    float* mods = (float*)(F.ws + CT_MODS);
    {
        const float* c = in[1]; const float* cctx = in[3];
        auto vf = [&](int r, int k) -> float { const float v = (r < 4) ? c[r * DM + k] : cctx[k]; return silu_f(v); };
        const int nitems = 2 * 96;
        for (int it = F.vcu; it < nitems; it += F.G) {
            const int l = it / 96, cg = it % 96;
            gemv_det_item<5>(in[l ? 17 : 4], 6144, cg * 64, mods + l * 5 * 6144, 6144, in[l ? 18 : 5], vf, F.tid, (LAS float*)F.lds);
        }
        __syncthreads();
    }
    for (int e = F.vcu * 512 + F.tid; e < 16384; e += F.G * 512) {
        const int k = e & 8191; const bool isn = e >= 8192;
        float sn, cs; sincospif(isn ? (float)k * (1.0f / 8192.0f) : (float)k * (1.0f / 4096.0f), &sn, &cs);
        cf t; t.x = cs; t.y = -sn;
        ((cf*)(F.ws + (isn ? SM_TWN : SM_TWM)))[k] = t;
    }
    LAS float* scr = (LAS float*)(F.lds + F.wave * 16384);
    const int gw = F.vcu * NWAVES + F.wave, NGW = F.G * NWAVES;
    constexpr int I_QKV = 16 * 96, I_O = 16 * 32, I_UP = 16 * 176, I_DN = 44 * 32;
    constexpr int NITEMS = 2 * I_QKV + 2 * I_O + 2 * I_UP + 2 * I_DN;
    for (int it = gw; it < NITEMS; it += NGW) {
        int r = it;
        if (r < I_QKV) { cvt_weight_item(in[8], DM, 3 * DM, (bf16*)(F.ws + WS_WQKV), r, scr, F.lane, 1); continue; } r -= I_QKV;
        if (r < I_O) { cvt_weight_item(in[12], DM, DM, (bf16*)(F.ws + WS_WO), r, scr, F.lane, 0); continue; } r -= I_O;
        if (r < I_UP) { cvt_weight_item(in[13], DM, 2 * FF, (bf16*)(F.ws + WS_WUP0), r, scr, F.lane, 2); continue; } r -= I_UP;
        if (r < I_DN) { cvt_weight_item(in[16], FF, DM, (bf16*)(F.ws + WS_WDN0), r, scr, F.lane, 0); continue; } r -= I_DN;
        if (r < I_QKV) { cvt_weight_item(in[21], DM, 3 * DM, (bf16*)(F.ws + WS_WIN), r, scr, F.lane, 0); continue; } r -= I_QKV;
        if (r < I_O) { cvt_weight_item(in[34], DM, DM, (bf16*)(F.ws + WS_WOUT), r, scr, F.lane, 0); continue; } r -= I_O;
        if (r < I_UP) { cvt_weight_item(in[36], DM, 2 * FF, (bf16*)(F.ws + WS_WUP1), r, scr, F.lane, 2); continue; } r -= I_UP;
        cvt_weight_item(in[39], FF, DM, (bf16*)(F.ws + WS_WDN1), r, scr, F.lane, 0);
    }
}

__device__ __forceinline__ void row_prescale(const float* xrow, const float* gain, const float* sc, bf16* orow, float* ssq_out, int lane) {
    const GAS f32x4* xr = (const GAS f32x4*)xrow + lane;
    const GAS f32x4* gr = (const GAS f32x4*)gain + lane;
    const GAS f32x4* sr = (const GAS f32x4*)sc + lane;
    f32x4 v[4]; float s = 0.f;
#pragma unroll
    for (int j = 0; j < 4; ++j) { v[j] = xr[64 * j]; s += (v[j].x * v[j].x + v[j].y * v[j].y) + (v[j].z * v[j].z + v[j].w * v[j].w); }
    s = wave_sum(s);
    if (lane == 0) *ssq_out = s;
    GAS unsigned long long* o8 = (GAS unsigned long long*)orow + lane;
#pragma unroll
    for (int j = 0; j < 4; ++j) { const f32x4 g = gr[64 * j], c = sr[64 * j]; const f32x4 w = v[j] * g * (c + 1.0f);
        o8[64 * j] = (unsigned long long)pk2(w.x, w.y) | ((unsigned long long)pk2(w.z, w.w) << 32); }
}
__device__ __forceinline__ void phase0b(Frame& F) {
    const float* const* in = F.in;
    const float* mods = (const float*)(F.ws + CT_MODS);
    const int gw = F.vcu * NWAVES + F.wave, NGW = F.G * NWAVES;
    for (int m = gw; m < TT + TC; m += NGW) {
        if (m < TT) { const int b = m / SEQ; row_prescale(in[0] + (size_t)m * DM, in[6], mods + b * 6144 + 1024, (bf16*)(F.ws + WS_XS) + (size_t)m * DM, (float*)(F.ws + SM_SSQ0) + m, F.lane); }
        else { const int mc = m - TT; row_prescale(in[2] + (size_t)mc * DM, in[6], mods + 4 * 6144 + 1024, (bf16*)(F.ws + WS_XSC) + (size_t)mc * DM, (float*)(F.ws + SM_SSQC) + mc, F.lane); }
    }
    {
        float* gn = (float*)(F.ws + SM_GN);
        for (int e = F.vcu * 512 + F.tid; e < 3 * 4 * 1024; e += F.G * 512) {
            const int i = e / 4096, b = (e / 1024) & 3, k = e & 1023;
            const float* g = in[i == 0 ? 7 : (i == 1 ? 19 : 20)];
            const float sc = mods[(i == 0 ? 0 : 1) * 5 * 6144 + b * 6144 + (i == 1 ? 1024 : 4096) + k];
            gn[e] = g[k] * (1.f + sc);
        }
    }
    {
        const int n_qkv = 48, n_up = 88, n_in = 48;
        const int nitems = n_qkv + n_up + n_in + n_up;
        LAS float* gs = (LAS float*)F.lds;
        for (int it0 = F.vcu; it0 < nitems; it0 += F.G) {
            int it = it0;
            if (it < n_qkv) { auto vf = [&](int r, int k) -> float { return mods[r * 6144 + k]; };
                gemv_det_item<5>(in[8], 3072, it * 64, (float*)(F.ws + CT_BQKV), 3072, nullptr, vf, F.tid, gs); continue; } it -= n_qkv;
            if (it < n_up) { auto vf = [&](int r, int k) -> float { return mods[r * 6144 + 3072 + k]; };
                gemv_det_item<4>(in[13], 5632, it * 64, (float*)(F.ws + CT_BUP0), 5632, nullptr, vf, F.tid, gs); continue; } it -= n_up;
            if (it < n_in) { auto vf = [&](int r, int k) -> float { return mods[5 * 6144 + r * 6144 + k]; };
                gemv_det_item<4>(in[21], 3072, it * 64, (float*)(F.ws + CT_BIN), 3072, in[22], vf, F.tid, gs); continue; } it -= n_in;
            { auto vf = [&](int r, int k) -> float { return mods[5 * 6144 + r * 6144 + 3072 + k]; };
                gemv_det_item<4>(in[36], 5632, it * 64, (float*)(F.ws + CT_BUP1), 5632, nullptr, vf, F.tid, gs); }
        }
        __syncthreads();
    }
}

using pg8::f32x4; using pg8::Unit;
__device__ __forceinline__ float row_rs(const float* ssq, int np, int row) {
    float s = 0.f;
    for (int i = 0; i < np; ++i) s += ssq[(size_t)i * TT + row];
    return 1.0f / sqrtf(s * (1.0f / 1024.0f) + EPS);
}
constexpr float QSCALE = 0.125f * 1.4426950408889634f;
template <int PART>
struct EpiQK {
    static constexpr bool PERM = true;
    bf16* dst; const float* ssq; int np; const float* bias; int bias_bstride; const float* gain; int seqlen;
    __device__ __forceinline__ void operator()(const f32x4 (&acc)[2][2][4][2], const Unit& u, int wr, int wc, int fr, int fq) const {
        const int head = 4 * u.pn + wc;
        const int b = (u.pm * 256) / seqlen;
        const float* bp = bias + (size_t)b * bias_bstride + PART * 1024 + head * 64 + 8 * fq;
        const float* gp = gain + 8 * fq;
        const float osc = PART == 0 ? QSCALE : 1.0f;
#pragma unroll
        for (int ai = 0; ai < 2; ++ai)
#pragma unroll
            for (int m = 0; m < 4; ++m) {
                const int row = u.pm * 256 + ai * 128 + wr * 64 + m * 16 + fr;
                const float rs = row_rs(ssq, np, row);
                f32x4 v[2][2]; float ss = 0.f;
#pragma unroll
                for (int bj = 0; bj < 2; ++bj)
#pragma unroll
                    for (int n = 0; n < 2; ++n) { v[bj][n] = acc[ai][bj][m][n] * rs + *(const f32x4*)(bp + 32 * bj + 4 * n); const f32x4 t = v[bj][n]; ss += (t.x * t.x + t.y * t.y) + (t.z * t.z + t.w * t.w); }
                ss += __shfl_xor(ss, 16); ss += __shfl_xor(ss, 32);
                const float rn = osc / sqrtf(ss * (1.0f / 64.0f) + EPS);
                const int tl = row - b * seqlen;
                bf16* rowp = (PART == 0) ? dst + (size_t)row * DM + head * 64 + 8 * fq
                                         : dst + ((((size_t)(b * NH + head) * (seqlen / 16) + (tl >> 4)) * 8 + fq) * 16 + (tl & 15)) * 8;
                constexpr int bjstep = (PART == 0) ? 32 : 4 * 16 * 8;
#pragma unroll
                for (int bj = 0; bj < 2; ++bj) { const f32x4 a0 = v[bj][0] * rn * *(const f32x4*)(gp + 32 * bj), a1 = v[bj][1] * rn * *(const f32x4*)(gp + 32 * bj + 4);
                    v4u w; w.x = pk2(a0.x, a0.y); w.y = pk2(a0.z, a0.w); w.z = pk2(a1.x, a1.y); w.w = pk2(a1.z, a1.w);
                    *(v4u*)(rowp + bjstep * bj) = w; }
                asm volatile("" ::: "memory");
            }
    }
};
struct EpiVT {
    static constexpr bool PERM = true;
    bf16* VTp; const float* ssq; int np; const float* bias; int bias_bstride; int seqlen;
    __device__ __forceinline__ void operator()(const f32x4 (&acc)[2][2][4][2], const Unit& u, int wr, int wc, int fr, int fq) const {
        const int head = 4 * u.pn + wc;
        const int b = (u.pm * 256) / seqlen;
        const float* bp = bias + (size_t)b * bias_bstride + 2048 + head * 64 + 8 * fq;
        const int odd = fr & 1;
        f32x4 bv[2][2];
#pragma unroll
        for (int bj = 0; bj < 2; ++bj)
#pragma unroll
            for (int n = 0; n < 2; ++n) bv[bj][n] = *(const f32x4*)(bp + 32 * bj + 4 * n);
#pragma unroll
        for (int ai = 0; ai < 2; ++ai)
#pragma unroll
            for (int m = 0; m < 4; ++m) {
                const int row = u.pm * 256 + ai * 128 + wr * 64 + m * 16 + fr;
                const float rs = row_rs(ssq, np, row);
                const int tl = row - b * seqlen;
                const int c16 = tl & 14, cpos = (c16 & 3) | ((c16 & 8) >> 1) | ((c16 & 4) << 1);
                bf16* vb = VTp + (((size_t)(b * NH + head) * (seqlen / 16) + (tl >> 4)) * 64 + 8 * fq + odd) * 16 + cpos;
#pragma unroll
                for (int bj = 0; bj < 2; ++bj)
#pragma unroll
                    for (int n = 0; n < 2; ++n) {
                        const f32x4 v = acc[ai][bj][m][n] * rs + bv[bj][n];
                        const unsigned w01 = pk2(v.x, v.y), w23 = pk2(v.z, v.w);
                        const unsigned p01 = (unsigned)__shfl_xor((int)w01, 1), p23 = (unsigned)__shfl_xor((int)w23, 1);
                        const unsigned o0 = odd ? ((w01 & 0xffff0000u) | (p01 >> 16)) : ((p01 << 16) | (w01 & 0xffffu));
                        const unsigned o1 = odd ? ((w23 & 0xffff0000u) | (p23 >> 16)) : ((p23 << 16) | (w23 & 0xffffu));
                        bf16* p = vb + (32 * bj + 4 * n) * 16;
                        *(unsigned*)p = o0; *(unsigned*)(p + 2 * 16) = o1;
                    }
            }
    }
};
template <bool BASE_F32, bool OUT_F32>
struct EpiRes {
    static constexpr bool PERM = true;
    const void* base; void* out; const float* gate; const float* bias; const float* gn; bf16* xs; float* ssq; float* hs;
    __device__ __forceinline__ void operator()(const f32x4 (&acc)[2][2][4][2], const Unit& u, int wr, int wc, int fr, int fq) const {
        const int b = (u.pm * 256) / SEQ;
        const int col0 = u.pn * 256 + wc * 32 + 8 * fq;
        constexpr int MB = BASE_F32 ? 2 : 4;
#pragma unroll
        for (int ai = 0; ai < 2; ++ai)
#pragma unroll
        for (int mb = 0; mb < 4; mb += MB) {
            f32x4 bf[MB][2][2]; v4u bh[MB][2];
#pragma unroll
            for (int mi = 0; mi < MB; ++mi) { const size_t off = (size_t)(u.pm * 256 + ai * 128 + wr * 64 + (mb + mi) * 16 + fr) * DM + col0;
#pragma unroll
                for (int bj = 0; bj < 2; ++bj) {
                    if (BASE_F32) { bf[mi][bj][0] = *(const f32x4*)((const float*)base + off + 128 * bj); bf[mi][bj][1] = *(const f32x4*)((const float*)base + off + 128 * bj + 4); }
                    else bh[mi][bj] = *(const v4u*)((const bf16*)base + off + 128 * bj); } }
#pragma unroll
            for (int mi = 0; mi < MB; ++mi) {
                const int m = mb + mi;
                const int rowl = ai * 128 + wr * 64 + m * 16 + fr;
                const size_t off = (size_t)(u.pm * 256 + rowl) * DM + col0;
                float ss = 0.f;
#pragma unroll
                for (int bj = 0; bj < 2; ++bj) {
                    const int c = col0 + 128 * bj;
                    f32x4 b0, b1;
                    if (BASE_F32) { b0 = bf[mi][bj][0]; b1 = bf[mi][bj][1]; }
                    else { const v4u w = bh[mi][bj]; b0 = (f32x4){bflo(w.x), bfhi(w.x), bflo(w.y), bfhi(w.y)}; b1 = (f32x4){bflo(w.z), bfhi(w.z), bflo(w.w), bfhi(w.w)}; }
                    f32x4 a0 = acc[ai][bj][m][0], a1 = acc[ai][bj][m][1];
                    if (bias) { a0 += *(const f32x4*)(bias + c); a1 += *(const f32x4*)(bias + c + 4); }
                    const f32x4 x0 = b0 + *(const f32x4*)(gate + (size_t)b * 6144 + c) * a0, x1 = b1 + *(const f32x4*)(gate + (size_t)b * 6144 + c + 4) * a1;
                    if (OUT_F32) { *(f32x4*)((float*)out + off + 128 * bj) = x0; *(f32x4*)((float*)out + off + 128 * bj + 4) = x1; }
                    else {
                        v4u w; w.x = pk2(x0.x, x0.y); w.y = pk2(x0.z, x0.w); w.z = pk2(x1.x, x1.y); w.w = pk2(x1.z, x1.w);
                        *(v4u*)((bf16*)out + off + 128 * bj) = w;
                        const f32x4 r0 = (f32x4){bflo(w.x), bfhi(w.x), bflo(w.y), bfhi(w.y)}, r1 = (f32x4){bflo(w.z), bfhi(w.z), bflo(w.w), bfhi(w.w)};
                        ss += (r0.x * r0.x + r0.y * r0.y) + (r0.z * r0.z + r0.w * r0.w) + (r1.x * r1.x + r1.y * r1.y) + (r1.z * r1.z + r1.w * r1.w);
                        const f32x4 q0 = r0 * *(const f32x4*)(gn + (size_t)b * 1024 + c), q1 = r1 * *(const f32x4*)(gn + (size_t)b * 1024 + c + 4);
                        v4u ws2; ws2.x = pk2(q0.x, q0.y); ws2.y = pk2(q0.z, q0.w); ws2.z = pk2(q1.x, q1.y); ws2.w = pk2(q1.z, q1.w);
                        *(v4u*)(xs + off + 128 * bj) = ws2;
                    }
                }
                if (!OUT_F32) { ss += __shfl_xor(ss, 16); ss += __shfl_xor(ss, 32); if (fq == 0) hs[rowl * 4 + wc] = ss; }
            }
            asm volatile("" ::: "memory");
        }
        if (!OUT_F32) {
            asm volatile("s_waitcnt lgkmcnt(0)" ::: "memory"); __builtin_amdgcn_s_barrier(); asm volatile("" ::: "memory");
            const int tid = threadIdx.x;
            if (tid < 256) { const f32x4 p = *(const f32x4*)(hs + tid * 4); ssq[(size_t)u.pn * TT + u.pm * 256 + tid] = ((p.x + p.y) + p.z) + p.w; }
        }
    }
};
struct EpiScaleBias {
    static constexpr bool PERM = true;
    bf16* O; int ldc; const float* ssq; int np; const float* bias; int bias_bstride;
    __device__ __forceinline__ void operator()(const f32x4 (&acc)[2][2][4][2], const Unit& u, int wr, int wc, int fr, int fq) const {
        const int b = (u.pm * 256) / SEQ;
        const int col0 = u.pn * 256 + wc * 32 + 8 * fq;
        f32x4 bv[2][2];
#pragma unroll
        for (int bj = 0; bj < 2; ++bj)
#pragma unroll
            for (int n = 0; n < 2; ++n) bv[bj][n] = *(const f32x4*)(bias + (size_t)b * bias_bstride + col0 + 128 * bj + 4 * n);
#pragma unroll
        for (int ai = 0; ai < 2; ++ai)
#pragma unroll
            for (int m = 0; m < 4; ++m) {
                const int row = u.pm * 256 + ai * 128 + wr * 64 + m * 16 + fr;
                const float rs = row_rs(ssq, np, row);
                bf16* rowp = O + (size_t)row * ldc + col0;
#pragma unroll
                for (int bj = 0; bj < 2; ++bj) { const f32x4 v0 = acc[ai][bj][m][0] * rs + bv[bj][0], v1 = acc[ai][bj][m][1] * rs + bv[bj][1];
                    v4u w; w.x = pk2(v0.x, v0.y); w.y = pk2(v0.z, v0.w); w.z = pk2(v1.x, v1.y); w.w = pk2(v1.z, v1.w);
                    *(v4u*)(rowp + 128 * bj) = w; }
            }
    }
};
__device__ __forceinline__ float gelu_as(float v) {
    const float av = fabsf(v), t = __builtin_amdgcn_rcpf(av * 0.2316418882f + 1.0f);
    float q = t * 0.5307027145f + (-0.7265760135f); q = q * t + 0.7107068705f; q = q * t + (-0.142248368f); q = q * t + 0.127414796f; q = q * t;
    const float e = __builtin_amdgcn_exp2f((v * v) * (-0.72134752044f));
    const float m = v * (q * e);
    return v < 0.f ? m : v - m;
}
template <int CTRL> __device__ __forceinline__ float dpp_f(float old, float src) {
    return __builtin_bit_cast(float, __builtin_amdgcn_update_dpp(__builtin_bit_cast(int, old), __builtin_bit_cast(int, src), CTRL, 0xf, 0xf, false));
}
struct EpiUpGlu {
    static constexpr bool PERM = true;
    bf16* act; const float* ssq; int np; const float* bias; const float* cw; const float* cb; float* Hg; float* Ha; float* hl;
    __device__ __forceinline__ void operator()(f32x4 (&acc)[2][2][4][2], const Unit& u, int wr, int wc, int fr, int fq) const {
        const int b = (u.pm * 256) / SEQ;
        const int j0 = u.pn * 128 + wc * 32 + 8 * fq;
        {
            f32x4 ba[2], bg[2];
#pragma unroll
            for (int n = 0; n < 2; ++n) { ba[n] = *(const f32x4*)(bias + (size_t)b * 5632 + j0 + 4 * n); bg[n] = *(const f32x4*)(bias + (size_t)b * 5632 + FF + j0 + 4 * n); }
#pragma unroll
            for (int ai = 0; ai < 2; ++ai)
#pragma unroll
                for (int m = 0; m < 4; ++m) { const int row = u.pm * 256 + ai * 128 + wr * 64 + m * 16 + fr; const float rs = row_rs(ssq, np, row);
#pragma unroll
                    for (int n = 0; n < 2; ++n) { acc[ai][0][m][n] = acc[ai][0][m][n] * rs + ba[n]; acc[ai][1][m][n] = acc[ai][1][m][n] * rs + bg[n]; }
                    if (m == 3) asm volatile("" ::: "memory"); }
        }
#pragma unroll
        for (int ai = 0; ai < 2; ++ai) { float* hp = hl + ((2 * ai + wr) * 2) * 128 + wc * 32 + 8 * fq;
            if (fr == 0) { *(f32x4*)(hp) = acc[ai][1][0][0]; *(f32x4*)(hp + 4) = acc[ai][1][0][1]; }
            if (fr == 15) { *(f32x4*)(hp + 128) = acc[ai][1][3][0]; *(f32x4*)(hp + 132) = acc[ai][1][3][1]; } }
        asm volatile("s_waitcnt lgkmcnt(0)" ::: "memory"); __builtin_amdgcn_s_barrier(); asm volatile("" ::: "memory");
        if (wr == 0 && fr < 2) { float* p = Hg + ((size_t)u.pm * 4 + fr) * FF + j0; *(f32x4*)p = acc[0][1][0][0]; *(f32x4*)(p + 4) = acc[0][1][0][1];
            if (fr == 0) { float* q = Ha + ((size_t)u.pm * 2) * FF + j0; *(f32x4*)q = acc[0][0][0][0]; *(f32x4*)(q + 4) = acc[0][0][0][1]; } }
        if (wr == 1 && fr >= 14) { float* p = Hg + ((size_t)u.pm * 4 + 2 + (fr - 14)) * FF + j0; *(f32x4*)p = acc[1][1][3][0]; *(f32x4*)(p + 4) = acc[1][1][3][1];
            if (fr == 15) { float* q = Ha + ((size_t)u.pm * 2 + 1) * FF + j0; *(f32x4*)q = acc[1][0][3][0]; *(f32x4*)(q + 4) = acc[1][0][3][1]; } }
#pragma unroll
        for (int n = 0; n < 2; ++n) {
            const f32x4 w0 = *(const f32x4*)(cw + j0 + 4 * n), w1 = *(const f32x4*)(cw + FF + j0 + 4 * n), w2 = *(const f32x4*)(cw + 2 * FF + j0 + 4 * n), cbv = *(const f32x4*)(cb + j0 + 4 * n);
#pragma unroll
            for (int ai = 0; ai < 2; ++ai) {
                const int gi = 2 * ai + wr;
                const f32x4 uph = *(const f32x4*)(hl + (((gi + 3) & 3) * 2 + 1) * 128 + wc * 32 + 8 * fq + 4 * n);
                const f32x4 dnh = *(const f32x4*)(hl + (((gi + 1) & 3) * 2) * 128 + wc * 32 + 8 * fq + 4 * n);
#pragma unroll
                for (int m = 0; m < 4; ++m) {
                    const int rowl = ai * 128 + wr * 64 + m * 16 + fr;
                    f32x4 r;
#pragma unroll
                    for (int e = 0; e < 4; ++e) {
                        const float g = acc[ai][1][m][n][e];
                        const float pu = (m > 0) ? dpp_f<0x121>(g, acc[ai][1][m > 0 ? m - 1 : 0][n][e]) : uph[e];
                        const float up = dpp_f<0x111>(pu, g);
                        const float pd = (m < 3) ? dpp_f<0x12f>(g, acc[ai][1][m < 3 ? m + 1 : 3][n][e]) : dnh[e];
                        const float dn = dpp_f<0x101>(pd, g);
                        const float cv = w0[e] * up + w1[e] * g + w2[e] * dn + cbv[e];
                        r[e] = acc[ai][0][m][n][e] * gelu_as(cv);
                    }
                    if (rowl != 0 && rowl != 255) { v2u w; w.x = pk2(r.x, r.y); w.y = pk2(r.z, r.w); *(v2u*)(act + (size_t)(u.pm * 256 + rowl) * FF + j0 + 4 * n) = w; }
                }
            }
        }
        asm volatile("s_waitcnt lgkmcnt(0)" ::: "memory"); __builtin_amdgcn_s_barrier(); asm volatile("" ::: "memory");
    }
};
__device__ __forceinline__ void glu_fix_phase(Frame& F, const float* cw, const float* cb) {
    const float* Hg = (const float*)(F.ws + WS_HG); const float* Ha = (const float*)(F.ws + WS_HA); bf16* act = (bf16*)(F.ws + WS_AG);
    const int total = (TT / 256) * 2 * FF;
    for (int e = F.vcu * 512 + F.tid; e < total; e += F.G * 512) {
        const int j = e % FF, which = (e / FF) & 1, pm = e / (2 * FF);
        const int t = pm * 256 + (which ? 255 : 0), tl = t % SEQ;
        float gm, g0, gp;
        if (which == 0) { gm = (tl == 0) ? 0.f : Hg[((size_t)(pm - 1) * 4 + 3) * FF + j]; g0 = Hg[((size_t)pm * 4 + 0) * FF + j]; gp = Hg[((size_t)pm * 4 + 1) * FF + j]; }
        else { gm = Hg[((size_t)pm * 4 + 2) * FF + j]; g0 = Hg[((size_t)pm * 4 + 3) * FF + j]; gp = (tl == SEQ - 1) ? 0.f : Hg[((size_t)(pm + 1) * 4 + 0) * FF + j]; }
        const float a = Ha[((size_t)pm * 2 + which) * FF + j];
        const float cv = cw[j] * gm + cw[FF + j] * g0 + cw[2 * FF + j] * gp + cb[j];
        act[(size_t)t * FF + j] = (bf16)f2bf(a * gelu_as(cv));
    }
}
struct EpiNull {
    static constexpr bool PERM = true;
    float* sink;
    __device__ __forceinline__ void operator()(const f32x4 (&acc)[2][2][4][2], const Unit& u, int wr, int wc, int fr, int fq) const {
        f32x4 s = {0.f, 0.f, 0.f, 0.f};
#pragma unroll
        for (int ai = 0; ai < 2; ++ai)
#pragma unroll
            for (int bj = 0; bj < 2; ++bj)
#pragma unroll
                for (int m = 0; m < 4; ++m)
#pragma unroll
                    for (int n = 0; n < 2; ++n) s += acc[ai][bj][m][n];
        if (u.pm == 100000) *(f32x4*)(sink + fr) = s;
    }
};
struct EpiInT {
    static constexpr bool PERM = true;
    bf16* UT; const float* ssq; int np; const float* bias;
    __device__ __forceinline__ void operator()(const f32x4 (&acc)[2][2][4][2], const Unit& u, int wr, int wc, int fr, int fq) const {
        const int b = (u.pm * 256) / SEQ;
        const int col0 = u.pn * 256 + wc * 32 + 8 * fq;
        const int odd = fr & 1;
        f32x4 bv[2][2];
#pragma unroll
        for (int bj = 0; bj < 2; ++bj)
#pragma unroll
            for (int n = 0; n < 2; ++n) bv[bj][n] = *(const f32x4*)(bias + (size_t)b * 3072 + col0 + 128 * bj + 4 * n);
#pragma unroll
        for (int ai = 0; ai < 2; ++ai)
#pragma unroll
            for (int m = 0; m < 4; ++m) {
                const int row = u.pm * 256 + ai * 128 + wr * 64 + m * 16 + fr;
                const int t = row - b * SEQ;
                const float rs = row_rs(ssq, np, row);
#pragma unroll
                for (int bj = 0; bj < 2; ++bj)
#pragma unroll
                    for (int n = 0; n < 2; ++n) { const f32x4 v = acc[ai][bj][m][n] * rs + bv[bj][n];
                        const unsigned w01 = pk2(v.x, v.y), w23 = pk2(v.z, v.w);
                        const unsigned p01 = (unsigned)__shfl_xor((int)w01, 1), p23 = (unsigned)__shfl_xor((int)w23, 1);
                        const unsigned o0 = odd ? ((w01 & 0xffff0000u) | (p01 >> 16)) : ((p01 << 16) | (w01 & 0xffffu));
                        const unsigned o1 = odd ? ((w23 & 0xffff0000u) | (p23 >> 16)) : ((p23 << 16) | (w23 & 0xffffu));
                        bf16* p = UT + ((size_t)b * 3072 + col0 + 128 * bj + 4 * n + odd) * SEQ + (t & ~1);
                        *(unsigned*)p = o0; *(unsigned*)(p + 2 * (size_t)SEQ) = o1; }
            }
    }
};

typedef short bf16x8 __attribute__((ext_vector_type(8)));
typedef float f32x16 __attribute__((ext_vector_type(16)));
typedef short s16x4 __attribute__((ext_vector_type(4)));
__device__ __forceinline__ unsigned cvtpk(float lo, float hi) { typedef float f2 __attribute__((ext_vector_type(2))); typedef __bf16 b2 __attribute__((ext_vector_type(2)));
    f2 v = {lo, hi}; b2 r = __builtin_convertvector(v, b2); return __builtin_bit_cast(unsigned, r); }
constexpr int BT_OFF = 64, BT_HEAD = 15 * 31;
__device__ __forceinline__ void attn_mfma_phase(Frame& F) {
    const bf16* Q = (const bf16*)(F.ws + WS_Q); const bf16* Kb = (const bf16*)(F.ws + WS_K); const bf16* VT = (const bf16*)(F.ws + WS_V);
    const bf16* Kc = (const bf16*)(F.ws + WS_KC); const bf16* VcT = (const bf16*)(F.ws + WS_VC);
    bf16* O = (bf16*)(F.ws + WS_O);
    const float* rpb = F.in[11];
    float* bt = (float*)F.lds;
    for (int e = F.tid; e < NH * BT_HEAD; e += 512) bt[BT_OFF + e] = rpb[e] * 1.4426950408889634f;
    __syncthreads();
    const int lane = F.lane, q = lane & 31, hi = lane >> 5;
    for (int g = F.vcu; g < NB * (GROWS / 8) * NH; g += F.G) {
        const int h = g & 15, rg = (g >> 4) & 15, b = g >> 8;
        const int r = rg * 8 + F.wave;
        const int r0 = min(max(r - WH / 2, 0), GROWS - WH);
        const size_t tok = (size_t)b * SEQ + r * GW + q;
        bf16x8 qf[2][4];
#pragma unroll
        for (int hf = 0; hf < 2; ++hf)
#pragma unroll
            for (int s4 = 0; s4 < 4; ++s4) qf[hf][s4] = *(const bf16x8*)(Q + (tok + 32 * hf) * DM + h * HD + 16 * s4 + 8 * hi);
        const f32x16 zero16 = {0.f, 0.f, 0.f, 0.f, 0.f, 0.f, 0.f, 0.f, 0.f, 0.f, 0.f, 0.f, 0.f, 0.f, 0.f, 0.f};
        f32x16 o[2][2] = {{zero16, zero16}, {zero16, zero16}};
        float lsum[2] = {0.f, 0.f};
#define ATT_LOAD(i, kf, va) do { \
            const bf16* kp_; const bf16* vp_; int sstr_; \
            if ((i) < 16) { const int rp_ = (i) >> 2, cb_ = (i) & 3, krow_ = r0 + 2 * rp_; \
                kp_ = Kb + ((((size_t)(b * NH + h) * (SEQ / 16) + (krow_ + (q >> 4)) * 4 + cb_) * 8 + hi) * 16 + (q & 15)) * 8; \
                vp_ = VT + (((size_t)(b * NH + h) * (SEQ / 16) + krow_ * 4 + cb_) * 64 + q) * 16 + 8 * hi; sstr_ = 4 * 64 * 16; } \
            else { const int j_ = (i) - 16; \
                kp_ = Kc + ((((size_t)(b * NH + h) * (CTXL / 16) + 2 * j_ + (q >> 4)) * 8 + hi) * 16 + (q & 15)) * 8; \
                vp_ = VcT + (((size_t)(b * NH + h) * (CTXL / 16) + 2 * j_) * 64 + q) * 16 + 8 * hi; sstr_ = 64 * 16; } \
            _Pragma("unroll") for (int s4 = 0; s4 < 4; ++s4) kf[s4] = *(const bf16x8*)(kp_ + s4 * (2 * 16 * 8)); \
            _Pragma("unroll") for (int dh = 0; dh < 2; ++dh) _Pragma("unroll") for (int s2 = 0; s2 < 2; ++s2) { const bf16* v_ = vp_ + dh * (32 * 16) + s2 * sstr_; \
                va[dh][s2] = *(const bf16x8*)v_; } } while (0)
#define ATT_HALF(i, kf, va, HF) do { \
            f32x16 sacc = zero16; \
            _Pragma("unroll") for (int s4 = 0; s4 < 4; ++s4) sacc = __builtin_amdgcn_mfma_f32_32x32x16_bf16(kf[s4], qf[HF][s4], sacc, 0, 0, 0); \
            float p[16]; \
            if ((i) < 16) { const int rp_ = (i) >> 2, cb_ = (i) & 3, krow_ = r0 + 2 * rp_; \
                const int c_ = 32 * HF + q, c0_ = min(max(c_ - WW / 2, 0), GW - WW), lo_ = c0_ - c_ + (WW - 1); \
                const int dcb = cb_ * 16 + 4 * hi - c_ + (WW - 1), dcl = dcb - lo_; \
                const float* btp = bt + BT_OFF + h * BT_HEAD + (krow_ - r + (WH - 1)) * 31 + dcb; \
                _Pragma("unroll") for (int rr = 0; rr < 16; ++rr) { const int kc = (rr & 3) + 8 * ((rr >> 2) & 1); \
                    const float e_ = __builtin_amdgcn_exp2f(sacc[rr] + btp[(rr >> 3) * 31 + kc]); \
                    p[rr] = ((unsigned)(dcl + kc) < (unsigned)WW) ? e_ : 0.f; lsum[HF] += p[rr]; } } \
            else { _Pragma("unroll") for (int rr = 0; rr < 16; ++rr) { p[rr] = __builtin_amdgcn_exp2f(sacc[rr]); lsum[HF] += p[rr]; } } \
            unsigned pw[8]; \
            _Pragma("unroll") for (int ii = 0; ii < 8; ++ii) pw[ii] = cvtpk(p[2 * ii], p[2 * ii + 1]); \
            _Pragma("unroll") for (int s2 = 0; s2 < 2; ++s2) { \
                const bf16x8 pb = __builtin_bit_cast(bf16x8, (v4u){pw[4 * s2], pw[4 * s2 + 1], pw[4 * s2 + 2], pw[4 * s2 + 3]}); \
                o[HF][0] = __builtin_amdgcn_mfma_f32_32x32x16_bf16(va[0][s2], pb, o[HF][0], 0, 0, 0); \
                o[HF][1] = __builtin_amdgcn_mfma_f32_32x32x16_bf16(va[1][s2], pb, o[HF][1], 0, 0, 0); } } while (0)
#define ATT_COMPUTE(i, kf, va) do { const int cbq_ = ((i) < 16) ? ((i) & 3) : 1; \
            if (cbq_ != 3) ATT_HALF(i, kf, va, 0); \
            if (cbq_ != 0) ATT_HALF(i, kf, va, 1); } while (0)
        bf16x8 kfA[4], kfB[4], vaA[2][2], vaB[2][2];
        ATT_LOAD(0, kfA, vaA);
#pragma unroll 1
        for (int i = 0; i < 24; i += 2) {
            ATT_LOAD(i + 1, kfB, vaB);
            ATT_COMPUTE(i, kfA, vaA);
            { const int i2 = (i + 2 < 24) ? i + 2 : 23; ATT_LOAD(i2, kfA, vaA); }
            ATT_COMPUTE(i + 1, kfB, vaB);
        }
#undef ATT_LOAD
#undef ATT_HALF
#undef ATT_COMPUTE
#pragma unroll
        for (int hf = 0; hf < 2; ++hf) {
            float l = lsum[hf]; l += __shfl_xor(l, 32);
            const float inv = 1.0f / l;
            bf16* op = O + (tok + 32 * hf) * DM + h * HD + 4 * hi;
#pragma unroll
            for (int gq = 0; gq < 4; ++gq) {
                v2u w0; w0.x = pk2(o[hf][0][4 * gq] * inv, o[hf][0][4 * gq + 1] * inv); w0.y = pk2(o[hf][0][4 * gq + 2] * inv, o[hf][0][4 * gq + 3] * inv);
                v2u w1; w1.x = pk2(o[hf][1][4 * gq] * inv, o[hf][1][4 * gq + 1] * inv); w1.y = pk2(o[hf][1][4 * gq + 2] * inv, o[hf][1][4 * gq + 3] * inv);
                *(v2u*)(op + 8 * gq) = w0; *(v2u*)(op + 32 + 8 * gq) = w1;
            }
        }
    }
    __syncthreads();
}

__device__ __forceinline__ void convglu_phase(Frame& F, const float* cw, const float* cb) {
    bf16* ag = (bf16*)(F.ws + WS_AG);
    const long nvec = (long)TT * (FF / 8);
    for (long e = (long)F.vcu * 512 + F.tid; e < nvec; e += (long)F.G * 512) {
        const int t = (int)(e / (FF / 8)), j0 = (int)(e % (FF / 8)) * 8;
        const int tl = t % SEQ;
        const bf16* rowp = ag + (size_t)t * (2 * FF);
        const v4u a = *(const v4u*)(rowp + j0);
        const v4u g0 = *(const v4u*)(rowp + FF + j0);
        v4u gm = (v4u){0u, 0u, 0u, 0u}, gp = (v4u){0u, 0u, 0u, 0u};
        if (tl > 0) gm = *(const v4u*)(rowp - 2 * FF + FF + j0);
        if (tl < SEQ - 1) gp = *(const v4u*)(rowp + 2 * FF + FF + j0);
        float av[8], g0v[8], gmv[8], gpv[8];
        av[0] = bflo(a.x); av[1] = bfhi(a.x); av[2] = bflo(a.y); av[3] = bfhi(a.y); av[4] = bflo(a.z); av[5] = bfhi(a.z); av[6] = bflo(a.w); av[7] = bfhi(a.w);
        g0v[0] = bflo(g0.x); g0v[1] = bfhi(g0.x); g0v[2] = bflo(g0.y); g0v[3] = bfhi(g0.y); g0v[4] = bflo(g0.z); g0v[5] = bfhi(g0.z); g0v[6] = bflo(g0.w); g0v[7] = bfhi(g0.w);
        gmv[0] = bflo(gm.x); gmv[1] = bfhi(gm.x); gmv[2] = bflo(gm.y); gmv[3] = bfhi(gm.y); gmv[4] = bflo(gm.z); gmv[5] = bfhi(gm.z); gmv[6] = bflo(gm.w); gmv[7] = bfhi(gm.w);
        gpv[0] = bflo(gp.x); gpv[1] = bfhi(gp.x); gpv[2] = bflo(gp.y); gpv[3] = bfhi(gp.y); gpv[4] = bflo(gp.z); gpv[5] = bfhi(gp.z); gpv[6] = bflo(gp.w); gpv[7] = bfhi(gp.w);
        float r[8];
#pragma unroll
        for (int i = 0; i < 8; ++i) { const int j = j0 + i; const float cv = cw[j] * gmv[i] + cw[FF + j] * g0v[i] + cw[2 * FF + j] * gpv[i] + cb[j]; r[i] = av[i] * gelu_f(cv); }
        v4u w; w.x = pk2(r[0], r[1]); w.y = pk2(r[2], r[3]); w.z = pk2(r[4], r[5]); w.w = pk2(r[6], r[7]);
        *(v4u*)(ag + (size_t)t * (2 * FF) + j0) = w;
    }
}

__device__ __forceinline__ void filtgen_phase(Frame& F) {
    const float* const* in = F.in;
    const float *w1 = in[25], *b1 = in[26], *w2 = in[27], *b2 = in[28], *w3 = in[29], *b3 = in[30], *wout = in[31], *freq = in[32];
    float* hT = (float*)(F.ws + WS_HT); float* fsqp = (float*)(F.ws + WS_FSQP);
    LAS float* zf = (LAS float*)(F.lds);
    LAS float* ha = zf + 16 * 36;
    LAS float* hb = ha + 16 * 64;
    const int tid = F.tid;
    for (int item = F.vcu; item < SEQ / 16; item += F.G) {
        const int l0 = item * 16;
        __syncthreads();
        for (int e = tid; e < 16 * 33; e += 512) {
            const int p = e / 33, i = e % 33, l = l0 + p;
            float v;
            if (i == 0) v = (float)l / 8191.0f;
            else { const int bi = (i - 1) & 15; const float band = 1e-4f + (float)bi * ((15.0f - 1e-4f) / 15.0f);
                const float w = (float)(2.0 * 3.14159265358979323846 / 8192.0) * (float)l; const float arg = band * w;
                v = (i <= 16) ? cosf(arg) : -sinf(arg); }
            zf[p * 36 + i] = v;
        }
        __syncthreads();
        for (int e = tid; e < 16 * 64; e += 512) { const int p = e >> 6, j = e & 63; float a = b1[j];
            for (int i = 0; i < 33; ++i) a += zf[p * 36 + i] * w1[i * 64 + j];
            ha[p * 64 + j] = sinf(freq[j] * a); }
        __syncthreads();
        for (int e = tid; e < 16 * 64; e += 512) { const int p = e >> 6, j = e & 63; float a = b2[j];
            for (int i = 0; i < 64; ++i) a += ha[p * 64 + i] * w2[i * 64 + j];
            hb[p * 64 + j] = sinf(freq[j] * a); }
        __syncthreads();
        for (int e = tid; e < 16 * 64; e += 512) { const int p = e >> 6, j = e & 63; float a = b3[j];
            for (int i = 0; i < 64; ++i) a += hb[p * 64 + i] * w3[i * 64 + j];
            ha[p * 64 + j] = sinf(freq[j] * a); }
        __syncthreads();
        float sq[2] = {0.f, 0.f};
        {
            float acc[4][16];
#pragma unroll
            for (int q = 0; q < 4; ++q)
#pragma unroll
                for (int p = 0; p < 16; ++p) acc[q][p] = 0.f;
#pragma unroll 2
            for (int j = 0; j < 64; ++j) {
                float w[4];
#pragma unroll
                for (int q = 0; q < 4; ++q) w[q] = wout[j * 2048 + tid + 512 * q];
#pragma unroll
                for (int p = 0; p < 16; ++p) { const float hv = ha[p * 64 + j];
#pragma unroll
                    for (int q = 0; q < 4; ++q) acc[q][p] += hv * w[q]; }
            }
            const float la = -15.350567286626973f, lb = -3.0701134573253946f;
#pragma unroll
            for (int q = 0; q < 4; ++q) {
                const int n = tid + 512 * q, dir = n >> 10, c = n & 1023;
                const float delta = fabsf(la + (float)c * ((lb - la) / 1023.0f));
                float* op = hT + ((size_t)dir * 1024 + c) * SEQ + l0;
                f32x4 ov[4];
#pragma unroll
                for (int p = 0; p < 16; ++p) { const float tpos = (float)(l0 + p) / 8191.0f; const float v = acc[q][p] * expf(-tpos * delta); ov[p >> 2][p & 3] = v; sq[q & 1] += v * v; }
#pragma unroll
                for (int p4 = 0; p4 < 4; ++p4) *(f32x4*)(op + 4 * p4) = ov[p4];
            }
        }
        fsqp[(size_t)item * 1024 + tid] = sq[0]; fsqp[(size_t)item * 1024 + tid + 512] = sq[1];
    }
    __syncthreads();
}

constexpr int F2_AO = 67584, F2_TW = 135168, F2_RED = 140 * 1024;
__device__ __forceinline__ void f2_load_tw(Frame& F, const cf* TWM) {
    cf* tw1 = (cf*)(F.lds + F2_TW);
    for (int e = F.tid; e < 544; e += 512) tw1[e] = e < 512 ? TWM[e] : TWM[16 * (e - 512)];
    __syncthreads();
}
__device__ __forceinline__ void filtfft_phase(Frame& F) {
    const float* hT = (const float*)(F.ws + WS_HT); const float* fsqp = (const float*)(F.ws + WS_FSQP);
    const cf* TWM = (const cf*)(F.ws + SM_TWM); const cf* TWN = (const cf*)(F.ws + SM_TWN);
    cf* Fsp = (cf*)(F.ws + WS_F);
    cf* aE = (cf*)F.lds; cf* aO = (cf*)(F.lds + F2_AO);
    const cf* tw1 = (const cf*)(F.lds + F2_TW); const cf* tw32 = tw1 + 512;
    float* red = (float*)(F.lds + F2_RED);
    f2_load_tw(F, TWM);
    for (int c = F.vcu; c < DM; c += F.G) {
        int tid = F.tid; FC_OPAQUE(tid);
        __syncthreads();
        red[tid] = fsqp[(size_t)tid * 1024 + c];
        __syncthreads();
        for (int st = 256; st > 0; st >>= 1) { if (tid < st) red[tid] += red[tid + st]; __syncthreads(); }
        const float nrm = 1.0f / sqrtf(red[0] + EPS);
        const float* hf = hT + (size_t)c * SEQ; const float* hb = hT + ((size_t)1024 + c) * SEQ;
        {
            cf v[16], w[16];
#pragma unroll
            for (int r = 0; r < 16; ++r) { const int n = tid + 512 * r; const float fa = hf[n] * nrm, fb = (n == 0) ? 0.f : hb[SEQ - n] * nrm;
                v[r].x = fa + fb; v[r].y = 0.f; cf t; t.x = fa - fb; t.y = 0.f; w[r] = cmul(t, TWN[n]); }
            f2_fwd_p1(v, tid, aE, tw1);
            f2_fwd_p1(w, tid, aO, tw1);
        }
        __syncthreads();
        f2_fwd_p2(tid, aE, tw32);
        f2_fwd_p2(tid, aO, tw32);
        __syncthreads();
        { const int path = tid >> 8, bf = tid & 255;
          f2_mid(bf, path ? aO : aE, (const cf*)nullptr, Fsp + ((size_t)c * 2 + path) * FC_M, 1.0f / 16384.0f); }
    }
    __syncthreads();
}

__device__ __forceinline__ void conv3_8(const v4u raw, float prev, float next, float w0, float w1, float w2, float bb, float* out) {
    float x[10]; x[0] = prev; x[9] = next;
    x[1] = bflo(raw.x); x[2] = bfhi(raw.x); x[3] = bflo(raw.y); x[4] = bfhi(raw.y); x[5] = bflo(raw.z); x[6] = bfhi(raw.z); x[7] = bflo(raw.w); x[8] = bfhi(raw.w);
#pragma unroll
    for (int i = 0; i < 8; ++i) out[i] = w0 * x[i] + w1 * x[i + 1] + w2 * x[i + 2] + bb;
}
__device__ __forceinline__ void hyena_fft_phase(Frame& F) {
    const float* const* in = F.in;
    const float* sw = in[23]; const float* sb = in[24]; const float* dbias = in[33];
    const bf16* UT = (const bf16*)(F.ws + WS_UT);
    const cf* TWM = (const cf*)(F.ws + SM_TWM); const cf* TWN = (const cf*)(F.ws + SM_TWN);
    const cf* Fsp = (const cf*)(F.ws + WS_F);
    cf* aE = (cf*)F.lds; cf* aO = (cf*)(F.lds + F2_AO);
    const cf* tw1 = (const cf*)(F.lds + F2_TW); const cf* tw32 = tw1 + 512;
    f2_load_tw(F, TWM);
    for (int unit = F.vcu; unit < 2 * DM; unit += F.G) {
        const int c = unit >> 1, b0 = (unit & 1) * 2;
        int tid = F.tid; FC_OPAQUE(tid);
        __syncthreads();
        {
            const float w10 = sw[1024 + c], w11 = sw[3072 + 1024 + c], w12 = sw[6144 + 1024 + c], bb1 = sb[1024 + c];
            const float wv0 = sw[2048 + c], wv1 = sw[3072 + 2048 + c], wv2 = sw[6144 + 2048 + c], bbv = sb[2048 + c];
#pragma unroll 1
            for (int h = 0; h < 2; ++h) {
                FC_OPAQUE(tid);
                const int t0 = (tid + 512 * h) * 8;
                float z[2][8];
#pragma unroll
                for (int bb = 0; bb < 2; ++bb) {
                    const bf16* x1r = UT + ((size_t)(b0 + bb) * 3072 + 1024 + c) * SEQ;
                    const bf16* vr = UT + ((size_t)(b0 + bb) * 3072 + 2048 + c) * SEQ;
                    const v4u x1raw = *(const v4u*)(x1r + t0), vraw = *(const v4u*)(vr + t0);
                    const float x1p = t0 > 0 ? bf2f(x1r[t0 - 1]) : 0.f, x1n = t0 + 8 < SEQ ? bf2f(x1r[t0 + 8]) : 0.f;
                    const float vp = t0 > 0 ? bf2f(vr[t0 - 1]) : 0.f, vn = t0 + 8 < SEQ ? bf2f(vr[t0 + 8]) : 0.f;
                    float x1c[8], vc[8];
                    conv3_8(x1raw, x1p, x1n, w10, w11, w12, bb1, x1c);
                    conv3_8(vraw, vp, vn, wv0, wv1, wv2, bbv, vc);
#pragma unroll
                    for (int i = 0; i < 8; ++i) z[bb][i] = x1c[i] * vc[i];
                }
                const int pb = F2_PIDX(t0);
#pragma unroll
                for (int i = 0; i < 8; ++i) { cf t; t.x = z[0][i]; t.y = z[1][i]; aE[pb + i] = t; }
            }
        }
        __syncthreads();
        cf wreg[16];
        FC_OPAQUE(tid);
        { const int pt = F2_PIDX(tid);
#pragma unroll
          for (int r = 0; r < 16; ++r) wreg[r] = aE[pt + 528 * r]; }
        const int path = tid >> 8, bf = tid & 255;
        cf freg[32];
        { const cf* fp = Fsp + ((size_t)c * 2 + path) * FC_M + bf;
#pragma unroll
          for (int i = 0; i < 32; ++i) freg[i] = fp[i * 256]; }
        {
            cf v[16];
#pragma unroll
            for (int r = 0; r < 16; ++r) v[r] = wreg[r];
            f2_fwd_p1(v, tid, aE, tw1);
            FC_OPAQUE(tid);
#pragma unroll
            for (int r = 0; r < 16; ++r) v[r] = cmul(wreg[r], TWN[tid + 512 * r]);
            f2_fwd_p1(v, tid, aO, tw1);
        }
        __syncthreads();
        f2_fwd_p2(tid, aE, tw32);
        f2_fwd_p2(tid, aO, tw32);
        __syncthreads();
        f2_mid(bf, path ? aO : aE, freg, (cf*)nullptr, 0.f);
        __syncthreads();
        f2_inv_p2(tid, aE, tw32);
        f2_inv_p2(tid, aO, tw32);
        __syncthreads();
        {
            cf ve[16], vo[16];
            f2_inv_p1(ve, tid, aE, tw1);
            f2_inv_p1(vo, tid, aO, tw1);
            const float db = dbias[c];
            FC_OPAQUE(tid);
            const int pt = F2_PIDX(tid);
#pragma unroll
            for (int r = 0; r < 16; ++r) { const int n = tid + 512 * r;
                const cf y = cadd(cconj(ve[r]), cmul(cconj(TWN[n]), cconj(vo[r])));
                cf o; o.x = y.x + wreg[r].x * db; o.y = y.y + wreg[r].y * db; aE[pt + 528 * r] = o; }
        }
        __syncthreads();
        {
            const float w00 = sw[c], w01 = sw[3072 + c], w02 = sw[6144 + c], bb0 = sb[c];
#pragma unroll 1
            for (int h = 0; h < 2; ++h) {
                FC_OPAQUE(tid);
                const int t0 = (tid + 512 * h) * 8;
                cf val[8];
                const int pb = F2_PIDX(t0);
#pragma unroll
                for (int i = 0; i < 8; ++i) val[i] = aE[pb + i];
#pragma unroll
                for (int bb = 0; bb < 2; ++bb) {
                    const bf16* x0r = UT + ((size_t)(b0 + bb) * 3072 + c) * SEQ;
                    const v4u raw = *(const v4u*)(x0r + t0);
                    const float xp = t0 > 0 ? bf2f(x0r[t0 - 1]) : 0.f, xn = t0 + 8 < SEQ ? bf2f(x0r[t0 + 8]) : 0.f;
                    float x0c[8]; conv3_8(raw, xp, xn, w00, w01, w02, bb0, x0c);
                    float p[8];
#pragma unroll
                    for (int i = 0; i < 8; ++i) p[i] = x0c[i] * (bb == 0 ? val[i].x : val[i].y);
                    v4u o; o.x = pk2(p[0], p[1]); o.y = pk2(p[2], p[3]); o.z = pk2(p[4], p[5]); o.w = pk2(p[6], p[7]);
                    *(v4u*)((bf16*)(F.ws + WS_XS) + ((size_t)(b0 + bb) * 1024 + c) * SEQ + t0) = o;
                }
            }
        }
    }
    __syncthreads();
}
__device__ __forceinline__ void transpose_p_phase(Frame& F) {
    const bf16* PT = (const bf16*)(F.ws + WS_XS); bf16* P = (bf16*)(F.ws + WS_P);
    LAS unsigned short* scr = (LAS unsigned short*)(F.lds + F.wave * 16384);
    const int gw = F.vcu * NWAVES + F.wave, NGW = F.G * NWAVES, lane = F.lane;
    const int ntile = NB * (DM / 64) * (SEQ / 64);
    for (int it = gw; it < ntile; it += NGW) {
        const int tb = it % (SEQ / 64), cb = (it / (SEQ / 64)) % (DM / 64), b = it / ((SEQ / 64) * (DM / 64));
        for (int rr = 0; rr < 64; ++rr) scr[rr * 66 + lane] = PT[((size_t)b * 1024 + cb * 64 + rr) * SEQ + tb * 64 + lane];
        LDS_WAIT(); asm volatile("" ::: "memory");
        for (int tt = 0; tt < 64; ++tt) P[((size_t)b * SEQ + tb * 64 + tt) * DM + cb * 64 + lane] = scr[lane * 66 + tt];
        LDS_WAIT(); asm volatile("" ::: "memory");
    }
}

constexpr int NPH = 15;
__global__ void __launch_bounds__(NWAVES * 64, 2) hybrid_fwd(Args args) {
    extern __shared__ __attribute__((aligned(16))) unsigned char lds[];
    Frame F;
    F.lds = (LAS unsigned char*)lds;
    F.tid = threadIdx.x; F.lane = F.tid & 63; F.wave = __builtin_amdgcn_readfirstlane(F.tid >> 6);
    F.G = gridDim.x; { const int bx = blockIdx.x; F.vcu = (F.G % 8 == 0) ? (bx % 8) * (F.G / 8) + bx / 8 : bx; }
    F.in = args.in; F.out = args.out; F.ws = args.ws;
    unsigned char* ws = args.ws;
    volatile LAS unsigned* MISC = (volatile LAS unsigned*)(F.lds + MISC_OFF);
    for (int u = F.tid; u < (LDS_BYTES - LDSCTL_OFF) / 4; u += NWAVES * 64) ((LAS unsigned*)(F.lds + LDSCTL_OFF))[u] = 0u;
    __syncthreads();
    XcdBarrier bar; bar.bar = (unsigned*)(ws + CT_BAR) + args.li * XCD_BAR_WORDS; bar.x = 0; bar.st = nullptr;
    const int lo = args.ph_lo, hi = args.ph_hi;
    if (hi - lo > 1) bar = xcd_barrier_post((unsigned*)(ws + CT_BAR) + args.li * XCD_BAR_WORDS, MISC + 8);
#ifndef EXP_PAIR
#define EXP_PAIR 0
#endif
#ifndef REP_MASK
#define REP_MASK 0
#endif
#define REPS(k) ((((REP_MASK) >> (k)) & 1) ? 2 : 1)
#ifndef PH_MASK
#define PH_MASK 0xFFFFFF
#endif
#define IN(k) ((((PH_MASK) >> (k)) & 1) && lo <= (k) && (k) < hi)
#define SEAM(k) do { if (IN(k) && IN((k) + 1)) xcd_barrier(bar); } while (0)
    const float* mods = (const float*)(ws + CT_MODS);
    const float* gnt = (const float*)(ws + SM_GN);
    float* ssqa = (float*)(ws + WS_SSQP);
    bf16* XS = (bf16*)(ws + WS_XS);

    if (IN(0)) { for (int rep = 0; rep < REPS(0); ++rep) { phase0a(F); filtgen_phase(F); } } SEAM(0);
    if (IN(1)) { for (int rep = 0; rep < REPS(1); ++rep) { phase0b(F); filtfft_phase(F); } } SEAM(1);
    if (IN(2)) for (int rep = 0; rep < REPS(2); ++rep) {
        { pg8::Gemm g{XS, (const bf16*)(ws + WS_WQKV), TT, DM, DM, DM}; pg8::StaticOrder S; S.init(TT, DM, F.G, (int)blockIdx.x);
          EpiQK<0> E{(bf16*)(ws + WS_Q), (const float*)(ws + SM_SSQ0), 1, (const float*)(ws + CT_BQKV), 3072, args.in[9], SEQ};
          pg8::gemm_phase<EpiQK<0>, pg8::StaticOrder, true, true>(F.lds, g, S, E); }
        { pg8::Gemm g{XS, (const bf16*)(ws + WS_WQKV) + (size_t)1024 * DM, TT, DM, DM, DM}; pg8::StaticOrder S; S.init(TT, DM, F.G, (int)blockIdx.x);
          EpiQK<1> E{(bf16*)(ws + WS_K), (const float*)(ws + SM_SSQ0), 1, (const float*)(ws + CT_BQKV), 3072, args.in[10], SEQ};
          pg8::gemm_phase<EpiQK<1>, pg8::StaticOrder, true, true>(F.lds, g, S, E); }
        { pg8::Gemm g{XS, (const bf16*)(ws + WS_WQKV) + (size_t)2048 * DM, TT, DM, DM, DM}; pg8::StaticOrder S; S.init(TT, DM, F.G, (int)blockIdx.x);
          EpiVT E{(bf16*)(ws + WS_V), (const float*)(ws + SM_SSQ0), 1, (const float*)(ws + CT_BQKV), 3072, SEQ};
          pg8::gemm_phase<EpiVT, pg8::StaticOrder, true, true>(F.lds, g, S, E); }
        { pg8::Gemm g{(const bf16*)(ws + WS_XSC), (const bf16*)(ws + WS_WQKV) + (size_t)1024 * DM, TC, DM, DM, DM}; pg8::StaticOrder S; S.init(TC, DM, F.G, (int)blockIdx.x);
          EpiQK<1> E{(bf16*)(ws + WS_KC), (const float*)(ws + SM_SSQC), 1, (const float*)(ws + CT_BQKV) + 4 * 3072, 0, args.in[10], CTXL};
          pg8::gemm_phase<EpiQK<1>, pg8::StaticOrder, true, true>(F.lds, g, S, E); }
        { pg8::Gemm g{(const bf16*)(ws + WS_XSC), (const bf16*)(ws + WS_WQKV) + (size_t)2048 * DM, TC, DM, DM, DM}; pg8::StaticOrder S; S.init(TC, DM, F.G, (int)blockIdx.x);
          EpiVT E{(bf16*)(ws + WS_VC), (const float*)(ws + SM_SSQC), 1, (const float*)(ws + CT_BQKV) + 4 * 3072, 0, CTXL};
          pg8::gemm_phase<EpiVT, pg8::StaticOrder, true, true>(F.lds, g, S, E); }
    } SEAM(2);
    if (IN(3)) { for (int rep = 0; rep < REPS(3); ++rep) attn_mfma_phase(F); } SEAM(3);
    if (IN(4)) for (int rep = 0; rep < REPS(4); ++rep) {
        pg8::Gemm g{(const bf16*)(ws + WS_O), (const bf16*)(ws + WS_WO), TT, DM, DM, DM}; pg8::StaticOrder S; S.init(TT, DM, F.G, (int)blockIdx.x);
        EpiRes<true, false> E{args.in[0], ws + WS_XB, mods + 2048, nullptr, gnt, XS, ssqa, (float*)(lds + RING_BYTES + 8192)};
        pg8::gemm_phase<EpiRes<true, false>, pg8::StaticOrder, true, true>(F.lds, g, S, E);
    } SEAM(4);
    if (IN(5)) for (int rep = 0; rep < REPS(5); ++rep) {
        pg8::Gemm g{XS, (const bf16*)(ws + WS_WUP0), TT, 2 * FF, DM, DM}; pg8::StaticOrder S; S.init(TT, 2 * FF, F.G, (int)blockIdx.x);
        EpiUpGlu E{(bf16*)(ws + WS_AG), ssqa, 4, (const float*)(ws + CT_BUP0), args.in[14], args.in[15], (float*)(ws + WS_HG), (float*)(ws + WS_HA), (float*)(lds + RING_BYTES)};
        pg8::gemm_phase<EpiUpGlu, pg8::StaticOrder, true, true>(F.lds, g, S, E);
    } SEAM(5);
    if (IN(6)) { for (int rep = 0; rep < REPS(6); ++rep) glu_fix_phase(F, args.in[14], args.in[15]); } SEAM(6);

    if (IN(7)) {
        pg8::Gemm g{(const bf16*)(ws + WS_AG), (const bf16*)(ws + WS_WDN0), TT, DM, FF, FF}; pg8::StaticOrder S; S.init(TT, DM, F.G, (int)blockIdx.x);
        EpiRes<false, false> E{ws + WS_XB, ws + WS_XB, mods + 5120, nullptr, gnt + 4096, XS, ssqa + 4 * TT, (float*)(lds + RING_BYTES + 8192)};
        pg8::gemm_phase<EpiRes<false, false>, pg8::StaticOrder, true, true>(F.lds, g, S, E);
    } SEAM(7);
    if (IN(8)) for (int rep = 0; rep < REPS(8); ++rep) {
        pg8::Gemm g{XS, (const bf16*)(ws + WS_WIN), TT, 3 * DM, DM, DM}; pg8::StaticOrder S; S.init(TT, 3 * DM, F.G, (int)blockIdx.x);
#ifdef EXP_P9
        EpiScaleBias E{(bf16*)(ws + WS_UT), 3 * DM, ssqa + 4 * TT, 4, (const float*)(ws + CT_BIN), 3072};
        pg8::gemm_phase<EpiScaleBias, pg8::StaticOrder, true, true>(F.lds, g, S, E);
#else
        EpiInT E{(bf16*)(ws + WS_UT), ssqa + 4 * TT, 4, (const float*)(ws + CT_BIN)};
        pg8::gemm_phase<EpiInT, pg8::StaticOrder, true, true>(F.lds, g, S, E);
#endif
    } SEAM(8);
    if (IN(9)) { for (int rep = 0; rep < REPS(9); ++rep) hyena_fft_phase(F); } SEAM(9);

    if (IN(10)) { for (int rep = 0; rep < REPS(10); ++rep) transpose_p_phase(F); } SEAM(10);
    if (IN(11)) {
        pg8::Gemm g{(const bf16*)(ws + WS_P), (const bf16*)(ws + WS_WOUT), TT, DM, DM, DM}; pg8::StaticOrder S; S.init(TT, DM, F.G, (int)blockIdx.x);
        EpiRes<false, false> E{ws + WS_XB, ws + WS_XB, mods + 5 * 6144 + 2048, args.in[35], gnt + 2 * 4096, XS, ssqa + 8 * TT, (float*)(lds + RING_BYTES + 8192)};
        pg8::gemm_phase<EpiRes<false, false>, pg8::StaticOrder, true, true>(F.lds, g, S, E);
    } SEAM(11);
    if (IN(12)) for (int rep = 0; rep < REPS(12); ++rep) {
        pg8::Gemm g{XS, (const bf16*)(ws + WS_WUP1), TT, 2 * FF, DM, DM}; pg8::StaticOrder S; S.init(TT, 2 * FF, F.G, (int)blockIdx.x);
        EpiUpGlu E{(bf16*)(ws + WS_AG), ssqa + 8 * TT, 4, (const float*)(ws + CT_BUP1), args.in[37], args.in[38], (float*)(ws + WS_HG), (float*)(ws + WS_HA), (float*)(lds + RING_BYTES)};
        pg8::gemm_phase<EpiUpGlu, pg8::StaticOrder, true, true>(F.lds, g, S, E);
    } SEAM(12);
    if (IN(13)) { glu_fix_phase(F, args.in[37], args.in[38]); } SEAM(13);
    if (IN(14)) {
        pg8::Gemm g{(const bf16*)(ws + WS_AG), (const bf16*)(ws + WS_WDN1), TT, DM, FF, FF}; pg8::StaticOrder S; S.init(TT, DM, F.G, (int)blockIdx.x);
        EpiRes<false, true> E{ws + WS_XB, args.out, mods + 5 * 6144 + 5120, nullptr, nullptr, nullptr, nullptr, nullptr};
        pg8::gemm_phase<EpiRes<false, true>, pg8::StaticOrder, true, true>(F.lds, g, S, E);
    }
#ifdef PROBE_NULL
    if (lo == 98) {
#if PROBE_NULL == 5
        pg8::Gemm g{XS, (const bf16*)(ws + WS_WUP0), TT, 2 * FF, DM, DM}; pg8::StaticOrder S; S.init(TT, 2 * FF, F.G, (int)blockIdx.x);
#elif PROBE_NULL == 4
        pg8::Gemm g{(const bf16*)(ws + WS_O), (const bf16*)(ws + WS_WO), TT, DM, DM, DM}; pg8::StaticOrder S; S.init(TT, DM, F.G, (int)blockIdx.x);
#elif PROBE_NULL == 7
        pg8::Gemm g{(const bf16*)(ws + WS_AG), (const bf16*)(ws + WS_WDN0), TT, DM, FF, FF}; pg8::StaticOrder S; S.init(TT, DM, F.G, (int)blockIdx.x);
#else
        pg8::Gemm g{XS, (const bf16*)(ws + WS_WQKV), TT, 3 * DM, DM, DM}; pg8::StaticOrder S; S.init(TT, 3 * DM, F.G, (int)blockIdx.x);
#endif
        EpiNull E{(float*)(ws + WS_FSQP)};
        pg8::gemm_phase<EpiNull, pg8::StaticOrder, true, true>(F.lds, g, S, E);
    }
#endif
#ifdef DUMP_SEL
    if (lo == 99) {
        float* o = args.out; const size_t n = (size_t)TT * DM;
        for (size_t e = (size_t)blockIdx.x * 512 + F.tid; e < n; e += (size_t)F.G * 512) {
            float v;
            if (DUMP_SEL == 1) { const float* h = (const float*)(ws + WS_HT); v = (e < (size_t)2 * 1024 * SEQ) ? h[e] : ((const float*)(ws + WS_FSQP))[e & 1023]; }
            else if (DUMP_SEL == 2) { const bf16* u = (const bf16*)(ws + WS_UT); v = bf2f(u[e]); }
            else if (DUMP_SEL == 3) { const bf16* u = (const bf16*)(ws + WS_UT); v = bf2f(u[e + (size_t)TT * DM]); }
            else if (DUMP_SEL == 4) { const bf16* u = (const bf16*)(ws + WS_UT); v = bf2f(u[e + (size_t)2 * TT * DM]); }
            else { const bf16* u = (const bf16*)(ws + WS_P); v = bf2f(u[e]); }
            o[e] = v;
        }
    }
#endif
#undef IN
#undef SEAM
}

extern "C" void kernel_launch(void* const* d_in, const int* in_sizes, int n_in, void* d_out, int out_size, void* d_ws, size_t ws_size, hipStream_t stream) {
    static int grid = 0;
    if (grid == 0) {
        if (n_in != 40 || out_size != TT * DM || ws_size < WS_END) { fprintf(stderr, "kernel_launch: unexpected shapes n_in %d out %d ws %zu\n", n_in, out_size, ws_size); grid = -1; return; }
        int dev = 0, cus = 0;
        if (hipGetDevice(&dev) != hipSuccess || hipDeviceGetAttribute(&cus, hipDeviceAttributeMultiprocessorCount, dev) != hipSuccess) { grid = -1; return; }
        if (hipFuncSetAttribute((const void*)hybrid_fwd, hipFuncAttributeMaxDynamicSharedMemorySize, LDS_BYTES) != hipSuccess) { fprintf(stderr, "kernel_launch: hipFuncSetAttribute failed\n"); grid = -1; return; }
        int per_cu = 0;
        if (hipOccupancyMaxActiveBlocksPerMultiprocessor(&per_cu, (const void*)hybrid_fwd, NWAVES * 64, LDS_BYTES) != hipSuccess || per_cu < 1) { fprintf(stderr, "kernel_launch: occupancy query says %d\n", per_cu); }
        (void)hipGetLastError();
        grid = cus;
    }
    if (grid < 0) return;
    (void)hipMemsetAsync((char*)d_ws + WS_CTL, 0, CTL_ZERO_BYTES, stream);
    Args a{};
    for (int i = 0; i < 40; ++i) a.in[i] = (const float*)d_in[i];
    a.out = (float*)d_out; a.ws = (unsigned char*)d_ws; a.repmask = REP_MASK;
#if defined(PROBE_NULL)
    {   const int k = PROBE_NULL; const int lo[3] = {0, 98, k}, hi[3] = {k, 99, NPH};
        for (int i = 0; i < 3; ++i) { a.ph_lo = lo[i]; a.ph_hi = hi[i]; a.li = i;
            hipLaunchKernelGGL(hybrid_fwd, dim3(grid), dim3(NWAVES * 64), LDS_BYTES, stream, a); } }
#elif defined(PROBE_PHASE)
    {   const int k = PROBE_PHASE; const int lo[4] = {0, k, k, k + 1}, hi[4] = {k, k + 1, k + 1, NPH};
        for (int i = 0; i < 4; ++i) { if (lo[i] >= hi[i]) continue; a.ph_lo = lo[i]; a.ph_hi = hi[i]; a.li = i;
            hipLaunchKernelGGL(hybrid_fwd, dim3(grid), dim3(NWAVES * 64), LDS_BYTES, stream, a); } }
#elif MK_ONE_LAUNCH
    a.ph_lo = 0; a.ph_hi = NPH;
    hipLaunchKernelGGL(hybrid_fwd, dim3(grid), dim3(NWAVES * 64), LDS_BYTES, stream, a);
#else
    for (int p = 0; p < PH_END; ++p) { a.ph_lo = p; a.ph_hi = p + 1; hipLaunchKernelGGL(hybrid_fwd, dim3(grid), dim3(NWAVES * 64), LDS_BYTES, stream, a); }
#ifdef DUMP_SEL
    a.ph_lo = 99; a.ph_hi = 100; hipLaunchKernelGGL(hybrid_fwd, dim3(grid), dim3(NWAVES * 64), LDS_BYTES, stream, a);
#endif
#endif
}
```

```cpp
#include <hip/hip_runtime.h>
#include <cstdio>
#include <cstdint>

#ifndef PH_END
#define PH_END 13
#endif
#ifndef MK_ONE_LAUNCH
#define MK_ONE_LAUNCH 1
#endif

namespace pg8 {
#define PG8_LAS __attribute__((address_space(3)))
typedef unsigned short bf16_t;
typedef short bf16x8 __attribute__((ext_vector_type(8)));
typedef float f32x4 __attribute__((ext_vector_type(4)));
typedef unsigned u32x4 __attribute__((ext_vector_type(4)));
constexpr int BM = 256, BK = 64, HALF = 128, HTB = HALF * BK * 2, STAGE_BYTES = 8 * HTB, NXCD = 8, WGM = 8;

__host__ __device__ __forceinline__ int lds_byte(int r, int c) { const int st = (r >> 4) * 2 + (c >> 5), rr = r & 15, cc = c & 31, ob = rr * 64 + cc * 2; return st * 1024 + (ob ^ (((ob >> 9) & 1) << 5)); }
__host__ __device__ __forceinline__ void stage_rc(int b, int& R, int& C) { const int st = b / 1024, sb = b % 1024, swz = sb ^ (((sb >> 9) & 1) << 5); R = (st >> 1) * 16 + swz / 64; C = (st & 1) * 32 + (swz % 64) / 2; }
__host__ __device__ __forceinline__ int perm32(int rho) { const int n = rho >> 4, i = rho & 15; return 8 * (i >> 2) + 4 * n + (i & 3); }

struct Unit { int pm, pn; };
struct Gemm { const bf16_t* A; const bf16_t* Bt; int M, N, K, lda; };

struct StaticOrder {
    int nM, nN, nwg, G, c;
    __host__ __device__ __forceinline__ void init(int M, int N, int G_, int c_) { nM = M / BM; nN = N / BM; nwg = nM * nN; G = G_; c = c_; }
    __host__ __device__ __forceinline__ bool next(int i, Unit& u) const {
        const long L = (long)i * G + c; if (L >= nwg) return false;
        int wgid = (int)L; { const int q = nwg / NXCD, r = nwg % NXCD, xcd = wgid % NXCD, off = wgid / NXCD; wgid = (xcd < r ? xcd * (q + 1) : r * (q + 1) + (xcd - r) * q) + off; }
        const int nig = WGM * nN, gid = wgid / nig, fm = gid * WGM, gsz = (nM - fm) < WGM ? (nM - fm) : WGM;
        u.pm = fm + ((wgid % nig) % gsz); u.pn = (wgid % nig) / gsz; return true;
    }
    __device__ __forceinline__ void a_ready(const Unit&) const {}
    __device__ __forceinline__ void done(const Unit&) const {}
};

__device__ __forceinline__ unsigned cvt_pk_bf16(float lo, float hi) { unsigned r; asm volatile("v_cvt_pk_bf16_f32 %0, %1, %2" : "=v"(r) : "v"(lo), "v"(hi)); return r; }

template <class E> __device__ __forceinline__ auto epi_prefetch(const E& e, const Unit& u, int) -> decltype(e.prefetch(u), void()) { e.prefetch(u); }
template <class E> __device__ __forceinline__ void epi_prefetch(const E&, const Unit&, long) {}
template <class Epi, class Sched, bool ALIGN_EPI = false, bool SP2 = false>
__device__ __forceinline__ void gemm_phase(PG8_LAS unsigned char* lds, const Gemm g, const Sched& S, const Epi& E) {
    const int tid = threadIdx.x, wid = __builtin_amdgcn_readfirstlane(tid >> 6), lane = tid & 63, wr = wid >> 2, wc = wid & 3, fr = lane & 15, fq = lane >> 4;
    const int K = g.K, nt = K / BK, lda = g.lda;
    unsigned voffA[2], voffB[2];
#pragma unroll
    for (int i = 0; i < 2; ++i) { int R, C; stage_rc(tid * 16 + i * 8192, R, C); const int Rb = Epi::PERM ? ((R & ~31) + perm32(R & 31)) : R;
        voffA[i] = (unsigned)(R * lda + C) * 2u; voffB[i] = (unsigned)(Rb * K + C) * 2u; }
    const size_t kstep = (size_t)(BK * 2);
    const size_t hstepA = (size_t)HALF * lda * 2, hstepB = (size_t)HALF * K * 2;
    const size_t tstepA = 2 * hstepA, tstepB = 2 * hstepB;
    const unsigned ldsw = (unsigned)wid * 1024u;
    const int aoff = lds_byte(wr * 64 + fr, fq * 8), boff = lds_byte(wc * 32 + fr, fq * 8);
#define PG8_SA(b, h) (((b) * 2 + (h)) * HTB)
#define PG8_SB(b, h) ((4 + (b) * 2 + (h)) * HTB)
#define PG8_STAGE(bufoff, gbase, voff) do { _Pragma("unroll") for (int _i = 0; _i < 2; ++_i) \
        __builtin_amdgcn_global_load_lds((const unsigned*)((const char*)(gbase) + (voff)[_i]), (PG8_LAS unsigned*)(lds + (bufoff) + ldsw + _i * 8192), 16, 0, 0); } while (0)
#define PG8_LDA(dst, b, h) do { _Pragma("unroll") for (int m = 0; m < 4; ++m) _Pragma("unroll") for (int k = 0; k < 2; ++k) dst[m][k] = *(const PG8_LAS bf16x8*)(lds + PG8_SA(b, h) + aoff + m * 2048 + k * 1024); } while (0)
#define PG8_LDB(dst, b, h) do { _Pragma("unroll") for (int n = 0; n < 2; ++n) _Pragma("unroll") for (int k = 0; k < 2; ++k) dst[n][k] = *(const PG8_LAS bf16x8*)(lds + PG8_SB(b, h) + boff + n * 2048 + k * 1024); } while (0)
#define PG8_MMA(ai, bj, At, Bt) do { __builtin_amdgcn_s_setprio(1); _Pragma("unroll") for (int m = 0; m < 4; ++m) _Pragma("unroll") for (int n = 0; n < 2; ++n) _Pragma("unroll") for (int k = 0; k < 2; ++k) \
        acc[ai][bj][m][n] = __builtin_amdgcn_mfma_f32_16x16x32_bf16(Bt[n][k], At[m][k], acc[ai][bj][m][n], 0, 0, 0); __builtin_amdgcn_s_setprio(0); } while (0)
#define PG8_WAIT_V(n) asm volatile("s_waitcnt vmcnt(" #n ")" ::: "memory")
#define PG8_WAIT_L(n) asm volatile("s_waitcnt lgkmcnt(" #n ")" ::: "memory")
#define PG8_BAR __builtin_amdgcn_s_barrier()
#define PG8_SCHED __builtin_amdgcn_sched_barrier(0)
    Unit cur, nxt; int ui = 0;
    if (!S.next(0, cur)) return;
    f32x4 acc[2][2][4][2];
#pragma unroll
    for (int a = 0; a < 2; ++a)
#pragma unroll
        for (int b = 0; b < 2; ++b)
#pragma unroll
            for (int m = 0; m < 4; ++m)
#pragma unroll
                for (int n = 0; n < 2; ++n) acc[a][b][m][n] = (f32x4){0.f, 0.f, 0.f, 0.f};
    bf16x8 At[4][2], B0[2][2], B1[2][2];
    const char* cA = (const char*)g.A + (size_t)cur.pm * tstepA; const char* cB = (const char*)g.Bt + (size_t)cur.pn * tstepB;
    S.a_ready(cur);
    epi_prefetch(E, cur, 0);
    if constexpr (SP2) {
        PG8_STAGE(PG8_SB(0, 0), cB, voffB); PG8_STAGE(PG8_SB(0, 1), cB + hstepB, voffB); PG8_STAGE(PG8_SA(0, 0), cA, voffA); PG8_STAGE(PG8_SA(0, 1), cA + hstepA, voffA);
        if (wr == 1) PG8_BAR;
        PG8_WAIT_V(2); PG8_BAR;
        PG8_STAGE(PG8_SB(1, 0), cB + kstep, voffB); PG8_STAGE(PG8_SA(1, 0), cA + kstep, voffA); PG8_STAGE(PG8_SB(1, 1), cB + hstepB + kstep, voffB);
        PG8_WAIT_V(6); PG8_BAR;
    } else {
        PG8_STAGE(PG8_SB(0, 0), cB, voffB); PG8_STAGE(PG8_SA(0, 0), cA, voffA); PG8_STAGE(PG8_SB(0, 1), cB + hstepB, voffB); PG8_STAGE(PG8_SA(0, 1), cA + hstepA, voffA);
        if (wr == 1) PG8_BAR;
        PG8_WAIT_V(4); PG8_BAR;
        PG8_STAGE(PG8_SB(1, 0), cB + kstep, voffB); PG8_STAGE(PG8_SA(1, 0), cA + kstep, voffA); PG8_STAGE(PG8_SB(1, 1), cB + hstepB + kstep, voffB);
        PG8_WAIT_V(6); PG8_BAR;
    }
    for (;;) {
        const bool has_next = S.next(ui + 1, nxt);
        const char* nA = has_next ? (const char*)g.A + (size_t)nxt.pm * tstepA : cA; const char* nB = has_next ? (const char*)g.Bt + (size_t)nxt.pn * tstepB : cB;
        for (int t = 0; t < nt; t += 2) {
            const bool last = (t == nt - 2);
            const char* a1 = cA + (size_t)(t + 1) * kstep;
            const char* a2 = last ? nA : cA + (size_t)(t + 2) * kstep; const char* b2 = last ? nB : cB + (size_t)(t + 2) * kstep;
            const char* a3 = a2 + kstep; const char* b3 = b2 + kstep;
            if (last && has_next) S.a_ready(nxt);
            if constexpr (SP2) {
            PG8_LDB(B0, 0, 0); PG8_LDB(B1, 0, 1); PG8_SCHED; PG8_LDA(At, 0, 0); PG8_STAGE(PG8_SA(1, 1), a1 + hstepA, voffA);
            PG8_WAIT_V(8); PG8_WAIT_L(0); PG8_BAR; PG8_MMA(0, 0, At, B0); PG8_MMA(0, 1, At, B1); PG8_BAR; PG8_SCHED;
            PG8_LDA(At, 0, 1); PG8_STAGE(PG8_SB(0, 0), b2, voffB); PG8_STAGE(PG8_SB(0, 1), b2 + hstepB, voffB); PG8_STAGE(PG8_SA(0, 0), a2, voffA);
            PG8_WAIT_V(8); PG8_WAIT_L(0); PG8_BAR; PG8_MMA(1, 0, At, B0); PG8_MMA(1, 1, At, B1); PG8_BAR; PG8_SCHED;
            PG8_LDB(B0, 1, 0); PG8_LDB(B1, 1, 1); PG8_SCHED; PG8_LDA(At, 1, 0); PG8_STAGE(PG8_SA(0, 1), a2 + hstepA, voffA);
            PG8_WAIT_V(8); PG8_WAIT_L(0); PG8_BAR; PG8_MMA(0, 0, At, B0); PG8_MMA(0, 1, At, B1); PG8_BAR; PG8_SCHED;
            PG8_LDA(At, 1, 1); PG8_STAGE(PG8_SB(1, 0), b3, voffB); PG8_STAGE(PG8_SB(1, 1), b3 + hstepB, voffB); PG8_STAGE(PG8_SA(1, 0), a3, voffA);
            PG8_WAIT_V(8); PG8_WAIT_L(0); PG8_BAR; PG8_MMA(1, 0, At, B0); PG8_MMA(1, 1, At, B1); PG8_BAR; PG8_SCHED;
            } else {
            PG8_LDB(B0, 0, 0); PG8_SCHED; PG8_LDA(At, 0, 0); PG8_STAGE(PG8_SA(1, 1), a1 + hstepA, voffA);
            PG8_WAIT_L(8); PG8_BAR; PG8_WAIT_L(0); PG8_MMA(0, 0, At, B0); PG8_BAR; PG8_SCHED;
            PG8_LDB(B1, 0, 1); PG8_STAGE(PG8_SB(0, 0), b2, voffB);
            PG8_BAR; PG8_WAIT_L(0); PG8_MMA(0, 1, At, B1); PG8_BAR;
            PG8_LDA(At, 0, 1); PG8_STAGE(PG8_SA(0, 0), a2, voffA);
            PG8_BAR; PG8_WAIT_L(0); PG8_MMA(1, 0, At, B0); PG8_BAR; PG8_SCHED;
            PG8_STAGE(PG8_SB(0, 1), b2 + hstepB, voffB);
            PG8_WAIT_V(6); PG8_BAR; PG8_MMA(1, 1, At, B1); PG8_BAR;
            PG8_LDB(B0, 1, 0); PG8_SCHED; PG8_LDA(At, 1, 0); PG8_STAGE(PG8_SA(0, 1), a2 + hstepA, voffA);
            PG8_WAIT_L(8); PG8_BAR; PG8_WAIT_L(0); PG8_MMA(0, 0, At, B0); PG8_BAR; PG8_SCHED;
            PG8_LDB(B1, 1, 1); PG8_STAGE(PG8_SB(1, 0), b3, voffB);
            PG8_BAR; PG8_WAIT_L(0); PG8_MMA(0, 1, At, B1); PG8_BAR;
            PG8_LDA(At, 1, 1); PG8_STAGE(PG8_SA(1, 0), a3, voffA);
            PG8_BAR; PG8_WAIT_L(0); PG8_MMA(1, 0, At, B0); PG8_BAR; PG8_SCHED;
            PG8_STAGE(PG8_SB(1, 1), b3 + hstepB, voffB);
            PG8_WAIT_V(6); PG8_BAR; PG8_MMA(1, 1, At, B1); PG8_BAR;
            }
        }
        if constexpr (ALIGN_EPI) { if (wr == 0) PG8_BAR; }
        E(acc, cur, wr, wc, fr, fq); S.done(cur);
        if (!has_next) break;
#pragma unroll
        for (int a = 0; a < 2; ++a)
#pragma unroll
            for (int b = 0; b < 2; ++b)
#pragma unroll
                for (int m = 0; m < 4; ++m)
#pragma unroll
                    for (int n = 0; n < 2; ++n) acc[a][b][m][n] = (f32x4){0.f, 0.f, 0.f, 0.f};
        cur = nxt; cA = nA; cB = nB; ++ui;
        epi_prefetch(E, cur, 0);
        if constexpr (ALIGN_EPI) { if (wr == 1) PG8_BAR; }
    }
    PG8_WAIT_V(0);
    if constexpr (!ALIGN_EPI) { if (wr == 0) PG8_BAR; }
    PG8_BAR;
#undef PG8_SA
#undef PG8_SB
#undef PG8_STAGE
#undef PG8_LDA
#undef PG8_LDB
#undef PG8_MMA
#undef PG8_WAIT_V
#undef PG8_WAIT_L
#undef PG8_BAR
#undef PG8_SCHED
}
}

constexpr int NB = 4, SEQ = 8192, DM = 1024, TT = NB * SEQ, CTXL = 256, TC = NB * CTXL, FF = 2816, NH = 16, HD = 64, GW = 64, GROWS = SEQ / GW;
constexpr int WH = 8, WW = 16;
constexpr float EPS = 1e-6f;
constexpr int NWAVES = 8;

constexpr size_t MiB = 1u << 20;
constexpr size_t WS_CTL = 0, CTL_ZERO_BYTES = 64 * 1024;
constexpr size_t CT_BAR = 4096;
constexpr size_t CT_MODS = 64 * 1024;
constexpr size_t CT_BQKV = CT_MODS + 2 * 5 * 6144 * 4;
constexpr size_t CT_BUP0 = CT_BQKV + 5 * 3072 * 4;
constexpr size_t CT_BIN  = CT_BUP0 + 4 * 5632 * 4;
constexpr size_t CT_BUP1 = CT_BIN + 4 * 3072 * 4;
constexpr size_t CT_END  = CT_BUP1 + 4 * 5632 * 4;
static_assert(CT_END <= 1 * MiB, "ctl region");
constexpr size_t SM_SSQ0 = 1 * MiB, SM_SSQC = SM_SSQ0 + 32768 * 4, SM_GN = SM_SSQC + 1024 * 4;
constexpr size_t WS_SSQP = 2 * MiB;
constexpr size_t WS_FSQP = 4 * MiB;
constexpr size_t WS_XB = 448 * MiB;
constexpr size_t WS_WQKV = 8 * MiB, WS_WO = 14 * MiB, WS_WUP0 = 16 * MiB, WS_WDN0 = 27 * MiB, WS_WIN = 33 * MiB, WS_WOUT = 39 * MiB, WS_WUP1 = 41 * MiB, WS_WDN1 = 52 * MiB;
constexpr size_t WS_XSC = 58 * MiB, WS_KC = 60 * MiB, WS_VC = 62 * MiB;
constexpr size_t WS_XS = 64 * MiB;
constexpr size_t WS_Q = 128 * MiB, WS_K = 192 * MiB, WS_V = 256 * MiB, WS_O = WS_Q;
constexpr size_t WS_AG = 128 * MiB;
constexpr size_t WS_HG = 308 * MiB, WS_HA = 314 * MiB;
constexpr size_t WS_UT = 128 * MiB;
constexpr size_t WS_HT = 128 * MiB;
constexpr size_t WS_F = 320 * MiB;
constexpr size_t SM_TWM = 1536 * 1024, SM_TWN = SM_TWM + 65536;
constexpr size_t WS_P = 384 * MiB;
constexpr size_t WS_END = 512 * MiB;

constexpr int RING_BYTES = 131072;
constexpr int LDS_BYTES = 163840;
constexpr int CB_LDS_OFF = 136 * 1024;
constexpr int LDSCTL_OFF = LDS_BYTES - 1024, MISC_OFF = LDSCTL_OFF + 320;

#define GAS __attribute__((address_space(1)))
#define LAS __attribute__((address_space(3)))
typedef unsigned short bf16;
typedef unsigned v4u __attribute__((ext_vector_type(4)));
typedef unsigned v2u __attribute__((ext_vector_type(2)));
typedef float f32x4 __attribute__((ext_vector_type(4)));
typedef GAS unsigned gu32;
#define RLX_AGENT __ATOMIC_RELAXED, __HIP_MEMORY_SCOPE_AGENT
#define LDS_WAIT() asm volatile("s_waitcnt lgkmcnt(0)" ::: "memory")
#define VM_WAIT() asm volatile("s_waitcnt vmcnt(0)" ::: "memory")
__device__ __forceinline__ unsigned f2bf(float f) { unsigned u = __builtin_bit_cast(unsigned, f); return (u + 0x7fffu + ((u >> 16) & 1u)) >> 16; }
__device__ __forceinline__ unsigned pk2(float lo, float hi) { return f2bf(lo) | (f2bf(hi) << 16); }
__device__ __forceinline__ float bf2f(unsigned short h) { return __builtin_bit_cast(float, (unsigned)h << 16); }
__device__ __forceinline__ float bflo(unsigned w) { return __builtin_bit_cast(float, w << 16); }
__device__ __forceinline__ float bfhi(unsigned w) { return __builtin_bit_cast(float, w & 0xffff0000u); }

#define FC_HD __device__ __forceinline__
typedef float cf __attribute__((ext_vector_type(2)));
FC_HD cf cmul(cf a, cf b) { const cf t = {-b.y, b.x}; return a.xx * b + a.yy * t; }
FC_HD cf cadd(cf a, cf b) { return a + b; }
FC_HD cf csub(cf a, cf b) { return a - b; }
FC_HD cf cconj(cf a) { cf r; r.x = a.x; r.y = -a.y; return r; }
FC_HD cf cmulnegi(cf a) { cf r; r.x = a.y; r.y = -a.x; return r; }
#define FC_OPAQUE(x) asm volatile("" : "+v"(x))
#define FC_PIDX(i) ((i) + (((i) >> 6) << 3))
#define FC_M 8192
#define FC_PADM (FC_M + FC_M / 8)
#define FC_S2 0.70710678118654752f
FC_HD void dft4(cf& a0, cf& a1, cf& a2, cf& a3) {
    const cf c0 = cadd(a0, a2), c1 = cadd(a1, a3), d0 = csub(a0, a2), d1 = cmulnegi(csub(a1, a3));
    a0 = cadd(c0, c1); a1 = cadd(d0, d1); a2 = csub(c0, c1); a3 = csub(d0, d1);
}
FC_HD void dft8(cf* v) {
    cf a0 = cadd(v[0], v[4]), a1 = cadd(v[1], v[5]), a2 = cadd(v[2], v[6]), a3 = cadd(v[3], v[7]);
    cf b0 = csub(v[0], v[4]), b1 = csub(v[1], v[5]), b2 = csub(v[2], v[6]), b3 = csub(v[3], v[7]);
    { cf t; t.x = (b1.x + b1.y) * FC_S2; t.y = (b1.y - b1.x) * FC_S2; b1 = t; }
    b2 = cmulnegi(b2);
    { cf t; t.x = (b3.y - b3.x) * FC_S2; t.y = (-b3.x - b3.y) * FC_S2; b3 = t; }
    dft4(a0, a1, a2, a3); dft4(b0, b1, b2, b3);
    v[0] = a0; v[2] = a1; v[4] = a2; v[6] = a3; v[1] = b0; v[3] = b1; v[5] = b2; v[7] = b3;
}
FC_HD void dft16(cf* v) {
    cf a[8], b[8];
    const float c1 = 0.92387953251128674f, s1 = 0.38268343236508977f;
#ifdef __HIP_DEVICE_COMPILE__
#pragma unroll
#endif
    for (int i = 0; i < 8; ++i) { a[i] = cadd(v[i], v[i + 8]); b[i] = csub(v[i], v[i + 8]); }
    { cf w; w.x = c1; w.y = -s1; b[1] = cmul(b[1], w); }
    { cf w; w.x = FC_S2; w.y = -FC_S2; b[2] = cmul(b[2], w); }
    { cf w; w.x = s1; w.y = -c1; b[3] = cmul(b[3], w); }
    b[4] = cmulnegi(b[4]);
    { cf w; w.x = -s1; w.y = -c1; b[5] = cmul(b[5], w); }
    { cf w; w.x = -FC_S2; w.y = -FC_S2; b[6] = cmul(b[6], w); }
    { cf w; w.x = -c1; w.y = -s1; b[7] = cmul(b[7], w); }
    dft8(a); dft8(b);
#ifdef __HIP_DEVICE_COMPILE__
#pragma unroll
#endif
    for (int i = 0; i < 8; ++i) { v[2 * i] = a[i]; v[2 * i + 1] = b[i]; }
}
template <int R> FC_HD void cpowers(cf w1, cf* w) {
    w[0].x = 1.f; w[0].y = 0.f; w[1] = w1;
#ifdef __HIP_DEVICE_COMPILE__
#pragma unroll
#endif
    for (int q = 2; q < R; ++q) w[q] = (q & 1) ? cmul(w[q - 1], w1) : cmul(w[q >> 1], w[q >> 1]);
}
template <class LP> FC_HD void fwd_pass1(cf* v, int tid, LP a, const cf* TWM) {
    dft16(v);
    FC_OPAQUE(tid);
    const cf w1 = TWM[tid]; cf cur = w1;
    const int pt = FC_PIDX(tid);
    a[pt] = v[0];
#ifdef __HIP_DEVICE_COMPILE__
#pragma unroll
#endif
    for (int q = 1; q < 16; ++q) { a[pt + 576 * q] = cmul(v[q], cur); cur = cmul(cur, w1); }
}
template <class LP> FC_HD void fwd_pass8(int tid, LP a, const cf* TWM, int s, int lgs) {
#pragma unroll 1
    for (int h = 0; h < 2; ++h) {
        FC_OPAQUE(tid);
        const int bf = tid + 512 * h, j = bf & (s - 1), base = (bf >> lgs) * 8 * s;
        const int pb = FC_PIDX(base + j), ps = (s == 64) ? 72 : 8;
        cf v[8];
#ifdef __HIP_DEVICE_COMPILE__
#pragma unroll
#endif
        for (int r = 0; r < 8; ++r) v[r] = a[pb + ps * r];
        dft8(v);
        const cf w1 = TWM[j]; cf cur = w1;
        a[pb] = v[0];
#ifdef __HIP_DEVICE_COMPILE__
#pragma unroll
#endif
        for (int q = 1; q < 8; ++q) { a[pb + ps * q] = cmul(v[q], cur); cur = cmul(cur, w1); }
    }
}
template <class LP> FC_HD void mid_pass(int tid, LP a, const cf* F, cf* Fout, float fscale) {
#pragma unroll 1
    for (int h = 0; h < 2; ++h) {
        FC_OPAQUE(tid);
        const int bf = tid + 512 * h, base = bf * 8, pb = FC_PIDX(base);
        cf v[8];
#ifdef __HIP_DEVICE_COMPILE__
#pragma unroll
#endif
        for (int r = 0; r < 8; ++r) v[r] = a[pb + r];
        dft8(v);
        if (F) {
#ifdef __HIP_DEVICE_COMPILE__
#pragma unroll
#endif
            for (int r = 0; r < 8; ++r) v[r] = cconj(cmul(v[r], F[base + r]));
            dft8(v);
#ifdef __HIP_DEVICE_COMPILE__
#pragma unroll
#endif
            for (int r = 0; r < 8; ++r) a[pb + r] = v[r];
        } else {
#ifdef __HIP_DEVICE_COMPILE__
#pragma unroll
#endif
            for (int r = 0; r < 8; ++r) { cf o; o.x = v[r].x * fscale; o.y = v[r].y * fscale; Fout[base + r] = o; }
        }
    }
}
template <class LP> FC_HD void mid_pass_reg(int tid, LP a, const cf* fr) {
#ifdef __HIP_DEVICE_COMPILE__
#pragma unroll
#endif
    for (int h = 0; h < 2; ++h) {
        FC_OPAQUE(tid);
        const int bf = tid + 512 * h, base = bf * 8, pb = FC_PIDX(base);
        cf v[8];
#ifdef __HIP_DEVICE_COMPILE__
#pragma unroll
#endif
        for (int r = 0; r < 8; ++r) v[r] = a[pb + r];
        dft8(v);
#ifdef __HIP_DEVICE_COMPILE__
#pragma unroll
#endif
        for (int r = 0; r < 8; ++r) v[r] = cconj(cmul(v[r], fr[h * 8 + r]));
        dft8(v);
#ifdef __HIP_DEVICE_COMPILE__
#pragma unroll
#endif
        for (int r = 0; r < 8; ++r) a[pb + r] = v[r];
    }
}
template <class LP> FC_HD void inv_pass8(int tid, LP a, const cf* TWM, int s, int lgs) {
#pragma unroll 1
    for (int h = 0; h < 2; ++h) {
        FC_OPAQUE(tid);
        const int bf = tid + 512 * h, j = bf & (s - 1), base = (bf >> lgs) * 8 * s;
        const int pb = FC_PIDX(base + j), ps = (s == 64) ? 72 : 8;
        cf v[8]; const cf w1 = TWM[j]; cf cur = w1;
        v[0] = a[FC_PIDX(base + j)];
#ifdef __HIP_DEVICE_COMPILE__
#pragma unroll
#endif
        for (int q = 1; q < 8; ++q) { v[q] = cmul(a[pb + ps * q], cur); cur = cmul(cur, w1); }
        dft8(v);
#ifdef __HIP_DEVICE_COMPILE__
#pragma unroll
#endif
        for (int r = 0; r < 8; ++r) a[pb + ps * r] = v[r];
    }
}
template <class LP> FC_HD void inv_pass1(cf* v, int tid, LP a, const cf* TWM) {
    FC_OPAQUE(tid);
    const cf w1 = TWM[tid]; cf cur = w1;
    const int pt = FC_PIDX(tid);
    v[0] = a[pt];
#ifdef __HIP_DEVICE_COMPILE__
#pragma unroll
#endif
    for (int q = 1; q < 16; ++q) { v[q] = cmul(a[pt + 576 * q], cur); cur = cmul(cur, w1); }
    dft16(v);
}

#define F2_PIDX(i) ((i) + ((i) >> 5))
#define F2_PADM (8192 + 256)
FC_HD void dft32(cf* v) {
    const float c[16] = {1.0f, 0.98078528040323043f, 0.92387953251128674f, 0.83146961230254524f, 0.70710678118654752f, 0.55557023301960218f, 0.38268343236508977f, 0.19509032201612825f,
                         0.0f, -0.19509032201612825f, -0.38268343236508977f, -0.55557023301960218f, -0.70710678118654752f, -0.83146961230254524f, -0.92387953251128674f, -0.98078528040323043f};
    const float s[16] = {0.0f, 0.19509032201612825f, 0.38268343236508977f, 0.55557023301960218f, 0.70710678118654752f, 0.83146961230254524f, 0.92387953251128674f, 0.98078528040323043f,
                         1.0f, 0.98078528040323043f, 0.92387953251128674f, 0.83146961230254524f, 0.70710678118654752f, 0.55557023301960218f, 0.38268343236508977f, 0.19509032201612825f};
#ifdef __HIP_DEVICE_COMPILE__
#pragma unroll
#endif
    for (int i = 0; i < 16; ++i) { const cf a = cadd(v[i], v[i + 16]); cf b = csub(v[i], v[i + 16]);
        if (i == 8) b = cmulnegi(b); else if (i != 0) { cf w; w.x = c[i]; w.y = -s[i]; b = cmul(b, w); }
        v[i] = a; v[i + 16] = b; }
    dft16(v); dft16(v + 16);
}
#define F2_Q(k) (2 * ((k) & 15) + ((k) >> 4))
template <class LP> FC_HD void f2_fwd_p1(cf* v, int tid, LP a, const cf* tw1) {
    dft16(v);
    FC_OPAQUE(tid);
    const cf w1 = tw1[tid]; cf cur = w1;
    const int pt = F2_PIDX(tid);
    a[pt] = v[0];
#ifdef __HIP_DEVICE_COMPILE__
#pragma unroll
#endif
    for (int q = 1; q < 16; ++q) { a[pt + 528 * q] = cmul(v[q], cur); cur = cmul(cur, w1); }
}
template <class LP> FC_HD void f2_fwd_p2(int tid, LP a, const cf* tw32) {
    FC_OPAQUE(tid);
    const int j = tid & 31, pb = F2_PIDX((tid >> 5) * 512 + j);
    cf v[16];
#ifdef __HIP_DEVICE_COMPILE__
#pragma unroll
#endif
    for (int r = 0; r < 16; ++r) v[r] = a[pb + 33 * r];
    dft16(v);
    const cf w1 = tw32[j]; cf cur = w1;
    a[pb] = v[0];
#ifdef __HIP_DEVICE_COMPILE__
#pragma unroll
#endif
    for (int q = 1; q < 16; ++q) { a[pb + 33 * q] = cmul(v[q], cur); cur = cmul(cur, w1); }
}
template <class LP> FC_HD void f2_fwd_p2_dual(int tid, LP a, LP b, const cf* tw32) {
    FC_OPAQUE(tid);
    const int j = tid & 31, pb = F2_PIDX((tid >> 5) * 512 + j);
    cf v[16], w[16];
#ifdef __HIP_DEVICE_COMPILE__
#pragma unroll
#endif
    for (int r = 0; r < 16; ++r) v[r] = a[pb + 33 * r];
#ifdef __HIP_DEVICE_COMPILE__
#pragma unroll
#endif
    for (int r = 0; r < 16; ++r) w[r] = b[pb + 33 * r];
    const cf w1 = tw32[j];
    dft16(v);
    { cf cur = w1; a[pb] = v[0];
#ifdef __HIP_DEVICE_COMPILE__
#pragma unroll
#endif
      for (int q = 1; q < 16; ++q) { a[pb + 33 * q] = cmul(v[q], cur); cur = cmul(cur, w1); } }
    dft16(w);
    { cf cur = w1; b[pb] = w[0];
#ifdef __HIP_DEVICE_COMPILE__
#pragma unroll
#endif
      for (int q = 1; q < 16; ++q) { b[pb + 33 * q] = cmul(w[q], cur); cur = cmul(cur, w1); } }
}
template <class LP> FC_HD void f2_inv_p2_dual(int tid, LP a, LP b, const cf* tw32) {
    FC_OPAQUE(tid);
    const int j = tid & 31, pb = F2_PIDX((tid >> 5) * 512 + j);
    cf v[16], w[16]; const cf w1 = tw32[j];
#ifdef __HIP_DEVICE_COMPILE__
#pragma unroll
#endif
    for (int r = 0; r < 16; ++r) v[r] = a[pb + 33 * r];
#ifdef __HIP_DEVICE_COMPILE__
#pragma unroll
#endif
    for (int r = 0; r < 16; ++r) w[r] = b[pb + 33 * r];
    { cf cur = w1;
#ifdef __HIP_DEVICE_COMPILE__
#pragma unroll
#endif
      for (int q = 1; q < 16; ++q) { v[q] = cmul(v[q], cur); cur = cmul(cur, w1); } }
    dft16(v);
#ifdef __HIP_DEVICE_COMPILE__
#pragma unroll
#endif
    for (int r = 0; r < 16; ++r) a[pb + 33 * r] = v[r];
    { cf cur = w1;
#ifdef __HIP_DEVICE_COMPILE__
#pragma unroll
#endif
      for (int q = 1; q < 16; ++q) { w[q] = cmul(w[q], cur); cur = cmul(cur, w1); } }
    dft16(w);
#ifdef __HIP_DEVICE_COMPILE__
#pragma unroll
#endif
    for (int r = 0; r < 16; ++r) b[pb + 33 * r] = w[r];
}
template <class LP> FC_HD void f2_mid(int bf, LP a, const cf* fr, cf* Fout, float fscale) {
    FC_OPAQUE(bf);
    const int pb = 33 * bf;
    cf v[32];
#ifdef __HIP_DEVICE_COMPILE__
#pragma unroll
#endif
    for (int i = 0; i < 32; ++i) v[i] = a[pb + i];
    dft32(v);
    if (fr) {
        cf w[32];
#ifdef __HIP_DEVICE_COMPILE__
#pragma unroll
#endif
        for (int k = 0; k < 32; ++k) w[F2_Q(k)] = cconj(cmul(v[k], fr[F2_Q(k)]));
        dft32(w);
#ifdef __HIP_DEVICE_COMPILE__
#pragma unroll
#endif
        for (int k = 0; k < 32; ++k) a[pb + F2_Q(k)] = w[k];
    } else {
#ifdef __HIP_DEVICE_COMPILE__
#pragma unroll
#endif
        for (int k = 0; k < 32; ++k) { cf o; o.x = v[k].x * fscale; o.y = v[k].y * fscale; Fout[F2_Q(k) * 256 + bf] = o; }
    }
}
template <class LP> FC_HD void f2_inv_p2(int tid, LP a, const cf* tw32) {
    FC_OPAQUE(tid);
    const int j = tid & 31, pb = F2_PIDX((tid >> 5) * 512 + j);
    cf v[16]; const cf w1 = tw32[j]; cf cur = w1;
    v[0] = a[pb];
#ifdef __HIP_DEVICE_COMPILE__
#pragma unroll
#endif
    for (int q = 1; q < 16; ++q) { v[q] = cmul(a[pb + 33 * q], cur); cur = cmul(cur, w1); }
    dft16(v);
#ifdef __HIP_DEVICE_COMPILE__
#pragma unroll
#endif
    for (int r = 0; r < 16; ++r) a[pb + 33 * r] = v[r];
}
template <class LP> FC_HD void f2_inv_p1(cf* v, int tid, LP a, const cf* tw1) {
    FC_OPAQUE(tid);
    const cf w1 = tw1[tid]; cf cur = w1;
    const int pt = F2_PIDX(tid);
    v[0] = a[pt];
#ifdef __HIP_DEVICE_COMPILE__
#pragma unroll
#endif
    for (int q = 1; q < 16; ++q) { v[q] = cmul(a[pt + 528 * q], cur); cur = cmul(cur, w1); }
    dft16(v);
}

#define XB_TMO      128
#define XB_XCNT(j)  (256  + 64 * (j))
#define XB_XSUB(j)  (1280 + 64 * (j))
#define XB_XGEN(j)  (2304 + 64 * (j))
#define XB_TOP      3328
#define XB_TOPGEN   3392
#define XCD_BAR_WORDS 3456
#define XB_SPIN_CAP (1u << 18)
__device__ __forceinline__ unsigned xb_ld(unsigned* p)              { return __hip_atomic_load(p, __ATOMIC_RELAXED, __HIP_MEMORY_SCOPE_AGENT); }
__device__ __forceinline__ unsigned xb_add(unsigned* p, unsigned v) { return __hip_atomic_fetch_add(p, v, __ATOMIC_RELAXED, __HIP_MEMORY_SCOPE_AGENT); }
__device__ __forceinline__ unsigned xb_xcc_id() { return (unsigned)__builtin_amdgcn_s_getreg((3 << 11) | 20) & 0xFu; }
#define XB_SPIN(cond, bar) do { unsigned _sp = 0; while (cond) { __builtin_amdgcn_s_sleep(1); \
    if ((++_sp & 255u) == 0u) { if (xb_ld(&(bar)[XB_TMO])) break; if (_sp > XB_SPIN_CAP) { atomicAdd(&(bar)[XB_TMO], 1u); break; } } } } while (0)
struct XcdBarrier { unsigned* bar; unsigned x; volatile LAS unsigned* st; };
__device__ __forceinline__ XcdBarrier xcd_barrier_post(unsigned* bar, volatile LAS unsigned* st) {
    XcdBarrier b; b.bar = bar; b.x = xb_xcc_id(); b.st = st;
    if (threadIdx.x == 0) (void)xb_add(&bar[XB_XCNT(b.x)], 1u);
    return b;
}
__device__ __forceinline__ void xcd_barrier_complete(unsigned* bar, unsigned x, unsigned& nloc, unsigned& nx) {
    const unsigned G = gridDim.x * gridDim.y * gridDim.z;
    unsigned sum, cnt, mine, sp = 0u;
    for (;;) {
        sum = 0u; cnt = 0u; mine = 0u;
#pragma unroll
        for (unsigned j = 0; j < 16; ++j) { const unsigned c = xb_ld(&bar[XB_XCNT(j)]); sum += c; cnt += (c > 0u) ? 1u : 0u; mine = (j == x) ? c : mine; }
        if (sum == G) break;
        __builtin_amdgcn_s_sleep(1);
        if ((++sp & 255u) == 0u) { if (xb_ld(&bar[XB_TMO])) break; if (sp > XB_SPIN_CAP) { atomicAdd(&bar[XB_TMO], 1u); break; } }
    }
    nloc = mine > 0u ? mine : 1u; nx = cnt > 0u ? cnt : 1u;
}
__device__ __forceinline__ void xcd_barrier(const XcdBarrier& b) {
    asm volatile("s_waitcnt vmcnt(0)" ::: "memory");
    __syncthreads();
    if (threadIdx.x == 0) {
        unsigned* bar = b.bar;
        __builtin_amdgcn_s_waitcnt(0);
        unsigned nloc = b.st[0], nx = b.st[1];
        if (nloc == 0u) { xcd_barrier_complete(bar, b.x, nloc, nx); b.st[0] = nloc; b.st[1] = nx; }
        const unsigned old = xb_add(&bar[XB_XSUB(b.x)], 1u);
        const unsigned gen = old / nloc;
        if (old + 1u == (gen + 1u) * nloc) {
            __builtin_amdgcn_fence(__ATOMIC_RELEASE, "agent");
            asm volatile("s_waitcnt vmcnt(0)" ::: "memory");
            const unsigned og = xb_add(&bar[XB_TOP], 1u);
            const unsigned tg = og / nx;
            if (og + 1u == (tg + 1u) * nx) xb_add(&bar[XB_TOPGEN], 1u);
            else XB_SPIN(xb_ld(&bar[XB_TOPGEN]) == tg, bar);
            __builtin_amdgcn_fence(__ATOMIC_ACQUIRE, "agent");
            xb_add(&bar[XB_XGEN(b.x)], 1u);
            asm volatile("s_waitcnt vmcnt(0)" ::: "memory");
        } else {
            XB_SPIN(xb_ld(&bar[XB_XGEN(b.x)]) == gen, bar);
            __builtin_amdgcn_fence(__ATOMIC_ACQUIRE, "agent");
            asm volatile("s_waitcnt vmcnt(0)" ::: "memory");
        }
    }
    __syncthreads();
}

struct Args { const float* in[40]; float* out; unsigned char* ws; int ph_lo, ph_hi, repmask, li; };
struct Frame {
    LAS unsigned char* lds;
    int tid, lane, wave, vcu, G;
    const float* const* in; float* out; unsigned char* ws;
};
__device__ __forceinline__ float wave_sum(float v) {
#pragma unroll
    for (int o = 1; o < 64; o <<= 1) v += __shfl_xor(v, o);
    return v;
}
__device__ __forceinline__ float silu_f(float x) { return x / (1.f + __expf(-x)); }

__device__ __forceinline__ float gelu_f(float v) { return 0.5f * v * (1.f + erff(v * 0.70710678118654752f)); }

__device__ __forceinline__ void transpose_item(const float* W, int K, int N, bf16* WT, int src_col0, int dst_row0, int k0, LAS float* scr, int lane) {
    {
        const int r8 = lane >> 3, c4 = (lane & 7) * 4;
        f32x4 x[8];
#pragma unroll
        for (int i = 0; i < 8; ++i) x[i] = *(const f32x4*)(W + (size_t)(k0 + 8 * i + r8) * N + src_col0 + c4);
#pragma unroll
        for (int i = 0; i < 8; ++i) { LAS float* d = scr + (8 * i + r8) * 33 + c4; d[0] = x[i].x; d[1] = x[i].y; d[2] = x[i].z; d[3] = x[i].w; }
    }
    LDS_WAIT(); asm volatile("" ::: "memory");
    const int c = lane & 7;
#pragma unroll
    for (int j = 0; j < 4; ++j) { const int n = (lane >> 3) + 8 * j; const LAS float* s = scr + (8 * c) * 33 + n;
        v4u o; o.x = pk2(s[0 * 33], s[1 * 33]); o.y = pk2(s[2 * 33], s[3 * 33]); o.z = pk2(s[4 * 33], s[5 * 33]); o.w = pk2(s[6 * 33], s[7 * 33]);
        *(GAS v4u*)(WT + (size_t)(dst_row0 + n) * K + k0 + 8 * c) = o; }
    LDS_WAIT(); asm volatile("" ::: "memory");
}
__device__ __forceinline__ void transpose_load(const float* W, int N, int src_col0, int k0, int lane, f32x4 (&x)[8]) {
    const int r8 = lane >> 3, c4 = (lane & 7) * 4;
#pragma unroll
    for (int i = 0; i < 8; ++i) x[i] = *(const f32x4*)(W + (size_t)(k0 + 8 * i + r8) * N + src_col0 + c4);
}
__device__ __forceinline__ void transpose_finish(const f32x4 (&x)[8], int K, bf16* WT, int dst_row0, int k0, LAS float* scr, int lane) {
    { const int r8 = lane >> 3, c4 = (lane & 7) * 4;
#pragma unroll
      for (int i = 0; i < 8; ++i) { LAS float* d = scr + (8 * i + r8) * 33 + c4; d[0] = x[i].x; d[1] = x[i].y; d[2] = x[i].z; d[3] = x[i].w; } }
    LDS_WAIT(); asm volatile("" ::: "memory");
    const int c = lane & 7;
#pragma unroll
    for (int j = 0; j < 4; ++j) { const int n = (lane >> 3) + 8 * j; const LAS float* s = scr + (8 * c) * 33 + n;
        v4u o; o.x = pk2(s[0 * 33], s[1 * 33]); o.y = pk2(s[2 * 33], s[3 * 33]); o.z = pk2(s[4 * 33], s[5 * 33]); o.w = pk2(s[6 * 33], s[7 * 33]);
        *(GAS v4u*)(WT + (size_t)(dst_row0 + n) * K + k0 + 8 * c) = o; }
    LDS_WAIT(); asm volatile("" ::: "memory");
}
__device__ __forceinline__ int qkv_slot_to_col(int slot) {
    const int part = slot >> 10, cc = slot & 1023, pnl = cc >> 8, s = cc & 255, bj = s >> 7, wc = (s & 127) >> 5, j = s & 31;
    return part * 1024 + (4 * pnl + wc) * 64 + 32 * bj + j;
}
__device__ __forceinline__ int up_slot_to_col(int slot) { const int pn = slot >> 8, bj = (slot >> 7) & 1, cc = slot & 127; return bj * FF + pn * 128 + cc; }
__device__ __forceinline__ void cvt_weight_item(const float* W, int K, int N, bf16* WT, int item, LAS float* scr, int lane, int perm) {
    const int nblk = N / 32, kb = item / nblk, nb = item % nblk;
    const int dst = 32 * nb, src = perm == 1 ? qkv_slot_to_col(dst) : (perm == 2 ? up_slot_to_col(dst) : dst);
    transpose_item(W, K, N, WT, src, dst, 64 * kb, scr, lane);
}

template <int R, class VF>
__device__ __forceinline__ void gemv_det_item(const float* W, int N, int n0, float* out, int ostride, const float* addbias, const VF& vf, int tid, LAS float* scr) {
    const int col = tid & 63, ks = tid >> 6;
    float acc[R];
#pragma unroll
    for (int r = 0; r < R; ++r) acc[r] = 0.f;
    const float* wp = W + (size_t)(ks * 128) * N + n0 + col;
#pragma unroll 8
    for (int k = 0; k < 128; ++k) { const float w = wp[(size_t)k * N];
#pragma unroll
        for (int r = 0; r < R; ++r) acc[r] += vf(r, ks * 128 + k) * w; }
    __syncthreads();
#pragma unroll
    for (int r = 0; r < R; ++r) scr[(ks * R + r) * 64 + col] = acc[r];
    __syncthreads();
    if (tid < R * 64) { const int r = tid >> 6; float s = 0.f;
#pragma unroll
        for (int k2 = 0; k2 < 8; ++k2) s += scr[(k2 * R + r) * 64 + col];
        if (addbias) s += addbias[n0 + col];
        out[(size_t)r * ostride + n0 + col] = s; }
}

template <int R, class VF>
__device__ __forceinline__ void gemv_det_item16(const float* W, int N, int n0, float* out, int ostride, const float* addbias, const VF& vf, int tid, LAS float* scr) {
    const int col = tid & 15, ks = tid >> 4;
    float acc[R];
#pragma unroll
    for (int r = 0; r < R; ++r) acc[r] = 0.f;
    const float* wp = W + (size_t)(ks * 32) * N + n0 + col;
#pragma unroll 8
    for (int k = 0; k < 32; ++k) { const float w = wp[(size_t)k * N];
#pragma unroll
        for (int r = 0; r < R; ++r) acc[r] += vf(r, ks * 32 + k) * w; }
    __syncthreads();
#pragma unroll
    for (int r = 0; r < R; ++r) scr[(ks * R + r) * 16 + col] = acc[r];
    __syncthreads();
    if (tid < R * 16) { const int r = tid >> 4; float s = 0.f;
#pragma unroll
        for (int k2 = 0; k2 < 32; ++k2) s += scr[(k2 * R + r) * 16 + col];
        if (addbias) s += addbias[n0 + col];
        out[(size_t)r * ostride + n0 + col] = s; }
}

__device__ __forceinline__ void phase0a(Frame& F) {
    const float* const* in = F.in;
    float* mods = (float*)(F.ws + CT_MODS);
    {
        const float* c = in[1]; const float* cctx = in[3];
        LAS float* sl = (LAS float*)(F.lds + 65536);
        for (int e = F.tid; e < 5 * DM; e += 512) { const float v = (e < 4 * DM) ? c[e] : cctx[e - 4 * DM]; sl[e] = silu_f(v); }
        __syncthreads();
        auto vf = [&](int r, int k) -> float { return sl[r * DM + k]; };
        const int nitems = 2 * 96;
        for (int it = F.vcu; it < nitems; it += F.G) {
            const int l = it / 96, cg = it % 96;
            gemv_det_item<5>(in[l ? 17 : 4], 6144, cg * 64, mods + l * 5 * 6144, 6144, in[l ? 18 : 5], vf, F.tid, (LAS float*)F.lds);
        }
        __syncthreads();
    }
    for (int e = F.vcu * 512 + F.tid; e < 16384; e += F.G * 512) {
        const int k = e & 8191; const bool isn = e >= 8192;
        float sn, cs; sincospif(isn ? (float)k * (1.0f / 8192.0f) : (float)k * (1.0f / 4096.0f), &sn, &cs);
        cf t; t.x = cs; t.y = -sn;
        ((cf*)(F.ws + (isn ? SM_TWN : SM_TWM)))[k] = t;
    }
    LAS float* scr = (LAS float*)(F.lds + F.wave * 16384);
    const int gw = F.vcu * NWAVES + F.wave, NGW = F.G * NWAVES;
    constexpr int I_QKV = 16 * 96, I_O = 16 * 32, I_UP = 16 * 176, I_DN = 44 * 32;
    constexpr int NITEMS = 2 * I_QKV + 2 * I_O + 2 * I_UP + 2 * I_DN;
    struct CvtD { const float* W; bf16* WT; int K, N, src, dst, k0; };
    auto desc = [&](int it) -> CvtD {
        int r = it; const float* W; bf16* WT; int K, N, perm = 0;
        if (r < I_QKV) { W = in[8]; K = DM; N = 3 * DM; WT = (bf16*)(F.ws + WS_WQKV); perm = 1; }
        else if ((r -= I_QKV) < I_O) { W = in[12]; K = DM; N = DM; WT = (bf16*)(F.ws + WS_WO); }
        else if ((r -= I_O) < I_UP) { W = in[13]; K = DM; N = 2 * FF; WT = (bf16*)(F.ws + WS_WUP0); perm = 2; }
        else if ((r -= I_UP) < I_DN) { W = in[16]; K = FF; N = DM; WT = (bf16*)(F.ws + WS_WDN0); }
        else if ((r -= I_DN) < I_QKV) { W = in[21]; K = DM; N = 3 * DM; WT = (bf16*)(F.ws + WS_WIN); }
        else if ((r -= I_QKV) < I_O) { W = in[34]; K = DM; N = DM; WT = (bf16*)(F.ws + WS_WOUT); }
        else if ((r -= I_O) < I_UP) { W = in[36]; K = DM; N = 2 * FF; WT = (bf16*)(F.ws + WS_WUP1); perm = 2; }
        else { r -= I_UP; W = in[39]; K = FF; N = DM; WT = (bf16*)(F.ws + WS_WDN1); }
        const int nblk = N / 32, kb = r / nblk, nb = r % nblk, dst = 32 * nb;
        const int src = perm == 1 ? qkv_slot_to_col(dst) : (perm == 2 ? up_slot_to_col(dst) : dst);
        return CvtD{W, WT, K, N, src, dst, 64 * kb};
    };
    if (gw < NITEMS) {
        f32x4 xc[8], xn[8];
        CvtD dc = desc(gw);
        transpose_load(dc.W, dc.N, dc.src, dc.k0, F.lane, xc);
        for (int it = gw; it < NITEMS; it += NGW) {
            const CvtD dn = desc(min(it + NGW, NITEMS - 1));
            transpose_load(dn.W, dn.N, dn.src, dn.k0, F.lane, xn);
            transpose_finish(xc, dc.K, dc.WT, dc.dst, dc.k0, scr, F.lane);
#pragma unroll
            for (int i = 0; i < 8; ++i) xc[i] = xn[i];
            dc = dn;
        }
    }
}

__device__ __forceinline__ void row_prescale(const float* xrow, const float* gain, const float* sc, bf16* orow, float* ssq_out, int lane) {
    const GAS f32x4* xr = (const GAS f32x4*)xrow + lane;
    const GAS f32x4* gr = (const GAS f32x4*)gain + lane;
    const GAS f32x4* sr = (const GAS f32x4*)sc + lane;
    f32x4 v[4]; float s = 0.f;
#pragma unroll
    for (int j = 0; j < 4; ++j) { v[j] = xr[64 * j]; s += (v[j].x * v[j].x + v[j].y * v[j].y) + (v[j].z * v[j].z + v[j].w * v[j].w); }
    s = wave_sum(s);
    if (lane == 0) *ssq_out = s;
    GAS unsigned long long* o8 = (GAS unsigned long long*)orow + lane;
#pragma unroll
    for (int j = 0; j < 4; ++j) { const f32x4 g = gr[64 * j], c = sr[64 * j]; const f32x4 w = v[j] * g * (c + 1.0f);
        o8[64 * j] = (unsigned long long)pk2(w.x, w.y) | ((unsigned long long)pk2(w.z, w.w) << 32); }
}
__device__ __forceinline__ void phase0b(Frame& F) {
    const float* const* in = F.in;
    const float* mods = (const float*)(F.ws + CT_MODS);
    const int gw = F.vcu * NWAVES + F.wave, NGW = F.G * NWAVES;
    for (int m = gw; m < TT + TC; m += NGW) {
        if (m < TT) { const int b = m / SEQ; row_prescale(in[0] + (size_t)m * DM, in[6], mods + b * 6144 + 1024, (bf16*)(F.ws + WS_XS) + (size_t)m * DM, (float*)(F.ws + SM_SSQ0) + m, F.lane); }
        else { const int mc = m - TT; row_prescale(in[2] + (size_t)mc * DM, in[6], mods + 4 * 6144 + 1024, (bf16*)(F.ws + WS_XSC) + (size_t)mc * DM, (float*)(F.ws + SM_SSQC) + mc, F.lane); }
    }
    {
        float* gn = (float*)(F.ws + SM_GN);
        for (int e = F.vcu * 512 + F.tid; e < 3 * 4 * 1024; e += F.G * 512) {
            const int i = e / 4096, b = (e / 1024) & 3, k = e & 1023;
            const float* g = in[i == 0 ? 7 : (i == 1 ? 19 : 20)];
            const float sc = mods[(i == 0 ? 0 : 1) * 5 * 6144 + b * 6144 + (i == 1 ? 1024 : 4096) + k];
            gn[e] = g[k] * (1.f + sc);
        }
    }
    {
        LAS float* gs = (LAS float*)F.lds;
        for (int it = F.vcu; it < 192; it += F.G) { auto vf = [&](int r, int k) -> float { return mods[r * 6144 + k]; };
            gemv_det_item16<5>(in[8], 3072, it * 16, (float*)(F.ws + CT_BQKV), 3072, nullptr, vf, F.tid, gs); }
        __syncthreads();
    }
}
__device__ __forceinline__ void bias_gemv_late(Frame& F, int it) {
    const float* const* in = F.in;
    const float* mods = (const float*)(F.ws + CT_MODS);
    const int n_up = 88, n_in = 48;
    LAS float* gs = (LAS float*)F.lds;
    if (it < n_up) { auto vf = [&](int r, int k) -> float { return mods[r * 6144 + 3072 + k]; };
        gemv_det_item<4>(in[13], 5632, it * 64, (float*)(F.ws + CT_BUP0), 5632, nullptr, vf, F.tid, gs); }
    else if (it < n_up + n_in) { it -= n_up; auto vf = [&](int r, int k) -> float { return mods[5 * 6144 + r * 6144 + k]; };
        gemv_det_item<4>(in[21], 3072, it * 64, (float*)(F.ws + CT_BIN), 3072, in[22], vf, F.tid, gs); }
    else if (it < 2 * n_up + n_in) { it -= n_up + n_in; auto vf = [&](int r, int k) -> float { return mods[5 * 6144 + r * 6144 + 3072 + k]; };
        gemv_det_item<4>(in[36], 5632, it * 64, (float*)(F.ws + CT_BUP1), 5632, nullptr, vf, F.tid, gs); }
    __syncthreads();
}

using pg8::f32x4; using pg8::Unit;
__device__ __forceinline__ float row_rs(const float* ssq, int np, int row) {
    float s = 0.f;
    for (int i = 0; i < np; ++i) s += ssq[(size_t)i * TT + row];
    return 1.0f / sqrtf(s * (1.0f / 1024.0f) + EPS);
}
constexpr float QSCALE = 0.125f * 1.4426950408889634f;
template <int PART>
struct EpiQK {
    static constexpr bool PERM = true;
    bf16* dst; const float* ssq; int np; const float* bias; int bias_bstride; const float* gain; int seqlen;
    __device__ __forceinline__ void operator()(const f32x4 (&acc)[2][2][4][2], const Unit& u, int wr, int wc, int fr, int fq) const {
        const int head = 4 * u.pn + wc;
        const int b = (u.pm * 256) / seqlen;
        const float* bp = bias + (size_t)b * bias_bstride + PART * 1024 + head * 64 + 8 * fq;
        const float* gp = gain + 8 * fq;
        const float osc = PART == 0 ? QSCALE : 1.0f;
#pragma unroll
        for (int ai = 0; ai < 2; ++ai)
#pragma unroll
            for (int m = 0; m < 4; ++m) {
                const int row = u.pm * 256 + ai * 128 + wr * 64 + m * 16 + fr;
                const float rs = row_rs(ssq, np, row);
                f32x4 v[2][2]; float ss = 0.f;
#pragma unroll
                for (int bj = 0; bj < 2; ++bj)
#pragma unroll
                    for (int n = 0; n < 2; ++n) { v[bj][n] = acc[ai][bj][m][n] * rs + *(const f32x4*)(bp + 32 * bj + 4 * n); const f32x4 t = v[bj][n]; ss += (t.x * t.x + t.y * t.y) + (t.z * t.z + t.w * t.w); }
                ss += __shfl_xor(ss, 16); ss += __shfl_xor(ss, 32);
                const float rn = osc / sqrtf(ss * (1.0f / 64.0f) + EPS);
                const int tl = row - b * seqlen;
                bf16* rowp = (PART == 0) ? dst + (size_t)row * DM + head * 64 + 8 * fq
                                         : dst + ((((size_t)(b * NH + head) * (seqlen / 16) + (tl >> 4)) * 8 + fq) * 16 + (tl & 15)) * 8;
                constexpr int bjstep = (PART == 0) ? 32 : 4 * 16 * 8;
#pragma unroll
                for (int bj = 0; bj < 2; ++bj) { const f32x4 a0 = v[bj][0] * rn * *(const f32x4*)(gp + 32 * bj), a1 = v[bj][1] * rn * *(const f32x4*)(gp + 32 * bj + 4);
                    v4u w; w.x = pk2(a0.x, a0.y); w.y = pk2(a0.z, a0.w); w.z = pk2(a1.x, a1.y); w.w = pk2(a1.z, a1.w);
                    *(v4u*)(rowp + bjstep * bj) = w; }
                asm volatile("" ::: "memory");
            }
    }
};
struct EpiVT {
    static constexpr bool PERM = true;
    bf16* VTp; const float* ssq; int np; const float* bias; int bias_bstride; int seqlen;
    __device__ __forceinline__ void operator()(const f32x4 (&acc)[2][2][4][2], const Unit& u, int wr, int wc, int fr, int fq) const {
        const int head = 4 * u.pn + wc;
        const int b = (u.pm * 256) / seqlen;
        const float* bp = bias + (size_t)b * bias_bstride + 2048 + head * 64 + 8 * fq;
        const int odd = fr & 1;
        f32x4 bv[2][2];
#pragma unroll
        for (int bj = 0; bj < 2; ++bj)
#pragma unroll
            for (int n = 0; n < 2; ++n) bv[bj][n] = *(const f32x4*)(bp + 32 * bj + 4 * n);
#pragma unroll
        for (int ai = 0; ai < 2; ++ai)
#pragma unroll
            for (int m = 0; m < 4; ++m) {
                const int row = u.pm * 256 + ai * 128 + wr * 64 + m * 16 + fr;
                const float rs = row_rs(ssq, np, row);
                const int tl = row - b * seqlen;
                const int c16 = tl & 14, cpos = (c16 & 3) | ((c16 & 8) >> 1) | ((c16 & 4) << 1);
                bf16* vb = VTp + (((size_t)(b * NH + head) * (seqlen / 16) + (tl >> 4)) * 64 + 8 * fq + odd) * 16 + cpos;
#pragma unroll
                for (int bj = 0; bj < 2; ++bj)
#pragma unroll
                    for (int n = 0; n < 2; ++n) {
                        const f32x4 v = acc[ai][bj][m][n] * rs + bv[bj][n];
                        const unsigned w01 = pk2(v.x, v.y), w23 = pk2(v.z, v.w);
                        const unsigned p01 = (unsigned)__shfl_xor((int)w01, 1), p23 = (unsigned)__shfl_xor((int)w23, 1);
                        const unsigned o0 = odd ? ((w01 & 0xffff0000u) | (p01 >> 16)) : ((p01 << 16) | (w01 & 0xffffu));
                        const unsigned o1 = odd ? ((w23 & 0xffff0000u) | (p23 >> 16)) : ((p23 << 16) | (w23 & 0xffffu));
                        bf16* p = vb + (32 * bj + 4 * n) * 16;
                        *(unsigned*)p = o0; *(unsigned*)(p + 2 * 16) = o1;
                    }
            }
    }
};
template <bool BASE_F32, bool OUT_F32>
struct EpiRes {
    static constexpr bool PERM = true;
    const void* base; void* out; const float* gate; const float* bias; const float* gn; bf16* xs; float* ssq; float* hs;
    __device__ __forceinline__ void operator()(const f32x4 (&acc)[2][2][4][2], const Unit& u, int wr, int wc, int fr, int fq) const {
        const int b = (u.pm * 256) / SEQ;
        const int col0 = u.pn * 256 + wc * 32 + 8 * fq;
        constexpr int MB = BASE_F32 ? 2 : 4;
#pragma unroll
        for (int ai = 0; ai < 2; ++ai)
#pragma unroll
        for (int mb = 0; mb < 4; mb += MB) {
            f32x4 bf[MB][2][2]; v4u bh[MB][2];
#pragma unroll
            for (int mi = 0; mi < MB; ++mi) { const size_t off = (size_t)(u.pm * 256 + ai * 128 + wr * 64 + (mb + mi) * 16 + fr) * DM + col0;
#pragma unroll
                for (int bj = 0; bj < 2; ++bj) {
                    if (BASE_F32) { bf[mi][bj][0] = *(const f32x4*)((const float*)base + off + 128 * bj); bf[mi][bj][1] = *(const f32x4*)((const float*)base + off + 128 * bj + 4); }
                    else bh[mi][bj] = *(const v4u*)((const bf16*)base + off + 128 * bj); } }
#pragma unroll
            for (int mi = 0; mi < MB; ++mi) {
                const int m = mb + mi;
                const int rowl = ai * 128 + wr * 64 + m * 16 + fr;
                const size_t off = (size_t)(u.pm * 256 + rowl) * DM + col0;
                float ss = 0.f;
#pragma unroll
                for (int bj = 0; bj < 2; ++bj) {
                    const int c = col0 + 128 * bj;
                    f32x4 b0, b1;
                    if (BASE_F32) { b0 = bf[mi][bj][0]; b1 = bf[mi][bj][1]; }
                    else { const v4u w = bh[mi][bj]; b0 = (f32x4){bflo(w.x), bfhi(w.x), bflo(w.y), bfhi(w.y)}; b1 = (f32x4){bflo(w.z), bfhi(w.z), bflo(w.w), bfhi(w.w)}; }
                    f32x4 a0 = acc[ai][bj][m][0], a1 = acc[ai][bj][m][1];
                    if (bias) { a0 += *(const f32x4*)(bias + c); a1 += *(const f32x4*)(bias + c + 4); }
                    const f32x4 x0 = b0 + *(const f32x4*)(gate + (size_t)b * 6144 + c) * a0, x1 = b1 + *(const f32x4*)(gate + (size_t)b * 6144 + c + 4) * a1;
                    if (OUT_F32) { *(f32x4*)((float*)out + off + 128 * bj) = x0; *(f32x4*)((float*)out + off + 128 * bj + 4) = x1; }
                    else {
                        v4u w; w.x = pk2(x0.x, x0.y); w.y = pk2(x0.z, x0.w); w.z = pk2(x1.x, x1.y); w.w = pk2(x1.z, x1.w);
                        *(v4u*)((bf16*)out + off + 128 * bj) = w;
                        const f32x4 r0 = (f32x4){bflo(w.x), bfhi(w.x), bflo(w.y), bfhi(w.y)}, r1 = (f32x4){bflo(w.z), bfhi(w.z), bflo(w.w), bfhi(w.w)};
                        ss += (r0.x * r0.x + r0.y * r0.y) + (r0.z * r0.z + r0.w * r0.w) + (r1.x * r1.x + r1.y * r1.y) + (r1.z * r1.z + r1.w * r1.w);
                        const f32x4 q0 = r0 * *(const f32x4*)(gn + (size_t)b * 1024 + c), q1 = r1 * *(const f32x4*)(gn + (size_t)b * 1024 + c + 4);
                        v4u ws2; ws2.x = pk2(q0.x, q0.y); ws2.y = pk2(q0.z, q0.w); ws2.z = pk2(q1.x, q1.y); ws2.w = pk2(q1.z, q1.w);
                        *(v4u*)(xs + off + 128 * bj) = ws2;
                    }
                }
                if (!OUT_F32) { ss += __shfl_xor(ss, 16); ss += __shfl_xor(ss, 32); if (fq == 0) hs[rowl * 4 + wc] = ss; }
            }
            asm volatile("" ::: "memory");
        }
        if (!OUT_F32) {
            asm volatile("s_waitcnt lgkmcnt(0)" ::: "memory"); __builtin_amdgcn_s_barrier(); asm volatile("" ::: "memory");
            const int tid = threadIdx.x;
            if (tid < 256) { const f32x4 p = *(const f32x4*)(hs + tid * 4); ssq[(size_t)u.pn * TT + u.pm * 256 + tid] = ((p.x + p.y) + p.z) + p.w; }
        }
    }
};
struct EpiScaleBias {
    static constexpr bool PERM = true;
    bf16* O; int ldc; const float* ssq; int np; const float* bias; int bias_bstride;
    __device__ __forceinline__ void operator()(const f32x4 (&acc)[2][2][4][2], const Unit& u, int wr, int wc, int fr, int fq) const {
        const int b = (u.pm * 256) / SEQ;
        const int col0 = u.pn * 256 + wc * 32 + 8 * fq;
        f32x4 bv[2][2];
#pragma unroll
        for (int bj = 0; bj < 2; ++bj)
#pragma unroll
            for (int n = 0; n < 2; ++n) bv[bj][n] = *(const f32x4*)(bias + (size_t)b * bias_bstride + col0 + 128 * bj + 4 * n);
#pragma unroll
        for (int ai = 0; ai < 2; ++ai)
#pragma unroll
            for (int m = 0; m < 4; ++m) {
                const int row = u.pm * 256 + ai * 128 + wr * 64 + m * 16 + fr;
                const float rs = row_rs(ssq, np, row);
                bf16* rowp = O + (size_t)row * ldc + col0;
#pragma unroll
                for (int bj = 0; bj < 2; ++bj) { const f32x4 v0 = acc[ai][bj][m][0] * rs + bv[bj][0], v1 = acc[ai][bj][m][1] * rs + bv[bj][1];
                    v4u w; w.x = pk2(v0.x, v0.y); w.y = pk2(v0.z, v0.w); w.z = pk2(v1.x, v1.y); w.w = pk2(v1.z, v1.w);
                    *(v4u*)(rowp + 128 * bj) = w; }
            }
    }
};
__device__ __forceinline__ float gelu_as(float v) {
    const float av = fabsf(v), t = __builtin_amdgcn_rcpf(av * 0.2316418882f + 1.0f);
    float q = t * 0.5307027145f + (-0.7265760135f); q = q * t + 0.7107068705f; q = q * t + (-0.142248368f); q = q * t + 0.127414796f; q = q * t;
    const float e = __builtin_amdgcn_exp2f((v * v) * (-0.72134752044f));
    const float m = v * (q * e);
    return v < 0.f ? m : v - m;
}
template <int CTRL> __device__ __forceinline__ float dpp_f(float old, float src) {
    return __builtin_bit_cast(float, __builtin_amdgcn_update_dpp(__builtin_bit_cast(int, old), __builtin_bit_cast(int, src), CTRL, 0xf, 0xf, false));
}
struct EpiUpGlu {
    static constexpr bool PERM = true;
    bf16* act; const float* ssq; int np; const float* bias; const float* cw; const float* cb; float* Hg; float* Ha; float* hl;
    __device__ __forceinline__ void prefetch(const Unit& u) const {
        int tid = threadIdx.x; asm volatile("" : "+v"(tid));
        const int wv = __builtin_amdgcn_readfirstlane(tid >> 6), ln = tid & 63;
        if (wv < 7) {
            const int b = (u.pm * 256) / SEQ, hf = ln >> 5, c4 = u.pn * 128 + (ln & 31) * 4;
            const float* src;
            if (wv == 0) src = bias + (size_t)b * 5632 + hf * FF + c4;
            else if (wv == 1) src = cw + hf * FF + c4;
            else if (wv == 2) src = (hf ? cb : cw + 2 * FF) + c4;
            else src = ssq + (size_t)(wv - 3) * TT + u.pm * 256 + ln * 4;
            __builtin_amdgcn_global_load_lds((const unsigned*)src, (LAS unsigned*)((unsigned char*)hl + (CB_LDS_OFF - RING_BYTES) + wv * 1024), 16, 0, 0);
        }
    }
    __device__ __forceinline__ void operator()(f32x4 (&acc)[2][2][4][2], const Unit& u, int wr, int wc, int fr_, int fq_) const {
        int ln_ = threadIdx.x & 63; asm volatile("" : "+v"(ln_));
        const int fr = ln_ & 15, fq = ln_ >> 4;
        const int j0 = u.pn * 128 + wc * 32 + 8 * fq;
        const float* ct = (const float*)((const unsigned char*)hl + (CB_LDS_OFF - RING_BYTES));
        const int jl = wc * 32 + 8 * fq;
        {
            f32x4 ba[2], bg[2];
#pragma unroll
            for (int n = 0; n < 2; ++n) { ba[n] = *(const f32x4*)(ct + jl + 4 * n); bg[n] = *(const f32x4*)(ct + 128 + jl + 4 * n); }
#pragma unroll
            for (int ai = 0; ai < 2; ++ai)
#pragma unroll
                for (int m = 0; m < 4; ++m) { const int rl_ = ai * 128 + wr * 64 + m * 16 + fr;
                    const float rs = 1.0f / sqrtf((((ct[768 + rl_] + ct[1024 + rl_]) + ct[1280 + rl_]) + ct[1536 + rl_]) * (1.0f / 1024.0f) + EPS);
#pragma unroll
                    for (int n = 0; n < 2; ++n) { acc[ai][0][m][n] = acc[ai][0][m][n] * rs + ba[n]; acc[ai][1][m][n] = acc[ai][1][m][n] * rs + bg[n]; }
                    if (m == 3) asm volatile("" ::: "memory"); }
        }
#pragma unroll
        for (int ai = 0; ai < 2; ++ai) { float* hp = hl + ((2 * ai + wr) * 2) * 128 + wc * 32 + 8 * fq;
            if (fr == 0) { *(f32x4*)(hp) = acc[ai][1][0][0]; *(f32x4*)(hp + 4) = acc[ai][1][0][1]; }
            if (fr == 15) { *(f32x4*)(hp + 128) = acc[ai][1][3][0]; *(f32x4*)(hp + 132) = acc[ai][1][3][1]; } }
        asm volatile("s_waitcnt lgkmcnt(0)" ::: "memory"); __builtin_amdgcn_s_barrier(); asm volatile("" ::: "memory");
        if (wr == 0 && fr < 2) { float* p = Hg + ((size_t)u.pm * 4 + fr) * FF + j0; *(f32x4*)p = acc[0][1][0][0]; *(f32x4*)(p + 4) = acc[0][1][0][1];
            if (fr == 0) { float* q = Ha + ((size_t)u.pm * 2) * FF + j0; *(f32x4*)q = acc[0][0][0][0]; *(f32x4*)(q + 4) = acc[0][0][0][1]; } }
        if (wr == 1 && fr >= 14) { float* p = Hg + ((size_t)u.pm * 4 + 2 + (fr - 14)) * FF + j0; *(f32x4*)p = acc[1][1][3][0]; *(f32x4*)(p + 4) = acc[1][1][3][1];
            if (fr == 15) { float* q = Ha + ((size_t)u.pm * 2 + 1) * FF + j0; *(f32x4*)q = acc[1][0][3][0]; *(f32x4*)(q + 4) = acc[1][0][3][1]; } }
#pragma unroll
        for (int n = 0; n < 2; ++n) {
            const f32x4 w0 = *(const f32x4*)(ct + 256 + jl + 4 * n), w1 = *(const f32x4*)(ct + 384 + jl + 4 * n), w2 = *(const f32x4*)(ct + 512 + jl + 4 * n), cbv = *(const f32x4*)(ct + 640 + jl + 4 * n);
#pragma unroll
            for (int ai = 0; ai < 2; ++ai) {
                const int gi = 2 * ai + wr;
                const f32x4 uph = *(const f32x4*)(hl + (((gi + 3) & 3) * 2 + 1) * 128 + wc * 32 + 8 * fq + 4 * n);
                const f32x4 dnh = *(const f32x4*)(hl + (((gi + 1) & 3) * 2) * 128 + wc * 32 + 8 * fq + 4 * n);
#pragma unroll
                for (int m = 0; m < 4; ++m) {
                    const int rowl = ai * 128 + wr * 64 + m * 16 + fr;
                    f32x4 r;
#pragma unroll
                    for (int e = 0; e < 4; ++e) {
                        const float g = acc[ai][1][m][n][e];
                        const float pu = (m > 0) ? dpp_f<0x121>(g, acc[ai][1][m > 0 ? m - 1 : 0][n][e]) : uph[e];
                        const float up = dpp_f<0x111>(pu, g);
                        const float pd = (m < 3) ? dpp_f<0x12f>(g, acc[ai][1][m < 3 ? m + 1 : 3][n][e]) : dnh[e];
                        const float dn = dpp_f<0x101>(pd, g);
                        const float cv = w0[e] * up + w1[e] * g + w2[e] * dn + cbv[e];
                        r[e] = acc[ai][0][m][n][e] * gelu_as(cv);
                    }
                    if (rowl != 0 && rowl != 255) { v2u w; w.x = pk2(r.x, r.y); w.y = pk2(r.z, r.w); *(v2u*)(act + (size_t)(u.pm * 256 + rowl) * FF + j0 + 4 * n) = w; }
                }
            }
        }
        asm volatile("s_waitcnt lgkmcnt(0)" ::: "memory"); __builtin_amdgcn_s_barrier(); asm volatile("" ::: "memory");
    }
};
__device__ __forceinline__ void glu_fix_tile(Frame& F, int pm, const float* cw, const float* cb) {
    const float* Hg = (const float*)(F.ws + WS_HG); const float* Ha = (const float*)(F.ws + WS_HA); bf16* act = (bf16*)(F.ws + WS_AG);
#pragma unroll 1
    for (int it = 0; it < 3; ++it) {
        const int e = F.tid + 512 * it;
        if (e < 2 * (FF / 4)) {
            const int which = e >= FF / 4 ? 1 : 0, j = (e - which * (FF / 4)) * 4;
            const int t = pm * 256 + (which ? 255 : 0), tl = t % SEQ;
            const int rm = which ? pm * 4 + 2 : max(pm - 1, 0) * 4 + 3, r0 = pm * 4 + (which ? 3 : 0), rp = which ? min(pm + 1, TT / 256 - 1) * 4 : pm * 4 + 1;
            f32x4 gm = *(const f32x4*)(Hg + (size_t)rm * FF + j), gp = *(const f32x4*)(Hg + (size_t)rp * FF + j);
            const f32x4 g0 = *(const f32x4*)(Hg + (size_t)r0 * FF + j), a = *(const f32x4*)(Ha + ((size_t)pm * 2 + which) * FF + j);
            const f32x4 w0 = *(const f32x4*)(cw + j), w1 = *(const f32x4*)(cw + FF + j), w2 = *(const f32x4*)(cw + 2 * FF + j), cbv = *(const f32x4*)(cb + j);
            if (!which && tl == 0) gm = (f32x4){0.f, 0.f, 0.f, 0.f};
            if (which && tl == SEQ - 1) gp = (f32x4){0.f, 0.f, 0.f, 0.f};
            const f32x4 cv = w0 * gm + w1 * g0 + w2 * gp + cbv;
            v2u w; w.x = pk2(a.x * gelu_as(cv.x), a.y * gelu_as(cv.y)); w.y = pk2(a.z * gelu_as(cv.z), a.w * gelu_as(cv.w));
            *(v2u*)(act + (size_t)t * FF + j) = w;
        }
    }
}
__device__ __forceinline__ void glu_fix_phase(Frame& F, const float* cw, const float* cb) {
    const float* Hg = (const float*)(F.ws + WS_HG); const float* Ha = (const float*)(F.ws + WS_HA); bf16* act = (bf16*)(F.ws + WS_AG);
    const int total = (TT / 256) * 2 * FF;
    for (int e = F.vcu * 512 + F.tid; e < total; e += F.G * 512) {
        const int j = e % FF, which = (e / FF) & 1, pm = e / (2 * FF);
        const int t = pm * 256 + (which ? 255 : 0), tl = t % SEQ;
        float gm, g0, gp;
        if (which == 0) { gm = (tl == 0) ? 0.f : Hg[((size_t)(pm - 1) * 4 + 3) * FF + j]; g0 = Hg[((size_t)pm * 4 + 0) * FF + j]; gp = Hg[((size_t)pm * 4 + 1) * FF + j]; }
        else { gm = Hg[((size_t)pm * 4 + 2) * FF + j]; g0 = Hg[((size_t)pm * 4 + 3) * FF + j]; gp = (tl == SEQ - 1) ? 0.f : Hg[((size_t)(pm + 1) * 4 + 0) * FF + j]; }
        const float a = Ha[((size_t)pm * 2 + which) * FF + j];
        const float cv = cw[j] * gm + cw[FF + j] * g0 + cw[2 * FF + j] * gp + cb[j];
        act[(size_t)t * FF + j] = (bf16)f2bf(a * gelu_as(cv));
    }
}
struct EpiNull {
    static constexpr bool PERM = true;
    float* sink;
    __device__ __forceinline__ void operator()(const f32x4 (&acc)[2][2][4][2], const Unit& u, int wr, int wc, int fr, int fq) const {
        f32x4 s = {0.f, 0.f, 0.f, 0.f};
#pragma unroll
        for (int ai = 0; ai < 2; ++ai)
#pragma unroll
            for (int bj = 0; bj < 2; ++bj)
#pragma unroll
                for (int m = 0; m < 4; ++m)
#pragma unroll
                    for (int n = 0; n < 2; ++n) s += acc[ai][bj][m][n];
        if (u.pm == 100000) *(f32x4*)(sink + fr) = s;
    }
};
struct EpiInT {
    static constexpr bool PERM = true;
    bf16* UT; const float* ssq; int np; const float* bias;
    __device__ __forceinline__ void operator()(const f32x4 (&acc)[2][2][4][2], const Unit& u, int wr, int wc, int fr, int fq) const {
        const int b = (u.pm * 256) / SEQ;
        const int col0 = u.pn * 256 + wc * 32 + 8 * fq;
        const int odd = fr & 1;
        f32x4 bv[2][2];
#pragma unroll
        for (int bj = 0; bj < 2; ++bj)
#pragma unroll
            for (int n = 0; n < 2; ++n) bv[bj][n] = *(const f32x4*)(bias + (size_t)b * 3072 + col0 + 128 * bj + 4 * n);
#pragma unroll
        for (int ai = 0; ai < 2; ++ai)
#pragma unroll
            for (int m = 0; m < 4; ++m) {
                const int row = u.pm * 256 + ai * 128 + wr * 64 + m * 16 + fr;
                const int t = row - b * SEQ;
                const float rs = row_rs(ssq, np, row);
#pragma unroll
                for (int bj = 0; bj < 2; ++bj)
#pragma unroll
                    for (int n = 0; n < 2; ++n) { const f32x4 v = acc[ai][bj][m][n] * rs + bv[bj][n];
                        const unsigned w01 = pk2(v.x, v.y), w23 = pk2(v.z, v.w);
                        const unsigned p01 = (unsigned)__shfl_xor((int)w01, 1), p23 = (unsigned)__shfl_xor((int)w23, 1);
                        const unsigned o0 = odd ? ((w01 & 0xffff0000u) | (p01 >> 16)) : ((p01 << 16) | (w01 & 0xffffu));
                        const unsigned o1 = odd ? ((w23 & 0xffff0000u) | (p23 >> 16)) : ((p23 << 16) | (w23 & 0xffffu));
                        bf16* p = UT + ((size_t)b * 3072 + col0 + 128 * bj + 4 * n + odd) * SEQ + (t & ~1);
                        *(unsigned*)p = o0; *(unsigned*)(p + 2 * (size_t)SEQ) = o1; }
            }
    }
};

struct EpiCtxKV {
    static constexpr bool PERM = true;
    EpiQK<1> ek; EpiVT ev;
    __device__ __forceinline__ void operator()(const f32x4 (&acc)[2][2][4][2], const Unit& u, int wr, int wc, int fr, int fq) const {
        if (u.pn < 4) ek(acc, u, wr, wc, fr, fq);
        else { Unit v = u; v.pn = u.pn - 4; ev(acc, v, wr, wc, fr, fq); }
    }
};

typedef short bf16x8 __attribute__((ext_vector_type(8)));
typedef float f32x16 __attribute__((ext_vector_type(16)));
typedef short s16x4 __attribute__((ext_vector_type(4)));
__device__ __forceinline__ unsigned cvtpk(float lo, float hi) { typedef float f2 __attribute__((ext_vector_type(2))); typedef __bf16 b2 __attribute__((ext_vector_type(2)));
    f2 v = {lo, hi}; b2 r = __builtin_convertvector(v, b2); return __builtin_bit_cast(unsigned, r); }
constexpr int BT_OFF = 64, BT_HEAD = 15 * 31;
__device__ __forceinline__ void attn_mfma_phase(Frame& F) {
    const bf16* Q = (const bf16*)(F.ws + WS_Q); const bf16* Kb = (const bf16*)(F.ws + WS_K); const bf16* VT = (const bf16*)(F.ws + WS_V);
    const bf16* Kc = (const bf16*)(F.ws + WS_KC); const bf16* VcT = (const bf16*)(F.ws + WS_VC);
    bf16* O = (bf16*)(F.ws + WS_O);
    const float* rpb = F.in[11];
    constexpr int AL_KC = 15 * 8192, AL_BT = AL_KC + 32768;
    const unsigned char* lk = (const unsigned char*)F.lds;
    float* bt = (float*)(F.lds + AL_BT);
    int th = -1;
    const int lane = F.lane, q = lane & 31, hi = lane >> 5;
    for (int g = F.vcu; g < NB * (GROWS / 8) * NH; g += F.G) {
        const int rg = g & 15, h = (g >> 4) & 15, b = g >> 8;
        const int r = rg * 8 + F.wave;
        const int r0 = min(max(r - WH / 2, 0), GROWS - WH);
        const int U0 = min(max(rg * 8 - WH / 2, 0), GROWS - WH), Ue = min(max(rg * 8 + 7 - WH / 2, 0), GROWS - WH) + WH;
        __syncthreads();
        if (h != th) { for (int e = F.tid; e < BT_HEAD; e += 512) bt[BT_OFF + e] = rpb[h * BT_HEAD + e] * 1.4426950408889634f; th = h; }
        {
            int tv = F.tid; FC_OPAQUE(tv);
            const bf16* ksrc = Kb + ((size_t)(b * NH + h) * (SEQ / 16) + (size_t)U0 * 4) * (8 * 16 * 8) + tv * 8;
            const bf16* csrc = Kc + ((size_t)(b * NH + h) * (CTXL / 16)) * (8 * 16 * 8) + tv * 8;
            const int nrow = Ue - U0;
#pragma unroll 1
            for (int rr0 = 0; rr0 < nrow + 4; rr0 += 4) {
                v4u x[4];
#pragma unroll
                for (int k = 0; k < 4; ++k) { const int rr = rr0 + k; if (rr < nrow + 4) x[k] = (rr < nrow) ? *(const v4u*)(ksrc + (size_t)rr * 4096) : *(const v4u*)(csrc + (size_t)(rr - nrow) * 4096); }
#pragma unroll
                for (int k = 0; k < 4; ++k) { const int rr = rr0 + k; if (rr < nrow + 4) *(v4u*)(F.lds + (rr < nrow ? rr * 8192 : AL_KC + (rr - nrow) * 8192) + tv * 16) = x[k]; }
            }
            asm volatile("" ::: "memory");
        }
        __syncthreads();
        const size_t tok = (size_t)b * SEQ + r * GW + q;
        bf16x8 qf[2][4];
#pragma unroll
        for (int hf = 0; hf < 2; ++hf)
#pragma unroll
            for (int s4 = 0; s4 < 4; ++s4) qf[hf][s4] = *(const bf16x8*)(Q + (tok + 32 * hf) * DM + h * HD + 16 * s4 + 8 * hi);
        const f32x16 zero16 = {0.f, 0.f, 0.f, 0.f, 0.f, 0.f, 0.f, 0.f, 0.f, 0.f, 0.f, 0.f, 0.f, 0.f, 0.f, 0.f};
        f32x16 o[2][2] = {{zero16, zero16}, {zero16, zero16}};
        float lsum[2] = {0.f, 0.f};
#define ATT_LOAD(i, kf, va) do { \
            const bf16* kp_; const bf16* vp_; int sstr_; \
            if ((i) < 16) { const int rp_ = (i) >> 2, cb_ = (i) & 3, krow_ = r0 + 2 * rp_; \
                kp_ = (const bf16*)(lk + (krow_ + (q >> 4) - U0) * 8192 + cb_ * 2048 + hi * 256 + (q & 15) * 16); \
                vp_ = VT + (((size_t)(b * NH + h) * (SEQ / 16) + krow_ * 4 + cb_) * 64 + q) * 16 + 8 * hi; sstr_ = 4 * 64 * 16; } \
            else { const int j_ = (i) - 16; \
                kp_ = (const bf16*)(lk + AL_KC + (2 * j_ + (q >> 4)) * 2048 + hi * 256 + (q & 15) * 16); \
                vp_ = VcT + (((size_t)(b * NH + h) * (CTXL / 16) + 2 * j_) * 64 + q) * 16 + 8 * hi; sstr_ = 64 * 16; } \
            _Pragma("unroll") for (int s4 = 0; s4 < 4; ++s4) kf[s4] = *(const bf16x8*)(kp_ + s4 * (2 * 16 * 8)); \
            _Pragma("unroll") for (int dh = 0; dh < 2; ++dh) _Pragma("unroll") for (int s2 = 0; s2 < 2; ++s2) { const bf16* v_ = vp_ + dh * (32 * 16) + s2 * sstr_; \
                va[dh][s2] = *(const bf16x8*)v_; } } while (0)
#define ATT_HALF(i, kf, va, HF) do { \
            f32x16 sacc = zero16; \
            _Pragma("unroll") for (int s4 = 0; s4 < 4; ++s4) sacc = __builtin_amdgcn_mfma_f32_32x32x16_bf16(kf[s4], qf[HF][s4], sacc, 0, 0, 0); \
            float p[16]; \
            if ((i) < 16) { const int rp_ = (i) >> 2, cb_ = (i) & 3, krow_ = r0 + 2 * rp_; \
                const int c_ = 32 * HF + q, c0_ = min(max(c_ - WW / 2, 0), GW - WW), lo_ = c0_ - c_ + (WW - 1); \
                const int dcb = cb_ * 16 + 4 * hi - c_ + (WW - 1), dcl = dcb - lo_; \
                const float* btp = bt + BT_OFF + (krow_ - r + (WH - 1)) * 31 + dcb; \
                _Pragma("unroll") for (int rr = 0; rr < 16; ++rr) { const int kc = (rr & 3) + 8 * ((rr >> 2) & 1); \
                    const float e_ = __builtin_amdgcn_exp2f(sacc[rr] + btp[(rr >> 3) * 31 + kc]); \
                    p[rr] = ((unsigned)(dcl + kc) < (unsigned)WW) ? e_ : 0.f; lsum[HF] += p[rr]; } } \
            else { _Pragma("unroll") for (int rr = 0; rr < 16; ++rr) { p[rr] = __builtin_amdgcn_exp2f(sacc[rr]); lsum[HF] += p[rr]; } } \
            unsigned pw[8]; \
            _Pragma("unroll") for (int ii = 0; ii < 8; ++ii) pw[ii] = cvtpk(p[2 * ii], p[2 * ii + 1]); \
            _Pragma("unroll") for (int s2 = 0; s2 < 2; ++s2) { \
                const bf16x8 pb = __builtin_bit_cast(bf16x8, (v4u){pw[4 * s2], pw[4 * s2 + 1], pw[4 * s2 + 2], pw[4 * s2 + 3]}); \
                o[HF][0] = __builtin_amdgcn_mfma_f32_32x32x16_bf16(va[0][s2], pb, o[HF][0], 0, 0, 0); \
                o[HF][1] = __builtin_amdgcn_mfma_f32_32x32x16_bf16(va[1][s2], pb, o[HF][1], 0, 0, 0); } } while (0)
#define ATT_COMPUTE(i, kf, va) do { const int cbq_ = ((i) < 16) ? ((i) & 3) : 1; \
            if (cbq_ != 3) ATT_HALF(i, kf, va, 0); \
            if (cbq_ != 0) ATT_HALF(i, kf, va, 1); } while (0)
        bf16x8 kfA[4], kfB[4], vaA[2][2], vaB[2][2];
        ATT_LOAD(0, kfA, vaA);
#pragma unroll 1
        for (int i = 0; i < 24; i += 2) {
            ATT_LOAD(i + 1, kfB, vaB);
            ATT_COMPUTE(i, kfA, vaA);
            { const int i2 = (i + 2 < 24) ? i + 2 : 23; ATT_LOAD(i2, kfA, vaA); }
            ATT_COMPUTE(i + 1, kfB, vaB);
        }
#undef ATT_LOAD
#undef ATT_HALF
#undef ATT_COMPUTE
#pragma unroll
        for (int hf = 0; hf < 2; ++hf) {
            float l = lsum[hf]; l += __shfl_xor(l, 32);
            const float inv = 1.0f / l;
            bf16* op = O + (tok + 32 * hf) * DM + h * HD + 4 * hi;
#pragma unroll
            for (int gq = 0; gq < 4; ++gq) {
                v2u w0; w0.x = pk2(o[hf][0][4 * gq] * inv, o[hf][0][4 * gq + 1] * inv); w0.y = pk2(o[hf][0][4 * gq + 2] * inv, o[hf][0][4 * gq + 3] * inv);
                v2u w1; w1.x = pk2(o[hf][1][4 * gq] * inv, o[hf][1][4 * gq + 1] * inv); w1.y = pk2(o[hf][1][4 * gq + 2] * inv, o[hf][1][4 * gq + 3] * inv);
                *(v2u*)(op + 8 * gq) = w0; *(v2u*)(op + 32 + 8 * gq) = w1;
            }
        }
    }
    __syncthreads();
}

__device__ __forceinline__ void convglu_phase(Frame& F, const float* cw, const float* cb) {
    bf16* ag = (bf16*)(F.ws + WS_AG);
    const long nvec = (long)TT * (FF / 8);
    for (long e = (long)F.vcu * 512 + F.tid; e < nvec; e += (long)F.G * 512) {
        const int t = (int)(e / (FF / 8)), j0 = (int)(e % (FF / 8)) * 8;
        const int tl = t % SEQ;
        const bf16* rowp = ag + (size_t)t * (2 * FF);
        const v4u a = *(const v4u*)(rowp + j0);
        const v4u g0 = *(const v4u*)(rowp + FF + j0);
        v4u gm = (v4u){0u, 0u, 0u, 0u}, gp = (v4u){0u, 0u, 0u, 0u};
        if (tl > 0) gm = *(const v4u*)(rowp - 2 * FF + FF + j0);
        if (tl < SEQ - 1) gp = *(const v4u*)(rowp + 2 * FF + FF + j0);
        float av[8], g0v[8], gmv[8], gpv[8];
        av[0] = bflo(a.x); av[1] = bfhi(a.x); av[2] = bflo(a.y); av[3] = bfhi(a.y); av[4] = bflo(a.z); av[5] = bfhi(a.z); av[6] = bflo(a.w); av[7] = bfhi(a.w);
        g0v[0] = bflo(g0.x); g0v[1] = bfhi(g0.x); g0v[2] = bflo(g0.y); g0v[3] = bfhi(g0.y); g0v[4] = bflo(g0.z); g0v[5] = bfhi(g0.z); g0v[6] = bflo(g0.w); g0v[7] = bfhi(g0.w);
        gmv[0] = bflo(gm.x); gmv[1] = bfhi(gm.x); gmv[2] = bflo(gm.y); gmv[3] = bfhi(gm.y); gmv[4] = bflo(gm.z); gmv[5] = bfhi(gm.z); gmv[6] = bflo(gm.w); gmv[7] = bfhi(gm.w);
        gpv[0] = bflo(gp.x); gpv[1] = bfhi(gp.x); gpv[2] = bflo(gp.y); gpv[3] = bfhi(gp.y); gpv[4] = bflo(gp.z); gpv[5] = bfhi(gp.z); gpv[6] = bflo(gp.w); gpv[7] = bfhi(gp.w);
        float r[8];
#pragma unroll
        for (int i = 0; i < 8; ++i) { const int j = j0 + i; const float cv = cw[j] * gmv[i] + cw[FF + j] * g0v[i] + cw[2 * FF + j] * gpv[i] + cb[j]; r[i] = av[i] * gelu_f(cv); }
        v4u w; w.x = pk2(r[0], r[1]); w.y = pk2(r[2], r[3]); w.z = pk2(r[4], r[5]); w.w = pk2(r[6], r[7]);
        *(v4u*)(ag + (size_t)t * (2 * FF) + j0) = w;
    }
}

__device__ __forceinline__ void filtgen_phase(Frame& F) {
    const float* const* in = F.in;
    const float *w1 = in[25], *b1 = in[26], *w2 = in[27], *b2 = in[28], *w3 = in[29], *b3 = in[30], *wout = in[31], *freq = in[32];
    float* hT = (float*)(F.ws + WS_HT); float* fsqp = (float*)(F.ws + WS_FSQP);
    LAS float* zf = (LAS float*)(F.lds);
    LAS float* ha = zf + 32 * 36;
    LAS float* hb = ha + 32 * 64;
    const int tid = F.tid;
    for (int item = F.vcu; item < SEQ / 32; item += F.G) {
        const int l0 = item * 32;
        const float bj1 = b1[tid & 63], bj2 = b2[tid & 63], bj3 = b3[tid & 63], fj = freq[tid & 63];
        __syncthreads();
        for (int e = tid; e < 32 * 33; e += 512) {
            const int p = e / 33, i = e % 33, l = l0 + p;
            float v;
            if (i == 0) v = (float)l / 8191.0f;
            else { const int bi = (i - 1) & 15; const float band = 1e-4f + (float)bi * ((15.0f - 1e-4f) / 15.0f);
                const float w = (float)(2.0 * 3.14159265358979323846 / 8192.0) * (float)l; const float arg = band * w;
                v = (i <= 16) ? cosf(arg) : -sinf(arg); }
            zf[p * 36 + i] = v;
        }
        __syncthreads();
        { const int j = tid & 63, p = tid >> 6; float a[4] = {bj1, bj1, bj1, bj1};
#pragma unroll 11
          for (int i = 0; i < 33; ++i) { const float w = w1[i * 64 + j];
#pragma unroll
            for (int k = 0; k < 4; ++k) a[k] += zf[(p + 8 * k) * 36 + i] * w; }
#pragma unroll
          for (int k = 0; k < 4; ++k) ha[(p + 8 * k) * 64 + j] = sinf(fj * a[k]); }
        __syncthreads();
        { const int j = tid & 63, p = tid >> 6; float a[4] = {bj2, bj2, bj2, bj2};
#pragma unroll 16
          for (int i = 0; i < 64; ++i) { const float w = w2[i * 64 + j];
#pragma unroll
            for (int k = 0; k < 4; ++k) a[k] += ha[(p + 8 * k) * 64 + i] * w; }
#pragma unroll
          for (int k = 0; k < 4; ++k) hb[(p + 8 * k) * 64 + j] = sinf(fj * a[k]); }
        __syncthreads();
        { const int j = tid & 63, p = tid >> 6; float a[4] = {bj3, bj3, bj3, bj3};
#pragma unroll 16
          for (int i = 0; i < 64; ++i) { const float w = w3[i * 64 + j];
#pragma unroll
            for (int k = 0; k < 4; ++k) a[k] += hb[(p + 8 * k) * 64 + i] * w; }
#pragma unroll
          for (int k = 0; k < 4; ++k) ha[(p + 8 * k) * 64 + j] = sinf(fj * a[k]); }
        __syncthreads();
        {
            const int lane = F.lane, li = lane & 15, lk = lane >> 4;
            float av[2][16];
#pragma unroll
            for (int mt = 0; mt < 2; ++mt)
#pragma unroll
                for (int st = 0; st < 16; ++st) av[mt][st] = ha[(16 * mt + li) * 64 + 4 * st + lk];
            const float la = -15.350567286626973f, lb = -3.0701134573253946f;
#pragma unroll 2
            for (int nt = 0; nt < 16; ++nt) {
                const int n = F.wave * 256 + nt * 16 + li;
                const float* wp = wout + (size_t)lk * 2048 + n;
                f32x4 acc0 = {0.f, 0.f, 0.f, 0.f}, acc1 = acc0;
#pragma unroll
                for (int st = 0; st < 16; ++st) { const float bvv = wp[(size_t)st * 4 * 2048];
                    acc0 = __builtin_amdgcn_mfma_f32_16x16x4f32(av[0][st], bvv, acc0, 0, 0, 0); acc1 = __builtin_amdgcn_mfma_f32_16x16x4f32(av[1][st], bvv, acc1, 0, 0, 0); }
                const int dir = n >> 10, c = n & 1023;
                const float delta = fabsf(la + (float)c * ((lb - la) / 1023.0f)) * 1.4426950408889634f;
                float sq = 0.f;
#pragma unroll
                for (int mt = 0; mt < 2; ++mt) { f32x4 ov; const f32x4 acc = mt ? acc1 : acc0;
#pragma unroll
                    for (int r = 0; r < 4; ++r) { const float tpos = (float)(l0 + 16 * mt + 4 * lk + r) / 8191.0f; const float v = acc[r] * __builtin_amdgcn_exp2f(-tpos * delta); ov[r] = v; sq += v * v; }
                    *(f32x4*)(hT + ((size_t)dir * 1024 + c) * SEQ + l0 + 16 * mt + 4 * lk) = ov; }
                sq += __shfl_xor(sq, 16); sq += __shfl_xor(sq, 32);
                if (lk == 0) fsqp[(size_t)item * 2048 + n] = sq;
            }
        }
    }
    __syncthreads();
}

constexpr int F2_AO = 67584, F2_TW = 135168, F2_RED = 140 * 1024, F2_PF = 144 * 1024;
__device__ __forceinline__ void f2_load_tw(Frame& F, const cf* TWM) {
    cf* tw1 = (cf*)(F.lds + F2_TW);
    for (int e = F.tid; e < 544; e += 512) tw1[e] = e < 512 ? TWM[e] : TWM[16 * (e - 512)];
    __syncthreads();
}
__device__ __forceinline__ void filtfft_phase(Frame& F) {
    const float* hT = (const float*)(F.ws + WS_HT); const float* fsqp = (const float*)(F.ws + WS_FSQP);
    const cf* TWM = (const cf*)(F.ws + SM_TWM); const cf* TWN = (const cf*)(F.ws + SM_TWN);
    cf* Fsp = (cf*)(F.ws + WS_F);
    cf* aE = (cf*)F.lds; cf* aO = (cf*)(F.lds + F2_AO);
    const cf* tw1 = (const cf*)(F.lds + F2_TW); const cf* tw32 = tw1 + 512;
    float* red = (float*)(F.lds + F2_RED);
    f2_load_tw(F, TWM);
    for (int c = F.vcu; c < DM; c += F.G) {
        int tid = F.tid; FC_OPAQUE(tid);
        __syncthreads();
        red[tid] = (tid < SEQ / 32) ? fsqp[(size_t)tid * 2048 + c] + fsqp[(size_t)tid * 2048 + 1024 + c] : 0.f;
        __syncthreads();
        for (int st = 256; st > 0; st >>= 1) { if (tid < st) red[tid] += red[tid + st]; __syncthreads(); }
        const float nrm = 1.0f / sqrtf(red[0] + EPS);
        const float* hf = hT + (size_t)c * SEQ; const float* hb = hT + ((size_t)1024 + c) * SEQ;
        if (c + F.G < DM) { const float* pr = hT + ((size_t)(tid >> 8) * 1024 + c + F.G) * SEQ + (size_t)(tid & 255) * 32;
            __builtin_amdgcn_global_load_lds((const unsigned*)pr, (LAS unsigned*)(F.lds + F2_PF + F.wave * 256), 4, 0, 0); }
        {
            cf v[16], w[16];
#pragma unroll
            for (int r = 0; r < 16; ++r) { const int n = tid + 512 * r; const float hbv = hb[SEQ - max(n, 1)];
                const float fa = hf[n] * nrm, fb = (n == 0) ? 0.f : hbv * nrm;
                v[r].x = fa + fb; v[r].y = 0.f; cf t; t.x = fa - fb; t.y = 0.f; w[r] = cmul(t, TWN[n]); }
            f2_fwd_p1(v, tid, aE, tw1);
            f2_fwd_p1(w, tid, aO, tw1);
        }
        __syncthreads();
        f2_fwd_p2_dual(tid, aE, aO, tw32);
        __syncthreads();
        { const int path = tid >> 8, bf = tid & 255;
          f2_mid(bf, path ? aO : aE, (const cf*)nullptr, Fsp + ((size_t)c * 2 + path) * FC_M, 1.0f / 16384.0f); }
    }
    __syncthreads();
}

__device__ __forceinline__ void conv3_8(const v4u raw, float prev, float next, float w0, float w1, float w2, float bb, float* out) {
    float x[10]; x[0] = prev; x[9] = next;
    x[1] = bflo(raw.x); x[2] = bfhi(raw.x); x[3] = bflo(raw.y); x[4] = bfhi(raw.y); x[5] = bflo(raw.z); x[6] = bfhi(raw.z); x[7] = bflo(raw.w); x[8] = bfhi(raw.w);
#pragma unroll
    for (int i = 0; i < 8; ++i) out[i] = w0 * x[i] + w1 * x[i + 1] + w2 * x[i + 2] + bb;
}
__device__ __forceinline__ void hyena_fft_phase(Frame& F) {
    const float* const* in = F.in;
    const float* sw = in[23]; const float* sb = in[24]; const float* dbias = in[33];
    const bf16* UT = (const bf16*)(F.ws + WS_UT);
    const cf* TWM = (const cf*)(F.ws + SM_TWM); const cf* TWN = (const cf*)(F.ws + SM_TWN);
    const cf* Fsp = (const cf*)(F.ws + WS_F);
    cf* aE = (cf*)F.lds; cf* aO = (cf*)(F.lds + F2_AO);
    const cf* tw1 = (const cf*)(F.lds + F2_TW); const cf* tw32 = tw1 + 512;
    f2_load_tw(F, TWM);
    for (int unit = F.vcu; unit < 2 * DM; unit += F.G) {
        const int c = unit >> 1, b0 = (unit & 1) * 2;
        int tid = F.tid; FC_OPAQUE(tid);
        __syncthreads();
        {
            const float w10 = sw[1024 + c], w11 = sw[3072 + 1024 + c], w12 = sw[6144 + 1024 + c], bb1 = sb[1024 + c];
            const float wv0 = sw[2048 + c], wv1 = sw[3072 + 2048 + c], wv2 = sw[6144 + 2048 + c], bbv = sb[2048 + c];
            v4u x1raw[2][2], vraw[2][2]; unsigned short hh[2][2][4];
            FC_OPAQUE(tid);
#pragma unroll
            for (int h = 0; h < 2; ++h) {
                const int t0 = (tid + 512 * h) * 8;
                const int ipv = max(t0 - 1, 0), inx = min(t0 + 8, SEQ - 1);
#pragma unroll
                for (int bb = 0; bb < 2; ++bb) {
                    const bf16* x1r = UT + ((size_t)(b0 + bb) * 3072 + 1024 + c) * SEQ;
                    const bf16* vr = UT + ((size_t)(b0 + bb) * 3072 + 2048 + c) * SEQ;
                    x1raw[h][bb] = *(const v4u*)(x1r + t0); vraw[h][bb] = *(const v4u*)(vr + t0);
                    hh[h][bb][0] = x1r[ipv]; hh[h][bb][1] = x1r[inx]; hh[h][bb][2] = vr[ipv]; hh[h][bb][3] = vr[inx];
                }
            }
#pragma unroll
            for (int h = 0; h < 2; ++h) {
                const int t0 = (tid + 512 * h) * 8;
                float z[2][8];
#pragma unroll
                for (int bb = 0; bb < 2; ++bb) {
                    const float x1p = t0 > 0 ? bf2f(hh[h][bb][0]) : 0.f, x1n = t0 + 8 < SEQ ? bf2f(hh[h][bb][1]) : 0.f;
                    const float vp = t0 > 0 ? bf2f(hh[h][bb][2]) : 0.f, vn = t0 + 8 < SEQ ? bf2f(hh[h][bb][3]) : 0.f;
                    float x1c[8], vc[8];
                    conv3_8(x1raw[h][bb], x1p, x1n, w10, w11, w12, bb1, x1c);
                    conv3_8(vraw[h][bb], vp, vn, wv0, wv1, wv2, bbv, vc);
#pragma unroll
                    for (int i = 0; i < 8; ++i) z[bb][i] = x1c[i] * vc[i];
                }
                const int pb = F2_PIDX(t0);
#pragma unroll
                for (int i = 0; i < 8; ++i) { cf t; t.x = z[0][i]; t.y = z[1][i]; aE[pb + i] = t; }
            }
        }
        __syncthreads();
        if (tid < 256) { const bf16* pr = UT + ((size_t)(b0 + (tid >> 7)) * 3072 + c) * SEQ + (size_t)(tid & 127) * 64;
            __builtin_amdgcn_global_load_lds((const unsigned*)pr, (LAS unsigned*)(F.lds + F2_PF + F.wave * 256), 4, 0, 0); }
        cf wreg[16];
        FC_OPAQUE(tid);
        { const int pt = F2_PIDX(tid);
#pragma unroll
          for (int r = 0; r < 16; ++r) wreg[r] = aE[pt + 528 * r]; }
        const int path = tid >> 8, bf = tid & 255;
        cf freg[32];
        { const cf* fp = Fsp + ((size_t)c * 2 + path) * FC_M + bf;
#pragma unroll
          for (int i = 0; i < 32; ++i) freg[i] = fp[i * 256]; }
        {
            cf v[16];
#pragma unroll
            for (int r = 0; r < 16; ++r) v[r] = wreg[r];
            f2_fwd_p1(v, tid, aE, tw1);
            FC_OPAQUE(tid);
#pragma unroll
            for (int r = 0; r < 16; ++r) v[r] = cmul(wreg[r], TWN[tid + 512 * r]);
            f2_fwd_p1(v, tid, aO, tw1);
        }
        __syncthreads();
        f2_fwd_p2_dual(tid, aE, aO, tw32);
        __syncthreads();
        f2_mid(bf, path ? aO : aE, freg, (cf*)nullptr, 0.f);
        __syncthreads();
        if (unit + F.G < 2 * DM) { const int nu = unit + F.G, nc = nu >> 1, nb = (nu & 1) * 2 + (tid >> 8), wh = 1 + ((tid >> 7) & 1);
            const bf16* pr = UT + ((size_t)nb * 3072 + wh * 1024 + nc) * SEQ + (size_t)(tid & 127) * 64;
            __builtin_amdgcn_global_load_lds((const unsigned*)pr, (LAS unsigned*)(F.lds + F2_PF + F.wave * 256), 4, 0, 0); }
        f2_inv_p2_dual(tid, aE, aO, tw32);
        __syncthreads();
        {
            cf ve[16], vo[16];
            f2_inv_p1(ve, tid, aE, tw1);
            f2_inv_p1(vo, tid, aO, tw1);
            const float db = dbias[c];
            FC_OPAQUE(tid);
            const int pt = F2_PIDX(tid);
#pragma unroll
            for (int r = 0; r < 16; ++r) { const int n = tid + 512 * r;
                const cf y = cadd(cconj(ve[r]), cmul(cconj(TWN[n]), cconj(vo[r])));
                cf o; o.x = y.x + wreg[r].x * db; o.y = y.y + wreg[r].y * db; aE[pt + 528 * r] = o; }
        }
        __syncthreads();
        {
            const float w00 = sw[c], w01 = sw[3072 + c], w02 = sw[6144 + c], bb0 = sb[c];
            v4u xraw[2][2]; unsigned short hx[2][2][2];
            FC_OPAQUE(tid);
#pragma unroll
            for (int h = 0; h < 2; ++h) {
                const int t0 = (tid + 512 * h) * 8;
#pragma unroll
                for (int bb = 0; bb < 2; ++bb) { const bf16* x0r = UT + ((size_t)(b0 + bb) * 3072 + c) * SEQ;
                    xraw[h][bb] = *(const v4u*)(x0r + t0); hx[h][bb][0] = x0r[max(t0 - 1, 0)]; hx[h][bb][1] = x0r[min(t0 + 8, SEQ - 1)]; }
            }
#pragma unroll
            for (int h = 0; h < 2; ++h) {
                const int t0 = (tid + 512 * h) * 8;
                cf val[8];
                const int pb = F2_PIDX(t0);
#pragma unroll
                for (int i = 0; i < 8; ++i) val[i] = aE[pb + i];
#pragma unroll
                for (int bb = 0; bb < 2; ++bb) {
                    const float xp = t0 > 0 ? bf2f(hx[h][bb][0]) : 0.f, xn = t0 + 8 < SEQ ? bf2f(hx[h][bb][1]) : 0.f;
                    float x0c[8]; conv3_8(xraw[h][bb], xp, xn, w00, w01, w02, bb0, x0c);
                    float p[8];
#pragma unroll
                    for (int i = 0; i < 8; ++i) p[i] = x0c[i] * (bb == 0 ? val[i].x : val[i].y);
                    v4u o; o.x = pk2(p[0], p[1]); o.y = pk2(p[2], p[3]); o.z = pk2(p[4], p[5]); o.w = pk2(p[6], p[7]);
                    *(v4u*)((bf16*)(F.ws + WS_XS) + ((size_t)(b0 + bb) * 1024 + c) * SEQ + t0) = o;
                }
            }
        }
    }
    __syncthreads();
}
__device__ __forceinline__ void transpose_p_phase(Frame& F) {
    const bf16* PT = (const bf16*)(F.ws + WS_XS); bf16* P = (bf16*)(F.ws + WS_P);
    LAS unsigned short* scr = (LAS unsigned short*)(F.lds + F.wave * 16384);
    const int gw = F.vcu * NWAVES + F.wave, NGW = F.G * NWAVES, lane = F.lane;
    const int ntile = NB * (DM / 64) * (SEQ / 64);
    const int l8 = lane >> 3, ch = (lane & 7) * 8;
    for (int it = gw; it < ntile; it += NGW) {
        const int tb = it % (SEQ / 64), cb = (it / (SEQ / 64)) % (DM / 64), b = it / ((SEQ / 64) * (DM / 64));
        v4u x[8];
#pragma unroll
        for (int k = 0; k < 8; ++k) x[k] = *(const v4u*)(PT + ((size_t)b * 1024 + cb * 64 + 8 * k + l8) * SEQ + tb * 64 + ch);
#pragma unroll
        for (int k = 0; k < 8; ++k) { LAS unsigned* d = (LAS unsigned*)(scr + (8 * k + l8) * 66 + ch); d[0] = x[k].x; d[1] = x[k].y; d[2] = x[k].z; d[3] = x[k].w; }
        LDS_WAIT(); asm volatile("" ::: "memory");
#pragma unroll
        for (int k = 0; k < 8; ++k) { const int t = 8 * k + l8; const LAS unsigned short* sp = scr + ch * 66 + t;
            v4u o; o.x = sp[0] | ((unsigned)sp[66] << 16); o.y = sp[2 * 66] | ((unsigned)sp[3 * 66] << 16); o.z = sp[4 * 66] | ((unsigned)sp[5 * 66] << 16); o.w = sp[6 * 66] | ((unsigned)sp[7 * 66] << 16);
            *(v4u*)(P + ((size_t)b * SEQ + tb * 64 + t) * DM + cb * 64 + ch) = o; }
        LDS_WAIT(); asm volatile("" ::: "memory");
    }
}

constexpr int NPH = 13;
__global__ void __launch_bounds__(NWAVES * 64, 2) hybrid_fwd(Args args) {
    extern __shared__ __attribute__((aligned(16))) unsigned char lds[];
    Frame F;
    F.lds = (LAS unsigned char*)lds;
    F.tid = threadIdx.x; F.lane = F.tid & 63; F.wave = __builtin_amdgcn_readfirstlane(F.tid >> 6);
    F.G = gridDim.x; { const int bx = blockIdx.x; F.vcu = (F.G % 8 == 0) ? (bx % 8) * (F.G / 8) + bx / 8 : bx; }
    F.in = args.in; F.out = args.out; F.ws = args.ws;
    unsigned char* ws = args.ws;
    volatile LAS unsigned* MISC = (volatile LAS unsigned*)(F.lds + MISC_OFF);
    for (int u = F.tid; u < (LDS_BYTES - LDSCTL_OFF) / 4; u += NWAVES * 64) ((LAS unsigned*)(F.lds + LDSCTL_OFF))[u] = 0u;
    __syncthreads();
    XcdBarrier bar; bar.bar = (unsigned*)(ws + CT_BAR) + args.li * XCD_BAR_WORDS; bar.x = 0; bar.st = nullptr;
    const int lo = args.ph_lo, hi = args.ph_hi;
    if (hi - lo > 1) bar = xcd_barrier_post((unsigned*)(ws + CT_BAR) + args.li * XCD_BAR_WORDS, MISC + 8);
#ifndef EXP_PAIR
#define EXP_PAIR 0
#endif
#ifndef REP_MASK
#define REP_MASK 0
#endif
#define REPS(k) ((((REP_MASK) >> (k)) & 1) ? 2 : 1)
#ifndef PH_MASK
#define PH_MASK 0xFFFFFF
#endif
#define IN(k) ((((PH_MASK) >> (k)) & 1) && lo <= (k) && (k) < hi)
#ifdef PROBE_TS
    unsigned long long ts_a = 0, ts_b = 0;
#define TS_MARK(k) do { if (blockIdx.x == 0 && F.tid == 0) { const unsigned long long t_ = __builtin_amdgcn_s_memrealtime(); if ((k) == PROBE_TS) ts_a = t_; if ((k) == PROBE_TS + 1) ts_b = t_; } } while (0)
#else
#define TS_MARK(k) do { } while (0)
#endif
#define SEAM(k) do { if (IN(k) && IN((k) + 1)) xcd_barrier(bar); TS_MARK((k) + 1); } while (0)
    const float* mods = (const float*)(ws + CT_MODS);
    const float* gnt = (const float*)(ws + SM_GN);
    float* ssqa = (float*)(ws + WS_SSQP);
    bf16* XS = (bf16*)(ws + WS_XS);

    TS_MARK(0);
    if (IN(0)) { for (int rep = 0; rep < REPS(0); ++rep) { phase0a(F); filtgen_phase(F); } } SEAM(0);
    if (IN(1)) { for (int rep = 0; rep < REPS(1); ++rep) { phase0b(F); filtfft_phase(F); } } SEAM(1);
    if (IN(2)) for (int rep = 0; rep < REPS(2); ++rep) {
        { pg8::Gemm g{XS, (const bf16*)(ws + WS_WQKV), TT, DM, DM, DM}; pg8::StaticOrder S; S.init(TT, DM, F.G, (int)blockIdx.x);
          EpiQK<0> E{(bf16*)(ws + WS_Q), (const float*)(ws + SM_SSQ0), 1, (const float*)(ws + CT_BQKV), 3072, args.in[9], SEQ};
          pg8::gemm_phase<EpiQK<0>, pg8::StaticOrder, true, true>(F.lds, g, S, E); }
        { pg8::Gemm g{XS, (const bf16*)(ws + WS_WQKV) + (size_t)1024 * DM, TT, DM, DM, DM}; pg8::StaticOrder S; S.init(TT, DM, F.G, (int)blockIdx.x);
          EpiQK<1> E{(bf16*)(ws + WS_K), (const float*)(ws + SM_SSQ0), 1, (const float*)(ws + CT_BQKV), 3072, args.in[10], SEQ};
          pg8::gemm_phase<EpiQK<1>, pg8::StaticOrder, true, true>(F.lds, g, S, E); }
        { pg8::Gemm g{XS, (const bf16*)(ws + WS_WQKV) + (size_t)2048 * DM, TT, DM, DM, DM}; pg8::StaticOrder S; S.init(TT, DM, F.G, (int)blockIdx.x);
          EpiVT E{(bf16*)(ws + WS_V), (const float*)(ws + SM_SSQ0), 1, (const float*)(ws + CT_BQKV), 3072, SEQ};
          pg8::gemm_phase<EpiVT, pg8::StaticOrder, true, true>(F.lds, g, S, E); }
        { pg8::Gemm g{(const bf16*)(ws + WS_XSC), (const bf16*)(ws + WS_WQKV) + (size_t)1024 * DM, TC, 2 * DM, DM, DM}; pg8::StaticOrder S; S.init(TC, 2 * DM, F.G, (int)blockIdx.x);
          EpiCtxKV E{ EpiQK<1>{(bf16*)(ws + WS_KC), (const float*)(ws + SM_SSQC), 1, (const float*)(ws + CT_BQKV) + 4 * 3072, 0, args.in[10], CTXL},
                      EpiVT{(bf16*)(ws + WS_VC), (const float*)(ws + SM_SSQC), 1, (const float*)(ws + CT_BQKV) + 4 * 3072, 0, CTXL} };
          pg8::gemm_phase<EpiCtxKV, pg8::StaticOrder, true, true>(F.lds, g, S, E); }
        { const int nct = (TC / 256) * (2 * DM / 256); const int idle = (int)F.G - nct;
          if (idle >= 184) { if ((int)blockIdx.x >= nct) bias_gemv_late(F, (int)blockIdx.x - nct); }
          else for (int it = (int)blockIdx.x; it < 184; it += (int)F.G) bias_gemv_late(F, it); }
    } SEAM(2);
    if (IN(3)) { for (int rep = 0; rep < REPS(3); ++rep) attn_mfma_phase(F); } SEAM(3);
    if (IN(4)) for (int rep = 0; rep < REPS(4); ++rep) {
        pg8::Gemm g{(const bf16*)(ws + WS_O), (const bf16*)(ws + WS_WO), TT, DM, DM, DM}; pg8::StaticOrder S; S.init(TT, DM, F.G, (int)blockIdx.x);
        EpiRes<true, false> E{args.in[0], ws + WS_XB, mods + 2048, nullptr, gnt, XS, ssqa, (float*)(lds + RING_BYTES + 8192)};
        pg8::gemm_phase<EpiRes<true, false>, pg8::StaticOrder, true, true>(F.lds, g, S, E);
    } SEAM(4);
    if (IN(5)) for (int rep = 0; rep < REPS(5); ++rep) {
        pg8::Gemm g{XS, (const bf16*)(ws + WS_WUP0), TT, 2 * FF, DM, DM}; pg8::StaticOrder S; S.init(TT, 2 * FF, F.G, (int)blockIdx.x);
        EpiUpGlu E{(bf16*)(ws + WS_AG), ssqa, 4, (const float*)(ws + CT_BUP0), args.in[14], args.in[15], (float*)(ws + WS_HG), (float*)(ws + WS_HA), (float*)(lds + RING_BYTES)};
        pg8::gemm_phase<EpiUpGlu, pg8::StaticOrder, true, true>(F.lds, g, S, E);
    } SEAM(5);

    if (IN(6)) {
        { pg8::StaticOrder S0; S0.init(TT, DM, F.G, (int)blockIdx.x); pg8::Unit fu;
#pragma unroll 1
          for (int i = 0; S0.next(i, fu); ++i) glu_fix_tile(F, fu.pm, args.in[14], args.in[15]);
          VM_WAIT(); __syncthreads(); asm volatile("" ::: "memory"); }
        pg8::Gemm g{(const bf16*)(ws + WS_AG), (const bf16*)(ws + WS_WDN0), TT, DM, FF, FF}; pg8::StaticOrder S; S.init(TT, DM, F.G, (int)blockIdx.x);
        EpiRes<false, false> E{ws + WS_XB, ws + WS_XB, mods + 5120, nullptr, gnt + 4096, XS, ssqa + 4 * TT, (float*)(lds + RING_BYTES + 8192)};
        pg8::gemm_phase<EpiRes<false, false>, pg8::StaticOrder, true, true>(F.lds, g, S, E);
    } SEAM(6);
    if (IN(7)) for (int rep = 0; rep < REPS(7); ++rep) {
        pg8::Gemm g{XS, (const bf16*)(ws + WS_WIN), TT, 3 * DM, DM, DM}; pg8::StaticOrder S; S.init(TT, 3 * DM, F.G, (int)blockIdx.x);
#ifdef EXP_P9
        EpiScaleBias E{(bf16*)(ws + WS_UT), 3 * DM, ssqa + 4 * TT, 4, (const float*)(ws + CT_BIN), 3072};
        pg8::gemm_phase<EpiScaleBias, pg8::StaticOrder, true, true>(F.lds, g, S, E);
#else
        EpiInT E{(bf16*)(ws + WS_UT), ssqa + 4 * TT, 4, (const float*)(ws + CT_BIN)};
        pg8::gemm_phase<EpiInT, pg8::StaticOrder, true, true>(F.lds, g, S, E);
#endif
    } SEAM(7);
    if (IN(8)) { for (int rep = 0; rep < REPS(8); ++rep) hyena_fft_phase(F); } SEAM(8);

    if (IN(9)) { for (int rep = 0; rep < REPS(9); ++rep) transpose_p_phase(F); } SEAM(9);
    if (IN(10)) {
        pg8::Gemm g{(const bf16*)(ws + WS_P), (const bf16*)(ws + WS_WOUT), TT, DM, DM, DM}; pg8::StaticOrder S; S.init(TT, DM, F.G, (int)blockIdx.x);
        EpiRes<false, false> E{ws + WS_XB, ws + WS_XB, mods + 5 * 6144 + 2048, args.in[35], gnt + 2 * 4096, XS, ssqa + 8 * TT, (float*)(lds + RING_BYTES + 8192)};
        pg8::gemm_phase<EpiRes<false, false>, pg8::StaticOrder, true, true>(F.lds, g, S, E);
    } SEAM(10);
    if (IN(11)) for (int rep = 0; rep < REPS(11); ++rep) {
        pg8::Gemm g{XS, (const bf16*)(ws + WS_WUP1), TT, 2 * FF, DM, DM}; pg8::StaticOrder S; S.init(TT, 2 * FF, F.G, (int)blockIdx.x);
        EpiUpGlu E{(bf16*)(ws + WS_AG), ssqa + 8 * TT, 4, (const float*)(ws + CT_BUP1), args.in[37], args.in[38], (float*)(ws + WS_HG), (float*)(ws + WS_HA), (float*)(lds + RING_BYTES)};
        pg8::gemm_phase<EpiUpGlu, pg8::StaticOrder, true, true>(F.lds, g, S, E);
    } SEAM(11);
    if (IN(12)) {
        { pg8::StaticOrder S0; S0.init(TT, DM, F.G, (int)blockIdx.x); pg8::Unit fu;
#pragma unroll 1
          for (int i = 0; S0.next(i, fu); ++i) glu_fix_tile(F, fu.pm, args.in[37], args.in[38]);
          VM_WAIT(); __syncthreads(); asm volatile("" ::: "memory"); }
        pg8::Gemm g{(const bf16*)(ws + WS_AG), (const bf16*)(ws + WS_WDN1), TT, DM, FF, FF}; pg8::StaticOrder S; S.init(TT, DM, F.G, (int)blockIdx.x);
        EpiRes<false, true> E{ws + WS_XB, args.out, mods + 5 * 6144 + 5120, nullptr, nullptr, nullptr, nullptr, nullptr};
        pg8::gemm_phase<EpiRes<false, true>, pg8::StaticOrder, true, true>(F.lds, g, S, E);
    }
#ifdef PROBE_TS
    TS_MARK(NPH);
    if (blockIdx.x == 0 && F.tid == 0) { asm volatile("s_waitcnt vmcnt(0)" ::: "memory"); args.out[0] = args.out[0] + (float)(ts_b - ts_a) * 0.01f; }
#endif
#ifdef PROBE_NULL
    if (lo == 98) {
#if PROBE_NULL == 5
        pg8::Gemm g{XS, (const bf16*)(ws + WS_WUP0), TT, 2 * FF, DM, DM}; pg8::StaticOrder S; S.init(TT, 2 * FF, F.G, (int)blockIdx.x);
#elif PROBE_NULL == 4
        pg8::Gemm g{(const bf16*)(ws + WS_O), (const bf16*)(ws + WS_WO), TT, DM, DM, DM}; pg8::StaticOrder S; S.init(TT, DM, F.G, (int)blockIdx.x);
#elif PROBE_NULL == 7
        pg8::Gemm g{(const bf16*)(ws + WS_AG), (const bf16*)(ws + WS_WDN0), TT, DM, FF, FF}; pg8::StaticOrder S; S.init(TT, DM, F.G, (int)blockIdx.x);
        { pg8::Unit fu; for (int i = 0; S.next(i, fu); ++i) glu_fix_tile(F, fu.pm, args.in[14], args.in[15]); VM_WAIT(); __syncthreads(); }
#else
        pg8::Gemm g{XS, (const bf16*)(ws + WS_WQKV), TT, 3 * DM, DM, DM}; pg8::StaticOrder S; S.init(TT, 3 * DM, F.G, (int)blockIdx.x);
#endif
        EpiNull E{(float*)(ws + WS_FSQP)};
        pg8::gemm_phase<EpiNull, pg8::StaticOrder, true, true>(F.lds, g, S, E);
    }
#endif
#ifdef DUMP_SEL
    if (lo == 99) {
        float* o = args.out; const size_t n = (size_t)TT * DM;
        for (size_t e = (size_t)blockIdx.x * 512 + F.tid; e < n; e += (size_t)F.G * 512) {
            float v;
            if (DUMP_SEL == 1) { const float* h = (const float*)(ws + WS_HT); v = (e < (size_t)2 * 1024 * SEQ) ? h[e] : ((const float*)(ws + WS_FSQP))[e & 1023]; }
            else if (DUMP_SEL == 2) { const bf16* u = (const bf16*)(ws + WS_UT); v = bf2f(u[e]); }
            else if (DUMP_SEL == 3) { const bf16* u = (const bf16*)(ws + WS_UT); v = bf2f(u[e + (size_t)TT * DM]); }
            else if (DUMP_SEL == 4) { const bf16* u = (const bf16*)(ws + WS_UT); v = bf2f(u[e + (size_t)2 * TT * DM]); }
            else { const bf16* u = (const bf16*)(ws + WS_P); v = bf2f(u[e]); }
            o[e] = v;
        }
    }
#endif
#undef IN
#undef SEAM
}

extern "C" void kernel_launch(void* const* d_in, const int* in_sizes, int n_in, void* d_out, int out_size, void* d_ws, size_t ws_size, hipStream_t stream) {
    static int grid = 0;
    if (grid == 0) {
        if (n_in != 40 || out_size != TT * DM || ws_size < WS_END) { fprintf(stderr, "kernel_launch: unexpected shapes n_in %d out %d ws %zu\n", n_in, out_size, ws_size); grid = -1; return; }
        int dev = 0, cus = 0;
        if (hipGetDevice(&dev) != hipSuccess || hipDeviceGetAttribute(&cus, hipDeviceAttributeMultiprocessorCount, dev) != hipSuccess) { grid = -1; return; }
        if (hipFuncSetAttribute((const void*)hybrid_fwd, hipFuncAttributeMaxDynamicSharedMemorySize, LDS_BYTES) != hipSuccess) { fprintf(stderr, "kernel_launch: hipFuncSetAttribute failed\n"); grid = -1; return; }
        int per_cu = 0;
        if (hipOccupancyMaxActiveBlocksPerMultiprocessor(&per_cu, (const void*)hybrid_fwd, NWAVES * 64, LDS_BYTES) != hipSuccess || per_cu < 1) { fprintf(stderr, "kernel_launch: occupancy query says %d\n", per_cu); }
        (void)hipGetLastError();
        grid = cus;
    }
    if (grid < 0) return;
    (void)hipMemsetAsync((char*)d_ws + WS_CTL, 0, CTL_ZERO_BYTES, stream);
    Args a{};
    for (int i = 0; i < 40; ++i) a.in[i] = (const float*)d_in[i];
    a.out = (float*)d_out; a.ws = (unsigned char*)d_ws; a.repmask = REP_MASK;
#if defined(PROBE_NULL)
    {   const int k = PROBE_NULL; const int lo[3] = {0, 98, k}, hi[3] = {k, 99, NPH};
        for (int i = 0; i < 3; ++i) { a.ph_lo = lo[i]; a.ph_hi = hi[i]; a.li = i;
            hipLaunchKernelGGL(hybrid_fwd, dim3(grid), dim3(NWAVES * 64), LDS_BYTES, stream, a); } }
#elif defined(PROBE_PHASE)
    {   const int k = PROBE_PHASE; const int lo[4] = {0, k, k, k + 1}, hi[4] = {k, k + 1, k + 1, NPH};
        for (int i = 0; i < 4; ++i) { if (lo[i] >= hi[i]) continue; a.ph_lo = lo[i]; a.ph_hi = hi[i]; a.li = i;
            hipLaunchKernelGGL(hybrid_fwd, dim3(grid), dim3(NWAVES * 64), LDS_BYTES, stream, a); } }
#elif MK_ONE_LAUNCH
    a.ph_lo = 0; a.ph_hi = NPH;
    hipLaunchKernelGGL(hybrid_fwd, dim3(grid), dim3(NWAVES * 64), LDS_BYTES, stream, a);
#else
    for (int p = 0; p < PH_END; ++p) { a.ph_lo = p; a.ph_hi = p + 1; hipLaunchKernelGGL(hybrid_fwd, dim3(grid), dim3(NWAVES * 64), LDS_BYTES, stream, a); }
#ifdef DUMP_SEL
    a.ph_lo = 99; a.ph_hi = 100; hipLaunchKernelGGL(hybrid_fwd, dim3(grid), dim3(NWAVES * 64), LDS_BYTES, stream, a);
#endif
#endif
}
```

```cpp
#include <hip/hip_runtime.h>
#include <cstdio>
#include <cstdint>

#ifndef PH_END
#define PH_END 13
#endif
#ifndef MK_ONE_LAUNCH
#define MK_ONE_LAUNCH 1
#endif

namespace pg8 {
#define PG8_LAS __attribute__((address_space(3)))
typedef unsigned short bf16_t;
typedef short bf16x8 __attribute__((ext_vector_type(8)));
typedef float f32x4 __attribute__((ext_vector_type(4)));
typedef unsigned u32x4 __attribute__((ext_vector_type(4)));
constexpr int BM = 256, BK = 64, HALF = 128, HTB = HALF * BK * 2, STAGE_BYTES = 8 * HTB, NXCD = 8, WGM = 8;

__host__ __device__ __forceinline__ int lds_byte(int r, int c) { const int st = (r >> 4) * 2 + (c >> 5), rr = r & 15, cc = c & 31, ob = rr * 64 + cc * 2; return st * 1024 + (ob ^ (((ob >> 9) & 1) << 5)); }
__host__ __device__ __forceinline__ void stage_rc(int b, int& R, int& C) { const int st = b / 1024, sb = b % 1024, swz = sb ^ (((sb >> 9) & 1) << 5); R = (st >> 1) * 16 + swz / 64; C = (st & 1) * 32 + (swz % 64) / 2; }
__host__ __device__ __forceinline__ int perm32(int rho) { const int n = rho >> 4, i = rho & 15; return 8 * (i >> 2) + 4 * n + (i & 3); }

struct Unit { int pm, pn; };
struct Gemm { const bf16_t* A; const bf16_t* Bt; int M, N, K, lda; };

struct StaticOrder {
    int nM, nN, nwg, G, c;
    __host__ __device__ __forceinline__ void init(int M, int N, int G_, int c_) { nM = M / BM; nN = N / BM; nwg = nM * nN; G = G_; c = c_; }
    __host__ __device__ __forceinline__ bool next(int i, Unit& u) const {
        const long L = (long)i * G + c; if (L >= nwg) return false;
        int wgid = (int)L; { const int q = nwg / NXCD, r = nwg % NXCD, xcd = wgid % NXCD, off = wgid / NXCD; wgid = (xcd < r ? xcd * (q + 1) : r * (q + 1) + (xcd - r) * q) + off; }
        const int nig = WGM * nN, gid = wgid / nig, fm = gid * WGM, gsz = (nM - fm) < WGM ? (nM - fm) : WGM;
        u.pm = fm + ((wgid % nig) % gsz); u.pn = (wgid % nig) / gsz; return true;
    }
    __device__ __forceinline__ void a_ready(const Unit&) const {}
    __device__ __forceinline__ void done(const Unit&) const {}
};

__device__ __forceinline__ unsigned cvt_pk_bf16(float lo, float hi) { unsigned r; asm volatile("v_cvt_pk_bf16_f32 %0, %1, %2" : "=v"(r) : "v"(lo), "v"(hi)); return r; }

template <class E> __device__ __forceinline__ auto epi_prefetch(const E& e, const Unit& u, int) -> decltype(e.prefetch(u), void()) { e.prefetch(u); }
template <class E> __device__ __forceinline__ void epi_prefetch(const E&, const Unit&, long) {}
template <class Epi, class Sched, bool ALIGN_EPI = false, bool SP2 = false>
__device__ __forceinline__ void gemm_phase(PG8_LAS unsigned char* lds, const Gemm g, const Sched& S, const Epi& E) {
    const int tid = threadIdx.x, wid = __builtin_amdgcn_readfirstlane(tid >> 6), lane = tid & 63, wr = wid >> 2, wc = wid & 3, fr = lane & 15, fq = lane >> 4;
    const int K = g.K, nt = K / BK, lda = g.lda;
    unsigned voffA[2], voffB[2];
#pragma unroll
    for (int i = 0; i < 2; ++i) { int R, C; stage_rc(tid * 16 + i * 8192, R, C); const int Rb = Epi::PERM ? ((R & ~31) + perm32(R & 31)) : R;
        voffA[i] = (unsigned)(R * lda + C) * 2u; voffB[i] = (unsigned)(Rb * K + C) * 2u; }
    const size_t kstep = (size_t)(BK * 2);
    const size_t hstepA = (size_t)HALF * lda * 2, hstepB = (size_t)HALF * K * 2;
    const size_t tstepA = 2 * hstepA, tstepB = 2 * hstepB;
    const unsigned ldsw = (unsigned)wid * 1024u;
    const int aoff = lds_byte(wr * 64 + fr, fq * 8), boff = lds_byte(wc * 32 + fr, fq * 8);
#define PG8_SA(b, h) (((b) * 2 + (h)) * HTB)
#define PG8_SB(b, h) ((4 + (b) * 2 + (h)) * HTB)
#define PG8_STAGE(bufoff, gbase, voff) do { _Pragma("unroll") for (int _i = 0; _i < 2; ++_i) \
        __builtin_amdgcn_global_load_lds((const unsigned*)((const char*)(gbase) + (voff)[_i]), (PG8_LAS unsigned*)(lds + (bufoff) + ldsw + _i * 8192), 16, 0, 0); } while (0)
#define PG8_LDA(dst, b, h) do { _Pragma("unroll") for (int m = 0; m < 4; ++m) _Pragma("unroll") for (int k = 0; k < 2; ++k) dst[m][k] = *(const PG8_LAS bf16x8*)(lds + PG8_SA(b, h) + aoff + m * 2048 + k * 1024); } while (0)
#define PG8_LDB(dst, b, h) do { _Pragma("unroll") for (int n = 0; n < 2; ++n) _Pragma("unroll") for (int k = 0; k < 2; ++k) dst[n][k] = *(const PG8_LAS bf16x8*)(lds + PG8_SB(b, h) + boff + n * 2048 + k * 1024); } while (0)
#define PG8_MMA(ai, bj, At, Bt) do { __builtin_amdgcn_s_setprio(1); _Pragma("unroll") for (int m = 0; m < 4; ++m) _Pragma("unroll") for (int n = 0; n < 2; ++n) _Pragma("unroll") for (int k = 0; k < 2; ++k) \
        acc[ai][bj][m][n] = __builtin_amdgcn_mfma_f32_16x16x32_bf16(Bt[n][k], At[m][k], acc[ai][bj][m][n], 0, 0, 0); __builtin_amdgcn_s_setprio(0); } while (0)
#define PG8_WAIT_V(n) asm volatile("s_waitcnt vmcnt(" #n ")" ::: "memory")
#define PG8_WAIT_L(n) asm volatile("s_waitcnt lgkmcnt(" #n ")" ::: "memory")
#define PG8_BAR __builtin_amdgcn_s_barrier()
#define PG8_SCHED __builtin_amdgcn_sched_barrier(0)
    Unit cur, nxt; int ui = 0;
    if (!S.next(0, cur)) return;
    f32x4 acc[2][2][4][2];
#pragma unroll
    for (int a = 0; a < 2; ++a)
#pragma unroll
        for (int b = 0; b < 2; ++b)
#pragma unroll
            for (int m = 0; m < 4; ++m)
#pragma unroll
                for (int n = 0; n < 2; ++n) acc[a][b][m][n] = (f32x4){0.f, 0.f, 0.f, 0.f};
    bf16x8 At[4][2], B0[2][2], B1[2][2];
    const char* cA = (const char*)g.A + (size_t)cur.pm * tstepA; const char* cB = (const char*)g.Bt + (size_t)cur.pn * tstepB;
    S.a_ready(cur);
    epi_prefetch(E, cur, 0);
    if constexpr (SP2) {
        PG8_STAGE(PG8_SB(0, 0), cB, voffB); PG8_STAGE(PG8_SB(0, 1), cB + hstepB, voffB); PG8_STAGE(PG8_SA(0, 0), cA, voffA); PG8_STAGE(PG8_SA(0, 1), cA + hstepA, voffA);
        if (wr == 1) PG8_BAR;
        PG8_WAIT_V(2); PG8_BAR;
        PG8_STAGE(PG8_SB(1, 0), cB + kstep, voffB); PG8_STAGE(PG8_SA(1, 0), cA + kstep, voffA); PG8_STAGE(PG8_SB(1, 1), cB + hstepB + kstep, voffB);
        PG8_WAIT_V(6); PG8_BAR;
    } else {
        PG8_STAGE(PG8_SB(0, 0), cB, voffB); PG8_STAGE(PG8_SA(0, 0), cA, voffA); PG8_STAGE(PG8_SB(0, 1), cB + hstepB, voffB); PG8_STAGE(PG8_SA(0, 1), cA + hstepA, voffA);
        if (wr == 1) PG8_BAR;
        PG8_WAIT_V(4); PG8_BAR;
        PG8_STAGE(PG8_SB(1, 0), cB + kstep, voffB); PG8_STAGE(PG8_SA(1, 0), cA + kstep, voffA); PG8_STAGE(PG8_SB(1, 1), cB + hstepB + kstep, voffB);
        PG8_WAIT_V(6); PG8_BAR;
    }
    for (;;) {
        const bool has_next = S.next(ui + 1, nxt);
        const char* nA = has_next ? (const char*)g.A + (size_t)nxt.pm * tstepA : cA; const char* nB = has_next ? (const char*)g.Bt + (size_t)nxt.pn * tstepB : cB;
        for (int t = 0; t < nt; t += 2) {
            const bool last = (t == nt - 2);
            const char* a1 = cA + (size_t)(t + 1) * kstep;
            const char* a2 = last ? nA : cA + (size_t)(t + 2) * kstep; const char* b2 = last ? nB : cB + (size_t)(t + 2) * kstep;
            const char* a3 = a2 + kstep; const char* b3 = b2 + kstep;
            if (last && has_next) S.a_ready(nxt);
            if constexpr (SP2) {
            PG8_LDB(B0, 0, 0); PG8_LDB(B1, 0, 1); PG8_SCHED; PG8_LDA(At, 0, 0); PG8_STAGE(PG8_SA(1, 1), a1 + hstepA, voffA);
            PG8_WAIT_V(8); PG8_WAIT_L(0); PG8_BAR; PG8_MMA(0, 0, At, B0); PG8_MMA(0, 1, At, B1); PG8_BAR; PG8_SCHED;
            PG8_LDA(At, 0, 1); PG8_STAGE(PG8_SB(0, 0), b2, voffB); PG8_STAGE(PG8_SB(0, 1), b2 + hstepB, voffB); PG8_STAGE(PG8_SA(0, 0), a2, voffA);
            PG8_WAIT_V(8); PG8_WAIT_L(0); PG8_BAR; PG8_MMA(1, 0, At, B0); PG8_MMA(1, 1, At, B1); PG8_BAR; PG8_SCHED;
            PG8_LDB(B0, 1, 0); PG8_LDB(B1, 1, 1); PG8_SCHED; PG8_LDA(At, 1, 0); PG8_STAGE(PG8_SA(0, 1), a2 + hstepA, voffA);
            PG8_WAIT_V(8); PG8_WAIT_L(0); PG8_BAR; PG8_MMA(0, 0, At, B0); PG8_MMA(0, 1, At, B1); PG8_BAR; PG8_SCHED;
            PG8_LDA(At, 1, 1); PG8_STAGE(PG8_SB(1, 0), b3, voffB); PG8_STAGE(PG8_SB(1, 1), b3 + hstepB, voffB); PG8_STAGE(PG8_SA(1, 0), a3, voffA);
            PG8_WAIT_V(8); PG8_WAIT_L(0); PG8_BAR; PG8_MMA(1, 0, At, B0); PG8_MMA(1, 1, At, B1); PG8_BAR; PG8_SCHED;
            } else {
            PG8_LDB(B0, 0, 0); PG8_SCHED; PG8_LDA(At, 0, 0); PG8_STAGE(PG8_SA(1, 1), a1 + hstepA, voffA);
            PG8_WAIT_L(8); PG8_BAR; PG8_WAIT_L(0); PG8_MMA(0, 0, At, B0); PG8_BAR; PG8_SCHED;
            PG8_LDB(B1, 0, 1); PG8_STAGE(PG8_SB(0, 0), b2, voffB);
            PG8_BAR; PG8_WAIT_L(0); PG8_MMA(0, 1, At, B1); PG8_BAR;
            PG8_LDA(At, 0, 1); PG8_STAGE(PG8_SA(0, 0), a2, voffA);
            PG8_BAR; PG8_WAIT_L(0); PG8_MMA(1, 0, At, B0); PG8_BAR; PG8_SCHED;
            PG8_STAGE(PG8_SB(0, 1), b2 + hstepB, voffB);
            PG8_WAIT_V(6); PG8_BAR; PG8_MMA(1, 1, At, B1); PG8_BAR;
            PG8_LDB(B0, 1, 0); PG8_SCHED; PG8_LDA(At, 1, 0); PG8_STAGE(PG8_SA(0, 1), a2 + hstepA, voffA);
            PG8_WAIT_L(8); PG8_BAR; PG8_WAIT_L(0); PG8_MMA(0, 0, At, B0); PG8_BAR; PG8_SCHED;
            PG8_LDB(B1, 1, 1); PG8_STAGE(PG8_SB(1, 0), b3, voffB);
            PG8_BAR; PG8_WAIT_L(0); PG8_MMA(0, 1, At, B1); PG8_BAR;
            PG8_LDA(At, 1, 1); PG8_STAGE(PG8_SA(1, 0), a3, voffA);
            PG8_BAR; PG8_WAIT_L(0); PG8_MMA(1, 0, At, B0); PG8_BAR; PG8_SCHED;
            PG8_STAGE(PG8_SB(1, 1), b3 + hstepB, voffB);
            PG8_WAIT_V(6); PG8_BAR; PG8_MMA(1, 1, At, B1); PG8_BAR;
            }
        }
        if constexpr (ALIGN_EPI) { if (wr == 0) PG8_BAR; }
        E(acc, cur, wr, wc, fr, fq); S.done(cur);
        if (!has_next) break;
#pragma unroll
        for (int a = 0; a < 2; ++a)
#pragma unroll
            for (int b = 0; b < 2; ++b)
#pragma unroll
                for (int m = 0; m < 4; ++m)
#pragma unroll
                    for (int n = 0; n < 2; ++n) acc[a][b][m][n] = (f32x4){0.f, 0.f, 0.f, 0.f};
        cur = nxt; cA = nA; cB = nB; ++ui;
        epi_prefetch(E, cur, 0);
        if constexpr (ALIGN_EPI) { if (wr == 1) PG8_BAR; }
    }
    PG8_WAIT_V(0);
    if constexpr (!ALIGN_EPI) { if (wr == 0) PG8_BAR; }
    PG8_BAR;
#undef PG8_SA
#undef PG8_SB
#undef PG8_STAGE
#undef PG8_LDA
#undef PG8_LDB
#undef PG8_MMA
#undef PG8_WAIT_V
#undef PG8_WAIT_L
#undef PG8_BAR
#undef PG8_SCHED
}
}

constexpr int NB = 4, SEQ = 8192, DM = 1024, TT = NB * SEQ, CTXL = 256, TC = NB * CTXL, FF = 2816, NH = 16, HD = 64, GW = 64, GROWS = SEQ / GW;
constexpr int WH = 8, WW = 16;
constexpr float EPS = 1e-6f;
constexpr int NWAVES = 8;

constexpr size_t MiB = 1u << 20;
constexpr size_t WS_CTL = 0, CTL_ZERO_BYTES = 64 * 1024;
constexpr size_t CT_BAR = 4096;
constexpr size_t CT_MODS = 64 * 1024;
constexpr size_t CT_BQKV = CT_MODS + 2 * 5 * 6144 * 4;
constexpr size_t CT_BUP0 = CT_BQKV + 5 * 3072 * 4;
constexpr size_t CT_BIN  = CT_BUP0 + 4 * 5632 * 4;
constexpr size_t CT_BUP1 = CT_BIN + 4 * 3072 * 4;
constexpr size_t CT_END  = CT_BUP1 + 4 * 5632 * 4;
static_assert(CT_END <= 1 * MiB, "ctl region");
constexpr size_t SM_SSQ0 = 1 * MiB, SM_SSQC = SM_SSQ0 + 32768 * 4, SM_GN = SM_SSQC + 1024 * 4;
constexpr size_t WS_SSQP = 2 * MiB;
constexpr size_t WS_FSQP = 4 * MiB;
constexpr size_t WS_XB = 448 * MiB;
constexpr size_t WS_WQKV = 8 * MiB, WS_WO = 14 * MiB, WS_WUP0 = 16 * MiB, WS_WDN0 = 27 * MiB, WS_WIN = 33 * MiB, WS_WOUT = 39 * MiB, WS_WUP1 = 41 * MiB, WS_WDN1 = 52 * MiB;
constexpr size_t WS_XSC = 58 * MiB, WS_KC = 60 * MiB, WS_VC = 62 * MiB;
constexpr size_t WS_XS = 64 * MiB;
constexpr size_t WS_Q = 128 * MiB, WS_K = 192 * MiB, WS_V = 256 * MiB, WS_O = WS_Q;
constexpr size_t WS_AG = 128 * MiB;
constexpr size_t WS_HG = 308 * MiB, WS_HA = 314 * MiB;
constexpr size_t WS_UT = 128 * MiB;
constexpr size_t WS_HT = 128 * MiB;
constexpr size_t WS_F = 320 * MiB;
constexpr size_t SM_TWM = 1536 * 1024, SM_TWN = SM_TWM + 65536;
constexpr size_t WS_P = 384 * MiB;
constexpr size_t WS_END = 512 * MiB;

constexpr int RING_BYTES = 131072;
constexpr int LDS_BYTES = 163840;
constexpr int CB_LDS_OFF = 136 * 1024;
constexpr int LDSCTL_OFF = LDS_BYTES - 1024, MISC_OFF = LDSCTL_OFF + 320;

#define GAS __attribute__((address_space(1)))
#define LAS __attribute__((address_space(3)))
typedef unsigned short bf16;
typedef unsigned v4u __attribute__((ext_vector_type(4)));
typedef unsigned v2u __attribute__((ext_vector_type(2)));
typedef float f32x4 __attribute__((ext_vector_type(4)));
typedef GAS unsigned gu32;
#define RLX_AGENT __ATOMIC_RELAXED, __HIP_MEMORY_SCOPE_AGENT
#define LDS_WAIT() asm volatile("s_waitcnt lgkmcnt(0)" ::: "memory")
#define VM_WAIT() asm volatile("s_waitcnt vmcnt(0)" ::: "memory")
__device__ __forceinline__ unsigned f2bf(float f) { unsigned u = __builtin_bit_cast(unsigned, f); return (u + 0x7fffu + ((u >> 16) & 1u)) >> 16; }
__device__ __forceinline__ unsigned pk2(float lo, float hi) { unsigned r; asm("v_cvt_pk_bf16_f32 %0, %1, %2" : "=v"(r) : "v"(lo), "v"(hi)); return r; }
__device__ __forceinline__ float bf2f(unsigned short h) { return __builtin_bit_cast(float, (unsigned)h << 16); }
__device__ __forceinline__ float bflo(unsigned w) { return __builtin_bit_cast(float, w << 16); }
__device__ __forceinline__ float bfhi(unsigned w) { return __builtin_bit_cast(float, w & 0xffff0000u); }

#define FC_HD __device__ __forceinline__
typedef float cf __attribute__((ext_vector_type(2)));
FC_HD cf cmul(cf a, cf b) { const cf t = {-b.y, b.x}; return a.xx * b + a.yy * t; }
FC_HD cf cadd(cf a, cf b) { return a + b; }
FC_HD cf csub(cf a, cf b) { return a - b; }
FC_HD cf cconj(cf a) { cf r; r.x = a.x; r.y = -a.y; return r; }
FC_HD cf cmulnegi(cf a) { cf r; r.x = a.y; r.y = -a.x; return r; }
#define FC_OPAQUE(x) asm volatile("" : "+v"(x))
#define FC_PIDX(i) ((i) + (((i) >> 6) << 3))
#define FC_M 8192
#define FC_PADM (FC_M + FC_M / 8)
#define FC_S2 0.70710678118654752f
FC_HD void dft4(cf& a0, cf& a1, cf& a2, cf& a3) {
    const cf c0 = cadd(a0, a2), c1 = cadd(a1, a3), d0 = csub(a0, a2), d1 = cmulnegi(csub(a1, a3));
    a0 = cadd(c0, c1); a1 = cadd(d0, d1); a2 = csub(c0, c1); a3 = csub(d0, d1);
}
FC_HD void dft8(cf* v) {
    cf a0 = cadd(v[0], v[4]), a1 = cadd(v[1], v[5]), a2 = cadd(v[2], v[6]), a3 = cadd(v[3], v[7]);
    cf b0 = csub(v[0], v[4]), b1 = csub(v[1], v[5]), b2 = csub(v[2], v[6]), b3 = csub(v[3], v[7]);
    { cf t; t.x = (b1.x + b1.y) * FC_S2; t.y = (b1.y - b1.x) * FC_S2; b1 = t; }
    b2 = cmulnegi(b2);
    { cf t; t.x = (b3.y - b3.x) * FC_S2; t.y = (-b3.x - b3.y) * FC_S2; b3 = t; }
    dft4(a0, a1, a2, a3); dft4(b0, b1, b2, b3);
    v[0] = a0; v[2] = a1; v[4] = a2; v[6] = a3; v[1] = b0; v[3] = b1; v[5] = b2; v[7] = b3;
}
FC_HD void dft16(cf* v) {
    cf a[8], b[8];
    const float c1 = 0.92387953251128674f, s1 = 0.38268343236508977f;
#ifdef __HIP_DEVICE_COMPILE__
#pragma unroll
#endif
    for (int i = 0; i < 8; ++i) { a[i] = cadd(v[i], v[i + 8]); b[i] = csub(v[i], v[i + 8]); }
    { cf w; w.x = c1; w.y = -s1; b[1] = cmul(b[1], w); }
    { cf w; w.x = FC_S2; w.y = -FC_S2; b[2] = cmul(b[2], w); }
    { cf w; w.x = s1; w.y = -c1; b[3] = cmul(b[3], w); }
    b[4] = cmulnegi(b[4]);
    { cf w; w.x = -s1; w.y = -c1; b[5] = cmul(b[5], w); }
    { cf w; w.x = -FC_S2; w.y = -FC_S2; b[6] = cmul(b[6], w); }
    { cf w; w.x = -c1; w.y = -s1; b[7] = cmul(b[7], w); }
    dft8(a); dft8(b);
#ifdef __HIP_DEVICE_COMPILE__
#pragma unroll
#endif
    for (int i = 0; i < 8; ++i) { v[2 * i] = a[i]; v[2 * i + 1] = b[i]; }
}
template <int R> FC_HD void cpowers(cf w1, cf* w) {
    w[0].x = 1.f; w[0].y = 0.f; w[1] = w1;
#ifdef __HIP_DEVICE_COMPILE__
#pragma unroll
#endif
    for (int q = 2; q < R; ++q) w[q] = (q & 1) ? cmul(w[q - 1], w1) : cmul(w[q >> 1], w[q >> 1]);
}
template <class LP> FC_HD void fwd_pass1(cf* v, int tid, LP a, const cf* TWM) {
    dft16(v);
    FC_OPAQUE(tid);
    const cf w1 = TWM[tid]; cf cur = w1;
    const int pt = FC_PIDX(tid);
    a[pt] = v[0];
#ifdef __HIP_DEVICE_COMPILE__
#pragma unroll
#endif
    for (int q = 1; q < 16; ++q) { a[pt + 576 * q] = cmul(v[q], cur); cur = cmul(cur, w1); }
}
template <class LP> FC_HD void fwd_pass8(int tid, LP a, const cf* TWM, int s, int lgs) {
#pragma unroll 1
    for (int h = 0; h < 2; ++h) {
        FC_OPAQUE(tid);
        const int bf = tid + 512 * h, j = bf & (s - 1), base = (bf >> lgs) * 8 * s;
        const int pb = FC_PIDX(base + j), ps = (s == 64) ? 72 : 8;
        cf v[8];
#ifdef __HIP_DEVICE_COMPILE__
#pragma unroll
#endif
        for (int r = 0; r < 8; ++r) v[r] = a[pb + ps * r];
        dft8(v);
        const cf w1 = TWM[j]; cf cur = w1;
        a[pb] = v[0];
#ifdef __HIP_DEVICE_COMPILE__
#pragma unroll
#endif
        for (int q = 1; q < 8; ++q) { a[pb + ps * q] = cmul(v[q], cur); cur = cmul(cur, w1); }
    }
}
template <class LP> FC_HD void mid_pass(int tid, LP a, const cf* F, cf* Fout, float fscale) {
#pragma unroll 1
    for (int h = 0; h < 2; ++h) {
        FC_OPAQUE(tid);
        const int bf = tid + 512 * h, base = bf * 8, pb = FC_PIDX(base);
        cf v[8];
#ifdef __HIP_DEVICE_COMPILE__
#pragma unroll
#endif
        for (int r = 0; r < 8; ++r) v[r] = a[pb + r];
        dft8(v);
        if (F) {
#ifdef __HIP_DEVICE_COMPILE__
#pragma unroll
#endif
            for (int r = 0; r < 8; ++r) v[r] = cconj(cmul(v[r], F[base + r]));
            dft8(v);
#ifdef __HIP_DEVICE_COMPILE__
#pragma unroll
#endif
            for (int r = 0; r < 8; ++r) a[pb + r] = v[r];
        } else {
#ifdef __HIP_DEVICE_COMPILE__
#pragma unroll
#endif
            for (int r = 0; r < 8; ++r) { cf o; o.x = v[r].x * fscale; o.y = v[r].y * fscale; Fout[base + r] = o; }
        }
    }
}
template <class LP> FC_HD void mid_pass_reg(int tid, LP a, const cf* fr) {
#ifdef __HIP_DEVICE_COMPILE__
#pragma unroll
#endif
    for (int h = 0; h < 2; ++h) {
        FC_OPAQUE(tid);
        const int bf = tid + 512 * h, base = bf * 8, pb = FC_PIDX(base);
        cf v[8];
#ifdef __HIP_DEVICE_COMPILE__
#pragma unroll
#endif
        for (int r = 0; r < 8; ++r) v[r] = a[pb + r];
        dft8(v);
#ifdef __HIP_DEVICE_COMPILE__
#pragma unroll
#endif
        for (int r = 0; r < 8; ++r) v[r] = cconj(cmul(v[r], fr[h * 8 + r]));
        dft8(v);
#ifdef __HIP_DEVICE_COMPILE__
#pragma unroll
#endif
        for (int r = 0; r < 8; ++r) a[pb + r] = v[r];
    }
}
template <class LP> FC_HD void inv_pass8(int tid, LP a, const cf* TWM, int s, int lgs) {
#pragma unroll 1
    for (int h = 0; h < 2; ++h) {
        FC_OPAQUE(tid);
        const int bf = tid + 512 * h, j = bf & (s - 1), base = (bf >> lgs) * 8 * s;
        const int pb = FC_PIDX(base + j), ps = (s == 64) ? 72 : 8;
        cf v[8]; const cf w1 = TWM[j]; cf cur = w1;
        v[0] = a[FC_PIDX(base + j)];
#ifdef __HIP_DEVICE_COMPILE__
#pragma unroll
#endif
        for (int q = 1; q < 8; ++q) { v[q] = cmul(a[pb + ps * q], cur); cur = cmul(cur, w1); }
        dft8(v);
#ifdef __HIP_DEVICE_COMPILE__
#pragma unroll
#endif
        for (int r = 0; r < 8; ++r) a[pb + ps * r] = v[r];
    }
}
template <class LP> FC_HD void inv_pass1(cf* v, int tid, LP a, const cf* TWM) {
    FC_OPAQUE(tid);
    const cf w1 = TWM[tid]; cf cur = w1;
    const int pt = FC_PIDX(tid);
    v[0] = a[pt];
#ifdef __HIP_DEVICE_COMPILE__
#pragma unroll
#endif
    for (int q = 1; q < 16; ++q) { v[q] = cmul(a[pt + 576 * q], cur); cur = cmul(cur, w1); }
    dft16(v);
}

#define F2_PIDX(i) ((i) + ((i) >> 5))
#define F2_PADM (8192 + 256)
FC_HD void dft32(cf* v) {
    const float c[16] = {1.0f, 0.98078528040323043f, 0.92387953251128674f, 0.83146961230254524f, 0.70710678118654752f, 0.55557023301960218f, 0.38268343236508977f, 0.19509032201612825f,
                         0.0f, -0.19509032201612825f, -0.38268343236508977f, -0.55557023301960218f, -0.70710678118654752f, -0.83146961230254524f, -0.92387953251128674f, -0.98078528040323043f};
    const float s[16] = {0.0f, 0.19509032201612825f, 0.38268343236508977f, 0.55557023301960218f, 0.70710678118654752f, 0.83146961230254524f, 0.92387953251128674f, 0.98078528040323043f,
                         1.0f, 0.98078528040323043f, 0.92387953251128674f, 0.83146961230254524f, 0.70710678118654752f, 0.55557023301960218f, 0.38268343236508977f, 0.19509032201612825f};
#ifdef __HIP_DEVICE_COMPILE__
#pragma unroll
#endif
    for (int i = 0; i < 16; ++i) { const cf a = cadd(v[i], v[i + 16]); cf b = csub(v[i], v[i + 16]);
        if (i == 8) b = cmulnegi(b); else if (i != 0) { cf w; w.x = c[i]; w.y = -s[i]; b = cmul(b, w); }
        v[i] = a; v[i + 16] = b; }
    dft16(v); dft16(v + 16);
}
#define F2_Q(k) (2 * ((k) & 15) + ((k) >> 4))
template <class LP> FC_HD void f2_fwd_p1(cf* v, int tid, LP a, const cf* tw1) {
    dft16(v);
    FC_OPAQUE(tid);
    const cf w1 = tw1[tid]; cf cur = w1;
    const int pt = F2_PIDX(tid);
    a[pt] = v[0];
#ifdef __HIP_DEVICE_COMPILE__
#pragma unroll
#endif
    for (int q = 1; q < 16; ++q) { a[pt + 528 * q] = cmul(v[q], cur); cur = cmul(cur, w1); }
}
template <class LP> FC_HD void f2_fwd_p2(int tid, LP a, const cf* tw32) {
    FC_OPAQUE(tid);
    const int j = tid & 31, pb = F2_PIDX((tid >> 5) * 512 + j);
    cf v[16];
#ifdef __HIP_DEVICE_COMPILE__
#pragma unroll
#endif
    for (int r = 0; r < 16; ++r) v[r] = a[pb + 33 * r];
    dft16(v);
    const cf w1 = tw32[j]; cf cur = w1;
    a[pb] = v[0];
#ifdef __HIP_DEVICE_COMPILE__
#pragma unroll
#endif
    for (int q = 1; q < 16; ++q) { a[pb + 33 * q] = cmul(v[q], cur); cur = cmul(cur, w1); }
}
template <class LP> FC_HD void f2_fwd_p2_dual(int tid, LP a, LP b, const cf* tw32) {
    FC_OPAQUE(tid);
    const int j = tid & 31, pb = F2_PIDX((tid >> 5) * 512 + j);
    cf v[16], w[16];
#ifdef __HIP_DEVICE_COMPILE__
#pragma unroll
#endif
    for (int r = 0; r < 16; ++r) v[r] = a[pb + 33 * r];
#ifdef __HIP_DEVICE_COMPILE__
#pragma unroll
#endif
    for (int r = 0; r < 16; ++r) w[r] = b[pb + 33 * r];
    const cf w1 = tw32[j];
    dft16(v);
    { cf cur = w1; a[pb] = v[0];
#ifdef __HIP_DEVICE_COMPILE__
#pragma unroll
#endif
      for (int q = 1; q < 16; ++q) { a[pb + 33 * q] = cmul(v[q], cur); cur = cmul(cur, w1); } }
    dft16(w);
    { cf cur = w1; b[pb] = w[0];
#ifdef __HIP_DEVICE_COMPILE__
#pragma unroll
#endif
      for (int q = 1; q < 16; ++q) { b[pb + 33 * q] = cmul(w[q], cur); cur = cmul(cur, w1); } }
}
template <class LP> FC_HD void f2_inv_p2_dual(int tid, LP a, LP b, const cf* tw32) {
    FC_OPAQUE(tid);
    const int j = tid & 31, pb = F2_PIDX((tid >> 5) * 512 + j);
    cf v[16], w[16]; const cf w1 = tw32[j];
#ifdef __HIP_DEVICE_COMPILE__
#pragma unroll
#endif
    for (int r = 0; r < 16; ++r) v[r] = a[pb + 33 * r];
#ifdef __HIP_DEVICE_COMPILE__
#pragma unroll
#endif
    for (int r = 0; r < 16; ++r) w[r] = b[pb + 33 * r];
    { cf cur = w1;
#ifdef __HIP_DEVICE_COMPILE__
#pragma unroll
#endif
      for (int q = 1; q < 16; ++q) { v[q] = cmul(v[q], cur); cur = cmul(cur, w1); } }
    dft16(v);
#ifdef __HIP_DEVICE_COMPILE__
#pragma unroll
#endif
    for (int r = 0; r < 16; ++r) a[pb + 33 * r] = v[r];
    { cf cur = w1;
#ifdef __HIP_DEVICE_COMPILE__
#pragma unroll
#endif
      for (int q = 1; q < 16; ++q) { w[q] = cmul(w[q], cur); cur = cmul(cur, w1); } }
    dft16(w);
#ifdef __HIP_DEVICE_COMPILE__
#pragma unroll
#endif
    for (int r = 0; r < 16; ++r) b[pb + 33 * r] = w[r];
}
template <class LP> FC_HD void f2_mid(int bf, LP a, const cf* fr, cf* Fout, float fscale) {
    FC_OPAQUE(bf);
    const int pb = 33 * bf;
    cf v[32];
#ifdef __HIP_DEVICE_COMPILE__
#pragma unroll
#endif
    for (int i = 0; i < 32; ++i) v[i] = a[pb + i];
    dft32(v);
    if (fr) {
        cf w[32];
#ifdef __HIP_DEVICE_COMPILE__
#pragma unroll
#endif
        for (int k = 0; k < 32; ++k) w[F2_Q(k)] = cconj(cmul(v[k], fr[F2_Q(k)]));
        dft32(w);
#ifdef __HIP_DEVICE_COMPILE__
#pragma unroll
#endif
        for (int k = 0; k < 32; ++k) a[pb + F2_Q(k)] = w[k];
    } else {
#ifdef __HIP_DEVICE_COMPILE__
#pragma unroll
#endif
        for (int k = 0; k < 32; ++k) { cf o; o.x = v[k].x * fscale; o.y = v[k].y * fscale; Fout[F2_Q(k) * 256 + bf] = o; }
    }
}
typedef _Float16 h2v __attribute__((ext_vector_type(2)));
FC_HD unsigned pkh2(cf a) { h2v v; v.x = (_Float16)a.x; v.y = (_Float16)a.y; return __builtin_bit_cast(unsigned, v); }
FC_HD cf unh2(unsigned u) { const h2v v = __builtin_bit_cast(h2v, u); cf r; r.x = (float)v.x; r.y = (float)v.y; return r; }
template <class LP> FC_HD void f2_mid_store16(int bf, LP a, v2u* Fout) {
    FC_OPAQUE(bf);
    const int pb = 33 * bf;
    cf v[32];
#pragma unroll
    for (int i = 0; i < 32; ++i) v[i] = a[pb + i];
    dft32(v);
#pragma unroll
    for (int k = 0; k < 16; ++k) { v2u o; o.x = pkh2(v[k]); o.y = pkh2(v[k + 16]); Fout[k * 256 + bf] = o; }
}
template <class LP> FC_HD void f2_mid16(int bf, LP a, const v2u* fr16) {
    FC_OPAQUE(bf);
    const int pb = 33 * bf;
    cf v[32];
#pragma unroll
    for (int i = 0; i < 32; ++i) v[i] = a[pb + i];
    dft32(v);
    cf w[32];
#pragma unroll
    for (int k = 0; k < 32; ++k) w[F2_Q(k)] = cconj(cmul(v[k], unh2(k < 16 ? fr16[k & 15].x : fr16[k & 15].y)));
    dft32(w);
#pragma unroll
    for (int k = 0; k < 32; ++k) a[pb + F2_Q(k)] = w[k];
}
template <class LP> FC_HD void f2_inv_p2(int tid, LP a, const cf* tw32) {
    FC_OPAQUE(tid);
    const int j = tid & 31, pb = F2_PIDX((tid >> 5) * 512 + j);
    cf v[16]; const cf w1 = tw32[j]; cf cur = w1;
    v[0] = a[pb];
#ifdef __HIP_DEVICE_COMPILE__
#pragma unroll
#endif
    for (int q = 1; q < 16; ++q) { v[q] = cmul(a[pb + 33 * q], cur); cur = cmul(cur, w1); }
    dft16(v);
#ifdef __HIP_DEVICE_COMPILE__
#pragma unroll
#endif
    for (int r = 0; r < 16; ++r) a[pb + 33 * r] = v[r];
}
template <class LP> FC_HD void f2_inv_p1(cf* v, int tid, LP a, const cf* tw1) {
    FC_OPAQUE(tid);
    const cf w1 = tw1[tid]; cf cur = w1;
    const int pt = F2_PIDX(tid);
    v[0] = a[pt];
#ifdef __HIP_DEVICE_COMPILE__
#pragma unroll
#endif
    for (int q = 1; q < 16; ++q) { v[q] = cmul(a[pt + 528 * q], cur); cur = cmul(cur, w1); }
    dft16(v);
}

#define XB_TMO      128
#define XB_XCNT(j)  (256  + 64 * (j))
#define XB_XSUB(j)  (1280 + 64 * (j))
#define XB_XGEN(j)  (2304 + 64 * (j))
#define XB_TOP      3328
#define XB_TOPGEN   3392
#define XCD_BAR_WORDS 3456
#define XB_SPIN_CAP (1u << 18)
__device__ __forceinline__ unsigned xb_ld(unsigned* p)              { return __hip_atomic_load(p, __ATOMIC_RELAXED, __HIP_MEMORY_SCOPE_AGENT); }
__device__ __forceinline__ unsigned xb_add(unsigned* p, unsigned v) { return __hip_atomic_fetch_add(p, v, __ATOMIC_RELAXED, __HIP_MEMORY_SCOPE_AGENT); }
__device__ __forceinline__ unsigned xb_xcc_id() { return (unsigned)__builtin_amdgcn_s_getreg((3 << 11) | 20) & 0xFu; }
#define XB_SPIN(cond, bar) do { unsigned _sp = 0; while (cond) { __builtin_amdgcn_s_sleep(1); \
    if ((++_sp & 255u) == 0u) { if (xb_ld(&(bar)[XB_TMO])) break; if (_sp > XB_SPIN_CAP) { atomicAdd(&(bar)[XB_TMO], 1u); break; } } } } while (0)
struct XcdBarrier { unsigned* bar; unsigned x; volatile LAS unsigned* st; };
__device__ __forceinline__ XcdBarrier xcd_barrier_post(unsigned* bar, volatile LAS unsigned* st) {
    XcdBarrier b; b.bar = bar; b.x = xb_xcc_id(); b.st = st;
    if (threadIdx.x == 0) (void)xb_add(&bar[XB_XCNT(b.x)], 1u);
    return b;
}
__device__ __forceinline__ void xcd_barrier_complete(unsigned* bar, unsigned x, unsigned& nloc, unsigned& nx) {
    const unsigned G = gridDim.x * gridDim.y * gridDim.z;
    unsigned sum, cnt, mine, sp = 0u;
    for (;;) {
        sum = 0u; cnt = 0u; mine = 0u;
#pragma unroll
        for (unsigned j = 0; j < 16; ++j) { const unsigned c = xb_ld(&bar[XB_XCNT(j)]); sum += c; cnt += (c > 0u) ? 1u : 0u; mine = (j == x) ? c : mine; }
        if (sum == G) break;
        __builtin_amdgcn_s_sleep(1);
        if ((++sp & 255u) == 0u) { if (xb_ld(&bar[XB_TMO])) break; if (sp > XB_SPIN_CAP) { atomicAdd(&bar[XB_TMO], 1u); break; } }
    }
    nloc = mine > 0u ? mine : 1u; nx = cnt > 0u ? cnt : 1u;
}
__device__ __forceinline__ void xcd_barrier(const XcdBarrier& b) {
    asm volatile("s_waitcnt vmcnt(0)" ::: "memory");
    __syncthreads();
    if (threadIdx.x == 0) {
        unsigned* bar = b.bar;
        __builtin_amdgcn_s_waitcnt(0);
        unsigned nloc = b.st[0], nx = b.st[1];
        if (nloc == 0u) { xcd_barrier_complete(bar, b.x, nloc, nx); b.st[0] = nloc; b.st[1] = nx; }
        const unsigned old = xb_add(&bar[XB_XSUB(b.x)], 1u);
        const unsigned gen = old / nloc;
        if (old + 1u == (gen + 1u) * nloc) {
            __builtin_amdgcn_fence(__ATOMIC_RELEASE, "agent");
            asm volatile("s_waitcnt vmcnt(0)" ::: "memory");
            const unsigned og = xb_add(&bar[XB_TOP], 1u);
            const unsigned tg = og / nx;
            if (og + 1u == (tg + 1u) * nx) xb_add(&bar[XB_TOPGEN], 1u);
            else XB_SPIN(xb_ld(&bar[XB_TOPGEN]) == tg, bar);
            __builtin_amdgcn_fence(__ATOMIC_ACQUIRE, "agent");
            xb_add(&bar[XB_XGEN(b.x)], 1u);
            asm volatile("s_waitcnt vmcnt(0)" ::: "memory");
        } else {
            XB_SPIN(xb_ld(&bar[XB_XGEN(b.x)]) == gen, bar);
            __builtin_amdgcn_fence(__ATOMIC_ACQUIRE, "agent");
            asm volatile("s_waitcnt vmcnt(0)" ::: "memory");
        }
    }
    __syncthreads();
}

struct Args { const float* in[40]; float* out; unsigned char* ws; int ph_lo, ph_hi, repmask, li; };
struct Frame {
    LAS unsigned char* lds;
    int tid, lane, wave, vcu, G;
    const float* const* in; float* out; unsigned char* ws;
#ifdef PROBE_SEC
    unsigned long long sec;
#endif
};
__device__ __forceinline__ float wave_sum(float v) {
#pragma unroll
    for (int o = 1; o < 64; o <<= 1) v += __shfl_xor(v, o);
    return v;
}
__device__ __forceinline__ float silu_f(float x) { return x / (1.f + __expf(-x)); }

__device__ __forceinline__ float gelu_f(float v) { return 0.5f * v * (1.f + erff(v * 0.70710678118654752f)); }

__device__ __forceinline__ void transpose_item(const float* W, int K, int N, bf16* WT, int src_col0, int dst_row0, int k0, LAS float* scr, int lane) {
    {
        const int r8 = lane >> 3, c4 = (lane & 7) * 4;
        f32x4 x[8];
#pragma unroll
        for (int i = 0; i < 8; ++i) x[i] = *(const f32x4*)(W + (size_t)(k0 + 8 * i + r8) * N + src_col0 + c4);
#pragma unroll
        for (int i = 0; i < 8; ++i) { LAS float* d = scr + (8 * i + r8) * 33 + c4; d[0] = x[i].x; d[1] = x[i].y; d[2] = x[i].z; d[3] = x[i].w; }
    }
    LDS_WAIT(); asm volatile("" ::: "memory");
    const int c = lane & 7;
#pragma unroll
    for (int j = 0; j < 4; ++j) { const int n = (lane >> 3) + 8 * j; const LAS float* s = scr + (8 * c) * 33 + n;
        v4u o; o.x = pk2(s[0 * 33], s[1 * 33]); o.y = pk2(s[2 * 33], s[3 * 33]); o.z = pk2(s[4 * 33], s[5 * 33]); o.w = pk2(s[6 * 33], s[7 * 33]);
        *(GAS v4u*)(WT + (size_t)(dst_row0 + n) * K + k0 + 8 * c) = o; }
    LDS_WAIT(); asm volatile("" ::: "memory");
}
__device__ __forceinline__ void transpose_load(const float* W, int N, int src_col0, int k0, int lane, f32x4 (&x)[8]) {
    const int r8 = lane >> 3, c4 = (lane & 7) * 4;
#pragma unroll
    for (int i = 0; i < 8; ++i) x[i] = *(const f32x4*)(W + (size_t)(k0 + 8 * i + r8) * N + src_col0 + c4);
}
__device__ __forceinline__ void transpose_finish(const f32x4 (&x)[8], int K, bf16* WT, int dst_row0, int k0, LAS float* scr, int lane) {
    { const int r8 = lane >> 3, c4 = (lane & 7) * 4;
#pragma unroll
      for (int i = 0; i < 8; ++i) { LAS float* d = scr + (8 * i + r8) * 33 + c4; d[0] = x[i].x; d[1] = x[i].y; d[2] = x[i].z; d[3] = x[i].w; } }
    LDS_WAIT(); asm volatile("" ::: "memory");
    const int c = lane & 7;
#pragma unroll
    for (int j = 0; j < 4; ++j) { const int n = (lane >> 3) + 8 * j; const LAS float* s = scr + (8 * c) * 33 + n;
        v4u o; o.x = pk2(s[0 * 33], s[1 * 33]); o.y = pk2(s[2 * 33], s[3 * 33]); o.z = pk2(s[4 * 33], s[5 * 33]); o.w = pk2(s[6 * 33], s[7 * 33]);
        *(GAS v4u*)(WT + (size_t)(dst_row0 + n) * K + k0 + 8 * c) = o; }
    LDS_WAIT(); asm volatile("" ::: "memory");
}
__device__ __forceinline__ int qkv_slot_to_col(int slot) {
    const int part = slot >> 10, cc = slot & 1023, pnl = cc >> 8, s = cc & 255, bj = s >> 7, wc = (s & 127) >> 5, j = s & 31;
    return part * 1024 + (4 * pnl + wc) * 64 + 32 * bj + j;
}
__device__ __forceinline__ int up_slot_to_col(int slot) { const int pn = slot >> 8, bj = (slot >> 7) & 1, cc = slot & 127; return bj * FF + pn * 128 + cc; }
__device__ __forceinline__ void cvt_weight_item(const float* W, int K, int N, bf16* WT, int item, LAS float* scr, int lane, int perm) {
    const int nblk = N / 32, kb = item / nblk, nb = item % nblk;
    const int dst = 32 * nb, src = perm == 1 ? qkv_slot_to_col(dst) : (perm == 2 ? up_slot_to_col(dst) : dst);
    transpose_item(W, K, N, WT, src, dst, 64 * kb, scr, lane);
}

template <int R, class VF>
__device__ __forceinline__ void gemv_det_item(const float* W, int N, int n0, float* out, int ostride, const float* addbias, const VF& vf, int tid, LAS float* scr) {
    const int col = tid & 63, ks = tid >> 6;
    float acc[R];
#pragma unroll
    for (int r = 0; r < R; ++r) acc[r] = 0.f;
    const float* wp = W + (size_t)(ks * 128) * N + n0 + col;
#pragma unroll 8
    for (int k = 0; k < 128; ++k) { const float w = wp[(size_t)k * N];
#pragma unroll
        for (int r = 0; r < R; ++r) acc[r] += vf(r, ks * 128 + k) * w; }
    __syncthreads();
#pragma unroll
    for (int r = 0; r < R; ++r) scr[(ks * R + r) * 64 + col] = acc[r];
    __syncthreads();
    if (tid < R * 64) { const int r = tid >> 6; float s = 0.f;
#pragma unroll
        for (int k2 = 0; k2 < 8; ++k2) s += scr[(k2 * R + r) * 64 + col];
        if (addbias) s += addbias[n0 + col];
        out[(size_t)r * ostride + n0 + col] = s; }
}

template <int R, class VF>
__device__ __forceinline__ void gemv_det_item16(const float* W, int N, int n0, float* out, int ostride, const float* addbias, const VF& vf, int tid, LAS float* scr) {
    const int col = tid & 15, ks = tid >> 4;
    float acc[R];
#pragma unroll
    for (int r = 0; r < R; ++r) acc[r] = 0.f;
    const float* wp = W + (size_t)(ks * 32) * N + n0 + col;
#pragma unroll 8
    for (int k = 0; k < 32; ++k) { const float w = wp[(size_t)k * N];
#pragma unroll
        for (int r = 0; r < R; ++r) acc[r] += vf(r, ks * 32 + k) * w; }
    __syncthreads();
#pragma unroll
    for (int r = 0; r < R; ++r) scr[(ks * R + r) * 16 + col] = acc[r];
    __syncthreads();
    if (tid < R * 16) { const int r = tid >> 4; float s = 0.f;
#pragma unroll
        for (int k2 = 0; k2 < 32; ++k2) s += scr[(k2 * R + r) * 16 + col];
        if (addbias) s += addbias[n0 + col];
        out[(size_t)r * ostride + n0 + col] = s; }
}

__device__ __forceinline__ void phase0a(Frame& F) {
    const float* const* in = F.in;
    float* mods = (float*)(F.ws + CT_MODS);
    {
        const float* c = in[1]; const float* cctx = in[3];
        LAS float* sl = (LAS float*)(F.lds + 65536);
        for (int e = F.tid; e < 5 * DM; e += 512) { const float v = (e < 4 * DM) ? c[e] : cctx[e - 4 * DM]; sl[e] = silu_f(v); }
        __syncthreads();
        auto vf = [&](int r, int k) -> float { return sl[r * DM + k]; };
        const int nitems = 2 * 96;
        for (int it = F.vcu; it < nitems; it += F.G) {
            const int l = it / 96, cg = it % 96;
            gemv_det_item<5>(in[l ? 17 : 4], 6144, cg * 64, mods + l * 5 * 6144, 6144, in[l ? 18 : 5], vf, F.tid, (LAS float*)F.lds);
        }
        __syncthreads();
    }
    for (int e = F.vcu * 512 + F.tid; e < 16384; e += F.G * 512) {
        const int k = e & 8191; const bool isn = e >= 8192;
        float sn, cs; sincospif(isn ? (float)k * (1.0f / 8192.0f) : (float)k * (1.0f / 4096.0f), &sn, &cs);
        cf t; t.x = cs; t.y = -sn;
        ((cf*)(F.ws + (isn ? SM_TWN : SM_TWM)))[k] = t;
    }
    LAS float* scr = (LAS float*)(F.lds + F.wave * 16384);
    const int gw = F.vcu * NWAVES + F.wave, NGW = F.G * NWAVES;
    constexpr int I_QKV = 16 * 96, I_O = 16 * 32, I_UP = 16 * 176, I_DN = 44 * 32;
    constexpr int NITEMS = 2 * I_QKV + 2 * I_O + 2 * I_UP + 2 * I_DN;
    struct CvtD { const float* W; bf16* WT; int K, N, src, dst, k0; };
    auto desc = [&](int it) -> CvtD {
        int r = it; const float* W; bf16* WT; int K, N, perm = 0;
        if (r < I_QKV) { W = in[8]; K = DM; N = 3 * DM; WT = (bf16*)(F.ws + WS_WQKV); perm = 1; }
        else if ((r -= I_QKV) < I_O) { W = in[12]; K = DM; N = DM; WT = (bf16*)(F.ws + WS_WO); }
        else if ((r -= I_O) < I_UP) { W = in[13]; K = DM; N = 2 * FF; WT = (bf16*)(F.ws + WS_WUP0); perm = 2; }
        else if ((r -= I_UP) < I_DN) { W = in[16]; K = FF; N = DM; WT = (bf16*)(F.ws + WS_WDN0); }
        else if ((r -= I_DN) < I_QKV) { W = in[21]; K = DM; N = 3 * DM; WT = (bf16*)(F.ws + WS_WIN); }
        else if ((r -= I_QKV) < I_O) { W = in[34]; K = DM; N = DM; WT = (bf16*)(F.ws + WS_WOUT); }
        else if ((r -= I_O) < I_UP) { W = in[36]; K = DM; N = 2 * FF; WT = (bf16*)(F.ws + WS_WUP1); perm = 2; }
        else { r -= I_UP; W = in[39]; K = FF; N = DM; WT = (bf16*)(F.ws + WS_WDN1); }
        const int nblk = N / 32, kb = r / nblk, nb = r % nblk, dst = 32 * nb;
        const int src = perm == 1 ? qkv_slot_to_col(dst) : (perm == 2 ? up_slot_to_col(dst) : dst);
        return CvtD{W, WT, K, N, src, dst, 64 * kb};
    };
    if (gw < NITEMS) {
        f32x4 xc[8], xn[8];
        CvtD dc = desc(gw);
        transpose_load(dc.W, dc.N, dc.src, dc.k0, F.lane, xc);
        for (int it = gw; it < NITEMS; it += NGW) {
            const CvtD dn = desc(min(it + NGW, NITEMS - 1));
            transpose_load(dn.W, dn.N, dn.src, dn.k0, F.lane, xn);
            transpose_finish(xc, dc.K, dc.WT, dc.dst, dc.k0, scr, F.lane);
#pragma unroll
            for (int i = 0; i < 8; ++i) xc[i] = xn[i];
            dc = dn;
        }
    }
}

__device__ __forceinline__ void row_prescale(const float* xrow, const float* gain, const float* sc, bf16* orow, float* ssq_out, int lane) {
    const GAS f32x4* xr = (const GAS f32x4*)xrow + lane;
    const GAS f32x4* gr = (const GAS f32x4*)gain + lane;
    const GAS f32x4* sr = (const GAS f32x4*)sc + lane;
    f32x4 v[4]; float s = 0.f;
#pragma unroll
    for (int j = 0; j < 4; ++j) { v[j] = xr[64 * j]; s += (v[j].x * v[j].x + v[j].y * v[j].y) + (v[j].z * v[j].z + v[j].w * v[j].w); }
    s = wave_sum(s);
    if (lane == 0) *ssq_out = s;
    GAS unsigned long long* o8 = (GAS unsigned long long*)orow + lane;
#pragma unroll
    for (int j = 0; j < 4; ++j) { const f32x4 g = gr[64 * j], c = sr[64 * j]; const f32x4 w = v[j] * g * (c + 1.0f);
        o8[64 * j] = (unsigned long long)pk2(w.x, w.y) | ((unsigned long long)pk2(w.z, w.w) << 32); }
}
__device__ __forceinline__ void phase0b(Frame& F) {
    const float* const* in = F.in;
    const float* mods = (const float*)(F.ws + CT_MODS);
    const int gw = F.vcu * NWAVES + F.wave, NGW = F.G * NWAVES;
    for (int m = gw; m < TT + TC; m += NGW) {
        if (m < TT) { const int b = m / SEQ; row_prescale(in[0] + (size_t)m * DM, in[6], mods + b * 6144 + 1024, (bf16*)(F.ws + WS_XS) + (size_t)m * DM, (float*)(F.ws + SM_SSQ0) + m, F.lane); }
        else { const int mc = m - TT; row_prescale(in[2] + (size_t)mc * DM, in[6], mods + 4 * 6144 + 1024, (bf16*)(F.ws + WS_XSC) + (size_t)mc * DM, (float*)(F.ws + SM_SSQC) + mc, F.lane); }
    }
    {
        float* gn = (float*)(F.ws + SM_GN);
        for (int e = F.vcu * 512 + F.tid; e < 3 * 4 * 1024; e += F.G * 512) {
            const int i = e / 4096, b = (e / 1024) & 3, k = e & 1023;
            const float* g = in[i == 0 ? 7 : (i == 1 ? 19 : 20)];
            const float sc = mods[(i == 0 ? 0 : 1) * 5 * 6144 + b * 6144 + (i == 1 ? 1024 : 4096) + k];
            gn[e] = g[k] * (1.f + sc);
        }
    }
    {
        LAS float* gs = (LAS float*)F.lds;
        for (int it = F.vcu; it < 192; it += F.G) { auto vf = [&](int r, int k) -> float { return mods[r * 6144 + k]; };
            gemv_det_item16<5>(in[8], 3072, it * 16, (float*)(F.ws + CT_BQKV), 3072, nullptr, vf, F.tid, gs); }
        __syncthreads();
    }
}
__device__ __forceinline__ void bias_gemv_late(Frame& F, int it) {
    const float* const* in = F.in;
    const float* mods = (const float*)(F.ws + CT_MODS);
    const int n_up = 88, n_in = 48;
    LAS float* gs = (LAS float*)F.lds;
    if (it < n_up) { auto vf = [&](int r, int k) -> float { return mods[r * 6144 + 3072 + k]; };
        gemv_det_item<4>(in[13], 5632, it * 64, (float*)(F.ws + CT_BUP0), 5632, nullptr, vf, F.tid, gs); }
    else if (it < n_up + n_in) { it -= n_up; auto vf = [&](int r, int k) -> float { return mods[5 * 6144 + r * 6144 + k]; };
        gemv_det_item<4>(in[21], 3072, it * 64, (float*)(F.ws + CT_BIN), 3072, in[22], vf, F.tid, gs); }
    else if (it < 2 * n_up + n_in) { it -= n_up + n_in; auto vf = [&](int r, int k) -> float { return mods[5 * 6144 + r * 6144 + 3072 + k]; };
        gemv_det_item<4>(in[36], 5632, it * 64, (float*)(F.ws + CT_BUP1), 5632, nullptr, vf, F.tid, gs); }
    __syncthreads();
}

using pg8::f32x4; using pg8::Unit;
__device__ __forceinline__ float row_rs(const float* ssq, int np, int row) {
    float s = 0.f;
    for (int i = 0; i < np; ++i) s += ssq[(size_t)i * TT + row];
    return 1.0f / sqrtf(s * (1.0f / 1024.0f) + EPS);
}
constexpr float QSCALE = 0.125f * 1.4426950408889634f;
template <int PART>
struct EpiQK {
    static constexpr bool PERM = true;
    bf16* dst; const float* ssq; int np; const float* bias; int bias_bstride; const float* gain; int seqlen;
    __device__ __forceinline__ void operator()(const f32x4 (&acc)[2][2][4][2], const Unit& u, int wr, int wc, int fr, int fq) const {
        const int head = 4 * u.pn + wc;
        const int b = (u.pm * 256) / seqlen;
        const float* bp = bias + (size_t)b * bias_bstride + PART * 1024 + head * 64 + 8 * fq;
        const float* gp = gain + 8 * fq;
        const float osc = PART == 0 ? QSCALE : 1.0f;
#pragma unroll
        for (int ai = 0; ai < 2; ++ai)
#pragma unroll
            for (int m = 0; m < 4; ++m) {
                const int row = u.pm * 256 + ai * 128 + wr * 64 + m * 16 + fr;
                const float rs = row_rs(ssq, np, row);
                f32x4 v[2][2]; float ss = 0.f;
#pragma unroll
                for (int bj = 0; bj < 2; ++bj)
#pragma unroll
                    for (int n = 0; n < 2; ++n) { v[bj][n] = acc[ai][bj][m][n] * rs + *(const f32x4*)(bp + 32 * bj + 4 * n); const f32x4 t = v[bj][n]; ss += (t.x * t.x + t.y * t.y) + (t.z * t.z + t.w * t.w); }
                ss += __shfl_xor(ss, 16); ss += __shfl_xor(ss, 32);
                const float rn = osc / sqrtf(ss * (1.0f / 64.0f) + EPS);
                const int tl = row - b * seqlen;
                bf16* rowp = (PART == 0) ? dst + (size_t)row * DM + head * 64 + 8 * fq
                                         : dst + ((((size_t)(b * NH + head) * (seqlen / 16) + (tl >> 4)) * 8 + fq) * 16 + (tl & 15)) * 8;
                constexpr int bjstep = (PART == 0) ? 32 : 4 * 16 * 8;
#pragma unroll
                for (int bj = 0; bj < 2; ++bj) { const f32x4 a0 = v[bj][0] * rn * *(const f32x4*)(gp + 32 * bj), a1 = v[bj][1] * rn * *(const f32x4*)(gp + 32 * bj + 4);
                    v4u w; w.x = pk2(a0.x, a0.y); w.y = pk2(a0.z, a0.w); w.z = pk2(a1.x, a1.y); w.w = pk2(a1.z, a1.w);
                    *(v4u*)(rowp + bjstep * bj) = w; }
                asm volatile("" ::: "memory");
            }
    }
};
struct EpiVT {
    static constexpr bool PERM = true;
    bf16* VTp; const float* ssq; int np; const float* bias; int bias_bstride; int seqlen;
    __device__ __forceinline__ void operator()(const f32x4 (&acc)[2][2][4][2], const Unit& u, int wr, int wc, int fr, int fq) const {
        const int head = 4 * u.pn + wc;
        const int b = (u.pm * 256) / seqlen;
        const float* bp = bias + (size_t)b * bias_bstride + 2048 + head * 64 + 8 * fq;
        const int odd = fr & 1;
        f32x4 bv[2][2];
#pragma unroll
        for (int bj = 0; bj < 2; ++bj)
#pragma unroll
            for (int n = 0; n < 2; ++n) bv[bj][n] = *(const f32x4*)(bp + 32 * bj + 4 * n);
#pragma unroll
        for (int ai = 0; ai < 2; ++ai)
#pragma unroll
            for (int m = 0; m < 4; ++m) {
                const int row = u.pm * 256 + ai * 128 + wr * 64 + m * 16 + fr;
                const float rs = row_rs(ssq, np, row);
                const int tl = row - b * seqlen;
                const int c16 = tl & 14, cpos = (c16 & 3) | ((c16 & 8) >> 1) | ((c16 & 4) << 1);
                bf16* vb = VTp + (((size_t)(b * NH + head) * (seqlen / 16) + (tl >> 4)) * 64 + 8 * fq + odd) * 16 + cpos;
#pragma unroll
                for (int bj = 0; bj < 2; ++bj)
#pragma unroll
                    for (int n = 0; n < 2; ++n) {
                        const f32x4 v = acc[ai][bj][m][n] * rs + bv[bj][n];
                        const unsigned w01 = pk2(v.x, v.y), w23 = pk2(v.z, v.w);
                        const unsigned p01 = (unsigned)__shfl_xor((int)w01, 1), p23 = (unsigned)__shfl_xor((int)w23, 1);
                        const unsigned o0 = odd ? ((w01 & 0xffff0000u) | (p01 >> 16)) : ((p01 << 16) | (w01 & 0xffffu));
                        const unsigned o1 = odd ? ((w23 & 0xffff0000u) | (p23 >> 16)) : ((p23 << 16) | (w23 & 0xffffu));
                        bf16* p = vb + (32 * bj + 4 * n) * 16;
                        *(unsigned*)p = o0; *(unsigned*)(p + 2 * 16) = o1;
                    }
            }
    }
};
template <bool BASE_F32, bool OUT_F32>
struct EpiRes {
    static constexpr bool PERM = true;
    const void* base; void* out; const float* gate; const float* bias; const float* gn; bf16* xs; float* ssq; float* hs;
    __device__ __forceinline__ void operator()(const f32x4 (&acc)[2][2][4][2], const Unit& u, int wr, int wc, int fr, int fq) const {
        const int b = (u.pm * 256) / SEQ;
        const int col0 = u.pn * 256 + wc * 32 + 8 * fq;
        constexpr int MB = BASE_F32 ? 2 : 4;
#pragma unroll
        for (int ai = 0; ai < 2; ++ai)
#pragma unroll
        for (int mb = 0; mb < 4; mb += MB) {
            f32x4 bf[MB][2][2]; v4u bh[MB][2];
#pragma unroll
            for (int mi = 0; mi < MB; ++mi) { const size_t off = (size_t)(u.pm * 256 + ai * 128 + wr * 64 + (mb + mi) * 16 + fr) * DM + col0;
#pragma unroll
                for (int bj = 0; bj < 2; ++bj) {
                    if (BASE_F32) { bf[mi][bj][0] = *(const f32x4*)((const float*)base + off + 128 * bj); bf[mi][bj][1] = *(const f32x4*)((const float*)base + off + 128 * bj + 4); }
                    else bh[mi][bj] = *(const v4u*)((const bf16*)base + off + 128 * bj); } }
#pragma unroll
            for (int mi = 0; mi < MB; ++mi) {
                const int m = mb + mi;
                const int rowl = ai * 128 + wr * 64 + m * 16 + fr;
                const size_t off = (size_t)(u.pm * 256 + rowl) * DM + col0;
                float ss = 0.f;
#pragma unroll
                for (int bj = 0; bj < 2; ++bj) {
                    const int c = col0 + 128 * bj;
                    f32x4 b0, b1;
                    if (BASE_F32) { b0 = bf[mi][bj][0]; b1 = bf[mi][bj][1]; }
                    else { const v4u w = bh[mi][bj]; b0 = (f32x4){bflo(w.x), bfhi(w.x), bflo(w.y), bfhi(w.y)}; b1 = (f32x4){bflo(w.z), bfhi(w.z), bflo(w.w), bfhi(w.w)}; }
                    f32x4 a0 = acc[ai][bj][m][0], a1 = acc[ai][bj][m][1];
                    if (bias) { a0 += *(const f32x4*)(bias + c); a1 += *(const f32x4*)(bias + c + 4); }
                    const f32x4 x0 = b0 + *(const f32x4*)(gate + (size_t)b * 6144 + c) * a0, x1 = b1 + *(const f32x4*)(gate + (size_t)b * 6144 + c + 4) * a1;
                    if (OUT_F32) { *(f32x4*)((float*)out + off + 128 * bj) = x0; *(f32x4*)((float*)out + off + 128 * bj + 4) = x1; }
                    else {
                        v4u w; w.x = pk2(x0.x, x0.y); w.y = pk2(x0.z, x0.w); w.z = pk2(x1.x, x1.y); w.w = pk2(x1.z, x1.w);
                        *(v4u*)((bf16*)out + off + 128 * bj) = w;
                        const f32x4 r0 = (f32x4){bflo(w.x), bfhi(w.x), bflo(w.y), bfhi(w.y)}, r1 = (f32x4){bflo(w.z), bfhi(w.z), bflo(w.w), bfhi(w.w)};
                        ss += (r0.x * r0.x + r0.y * r0.y) + (r0.z * r0.z + r0.w * r0.w) + (r1.x * r1.x + r1.y * r1.y) + (r1.z * r1.z + r1.w * r1.w);
                        const f32x4 q0 = r0 * *(const f32x4*)(gn + (size_t)b * 1024 + c), q1 = r1 * *(const f32x4*)(gn + (size_t)b * 1024 + c + 4);
                        v4u ws2; ws2.x = pk2(q0.x, q0.y); ws2.y = pk2(q0.z, q0.w); ws2.z = pk2(q1.x, q1.y); ws2.w = pk2(q1.z, q1.w);
                        *(v4u*)(xs + off + 128 * bj) = ws2;
                    }
                }
                if (!OUT_F32) { ss += __shfl_xor(ss, 16); ss += __shfl_xor(ss, 32); if (fq == 0) hs[rowl * 4 + wc] = ss; }
            }
            asm volatile("" ::: "memory");
        }
        if (!OUT_F32) {
            asm volatile("s_waitcnt lgkmcnt(0)" ::: "memory"); __builtin_amdgcn_s_barrier(); asm volatile("" ::: "memory");
            const int tid = threadIdx.x;
            if (tid < 256) { const f32x4 p = *(const f32x4*)(hs + tid * 4); ssq[(size_t)u.pn * TT + u.pm * 256 + tid] = ((p.x + p.y) + p.z) + p.w; }
        }
    }
};
struct EpiScaleBias {
    static constexpr bool PERM = true;
    bf16* O; int ldc; const float* ssq; int np; const float* bias; int bias_bstride;
    __device__ __forceinline__ void operator()(const f32x4 (&acc)[2][2][4][2], const Unit& u, int wr, int wc, int fr, int fq) const {
        const int b = (u.pm * 256) / SEQ;
        const int col0 = u.pn * 256 + wc * 32 + 8 * fq;
        f32x4 bv[2][2];
#pragma unroll
        for (int bj = 0; bj < 2; ++bj)
#pragma unroll
            for (int n = 0; n < 2; ++n) bv[bj][n] = *(const f32x4*)(bias + (size_t)b * bias_bstride + col0 + 128 * bj + 4 * n);
#pragma unroll
        for (int ai = 0; ai < 2; ++ai)
#pragma unroll
            for (int m = 0; m < 4; ++m) {
                const int row = u.pm * 256 + ai * 128 + wr * 64 + m * 16 + fr;
                const float rs = row_rs(ssq, np, row);
                bf16* rowp = O + (size_t)row * ldc + col0;
#pragma unroll
                for (int bj = 0; bj < 2; ++bj) { const f32x4 v0 = acc[ai][bj][m][0] * rs + bv[bj][0], v1 = acc[ai][bj][m][1] * rs + bv[bj][1];
                    v4u w; w.x = pk2(v0.x, v0.y); w.y = pk2(v0.z, v0.w); w.z = pk2(v1.x, v1.y); w.w = pk2(v1.z, v1.w);
                    *(v4u*)(rowp + 128 * bj) = w; }
            }
    }
};
__device__ __forceinline__ float gelu_as(float v) {
    const float av = fabsf(v), t = __builtin_amdgcn_rcpf(av * 0.2316418882f + 1.0f);
    float q = t * 0.5307027145f + (-0.7265760135f); q = q * t + 0.7107068705f; q = q * t + (-0.142248368f); q = q * t + 0.127414796f; q = q * t;
    const float e = __builtin_amdgcn_exp2f((v * v) * (-0.72134752044f));
    const float m = v * (q * e);
    return v < 0.f ? m : v - m;
}
template <int CTRL> __device__ __forceinline__ float dpp_f(float old, float src) {
    return __builtin_bit_cast(float, __builtin_amdgcn_update_dpp(__builtin_bit_cast(int, old), __builtin_bit_cast(int, src), CTRL, 0xf, 0xf, false));
}
struct EpiUpGlu {
    static constexpr bool PERM = true;
    bf16* act; const float* ssq; int np; const float* bias; const float* cw; const float* cb; float* Hg; float* Ha; float* hl;
    __device__ __forceinline__ void prefetch(const Unit& u) const {
        int tid = threadIdx.x; asm volatile("" : "+v"(tid));
        const int wv = __builtin_amdgcn_readfirstlane(tid >> 6), ln = tid & 63;
        if (wv < 7) {
            const int b = (u.pm * 256) / SEQ, hf = ln >> 5, c4 = u.pn * 128 + (ln & 31) * 4;
            const float* src;
            if (wv == 0) src = bias + (size_t)b * 5632 + hf * FF + c4;
            else if (wv == 1) src = cw + hf * FF + c4;
            else if (wv == 2) src = (hf ? cb : cw + 2 * FF) + c4;
            else src = ssq + (size_t)(wv - 3) * TT + u.pm * 256 + ln * 4;
            __builtin_amdgcn_global_load_lds((const unsigned*)src, (LAS unsigned*)((unsigned char*)hl + (CB_LDS_OFF - RING_BYTES) + wv * 1024), 16, 0, 0);
        }
    }
    __device__ __forceinline__ void operator()(f32x4 (&acc)[2][2][4][2], const Unit& u, int wr, int wc, int fr_, int fq_) const {
        int ln_ = threadIdx.x & 63; asm volatile("" : "+v"(ln_));
        const int fr = ln_ & 15, fq = ln_ >> 4;
        const int j0 = u.pn * 128 + wc * 32 + 8 * fq;
        const float* ct = (const float*)((const unsigned char*)hl + (CB_LDS_OFF - RING_BYTES));
        const int jl = wc * 32 + 8 * fq;
        {
            f32x4 ba[2], bg[2];
#pragma unroll
            for (int n = 0; n < 2; ++n) { ba[n] = *(const f32x4*)(ct + jl + 4 * n); bg[n] = *(const f32x4*)(ct + 128 + jl + 4 * n); }
#pragma unroll
            for (int ai = 0; ai < 2; ++ai)
#pragma unroll
                for (int m = 0; m < 4; ++m) { const int rl_ = ai * 128 + wr * 64 + m * 16 + fr;
                    const float rs = 1.0f / sqrtf((((ct[768 + rl_] + ct[1024 + rl_]) + ct[1280 + rl_]) + ct[1536 + rl_]) * (1.0f / 1024.0f) + EPS);
#pragma unroll
                    for (int n = 0; n < 2; ++n) { acc[ai][0][m][n] = acc[ai][0][m][n] * rs + ba[n]; acc[ai][1][m][n] = acc[ai][1][m][n] * rs + bg[n]; }
                    if (m == 3) asm volatile("" ::: "memory"); }
        }
#pragma unroll
        for (int ai = 0; ai < 2; ++ai) { float* hp = hl + ((2 * ai + wr) * 2) * 128 + wc * 32 + 8 * fq;
            if (fr == 0) { *(f32x4*)(hp) = acc[ai][1][0][0]; *(f32x4*)(hp + 4) = acc[ai][1][0][1]; }
            if (fr == 15) { *(f32x4*)(hp + 128) = acc[ai][1][3][0]; *(f32x4*)(hp + 132) = acc[ai][1][3][1]; } }
        asm volatile("s_waitcnt lgkmcnt(0)" ::: "memory"); __builtin_amdgcn_s_barrier(); asm volatile("" ::: "memory");
        if (wr == 0 && fr < 2) { float* p = Hg + ((size_t)u.pm * 4 + fr) * FF + j0; *(f32x4*)p = acc[0][1][0][0]; *(f32x4*)(p + 4) = acc[0][1][0][1];
            if (fr == 0) { float* q = Ha + ((size_t)u.pm * 2) * FF + j0; *(f32x4*)q = acc[0][0][0][0]; *(f32x4*)(q + 4) = acc[0][0][0][1]; } }
        if (wr == 1 && fr >= 14) { float* p = Hg + ((size_t)u.pm * 4 + 2 + (fr - 14)) * FF + j0; *(f32x4*)p = acc[1][1][3][0]; *(f32x4*)(p + 4) = acc[1][1][3][1];
            if (fr == 15) { float* q = Ha + ((size_t)u.pm * 2 + 1) * FF + j0; *(f32x4*)q = acc[1][0][3][0]; *(f32x4*)(q + 4) = acc[1][0][3][1]; } }
#pragma unroll
        for (int n = 0; n < 2; ++n) {
            const f32x4 w0 = *(const f32x4*)(ct + 256 + jl + 4 * n), w1 = *(const f32x4*)(ct + 384 + jl + 4 * n), w2 = *(const f32x4*)(ct + 512 + jl + 4 * n), cbv = *(const f32x4*)(ct + 640 + jl + 4 * n);
#pragma unroll
            for (int ai = 0; ai < 2; ++ai) {
                const int gi = 2 * ai + wr;
                const f32x4 uph = *(const f32x4*)(hl + (((gi + 3) & 3) * 2 + 1) * 128 + wc * 32 + 8 * fq + 4 * n);
                const f32x4 dnh = *(const f32x4*)(hl + (((gi + 1) & 3) * 2) * 128 + wc * 32 + 8 * fq + 4 * n);
#pragma unroll
                for (int m = 0; m < 4; ++m) {
                    const int rowl = ai * 128 + wr * 64 + m * 16 + fr;
                    f32x4 r;
#pragma unroll
                    for (int e = 0; e < 4; ++e) {
                        const float g = acc[ai][1][m][n][e];
                        const float pu = (m > 0) ? dpp_f<0x121>(g, acc[ai][1][m > 0 ? m - 1 : 0][n][e]) : uph[e];
                        const float up = dpp_f<0x111>(pu, g);
                        const float pd = (m < 3) ? dpp_f<0x12f>(g, acc[ai][1][m < 3 ? m + 1 : 3][n][e]) : dnh[e];
                        const float dn = dpp_f<0x101>(pd, g);
                        const float cv = w0[e] * up + w1[e] * g + w2[e] * dn + cbv[e];
                        r[e] = acc[ai][0][m][n][e] * gelu_as(cv);
                    }
                    if (rowl != 0 && rowl != 255) { v2u w; w.x = pk2(r.x, r.y); w.y = pk2(r.z, r.w); *(v2u*)(act + (size_t)(u.pm * 256 + rowl) * FF + j0 + 4 * n) = w; }
                }
            }
        }
        asm volatile("s_waitcnt lgkmcnt(0)" ::: "memory"); __builtin_amdgcn_s_barrier(); asm volatile("" ::: "memory");
    }
};
__device__ __forceinline__ void glu_fix_tile(Frame& F, int pm, const float* cw, const float* cb) {
    const float* Hg = (const float*)(F.ws + WS_HG); const float* Ha = (const float*)(F.ws + WS_HA); bf16* act = (bf16*)(F.ws + WS_AG);
#pragma unroll 1
    for (int it = 0; it < 3; ++it) {
        const int e = F.tid + 512 * it;
        if (e < 2 * (FF / 4)) {
            const int which = e >= FF / 4 ? 1 : 0, j = (e - which * (FF / 4)) * 4;
            const int t = pm * 256 + (which ? 255 : 0), tl = t % SEQ;
            const int rm = which ? pm * 4 + 2 : max(pm - 1, 0) * 4 + 3, r0 = pm * 4 + (which ? 3 : 0), rp = which ? min(pm + 1, TT / 256 - 1) * 4 : pm * 4 + 1;
            f32x4 gm = *(const f32x4*)(Hg + (size_t)rm * FF + j), gp = *(const f32x4*)(Hg + (size_t)rp * FF + j);
            const f32x4 g0 = *(const f32x4*)(Hg + (size_t)r0 * FF + j), a = *(const f32x4*)(Ha + ((size_t)pm * 2 + which) * FF + j);
            const f32x4 w0 = *(const f32x4*)(cw + j), w1 = *(const f32x4*)(cw + FF + j), w2 = *(const f32x4*)(cw + 2 * FF + j), cbv = *(const f32x4*)(cb + j);
            if (!which && tl == 0) gm = (f32x4){0.f, 0.f, 0.f, 0.f};
            if (which && tl == SEQ - 1) gp = (f32x4){0.f, 0.f, 0.f, 0.f};
            const f32x4 cv = w0 * gm + w1 * g0 + w2 * gp + cbv;
            v2u w; w.x = pk2(a.x * gelu_as(cv.x), a.y * gelu_as(cv.y)); w.y = pk2(a.z * gelu_as(cv.z), a.w * gelu_as(cv.w));
            *(v2u*)(act + (size_t)t * FF + j) = w;
        }
    }
}
__device__ __forceinline__ void glu_fix_phase(Frame& F, const float* cw, const float* cb) {
    const float* Hg = (const float*)(F.ws + WS_HG); const float* Ha = (const float*)(F.ws + WS_HA); bf16* act = (bf16*)(F.ws + WS_AG);
    const int total = (TT / 256) * 2 * FF;
    for (int e = F.vcu * 512 + F.tid; e < total; e += F.G * 512) {
        const int j = e % FF, which = (e / FF) & 1, pm = e / (2 * FF);
        const int t = pm * 256 + (which ? 255 : 0), tl = t % SEQ;
        float gm, g0, gp;
        if (which == 0) { gm = (tl == 0) ? 0.f : Hg[((size_t)(pm - 1) * 4 + 3) * FF + j]; g0 = Hg[((size_t)pm * 4 + 0) * FF + j]; gp = Hg[((size_t)pm * 4 + 1) * FF + j]; }
        else { gm = Hg[((size_t)pm * 4 + 2) * FF + j]; g0 = Hg[((size_t)pm * 4 + 3) * FF + j]; gp = (tl == SEQ - 1) ? 0.f : Hg[((size_t)(pm + 1) * 4 + 0) * FF + j]; }
        const float a = Ha[((size_t)pm * 2 + which) * FF + j];
        const float cv = cw[j] * gm + cw[FF + j] * g0 + cw[2 * FF + j] * gp + cb[j];
        act[(size_t)t * FF + j] = (bf16)f2bf(a * gelu_as(cv));
    }
}
struct EpiNull {
    static constexpr bool PERM = true;
    float* sink;
    __device__ __forceinline__ void operator()(const f32x4 (&acc)[2][2][4][2], const Unit& u, int wr, int wc, int fr, int fq) const {
        f32x4 s = {0.f, 0.f, 0.f, 0.f};
#pragma unroll
        for (int ai = 0; ai < 2; ++ai)
#pragma unroll
            for (int bj = 0; bj < 2; ++bj)
#pragma unroll
                for (int m = 0; m < 4; ++m)
#pragma unroll
                    for (int n = 0; n < 2; ++n) s += acc[ai][bj][m][n];
        if (u.pm == 100000) *(f32x4*)(sink + fr) = s;
    }
};
struct EpiInT {
    static constexpr bool PERM = true;
    bf16* UT; const float* ssq; int np; const float* bias;
    __device__ __forceinline__ void operator()(const f32x4 (&acc)[2][2][4][2], const Unit& u, int wr, int wc, int fr, int fq) const {
        const int b = (u.pm * 256) / SEQ;
        const int col0 = u.pn * 256 + wc * 32 + 8 * fq;
        const int odd = fr & 1;
        f32x4 bv[2][2];
#pragma unroll
        for (int bj = 0; bj < 2; ++bj)
#pragma unroll
            for (int n = 0; n < 2; ++n) bv[bj][n] = *(const f32x4*)(bias + (size_t)b * 3072 + col0 + 128 * bj + 4 * n);
#pragma unroll
        for (int ai = 0; ai < 2; ++ai)
#pragma unroll
            for (int m = 0; m < 4; ++m) {
                const int row = u.pm * 256 + ai * 128 + wr * 64 + m * 16 + fr;
                const int t = row - b * SEQ;
                const float rs = row_rs(ssq, np, row);
#pragma unroll
                for (int bj = 0; bj < 2; ++bj)
#pragma unroll
                    for (int n = 0; n < 2; ++n) { const f32x4 v = acc[ai][bj][m][n] * rs + bv[bj][n];
                        const unsigned w01 = pk2(v.x, v.y), w23 = pk2(v.z, v.w);
                        const unsigned p01 = (unsigned)__shfl_xor((int)w01, 1), p23 = (unsigned)__shfl_xor((int)w23, 1);
                        const unsigned o0 = odd ? ((w01 & 0xffff0000u) | (p01 >> 16)) : ((p01 << 16) | (w01 & 0xffffu));
                        const unsigned o1 = odd ? ((w23 & 0xffff0000u) | (p23 >> 16)) : ((p23 << 16) | (w23 & 0xffffu));
                        bf16* p = UT + ((size_t)b * 3072 + col0 + 128 * bj + 4 * n + odd) * SEQ + (t & ~1);
                        *(unsigned*)p = o0; *(unsigned*)(p + 2 * (size_t)SEQ) = o1; }
            }
    }
};

struct EpiCtxKV {
    static constexpr bool PERM = true;
    EpiQK<1> ek; EpiVT ev;
    __device__ __forceinline__ void operator()(const f32x4 (&acc)[2][2][4][2], const Unit& u, int wr, int wc, int fr, int fq) const {
        if (u.pn < 4) ek(acc, u, wr, wc, fr, fq);
        else { Unit v = u; v.pn = u.pn - 4; ev(acc, v, wr, wc, fr, fq); }
    }
};

typedef short bf16x8 __attribute__((ext_vector_type(8)));
typedef float f32x16 __attribute__((ext_vector_type(16)));
typedef short s16x4 __attribute__((ext_vector_type(4)));
__device__ __forceinline__ unsigned cvtpk(float lo, float hi) { typedef float f2 __attribute__((ext_vector_type(2))); typedef __bf16 b2 __attribute__((ext_vector_type(2)));
    f2 v = {lo, hi}; b2 r = __builtin_convertvector(v, b2); return __builtin_bit_cast(unsigned, r); }
constexpr int BT_OFF = 64, BT_HEAD = 15 * 31;
__device__ __forceinline__ void attn_mfma_phase(Frame& F) {
    const bf16* Q = (const bf16*)(F.ws + WS_Q); const bf16* Kb = (const bf16*)(F.ws + WS_K); const bf16* VT = (const bf16*)(F.ws + WS_V);
    const bf16* Kc = (const bf16*)(F.ws + WS_KC); const bf16* VcT = (const bf16*)(F.ws + WS_VC);
    bf16* O = (bf16*)(F.ws + WS_O);
    const float* rpb = F.in[11];
    constexpr int AL_KC = 15 * 8192, AL_BT = AL_KC + 32768;
    const unsigned char* lk = (const unsigned char*)F.lds;
    float* bt = (float*)(F.lds + AL_BT);
    int th = -1;
    const int lane = F.lane, q = lane & 31, hi = lane >> 5;
    for (int g = F.vcu; g < NB * (GROWS / 8) * NH; g += F.G) {
        const int rg = g & 15, h = (g >> 4) & 15, b = g >> 8;
        const int r = rg * 8 + F.wave;
        const int r0 = min(max(r - WH / 2, 0), GROWS - WH);
        const int U0 = min(max(rg * 8 - WH / 2, 0), GROWS - WH), Ue = min(max(rg * 8 + 7 - WH / 2, 0), GROWS - WH) + WH;
        __syncthreads();
        if (h != th) { for (int e = F.tid; e < BT_HEAD; e += 512) bt[BT_OFF + e] = rpb[h * BT_HEAD + e] * 1.4426950408889634f; th = h; }
        {
            int tv = F.tid; FC_OPAQUE(tv);
            const bf16* ksrc = Kb + ((size_t)(b * NH + h) * (SEQ / 16) + (size_t)U0 * 4) * (8 * 16 * 8) + tv * 8;
            const bf16* csrc = Kc + ((size_t)(b * NH + h) * (CTXL / 16)) * (8 * 16 * 8) + tv * 8;
            const int nrow = Ue - U0;
#pragma unroll 1
            for (int rr0 = 0; rr0 < nrow + 4; rr0 += 4) {
                v4u x[4];
#pragma unroll
                for (int k = 0; k < 4; ++k) { const int rr = rr0 + k; if (rr < nrow + 4) x[k] = (rr < nrow) ? *(const v4u*)(ksrc + (size_t)rr * 4096) : *(const v4u*)(csrc + (size_t)(rr - nrow) * 4096); }
#pragma unroll
                for (int k = 0; k < 4; ++k) { const int rr = rr0 + k; if (rr < nrow + 4) *(v4u*)(F.lds + (rr < nrow ? rr * 8192 : AL_KC + (rr - nrow) * 8192) + tv * 16) = x[k]; }
            }
            asm volatile("" ::: "memory");
        }
        __syncthreads();
        const size_t tok = (size_t)b * SEQ + r * GW + q;
        bf16x8 qf[2][4];
#pragma unroll
        for (int hf = 0; hf < 2; ++hf)
#pragma unroll
            for (int s4 = 0; s4 < 4; ++s4) qf[hf][s4] = *(const bf16x8*)(Q + (tok + 32 * hf) * DM + h * HD + 16 * s4 + 8 * hi);
        const f32x16 zero16 = {0.f, 0.f, 0.f, 0.f, 0.f, 0.f, 0.f, 0.f, 0.f, 0.f, 0.f, 0.f, 0.f, 0.f, 0.f, 0.f};
        f32x16 o[2][2] = {{zero16, zero16}, {zero16, zero16}};
        float lsum[2] = {0.f, 0.f};
#define ATT_LOAD(i, kf, va) do { \
            const bf16* kp_; const bf16* vp_; int sstr_; \
            if ((i) < 16) { const int rp_ = (i) >> 2, cb_ = (i) & 3, krow_ = r0 + 2 * rp_; \
                kp_ = (const bf16*)(lk + (krow_ + (q >> 4) - U0) * 8192 + cb_ * 2048 + hi * 256 + (q & 15) * 16); \
                vp_ = VT + (((size_t)(b * NH + h) * (SEQ / 16) + krow_ * 4 + cb_) * 64 + q) * 16 + 8 * hi; sstr_ = 4 * 64 * 16; } \
            else { const int j_ = (i) - 16; \
                kp_ = (const bf16*)(lk + AL_KC + (2 * j_ + (q >> 4)) * 2048 + hi * 256 + (q & 15) * 16); \
                vp_ = VcT + (((size_t)(b * NH + h) * (CTXL / 16) + 2 * j_) * 64 + q) * 16 + 8 * hi; sstr_ = 64 * 16; } \
            _Pragma("unroll") for (int s4 = 0; s4 < 4; ++s4) kf[s4] = *(const bf16x8*)(kp_ + s4 * (2 * 16 * 8)); \
            _Pragma("unroll") for (int dh = 0; dh < 2; ++dh) _Pragma("unroll") for (int s2 = 0; s2 < 2; ++s2) { const bf16* v_ = vp_ + dh * (32 * 16) + s2 * sstr_; \
                va[dh][s2] = *(const bf16x8*)v_; } } while (0)
#define ATT_HALF(i, kf, va, HF) do { \
            f32x16 sacc = zero16; \
            _Pragma("unroll") for (int s4 = 0; s4 < 4; ++s4) sacc = __builtin_amdgcn_mfma_f32_32x32x16_bf16(kf[s4], qf[HF][s4], sacc, 0, 0, 0); \
            float p[16]; \
            if ((i) < 16) { const int rp_ = (i) >> 2, cb_ = (i) & 3, krow_ = r0 + 2 * rp_; \
                const int c_ = 32 * HF + q, c0_ = min(max(c_ - WW / 2, 0), GW - WW), lo_ = c0_ - c_ + (WW - 1); \
                const int dcb = cb_ * 16 + 4 * hi - c_ + (WW - 1), dcl = dcb - lo_; \
                const float* btp = bt + BT_OFF + (krow_ - r + (WH - 1)) * 31 + dcb; \
                _Pragma("unroll") for (int rr = 0; rr < 16; ++rr) { const int kc = (rr & 3) + 8 * ((rr >> 2) & 1); \
                    const float e_ = __builtin_amdgcn_exp2f(sacc[rr] + btp[(rr >> 3) * 31 + kc]); \
                    p[rr] = ((unsigned)(dcl + kc) < (unsigned)WW) ? e_ : 0.f; lsum[HF] += p[rr]; } } \
            else { _Pragma("unroll") for (int rr = 0; rr < 16; ++rr) { p[rr] = __builtin_amdgcn_exp2f(sacc[rr]); lsum[HF] += p[rr]; } } \
            unsigned pw[8]; \
            _Pragma("unroll") for (int ii = 0; ii < 8; ++ii) pw[ii] = cvtpk(p[2 * ii], p[2 * ii + 1]); \
            _Pragma("unroll") for (int s2 = 0; s2 < 2; ++s2) { \
                const bf16x8 pb = __builtin_bit_cast(bf16x8, (v4u){pw[4 * s2], pw[4 * s2 + 1], pw[4 * s2 + 2], pw[4 * s2 + 3]}); \
                o[HF][0] = __builtin_amdgcn_mfma_f32_32x32x16_bf16(va[0][s2], pb, o[HF][0], 0, 0, 0); \
                o[HF][1] = __builtin_amdgcn_mfma_f32_32x32x16_bf16(va[1][s2], pb, o[HF][1], 0, 0, 0); } } while (0)
#define ATT_COMPUTE(i, kf, va) do { const int cbq_ = ((i) < 16) ? ((i) & 3) : 1; \
            if (cbq_ != 3) ATT_HALF(i, kf, va, 0); \
            if (cbq_ != 0) ATT_HALF(i, kf, va, 1); } while (0)
        bf16x8 kfA[4], kfB[4], vaA[2][2], vaB[2][2];
        ATT_LOAD(0, kfA, vaA);
#pragma unroll 1
        for (int i = 0; i < 24; i += 2) {
            ATT_LOAD(i + 1, kfB, vaB);
            ATT_COMPUTE(i, kfA, vaA);
            { const int i2 = (i + 2 < 24) ? i + 2 : 23; ATT_LOAD(i2, kfA, vaA); }
            ATT_COMPUTE(i + 1, kfB, vaB);
        }
#undef ATT_LOAD
#undef ATT_HALF
#undef ATT_COMPUTE
#pragma unroll
        for (int hf = 0; hf < 2; ++hf) {
            float l = lsum[hf]; l += __shfl_xor(l, 32);
            const float inv = 1.0f / l;
            bf16* op = O + (tok + 32 * hf) * DM + h * HD + 4 * hi;
#pragma unroll
            for (int gq = 0; gq < 4; ++gq) {
                v2u w0; w0.x = pk2(o[hf][0][4 * gq] * inv, o[hf][0][4 * gq + 1] * inv); w0.y = pk2(o[hf][0][4 * gq + 2] * inv, o[hf][0][4 * gq + 3] * inv);
                v2u w1; w1.x = pk2(o[hf][1][4 * gq] * inv, o[hf][1][4 * gq + 1] * inv); w1.y = pk2(o[hf][1][4 * gq + 2] * inv, o[hf][1][4 * gq + 3] * inv);
                *(v2u*)(op + 8 * gq) = w0; *(v2u*)(op + 32 + 8 * gq) = w1;
            }
        }
    }
    __syncthreads();
}

__device__ __forceinline__ void convglu_phase(Frame& F, const float* cw, const float* cb) {
    bf16* ag = (bf16*)(F.ws + WS_AG);
    const long nvec = (long)TT * (FF / 8);
    for (long e = (long)F.vcu * 512 + F.tid; e < nvec; e += (long)F.G * 512) {
        const int t = (int)(e / (FF / 8)), j0 = (int)(e % (FF / 8)) * 8;
        const int tl = t % SEQ;
        const bf16* rowp = ag + (size_t)t * (2 * FF);
        const v4u a = *(const v4u*)(rowp + j0);
        const v4u g0 = *(const v4u*)(rowp + FF + j0);
        v4u gm = (v4u){0u, 0u, 0u, 0u}, gp = (v4u){0u, 0u, 0u, 0u};
        if (tl > 0) gm = *(const v4u*)(rowp - 2 * FF + FF + j0);
        if (tl < SEQ - 1) gp = *(const v4u*)(rowp + 2 * FF + FF + j0);
        float av[8], g0v[8], gmv[8], gpv[8];
        av[0] = bflo(a.x); av[1] = bfhi(a.x); av[2] = bflo(a.y); av[3] = bfhi(a.y); av[4] = bflo(a.z); av[5] = bfhi(a.z); av[6] = bflo(a.w); av[7] = bfhi(a.w);
        g0v[0] = bflo(g0.x); g0v[1] = bfhi(g0.x); g0v[2] = bflo(g0.y); g0v[3] = bfhi(g0.y); g0v[4] = bflo(g0.z); g0v[5] = bfhi(g0.z); g0v[6] = bflo(g0.w); g0v[7] = bfhi(g0.w);
        gmv[0] = bflo(gm.x); gmv[1] = bfhi(gm.x); gmv[2] = bflo(gm.y); gmv[3] = bfhi(gm.y); gmv[4] = bflo(gm.z); gmv[5] = bfhi(gm.z); gmv[6] = bflo(gm.w); gmv[7] = bfhi(gm.w);
        gpv[0] = bflo(gp.x); gpv[1] = bfhi(gp.x); gpv[2] = bflo(gp.y); gpv[3] = bfhi(gp.y); gpv[4] = bflo(gp.z); gpv[5] = bfhi(gp.z); gpv[6] = bflo(gp.w); gpv[7] = bfhi(gp.w);
        float r[8];
#pragma unroll
        for (int i = 0; i < 8; ++i) { const int j = j0 + i; const float cv = cw[j] * gmv[i] + cw[FF + j] * g0v[i] + cw[2 * FF + j] * gpv[i] + cb[j]; r[i] = av[i] * gelu_f(cv); }
        v4u w; w.x = pk2(r[0], r[1]); w.y = pk2(r[2], r[3]); w.z = pk2(r[4], r[5]); w.w = pk2(r[6], r[7]);
        *(v4u*)(ag + (size_t)t * (2 * FF) + j0) = w;
    }
}

__device__ __forceinline__ void filtgen_phase(Frame& F) {
    const float* const* in = F.in;
    const float *w1 = in[25], *b1 = in[26], *w2 = in[27], *b2 = in[28], *w3 = in[29], *b3 = in[30], *wout = in[31], *freq = in[32];
    float* hT = (float*)(F.ws + WS_HT); float* fsqp = (float*)(F.ws + WS_FSQP);
    LAS float* zf = (LAS float*)(F.lds);
    LAS float* ha = zf + 32 * 36;
    LAS float* hb = ha + 32 * 64;
    const int tid = F.tid;
    for (int item = F.vcu; item < SEQ / 32; item += F.G) {
        const int l0 = item * 32;
        const float bj1 = b1[tid & 63], bj2 = b2[tid & 63], bj3 = b3[tid & 63], fj = freq[tid & 63];
        __syncthreads();
        for (int e = tid; e < 32 * 33; e += 512) {
            const int p = e / 33, i = e % 33, l = l0 + p;
            float v;
            if (i == 0) v = (float)l / 8191.0f;
            else { const int bi = (i - 1) & 15; const float band = 1e-4f + (float)bi * ((15.0f - 1e-4f) / 15.0f);
                const float w = (float)(2.0 * 3.14159265358979323846 / 8192.0) * (float)l; const float arg = band * w;
                v = (i <= 16) ? cosf(arg) : -sinf(arg); }
            zf[p * 36 + i] = v;
        }
        __syncthreads();
        { const int j = tid & 63, p = tid >> 6; float a[4] = {bj1, bj1, bj1, bj1};
#pragma unroll 11
          for (int i = 0; i < 33; ++i) { const float w = w1[i * 64 + j];
#pragma unroll
            for (int k = 0; k < 4; ++k) a[k] += zf[(p + 8 * k) * 36 + i] * w; }
#pragma unroll
          for (int k = 0; k < 4; ++k) ha[(p + 8 * k) * 64 + j] = sinf(fj * a[k]); }
        __syncthreads();
        { const int j = tid & 63, p = tid >> 6; float a[4] = {bj2, bj2, bj2, bj2};
#pragma unroll 16
          for (int i = 0; i < 64; ++i) { const float w = w2[i * 64 + j];
#pragma unroll
            for (int k = 0; k < 4; ++k) a[k] += ha[(p + 8 * k) * 64 + i] * w; }
#pragma unroll
          for (int k = 0; k < 4; ++k) hb[(p + 8 * k) * 64 + j] = sinf(fj * a[k]); }
        __syncthreads();
        { const int j = tid & 63, p = tid >> 6; float a[4] = {bj3, bj3, bj3, bj3};
#pragma unroll 16
          for (int i = 0; i < 64; ++i) { const float w = w3[i * 64 + j];
#pragma unroll
            for (int k = 0; k < 4; ++k) a[k] += hb[(p + 8 * k) * 64 + i] * w; }
#pragma unroll
          for (int k = 0; k < 4; ++k) ha[(p + 8 * k) * 64 + j] = sinf(fj * a[k]); }
        __syncthreads();
        {
            const int lane = F.lane, li = lane & 15, lk = lane >> 4;
            float av[2][16];
#pragma unroll
            for (int mt = 0; mt < 2; ++mt)
#pragma unroll
                for (int st = 0; st < 16; ++st) av[mt][st] = ha[(16 * mt + li) * 64 + 4 * st + lk];
            const float la = -15.350567286626973f, lb = -3.0701134573253946f;
#pragma unroll 2
            for (int nt = 0; nt < 16; ++nt) {
                const int n = F.wave * 256 + nt * 16 + li;
                const float* wp = wout + (size_t)lk * 2048 + n;
                f32x4 acc0 = {0.f, 0.f, 0.f, 0.f}, acc1 = acc0;
#pragma unroll
                for (int st = 0; st < 16; ++st) { const float bvv = wp[(size_t)st * 4 * 2048];
                    acc0 = __builtin_amdgcn_mfma_f32_16x16x4f32(av[0][st], bvv, acc0, 0, 0, 0); acc1 = __builtin_amdgcn_mfma_f32_16x16x4f32(av[1][st], bvv, acc1, 0, 0, 0); }
                const int dir = n >> 10, c = n & 1023;
                const float delta = fabsf(la + (float)c * ((lb - la) / 1023.0f)) * 1.4426950408889634f;
                float sq = 0.f;
#pragma unroll
                for (int mt = 0; mt < 2; ++mt) { f32x4 ov; const f32x4 acc = mt ? acc1 : acc0;
#pragma unroll
                    for (int r = 0; r < 4; ++r) { const float tpos = (float)(l0 + 16 * mt + 4 * lk + r) / 8191.0f; const float v = acc[r] * __builtin_amdgcn_exp2f(-tpos * delta); ov[r] = v; sq += v * v; }
                    *(f32x4*)(hT + ((size_t)dir * 1024 + c) * SEQ + l0 + 16 * mt + 4 * lk) = ov; }
                sq += __shfl_xor(sq, 16); sq += __shfl_xor(sq, 32);
                if (lk == 0) fsqp[(size_t)item * 2048 + n] = sq;
            }
        }
    }
    __syncthreads();
}

constexpr int F2_AO = 67584, F2_TW = 135168, F2_RED = 140 * 1024, F2_PF = 144 * 1024, F2_TN = 146 * 1024;
__device__ __forceinline__ void f2_load_tw(Frame& F, const cf* TWM, const cf* TWN) {
    cf* tw1 = (cf*)(F.lds + F2_TW);
    for (int e = F.tid; e < 544; e += 512) tw1[e] = e < 512 ? TWM[e] : TWM[16 * (e - 512)];
    ((cf*)(F.lds + F2_TN))[F.tid] = TWN[F.tid];
    __syncthreads();
}
__device__ __forceinline__ cf tn_pow(cf base, int r) {
    const float c[16] = {1.0f, 0.98078528040323043f, 0.92387953251128674f, 0.83146961230254524f, 0.70710678118654752f, 0.55557023301960218f, 0.38268343236508977f, 0.19509032201612825f,
                         0.0f, -0.19509032201612825f, -0.38268343236508977f, -0.55557023301960218f, -0.70710678118654752f, -0.83146961230254524f, -0.92387953251128674f, -0.98078528040323043f};
    const float sn[16] = {0.0f, 0.19509032201612825f, 0.38268343236508977f, 0.55557023301960218f, 0.70710678118654752f, 0.83146961230254524f, 0.92387953251128674f, 0.98078528040323043f,
                          1.0f, 0.98078528040323043f, 0.92387953251128674f, 0.83146961230254524f, 0.70710678118654752f, 0.55557023301960218f, 0.38268343236508977f, 0.19509032201612825f};
    if (r == 0) return base;
    if (r == 8) return cmulnegi(base);
    cf w; w.x = c[r]; w.y = -sn[r]; return cmul(base, w);
}
__device__ __forceinline__ void filtfft_phase(Frame& F) {
    const float* hT = (const float*)(F.ws + WS_HT); const float* fsqp = (const float*)(F.ws + WS_FSQP);
    const cf* TWM = (const cf*)(F.ws + SM_TWM); const cf* TWN = (const cf*)(F.ws + SM_TWN);
    cf* Fsp = (cf*)(F.ws + WS_F);
    cf* aE = (cf*)F.lds; cf* aO = (cf*)(F.lds + F2_AO);
    const cf* tw1 = (const cf*)(F.lds + F2_TW); const cf* tw32 = tw1 + 512;
    float* red = (float*)(F.lds + F2_RED);
    f2_load_tw(F, TWM, TWN);
    for (int c = F.vcu; c < DM; c += F.G) {
        int tid = F.tid; FC_OPAQUE(tid);
        __syncthreads();
        red[tid] = (tid < SEQ / 32) ? fsqp[(size_t)tid * 2048 + c] + fsqp[(size_t)tid * 2048 + 1024 + c] : 0.f;
        __syncthreads();
        for (int st = 256; st > 0; st >>= 1) { if (tid < st) red[tid] += red[tid + st]; __syncthreads(); }
        const float nrm = 1.0f / sqrtf(red[0] + EPS);
        const float* hf = hT + (size_t)c * SEQ; const float* hb = hT + ((size_t)1024 + c) * SEQ;
        if (c + F.G < DM) { const float* pr = hT + ((size_t)(tid >> 8) * 1024 + c + F.G) * SEQ + (size_t)(tid & 255) * 32;
            __builtin_amdgcn_global_load_lds((const unsigned*)pr, (LAS unsigned*)(F.lds + F2_PF + F.wave * 256), 4, 0, 0); }
        {
            cf v[16], w[16];
            const cf tnb = ((const cf*)(F.lds + F2_TN))[tid];
#pragma unroll
            for (int r = 0; r < 16; ++r) { const int n = tid + 512 * r; const float hbv = hb[SEQ - max(n, 1)];
                const float fa = hf[n] * nrm, fb = (n == 0) ? 0.f : hbv * nrm;
                v[r].x = fa + fb; v[r].y = 0.f; const cf tnr = tn_pow(tnb, r); w[r].x = (fa - fb) * tnr.x; w[r].y = (fa - fb) * tnr.y; }
            f2_fwd_p1(v, tid, aE, tw1);
            f2_fwd_p1(w, tid, aO, tw1);
        }
        __syncthreads();
        f2_fwd_p2_dual(tid, aE, aO, tw32);
        __syncthreads();
        { const int path = tid >> 8, bf = tid & 255;
          f2_mid_store16(bf, path ? aO : aE, (v2u*)Fsp + ((size_t)c * 2 + path) * (FC_M / 2)); }
    }
    __syncthreads();
}

__device__ __forceinline__ void conv3_8(const v4u raw, float prev, float next, float w0, float w1, float w2, float bb, float* out) {
    float x[10]; x[0] = prev; x[9] = next;
    x[1] = bflo(raw.x); x[2] = bfhi(raw.x); x[3] = bflo(raw.y); x[4] = bfhi(raw.y); x[5] = bflo(raw.z); x[6] = bfhi(raw.z); x[7] = bflo(raw.w); x[8] = bfhi(raw.w);
#pragma unroll
    for (int i = 0; i < 8; ++i) out[i] = w0 * x[i] + w1 * x[i + 1] + w2 * x[i + 2] + bb;
}
#ifdef PROBE_SEC
#define SEC_MARK(k) do { const unsigned long long t_ = __builtin_amdgcn_s_memrealtime(); if ((k) > 0 && (k) - 1 == PROBE_SEC) F.sec += t_ - sec_t0; sec_t0 = t_; } while (0)
#else
#define SEC_MARK(k) do { } while (0)
#endif
__device__ __forceinline__ void hyena_fft_phase(Frame& F) {
#ifdef PROBE_SEC
    unsigned long long sec_t0 = 0;
#endif
    const float* const* in = F.in;
    const float* sw = in[23]; const float* sb = in[24]; const float* dbias = in[33];
    const bf16* UT = (const bf16*)(F.ws + WS_UT);
    const cf* TWM = (const cf*)(F.ws + SM_TWM); const cf* TWN = (const cf*)(F.ws + SM_TWN);
    const cf* Fsp = (const cf*)(F.ws + WS_F);
    cf* aE = (cf*)F.lds; cf* aO = (cf*)(F.lds + F2_AO);
    const cf* tw1 = (const cf*)(F.lds + F2_TW); const cf* tw32 = tw1 + 512;
    f2_load_tw(F, TWM, TWN);
    for (int unit = F.vcu; unit < 2 * DM; unit += F.G) {
        const int c = unit >> 1, b0 = (unit & 1) * 2;
        int tid = F.tid; FC_OPAQUE(tid);
        SEC_MARK(0);
        __syncthreads();
        {
            const float w10 = sw[1024 + c], w11 = sw[3072 + 1024 + c], w12 = sw[6144 + 1024 + c], bb1 = sb[1024 + c];
            const float wv0 = sw[2048 + c], wv1 = sw[3072 + 2048 + c], wv2 = sw[6144 + 2048 + c], bbv = sb[2048 + c];
            v4u x1raw[2][2], vraw[2][2]; unsigned short hh[2][2][4];
            FC_OPAQUE(tid);
#pragma unroll
            for (int h = 0; h < 2; ++h) {
                const int t0 = (tid + 512 * h) * 8;
                const int ipv = max(t0 - 1, 0), inx = min(t0 + 8, SEQ - 1);
#pragma unroll
                for (int bb = 0; bb < 2; ++bb) {
                    const bf16* x1r = UT + ((size_t)(b0 + bb) * 3072 + 1024 + c) * SEQ;
                    const bf16* vr = UT + ((size_t)(b0 + bb) * 3072 + 2048 + c) * SEQ;
                    x1raw[h][bb] = *(const v4u*)(x1r + t0); vraw[h][bb] = *(const v4u*)(vr + t0);
                    hh[h][bb][0] = x1r[ipv]; hh[h][bb][1] = x1r[inx]; hh[h][bb][2] = vr[ipv]; hh[h][bb][3] = vr[inx];
                }
            }
#pragma unroll
            for (int h = 0; h < 2; ++h) {
                const int t0 = (tid + 512 * h) * 8;
                float z[2][8];
#pragma unroll
                for (int bb = 0; bb < 2; ++bb) {
                    const float x1p = t0 > 0 ? bf2f(hh[h][bb][0]) : 0.f, x1n = t0 + 8 < SEQ ? bf2f(hh[h][bb][1]) : 0.f;
                    const float vp = t0 > 0 ? bf2f(hh[h][bb][2]) : 0.f, vn = t0 + 8 < SEQ ? bf2f(hh[h][bb][3]) : 0.f;
                    float x1c[8], vc[8];
                    conv3_8(x1raw[h][bb], x1p, x1n, w10, w11, w12, bb1, x1c);
                    conv3_8(vraw[h][bb], vp, vn, wv0, wv1, wv2, bbv, vc);
#pragma unroll
                    for (int i = 0; i < 8; ++i) z[bb][i] = x1c[i] * vc[i];
                }
                const int pb = F2_PIDX(t0);
#pragma unroll
                for (int i = 0; i < 8; ++i) { cf t; t.x = z[0][i]; t.y = z[1][i]; aE[pb + i] = t; }
            }
        }
        __syncthreads();
        SEC_MARK(1);
        cf wreg[16];
        FC_OPAQUE(tid);
        { const int pt = F2_PIDX(tid);
#pragma unroll
          for (int r = 0; r < 16; ++r) wreg[r] = aE[pt + 528 * r]; }
        const int path = tid >> 8, bf = tid & 255;
        const cf tnb = ((const cf*)(F.lds + F2_TN))[tid];
        cf tn[16];
#pragma unroll
        for (int r = 0; r < 16; ++r) tn[r] = tn_pow(tnb, r);
        {
            cf v[16];
#pragma unroll
            for (int r = 0; r < 16; ++r) v[r] = cmul(wreg[r], tn[r]);
            f2_fwd_p1(v, tid, aO, tw1);
            FC_OPAQUE(tid);
#pragma unroll
            for (int r = 0; r < 16; ++r) v[r] = wreg[r];
            f2_fwd_p1(v, tid, aE, tw1);
        }
        __syncthreads();
        SEC_MARK(2);
        f2_fwd_p2_dual(tid, aE, aO, tw32);
        __syncthreads();
        SEC_MARK(3);
        v2u freg[16];
        { const v2u* fp = (const v2u*)Fsp + ((size_t)c * 2 + path) * (FC_M / 2) + bf;
#pragma unroll
          for (int i = 0; i < 16; ++i) freg[i] = fp[i * 256]; }
        f2_mid16(bf, path ? aO : aE, freg);
        __syncthreads();
        SEC_MARK(4);
        if (tid < 256) { const bf16* pr = UT + ((size_t)(b0 + (tid >> 7)) * 3072 + c) * SEQ + (size_t)(tid & 127) * 64;
            __builtin_amdgcn_global_load_lds((const unsigned*)pr, (LAS unsigned*)(F.lds + F2_PF + F.wave * 256), 4, 0, 0); }
        if (unit + F.G < 2 * DM) { const int nu = unit + F.G, nc = nu >> 1, nb = (nu & 1) * 2 + (tid >> 8), wh = 1 + ((tid >> 7) & 1);
            const bf16* pr = UT + ((size_t)nb * 3072 + wh * 1024 + nc) * SEQ + (size_t)(tid & 127) * 64;
            __builtin_amdgcn_global_load_lds((const unsigned*)pr, (LAS unsigned*)(F.lds + F2_PF + F.wave * 256), 4, 0, 0); }
        f2_inv_p2_dual(tid, aE, aO, tw32);
        __syncthreads();
        SEC_MARK(5);
        {
            cf ve[16], vo[16];
            f2_inv_p1(ve, tid, aE, tw1);
            f2_inv_p1(vo, tid, aO, tw1);
            const float db = dbias[c];
            FC_OPAQUE(tid);
            const int pt = F2_PIDX(tid);
            const cf tnb2 = ((const cf*)(F.lds + F2_TN))[tid];
#pragma unroll
            for (int r = 0; r < 16; ++r) { const int n = tid + 512 * r;
                const cf y = cadd(cconj(ve[r]), cmul(cconj(tn_pow(tnb2, r)), cconj(vo[r])));
                cf o; o.x = y.x * (1.0f / 16384.0f) + wreg[r].x * db; o.y = y.y * (1.0f / 16384.0f) + wreg[r].y * db; aE[pt + 528 * r] = o; }
        }
        __syncthreads();
        SEC_MARK(6);
        {
            const float w00 = sw[c], w01 = sw[3072 + c], w02 = sw[6144 + c], bb0 = sb[c];
            v4u xraw[2][2]; unsigned short hx[2][2][2];
            FC_OPAQUE(tid);
#pragma unroll
            for (int h = 0; h < 2; ++h) {
                const int t0 = (tid + 512 * h) * 8;
#pragma unroll
                for (int bb = 0; bb < 2; ++bb) { const bf16* x0r = UT + ((size_t)(b0 + bb) * 3072 + c) * SEQ;
                    xraw[h][bb] = *(const v4u*)(x0r + t0); hx[h][bb][0] = x0r[max(t0 - 1, 0)]; hx[h][bb][1] = x0r[min(t0 + 8, SEQ - 1)]; }
            }
#pragma unroll
            for (int h = 0; h < 2; ++h) {
                const int t0 = (tid + 512 * h) * 8;
                cf val[8];
                const int pb = F2_PIDX(t0);
#pragma unroll
                for (int i = 0; i < 8; ++i) val[i] = aE[pb + i];
#pragma unroll
                for (int bb = 0; bb < 2; ++bb) {
                    const float xp = t0 > 0 ? bf2f(hx[h][bb][0]) : 0.f, xn = t0 + 8 < SEQ ? bf2f(hx[h][bb][1]) : 0.f;
                    float x0c[8]; conv3_8(xraw[h][bb], xp, xn, w00, w01, w02, bb0, x0c);
                    float p[8];
#pragma unroll
                    for (int i = 0; i < 8; ++i) p[i] = x0c[i] * (bb == 0 ? val[i].x : val[i].y);
                    v4u o; o.x = pk2(p[0], p[1]); o.y = pk2(p[2], p[3]); o.z = pk2(p[4], p[5]); o.w = pk2(p[6], p[7]);
                    *(v4u*)((bf16*)(F.ws + WS_XS) + ((size_t)(b0 + bb) * 1024 + c) * SEQ + t0) = o;
                }
            }
        }
        SEC_MARK(7);
    }
    __syncthreads();
}
__device__ __forceinline__ void transpose_p_phase(Frame& F) {
    const bf16* PT = (const bf16*)(F.ws + WS_XS); bf16* P = (bf16*)(F.ws + WS_P);
    LAS unsigned short* scr = (LAS unsigned short*)(F.lds + F.wave * 16384);
    const int gw = F.vcu * NWAVES + F.wave, NGW = F.G * NWAVES, lane = F.lane;
    const int ntile = NB * (DM / 64) * (SEQ / 64);
    const int l8 = lane >> 3, ch = (lane & 7) * 8;
    for (int it = gw; it < ntile; it += NGW) {
        const int tb = it % (SEQ / 64), cb = (it / (SEQ / 64)) % (DM / 64), b = it / ((SEQ / 64) * (DM / 64));
        v4u x[8];
#pragma unroll
        for (int k = 0; k < 8; ++k) x[k] = *(const v4u*)(PT + ((size_t)b * 1024 + cb * 64 + 8 * k + l8) * SEQ + tb * 64 + ch);
#pragma unroll
        for (int k = 0; k < 8; ++k) { LAS unsigned* d = (LAS unsigned*)(scr + (8 * k + l8) * 66 + ch); d[0] = x[k].x; d[1] = x[k].y; d[2] = x[k].z; d[3] = x[k].w; }
        LDS_WAIT(); asm volatile("" ::: "memory");
#pragma unroll
        for (int k = 0; k < 8; ++k) { const int t = 8 * k + l8; const LAS unsigned short* sp = scr + ch * 66 + t;
            v4u o; o.x = sp[0] | ((unsigned)sp[66] << 16); o.y = sp[2 * 66] | ((unsigned)sp[3 * 66] << 16); o.z = sp[4 * 66] | ((unsigned)sp[5 * 66] << 16); o.w = sp[6 * 66] | ((unsigned)sp[7 * 66] << 16);
            *(v4u*)(P + ((size_t)b * SEQ + tb * 64 + t) * DM + cb * 64 + ch) = o; }
        LDS_WAIT(); asm volatile("" ::: "memory");
    }
}

constexpr int NPH = 13;
__global__ void __launch_bounds__(NWAVES * 64, 2) hybrid_fwd(Args args) {
    extern __shared__ __attribute__((aligned(16))) unsigned char lds[];
    Frame F;
    F.lds = (LAS unsigned char*)lds;
    F.tid = threadIdx.x; F.lane = F.tid & 63; F.wave = __builtin_amdgcn_readfirstlane(F.tid >> 6);
    F.G = gridDim.x; { const int bx = blockIdx.x; F.vcu = (F.G % 8 == 0) ? (bx % 8) * (F.G / 8) + bx / 8 : bx; }
    F.in = args.in; F.out = args.out; F.ws = args.ws;
#ifdef PROBE_SEC
    F.sec = 0;
#endif
    unsigned char* ws = args.ws;
    volatile LAS unsigned* MISC = (volatile LAS unsigned*)(F.lds + MISC_OFF);
    for (int u = F.tid; u < (LDS_BYTES - LDSCTL_OFF) / 4; u += NWAVES * 64) ((LAS unsigned*)(F.lds + LDSCTL_OFF))[u] = 0u;
    __syncthreads();
    XcdBarrier bar; bar.bar = (unsigned*)(ws + CT_BAR) + args.li * XCD_BAR_WORDS; bar.x = 0; bar.st = nullptr;
    const int lo = args.ph_lo, hi = args.ph_hi;
    if (hi - lo > 1) bar = xcd_barrier_post((unsigned*)(ws + CT_BAR) + args.li * XCD_BAR_WORDS, MISC + 8);
#ifndef EXP_PAIR
#define EXP_PAIR 0
#endif
#ifndef REP_MASK
#define REP_MASK 0
#endif
#define REPS(k) ((((REP_MASK) >> (k)) & 1) ? 2 : 1)
#ifndef PH_MASK
#define PH_MASK 0xFFFFFF
#endif
#define IN(k) ((((PH_MASK) >> (k)) & 1) && lo <= (k) && (k) < hi)
#ifdef PROBE_TS
    unsigned long long ts_a = 0, ts_b = 0;
#define TS_MARK(k) do { if (blockIdx.x == 0 && F.tid == 0) { const unsigned long long t_ = __builtin_amdgcn_s_memrealtime(); if ((k) == PROBE_TS) ts_a = t_; if ((k) == PROBE_TS + 1) ts_b = t_; } } while (0)
#else
#define TS_MARK(k) do { } while (0)
#endif
#define SEAM(k) do { if (IN(k) && IN((k) + 1)) xcd_barrier(bar); TS_MARK((k) + 1); } while (0)
    const float* mods = (const float*)(ws + CT_MODS);
    const float* gnt = (const float*)(ws + SM_GN);
    float* ssqa = (float*)(ws + WS_SSQP);
    bf16* XS = (bf16*)(ws + WS_XS);

    TS_MARK(0);
    if (IN(0)) { for (int rep = 0; rep < REPS(0); ++rep) { phase0a(F); filtgen_phase(F); } } SEAM(0);
    if (IN(1)) { for (int rep = 0; rep < REPS(1); ++rep) { phase0b(F); filtfft_phase(F); } } SEAM(1);
    if (IN(2)) for (int rep = 0; rep < REPS(2); ++rep) {
        { pg8::Gemm g{XS, (const bf16*)(ws + WS_WQKV), TT, DM, DM, DM}; pg8::StaticOrder S; S.init(TT, DM, F.G, (int)blockIdx.x);
          EpiQK<0> E{(bf16*)(ws + WS_Q), (const float*)(ws + SM_SSQ0), 1, (const float*)(ws + CT_BQKV), 3072, args.in[9], SEQ};
          pg8::gemm_phase<EpiQK<0>, pg8::StaticOrder, true, true>(F.lds, g, S, E); }
        { pg8::Gemm g{XS, (const bf16*)(ws + WS_WQKV) + (size_t)1024 * DM, TT, DM, DM, DM}; pg8::StaticOrder S; S.init(TT, DM, F.G, (int)blockIdx.x);
          EpiQK<1> E{(bf16*)(ws + WS_K), (const float*)(ws + SM_SSQ0), 1, (const float*)(ws + CT_BQKV), 3072, args.in[10], SEQ};
          pg8::gemm_phase<EpiQK<1>, pg8::StaticOrder, true, true>(F.lds, g, S, E); }
        { pg8::Gemm g{XS, (const bf16*)(ws + WS_WQKV) + (size_t)2048 * DM, TT, DM, DM, DM}; pg8::StaticOrder S; S.init(TT, DM, F.G, (int)blockIdx.x);
          EpiVT E{(bf16*)(ws + WS_V), (const float*)(ws + SM_SSQ0), 1, (const float*)(ws + CT_BQKV), 3072, SEQ};
          pg8::gemm_phase<EpiVT, pg8::StaticOrder, true, true>(F.lds, g, S, E); }
        { pg8::Gemm g{(const bf16*)(ws + WS_XSC), (const bf16*)(ws + WS_WQKV) + (size_t)1024 * DM, TC, 2 * DM, DM, DM}; pg8::StaticOrder S; S.init(TC, 2 * DM, F.G, (int)blockIdx.x);
          EpiCtxKV E{ EpiQK<1>{(bf16*)(ws + WS_KC), (const float*)(ws + SM_SSQC), 1, (const float*)(ws + CT_BQKV) + 4 * 3072, 0, args.in[10], CTXL},
                      EpiVT{(bf16*)(ws + WS_VC), (const float*)(ws + SM_SSQC), 1, (const float*)(ws + CT_BQKV) + 4 * 3072, 0, CTXL} };
          pg8::gemm_phase<EpiCtxKV, pg8::StaticOrder, true, true>(F.lds, g, S, E); }
        { const int nct = (TC / 256) * (2 * DM / 256); const int idle = (int)F.G - nct;
          if (idle >= 184) { if ((int)blockIdx.x >= nct) bias_gemv_late(F, (int)blockIdx.x - nct); }
          else for (int it = (int)blockIdx.x; it < 184; it += (int)F.G) bias_gemv_late(F, it); }
    } SEAM(2);
    if (IN(3)) { for (int rep = 0; rep < REPS(3); ++rep) attn_mfma_phase(F); } SEAM(3);
    if (IN(4)) for (int rep = 0; rep < REPS(4); ++rep) {
        pg8::Gemm g{(const bf16*)(ws + WS_O), (const bf16*)(ws + WS_WO), TT, DM, DM, DM}; pg8::StaticOrder S; S.init(TT, DM, F.G, (int)blockIdx.x);
        EpiRes<true, false> E{args.in[0], ws + WS_XB, mods + 2048, nullptr, gnt, XS, ssqa, (float*)(lds + RING_BYTES + 8192)};
        pg8::gemm_phase<EpiRes<true, false>, pg8::StaticOrder, true, true>(F.lds, g, S, E);
    } SEAM(4);
    if (IN(5)) for (int rep = 0; rep < REPS(5); ++rep) {
        pg8::Gemm g{XS, (const bf16*)(ws + WS_WUP0), TT, 2 * FF, DM, DM}; pg8::StaticOrder S; S.init(TT, 2 * FF, F.G, (int)blockIdx.x);
        EpiUpGlu E{(bf16*)(ws + WS_AG), ssqa, 4, (const float*)(ws + CT_BUP0), args.in[14], args.in[15], (float*)(ws + WS_HG), (float*)(ws + WS_HA), (float*)(lds + RING_BYTES)};
        pg8::gemm_phase<EpiUpGlu, pg8::StaticOrder, true, true>(F.lds, g, S, E);
    } SEAM(5);

    if (IN(6)) {
        { pg8::StaticOrder S0; S0.init(TT, DM, F.G, (int)blockIdx.x); pg8::Unit fu;
#pragma unroll 1
          for (int i = 0; S0.next(i, fu); ++i) glu_fix_tile(F, fu.pm, args.in[14], args.in[15]);
          VM_WAIT(); __syncthreads(); asm volatile("" ::: "memory"); }
        pg8::Gemm g{(const bf16*)(ws + WS_AG), (const bf16*)(ws + WS_WDN0), TT, DM, FF, FF}; pg8::StaticOrder S; S.init(TT, DM, F.G, (int)blockIdx.x);
        EpiRes<false, false> E{ws + WS_XB, ws + WS_XB, mods + 5120, nullptr, gnt + 4096, XS, ssqa + 4 * TT, (float*)(lds + RING_BYTES + 8192)};
        pg8::gemm_phase<EpiRes<false, false>, pg8::StaticOrder, true, true>(F.lds, g, S, E);
    } SEAM(6);
    if (IN(7)) for (int rep = 0; rep < REPS(7); ++rep) {
        pg8::Gemm g{XS, (const bf16*)(ws + WS_WIN), TT, 3 * DM, DM, DM}; pg8::StaticOrder S; S.init(TT, 3 * DM, F.G, (int)blockIdx.x);
#ifdef EXP_P9
        EpiScaleBias E{(bf16*)(ws + WS_UT), 3 * DM, ssqa + 4 * TT, 4, (const float*)(ws + CT_BIN), 3072};
        pg8::gemm_phase<EpiScaleBias, pg8::StaticOrder, true, true>(F.lds, g, S, E);
#else
        EpiInT E{(bf16*)(ws + WS_UT), ssqa + 4 * TT, 4, (const float*)(ws + CT_BIN)};
        pg8::gemm_phase<EpiInT, pg8::StaticOrder, true, true>(F.lds, g, S, E);
#endif
    } SEAM(7);
    if (IN(8)) { for (int rep = 0; rep < REPS(8); ++rep) hyena_fft_phase(F); } SEAM(8);

    if (IN(9)) { for (int rep = 0; rep < REPS(9); ++rep) transpose_p_phase(F); } SEAM(9);
    if (IN(10)) {
        pg8::Gemm g{(const bf16*)(ws + WS_P), (const bf16*)(ws + WS_WOUT), TT, DM, DM, DM}; pg8::StaticOrder S; S.init(TT, DM, F.G, (int)blockIdx.x);
        EpiRes<false, false> E{ws + WS_XB, ws + WS_XB, mods + 5 * 6144 + 2048, args.in[35], gnt + 2 * 4096, XS, ssqa + 8 * TT, (float*)(lds + RING_BYTES + 8192)};
        pg8::gemm_phase<EpiRes<false, false>, pg8::StaticOrder, true, true>(F.lds, g, S, E);
    } SEAM(10);
    if (IN(11)) for (int rep = 0; rep < REPS(11); ++rep) {
        pg8::Gemm g{XS, (const bf16*)(ws + WS_WUP1), TT, 2 * FF, DM, DM}; pg8::StaticOrder S; S.init(TT, 2 * FF, F.G, (int)blockIdx.x);
        EpiUpGlu E{(bf16*)(ws + WS_AG), ssqa + 8 * TT, 4, (const float*)(ws + CT_BUP1), args.in[37], args.in[38], (float*)(ws + WS_HG), (float*)(ws + WS_HA), (float*)(lds + RING_BYTES)};
        pg8::gemm_phase<EpiUpGlu, pg8::StaticOrder, true, true>(F.lds, g, S, E);
    } SEAM(11);
    if (IN(12)) {
        { pg8::StaticOrder S0; S0.init(TT, DM, F.G, (int)blockIdx.x); pg8::Unit fu;
#pragma unroll 1
          for (int i = 0; S0.next(i, fu); ++i) glu_fix_tile(F, fu.pm, args.in[37], args.in[38]);
          VM_WAIT(); __syncthreads(); asm volatile("" ::: "memory"); }
        pg8::Gemm g{(const bf16*)(ws + WS_AG), (const bf16*)(ws + WS_WDN1), TT, DM, FF, FF}; pg8::StaticOrder S; S.init(TT, DM, F.G, (int)blockIdx.x);
        EpiRes<false, true> E{ws + WS_XB, args.out, mods + 5 * 6144 + 5120, nullptr, nullptr, nullptr, nullptr, nullptr};
        pg8::gemm_phase<EpiRes<false, true>, pg8::StaticOrder, true, true>(F.lds, g, S, E);
    }
#ifdef PROBE_SEC
    if (blockIdx.x == 0 && F.tid == 0) { asm volatile("s_waitcnt vmcnt(0)" ::: "memory"); args.out[0] = args.out[0] + (float)F.sec * 0.01f; }
#endif
#ifdef PROBE_TS
    TS_MARK(NPH);
    if (blockIdx.x == 0 && F.tid == 0) { asm volatile("s_waitcnt vmcnt(0)" ::: "memory"); args.out[0] = args.out[0] + (float)(ts_b - ts_a) * 0.01f; }
#endif
#ifdef PROBE_NULL
    if (lo == 98) {
#if PROBE_NULL == 5
        pg8::Gemm g{XS, (const bf16*)(ws + WS_WUP0), TT, 2 * FF, DM, DM}; pg8::StaticOrder S; S.init(TT, 2 * FF, F.G, (int)blockIdx.x);
#elif PROBE_NULL == 4
        pg8::Gemm g{(const bf16*)(ws + WS_O), (const bf16*)(ws + WS_WO), TT, DM, DM, DM}; pg8::StaticOrder S; S.init(TT, DM, F.G, (int)blockIdx.x);
#elif PROBE_NULL == 7
        pg8::Gemm g{(const bf16*)(ws + WS_AG), (const bf16*)(ws + WS_WDN0), TT, DM, FF, FF}; pg8::StaticOrder S; S.init(TT, DM, F.G, (int)blockIdx.x);
        { pg8::Unit fu; for (int i = 0; S.next(i, fu); ++i) glu_fix_tile(F, fu.pm, args.in[14], args.in[15]); VM_WAIT(); __syncthreads(); }
#else
        pg8::Gemm g{XS, (const bf16*)(ws + WS_WQKV), TT, 3 * DM, DM, DM}; pg8::StaticOrder S; S.init(TT, 3 * DM, F.G, (int)blockIdx.x);
#endif
        EpiNull E{(float*)(ws + WS_FSQP)};
        pg8::gemm_phase<EpiNull, pg8::StaticOrder, true, true>(F.lds, g, S, E);
    }
#endif
#ifdef DUMP_SEL
    if (lo == 99) {
        float* o = args.out; const size_t n = (size_t)TT * DM;
        for (size_t e = (size_t)blockIdx.x * 512 + F.tid; e < n; e += (size_t)F.G * 512) {
            float v;
            if (DUMP_SEL == 1) { const float* h = (const float*)(ws + WS_HT); v = (e < (size_t)2 * 1024 * SEQ) ? h[e] : ((const float*)(ws + WS_FSQP))[e & 1023]; }
            else if (DUMP_SEL == 2) { const bf16* u = (const bf16*)(ws + WS_UT); v = bf2f(u[e]); }
            else if (DUMP_SEL == 3) { const bf16* u = (const bf16*)(ws + WS_UT); v = bf2f(u[e + (size_t)TT * DM]); }
            else if (DUMP_SEL == 4) { const bf16* u = (const bf16*)(ws + WS_UT); v = bf2f(u[e + (size_t)2 * TT * DM]); }
            else { const bf16* u = (const bf16*)(ws + WS_P); v = bf2f(u[e]); }
            o[e] = v;
        }
    }
#endif
#undef IN
#undef SEAM
}

extern "C" void kernel_launch(void* const* d_in, const int* in_sizes, int n_in, void* d_out, int out_size, void* d_ws, size_t ws_size, hipStream_t stream) {
    static int grid = 0;
    if (grid == 0) {
        if (n_in != 40 || out_size != TT * DM || ws_size < WS_END) { fprintf(stderr, "kernel_launch: unexpected shapes n_in %d out %d ws %zu\n", n_in, out_size, ws_size); grid = -1; return; }
        int dev = 0, cus = 0;
        if (hipGetDevice(&dev) != hipSuccess || hipDeviceGetAttribute(&cus, hipDeviceAttributeMultiprocessorCount, dev) != hipSuccess) { grid = -1; return; }
        if (hipFuncSetAttribute((const void*)hybrid_fwd, hipFuncAttributeMaxDynamicSharedMemorySize, LDS_BYTES) != hipSuccess) { fprintf(stderr, "kernel_launch: hipFuncSetAttribute failed\n"); grid = -1; return; }
        int per_cu = 0;
        if (hipOccupancyMaxActiveBlocksPerMultiprocessor(&per_cu, (const void*)hybrid_fwd, NWAVES * 64, LDS_BYTES) != hipSuccess || per_cu < 1) { fprintf(stderr, "kernel_launch: occupancy query says %d\n", per_cu); }
        (void)hipGetLastError();
        grid = cus;
    }
    if (grid < 0) return;
    (void)hipMemsetAsync((char*)d_ws + WS_CTL, 0, CTL_ZERO_BYTES, stream);
    Args a{};
    for (int i = 0; i < 40; ++i) a.in[i] = (const float*)d_in[i];
    a.out = (float*)d_out; a.ws = (unsigned char*)d_ws; a.repmask = REP_MASK;
#if defined(PROBE_NULL)
    {   const int k = PROBE_NULL; const int lo[3] = {0, 98, k}, hi[3] = {k, 99, NPH};
        for (int i = 0; i < 3; ++i) { a.ph_lo = lo[i]; a.ph_hi = hi[i]; a.li = i;
            hipLaunchKernelGGL(hybrid_fwd, dim3(grid), dim3(NWAVES * 64), LDS_BYTES, stream, a); } }
#elif defined(PROBE_PHASE)
    {   const int k = PROBE_PHASE; const int lo[4] = {0, k, k, k + 1}, hi[4] = {k, k + 1, k + 1, NPH};
        for (int i = 0; i < 4; ++i) { if (lo[i] >= hi[i]) continue; a.ph_lo = lo[i]; a.ph_hi = hi[i]; a.li = i;
            hipLaunchKernelGGL(hybrid_fwd, dim3(grid), dim3(NWAVES * 64), LDS_BYTES, stream, a); } }
#elif MK_ONE_LAUNCH
    a.ph_lo = 0; a.ph_hi = NPH;
    hipLaunchKernelGGL(hybrid_fwd, dim3(grid), dim3(NWAVES * 64), LDS_BYTES, stream, a);
#else
    for (int p = 0; p < PH_END; ++p) { a.ph_lo = p; a.ph_hi = p + 1; hipLaunchKernelGGL(hybrid_fwd, dim3(grid), dim3(NWAVES * 64), LDS_BYTES, stream, a); }
#ifdef DUMP_SEL
    a.ph_lo = 99; a.ph_hi = 100; hipLaunchKernelGGL(hybrid_fwd, dim3(grid), dim3(NWAVES * 64), LDS_BYTES, stream, a);
#endif
#endif
}
```

```cpp
#include <hip/hip_runtime.h>
#include <cstdio>
#include <cstdint>

#ifndef PH_END
#define PH_END 13
#endif
#ifndef MK_ONE_LAUNCH
#define MK_ONE_LAUNCH 1
#endif

namespace pg8 {
#define PG8_LAS __attribute__((address_space(3)))
typedef unsigned short bf16_t;
typedef short bf16x8 __attribute__((ext_vector_type(8)));
typedef float f32x4 __attribute__((ext_vector_type(4)));
typedef unsigned u32x4 __attribute__((ext_vector_type(4)));
constexpr int BM = 256, BK = 64, HALF = 128, HTB = HALF * BK * 2, STAGE_BYTES = 8 * HTB, NXCD = 8, WGM = 8;

__host__ __device__ __forceinline__ int lds_byte(int r, int c) { const int st = (r >> 4) * 2 + (c >> 5), rr = r & 15, cc = c & 31, ob = rr * 64 + cc * 2; return st * 1024 + (ob ^ (((ob >> 9) & 1) << 5)); }
__host__ __device__ __forceinline__ void stage_rc(int b, int& R, int& C) { const int st = b / 1024, sb = b % 1024, swz = sb ^ (((sb >> 9) & 1) << 5); R = (st >> 1) * 16 + swz / 64; C = (st & 1) * 32 + (swz % 64) / 2; }
__host__ __device__ __forceinline__ int perm32(int rho) { const int n = rho >> 4, i = rho & 15; return 8 * (i >> 2) + 4 * n + (i & 3); }

struct Unit { int pm, pn; };
struct Gemm { const bf16_t* A; const bf16_t* Bt; int M, N, K, lda; };

struct StaticOrder {
    int nM, nN, nwg, G, c;
    __host__ __device__ __forceinline__ void init(int M, int N, int G_, int c_) { nM = M / BM; nN = N / BM; nwg = nM * nN; G = G_; c = c_; }
    __host__ __device__ __forceinline__ bool next(int i, Unit& u) const {
        const long L = (long)i * G + c; if (L >= nwg) return false;
        int wgid = (int)L; { const int q = nwg / NXCD, r = nwg % NXCD, xcd = wgid % NXCD, off = wgid / NXCD; wgid = (xcd < r ? xcd * (q + 1) : r * (q + 1) + (xcd - r) * q) + off; }
        const int nig = WGM * nN, gid = wgid / nig, fm = gid * WGM, gsz = (nM - fm) < WGM ? (nM - fm) : WGM;
        u.pm = fm + ((wgid % nig) % gsz); u.pn = (wgid % nig) / gsz; return true;
    }
    __device__ __forceinline__ void a_ready(const Unit&) const {}
    __device__ __forceinline__ void done(const Unit&) const {}
};

__device__ __forceinline__ unsigned cvt_pk_bf16(float lo, float hi) { unsigned r; asm volatile("v_cvt_pk_bf16_f32 %0, %1, %2" : "=v"(r) : "v"(lo), "v"(hi)); return r; }

template <class E> __device__ __forceinline__ auto epi_prefetch(const E& e, const Unit& u, int) -> decltype(e.prefetch(u), void()) { e.prefetch(u); }
template <class E> __device__ __forceinline__ void epi_prefetch(const E&, const Unit&, long) {}
template <class Epi, class Sched, bool ALIGN_EPI = false, bool SP2 = false>
__device__ __forceinline__ void gemm_phase(PG8_LAS unsigned char* lds, const Gemm g, const Sched& S, const Epi& E) {
    const int tid = threadIdx.x, wid = __builtin_amdgcn_readfirstlane(tid >> 6), lane = tid & 63, wr = wid >> 2, wc = wid & 3, fr = lane & 15, fq = lane >> 4;
    const int K = g.K, nt = K / BK, lda = g.lda;
    unsigned voffA[2], voffB[2];
#pragma unroll
    for (int i = 0; i < 2; ++i) { int R, C; stage_rc(tid * 16 + i * 8192, R, C); const int Rb = Epi::PERM ? ((R & ~31) + perm32(R & 31)) : R;
        voffA[i] = (unsigned)(R * lda + C) * 2u; voffB[i] = (unsigned)(Rb * K + C) * 2u; }
    const size_t kstep = (size_t)(BK * 2);
    const size_t hstepA = (size_t)HALF * lda * 2, hstepB = (size_t)HALF * K * 2;
    const size_t tstepA = 2 * hstepA, tstepB = 2 * hstepB;
    const unsigned ldsw = (unsigned)wid * 1024u;
    const int aoff = lds_byte(wr * 64 + fr, fq * 8), boff = lds_byte(wc * 32 + fr, fq * 8);
#define PG8_SA(b, h) (((b) * 2 + (h)) * HTB)
#define PG8_SB(b, h) ((4 + (b) * 2 + (h)) * HTB)
#define PG8_STAGE(bufoff, gbase, voff) do { _Pragma("unroll") for (int _i = 0; _i < 2; ++_i) \
        __builtin_amdgcn_global_load_lds((const unsigned*)((const char*)(gbase) + (voff)[_i]), (PG8_LAS unsigned*)(lds + (bufoff) + ldsw + _i * 8192), 16, 0, 0); } while (0)
#define PG8_LDA(dst, b, h) do { _Pragma("unroll") for (int m = 0; m < 4; ++m) _Pragma("unroll") for (int k = 0; k < 2; ++k) dst[m][k] = *(const PG8_LAS bf16x8*)(lds + PG8_SA(b, h) + aoff + m * 2048 + k * 1024); } while (0)
#define PG8_LDB(dst, b, h) do { _Pragma("unroll") for (int n = 0; n < 2; ++n) _Pragma("unroll") for (int k = 0; k < 2; ++k) dst[n][k] = *(const PG8_LAS bf16x8*)(lds + PG8_SB(b, h) + boff + n * 2048 + k * 1024); } while (0)
#define PG8_MMA(ai, bj, At, Bt) do { __builtin_amdgcn_s_setprio(1); _Pragma("unroll") for (int m = 0; m < 4; ++m) _Pragma("unroll") for (int n = 0; n < 2; ++n) _Pragma("unroll") for (int k = 0; k < 2; ++k) \
        acc[ai][bj][m][n] = __builtin_amdgcn_mfma_f32_16x16x32_bf16(Bt[n][k], At[m][k], acc[ai][bj][m][n], 0, 0, 0); __builtin_amdgcn_s_setprio(0); } while (0)
#define PG8_WAIT_V(n) asm volatile("s_waitcnt vmcnt(" #n ")" ::: "memory")
#define PG8_WAIT_L(n) asm volatile("s_waitcnt lgkmcnt(" #n ")" ::: "memory")
#define PG8_BAR __builtin_amdgcn_s_barrier()
#define PG8_SCHED __builtin_amdgcn_sched_barrier(0)
    Unit cur, nxt; int ui = 0;
    if (!S.next(0, cur)) return;
    f32x4 acc[2][2][4][2];
#pragma unroll
    for (int a = 0; a < 2; ++a)
#pragma unroll
        for (int b = 0; b < 2; ++b)
#pragma unroll
            for (int m = 0; m < 4; ++m)
#pragma unroll
                for (int n = 0; n < 2; ++n) acc[a][b][m][n] = (f32x4){0.f, 0.f, 0.f, 0.f};
    bf16x8 At[4][2], B0[2][2], B1[2][2];
    const char* cA = (const char*)g.A + (size_t)cur.pm * tstepA; const char* cB = (const char*)g.Bt + (size_t)cur.pn * tstepB;
    S.a_ready(cur);
    epi_prefetch(E, cur, 0);
    if constexpr (SP2) {
        PG8_STAGE(PG8_SB(0, 0), cB, voffB); PG8_STAGE(PG8_SB(0, 1), cB + hstepB, voffB); PG8_STAGE(PG8_SA(0, 0), cA, voffA); PG8_STAGE(PG8_SA(0, 1), cA + hstepA, voffA);
        if (wr == 1) PG8_BAR;
        PG8_WAIT_V(2); PG8_BAR;
        PG8_STAGE(PG8_SB(1, 0), cB + kstep, voffB); PG8_STAGE(PG8_SA(1, 0), cA + kstep, voffA); PG8_STAGE(PG8_SB(1, 1), cB + hstepB + kstep, voffB);
        PG8_WAIT_V(6); PG8_BAR;
    } else {
        PG8_STAGE(PG8_SB(0, 0), cB, voffB); PG8_STAGE(PG8_SA(0, 0), cA, voffA); PG8_STAGE(PG8_SB(0, 1), cB + hstepB, voffB); PG8_STAGE(PG8_SA(0, 1), cA + hstepA, voffA);
        if (wr == 1) PG8_BAR;
        PG8_WAIT_V(4); PG8_BAR;
        PG8_STAGE(PG8_SB(1, 0), cB + kstep, voffB); PG8_STAGE(PG8_SA(1, 0), cA + kstep, voffA); PG8_STAGE(PG8_SB(1, 1), cB + hstepB + kstep, voffB);
        PG8_WAIT_V(6); PG8_BAR;
    }
    for (;;) {
        const bool has_next = S.next(ui + 1, nxt);
        const char* nA = has_next ? (const char*)g.A + (size_t)nxt.pm * tstepA : cA; const char* nB = has_next ? (const char*)g.Bt + (size_t)nxt.pn * tstepB : cB;
        for (int t = 0; t < nt; t += 2) {
            const bool last = (t == nt - 2);
            const char* a1 = cA + (size_t)(t + 1) * kstep;
            const char* a2 = last ? nA : cA + (size_t)(t + 2) * kstep; const char* b2 = last ? nB : cB + (size_t)(t + 2) * kstep;
            const char* a3 = a2 + kstep; const char* b3 = b2 + kstep;
            if (last && has_next) S.a_ready(nxt);
            if constexpr (SP2) {
            PG8_LDB(B0, 0, 0); PG8_LDB(B1, 0, 1); PG8_SCHED; PG8_LDA(At, 0, 0); PG8_STAGE(PG8_SA(1, 1), a1 + hstepA, voffA);
            PG8_WAIT_V(8); PG8_WAIT_L(0); PG8_BAR; PG8_MMA(0, 0, At, B0); PG8_MMA(0, 1, At, B1); PG8_BAR; PG8_SCHED;
            PG8_LDA(At, 0, 1); PG8_STAGE(PG8_SB(0, 0), b2, voffB); PG8_STAGE(PG8_SB(0, 1), b2 + hstepB, voffB); PG8_STAGE(PG8_SA(0, 0), a2, voffA);
            PG8_WAIT_V(8); PG8_WAIT_L(0); PG8_BAR; PG8_MMA(1, 0, At, B0); PG8_MMA(1, 1, At, B1); PG8_BAR; PG8_SCHED;
            PG8_LDB(B0, 1, 0); PG8_LDB(B1, 1, 1); PG8_SCHED; PG8_LDA(At, 1, 0); PG8_STAGE(PG8_SA(0, 1), a2 + hstepA, voffA);
            PG8_WAIT_V(8); PG8_WAIT_L(0); PG8_BAR; PG8_MMA(0, 0, At, B0); PG8_MMA(0, 1, At, B1); PG8_BAR; PG8_SCHED;
            PG8_LDA(At, 1, 1); PG8_STAGE(PG8_SB(1, 0), b3, voffB); PG8_STAGE(PG8_SB(1, 1), b3 + hstepB, voffB); PG8_STAGE(PG8_SA(1, 0), a3, voffA);
            PG8_WAIT_V(8); PG8_WAIT_L(0); PG8_BAR; PG8_MMA(1, 0, At, B0); PG8_MMA(1, 1, At, B1); PG8_BAR; PG8_SCHED;
            } else {
            PG8_LDB(B0, 0, 0); PG8_SCHED; PG8_LDA(At, 0, 0); PG8_STAGE(PG8_SA(1, 1), a1 + hstepA, voffA);
            PG8_WAIT_L(8); PG8_BAR; PG8_WAIT_L(0); PG8_MMA(0, 0, At, B0); PG8_BAR; PG8_SCHED;
            PG8_LDB(B1, 0, 1); PG8_STAGE(PG8_SB(0, 0), b2, voffB);
            PG8_BAR; PG8_WAIT_L(0); PG8_MMA(0, 1, At, B1); PG8_BAR;
            PG8_LDA(At, 0, 1); PG8_STAGE(PG8_SA(0, 0), a2, voffA);
            PG8_BAR; PG8_WAIT_L(0); PG8_MMA(1, 0, At, B0); PG8_BAR; PG8_SCHED;
            PG8_STAGE(PG8_SB(0, 1), b2 + hstepB, voffB);
            PG8_WAIT_V(6); PG8_BAR; PG8_MMA(1, 1, At, B1); PG8_BAR;
            PG8_LDB(B0, 1, 0); PG8_SCHED; PG8_LDA(At, 1, 0); PG8_STAGE(PG8_SA(0, 1), a2 + hstepA, voffA);
            PG8_WAIT_L(8); PG8_BAR; PG8_WAIT_L(0); PG8_MMA(0, 0, At, B0); PG8_BAR; PG8_SCHED;
            PG8_LDB(B1, 1, 1); PG8_STAGE(PG8_SB(1, 0), b3, voffB);
            PG8_BAR; PG8_WAIT_L(0); PG8_MMA(0, 1, At, B1); PG8_BAR;
            PG8_LDA(At, 1, 1); PG8_STAGE(PG8_SA(1, 0), a3, voffA);
            PG8_BAR; PG8_WAIT_L(0); PG8_MMA(1, 0, At, B0); PG8_BAR; PG8_SCHED;
            PG8_STAGE(PG8_SB(1, 1), b3 + hstepB, voffB);
            PG8_WAIT_V(6); PG8_BAR; PG8_MMA(1, 1, At, B1); PG8_BAR;
            }
        }
        if constexpr (ALIGN_EPI) { if (wr == 0) PG8_BAR; }
        E(acc, cur, wr, wc, fr, fq); S.done(cur);
        if (!has_next) break;
#pragma unroll
        for (int a = 0; a < 2; ++a)
#pragma unroll
            for (int b = 0; b < 2; ++b)
#pragma unroll
                for (int m = 0; m < 4; ++m)
#pragma unroll
                    for (int n = 0; n < 2; ++n) acc[a][b][m][n] = (f32x4){0.f, 0.f, 0.f, 0.f};
        cur = nxt; cA = nA; cB = nB; ++ui;
        epi_prefetch(E, cur, 0);
        if constexpr (ALIGN_EPI) { if (wr == 1) PG8_BAR; }
    }
    PG8_WAIT_V(0);
    if constexpr (!ALIGN_EPI) { if (wr == 0) PG8_BAR; }
    PG8_BAR;
#undef PG8_SA
#undef PG8_SB
#undef PG8_STAGE
#undef PG8_LDA
#undef PG8_LDB
#undef PG8_MMA
#undef PG8_WAIT_V
#undef PG8_WAIT_L
#undef PG8_BAR
#undef PG8_SCHED
}
}

constexpr int NB = 4, SEQ = 8192, DM = 1024, TT = NB * SEQ, CTXL = 256, TC = NB * CTXL, FF = 2816, NH = 16, HD = 64, GW = 64, GROWS = SEQ / GW;
constexpr int WH = 8, WW = 16;
constexpr float EPS = 1e-6f;
constexpr int NWAVES = 8;

constexpr size_t MiB = 1u << 20;
constexpr size_t WS_CTL = 0, CTL_ZERO_BYTES = 64 * 1024;
constexpr size_t CT_BAR = 4096;
constexpr size_t CT_MODS = 64 * 1024;
constexpr size_t CT_BQKV = CT_MODS + 2 * 5 * 6144 * 4;
constexpr size_t CT_BUP0 = CT_BQKV + 5 * 3072 * 4;
constexpr size_t CT_BIN  = CT_BUP0 + 4 * 5632 * 4;
constexpr size_t CT_BUP1 = CT_BIN + 4 * 3072 * 4;
constexpr size_t CT_END  = CT_BUP1 + 4 * 5632 * 4;
static_assert(CT_END <= 1 * MiB, "ctl region");
constexpr size_t SM_SSQ0 = 1 * MiB, SM_SSQC = SM_SSQ0 + 32768 * 4, SM_GN = SM_SSQC + 1024 * 4;
constexpr size_t WS_SSQP = 2 * MiB;
constexpr size_t WS_FSQP = 4 * MiB;
constexpr size_t WS_XB = 448 * MiB;
constexpr size_t WS_WQKV = 8 * MiB, WS_WO = 14 * MiB, WS_WUP0 = 16 * MiB, WS_WDN0 = 27 * MiB, WS_WIN = 33 * MiB, WS_WOUT = 39 * MiB, WS_WUP1 = 41 * MiB, WS_WDN1 = 52 * MiB;
constexpr size_t WS_XSC = 58 * MiB, WS_KC = 60 * MiB, WS_VC = 62 * MiB;
constexpr size_t WS_XS = 64 * MiB;
constexpr size_t WS_Q = 128 * MiB, WS_K = 192 * MiB, WS_V = 256 * MiB, WS_O = WS_Q;
constexpr size_t WS_AG = 128 * MiB;
constexpr size_t WS_HG = 308 * MiB, WS_HA = 314 * MiB;
constexpr size_t WS_UT = 128 * MiB;
constexpr size_t WS_HT = 128 * MiB;
constexpr size_t WS_F = 320 * MiB;
constexpr size_t SM_TWM = 1536 * 1024, SM_TWN = SM_TWM + 65536;
constexpr size_t WS_P = 384 * MiB;
constexpr size_t WS_END = 512 * MiB;

constexpr int RING_BYTES = 131072;
constexpr int LDS_BYTES = 163840;
constexpr int CB_LDS_OFF = 136 * 1024;
constexpr int LDSCTL_OFF = LDS_BYTES - 1024, MISC_OFF = LDSCTL_OFF + 320;

#define GAS __attribute__((address_space(1)))
#define LAS __attribute__((address_space(3)))
typedef unsigned short bf16;
typedef unsigned v4u __attribute__((ext_vector_type(4)));
typedef unsigned v2u __attribute__((ext_vector_type(2)));
typedef float f32x4 __attribute__((ext_vector_type(4)));
typedef GAS unsigned gu32;
#define RLX_AGENT __ATOMIC_RELAXED, __HIP_MEMORY_SCOPE_AGENT
#define LDS_WAIT() asm volatile("s_waitcnt lgkmcnt(0)" ::: "memory")
#define VM_WAIT() asm volatile("s_waitcnt vmcnt(0)" ::: "memory")
__device__ __forceinline__ unsigned f2bf(float f) { unsigned u = __builtin_bit_cast(unsigned, f); return (u + 0x7fffu + ((u >> 16) & 1u)) >> 16; }
__device__ __forceinline__ unsigned pk2(float lo, float hi) { unsigned r; asm("v_cvt_pk_bf16_f32 %0, %1, %2" : "=v"(r) : "v"(lo), "v"(hi)); return r; }
__device__ __forceinline__ float bf2f(unsigned short h) { return __builtin_bit_cast(float, (unsigned)h << 16); }
__device__ __forceinline__ float bflo(unsigned w) { return __builtin_bit_cast(float, w << 16); }
__device__ __forceinline__ float bfhi(unsigned w) { return __builtin_bit_cast(float, w & 0xffff0000u); }

#define FC_HD __device__ __forceinline__
typedef float cf __attribute__((ext_vector_type(2)));
FC_HD cf cmul(cf a, cf b) { const cf t = {-b.y, b.x}; return a.xx * b + a.yy * t; }
FC_HD cf cadd(cf a, cf b) { return a + b; }
FC_HD cf csub(cf a, cf b) { return a - b; }
FC_HD cf cconj(cf a) { cf r; r.x = a.x; r.y = -a.y; return r; }
FC_HD cf cmulnegi(cf a) { cf r; r.x = a.y; r.y = -a.x; return r; }
#define FC_OPAQUE(x) asm volatile("" : "+v"(x))
#define FC_PIDX(i) ((i) + (((i) >> 6) << 3))
#define FC_M 8192
#define FC_PADM (FC_M + FC_M / 8)
#define FC_S2 0.70710678118654752f
FC_HD void dft4(cf& a0, cf& a1, cf& a2, cf& a3) {
    const cf c0 = cadd(a0, a2), c1 = cadd(a1, a3), d0 = csub(a0, a2), d1 = cmulnegi(csub(a1, a3));
    a0 = cadd(c0, c1); a1 = cadd(d0, d1); a2 = csub(c0, c1); a3 = csub(d0, d1);
}
FC_HD void dft8(cf* v) {
    cf a0 = cadd(v[0], v[4]), a1 = cadd(v[1], v[5]), a2 = cadd(v[2], v[6]), a3 = cadd(v[3], v[7]);
    cf b0 = csub(v[0], v[4]), b1 = csub(v[1], v[5]), b2 = csub(v[2], v[6]), b3 = csub(v[3], v[7]);
    { cf t; t.x = (b1.x + b1.y) * FC_S2; t.y = (b1.y - b1.x) * FC_S2; b1 = t; }
    b2 = cmulnegi(b2);
    { cf t; t.x = (b3.y - b3.x) * FC_S2; t.y = (-b3.x - b3.y) * FC_S2; b3 = t; }
    dft4(a0, a1, a2, a3); dft4(b0, b1, b2, b3);
    v[0] = a0; v[2] = a1; v[4] = a2; v[6] = a3; v[1] = b0; v[3] = b1; v[5] = b2; v[7] = b3;
}
FC_HD void dft16(cf* v) {
    cf a[8], b[8];
    const float c1 = 0.92387953251128674f, s1 = 0.38268343236508977f;
#ifdef __HIP_DEVICE_COMPILE__
#pragma unroll
#endif
    for (int i = 0; i < 8; ++i) { a[i] = cadd(v[i], v[i + 8]); b[i] = csub(v[i], v[i + 8]); }
    { cf w; w.x = c1; w.y = -s1; b[1] = cmul(b[1], w); }
    { cf w; w.x = FC_S2; w.y = -FC_S2; b[2] = cmul(b[2], w); }
    { cf w; w.x = s1; w.y = -c1; b[3] = cmul(b[3], w); }
    b[4] = cmulnegi(b[4]);
    { cf w; w.x = -s1; w.y = -c1; b[5] = cmul(b[5], w); }
    { cf w; w.x = -FC_S2; w.y = -FC_S2; b[6] = cmul(b[6], w); }
    { cf w; w.x = -c1; w.y = -s1; b[7] = cmul(b[7], w); }
    dft8(a); dft8(b);
#ifdef __HIP_DEVICE_COMPILE__
#pragma unroll
#endif
    for (int i = 0; i < 8; ++i) { v[2 * i] = a[i]; v[2 * i + 1] = b[i]; }
}
template <int R> FC_HD void cpowers(cf w1, cf* w) {
    w[0].x = 1.f; w[0].y = 0.f; w[1] = w1;
#ifdef __HIP_DEVICE_COMPILE__
#pragma unroll
#endif
    for (int q = 2; q < R; ++q) w[q] = (q & 1) ? cmul(w[q - 1], w1) : cmul(w[q >> 1], w[q >> 1]);
}
template <class LP> FC_HD void fwd_pass1(cf* v, int tid, LP a, const cf* TWM) {
    dft16(v);
    FC_OPAQUE(tid);
    const cf w1 = TWM[tid]; cf cur = w1;
    const int pt = FC_PIDX(tid);
    a[pt] = v[0];
#ifdef __HIP_DEVICE_COMPILE__
#pragma unroll
#endif
    for (int q = 1; q < 16; ++q) { a[pt + 576 * q] = cmul(v[q], cur); cur = cmul(cur, w1); }
}
template <class LP> FC_HD void fwd_pass8(int tid, LP a, const cf* TWM, int s, int lgs) {
#pragma unroll 1
    for (int h = 0; h < 2; ++h) {
        FC_OPAQUE(tid);
        const int bf = tid + 512 * h, j = bf & (s - 1), base = (bf >> lgs) * 8 * s;
        const int pb = FC_PIDX(base + j), ps = (s == 64) ? 72 : 8;
        cf v[8];
#ifdef __HIP_DEVICE_COMPILE__
#pragma unroll
#endif
        for (int r = 0; r < 8; ++r) v[r] = a[pb + ps * r];
        dft8(v);
        const cf w1 = TWM[j]; cf cur = w1;
        a[pb] = v[0];
#ifdef __HIP_DEVICE_COMPILE__
#pragma unroll
#endif
        for (int q = 1; q < 8; ++q) { a[pb + ps * q] = cmul(v[q], cur); cur = cmul(cur, w1); }
    }
}
template <class LP> FC_HD void mid_pass(int tid, LP a, const cf* F, cf* Fout, float fscale) {
#pragma unroll 1
    for (int h = 0; h < 2; ++h) {
        FC_OPAQUE(tid);
        const int bf = tid + 512 * h, base = bf * 8, pb = FC_PIDX(base);
        cf v[8];
#ifdef __HIP_DEVICE_COMPILE__
#pragma unroll
#endif
        for (int r = 0; r < 8; ++r) v[r] = a[pb + r];
        dft8(v);
        if (F) {
#ifdef __HIP_DEVICE_COMPILE__
#pragma unroll
#endif
            for (int r = 0; r < 8; ++r) v[r] = cconj(cmul(v[r], F[base + r]));
            dft8(v);
#ifdef __HIP_DEVICE_COMPILE__
#pragma unroll
#endif
            for (int r = 0; r < 8; ++r) a[pb + r] = v[r];
        } else {
#ifdef __HIP_DEVICE_COMPILE__
#pragma unroll
#endif
            for (int r = 0; r < 8; ++r) { cf o; o.x = v[r].x * fscale; o.y = v[r].y * fscale; Fout[base + r] = o; }
        }
    }
}
template <class LP> FC_HD void mid_pass_reg(int tid, LP a, const cf* fr) {
#ifdef __HIP_DEVICE_COMPILE__
#pragma unroll
#endif
    for (int h = 0; h < 2; ++h) {
        FC_OPAQUE(tid);
        const int bf = tid + 512 * h, base = bf * 8, pb = FC_PIDX(base);
        cf v[8];
#ifdef __HIP_DEVICE_COMPILE__
#pragma unroll
#endif
        for (int r = 0; r < 8; ++r) v[r] = a[pb + r];
        dft8(v);
#ifdef __HIP_DEVICE_COMPILE__
#pragma unroll
#endif
        for (int r = 0; r < 8; ++r) v[r] = cconj(cmul(v[r], fr[h * 8 + r]));
        dft8(v);
#ifdef __HIP_DEVICE_COMPILE__
#pragma unroll
#endif
        for (int r = 0; r < 8; ++r) a[pb + r] = v[r];
    }
}
template <class LP> FC_HD void inv_pass8(int tid, LP a, const cf* TWM, int s, int lgs) {
#pragma unroll 1
    for (int h = 0; h < 2; ++h) {
        FC_OPAQUE(tid);
        const int bf = tid + 512 * h, j = bf & (s - 1), base = (bf >> lgs) * 8 * s;
        const int pb = FC_PIDX(base + j), ps = (s == 64) ? 72 : 8;
        cf v[8]; const cf w1 = TWM[j]; cf cur = w1;
        v[0] = a[FC_PIDX(base + j)];
#ifdef __HIP_DEVICE_COMPILE__
#pragma unroll
#endif
        for (int q = 1; q < 8; ++q) { v[q] = cmul(a[pb + ps * q], cur); cur = cmul(cur, w1); }
        dft8(v);
#ifdef __HIP_DEVICE_COMPILE__
#pragma unroll
#endif
        for (int r = 0; r < 8; ++r) a[pb + ps * r] = v[r];
    }
}
template <class LP> FC_HD void inv_pass1(cf* v, int tid, LP a, const cf* TWM) {
    FC_OPAQUE(tid);
    const cf w1 = TWM[tid]; cf cur = w1;
    const int pt = FC_PIDX(tid);
    v[0] = a[pt];
#ifdef __HIP_DEVICE_COMPILE__
#pragma unroll
#endif
    for (int q = 1; q < 16; ++q) { v[q] = cmul(a[pt + 576 * q], cur); cur = cmul(cur, w1); }
    dft16(v);
}

#define F2_PIDX(i) ((i) + ((i) >> 5))
#define F2_PADM (8192 + 256)
FC_HD void dft32(cf* v) {
    const float c[16] = {1.0f, 0.98078528040323043f, 0.92387953251128674f, 0.83146961230254524f, 0.70710678118654752f, 0.55557023301960218f, 0.38268343236508977f, 0.19509032201612825f,
                         0.0f, -0.19509032201612825f, -0.38268343236508977f, -0.55557023301960218f, -0.70710678118654752f, -0.83146961230254524f, -0.92387953251128674f, -0.98078528040323043f};
    const float s[16] = {0.0f, 0.19509032201612825f, 0.38268343236508977f, 0.55557023301960218f, 0.70710678118654752f, 0.83146961230254524f, 0.92387953251128674f, 0.98078528040323043f,
                         1.0f, 0.98078528040323043f, 0.92387953251128674f, 0.83146961230254524f, 0.70710678118654752f, 0.55557023301960218f, 0.38268343236508977f, 0.19509032201612825f};
#ifdef __HIP_DEVICE_COMPILE__
#pragma unroll
#endif
    for (int i = 0; i < 16; ++i) { const cf a = cadd(v[i], v[i + 16]); cf b = csub(v[i], v[i + 16]);
        if (i == 8) b = cmulnegi(b); else if (i != 0) { cf w; w.x = c[i]; w.y = -s[i]; b = cmul(b, w); }
        v[i] = a; v[i + 16] = b; }
    dft16(v); dft16(v + 16);
}
#define F2_Q(k) (2 * ((k) & 15) + ((k) >> 4))
template <class LP> FC_HD void f2_fwd_p1(cf* v, int tid, LP a, const cf* tw1) {
    dft16(v);
    FC_OPAQUE(tid);
    const cf w1 = tw1[tid]; cf cur = w1;
    const int pt = F2_PIDX(tid);
    a[pt] = v[0];
#ifdef __HIP_DEVICE_COMPILE__
#pragma unroll
#endif
    for (int q = 1; q < 16; ++q) { a[pt + 528 * q] = cmul(v[q], cur); cur = cmul(cur, w1); }
}
template <class LP> FC_HD void f2_fwd_p2(int tid, LP a, const cf* tw32) {
    FC_OPAQUE(tid);
    const int j = tid & 31, pb = F2_PIDX((tid >> 5) * 512 + j);
    cf v[16];
#ifdef __HIP_DEVICE_COMPILE__
#pragma unroll
#endif
    for (int r = 0; r < 16; ++r) v[r] = a[pb + 33 * r];
    dft16(v);
    const cf w1 = tw32[j]; cf cur = w1;
    a[pb] = v[0];
#ifdef __HIP_DEVICE_COMPILE__
#pragma unroll
#endif
    for (int q = 1; q < 16; ++q) { a[pb + 33 * q] = cmul(v[q], cur); cur = cmul(cur, w1); }
}
template <class LP> FC_HD void f2_fwd_p2_dual(int tid, LP a, LP b, const cf* tw32) {
    FC_OPAQUE(tid);
    const int j = tid & 31, pb = F2_PIDX((tid >> 5) * 512 + j);
    cf v[16], w[16];
#ifdef __HIP_DEVICE_COMPILE__
#pragma unroll
#endif
    for (int r = 0; r < 16; ++r) v[r] = a[pb + 33 * r];
#ifdef __HIP_DEVICE_COMPILE__
#pragma unroll
#endif
    for (int r = 0; r < 16; ++r) w[r] = b[pb + 33 * r];
    const cf w1 = tw32[j];
    dft16(v);
    { cf cur = w1; a[pb] = v[0];
#ifdef __HIP_DEVICE_COMPILE__
#pragma unroll
#endif
      for (int q = 1; q < 16; ++q) { a[pb + 33 * q] = cmul(v[q], cur); cur = cmul(cur, w1); } }
    dft16(w);
    { cf cur = w1; b[pb] = w[0];
#ifdef __HIP_DEVICE_COMPILE__
#pragma unroll
#endif
      for (int q = 1; q < 16; ++q) { b[pb + 33 * q] = cmul(w[q], cur); cur = cmul(cur, w1); } }
}
template <class LP> FC_HD void f2_inv_p2_dual(int tid, LP a, LP b, const cf* tw32) {
    FC_OPAQUE(tid);
    const int j = tid & 31, pb = F2_PIDX((tid >> 5) * 512 + j);
    cf v[16], w[16]; const cf w1 = tw32[j];
#ifdef __HIP_DEVICE_COMPILE__
#pragma unroll
#endif
    for (int r = 0; r < 16; ++r) v[r] = a[pb + 33 * r];
#ifdef __HIP_DEVICE_COMPILE__
#pragma unroll
#endif
    for (int r = 0; r < 16; ++r) w[r] = b[pb + 33 * r];
    { cf cur = w1;
#ifdef __HIP_DEVICE_COMPILE__
#pragma unroll
#endif
      for (int q = 1; q < 16; ++q) { v[q] = cmul(v[q], cur); cur = cmul(cur, w1); } }
    dft16(v);
#ifdef __HIP_DEVICE_COMPILE__
#pragma unroll
#endif
    for (int r = 0; r < 16; ++r) a[pb + 33 * r] = v[r];
    { cf cur = w1;
#ifdef __HIP_DEVICE_COMPILE__
#pragma unroll
#endif
      for (int q = 1; q < 16; ++q) { w[q] = cmul(w[q], cur); cur = cmul(cur, w1); } }
    dft16(w);
#ifdef __HIP_DEVICE_COMPILE__
#pragma unroll
#endif
    for (int r = 0; r < 16; ++r) b[pb + 33 * r] = w[r];
}
template <class LP> FC_HD void f2_mid(int bf, LP a, const cf* fr, cf* Fout, float fscale) {
    FC_OPAQUE(bf);
    const int pb = 33 * bf;
    cf v[32];
#ifdef __HIP_DEVICE_COMPILE__
#pragma unroll
#endif
    for (int i = 0; i < 32; ++i) v[i] = a[pb + i];
    dft32(v);
    if (fr) {
        cf w[32];
#ifdef __HIP_DEVICE_COMPILE__
#pragma unroll
#endif
        for (int k = 0; k < 32; ++k) w[F2_Q(k)] = cconj(cmul(v[k], fr[F2_Q(k)]));
        dft32(w);
#ifdef __HIP_DEVICE_COMPILE__
#pragma unroll
#endif
        for (int k = 0; k < 32; ++k) a[pb + F2_Q(k)] = w[k];
    } else {
#ifdef __HIP_DEVICE_COMPILE__
#pragma unroll
#endif
        for (int k = 0; k < 32; ++k) { cf o; o.x = v[k].x * fscale; o.y = v[k].y * fscale; Fout[F2_Q(k) * 256 + bf] = o; }
    }
}
typedef _Float16 h2v __attribute__((ext_vector_type(2)));
FC_HD unsigned pkh2(cf a) { h2v v; v.x = (_Float16)a.x; v.y = (_Float16)a.y; return __builtin_bit_cast(unsigned, v); }
FC_HD cf unh2(unsigned u) { const h2v v = __builtin_bit_cast(h2v, u); cf r; r.x = (float)v.x; r.y = (float)v.y; return r; }
template <class LP> FC_HD void f2_mid_store16(int bf, LP a, v2u* Fout) {
    FC_OPAQUE(bf);
    const int pb = 33 * bf;
    cf v[32];
#pragma unroll
    for (int i = 0; i < 32; ++i) v[i] = a[pb + i];
    dft32(v);
#pragma unroll
    for (int k = 0; k < 16; ++k) { v2u o; o.x = pkh2(v[k]); o.y = pkh2(v[k + 16]); Fout[k * 256 + bf] = o; }
}
template <class LP> FC_HD void f2_mid16(int bf, LP a, const v2u* fr16) {
    FC_OPAQUE(bf);
    const int pb = 33 * bf;
    cf v[32];
#pragma unroll
    for (int i = 0; i < 32; ++i) v[i] = a[pb + i];
    dft32(v);
    cf w[32];
#pragma unroll
    for (int k = 0; k < 32; ++k) w[F2_Q(k)] = cconj(cmul(v[k], unh2(k < 16 ? fr16[k & 15].x : fr16[k & 15].y)));
    dft32(w);
#pragma unroll
    for (int k = 0; k < 32; ++k) a[pb + F2_Q(k)] = w[k];
}
template <class LP> FC_HD void f2_inv_p2(int tid, LP a, const cf* tw32) {
    FC_OPAQUE(tid);
    const int j = tid & 31, pb = F2_PIDX((tid >> 5) * 512 + j);
    cf v[16]; const cf w1 = tw32[j]; cf cur = w1;
    v[0] = a[pb];
#ifdef __HIP_DEVICE_COMPILE__
#pragma unroll
#endif
    for (int q = 1; q < 16; ++q) { v[q] = cmul(a[pb + 33 * q], cur); cur = cmul(cur, w1); }
    dft16(v);
#ifdef __HIP_DEVICE_COMPILE__
#pragma unroll
#endif
    for (int r = 0; r < 16; ++r) a[pb + 33 * r] = v[r];
}
template <class LP> FC_HD void f2_inv_p1(cf* v, int tid, LP a, const cf* tw1) {
    FC_OPAQUE(tid);
    const cf w1 = tw1[tid]; cf cur = w1;
    const int pt = F2_PIDX(tid);
    v[0] = a[pt];
#ifdef __HIP_DEVICE_COMPILE__
#pragma unroll
#endif
    for (int q = 1; q < 16; ++q) { v[q] = cmul(a[pt + 528 * q], cur); cur = cmul(cur, w1); }
    dft16(v);
}

#define XB_TMO      128
#define XB_XCNT(j)  (256  + 64 * (j))
#define XB_XSUB(j)  (1280 + 64 * (j))
#define XB_XGEN(j)  (2304 + 64 * (j))
#define XB_TOP      3328
#define XB_TOPGEN   3392
#define XCD_BAR_WORDS 3456
#define XB_SPIN_CAP (1u << 18)
__device__ __forceinline__ unsigned xb_ld(unsigned* p)              { return __hip_atomic_load(p, __ATOMIC_RELAXED, __HIP_MEMORY_SCOPE_AGENT); }
__device__ __forceinline__ unsigned xb_add(unsigned* p, unsigned v) { return __hip_atomic_fetch_add(p, v, __ATOMIC_RELAXED, __HIP_MEMORY_SCOPE_AGENT); }
__device__ __forceinline__ unsigned xb_xcc_id() { return (unsigned)__builtin_amdgcn_s_getreg((3 << 11) | 20) & 0xFu; }
#define XB_SPIN(cond, bar) do { unsigned _sp = 0; while (cond) { __builtin_amdgcn_s_sleep(1); \
    if ((++_sp & 255u) == 0u) { if (xb_ld(&(bar)[XB_TMO])) break; if (_sp > XB_SPIN_CAP) { atomicAdd(&(bar)[XB_TMO], 1u); break; } } } } while (0)
struct XcdBarrier { unsigned* bar; unsigned x; volatile LAS unsigned* st; };
__device__ __forceinline__ XcdBarrier xcd_barrier_post(unsigned* bar, volatile LAS unsigned* st) {
    XcdBarrier b; b.bar = bar; b.x = xb_xcc_id(); b.st = st;
    if (threadIdx.x == 0) (void)xb_add(&bar[XB_XCNT(b.x)], 1u);
    return b;
}
__device__ __forceinline__ void xcd_barrier_complete(unsigned* bar, unsigned x, unsigned& nloc, unsigned& nx) {
    const unsigned G = gridDim.x * gridDim.y * gridDim.z;
    unsigned sum, cnt, mine, sp = 0u;
    for (;;) {
        sum = 0u; cnt = 0u; mine = 0u;
#pragma unroll
        for (unsigned j = 0; j < 16; ++j) { const unsigned c = xb_ld(&bar[XB_XCNT(j)]); sum += c; cnt += (c > 0u) ? 1u : 0u; mine = (j == x) ? c : mine; }
        if (sum == G) break;
        __builtin_amdgcn_s_sleep(1);
        if ((++sp & 255u) == 0u) { if (xb_ld(&bar[XB_TMO])) break; if (sp > XB_SPIN_CAP) { atomicAdd(&bar[XB_TMO], 1u); break; } }
    }
    nloc = mine > 0u ? mine : 1u; nx = cnt > 0u ? cnt : 1u;
}
__device__ __forceinline__ void xcd_barrier(const XcdBarrier& b) {
    asm volatile("s_waitcnt vmcnt(0)" ::: "memory");
    __syncthreads();
    if (threadIdx.x == 0) {
        unsigned* bar = b.bar;
        __builtin_amdgcn_s_waitcnt(0);
        unsigned nloc = b.st[0], nx = b.st[1];
        if (nloc == 0u) { xcd_barrier_complete(bar, b.x, nloc, nx); b.st[0] = nloc; b.st[1] = nx; }
        const unsigned old = xb_add(&bar[XB_XSUB(b.x)], 1u);
        const unsigned gen = old / nloc;
        if (old + 1u == (gen + 1u) * nloc) {
            __builtin_amdgcn_fence(__ATOMIC_RELEASE, "agent");
            asm volatile("s_waitcnt vmcnt(0)" ::: "memory");
            const unsigned og = xb_add(&bar[XB_TOP], 1u);
            const unsigned tg = og / nx;
            if (og + 1u == (tg + 1u) * nx) xb_add(&bar[XB_TOPGEN], 1u);
            else XB_SPIN(xb_ld(&bar[XB_TOPGEN]) == tg, bar);
            __builtin_amdgcn_fence(__ATOMIC_ACQUIRE, "agent");
            xb_add(&bar[XB_XGEN(b.x)], 1u);
            asm volatile("s_waitcnt vmcnt(0)" ::: "memory");
        } else {
            XB_SPIN(xb_ld(&bar[XB_XGEN(b.x)]) == gen, bar);
            __builtin_amdgcn_fence(__ATOMIC_ACQUIRE, "agent");
            asm volatile("s_waitcnt vmcnt(0)" ::: "memory");
        }
    }
    __syncthreads();
}

struct Args { const float* in[40]; float* out; unsigned char* ws; int ph_lo, ph_hi, repmask, li; };
struct Frame {
    LAS unsigned char* lds;
    int tid, lane, wave, vcu, G;
    const float* const* in; float* out; unsigned char* ws;
#ifdef PROBE_SEC
    unsigned long long sec;
#endif
};
__device__ __forceinline__ float wave_sum(float v) {
#pragma unroll
    for (int o = 1; o < 64; o <<= 1) v += __shfl_xor(v, o);
    return v;
}
__device__ __forceinline__ float silu_f(float x) { return x / (1.f + __expf(-x)); }

__device__ __forceinline__ float gelu_f(float v) { return 0.5f * v * (1.f + erff(v * 0.70710678118654752f)); }

__device__ __forceinline__ void transpose_item(const float* W, int K, int N, bf16* WT, int src_col0, int dst_row0, int k0, LAS float* scr, int lane) {
    {
        const int r8 = lane >> 3, c4 = (lane & 7) * 4;
        f32x4 x[8];
#pragma unroll
        for (int i = 0; i < 8; ++i) x[i] = *(const f32x4*)(W + (size_t)(k0 + 8 * i + r8) * N + src_col0 + c4);
#pragma unroll
        for (int i = 0; i < 8; ++i) { LAS float* d = scr + (8 * i + r8) * 33 + c4; d[0] = x[i].x; d[1] = x[i].y; d[2] = x[i].z; d[3] = x[i].w; }
    }
    LDS_WAIT(); asm volatile("" ::: "memory");
    const int c = lane & 7;
#pragma unroll
    for (int j = 0; j < 4; ++j) { const int n = (lane >> 3) + 8 * j; const LAS float* s = scr + (8 * c) * 33 + n;
        v4u o; o.x = pk2(s[0 * 33], s[1 * 33]); o.y = pk2(s[2 * 33], s[3 * 33]); o.z = pk2(s[4 * 33], s[5 * 33]); o.w = pk2(s[6 * 33], s[7 * 33]);
        *(GAS v4u*)(WT + (size_t)(dst_row0 + n) * K + k0 + 8 * c) = o; }
    LDS_WAIT(); asm volatile("" ::: "memory");
}
__device__ __forceinline__ void transpose_load(const float* W, int N, int src_col0, int k0, int lane, f32x4 (&x)[8]) {
    const int r8 = lane >> 3, c4 = (lane & 7) * 4;
#pragma unroll
    for (int i = 0; i < 8; ++i) x[i] = *(const f32x4*)(W + (size_t)(k0 + 8 * i + r8) * N + src_col0 + c4);
}
__device__ __forceinline__ void transpose_finish(const f32x4 (&x)[8], int K, bf16* WT, int dst_row0, int k0, LAS float* scr, int lane) {
    { const int r8 = lane >> 3, c4 = (lane & 7) * 4;
#pragma unroll
      for (int i = 0; i < 8; ++i) { LAS float* d = scr + (8 * i + r8) * 33 + c4; d[0] = x[i].x; d[1] = x[i].y; d[2] = x[i].z; d[3] = x[i].w; } }
    LDS_WAIT(); asm volatile("" ::: "memory");
    const int c = lane & 7;
#pragma unroll
    for (int j = 0; j < 4; ++j) { const int n = (lane >> 3) + 8 * j; const LAS float* s = scr + (8 * c) * 33 + n;
        v4u o; o.x = pk2(s[0 * 33], s[1 * 33]); o.y = pk2(s[2 * 33], s[3 * 33]); o.z = pk2(s[4 * 33], s[5 * 33]); o.w = pk2(s[6 * 33], s[7 * 33]);
        *(GAS v4u*)(WT + (size_t)(dst_row0 + n) * K + k0 + 8 * c) = o; }
    LDS_WAIT(); asm volatile("" ::: "memory");
}
__device__ __forceinline__ int qkv_slot_to_col(int slot) {
    const int part = slot >> 10, cc = slot & 1023, pnl = cc >> 8, s = cc & 255, bj = s >> 7, wc = (s & 127) >> 5, j = s & 31;
    return part * 1024 + (4 * pnl + wc) * 64 + 32 * bj + j;
}
__device__ __forceinline__ int up_slot_to_col(int slot) { const int pn = slot >> 8, bj = (slot >> 7) & 1, cc = slot & 127; return bj * FF + pn * 128 + cc; }
__device__ __forceinline__ void cvt_weight_item(const float* W, int K, int N, bf16* WT, int item, LAS float* scr, int lane, int perm) {
    const int nblk = N / 32, kb = item / nblk, nb = item % nblk;
    const int dst = 32 * nb, src = perm == 1 ? qkv_slot_to_col(dst) : (perm == 2 ? up_slot_to_col(dst) : dst);
    transpose_item(W, K, N, WT, src, dst, 64 * kb, scr, lane);
}

template <int R, class VF>
__device__ __forceinline__ void gemv_det_item(const float* W, int N, int n0, float* out, int ostride, const float* addbias, const VF& vf, int tid, LAS float* scr) {
    const int col = tid & 63, ks = tid >> 6;
    float acc[R];
#pragma unroll
    for (int r = 0; r < R; ++r) acc[r] = 0.f;
    const float* wp = W + (size_t)(ks * 128) * N + n0 + col;
#pragma unroll 8
    for (int k = 0; k < 128; ++k) { const float w = wp[(size_t)k * N];
#pragma unroll
        for (int r = 0; r < R; ++r) acc[r] += vf(r, ks * 128 + k) * w; }
    __syncthreads();
#pragma unroll
    for (int r = 0; r < R; ++r) scr[(ks * R + r) * 64 + col] = acc[r];
    __syncthreads();
    if (tid < R * 64) { const int r = tid >> 6; float s = 0.f;
#pragma unroll
        for (int k2 = 0; k2 < 8; ++k2) s += scr[(k2 * R + r) * 64 + col];
        if (addbias) s += addbias[n0 + col];
        out[(size_t)r * ostride + n0 + col] = s; }
}

template <int R, class VF>
__device__ __forceinline__ void gemv_det_item16(const float* W, int N, int n0, float* out, int ostride, const float* addbias, const VF& vf, int tid, LAS float* scr) {
    const int col = tid & 15, ks = tid >> 4;
    float acc[R];
#pragma unroll
    for (int r = 0; r < R; ++r) acc[r] = 0.f;
    const float* wp = W + (size_t)(ks * 32) * N + n0 + col;
#pragma unroll 8
    for (int k = 0; k < 32; ++k) { const float w = wp[(size_t)k * N];
#pragma unroll
        for (int r = 0; r < R; ++r) acc[r] += vf(r, ks * 32 + k) * w; }
    __syncthreads();
#pragma unroll
    for (int r = 0; r < R; ++r) scr[(ks * R + r) * 16 + col] = acc[r];
    __syncthreads();
    if (tid < R * 16) { const int r = tid >> 4; float s = 0.f;
#pragma unroll
        for (int k2 = 0; k2 < 32; ++k2) s += scr[(k2 * R + r) * 16 + col];
        if (addbias) s += addbias[n0 + col];
        out[(size_t)r * ostride + n0 + col] = s; }
}

__device__ __forceinline__ void phase0a(Frame& F) {
    const float* const* in = F.in;
    float* mods = (float*)(F.ws + CT_MODS);
    {
        const float* c = in[1]; const float* cctx = in[3];
        LAS float* sl = (LAS float*)(F.lds + 65536);
        for (int e = F.tid; e < 5 * DM; e += 512) { const float v = (e < 4 * DM) ? c[e] : cctx[e - 4 * DM]; sl[e] = silu_f(v); }
        __syncthreads();
        auto vf = [&](int r, int k) -> float { return sl[r * DM + k]; };
        const int nitems = 2 * 96;
        for (int it = F.vcu; it < nitems; it += F.G) {
            const int l = it / 96, cg = it % 96;
            gemv_det_item<5>(in[l ? 17 : 4], 6144, cg * 64, mods + l * 5 * 6144, 6144, in[l ? 18 : 5], vf, F.tid, (LAS float*)F.lds);
        }
        __syncthreads();
    }
    for (int e = F.vcu * 512 + F.tid; e < 16384; e += F.G * 512) {
        const int k = e & 8191; const bool isn = e >= 8192;
        float sn, cs; sincospif(isn ? (float)k * (1.0f / 8192.0f) : (float)k * (1.0f / 4096.0f), &sn, &cs);
        cf t; t.x = cs; t.y = -sn;
        ((cf*)(F.ws + (isn ? SM_TWN : SM_TWM)))[k] = t;
    }
    LAS float* scr = (LAS float*)(F.lds + F.wave * 16384);
    const int gw = F.vcu * NWAVES + F.wave, NGW = F.G * NWAVES;
    constexpr int I_QKV = 16 * 96, I_O = 16 * 32, I_UP = 16 * 176, I_DN = 44 * 32;
    constexpr int NITEMS = 2 * I_QKV + 2 * I_O + 2 * I_UP + 2 * I_DN;
    struct CvtD { const float* W; bf16* WT; int K, N, src, dst, k0; };
    auto desc = [&](int it) -> CvtD {
        int r = it; const float* W; bf16* WT; int K, N, perm = 0;
        if (r < I_QKV) { W = in[8]; K = DM; N = 3 * DM; WT = (bf16*)(F.ws + WS_WQKV); perm = 1; }
        else if ((r -= I_QKV) < I_O) { W = in[12]; K = DM; N = DM; WT = (bf16*)(F.ws + WS_WO); }
        else if ((r -= I_O) < I_UP) { W = in[13]; K = DM; N = 2 * FF; WT = (bf16*)(F.ws + WS_WUP0); perm = 2; }
        else if ((r -= I_UP) < I_DN) { W = in[16]; K = FF; N = DM; WT = (bf16*)(F.ws + WS_WDN0); }
        else if ((r -= I_DN) < I_QKV) { W = in[21]; K = DM; N = 3 * DM; WT = (bf16*)(F.ws + WS_WIN); }
        else if ((r -= I_QKV) < I_O) { W = in[34]; K = DM; N = DM; WT = (bf16*)(F.ws + WS_WOUT); }
        else if ((r -= I_O) < I_UP) { W = in[36]; K = DM; N = 2 * FF; WT = (bf16*)(F.ws + WS_WUP1); perm = 2; }
        else { r -= I_UP; W = in[39]; K = FF; N = DM; WT = (bf16*)(F.ws + WS_WDN1); }
        const int nblk = N / 32, kb = r / nblk, nb = r % nblk, dst = 32 * nb;
        const int src = perm == 1 ? qkv_slot_to_col(dst) : (perm == 2 ? up_slot_to_col(dst) : dst);
        return CvtD{W, WT, K, N, src, dst, 64 * kb};
    };
    if (gw < NITEMS) {
        f32x4 xc[8], xn[8];
        CvtD dc = desc(gw);
        transpose_load(dc.W, dc.N, dc.src, dc.k0, F.lane, xc);
        for (int it = gw; it < NITEMS; it += NGW) {
            const CvtD dn = desc(min(it + NGW, NITEMS - 1));
            transpose_load(dn.W, dn.N, dn.src, dn.k0, F.lane, xn);
            transpose_finish(xc, dc.K, dc.WT, dc.dst, dc.k0, scr, F.lane);
#pragma unroll
            for (int i = 0; i < 8; ++i) xc[i] = xn[i];
            dc = dn;
        }
    }
}

__device__ __forceinline__ void row_prescale(const float* xrow, const float* gain, const float* sc, bf16* orow, float* ssq_out, int lane) {
    const GAS f32x4* xr = (const GAS f32x4*)xrow + lane;
    const GAS f32x4* gr = (const GAS f32x4*)gain + lane;
    const GAS f32x4* sr = (const GAS f32x4*)sc + lane;
    f32x4 v[4]; float s = 0.f;
#pragma unroll
    for (int j = 0; j < 4; ++j) { v[j] = xr[64 * j]; s += (v[j].x * v[j].x + v[j].y * v[j].y) + (v[j].z * v[j].z + v[j].w * v[j].w); }
    s = wave_sum(s);
    if (lane == 0) *ssq_out = s;
    GAS unsigned long long* o8 = (GAS unsigned long long*)orow + lane;
#pragma unroll
    for (int j = 0; j < 4; ++j) { const f32x4 g = gr[64 * j], c = sr[64 * j]; const f32x4 w = v[j] * g * (c + 1.0f);
        o8[64 * j] = (unsigned long long)pk2(w.x, w.y) | ((unsigned long long)pk2(w.z, w.w) << 32); }
}
__device__ __forceinline__ void phase0b(Frame& F) {
    const float* const* in = F.in;
    const float* mods = (const float*)(F.ws + CT_MODS);
    const int gw = F.vcu * NWAVES + F.wave, NGW = F.G * NWAVES;
    for (int m = gw; m < TT + TC; m += NGW) {
        if (m < TT) { const int b = m / SEQ; row_prescale(in[0] + (size_t)m * DM, in[6], mods + b * 6144 + 1024, (bf16*)(F.ws + WS_XS) + (size_t)m * DM, (float*)(F.ws + SM_SSQ0) + m, F.lane); }
        else { const int mc = m - TT; row_prescale(in[2] + (size_t)mc * DM, in[6], mods + 4 * 6144 + 1024, (bf16*)(F.ws + WS_XSC) + (size_t)mc * DM, (float*)(F.ws + SM_SSQC) + mc, F.lane); }
    }
    {
        float* gn = (float*)(F.ws + SM_GN);
        for (int e = F.vcu * 512 + F.tid; e < 3 * 4 * 1024; e += F.G * 512) {
            const int i = e / 4096, b = (e / 1024) & 3, k = e & 1023;
            const float* g = in[i == 0 ? 7 : (i == 1 ? 19 : 20)];
            const float sc = mods[(i == 0 ? 0 : 1) * 5 * 6144 + b * 6144 + (i == 1 ? 1024 : 4096) + k];
            gn[e] = g[k] * (1.f + sc);
        }
    }
    {
        LAS float* gs = (LAS float*)F.lds;
        for (int it = F.vcu; it < 192; it += F.G) { auto vf = [&](int r, int k) -> float { return mods[r * 6144 + k]; };
            gemv_det_item16<5>(in[8], 3072, it * 16, (float*)(F.ws + CT_BQKV), 3072, nullptr, vf, F.tid, gs); }
        __syncthreads();
    }
}
__device__ __forceinline__ void bias_gemv_late(Frame& F, int it) {
    const float* const* in = F.in;
    const float* mods = (const float*)(F.ws + CT_MODS);
    const int n_up = 88, n_in = 48;
    LAS float* gs = (LAS float*)F.lds;
    if (it < n_up) { auto vf = [&](int r, int k) -> float { return mods[r * 6144 + 3072 + k]; };
        gemv_det_item<4>(in[13], 5632, it * 64, (float*)(F.ws + CT_BUP0), 5632, nullptr, vf, F.tid, gs); }
    else if (it < n_up + n_in) { it -= n_up; auto vf = [&](int r, int k) -> float { return mods[5 * 6144 + r * 6144 + k]; };
        gemv_det_item<4>(in[21], 3072, it * 64, (float*)(F.ws + CT_BIN), 3072, in[22], vf, F.tid, gs); }
    else if (it < 2 * n_up + n_in) { it -= n_up + n_in; auto vf = [&](int r, int k) -> float { return mods[5 * 6144 + r * 6144 + 3072 + k]; };
        gemv_det_item<4>(in[36], 5632, it * 64, (float*)(F.ws + CT_BUP1), 5632, nullptr, vf, F.tid, gs); }
    __syncthreads();
}

using pg8::f32x4; using pg8::Unit;
__device__ __forceinline__ float row_rs(const float* ssq, int np, int row) {
    float s = 0.f;
    for (int i = 0; i < np; ++i) s += ssq[(size_t)i * TT + row];
    return 1.0f / sqrtf(s * (1.0f / 1024.0f) + EPS);
}
constexpr float QSCALE = 0.125f * 1.4426950408889634f;
template <int PART>
struct EpiQK {
    static constexpr bool PERM = true;
    bf16* dst; const float* ssq; int np; const float* bias; int bias_bstride; const float* gain; int seqlen;
    __device__ __forceinline__ void operator()(const f32x4 (&acc)[2][2][4][2], const Unit& u, int wr, int wc, int fr, int fq) const {
        const int head = 4 * u.pn + wc;
        const int b = (u.pm * 256) / seqlen;
        const float* bp = bias + (size_t)b * bias_bstride + PART * 1024 + head * 64 + 8 * fq;
        const float* gp = gain + 8 * fq;
        const float osc = PART == 0 ? QSCALE : 1.0f;
#pragma unroll
        for (int ai = 0; ai < 2; ++ai)
#pragma unroll
            for (int m = 0; m < 4; ++m) {
                const int row = u.pm * 256 + ai * 128 + wr * 64 + m * 16 + fr;
                const float rs = row_rs(ssq, np, row);
                f32x4 v[2][2]; float ss = 0.f;
#pragma unroll
                for (int bj = 0; bj < 2; ++bj)
#pragma unroll
                    for (int n = 0; n < 2; ++n) { v[bj][n] = acc[ai][bj][m][n] * rs + *(const f32x4*)(bp + 32 * bj + 4 * n); const f32x4 t = v[bj][n]; ss += (t.x * t.x + t.y * t.y) + (t.z * t.z + t.w * t.w); }
                ss += __shfl_xor(ss, 16); ss += __shfl_xor(ss, 32);
                const float rn = osc / sqrtf(ss * (1.0f / 64.0f) + EPS);
                const int tl = row - b * seqlen;
                bf16* rowp = (PART == 0) ? dst + (size_t)row * DM + head * 64 + 8 * fq
                                         : dst + ((((size_t)(b * NH + head) * (seqlen / 16) + (tl >> 4)) * 8 + fq) * 16 + (tl & 15)) * 8;
                constexpr int bjstep = (PART == 0) ? 32 : 4 * 16 * 8;
#pragma unroll
                for (int bj = 0; bj < 2; ++bj) { const f32x4 a0 = v[bj][0] * rn * *(const f32x4*)(gp + 32 * bj), a1 = v[bj][1] * rn * *(const f32x4*)(gp + 32 * bj + 4);
                    v4u w; w.x = pk2(a0.x, a0.y); w.y = pk2(a0.z, a0.w); w.z = pk2(a1.x, a1.y); w.w = pk2(a1.z, a1.w);
                    *(v4u*)(rowp + bjstep * bj) = w; }
                asm volatile("" ::: "memory");
            }
    }
};
struct EpiVT {
    static constexpr bool PERM = true;
    bf16* VTp; const float* ssq; int np; const float* bias; int bias_bstride; int seqlen;
    __device__ __forceinline__ void operator()(const f32x4 (&acc)[2][2][4][2], const Unit& u, int wr, int wc, int fr, int fq) const {
        const int head = 4 * u.pn + wc;
        const int b = (u.pm * 256) / seqlen;
        const float* bp = bias + (size_t)b * bias_bstride + 2048 + head * 64 + 8 * fq;
        const int odd = fr & 1;
        f32x4 bv[2][2];
#pragma unroll
        for (int bj = 0; bj < 2; ++bj)
#pragma unroll
            for (int n = 0; n < 2; ++n) bv[bj][n] = *(const f32x4*)(bp + 32 * bj + 4 * n);
#pragma unroll
        for (int ai = 0; ai < 2; ++ai)
#pragma unroll
            for (int m = 0; m < 4; ++m) {
                const int row = u.pm * 256 + ai * 128 + wr * 64 + m * 16 + fr;
                const float rs = row_rs(ssq, np, row);
                const int tl = row - b * seqlen;
                const int c16 = tl & 14, cpos = (c16 & 3) | ((c16 & 8) >> 1) | ((c16 & 4) << 1);
                bf16* vb = VTp + (((size_t)(b * NH + head) * (seqlen / 16) + (tl >> 4)) * 64 + 8 * fq + odd) * 16 + cpos;
#pragma unroll
                for (int bj = 0; bj < 2; ++bj)
#pragma unroll
                    for (int n = 0; n < 2; ++n) {
                        const f32x4 v = acc[ai][bj][m][n] * rs + bv[bj][n];
                        const unsigned w01 = pk2(v.x, v.y), w23 = pk2(v.z, v.w);
                        const unsigned p01 = (unsigned)__shfl_xor((int)w01, 1), p23 = (unsigned)__shfl_xor((int)w23, 1);
                        const unsigned o0 = odd ? ((w01 & 0xffff0000u) | (p01 >> 16)) : ((p01 << 16) | (w01 & 0xffffu));
                        const unsigned o1 = odd ? ((w23 & 0xffff0000u) | (p23 >> 16)) : ((p23 << 16) | (w23 & 0xffffu));
                        bf16* p = vb + (32 * bj + 4 * n) * 16;
                        *(unsigned*)p = o0; *(unsigned*)(p + 2 * 16) = o1;
                    }
            }
    }
};
template <bool BASE_F32, bool OUT_F32>
struct EpiRes {
    static constexpr bool PERM = true;
    const void* base; void* out; const float* gate; const float* bias; const float* gn; bf16* xs; float* ssq; float* hs;
    __device__ __forceinline__ void operator()(const f32x4 (&acc)[2][2][4][2], const Unit& u, int wr, int wc, int fr, int fq) const {
        const int b = (u.pm * 256) / SEQ;
        const int col0 = u.pn * 256 + wc * 32 + 8 * fq;
        constexpr int MB = BASE_F32 ? 2 : 4;
#pragma unroll
        for (int ai = 0; ai < 2; ++ai)
#pragma unroll
        for (int mb = 0; mb < 4; mb += MB) {
            f32x4 bf[MB][2][2]; v4u bh[MB][2];
#pragma unroll
            for (int mi = 0; mi < MB; ++mi) { const size_t off = (size_t)(u.pm * 256 + ai * 128 + wr * 64 + (mb + mi) * 16 + fr) * DM + col0;
#pragma unroll
                for (int bj = 0; bj < 2; ++bj) {
                    if (BASE_F32) { bf[mi][bj][0] = *(const f32x4*)((const float*)base + off + 128 * bj); bf[mi][bj][1] = *(const f32x4*)((const float*)base + off + 128 * bj + 4); }
                    else bh[mi][bj] = *(const v4u*)((const bf16*)base + off + 128 * bj); } }
#pragma unroll
            for (int mi = 0; mi < MB; ++mi) {
                const int m = mb + mi;
                const int rowl = ai * 128 + wr * 64 + m * 16 + fr;
                const size_t off = (size_t)(u.pm * 256 + rowl) * DM + col0;
                float ss = 0.f;
#pragma unroll
                for (int bj = 0; bj < 2; ++bj) {
                    const int c = col0 + 128 * bj;
                    f32x4 b0, b1;
                    if (BASE_F32) { b0 = bf[mi][bj][0]; b1 = bf[mi][bj][1]; }
                    else { const v4u w = bh[mi][bj]; b0 = (f32x4){bflo(w.x), bfhi(w.x), bflo(w.y), bfhi(w.y)}; b1 = (f32x4){bflo(w.z), bfhi(w.z), bflo(w.w), bfhi(w.w)}; }
                    f32x4 a0 = acc[ai][bj][m][0], a1 = acc[ai][bj][m][1];
                    if (bias) { a0 += *(const f32x4*)(bias + c); a1 += *(const f32x4*)(bias + c + 4); }
                    const f32x4 x0 = b0 + *(const f32x4*)(gate + (size_t)b * 6144 + c) * a0, x1 = b1 + *(const f32x4*)(gate + (size_t)b * 6144 + c + 4) * a1;
                    if (OUT_F32) { *(f32x4*)((float*)out + off + 128 * bj) = x0; *(f32x4*)((float*)out + off + 128 * bj + 4) = x1; }
                    else {
                        v4u w; w.x = pk2(x0.x, x0.y); w.y = pk2(x0.z, x0.w); w.z = pk2(x1.x, x1.y); w.w = pk2(x1.z, x1.w);
                        *(v4u*)((bf16*)out + off + 128 * bj) = w;
                        const f32x4 r0 = (f32x4){bflo(w.x), bfhi(w.x), bflo(w.y), bfhi(w.y)}, r1 = (f32x4){bflo(w.z), bfhi(w.z), bflo(w.w), bfhi(w.w)};
                        ss += (r0.x * r0.x + r0.y * r0.y) + (r0.z * r0.z + r0.w * r0.w) + (r1.x * r1.x + r1.y * r1.y) + (r1.z * r1.z + r1.w * r1.w);
                        const f32x4 q0 = r0 * *(const f32x4*)(gn + (size_t)b * 1024 + c), q1 = r1 * *(const f32x4*)(gn + (size_t)b * 1024 + c + 4);
                        v4u ws2; ws2.x = pk2(q0.x, q0.y); ws2.y = pk2(q0.z, q0.w); ws2.z = pk2(q1.x, q1.y); ws2.w = pk2(q1.z, q1.w);
                        *(v4u*)(xs + off + 128 * bj) = ws2;
                    }
                }
                if (!OUT_F32) { ss += __shfl_xor(ss, 16); ss += __shfl_xor(ss, 32); if (fq == 0) hs[rowl * 4 + wc] = ss; }
            }
            asm volatile("" ::: "memory");
        }
        if (!OUT_F32) {
            asm volatile("s_waitcnt lgkmcnt(0)" ::: "memory"); __builtin_amdgcn_s_barrier(); asm volatile("" ::: "memory");
            const int tid = threadIdx.x;
            if (tid < 256) { const f32x4 p = *(const f32x4*)(hs + tid * 4); ssq[(size_t)u.pn * TT + u.pm * 256 + tid] = ((p.x + p.y) + p.z) + p.w; }
        }
    }
};
struct EpiScaleBias {
    static constexpr bool PERM = true;
    bf16* O; int ldc; const float* ssq; int np; const float* bias; int bias_bstride;
    __device__ __forceinline__ void operator()(const f32x4 (&acc)[2][2][4][2], const Unit& u, int wr, int wc, int fr, int fq) const {
        const int b = (u.pm * 256) / SEQ;
        const int col0 = u.pn * 256 + wc * 32 + 8 * fq;
        f32x4 bv[2][2];
#pragma unroll
        for (int bj = 0; bj < 2; ++bj)
#pragma unroll
            for (int n = 0; n < 2; ++n) bv[bj][n] = *(const f32x4*)(bias + (size_t)b * bias_bstride + col0 + 128 * bj + 4 * n);
#pragma unroll
        for (int ai = 0; ai < 2; ++ai)
#pragma unroll
            for (int m = 0; m < 4; ++m) {
                const int row = u.pm * 256 + ai * 128 + wr * 64 + m * 16 + fr;
                const float rs = row_rs(ssq, np, row);
                bf16* rowp = O + (size_t)row * ldc + col0;
#pragma unroll
                for (int bj = 0; bj < 2; ++bj) { const f32x4 v0 = acc[ai][bj][m][0] * rs + bv[bj][0], v1 = acc[ai][bj][m][1] * rs + bv[bj][1];
                    v4u w; w.x = pk2(v0.x, v0.y); w.y = pk2(v0.z, v0.w); w.z = pk2(v1.x, v1.y); w.w = pk2(v1.z, v1.w);
                    *(v4u*)(rowp + 128 * bj) = w; }
            }
    }
};
__device__ __forceinline__ float gelu_as(float v) {
    const float av = fabsf(v), t = __builtin_amdgcn_rcpf(av * 0.2316418882f + 1.0f);
    float q = t * 0.5307027145f + (-0.7265760135f); q = q * t + 0.7107068705f; q = q * t + (-0.142248368f); q = q * t + 0.127414796f; q = q * t;
    const float e = __builtin_amdgcn_exp2f((v * v) * (-0.72134752044f));
    const float m = v * (q * e);
    return v < 0.f ? m : v - m;
}
template <int CTRL> __device__ __forceinline__ float dpp_f(float old, float src) {
    return __builtin_bit_cast(float, __builtin_amdgcn_update_dpp(__builtin_bit_cast(int, old), __builtin_bit_cast(int, src), CTRL, 0xf, 0xf, false));
}
struct EpiUpGlu {
    static constexpr bool PERM = true;
    bf16* act; const float* ssq; int np; const float* bias; const float* cw; const float* cb; float* Hg; float* Ha; float* hl;
    __device__ __forceinline__ void prefetch(const Unit& u) const {
        int tid = threadIdx.x; asm volatile("" : "+v"(tid));
        const int wv = __builtin_amdgcn_readfirstlane(tid >> 6), ln = tid & 63;
        if (wv < 7) {
            const int b = (u.pm * 256) / SEQ, hf = ln >> 5, c4 = u.pn * 128 + (ln & 31) * 4;
            const float* src;
            if (wv == 0) src = bias + (size_t)b * 5632 + hf * FF + c4;
            else if (wv == 1) src = cw + hf * FF + c4;
            else if (wv == 2) src = (hf ? cb : cw + 2 * FF) + c4;
            else src = ssq + (size_t)(wv - 3) * TT + u.pm * 256 + ln * 4;
            __builtin_amdgcn_global_load_lds((const unsigned*)src, (LAS unsigned*)((unsigned char*)hl + (CB_LDS_OFF - RING_BYTES) + wv * 1024), 16, 0, 0);
        }
    }
    __device__ __forceinline__ void operator()(f32x4 (&acc)[2][2][4][2], const Unit& u, int wr, int wc, int fr_, int fq_) const {
        int ln_ = threadIdx.x & 63; asm volatile("" : "+v"(ln_));
        const int fr = ln_ & 15, fq = ln_ >> 4;
        const int j0 = u.pn * 128 + wc * 32 + 8 * fq;
        const float* ct = (const float*)((const unsigned char*)hl + (CB_LDS_OFF - RING_BYTES));
        const int jl = wc * 32 + 8 * fq;
        {
            f32x4 ba[2], bg[2];
#pragma unroll
            for (int n = 0; n < 2; ++n) { ba[n] = *(const f32x4*)(ct + jl + 4 * n); bg[n] = *(const f32x4*)(ct + 128 + jl + 4 * n); }
#pragma unroll
            for (int ai = 0; ai < 2; ++ai)
#pragma unroll
                for (int m = 0; m < 4; ++m) { const int rl_ = ai * 128 + wr * 64 + m * 16 + fr;
                    const float rs = 1.0f / sqrtf((((ct[768 + rl_] + ct[1024 + rl_]) + ct[1280 + rl_]) + ct[1536 + rl_]) * (1.0f / 1024.0f) + EPS);
#pragma unroll
                    for (int n = 0; n < 2; ++n) { acc[ai][0][m][n] = acc[ai][0][m][n] * rs + ba[n]; acc[ai][1][m][n] = acc[ai][1][m][n] * rs + bg[n]; }
                    if (m == 3) asm volatile("" ::: "memory"); }
        }
#pragma unroll
        for (int ai = 0; ai < 2; ++ai) { float* hp = hl + ((2 * ai + wr) * 2) * 128 + wc * 32 + 8 * fq;
            if (fr == 0) { *(f32x4*)(hp) = acc[ai][1][0][0]; *(f32x4*)(hp + 4) = acc[ai][1][0][1]; }
            if (fr == 15) { *(f32x4*)(hp + 128) = acc[ai][1][3][0]; *(f32x4*)(hp + 132) = acc[ai][1][3][1]; } }
        asm volatile("s_waitcnt lgkmcnt(0)" ::: "memory"); __builtin_amdgcn_s_barrier(); asm volatile("" ::: "memory");
        if (wr == 0 && fr < 2) { float* p = Hg + ((size_t)u.pm * 4 + fr) * FF + j0; *(f32x4*)p = acc[0][1][0][0]; *(f32x4*)(p + 4) = acc[0][1][0][1];
            if (fr == 0) { float* q = Ha + ((size_t)u.pm * 2) * FF + j0; *(f32x4*)q = acc[0][0][0][0]; *(f32x4*)(q + 4) = acc[0][0][0][1]; } }
        if (wr == 1 && fr >= 14) { float* p = Hg + ((size_t)u.pm * 4 + 2 + (fr - 14)) * FF + j0; *(f32x4*)p = acc[1][1][3][0]; *(f32x4*)(p + 4) = acc[1][1][3][1];
            if (fr == 15) { float* q = Ha + ((size_t)u.pm * 2 + 1) * FF + j0; *(f32x4*)q = acc[1][0][3][0]; *(f32x4*)(q + 4) = acc[1][0][3][1]; } }
#pragma unroll
        for (int n = 0; n < 2; ++n) {
            const f32x4 w0 = *(const f32x4*)(ct + 256 + jl + 4 * n), w1 = *(const f32x4*)(ct + 384 + jl + 4 * n), w2 = *(const f32x4*)(ct + 512 + jl + 4 * n), cbv = *(const f32x4*)(ct + 640 + jl + 4 * n);
#pragma unroll
            for (int ai = 0; ai < 2; ++ai) {
                const int gi = 2 * ai + wr;
                const f32x4 uph = *(const f32x4*)(hl + (((gi + 3) & 3) * 2 + 1) * 128 + wc * 32 + 8 * fq + 4 * n);
                const f32x4 dnh = *(const f32x4*)(hl + (((gi + 1) & 3) * 2) * 128 + wc * 32 + 8 * fq + 4 * n);
#pragma unroll
                for (int m = 0; m < 4; ++m) {
                    const int rowl = ai * 128 + wr * 64 + m * 16 + fr;
                    f32x4 r;
#pragma unroll
                    for (int e = 0; e < 4; ++e) {
                        const float g = acc[ai][1][m][n][e];
                        const float pu = (m > 0) ? dpp_f<0x121>(g, acc[ai][1][m > 0 ? m - 1 : 0][n][e]) : uph[e];
                        const float up = dpp_f<0x111>(pu, g);
                        const float pd = (m < 3) ? dpp_f<0x12f>(g, acc[ai][1][m < 3 ? m + 1 : 3][n][e]) : dnh[e];
                        const float dn = dpp_f<0x101>(pd, g);
                        const float cv = w0[e] * up + w1[e] * g + w2[e] * dn + cbv[e];
                        r[e] = acc[ai][0][m][n][e] * gelu_as(cv);
                    }
                    if (rowl != 0 && rowl != 255) { v2u w; w.x = pk2(r.x, r.y); w.y = pk2(r.z, r.w); *(v2u*)(act + (size_t)(u.pm * 256 + rowl) * FF + j0 + 4 * n) = w; }
                }
            }
        }
        asm volatile("s_waitcnt lgkmcnt(0)" ::: "memory"); __builtin_amdgcn_s_barrier(); asm volatile("" ::: "memory");
    }
};
__device__ __forceinline__ void glu_fix_tile(Frame& F, int pm, const float* cw, const float* cb) {
    const float* Hg = (const float*)(F.ws + WS_HG); const float* Ha = (const float*)(F.ws + WS_HA); bf16* act = (bf16*)(F.ws + WS_AG);
#pragma unroll 1
    for (int it = 0; it < 3; ++it) {
        const int e = F.tid + 512 * it;
        if (e < 2 * (FF / 4)) {
            const int which = e >= FF / 4 ? 1 : 0, j = (e - which * (FF / 4)) * 4;
            const int t = pm * 256 + (which ? 255 : 0), tl = t % SEQ;
            const int rm = which ? pm * 4 + 2 : max(pm - 1, 0) * 4 + 3, r0 = pm * 4 + (which ? 3 : 0), rp = which ? min(pm + 1, TT / 256 - 1) * 4 : pm * 4 + 1;
            f32x4 gm = *(const f32x4*)(Hg + (size_t)rm * FF + j), gp = *(const f32x4*)(Hg + (size_t)rp * FF + j);
            const f32x4 g0 = *(const f32x4*)(Hg + (size_t)r0 * FF + j), a = *(const f32x4*)(Ha + ((size_t)pm * 2 + which) * FF + j);
            const f32x4 w0 = *(const f32x4*)(cw + j), w1 = *(const f32x4*)(cw + FF + j), w2 = *(const f32x4*)(cw + 2 * FF + j), cbv = *(const f32x4*)(cb + j);
            if (!which && tl == 0) gm = (f32x4){0.f, 0.f, 0.f, 0.f};
            if (which && tl == SEQ - 1) gp = (f32x4){0.f, 0.f, 0.f, 0.f};
            const f32x4 cv = w0 * gm + w1 * g0 + w2 * gp + cbv;
            v2u w; w.x = pk2(a.x * gelu_as(cv.x), a.y * gelu_as(cv.y)); w.y = pk2(a.z * gelu_as(cv.z), a.w * gelu_as(cv.w));
            *(v2u*)(act + (size_t)t * FF + j) = w;
        }
    }
}
__device__ __forceinline__ void glu_fix_phase(Frame& F, const float* cw, const float* cb) {
    const float* Hg = (const float*)(F.ws + WS_HG); const float* Ha = (const float*)(F.ws + WS_HA); bf16* act = (bf16*)(F.ws + WS_AG);
    const int total = (TT / 256) * 2 * FF;
    for (int e = F.vcu * 512 + F.tid; e < total; e += F.G * 512) {
        const int j = e % FF, which = (e / FF) & 1, pm = e / (2 * FF);
        const int t = pm * 256 + (which ? 255 : 0), tl = t % SEQ;
        float gm, g0, gp;
        if (which == 0) { gm = (tl == 0) ? 0.f : Hg[((size_t)(pm - 1) * 4 + 3) * FF + j]; g0 = Hg[((size_t)pm * 4 + 0) * FF + j]; gp = Hg[((size_t)pm * 4 + 1) * FF + j]; }
        else { gm = Hg[((size_t)pm * 4 + 2) * FF + j]; g0 = Hg[((size_t)pm * 4 + 3) * FF + j]; gp = (tl == SEQ - 1) ? 0.f : Hg[((size_t)(pm + 1) * 4 + 0) * FF + j]; }
        const float a = Ha[((size_t)pm * 2 + which) * FF + j];
        const float cv = cw[j] * gm + cw[FF + j] * g0 + cw[2 * FF + j] * gp + cb[j];
        act[(size_t)t * FF + j] = (bf16)f2bf(a * gelu_as(cv));
    }
}
struct EpiNull {
    static constexpr bool PERM = true;
    float* sink;
    __device__ __forceinline__ void operator()(const f32x4 (&acc)[2][2][4][2], const Unit& u, int wr, int wc, int fr, int fq) const {
        f32x4 s = {0.f, 0.f, 0.f, 0.f};
#pragma unroll
        for (int ai = 0; ai < 2; ++ai)
#pragma unroll
            for (int bj = 0; bj < 2; ++bj)
#pragma unroll
                for (int m = 0; m < 4; ++m)
#pragma unroll
                    for (int n = 0; n < 2; ++n) s += acc[ai][bj][m][n];
        if (u.pm == 100000) *(f32x4*)(sink + fr) = s;
    }
};
struct EpiInT {
    static constexpr bool PERM = true;
    bf16* UT; const float* ssq; int np; const float* bias;
    __device__ __forceinline__ void operator()(const f32x4 (&acc)[2][2][4][2], const Unit& u, int wr, int wc, int fr, int fq) const {
        const int b = (u.pm * 256) / SEQ;
        const int col0 = u.pn * 256 + wc * 32 + 8 * fq;
        const int odd = fr & 1;
        f32x4 bv[2][2];
#pragma unroll
        for (int bj = 0; bj < 2; ++bj)
#pragma unroll
            for (int n = 0; n < 2; ++n) bv[bj][n] = *(const f32x4*)(bias + (size_t)b * 3072 + col0 + 128 * bj + 4 * n);
#pragma unroll
        for (int ai = 0; ai < 2; ++ai)
#pragma unroll
            for (int m = 0; m < 4; ++m) {
                const int row = u.pm * 256 + ai * 128 + wr * 64 + m * 16 + fr;
                const int t = row - b * SEQ;
                const float rs = row_rs(ssq, np, row);
#pragma unroll
                for (int bj = 0; bj < 2; ++bj)
#pragma unroll
                    for (int n = 0; n < 2; ++n) { const f32x4 v = acc[ai][bj][m][n] * rs + bv[bj][n];
                        const unsigned w01 = pk2(v.x, v.y), w23 = pk2(v.z, v.w);
                        const unsigned p01 = (unsigned)__shfl_xor((int)w01, 1), p23 = (unsigned)__shfl_xor((int)w23, 1);
                        const unsigned o0 = odd ? ((w01 & 0xffff0000u) | (p01 >> 16)) : ((p01 << 16) | (w01 & 0xffffu));
                        const unsigned o1 = odd ? ((w23 & 0xffff0000u) | (p23 >> 16)) : ((p23 << 16) | (w23 & 0xffffu));
                        bf16* p = UT + ((size_t)b * 3072 + col0 + 128 * bj + 4 * n + odd) * SEQ + (t & ~1);
                        *(unsigned*)p = o0; *(unsigned*)(p + 2 * (size_t)SEQ) = o1; }
            }
    }
};

struct EpiCtxKV {
    static constexpr bool PERM = true;
    EpiQK<1> ek; EpiVT ev;
    __device__ __forceinline__ void operator()(const f32x4 (&acc)[2][2][4][2], const Unit& u, int wr, int wc, int fr, int fq) const {
        if (u.pn < 4) ek(acc, u, wr, wc, fr, fq);
        else { Unit v = u; v.pn = u.pn - 4; ev(acc, v, wr, wc, fr, fq); }
    }
};

typedef short bf16x8 __attribute__((ext_vector_type(8)));
typedef float f32x16 __attribute__((ext_vector_type(16)));
typedef short s16x4 __attribute__((ext_vector_type(4)));
__device__ __forceinline__ unsigned cvtpk(float lo, float hi) { typedef float f2 __attribute__((ext_vector_type(2))); typedef __bf16 b2 __attribute__((ext_vector_type(2)));
    f2 v = {lo, hi}; b2 r = __builtin_convertvector(v, b2); return __builtin_bit_cast(unsigned, r); }
constexpr int BT_OFF = 64, BT_HEAD = 15 * 31;
__device__ __forceinline__ void attn_mfma_phase(Frame& F) {
    const bf16* Q = (const bf16*)(F.ws + WS_Q); const bf16* Kb = (const bf16*)(F.ws + WS_K); const bf16* VT = (const bf16*)(F.ws + WS_V);
    const bf16* Kc = (const bf16*)(F.ws + WS_KC); const bf16* VcT = (const bf16*)(F.ws + WS_VC);
    bf16* O = (bf16*)(F.ws + WS_O);
    const float* rpb = F.in[11];
    constexpr int AL_KC = 15 * 8192, AL_BT = AL_KC + 32768;
    const unsigned char* lk = (const unsigned char*)F.lds;
    float* bt = (float*)(F.lds + AL_BT);
    int th = -1;
    const int lane = F.lane, q = lane & 31, hi = lane >> 5;
    for (int g = F.vcu; g < NB * (GROWS / 8) * NH; g += F.G) {
        const int rg = g & 15, h = (g >> 4) & 15, b = g >> 8;
        const int r = rg * 8 + F.wave;
        const int r0 = min(max(r - WH / 2, 0), GROWS - WH);
        const int U0 = min(max(rg * 8 - WH / 2, 0), GROWS - WH), Ue = min(max(rg * 8 + 7 - WH / 2, 0), GROWS - WH) + WH;
        __syncthreads();
        if (h != th) { for (int e = F.tid; e < BT_HEAD; e += 512) bt[BT_OFF + e] = rpb[h * BT_HEAD + e] * 1.4426950408889634f; th = h; }
        {
            int tv = F.tid; FC_OPAQUE(tv);
            const bf16* ksrc = Kb + ((size_t)(b * NH + h) * (SEQ / 16) + (size_t)U0 * 4) * (8 * 16 * 8) + tv * 8;
            const bf16* csrc = Kc + ((size_t)(b * NH + h) * (CTXL / 16)) * (8 * 16 * 8) + tv * 8;
            const int nrow = Ue - U0;
#pragma unroll 1
            for (int rr0 = 0; rr0 < nrow + 4; rr0 += 4) {
                v4u x[4];
#pragma unroll
                for (int k = 0; k < 4; ++k) { const int rr = rr0 + k; if (rr < nrow + 4) x[k] = (rr < nrow) ? *(const v4u*)(ksrc + (size_t)rr * 4096) : *(const v4u*)(csrc + (size_t)(rr - nrow) * 4096); }
#pragma unroll
                for (int k = 0; k < 4; ++k) { const int rr = rr0 + k; if (rr < nrow + 4) *(v4u*)(F.lds + (rr < nrow ? rr * 8192 : AL_KC + (rr - nrow) * 8192) + tv * 16) = x[k]; }
            }
            asm volatile("" ::: "memory");
        }
        __syncthreads();
        const size_t tok = (size_t)b * SEQ + r * GW + q;
        bf16x8 qf[2][4];
#pragma unroll
        for (int hf = 0; hf < 2; ++hf)
#pragma unroll
            for (int s4 = 0; s4 < 4; ++s4) qf[hf][s4] = *(const bf16x8*)(Q + (tok + 32 * hf) * DM + h * HD + 16 * s4 + 8 * hi);
        const f32x16 zero16 = {0.f, 0.f, 0.f, 0.f, 0.f, 0.f, 0.f, 0.f, 0.f, 0.f, 0.f, 0.f, 0.f, 0.f, 0.f, 0.f};
        f32x16 o[2][2] = {{zero16, zero16}, {zero16, zero16}};
        float lsum[2] = {0.f, 0.f};
#define ATT_LOAD(i, kf, va) do { \
            const bf16* kp_; const bf16* vp_; int sstr_; \
            if ((i) < 16) { const int rp_ = (i) >> 2, cb_ = (i) & 3, krow_ = r0 + 2 * rp_; \
                kp_ = (const bf16*)(lk + (krow_ + (q >> 4) - U0) * 8192 + cb_ * 2048 + hi * 256 + (q & 15) * 16); \
                vp_ = VT + (((size_t)(b * NH + h) * (SEQ / 16) + krow_ * 4 + cb_) * 64 + q) * 16 + 8 * hi; sstr_ = 4 * 64 * 16; } \
            else { const int j_ = (i) - 16; \
                kp_ = (const bf16*)(lk + AL_KC + (2 * j_ + (q >> 4)) * 2048 + hi * 256 + (q & 15) * 16); \
                vp_ = VcT + (((size_t)(b * NH + h) * (CTXL / 16) + 2 * j_) * 64 + q) * 16 + 8 * hi; sstr_ = 64 * 16; } \
            _Pragma("unroll") for (int s4 = 0; s4 < 4; ++s4) kf[s4] = *(const bf16x8*)(kp_ + s4 * (2 * 16 * 8)); \
            _Pragma("unroll") for (int dh = 0; dh < 2; ++dh) _Pragma("unroll") for (int s2 = 0; s2 < 2; ++s2) { const bf16* v_ = vp_ + dh * (32 * 16) + s2 * sstr_; \
                va[dh][s2] = *(const bf16x8*)v_; } } while (0)
#define ATT_HALF(i, kf, va, HF) do { \
            f32x16 sacc = zero16; \
            _Pragma("unroll") for (int s4 = 0; s4 < 4; ++s4) sacc = __builtin_amdgcn_mfma_f32_32x32x16_bf16(kf[s4], qf[HF][s4], sacc, 0, 0, 0); \
            float p[16]; \
            if ((i) < 16) { const int rp_ = (i) >> 2, cb_ = (i) & 3, krow_ = r0 + 2 * rp_; \
                const int c_ = 32 * HF + q, c0_ = min(max(c_ - WW / 2, 0), GW - WW), lo_ = c0_ - c_ + (WW - 1); \
                const int dcb = cb_ * 16 + 4 * hi - c_ + (WW - 1), dcl = dcb - lo_; \
                const float* btp = bt + BT_OFF + (krow_ - r + (WH - 1)) * 31 + dcb; \
                _Pragma("unroll") for (int rr = 0; rr < 16; ++rr) { const int kc = (rr & 3) + 8 * ((rr >> 2) & 1); \
                    const float e_ = __builtin_amdgcn_exp2f(sacc[rr] + btp[(rr >> 3) * 31 + kc]); \
                    p[rr] = ((unsigned)(dcl + kc) < (unsigned)WW) ? e_ : 0.f; lsum[HF] += p[rr]; } } \
            else { _Pragma("unroll") for (int rr = 0; rr < 16; ++rr) { p[rr] = __builtin_amdgcn_exp2f(sacc[rr]); lsum[HF] += p[rr]; } } \
            unsigned pw[8]; \
            _Pragma("unroll") for (int ii = 0; ii < 8; ++ii) pw[ii] = cvtpk(p[2 * ii], p[2 * ii + 1]); \
            _Pragma("unroll") for (int s2 = 0; s2 < 2; ++s2) { \
                const bf16x8 pb = __builtin_bit_cast(bf16x8, (v4u){pw[4 * s2], pw[4 * s2 + 1], pw[4 * s2 + 2], pw[4 * s2 + 3]}); \
                o[HF][0] = __builtin_amdgcn_mfma_f32_32x32x16_bf16(va[0][s2], pb, o[HF][0], 0, 0, 0); \
                o[HF][1] = __builtin_amdgcn_mfma_f32_32x32x16_bf16(va[1][s2], pb, o[HF][1], 0, 0, 0); } } while (0)
#define ATT_COMPUTE(i, kf, va) do { const int cbq_ = ((i) < 16) ? ((i) & 3) : 1; \
            if (cbq_ != 3) ATT_HALF(i, kf, va, 0); \
            if (cbq_ != 0) ATT_HALF(i, kf, va, 1); } while (0)
        bf16x8 kfA[4], kfB[4], vaA[2][2], vaB[2][2];
        ATT_LOAD(0, kfA, vaA);
#pragma unroll 1
        for (int i = 0; i < 24; i += 2) {
            ATT_LOAD(i + 1, kfB, vaB);
            ATT_COMPUTE(i, kfA, vaA);
            { const int i2 = (i + 2 < 24) ? i + 2 : 23; ATT_LOAD(i2, kfA, vaA); }
            ATT_COMPUTE(i + 1, kfB, vaB);
        }
#undef ATT_LOAD
#undef ATT_HALF
#undef ATT_COMPUTE
#pragma unroll
        for (int hf = 0; hf < 2; ++hf) {
            float l = lsum[hf]; l += __shfl_xor(l, 32);
            const float inv = 1.0f / l;
            bf16* op = O + (tok + 32 * hf) * DM + h * HD + 4 * hi;
#pragma unroll
            for (int gq = 0; gq < 4; ++gq) {
                v2u w0; w0.x = pk2(o[hf][0][4 * gq] * inv, o[hf][0][4 * gq + 1] * inv); w0.y = pk2(o[hf][0][4 * gq + 2] * inv, o[hf][0][4 * gq + 3] * inv);
                v2u w1; w1.x = pk2(o[hf][1][4 * gq] * inv, o[hf][1][4 * gq + 1] * inv); w1.y = pk2(o[hf][1][4 * gq + 2] * inv, o[hf][1][4 * gq + 3] * inv);
                *(v2u*)(op + 8 * gq) = w0; *(v2u*)(op + 32 + 8 * gq) = w1;
            }
        }
    }
    __syncthreads();
}

__device__ __forceinline__ void convglu_phase(Frame& F, const float* cw, const float* cb) {
    bf16* ag = (bf16*)(F.ws + WS_AG);
    const long nvec = (long)TT * (FF / 8);
    for (long e = (long)F.vcu * 512 + F.tid; e < nvec; e += (long)F.G * 512) {
        const int t = (int)(e / (FF / 8)), j0 = (int)(e % (FF / 8)) * 8;
        const int tl = t % SEQ;
        const bf16* rowp = ag + (size_t)t * (2 * FF);
        const v4u a = *(const v4u*)(rowp + j0);
        const v4u g0 = *(const v4u*)(rowp + FF + j0);
        v4u gm = (v4u){0u, 0u, 0u, 0u}, gp = (v4u){0u, 0u, 0u, 0u};
        if (tl > 0) gm = *(const v4u*)(rowp - 2 * FF + FF + j0);
        if (tl < SEQ - 1) gp = *(const v4u*)(rowp + 2 * FF + FF + j0);
        float av[8], g0v[8], gmv[8], gpv[8];
        av[0] = bflo(a.x); av[1] = bfhi(a.x); av[2] = bflo(a.y); av[3] = bfhi(a.y); av[4] = bflo(a.z); av[5] = bfhi(a.z); av[6] = bflo(a.w); av[7] = bfhi(a.w);
        g0v[0] = bflo(g0.x); g0v[1] = bfhi(g0.x); g0v[2] = bflo(g0.y); g0v[3] = bfhi(g0.y); g0v[4] = bflo(g0.z); g0v[5] = bfhi(g0.z); g0v[6] = bflo(g0.w); g0v[7] = bfhi(g0.w);
        gmv[0] = bflo(gm.x); gmv[1] = bfhi(gm.x); gmv[2] = bflo(gm.y); gmv[3] = bfhi(gm.y); gmv[4] = bflo(gm.z); gmv[5] = bfhi(gm.z); gmv[6] = bflo(gm.w); gmv[7] = bfhi(gm.w);
        gpv[0] = bflo(gp.x); gpv[1] = bfhi(gp.x); gpv[2] = bflo(gp.y); gpv[3] = bfhi(gp.y); gpv[4] = bflo(gp.z); gpv[5] = bfhi(gp.z); gpv[6] = bflo(gp.w); gpv[7] = bfhi(gp.w);
        float r[8];
#pragma unroll
        for (int i = 0; i < 8; ++i) { const int j = j0 + i; const float cv = cw[j] * gmv[i] + cw[FF + j] * g0v[i] + cw[2 * FF + j] * gpv[i] + cb[j]; r[i] = av[i] * gelu_f(cv); }
        v4u w; w.x = pk2(r[0], r[1]); w.y = pk2(r[2], r[3]); w.z = pk2(r[4], r[5]); w.w = pk2(r[6], r[7]);
        *(v4u*)(ag + (size_t)t * (2 * FF) + j0) = w;
    }
}

__device__ __forceinline__ void filtgen_phase(Frame& F) {
    const float* const* in = F.in;
    const float *w1 = in[25], *b1 = in[26], *w2 = in[27], *b2 = in[28], *w3 = in[29], *b3 = in[30], *freq = in[32];
    const float* __restrict__ wout = in[31];
    float* __restrict__ hT = (float*)(F.ws + WS_HT); float* __restrict__ fsqp = (float*)(F.ws + WS_FSQP);
    LAS float* zf = (LAS float*)(F.lds);
    LAS float* ha = zf + 32 * 36;
    LAS float* hb = ha + 32 * 64;
    const int tid = F.tid;
    for (int item = F.vcu; item < SEQ / 32; item += F.G) {
        const int l0 = item * 32;
        const float bj1 = b1[tid & 63], bj2 = b2[tid & 63], bj3 = b3[tid & 63], fj = freq[tid & 63];
        __syncthreads();
        for (int e = tid; e < 32 * 33; e += 512) {
            const int p = e / 33, i = e % 33, l = l0 + p;
            float v;
            if (i == 0) v = (float)l / 8191.0f;
            else { const int bi = (i - 1) & 15; const float band = 1e-4f + (float)bi * ((15.0f - 1e-4f) / 15.0f);
                const float w = (float)(2.0 * 3.14159265358979323846 / 8192.0) * (float)l; const float arg = band * w;
                v = (i <= 16) ? cosf(arg) : -sinf(arg); }
            zf[p * 36 + i] = v;
        }
        __syncthreads();
        { const int j = tid & 63, p = tid >> 6; float a[4] = {bj1, bj1, bj1, bj1};
#pragma unroll 11
          for (int i = 0; i < 33; ++i) { const float w = w1[i * 64 + j];
#pragma unroll
            for (int k = 0; k < 4; ++k) a[k] += zf[(p + 8 * k) * 36 + i] * w; }
#pragma unroll
          for (int k = 0; k < 4; ++k) ha[(p + 8 * k) * 64 + j] = sinf(fj * a[k]); }
        __syncthreads();
        { const int j = tid & 63, p = tid >> 6; float a[4] = {bj2, bj2, bj2, bj2};
#pragma unroll 16
          for (int i = 0; i < 64; ++i) { const float w = w2[i * 64 + j];
#pragma unroll
            for (int k = 0; k < 4; ++k) a[k] += ha[(p + 8 * k) * 64 + i] * w; }
#pragma unroll
          for (int k = 0; k < 4; ++k) hb[(p + 8 * k) * 64 + j] = sinf(fj * a[k]); }
        __syncthreads();
        { const int j = tid & 63, p = tid >> 6; float a[4] = {bj3, bj3, bj3, bj3};
#pragma unroll 16
          for (int i = 0; i < 64; ++i) { const float w = w3[i * 64 + j];
#pragma unroll
            for (int k = 0; k < 4; ++k) a[k] += hb[(p + 8 * k) * 64 + i] * w; }
#pragma unroll
          for (int k = 0; k < 4; ++k) ha[(p + 8 * k) * 64 + j] = sinf(fj * a[k]); }
        __syncthreads();
        {
            const int lane = F.lane, li = lane & 15, lk = lane >> 4;
            float av[2][16];
#pragma unroll
            for (int mt = 0; mt < 2; ++mt)
#pragma unroll
                for (int st = 0; st < 16; ++st) av[mt][st] = ha[(16 * mt + li) * 64 + 4 * st + lk];
            const float la = -15.350567286626973f, lb = -3.0701134573253946f;
#pragma unroll 1
            for (int nt = 0; nt < 16; nt += 2) {
                const int n0 = F.wave * 256 + nt * 16 + li;
                const float* wp = wout + (size_t)lk * 2048 + n0;
                float bv0[16], bv1[16];
#pragma unroll
                for (int st = 0; st < 16; ++st) { bv0[st] = wp[(size_t)st * 4 * 2048]; bv1[st] = wp[(size_t)st * 4 * 2048 + 16]; }
                f32x4 acc[2][2];
#pragma unroll
                for (int t2 = 0; t2 < 2; ++t2) { acc[t2][0] = (f32x4){0.f, 0.f, 0.f, 0.f}; acc[t2][1] = acc[t2][0]; }
#pragma unroll
                for (int st = 0; st < 16; ++st) {
                    acc[0][0] = __builtin_amdgcn_mfma_f32_16x16x4f32(av[0][st], bv0[st], acc[0][0], 0, 0, 0); acc[0][1] = __builtin_amdgcn_mfma_f32_16x16x4f32(av[1][st], bv0[st], acc[0][1], 0, 0, 0);
                    acc[1][0] = __builtin_amdgcn_mfma_f32_16x16x4f32(av[0][st], bv1[st], acc[1][0], 0, 0, 0); acc[1][1] = __builtin_amdgcn_mfma_f32_16x16x4f32(av[1][st], bv1[st], acc[1][1], 0, 0, 0); }
#pragma unroll
                for (int t2 = 0; t2 < 2; ++t2) {
                    const int n = n0 + 16 * t2;
                    const int dir = n >> 10, c = n & 1023;
                    const float delta = fabsf(la + (float)c * ((lb - la) / 1023.0f)) * 1.4426950408889634f;
                    float sq = 0.f;
#pragma unroll
                    for (int mt = 0; mt < 2; ++mt) { f32x4 ov; const f32x4 ac = acc[t2][mt];
#pragma unroll
                        for (int r = 0; r < 4; ++r) { const float tpos = (float)(l0 + 16 * mt + 4 * lk + r) / 8191.0f; const float v = ac[r] * __builtin_amdgcn_exp2f(-tpos * delta); ov[r] = v; sq += v * v; }
                        *(f32x4*)(hT + ((size_t)dir * 1024 + c) * SEQ + l0 + 16 * mt + 4 * lk) = ov; }
                    sq += __shfl_xor(sq, 16); sq += __shfl_xor(sq, 32);
                    if (lk == 0) fsqp[(size_t)item * 2048 + n] = sq;
                }
            }
        }
    }
    __syncthreads();
}

constexpr int F2_AO = 67584, F2_TW = 135168, F2_RED = 140 * 1024, F2_PF = 144 * 1024, F2_TN = 146 * 1024;
__device__ __forceinline__ void f2_load_tw(Frame& F, const cf* TWM, const cf* TWN) {
    cf* tw1 = (cf*)(F.lds + F2_TW);
    for (int e = F.tid; e < 544; e += 512) tw1[e] = e < 512 ? TWM[e] : TWM[16 * (e - 512)];
    ((cf*)(F.lds + F2_TN))[F.tid] = TWN[F.tid];
    __syncthreads();
}
__device__ __forceinline__ cf tn_pow(cf base, int r) {
    const float c[16] = {1.0f, 0.98078528040323043f, 0.92387953251128674f, 0.83146961230254524f, 0.70710678118654752f, 0.55557023301960218f, 0.38268343236508977f, 0.19509032201612825f,
                         0.0f, -0.19509032201612825f, -0.38268343236508977f, -0.55557023301960218f, -0.70710678118654752f, -0.83146961230254524f, -0.92387953251128674f, -0.98078528040323043f};
    const float sn[16] = {0.0f, 0.19509032201612825f, 0.38268343236508977f, 0.55557023301960218f, 0.70710678118654752f, 0.83146961230254524f, 0.92387953251128674f, 0.98078528040323043f,
                          1.0f, 0.98078528040323043f, 0.92387953251128674f, 0.83146961230254524f, 0.70710678118654752f, 0.55557023301960218f, 0.38268343236508977f, 0.19509032201612825f};
    if (r == 0) return base;
    if (r == 8) return cmulnegi(base);
    cf w; w.x = c[r]; w.y = -sn[r]; return cmul(base, w);
}
__device__ __forceinline__ void filtfft_phase(Frame& F) {
    const float* hT = (const float*)(F.ws + WS_HT); const float* fsqp = (const float*)(F.ws + WS_FSQP);
    const cf* TWM = (const cf*)(F.ws + SM_TWM); const cf* TWN = (const cf*)(F.ws + SM_TWN);
    cf* Fsp = (cf*)(F.ws + WS_F);
    cf* aE = (cf*)F.lds; cf* aO = (cf*)(F.lds + F2_AO);
    const cf* tw1 = (const cf*)(F.lds + F2_TW); const cf* tw32 = tw1 + 512;
    float* red = (float*)(F.lds + F2_RED);
    f2_load_tw(F, TWM, TWN);
    for (int c = F.vcu; c < DM; c += F.G) {
        int tid = F.tid; FC_OPAQUE(tid);
        __syncthreads();
        red[tid] = (tid < SEQ / 32) ? fsqp[(size_t)tid * 2048 + c] + fsqp[(size_t)tid * 2048 + 1024 + c] : 0.f;
        __syncthreads();
        for (int st = 256; st > 0; st >>= 1) { if (tid < st) red[tid] += red[tid + st]; __syncthreads(); }
        const float nrm = 1.0f / sqrtf(red[0] + EPS);
        const float* hf = hT + (size_t)c * SEQ; const float* hb = hT + ((size_t)1024 + c) * SEQ;
        if (c + F.G < DM) { const float* pr = hT + ((size_t)(tid >> 8) * 1024 + c + F.G) * SEQ + (size_t)(tid & 255) * 32;
            __builtin_amdgcn_global_load_lds((const unsigned*)pr, (LAS unsigned*)(F.lds + F2_PF + F.wave * 256), 4, 0, 0); }
        {
            cf v[16], w[16];
            const cf tnb = ((const cf*)(F.lds + F2_TN))[tid];
#pragma unroll
            for (int r = 0; r < 16; ++r) { const int n = tid + 512 * r; const float hbv = hb[SEQ - max(n, 1)];
                const float fa = hf[n] * nrm, fb = (n == 0) ? 0.f : hbv * nrm;
                v[r].x = fa + fb; v[r].y = 0.f; const cf tnr = tn_pow(tnb, r); w[r].x = (fa - fb) * tnr.x; w[r].y = (fa - fb) * tnr.y; }
            f2_fwd_p1(v, tid, aE, tw1);
            f2_fwd_p1(w, tid, aO, tw1);
        }
        __syncthreads();
        f2_fwd_p2_dual(tid, aE, aO, tw32);
        __syncthreads();
        { const int path = tid >> 8, bf = tid & 255;
          f2_mid_store16(bf, path ? aO : aE, (v2u*)Fsp + ((size_t)c * 2 + path) * (FC_M / 2)); }
    }
    __syncthreads();
}

__device__ __forceinline__ void conv3_8(const v4u raw, float prev, float next, float w0, float w1, float w2, float bb, float* out) {
    float x[10]; x[0] = prev; x[9] = next;
    x[1] = bflo(raw.x); x[2] = bfhi(raw.x); x[3] = bflo(raw.y); x[4] = bfhi(raw.y); x[5] = bflo(raw.z); x[6] = bfhi(raw.z); x[7] = bflo(raw.w); x[8] = bfhi(raw.w);
#pragma unroll
    for (int i = 0; i < 8; ++i) out[i] = w0 * x[i] + w1 * x[i + 1] + w2 * x[i + 2] + bb;
}
#ifdef PROBE_SEC
#define SEC_MARK(k) do { const unsigned long long t_ = __builtin_amdgcn_s_memrealtime(); if ((k) > 0 && (k) - 1 == PROBE_SEC) F.sec += t_ - sec_t0; sec_t0 = t_; } while (0)
#else
#define SEC_MARK(k) do { } while (0)
#endif
__device__ __forceinline__ void hyena_fft_phase(Frame& F) {
#ifdef PROBE_SEC
    unsigned long long sec_t0 = 0;
#endif
    const float* const* in = F.in;
    const float* sw = in[23]; const float* sb = in[24]; const float* dbias = in[33];
    const bf16* UT = (const bf16*)(F.ws + WS_UT);
    const cf* TWM = (const cf*)(F.ws + SM_TWM); const cf* TWN = (const cf*)(F.ws + SM_TWN);
    const cf* Fsp = (const cf*)(F.ws + WS_F);
    cf* aE = (cf*)F.lds; cf* aO = (cf*)(F.lds + F2_AO);
    const cf* tw1 = (const cf*)(F.lds + F2_TW); const cf* tw32 = tw1 + 512;
    f2_load_tw(F, TWM, TWN);
    for (int unit = F.vcu; unit < 2 * DM; unit += F.G) {
        const int c = unit >> 1, b0 = (unit & 1) * 2;
        int tid = F.tid; FC_OPAQUE(tid);
        SEC_MARK(0);
        __syncthreads();
        {
            const float w10 = sw[1024 + c], w11 = sw[3072 + 1024 + c], w12 = sw[6144 + 1024 + c], bb1 = sb[1024 + c];
            const float wv0 = sw[2048 + c], wv1 = sw[3072 + 2048 + c], wv2 = sw[6144 + 2048 + c], bbv = sb[2048 + c];
            v4u x1raw[2][2], vraw[2][2]; unsigned short hh[2][2][4];
            FC_OPAQUE(tid);
#pragma unroll
            for (int h = 0; h < 2; ++h) {
                const int t0 = (tid + 512 * h) * 8;
                const int ipv = max(t0 - 1, 0), inx = min(t0 + 8, SEQ - 1);
#pragma unroll
                for (int bb = 0; bb < 2; ++bb) {
                    const bf16* x1r = UT + ((size_t)(b0 + bb) * 3072 + 1024 + c) * SEQ;
                    const bf16* vr = UT + ((size_t)(b0 + bb) * 3072 + 2048 + c) * SEQ;
                    x1raw[h][bb] = *(const v4u*)(x1r + t0); vraw[h][bb] = *(const v4u*)(vr + t0);
                    hh[h][bb][0] = x1r[ipv]; hh[h][bb][1] = x1r[inx]; hh[h][bb][2] = vr[ipv]; hh[h][bb][3] = vr[inx];
                }
            }
#pragma unroll
            for (int h = 0; h < 2; ++h) {
                const int t0 = (tid + 512 * h) * 8;
                float z[2][8];
#pragma unroll
                for (int bb = 0; bb < 2; ++bb) {
                    const float x1p = t0 > 0 ? bf2f(hh[h][bb][0]) : 0.f, x1n = t0 + 8 < SEQ ? bf2f(hh[h][bb][1]) : 0.f;
                    const float vp = t0 > 0 ? bf2f(hh[h][bb][2]) : 0.f, vn = t0 + 8 < SEQ ? bf2f(hh[h][bb][3]) : 0.f;
                    float x1c[8], vc[8];
                    conv3_8(x1raw[h][bb], x1p, x1n, w10, w11, w12, bb1, x1c);
                    conv3_8(vraw[h][bb], vp, vn, wv0, wv1, wv2, bbv, vc);
#pragma unroll
                    for (int i = 0; i < 8; ++i) z[bb][i] = x1c[i] * vc[i];
                }
                const int pb = F2_PIDX(t0);
#pragma unroll
                for (int i = 0; i < 8; ++i) { cf t; t.x = z[0][i]; t.y = z[1][i]; aE[pb + i] = t; }
            }
        }
        __syncthreads();
        SEC_MARK(1);
        cf wreg[16];
        FC_OPAQUE(tid);
        { const int pt = F2_PIDX(tid);
#pragma unroll
          for (int r = 0; r < 16; ++r) wreg[r] = aE[pt + 528 * r]; }
        const int path = tid >> 8, bf = tid & 255;
        const cf tnb = ((const cf*)(F.lds + F2_TN))[tid];
        cf tn[16];
#pragma unroll
        for (int r = 0; r < 16; ++r) tn[r] = tn_pow(tnb, r);
        {
            cf v[16];
#pragma unroll
            for (int r = 0; r < 16; ++r) v[r] = cmul(wreg[r], tn[r]);
            f2_fwd_p1(v, tid, aO, tw1);
            FC_OPAQUE(tid);
#pragma unroll
            for (int r = 0; r < 16; ++r) v[r] = wreg[r];
            f2_fwd_p1(v, tid, aE, tw1);
        }
        __syncthreads();
        SEC_MARK(2);
        f2_fwd_p2_dual(tid, aE, aO, tw32);
        __syncthreads();
        SEC_MARK(3);
        v2u freg[16];
        { const v2u* fp = (const v2u*)Fsp + ((size_t)c * 2 + path) * (FC_M / 2) + bf;
#pragma unroll
          for (int i = 0; i < 16; ++i) freg[i] = fp[i * 256]; }
        f2_mid16(bf, path ? aO : aE, freg);
        __syncthreads();
        SEC_MARK(4);
        if (tid < 256) { const bf16* pr = UT + ((size_t)(b0 + (tid >> 7)) * 3072 + c) * SEQ + (size_t)(tid & 127) * 64;
            __builtin_amdgcn_global_load_lds((const unsigned*)pr, (LAS unsigned*)(F.lds + F2_PF + F.wave * 256), 4, 0, 0); }
        if (unit + F.G < 2 * DM) { const int nu = unit + F.G, nc = nu >> 1, nb = (nu & 1) * 2 + (tid >> 8), wh = 1 + ((tid >> 7) & 1);
            const bf16* pr = UT + ((size_t)nb * 3072 + wh * 1024 + nc) * SEQ + (size_t)(tid & 127) * 64;
            __builtin_amdgcn_global_load_lds((const unsigned*)pr, (LAS unsigned*)(F.lds + F2_PF + F.wave * 256), 4, 0, 0); }
        f2_inv_p2_dual(tid, aE, aO, tw32);
        __syncthreads();
        SEC_MARK(5);
        {
            cf ve[16], vo[16];
            f2_inv_p1(ve, tid, aE, tw1);
            f2_inv_p1(vo, tid, aO, tw1);
            const float db = dbias[c];
            FC_OPAQUE(tid);
            const int pt = F2_PIDX(tid);
            const cf tnb2 = ((const cf*)(F.lds + F2_TN))[tid];
#pragma unroll
            for (int r = 0; r < 16; ++r) { const int n = tid + 512 * r;
                const cf y = cadd(cconj(ve[r]), cmul(cconj(tn_pow(tnb2, r)), cconj(vo[r])));
                cf o; o.x = y.x * (1.0f / 16384.0f) + wreg[r].x * db; o.y = y.y * (1.0f / 16384.0f) + wreg[r].y * db; aE[pt + 528 * r] = o; }
        }
        __syncthreads();
        SEC_MARK(6);
        {
            const float w00 = sw[c], w01 = sw[3072 + c], w02 = sw[6144 + c], bb0 = sb[c];
            v4u xraw[2][2]; unsigned short hx[2][2][2];
            FC_OPAQUE(tid);
#pragma unroll
            for (int h = 0; h < 2; ++h) {
                const int t0 = (tid + 512 * h) * 8;
#pragma unroll
                for (int bb = 0; bb < 2; ++bb) { const bf16* x0r = UT + ((size_t)(b0 + bb) * 3072 + c) * SEQ;
                    xraw[h][bb] = *(const v4u*)(x0r + t0); hx[h][bb][0] = x0r[max(t0 - 1, 0)]; hx[h][bb][1] = x0r[min(t0 + 8, SEQ - 1)]; }
            }
#pragma unroll
            for (int h = 0; h < 2; ++h) {
                const int t0 = (tid + 512 * h) * 8;
                cf val[8];
                const int pb = F2_PIDX(t0);
#pragma unroll
                for (int i = 0; i < 8; ++i) val[i] = aE[pb + i];
#pragma unroll
                for (int bb = 0; bb < 2; ++bb) {
                    const float xp = t0 > 0 ? bf2f(hx[h][bb][0]) : 0.f, xn = t0 + 8 < SEQ ? bf2f(hx[h][bb][1]) : 0.f;
                    float x0c[8]; conv3_8(xraw[h][bb], xp, xn, w00, w01, w02, bb0, x0c);
                    float p[8];
#pragma unroll
                    for (int i = 0; i < 8; ++i) p[i] = x0c[i] * (bb == 0 ? val[i].x : val[i].y);
                    v4u o; o.x = pk2(p[0], p[1]); o.y = pk2(p[2], p[3]); o.z = pk2(p[4], p[5]); o.w = pk2(p[6], p[7]);
                    *(v4u*)((bf16*)(F.ws + WS_XS) + ((size_t)(b0 + bb) * 1024 + c) * SEQ + t0) = o;
                }
            }
        }
        SEC_MARK(7);
    }
    __syncthreads();
}
__device__ __forceinline__ void transpose_p_phase(Frame& F) {
    const bf16* PT = (const bf16*)(F.ws + WS_XS); bf16* P = (bf16*)(F.ws + WS_P);
    LAS unsigned short* scr = (LAS unsigned short*)(F.lds + F.wave * 16384);
    const int gw = F.vcu * NWAVES + F.wave, NGW = F.G * NWAVES, lane = F.lane;
    const int ntile = NB * (DM / 64) * (SEQ / 64);
    const int l8 = lane >> 3, ch = (lane & 7) * 8;
    for (int it = gw; it < ntile; it += NGW) {
        const int tb = it % (SEQ / 64), cb = (it / (SEQ / 64)) % (DM / 64), b = it / ((SEQ / 64) * (DM / 64));
        v4u x[8];
#pragma unroll
        for (int k = 0; k < 8; ++k) x[k] = *(const v4u*)(PT + ((size_t)b * 1024 + cb * 64 + 8 * k + l8) * SEQ + tb * 64 + ch);
#pragma unroll
        for (int k = 0; k < 8; ++k) { LAS unsigned* d = (LAS unsigned*)(scr + (8 * k + l8) * 66 + ch); d[0] = x[k].x; d[1] = x[k].y; d[2] = x[k].z; d[3] = x[k].w; }
        LDS_WAIT(); asm volatile("" ::: "memory");
#pragma unroll
        for (int k = 0; k < 8; ++k) { const int t = 8 * k + l8; const LAS unsigned short* sp = scr + ch * 66 + t;
            v4u o; o.x = sp[0] | ((unsigned)sp[66] << 16); o.y = sp[2 * 66] | ((unsigned)sp[3 * 66] << 16); o.z = sp[4 * 66] | ((unsigned)sp[5 * 66] << 16); o.w = sp[6 * 66] | ((unsigned)sp[7 * 66] << 16);
            *(v4u*)(P + ((size_t)b * SEQ + tb * 64 + t) * DM + cb * 64 + ch) = o; }
        LDS_WAIT(); asm volatile("" ::: "memory");
    }
}

constexpr int NPH = 13;
__global__ void __launch_bounds__(NWAVES * 64, 2) hybrid_fwd(Args args) {
    extern __shared__ __attribute__((aligned(16))) unsigned char lds[];
    Frame F;
    F.lds = (LAS unsigned char*)lds;
    F.tid = threadIdx.x; F.lane = F.tid & 63; F.wave = __builtin_amdgcn_readfirstlane(F.tid >> 6);
    F.G = gridDim.x; { const int bx = blockIdx.x; F.vcu = (F.G % 8 == 0) ? (bx % 8) * (F.G / 8) + bx / 8 : bx; }
    F.in = args.in; F.out = args.out; F.ws = args.ws;
#ifdef PROBE_SEC
    F.sec = 0;
#endif
    unsigned char* ws = args.ws;
    volatile LAS unsigned* MISC = (volatile LAS unsigned*)(F.lds + MISC_OFF);
    for (int u = F.tid; u < (LDS_BYTES - LDSCTL_OFF) / 4; u += NWAVES * 64) ((LAS unsigned*)(F.lds + LDSCTL_OFF))[u] = 0u;
    __syncthreads();
    XcdBarrier bar; bar.bar = (unsigned*)(ws + CT_BAR) + args.li * XCD_BAR_WORDS; bar.x = 0; bar.st = nullptr;
    const int lo = args.ph_lo, hi = args.ph_hi;
    if (hi - lo > 1) bar = xcd_barrier_post((unsigned*)(ws + CT_BAR) + args.li * XCD_BAR_WORDS, MISC + 8);
#ifndef EXP_PAIR
#define EXP_PAIR 0
#endif
#ifndef REP_MASK
#define REP_MASK 0
#endif
#define REPS(k) ((((REP_MASK) >> (k)) & 1) ? 2 : 1)
#ifndef PH_MASK
#define PH_MASK 0xFFFFFF
#endif
#define IN(k) ((((PH_MASK) >> (k)) & 1) && lo <= (k) && (k) < hi)
#ifdef PROBE_TS
    unsigned long long ts_a = 0, ts_b = 0;
#define TS_MARK(k) do { if (blockIdx.x == 0 && F.tid == 0) { const unsigned long long t_ = __builtin_amdgcn_s_memrealtime(); if ((k) == PROBE_TS) ts_a = t_; if ((k) == PROBE_TS + 1) ts_b = t_; } } while (0)
#else
#define TS_MARK(k) do { } while (0)
#endif
#define SEAM(k) do { if (IN(k) && IN((k) + 1)) xcd_barrier(bar); TS_MARK((k) + 1); } while (0)
    const float* mods = (const float*)(ws + CT_MODS);
    const float* gnt = (const float*)(ws + SM_GN);
    float* ssqa = (float*)(ws + WS_SSQP);
    bf16* XS = (bf16*)(ws + WS_XS);

    TS_MARK(0);
    if (IN(0)) { for (int rep = 0; rep < REPS(0); ++rep) { phase0a(F); filtgen_phase(F); } } SEAM(0);
    if (IN(1)) { for (int rep = 0; rep < REPS(1); ++rep) { phase0b(F); filtfft_phase(F); } } SEAM(1);
    if (IN(2)) for (int rep = 0; rep < REPS(2); ++rep) {
        { pg8::Gemm g{XS, (const bf16*)(ws + WS_WQKV), TT, DM, DM, DM}; pg8::StaticOrder S; S.init(TT, DM, F.G, (int)blockIdx.x);
          EpiQK<0> E{(bf16*)(ws + WS_Q), (const float*)(ws + SM_SSQ0), 1, (const float*)(ws + CT_BQKV), 3072, args.in[9], SEQ};
          pg8::gemm_phase<EpiQK<0>, pg8::StaticOrder, true, true>(F.lds, g, S, E); }
        { pg8::Gemm g{XS, (const bf16*)(ws + WS_WQKV) + (size_t)1024 * DM, TT, DM, DM, DM}; pg8::StaticOrder S; S.init(TT, DM, F.G, (int)blockIdx.x);
          EpiQK<1> E{(bf16*)(ws + WS_K), (const float*)(ws + SM_SSQ0), 1, (const float*)(ws + CT_BQKV), 3072, args.in[10], SEQ};
          pg8::gemm_phase<EpiQK<1>, pg8::StaticOrder, true, true>(F.lds, g, S, E); }
        { pg8::Gemm g{XS, (const bf16*)(ws + WS_WQKV) + (size_t)2048 * DM, TT, DM, DM, DM}; pg8::StaticOrder S; S.init(TT, DM, F.G, (int)blockIdx.x);
          EpiVT E{(bf16*)(ws + WS_V), (const float*)(ws + SM_SSQ0), 1, (const float*)(ws + CT_BQKV), 3072, SEQ};
          pg8::gemm_phase<EpiVT, pg8::StaticOrder, true, true>(F.lds, g, S, E); }
        { pg8::Gemm g{(const bf16*)(ws + WS_XSC), (const bf16*)(ws + WS_WQKV) + (size_t)1024 * DM, TC, 2 * DM, DM, DM}; pg8::StaticOrder S; S.init(TC, 2 * DM, F.G, (int)blockIdx.x);
          EpiCtxKV E{ EpiQK<1>{(bf16*)(ws + WS_KC), (const float*)(ws + SM_SSQC), 1, (const float*)(ws + CT_BQKV) + 4 * 3072, 0, args.in[10], CTXL},
                      EpiVT{(bf16*)(ws + WS_VC), (const float*)(ws + SM_SSQC), 1, (const float*)(ws + CT_BQKV) + 4 * 3072, 0, CTXL} };
          pg8::gemm_phase<EpiCtxKV, pg8::StaticOrder, true, true>(F.lds, g, S, E); }
        { const int nct = (TC / 256) * (2 * DM / 256); const int idle = (int)F.G - nct;
          if (idle >= 184) { if ((int)blockIdx.x >= nct) bias_gemv_late(F, (int)blockIdx.x - nct); }
          else for (int it = (int)blockIdx.x; it < 184; it += (int)F.G) bias_gemv_late(F, it); }
    } SEAM(2);
    if (IN(3)) { for (int rep = 0; rep < REPS(3); ++rep) attn_mfma_phase(F); } SEAM(3);
    if (IN(4)) for (int rep = 0; rep < REPS(4); ++rep) {
        pg8::Gemm g{(const bf16*)(ws + WS_O), (const bf16*)(ws + WS_WO), TT, DM, DM, DM}; pg8::StaticOrder S; S.init(TT, DM, F.G, (int)blockIdx.x);
        EpiRes<true, false> E{args.in[0], ws + WS_XB, mods + 2048, nullptr, gnt, XS, ssqa, (float*)(lds + RING_BYTES + 8192)};
        pg8::gemm_phase<EpiRes<true, false>, pg8::StaticOrder, true, true>(F.lds, g, S, E);
    } SEAM(4);
    if (IN(5)) for (int rep = 0; rep < REPS(5); ++rep) {
        pg8::Gemm g{XS, (const bf16*)(ws + WS_WUP0), TT, 2 * FF, DM, DM}; pg8::StaticOrder S; S.init(TT, 2 * FF, F.G, (int)blockIdx.x);
        EpiUpGlu E{(bf16*)(ws + WS_AG), ssqa, 4, (const float*)(ws + CT_BUP0), args.in[14], args.in[15], (float*)(ws + WS_HG), (float*)(ws + WS_HA), (float*)(lds + RING_BYTES)};
        pg8::gemm_phase<EpiUpGlu, pg8::StaticOrder, true, true>(F.lds, g, S, E);
    } SEAM(5);

    if (IN(6)) {
        { pg8::StaticOrder S0; S0.init(TT, DM, F.G, (int)blockIdx.x); pg8::Unit fu;
#pragma unroll 1
          for (int i = 0; S0.next(i, fu); ++i) glu_fix_tile(F, fu.pm, args.in[14], args.in[15]);
          VM_WAIT(); __syncthreads(); asm volatile("" ::: "memory"); }
        pg8::Gemm g{(const bf16*)(ws + WS_AG), (const bf16*)(ws + WS_WDN0), TT, DM, FF, FF}; pg8::StaticOrder S; S.init(TT, DM, F.G, (int)blockIdx.x);
        EpiRes<false, false> E{ws + WS_XB, ws + WS_XB, mods + 5120, nullptr, gnt + 4096, XS, ssqa + 4 * TT, (float*)(lds + RING_BYTES + 8192)};
        pg8::gemm_phase<EpiRes<false, false>, pg8::StaticOrder, true, true>(F.lds, g, S, E);
    } SEAM(6);
    if (IN(7)) for (int rep = 0; rep < REPS(7); ++rep) {
        pg8::Gemm g{XS, (const bf16*)(ws + WS_WIN), TT, 3 * DM, DM, DM}; pg8::StaticOrder S; S.init(TT, 3 * DM, F.G, (int)blockIdx.x);
#ifdef EXP_P9
        EpiScaleBias E{(bf16*)(ws + WS_UT), 3 * DM, ssqa + 4 * TT, 4, (const float*)(ws + CT_BIN), 3072};
        pg8::gemm_phase<EpiScaleBias, pg8::StaticOrder, true, true>(F.lds, g, S, E);
#else
        EpiInT E{(bf16*)(ws + WS_UT), ssqa + 4 * TT, 4, (const float*)(ws + CT_BIN)};
        pg8::gemm_phase<EpiInT, pg8::StaticOrder, true, true>(F.lds, g, S, E);
#endif
    } SEAM(7);
    if (IN(8)) { for (int rep = 0; rep < REPS(8); ++rep) hyena_fft_phase(F); } SEAM(8);

    if (IN(9)) { for (int rep = 0; rep < REPS(9); ++rep) transpose_p_phase(F); } SEAM(9);
    if (IN(10)) {
        pg8::Gemm g{(const bf16*)(ws + WS_P), (const bf16*)(ws + WS_WOUT), TT, DM, DM, DM}; pg8::StaticOrder S; S.init(TT, DM, F.G, (int)blockIdx.x);
        EpiRes<false, false> E{ws + WS_XB, ws + WS_XB, mods + 5 * 6144 + 2048, args.in[35], gnt + 2 * 4096, XS, ssqa + 8 * TT, (float*)(lds + RING_BYTES + 8192)};
        pg8::gemm_phase<EpiRes<false, false>, pg8::StaticOrder, true, true>(F.lds, g, S, E);
    } SEAM(10);
    if (IN(11)) for (int rep = 0; rep < REPS(11); ++rep) {
        pg8::Gemm g{XS, (const bf16*)(ws + WS_WUP1), TT, 2 * FF, DM, DM}; pg8::StaticOrder S; S.init(TT, 2 * FF, F.G, (int)blockIdx.x);
        EpiUpGlu E{(bf16*)(ws + WS_AG), ssqa + 8 * TT, 4, (const float*)(ws + CT_BUP1), args.in[37], args.in[38], (float*)(ws + WS_HG), (float*)(ws + WS_HA), (float*)(lds + RING_BYTES)};
        pg8::gemm_phase<EpiUpGlu, pg8::StaticOrder, true, true>(F.lds, g, S, E);
    } SEAM(11);
    if (IN(12)) {
        { pg8::StaticOrder S0; S0.init(TT, DM, F.G, (int)blockIdx.x); pg8::Unit fu;
#pragma unroll 1
          for (int i = 0; S0.next(i, fu); ++i) glu_fix_tile(F, fu.pm, args.in[37], args.in[38]);
          VM_WAIT(); __syncthreads(); asm volatile("" ::: "memory"); }
        pg8::Gemm g{(const bf16*)(ws + WS_AG), (const bf16*)(ws + WS_WDN1), TT, DM, FF, FF}; pg8::StaticOrder S; S.init(TT, DM, F.G, (int)blockIdx.x);
        EpiRes<false, true> E{ws + WS_XB, args.out, mods + 5 * 6144 + 5120, nullptr, nullptr, nullptr, nullptr, nullptr};
        pg8::gemm_phase<EpiRes<false, true>, pg8::StaticOrder, true, true>(F.lds, g, S, E);
    }
#ifdef PROBE_SEC
    if (blockIdx.x == 0 && F.tid == 0) { asm volatile("s_waitcnt vmcnt(0)" ::: "memory"); args.out[0] = args.out[0] + (float)F.sec * 0.01f; }
#endif
#ifdef PROBE_TS
    TS_MARK(NPH);
    if (blockIdx.x == 0 && F.tid == 0) { asm volatile("s_waitcnt vmcnt(0)" ::: "memory"); args.out[0] = args.out[0] + (float)(ts_b - ts_a) * 0.01f; }
#endif
#ifdef PROBE_NULL
    if (lo == 98) {
#if PROBE_NULL == 5
        pg8::Gemm g{XS, (const bf16*)(ws + WS_WUP0), TT, 2 * FF, DM, DM}; pg8::StaticOrder S; S.init(TT, 2 * FF, F.G, (int)blockIdx.x);
#elif PROBE_NULL == 4
        pg8::Gemm g{(const bf16*)(ws + WS_O), (const bf16*)(ws + WS_WO), TT, DM, DM, DM}; pg8::StaticOrder S; S.init(TT, DM, F.G, (int)blockIdx.x);
#elif PROBE_NULL == 7
        pg8::Gemm g{(const bf16*)(ws + WS_AG), (const bf16*)(ws + WS_WDN0), TT, DM, FF, FF}; pg8::StaticOrder S; S.init(TT, DM, F.G, (int)blockIdx.x);
        { pg8::Unit fu; for (int i = 0; S.next(i, fu); ++i) glu_fix_tile(F, fu.pm, args.in[14], args.in[15]); VM_WAIT(); __syncthreads(); }
#else
        pg8::Gemm g{XS, (const bf16*)(ws + WS_WQKV), TT, 3 * DM, DM, DM}; pg8::StaticOrder S; S.init(TT, 3 * DM, F.G, (int)blockIdx.x);
#endif
        EpiNull E{(float*)(ws + WS_FSQP)};
        pg8::gemm_phase<EpiNull, pg8::StaticOrder, true, true>(F.lds, g, S, E);
    }
#endif
#ifdef DUMP_SEL
    if (lo == 99) {
        float* o = args.out; const size_t n = (size_t)TT * DM;
        for (size_t e = (size_t)blockIdx.x * 512 + F.tid; e < n; e += (size_t)F.G * 512) {
            float v;
            if (DUMP_SEL == 1) { const float* h = (const float*)(ws + WS_HT); v = (e < (size_t)2 * 1024 * SEQ) ? h[e] : ((const float*)(ws + WS_FSQP))[e & 1023]; }
            else if (DUMP_SEL == 2) { const bf16* u = (const bf16*)(ws + WS_UT); v = bf2f(u[e]); }
            else if (DUMP_SEL == 3) { const bf16* u = (const bf16*)(ws + WS_UT); v = bf2f(u[e + (size_t)TT * DM]); }
            else if (DUMP_SEL == 4) { const bf16* u = (const bf16*)(ws + WS_UT); v = bf2f(u[e + (size_t)2 * TT * DM]); }
            else { const bf16* u = (const bf16*)(ws + WS_P); v = bf2f(u[e]); }
            o[e] = v;
        }
    }
#endif
#undef IN
#undef SEAM
}

extern "C" void kernel_launch(void* const* d_in, const int* in_sizes, int n_in, void* d_out, int out_size, void* d_ws, size_t ws_size, hipStream_t stream) {
    static int grid = 0;
    if (grid == 0) {
        if (n_in != 40 || out_size != TT * DM || ws_size < WS_END) { fprintf(stderr, "kernel_launch: unexpected shapes n_in %d out %d ws %zu\n", n_in, out_size, ws_size); grid = -1; return; }
        int dev = 0, cus = 0;
        if (hipGetDevice(&dev) != hipSuccess || hipDeviceGetAttribute(&cus, hipDeviceAttributeMultiprocessorCount, dev) != hipSuccess) { grid = -1; return; }
        if (hipFuncSetAttribute((const void*)hybrid_fwd, hipFuncAttributeMaxDynamicSharedMemorySize, LDS_BYTES) != hipSuccess) { fprintf(stderr, "kernel_launch: hipFuncSetAttribute failed\n"); grid = -1; return; }
        int per_cu = 0;
        if (hipOccupancyMaxActiveBlocksPerMultiprocessor(&per_cu, (const void*)hybrid_fwd, NWAVES * 64, LDS_BYTES) != hipSuccess || per_cu < 1) { fprintf(stderr, "kernel_launch: occupancy query says %d\n", per_cu); }
        (void)hipGetLastError();
        grid = cus;
    }
    if (grid < 0) return;
    (void)hipMemsetAsync((char*)d_ws + WS_CTL, 0, CTL_ZERO_BYTES, stream);
    Args a{};
    for (int i = 0; i < 40; ++i) a.in[i] = (const float*)d_in[i];
    a.out = (float*)d_out; a.ws = (unsigned char*)d_ws; a.repmask = REP_MASK;
#if defined(PROBE_NULL)
    {   const int k = PROBE_NULL; const int lo[3] = {0, 98, k}, hi[3] = {k, 99, NPH};
        for (int i = 0; i < 3; ++i) { a.ph_lo = lo[i]; a.ph_hi = hi[i]; a.li = i;
            hipLaunchKernelGGL(hybrid_fwd, dim3(grid), dim3(NWAVES * 64), LDS_BYTES, stream, a); } }
#elif defined(PROBE_PHASE)
    {   const int k = PROBE_PHASE; const int lo[4] = {0, k, k, k + 1}, hi[4] = {k, k + 1, k + 1, NPH};
        for (int i = 0; i < 4; ++i) { if (lo[i] >= hi[i]) continue; a.ph_lo = lo[i]; a.ph_hi = hi[i]; a.li = i;
            hipLaunchKernelGGL(hybrid_fwd, dim3(grid), dim3(NWAVES * 64), LDS_BYTES, stream, a); } }
#elif MK_ONE_LAUNCH
    a.ph_lo = 0; a.ph_hi = NPH;
    hipLaunchKernelGGL(hybrid_fwd, dim3(grid), dim3(NWAVES * 64), LDS_BYTES, stream, a);
#else
    for (int p = 0; p < PH_END; ++p) { a.ph_lo = p; a.ph_hi = p + 1; hipLaunchKernelGGL(hybrid_fwd, dim3(grid), dim3(NWAVES * 64), LDS_BYTES, stream, a); }
#ifdef DUMP_SEL
    a.ph_lo = 99; a.ph_hi = 100; hipLaunchKernelGGL(hybrid_fwd, dim3(grid), dim3(NWAVES * 64), LDS_BYTES, stream, a);
#endif
#endif
}
```

```cpp
#include <hip/hip_runtime.h>
#include <cstdio>
#include <cstdint>

#ifndef PH_END
#define PH_END 13
#endif
#ifndef MK_ONE_LAUNCH
#define MK_ONE_LAUNCH 1
#endif

namespace pg8 {
#define PG8_LAS __attribute__((address_space(3)))
typedef unsigned short bf16_t;
typedef short bf16x8 __attribute__((ext_vector_type(8)));
typedef float f32x4 __attribute__((ext_vector_type(4)));
typedef unsigned u32x4 __attribute__((ext_vector_type(4)));
constexpr int BM = 256, BK = 64, HALF = 128, HTB = HALF * BK * 2, STAGE_BYTES = 8 * HTB, NXCD = 8, WGM = 8;

__host__ __device__ __forceinline__ int lds_byte(int r, int c) { const int st = (r >> 4) * 2 + (c >> 5), rr = r & 15, cc = c & 31, ob = rr * 64 + cc * 2; return st * 1024 + (ob ^ (((ob >> 9) & 1) << 5)); }
__host__ __device__ __forceinline__ void stage_rc(int b, int& R, int& C) { const int st = b / 1024, sb = b % 1024, swz = sb ^ (((sb >> 9) & 1) << 5); R = (st >> 1) * 16 + swz / 64; C = (st & 1) * 32 + (swz % 64) / 2; }
__host__ __device__ __forceinline__ int perm32(int rho) { const int n = rho >> 4, i = rho & 15; return 8 * (i >> 2) + 4 * n + (i & 3); }

struct Unit { int pm, pn; };
struct Gemm { const bf16_t* A; const bf16_t* Bt; int M, N, K, lda; };

struct StaticOrder {
    int nM, nN, nwg, G, c;
    __host__ __device__ __forceinline__ void init(int M, int N, int G_, int c_) { nM = M / BM; nN = N / BM; nwg = nM * nN; G = G_; c = c_; }
    __host__ __device__ __forceinline__ bool next(int i, Unit& u) const {
        const long L = (long)i * G + c; if (L >= nwg) return false;
        int wgid = (int)L; { const int q = nwg / NXCD, r = nwg % NXCD, xcd = wgid % NXCD, off = wgid / NXCD; wgid = (xcd < r ? xcd * (q + 1) : r * (q + 1) + (xcd - r) * q) + off; }
        const int nig = WGM * nN, gid = wgid / nig, fm = gid * WGM, gsz = (nM - fm) < WGM ? (nM - fm) : WGM;
        u.pm = fm + ((wgid % nig) % gsz); u.pn = (wgid % nig) / gsz; return true;
    }
    __device__ __forceinline__ void a_ready(const Unit&) const {}
    __device__ __forceinline__ void done(const Unit&) const {}
};

__device__ __forceinline__ unsigned cvt_pk_bf16(float lo, float hi) { unsigned r; asm volatile("v_cvt_pk_bf16_f32 %0, %1, %2" : "=v"(r) : "v"(lo), "v"(hi)); return r; }

template <class E> __device__ __forceinline__ auto epi_prefetch(const E& e, const Unit& u, int) -> decltype(e.prefetch(u), void()) { e.prefetch(u); }
template <class E> __device__ __forceinline__ void epi_prefetch(const E&, const Unit&, long) {}
template <class Epi, class Sched, bool ALIGN_EPI = false, bool SP2 = false>
__device__ __forceinline__ void gemm_phase(PG8_LAS unsigned char* lds, const Gemm g, const Sched& S, const Epi& E) {
    const int tid = threadIdx.x, wid = __builtin_amdgcn_readfirstlane(tid >> 6), lane = tid & 63, wr = wid >> 2, wc = wid & 3, fr = lane & 15, fq = lane >> 4;
    const int K = g.K, nt = K / BK, lda = g.lda;
    unsigned voffA[2], voffB[2];
#pragma unroll
    for (int i = 0; i < 2; ++i) { int R, C; stage_rc(tid * 16 + i * 8192, R, C); const int Rb = Epi::PERM ? ((R & ~31) + perm32(R & 31)) : R;
        voffA[i] = (unsigned)(R * lda + C) * 2u; voffB[i] = (unsigned)(Rb * K + C) * 2u; }
    const size_t kstep = (size_t)(BK * 2);
    const size_t hstepA = (size_t)HALF * lda * 2, hstepB = (size_t)HALF * K * 2;
    const size_t tstepA = 2 * hstepA, tstepB = 2 * hstepB;
    const unsigned ldsw = (unsigned)wid * 1024u;
    const int aoff = lds_byte(wr * 64 + fr, fq * 8), boff = lds_byte(wc * 32 + fr, fq * 8);
#define PG8_SA(b, h) (((b) * 2 + (h)) * HTB)
#define PG8_SB(b, h) ((4 + (b) * 2 + (h)) * HTB)
#define PG8_STAGE(bufoff, gbase, voff) do { _Pragma("unroll") for (int _i = 0; _i < 2; ++_i) \
        __builtin_amdgcn_global_load_lds((const unsigned*)((const char*)(gbase) + (voff)[_i]), (PG8_LAS unsigned*)(lds + (bufoff) + ldsw + _i * 8192), 16, 0, 0); } while (0)
#define PG8_LDA(dst, b, h) do { _Pragma("unroll") for (int m = 0; m < 4; ++m) _Pragma("unroll") for (int k = 0; k < 2; ++k) dst[m][k] = *(const PG8_LAS bf16x8*)(lds + PG8_SA(b, h) + aoff + m * 2048 + k * 1024); } while (0)
#define PG8_LDB(dst, b, h) do { _Pragma("unroll") for (int n = 0; n < 2; ++n) _Pragma("unroll") for (int k = 0; k < 2; ++k) dst[n][k] = *(const PG8_LAS bf16x8*)(lds + PG8_SB(b, h) + boff + n * 2048 + k * 1024); } while (0)
#define PG8_MMA(ai, bj, At, Bt) do { __builtin_amdgcn_s_setprio(1); _Pragma("unroll") for (int m = 0; m < 4; ++m) _Pragma("unroll") for (int n = 0; n < 2; ++n) _Pragma("unroll") for (int k = 0; k < 2; ++k) \
        acc[ai][bj][m][n] = __builtin_amdgcn_mfma_f32_16x16x32_bf16(Bt[n][k], At[m][k], acc[ai][bj][m][n], 0, 0, 0); __builtin_amdgcn_s_setprio(0); } while (0)
#define PG8_WAIT_V(n) asm volatile("s_waitcnt vmcnt(" #n ")" ::: "memory")
#define PG8_WAIT_L(n) asm volatile("s_waitcnt lgkmcnt(" #n ")" ::: "memory")
#define PG8_BAR __builtin_amdgcn_s_barrier()
#define PG8_SCHED __builtin_amdgcn_sched_barrier(0)
    Unit cur, nxt; int ui = 0;
    if (!S.next(0, cur)) return;
    f32x4 acc[2][2][4][2];
#pragma unroll
    for (int a = 0; a < 2; ++a)
#pragma unroll
        for (int b = 0; b < 2; ++b)
#pragma unroll
            for (int m = 0; m < 4; ++m)
#pragma unroll
                for (int n = 0; n < 2; ++n) acc[a][b][m][n] = (f32x4){0.f, 0.f, 0.f, 0.f};
    bf16x8 At[4][2], B0[2][2], B1[2][2];
    const char* cA = (const char*)g.A + (size_t)cur.pm * tstepA; const char* cB = (const char*)g.Bt + (size_t)cur.pn * tstepB;
    S.a_ready(cur);
    epi_prefetch(E, cur, 0);
    if constexpr (SP2) {
        PG8_STAGE(PG8_SB(0, 0), cB, voffB); PG8_STAGE(PG8_SB(0, 1), cB + hstepB, voffB); PG8_STAGE(PG8_SA(0, 0), cA, voffA); PG8_STAGE(PG8_SA(0, 1), cA + hstepA, voffA);
        if (wr == 1) PG8_BAR;
        PG8_WAIT_V(2); PG8_BAR;
        PG8_STAGE(PG8_SB(1, 0), cB + kstep, voffB); PG8_STAGE(PG8_SA(1, 0), cA + kstep, voffA); PG8_STAGE(PG8_SB(1, 1), cB + hstepB + kstep, voffB);
        PG8_WAIT_V(6); PG8_BAR;
    } else {
        PG8_STAGE(PG8_SB(0, 0), cB, voffB); PG8_STAGE(PG8_SA(0, 0), cA, voffA); PG8_STAGE(PG8_SB(0, 1), cB + hstepB, voffB); PG8_STAGE(PG8_SA(0, 1), cA + hstepA, voffA);
        if (wr == 1) PG8_BAR;
        PG8_WAIT_V(4); PG8_BAR;
        PG8_STAGE(PG8_SB(1, 0), cB + kstep, voffB); PG8_STAGE(PG8_SA(1, 0), cA + kstep, voffA); PG8_STAGE(PG8_SB(1, 1), cB + hstepB + kstep, voffB);
        PG8_WAIT_V(6); PG8_BAR;
    }
    for (;;) {
        const bool has_next = S.next(ui + 1, nxt);
        const char* nA = has_next ? (const char*)g.A + (size_t)nxt.pm * tstepA : cA; const char* nB = has_next ? (const char*)g.Bt + (size_t)nxt.pn * tstepB : cB;
        for (int t = 0; t < nt; t += 2) {
            const bool last = (t == nt - 2);
            const char* a1 = cA + (size_t)(t + 1) * kstep;
            const char* a2 = last ? nA : cA + (size_t)(t + 2) * kstep; const char* b2 = last ? nB : cB + (size_t)(t + 2) * kstep;
            const char* a3 = a2 + kstep; const char* b3 = b2 + kstep;
            if (last && has_next) S.a_ready(nxt);
            if constexpr (SP2) {
            PG8_LDB(B0, 0, 0); PG8_LDB(B1, 0, 1); PG8_SCHED; PG8_LDA(At, 0, 0); PG8_STAGE(PG8_SA(1, 1), a1 + hstepA, voffA);
            PG8_WAIT_V(8); PG8_WAIT_L(0); PG8_BAR; PG8_MMA(0, 0, At, B0); PG8_MMA(0, 1, At, B1); PG8_BAR; PG8_SCHED;
            PG8_LDA(At, 0, 1); PG8_STAGE(PG8_SB(0, 0), b2, voffB); PG8_STAGE(PG8_SB(0, 1), b2 + hstepB, voffB); PG8_STAGE(PG8_SA(0, 0), a2, voffA);
            PG8_WAIT_V(8); PG8_WAIT_L(0); PG8_BAR; PG8_MMA(1, 0, At, B0); PG8_MMA(1, 1, At, B1); PG8_BAR; PG8_SCHED;
            PG8_LDB(B0, 1, 0); PG8_LDB(B1, 1, 1); PG8_SCHED; PG8_LDA(At, 1, 0); PG8_STAGE(PG8_SA(0, 1), a2 + hstepA, voffA);
            PG8_WAIT_V(8); PG8_WAIT_L(0); PG8_BAR; PG8_MMA(0, 0, At, B0); PG8_MMA(0, 1, At, B1); PG8_BAR; PG8_SCHED;
            PG8_LDA(At, 1, 1); PG8_STAGE(PG8_SB(1, 0), b3, voffB); PG8_STAGE(PG8_SB(1, 1), b3 + hstepB, voffB); PG8_STAGE(PG8_SA(1, 0), a3, voffA);
            PG8_WAIT_V(8); PG8_WAIT_L(0); PG8_BAR; PG8_MMA(1, 0, At, B0); PG8_MMA(1, 1, At, B1); PG8_BAR; PG8_SCHED;
            } else {
            PG8_LDB(B0, 0, 0); PG8_SCHED; PG8_LDA(At, 0, 0); PG8_STAGE(PG8_SA(1, 1), a1 + hstepA, voffA);
            PG8_WAIT_L(8); PG8_BAR; PG8_WAIT_L(0); PG8_MMA(0, 0, At, B0); PG8_BAR; PG8_SCHED;
            PG8_LDB(B1, 0, 1); PG8_STAGE(PG8_SB(0, 0), b2, voffB);
            PG8_BAR; PG8_WAIT_L(0); PG8_MMA(0, 1, At, B1); PG8_BAR;
            PG8_LDA(At, 0, 1); PG8_STAGE(PG8_SA(0, 0), a2, voffA);
            PG8_BAR; PG8_WAIT_L(0); PG8_MMA(1, 0, At, B0); PG8_BAR; PG8_SCHED;
            PG8_STAGE(PG8_SB(0, 1), b2 + hstepB, voffB);
            PG8_WAIT_V(6); PG8_BAR; PG8_MMA(1, 1, At, B1); PG8_BAR;
            PG8_LDB(B0, 1, 0); PG8_SCHED; PG8_LDA(At, 1, 0); PG8_STAGE(PG8_SA(0, 1), a2 + hstepA, voffA);
            PG8_WAIT_L(8); PG8_BAR; PG8_WAIT_L(0); PG8_MMA(0, 0, At, B0); PG8_BAR; PG8_SCHED;
            PG8_LDB(B1, 1, 1); PG8_STAGE(PG8_SB(1, 0), b3, voffB);
            PG8_BAR; PG8_WAIT_L(0); PG8_MMA(0, 1, At, B1); PG8_BAR;
            PG8_LDA(At, 1, 1); PG8_STAGE(PG8_SA(1, 0), a3, voffA);
            PG8_BAR; PG8_WAIT_L(0); PG8_MMA(1, 0, At, B0); PG8_BAR; PG8_SCHED;
            PG8_STAGE(PG8_SB(1, 1), b3 + hstepB, voffB);
            PG8_WAIT_V(6); PG8_BAR; PG8_MMA(1, 1, At, B1); PG8_BAR;
            }
        }
        if constexpr (ALIGN_EPI) { if (wr == 0) PG8_BAR; }
        E(acc, cur, wr, wc, fr, fq); S.done(cur);
        if (!has_next) break;
#pragma unroll
        for (int a = 0; a < 2; ++a)
#pragma unroll
            for (int b = 0; b < 2; ++b)
#pragma unroll
                for (int m = 0; m < 4; ++m)
#pragma unroll
                    for (int n = 0; n < 2; ++n) acc[a][b][m][n] = (f32x4){0.f, 0.f, 0.f, 0.f};
        cur = nxt; cA = nA; cB = nB; ++ui;
        epi_prefetch(E, cur, 0);
        if constexpr (ALIGN_EPI) { if (wr == 1) PG8_BAR; }
    }
    PG8_WAIT_V(0);
    if constexpr (!ALIGN_EPI) { if (wr == 0) PG8_BAR; }
    PG8_BAR;
#undef PG8_SA
#undef PG8_SB
#undef PG8_STAGE
#undef PG8_LDA
#undef PG8_LDB
#undef PG8_MMA
#undef PG8_WAIT_V
#undef PG8_WAIT_L
#undef PG8_BAR
#undef PG8_SCHED
}
}

constexpr int NB = 4, SEQ = 8192, DM = 1024, TT = NB * SEQ, CTXL = 256, TC = NB * CTXL, FF = 2816, NH = 16, HD = 64, GW = 64, GROWS = SEQ / GW;
constexpr int WH = 8, WW = 16;
constexpr float EPS = 1e-6f;
constexpr int NWAVES = 8;

constexpr size_t MiB = 1u << 20;
constexpr size_t WS_CTL = 0, CTL_ZERO_BYTES = 64 * 1024;
constexpr size_t CT_BAR = 4096;
constexpr size_t CT_MODS = 64 * 1024;
constexpr size_t CT_BQKV = CT_MODS + 2 * 5 * 6144 * 4;
constexpr size_t CT_BUP0 = CT_BQKV + 5 * 3072 * 4;
constexpr size_t CT_BIN  = CT_BUP0 + 4 * 5632 * 4;
constexpr size_t CT_BUP1 = CT_BIN + 4 * 3072 * 4;
constexpr size_t CT_END  = CT_BUP1 + 4 * 5632 * 4;
static_assert(CT_END <= 1 * MiB, "ctl region");
constexpr size_t SM_SSQ0 = 1 * MiB, SM_SSQC = SM_SSQ0 + 32768 * 4, SM_GN = SM_SSQC + 1024 * 4;
constexpr size_t WS_SSQP = 2 * MiB;
constexpr size_t WS_FSQP = 4 * MiB;
constexpr size_t WS_XB = 448 * MiB;
constexpr size_t WS_WQKV = 8 * MiB, WS_WO = 14 * MiB, WS_WUP0 = 16 * MiB, WS_WDN0 = 27 * MiB, WS_WIN = 33 * MiB, WS_WOUT = 39 * MiB, WS_WUP1 = 41 * MiB, WS_WDN1 = 52 * MiB;
constexpr size_t WS_XSC = 58 * MiB, WS_KC = 60 * MiB, WS_VC = 62 * MiB;
constexpr size_t WS_XS = 64 * MiB;
constexpr size_t WS_Q = 128 * MiB, WS_K = 192 * MiB, WS_V = 256 * MiB, WS_O = WS_Q;
constexpr size_t WS_AG = 128 * MiB;
constexpr size_t WS_HG = 308 * MiB, WS_HA = 314 * MiB;
constexpr size_t WS_UT = 128 * MiB;
constexpr size_t WS_HT = 128 * MiB;
constexpr size_t WS_F = 320 * MiB;
constexpr size_t SM_TWM = 1536 * 1024, SM_TWN = SM_TWM + 65536;
constexpr size_t WS_P = 384 * MiB;
constexpr size_t WS_END = 512 * MiB;

constexpr int RING_BYTES = 131072;
constexpr int LDS_BYTES = 163840;
constexpr int CB_LDS_OFF = 136 * 1024;
constexpr int LDSCTL_OFF = LDS_BYTES - 1024, MISC_OFF = LDSCTL_OFF + 320;

#define GAS __attribute__((address_space(1)))
#define LAS __attribute__((address_space(3)))
typedef unsigned short bf16;
typedef unsigned v4u __attribute__((ext_vector_type(4)));
typedef unsigned v2u __attribute__((ext_vector_type(2)));
typedef float f32x4 __attribute__((ext_vector_type(4)));
typedef GAS unsigned gu32;
#define RLX_AGENT __ATOMIC_RELAXED, __HIP_MEMORY_SCOPE_AGENT
#define LDS_WAIT() asm volatile("s_waitcnt lgkmcnt(0)" ::: "memory")
#define VM_WAIT() asm volatile("s_waitcnt vmcnt(0)" ::: "memory")
__device__ __forceinline__ unsigned f2bf(float f) { unsigned u = __builtin_bit_cast(unsigned, f); return (u + 0x7fffu + ((u >> 16) & 1u)) >> 16; }
__device__ __forceinline__ unsigned pk2(float lo, float hi) { unsigned r; asm("v_cvt_pk_bf16_f32 %0, %1, %2" : "=v"(r) : "v"(lo), "v"(hi)); return r; }
__device__ __forceinline__ float bf2f(unsigned short h) { return __builtin_bit_cast(float, (unsigned)h << 16); }
__device__ __forceinline__ float bflo(unsigned w) { return __builtin_bit_cast(float, w << 16); }
__device__ __forceinline__ float bfhi(unsigned w) { return __builtin_bit_cast(float, w & 0xffff0000u); }

#define FC_HD __device__ __forceinline__
typedef float cf __attribute__((ext_vector_type(2)));
FC_HD cf cmul(cf a, cf b) { const cf t = {-b.y, b.x}; return a.xx * b + a.yy * t; }
FC_HD cf cadd(cf a, cf b) { return a + b; }
FC_HD cf csub(cf a, cf b) { return a - b; }
FC_HD cf cconj(cf a) { cf r; r.x = a.x; r.y = -a.y; return r; }
FC_HD cf cmulnegi(cf a) { cf r; r.x = a.y; r.y = -a.x; return r; }
#define FC_OPAQUE(x) asm volatile("" : "+v"(x))
#define FC_PIDX(i) ((i) + (((i) >> 6) << 3))
#define FC_M 8192
#define FC_PADM (FC_M + FC_M / 8)
#define FC_S2 0.70710678118654752f
FC_HD void dft4(cf& a0, cf& a1, cf& a2, cf& a3) {
    const cf c0 = cadd(a0, a2), c1 = cadd(a1, a3), d0 = csub(a0, a2), d1 = cmulnegi(csub(a1, a3));
    a0 = cadd(c0, c1); a1 = cadd(d0, d1); a2 = csub(c0, c1); a3 = csub(d0, d1);
}
FC_HD void dft8(cf* v) {
    cf a0 = cadd(v[0], v[4]), a1 = cadd(v[1], v[5]), a2 = cadd(v[2], v[6]), a3 = cadd(v[3], v[7]);
    cf b0 = csub(v[0], v[4]), b1 = csub(v[1], v[5]), b2 = csub(v[2], v[6]), b3 = csub(v[3], v[7]);
    { cf t; t.x = (b1.x + b1.y) * FC_S2; t.y = (b1.y - b1.x) * FC_S2; b1 = t; }
    b2 = cmulnegi(b2);
    { cf t; t.x = (b3.y - b3.x) * FC_S2; t.y = (-b3.x - b3.y) * FC_S2; b3 = t; }
    dft4(a0, a1, a2, a3); dft4(b0, b1, b2, b3);
    v[0] = a0; v[2] = a1; v[4] = a2; v[6] = a3; v[1] = b0; v[3] = b1; v[5] = b2; v[7] = b3;
}
FC_HD void dft16(cf* v) {
    cf a[8], b[8];
    const float c1 = 0.92387953251128674f, s1 = 0.38268343236508977f;
#ifdef __HIP_DEVICE_COMPILE__
#pragma unroll
#endif
    for (int i = 0; i < 8; ++i) { a[i] = cadd(v[i], v[i + 8]); b[i] = csub(v[i], v[i + 8]); }
    { cf w; w.x = c1; w.y = -s1; b[1] = cmul(b[1], w); }
    { cf w; w.x = FC_S2; w.y = -FC_S2; b[2] = cmul(b[2], w); }
    { cf w; w.x = s1; w.y = -c1; b[3] = cmul(b[3], w); }
    b[4] = cmulnegi(b[4]);
    { cf w; w.x = -s1; w.y = -c1; b[5] = cmul(b[5], w); }
    { cf w; w.x = -FC_S2; w.y = -FC_S2; b[6] = cmul(b[6], w); }
    { cf w; w.x = -c1; w.y = -s1; b[7] = cmul(b[7], w); }
    dft8(a); dft8(b);
#ifdef __HIP_DEVICE_COMPILE__
#pragma unroll
#endif
    for (int i = 0; i < 8; ++i) { v[2 * i] = a[i]; v[2 * i + 1] = b[i]; }
}
template <int R> FC_HD void cpowers(cf w1, cf* w) {
    w[0].x = 1.f; w[0].y = 0.f; w[1] = w1;
#ifdef __HIP_DEVICE_COMPILE__
#pragma unroll
#endif
    for (int q = 2; q < R; ++q) w[q] = (q & 1) ? cmul(w[q - 1], w1) : cmul(w[q >> 1], w[q >> 1]);
}
template <class LP> FC_HD void fwd_pass1(cf* v, int tid, LP a, const cf* TWM) {
    dft16(v);
    FC_OPAQUE(tid);
    const cf w1 = TWM[tid]; cf cur = w1;
    const int pt = FC_PIDX(tid);
    a[pt] = v[0];
#ifdef __HIP_DEVICE_COMPILE__
#pragma unroll
#endif
    for (int q = 1; q < 16; ++q) { a[pt + 576 * q] = cmul(v[q], cur); cur = cmul(cur, w1); }
}
template <class LP> FC_HD void fwd_pass8(int tid, LP a, const cf* TWM, int s, int lgs) {
#pragma unroll 1
    for (int h = 0; h < 2; ++h) {
        FC_OPAQUE(tid);
        const int bf = tid + 512 * h, j = bf & (s - 1), base = (bf >> lgs) * 8 * s;
        const int pb = FC_PIDX(base + j), ps = (s == 64) ? 72 : 8;
        cf v[8];
#ifdef __HIP_DEVICE_COMPILE__
#pragma unroll
#endif
        for (int r = 0; r < 8; ++r) v[r] = a[pb + ps * r];
        dft8(v);
        const cf w1 = TWM[j]; cf cur = w1;
        a[pb] = v[0];
#ifdef __HIP_DEVICE_COMPILE__
#pragma unroll
#endif
        for (int q = 1; q < 8; ++q) { a[pb + ps * q] = cmul(v[q], cur); cur = cmul(cur, w1); }
    }
}
template <class LP> FC_HD void mid_pass(int tid, LP a, const cf* F, cf* Fout, float fscale) {
#pragma unroll 1
    for (int h = 0; h < 2; ++h) {
        FC_OPAQUE(tid);
        const int bf = tid + 512 * h, base = bf * 8, pb = FC_PIDX(base);
        cf v[8];
#ifdef __HIP_DEVICE_COMPILE__
#pragma unroll
#endif
        for (int r = 0; r < 8; ++r) v[r] = a[pb + r];
        dft8(v);
        if (F) {
#ifdef __HIP_DEVICE_COMPILE__
#pragma unroll
#endif
            for (int r = 0; r < 8; ++r) v[r] = cconj(cmul(v[r], F[base + r]));
            dft8(v);
#ifdef __HIP_DEVICE_COMPILE__
#pragma unroll
#endif
            for (int r = 0; r < 8; ++r) a[pb + r] = v[r];
        } else {
#ifdef __HIP_DEVICE_COMPILE__
#pragma unroll
#endif
            for (int r = 0; r < 8; ++r) { cf o; o.x = v[r].x * fscale; o.y = v[r].y * fscale; Fout[base + r] = o; }
        }
    }
}
template <class LP> FC_HD void mid_pass_reg(int tid, LP a, const cf* fr) {
#ifdef __HIP_DEVICE_COMPILE__
#pragma unroll
#endif
    for (int h = 0; h < 2; ++h) {
        FC_OPAQUE(tid);
        const int bf = tid + 512 * h, base = bf * 8, pb = FC_PIDX(base);
        cf v[8];
#ifdef __HIP_DEVICE_COMPILE__
#pragma unroll
#endif
        for (int r = 0; r < 8; ++r) v[r] = a[pb + r];
        dft8(v);
#ifdef __HIP_DEVICE_COMPILE__
#pragma unroll
#endif
        for (int r = 0; r < 8; ++r) v[r] = cconj(cmul(v[r], fr[h * 8 + r]));
        dft8(v);
#ifdef __HIP_DEVICE_COMPILE__
#pragma unroll
#endif
        for (int r = 0; r < 8; ++r) a[pb + r] = v[r];
    }
}
template <class LP> FC_HD void inv_pass8(int tid, LP a, const cf* TWM, int s, int lgs) {
#pragma unroll 1
    for (int h = 0; h < 2; ++h) {
        FC_OPAQUE(tid);
        const int bf = tid + 512 * h, j = bf & (s - 1), base = (bf >> lgs) * 8 * s;
        const int pb = FC_PIDX(base + j), ps = (s == 64) ? 72 : 8;
        cf v[8]; const cf w1 = TWM[j]; cf cur = w1;
        v[0] = a[FC_PIDX(base + j)];
#ifdef __HIP_DEVICE_COMPILE__
#pragma unroll
#endif
        for (int q = 1; q < 8; ++q) { v[q] = cmul(a[pb + ps * q], cur); cur = cmul(cur, w1); }
        dft8(v);
#ifdef __HIP_DEVICE_COMPILE__
#pragma unroll
#endif
        for (int r = 0; r < 8; ++r) a[pb + ps * r] = v[r];
    }
}
template <class LP> FC_HD void inv_pass1(cf* v, int tid, LP a, const cf* TWM) {
    FC_OPAQUE(tid);
    const cf w1 = TWM[tid]; cf cur = w1;
    const int pt = FC_PIDX(tid);
    v[0] = a[pt];
#ifdef __HIP_DEVICE_COMPILE__
#pragma unroll
#endif
    for (int q = 1; q < 16; ++q) { v[q] = cmul(a[pt + 576 * q], cur); cur = cmul(cur, w1); }
    dft16(v);
}

#define F2_PIDX(i) ((i) + ((i) >> 5))
#define F2_PADM (8192 + 256)
FC_HD void dft32(cf* v) {
    const float c[16] = {1.0f, 0.98078528040323043f, 0.92387953251128674f, 0.83146961230254524f, 0.70710678118654752f, 0.55557023301960218f, 0.38268343236508977f, 0.19509032201612825f,
                         0.0f, -0.19509032201612825f, -0.38268343236508977f, -0.55557023301960218f, -0.70710678118654752f, -0.83146961230254524f, -0.92387953251128674f, -0.98078528040323043f};
    const float s[16] = {0.0f, 0.19509032201612825f, 0.38268343236508977f, 0.55557023301960218f, 0.70710678118654752f, 0.83146961230254524f, 0.92387953251128674f, 0.98078528040323043f,
                         1.0f, 0.98078528040323043f, 0.92387953251128674f, 0.83146961230254524f, 0.70710678118654752f, 0.55557023301960218f, 0.38268343236508977f, 0.19509032201612825f};
#ifdef __HIP_DEVICE_COMPILE__
#pragma unroll
#endif
    for (int i = 0; i < 16; ++i) { const cf a = cadd(v[i], v[i + 16]); cf b = csub(v[i], v[i + 16]);
        if (i == 8) b = cmulnegi(b); else if (i != 0) { cf w; w.x = c[i]; w.y = -s[i]; b = cmul(b, w); }
        v[i] = a; v[i + 16] = b; }
    dft16(v); dft16(v + 16);
}
#define F2_Q(k) (2 * ((k) & 15) + ((k) >> 4))
template <class LP> FC_HD void f2_fwd_p1(cf* v, int tid, LP a, const cf* tw1) {
    dft16(v);
    FC_OPAQUE(tid);
    const cf w1 = tw1[tid]; cf cur = w1;
    const int pt = F2_PIDX(tid);
    a[pt] = v[0];
#ifdef __HIP_DEVICE_COMPILE__
#pragma unroll
#endif
    for (int q = 1; q < 16; ++q) { a[pt + 528 * q] = cmul(v[q], cur); cur = cmul(cur, w1); }
}
template <class LP> FC_HD void f2_fwd_p2(int tid, LP a, const cf* tw32) {
    FC_OPAQUE(tid);
    const int j = tid & 31, pb = F2_PIDX((tid >> 5) * 512 + j);
    cf v[16];
#ifdef __HIP_DEVICE_COMPILE__
#pragma unroll
#endif
    for (int r = 0; r < 16; ++r) v[r] = a[pb + 33 * r];
    dft16(v);
    const cf w1 = tw32[j]; cf cur = w1;
    a[pb] = v[0];
#ifdef __HIP_DEVICE_COMPILE__
#pragma unroll
#endif
    for (int q = 1; q < 16; ++q) { a[pb + 33 * q] = cmul(v[q], cur); cur = cmul(cur, w1); }
}
template <class LP> FC_HD void f2_fwd_p2_dual(int tid, LP a, LP b, const cf* tw32) {
    FC_OPAQUE(tid);
    const int j = tid & 31, pb = F2_PIDX((tid >> 5) * 512 + j);
    cf v[16], w[16];
#ifdef __HIP_DEVICE_COMPILE__
#pragma unroll
#endif
    for (int r = 0; r < 16; ++r) v[r] = a[pb + 33 * r];
#ifdef __HIP_DEVICE_COMPILE__
#pragma unroll
#endif
    for (int r = 0; r < 16; ++r) w[r] = b[pb + 33 * r];
    const cf w1 = tw32[j];
    dft16(v);
    { cf cur = w1; a[pb] = v[0];
#ifdef __HIP_DEVICE_COMPILE__
#pragma unroll
#endif
      for (int q = 1; q < 16; ++q) { a[pb + 33 * q] = cmul(v[q], cur); cur = cmul(cur, w1); } }
    dft16(w);
    { cf cur = w1; b[pb] = w[0];
#ifdef __HIP_DEVICE_COMPILE__
#pragma unroll
#endif
      for (int q = 1; q < 16; ++q) { b[pb + 33 * q] = cmul(w[q], cur); cur = cmul(cur, w1); } }
}
template <class LP> FC_HD void f2_inv_p2_dual(int tid, LP a, LP b, const cf* tw32) {
    FC_OPAQUE(tid);
    const int j = tid & 31, pb = F2_PIDX((tid >> 5) * 512 + j);
    cf v[16], w[16]; const cf w1 = tw32[j];
#ifdef __HIP_DEVICE_COMPILE__
#pragma unroll
#endif
    for (int r = 0; r < 16; ++r) v[r] = a[pb + 33 * r];
#ifdef __HIP_DEVICE_COMPILE__
#pragma unroll
#endif
    for (int r = 0; r < 16; ++r) w[r] = b[pb + 33 * r];
    { cf cur = w1;
#ifdef __HIP_DEVICE_COMPILE__
#pragma unroll
#endif
      for (int q = 1; q < 16; ++q) { v[q] = cmul(v[q], cur); cur = cmul(cur, w1); } }
    dft16(v);
#ifdef __HIP_DEVICE_COMPILE__
#pragma unroll
#endif
    for (int r = 0; r < 16; ++r) a[pb + 33 * r] = v[r];
    { cf cur = w1;
#ifdef __HIP_DEVICE_COMPILE__
#pragma unroll
#endif
      for (int q = 1; q < 16; ++q) { w[q] = cmul(w[q], cur); cur = cmul(cur, w1); } }
    dft16(w);
#ifdef __HIP_DEVICE_COMPILE__
#pragma unroll
#endif
    for (int r = 0; r < 16; ++r) b[pb + 33 * r] = w[r];
}
template <class LP> FC_HD void f2_mid(int bf, LP a, const cf* fr, cf* Fout, float fscale) {
    FC_OPAQUE(bf);
    const int pb = 33 * bf;
    cf v[32];
#ifdef __HIP_DEVICE_COMPILE__
#pragma unroll
#endif
    for (int i = 0; i < 32; ++i) v[i] = a[pb + i];
    dft32(v);
    if (fr) {
        cf w[32];
#ifdef __HIP_DEVICE_COMPILE__
#pragma unroll
#endif
        for (int k = 0; k < 32; ++k) w[F2_Q(k)] = cconj(cmul(v[k], fr[F2_Q(k)]));
        dft32(w);
#ifdef __HIP_DEVICE_COMPILE__
#pragma unroll
#endif
        for (int k = 0; k < 32; ++k) a[pb + F2_Q(k)] = w[k];
    } else {
#ifdef __HIP_DEVICE_COMPILE__
#pragma unroll
#endif
        for (int k = 0; k < 32; ++k) { cf o; o.x = v[k].x * fscale; o.y = v[k].y * fscale; Fout[F2_Q(k) * 256 + bf] = o; }
    }
}
typedef _Float16 h2v __attribute__((ext_vector_type(2)));
FC_HD unsigned pkh2(cf a) { h2v v; v.x = (_Float16)a.x; v.y = (_Float16)a.y; return __builtin_bit_cast(unsigned, v); }
FC_HD cf unh2(unsigned u) { const h2v v = __builtin_bit_cast(h2v, u); cf r; r.x = (float)v.x; r.y = (float)v.y; return r; }
template <class LP> FC_HD void f2_mid_store16(int bf, LP a, v2u* Fout) {
    FC_OPAQUE(bf);
    const int pb = 33 * bf;
    cf v[32];
#pragma unroll
    for (int i = 0; i < 32; ++i) v[i] = a[pb + i];
    dft32(v);
#pragma unroll
    for (int k = 0; k < 16; ++k) { v2u o; o.x = pkh2(v[k]); o.y = pkh2(v[k + 16]); Fout[k * 256 + bf] = o; }
}
template <class LP> FC_HD void f2_mid16(int bf, LP a, const v2u* fr16) {
    FC_OPAQUE(bf);
    const int pb = 33 * bf;
    cf v[32];
#pragma unroll
    for (int i = 0; i < 32; ++i) v[i] = a[pb + i];
    dft32(v);
    cf w[32];
#pragma unroll
    for (int k = 0; k < 32; ++k) w[F2_Q(k)] = cconj(cmul(v[k], unh2(k < 16 ? fr16[k & 15].x : fr16[k & 15].y)));
    dft32(w);
#pragma unroll
    for (int k = 0; k < 32; ++k) a[pb + F2_Q(k)] = w[k];
}
template <class LP> FC_HD void f2_inv_p2(int tid, LP a, const cf* tw32) {
    FC_OPAQUE(tid);
    const int j = tid & 31, pb = F2_PIDX((tid >> 5) * 512 + j);
    cf v[16]; const cf w1 = tw32[j]; cf cur = w1;
    v[0] = a[pb];
#ifdef __HIP_DEVICE_COMPILE__
#pragma unroll
#endif
    for (int q = 1; q < 16; ++q) { v[q] = cmul(a[pb + 33 * q], cur); cur = cmul(cur, w1); }
    dft16(v);
#ifdef __HIP_DEVICE_COMPILE__
#pragma unroll
#endif
    for (int r = 0; r < 16; ++r) a[pb + 33 * r] = v[r];
}
template <class LP> FC_HD void f2_inv_p1(cf* v, int tid, LP a, const cf* tw1) {
    FC_OPAQUE(tid);
    const cf w1 = tw1[tid]; cf cur = w1;
    const int pt = F2_PIDX(tid);
    v[0] = a[pt];
#ifdef __HIP_DEVICE_COMPILE__
#pragma unroll
#endif
    for (int q = 1; q < 16; ++q) { v[q] = cmul(a[pt + 528 * q], cur); cur = cmul(cur, w1); }
    dft16(v);
}

#define XB_TMO      128
#define XB_XCNT(j)  (256  + 64 * (j))
#define XB_XSUB(j)  (1280 + 64 * (j))
#define XB_XGEN(j)  (2304 + 64 * (j))
#define XB_TOP      3328
#define XB_TOPGEN   3392
#define XCD_BAR_WORDS 3456
#define XB_SPIN_CAP (1u << 18)
__device__ __forceinline__ unsigned xb_ld(unsigned* p)              { return __hip_atomic_load(p, __ATOMIC_RELAXED, __HIP_MEMORY_SCOPE_AGENT); }
__device__ __forceinline__ unsigned xb_add(unsigned* p, unsigned v) { return __hip_atomic_fetch_add(p, v, __ATOMIC_RELAXED, __HIP_MEMORY_SCOPE_AGENT); }
__device__ __forceinline__ unsigned xb_xcc_id() { return (unsigned)__builtin_amdgcn_s_getreg((3 << 11) | 20) & 0xFu; }
#define XB_SPIN(cond, bar) do { unsigned _sp = 0; while (cond) { __builtin_amdgcn_s_sleep(1); \
    if ((++_sp & 255u) == 0u) { if (xb_ld(&(bar)[XB_TMO])) break; if (_sp > XB_SPIN_CAP) { atomicAdd(&(bar)[XB_TMO], 1u); break; } } } } while (0)
struct XcdBarrier { unsigned* bar; unsigned x; volatile LAS unsigned* st; };
__device__ __forceinline__ XcdBarrier xcd_barrier_post(unsigned* bar, volatile LAS unsigned* st) {
    XcdBarrier b; b.bar = bar; b.x = xb_xcc_id(); b.st = st;
    if (threadIdx.x == 0) (void)xb_add(&bar[XB_XCNT(b.x)], 1u);
    return b;
}
__device__ __forceinline__ void xcd_barrier_complete(unsigned* bar, unsigned x, unsigned& nloc, unsigned& nx) {
    const unsigned G = gridDim.x * gridDim.y * gridDim.z;
    unsigned sum, cnt, mine, sp = 0u;
    for (;;) {
        sum = 0u; cnt = 0u; mine = 0u;
#pragma unroll
        for (unsigned j = 0; j < 16; ++j) { const unsigned c = xb_ld(&bar[XB_XCNT(j)]); sum += c; cnt += (c > 0u) ? 1u : 0u; mine = (j == x) ? c : mine; }
        if (sum == G) break;
        __builtin_amdgcn_s_sleep(1);
        if ((++sp & 255u) == 0u) { if (xb_ld(&bar[XB_TMO])) break; if (sp > XB_SPIN_CAP) { atomicAdd(&bar[XB_TMO], 1u); break; } }
    }
    nloc = mine > 0u ? mine : 1u; nx = cnt > 0u ? cnt : 1u;
}
__device__ __forceinline__ void xcd_barrier(const XcdBarrier& b) {
    asm volatile("s_waitcnt vmcnt(0)" ::: "memory");
    __syncthreads();
    if (threadIdx.x == 0) {
        unsigned* bar = b.bar;
        __builtin_amdgcn_s_waitcnt(0);
        unsigned nloc = b.st[0], nx = b.st[1];
        if (nloc == 0u) { xcd_barrier_complete(bar, b.x, nloc, nx); b.st[0] = nloc; b.st[1] = nx; }
        const unsigned old = xb_add(&bar[XB_XSUB(b.x)], 1u);
        const unsigned gen = old / nloc;
        if (old + 1u == (gen + 1u) * nloc) {
            __builtin_amdgcn_fence(__ATOMIC_RELEASE, "agent");
            asm volatile("s_waitcnt vmcnt(0)" ::: "memory");
            const unsigned og = xb_add(&bar[XB_TOP], 1u);
            const unsigned tg = og / nx;
            if (og + 1u == (tg + 1u) * nx) xb_add(&bar[XB_TOPGEN], 1u);
            else XB_SPIN(xb_ld(&bar[XB_TOPGEN]) == tg, bar);
            __builtin_amdgcn_fence(__ATOMIC_ACQUIRE, "agent");
            xb_add(&bar[XB_XGEN(b.x)], 1u);
            asm volatile("s_waitcnt vmcnt(0)" ::: "memory");
        } else {
            XB_SPIN(xb_ld(&bar[XB_XGEN(b.x)]) == gen, bar);
            __builtin_amdgcn_fence(__ATOMIC_ACQUIRE, "agent");
            asm volatile("s_waitcnt vmcnt(0)" ::: "memory");
        }
    }
    __syncthreads();
}

struct Args { const float* in[40]; float* out; unsigned char* ws; int ph_lo, ph_hi, repmask, li; };
struct Frame {
    LAS unsigned char* lds;
    int tid, lane, wave, vcu, G;
    const float* const* in; float* out; unsigned char* ws;
#ifdef PROBE_SEC
    unsigned long long sec;
#endif
};
__device__ __forceinline__ float wave_sum(float v) {
#pragma unroll
    for (int o = 1; o < 64; o <<= 1) v += __shfl_xor(v, o);
    return v;
}
__device__ __forceinline__ float silu_f(float x) { return x / (1.f + __expf(-x)); }

__device__ __forceinline__ float gelu_f(float v) { return 0.5f * v * (1.f + erff(v * 0.70710678118654752f)); }

__device__ __forceinline__ void transpose_item(const float* W, int K, int N, bf16* WT, int src_col0, int dst_row0, int k0, LAS float* scr, int lane) {
    {
        const int r8 = lane >> 3, c4 = (lane & 7) * 4;
        f32x4 x[8];
#pragma unroll
        for (int i = 0; i < 8; ++i) x[i] = *(const f32x4*)(W + (size_t)(k0 + 8 * i + r8) * N + src_col0 + c4);
#pragma unroll
        for (int i = 0; i < 8; ++i) { LAS float* d = scr + (8 * i + r8) * 33 + c4; d[0] = x[i].x; d[1] = x[i].y; d[2] = x[i].z; d[3] = x[i].w; }
    }
    LDS_WAIT(); asm volatile("" ::: "memory");
    const int c = lane & 7;
#pragma unroll
    for (int j = 0; j < 4; ++j) { const int n = (lane >> 3) + 8 * j; const LAS float* s = scr + (8 * c) * 33 + n;
        v4u o; o.x = pk2(s[0 * 33], s[1 * 33]); o.y = pk2(s[2 * 33], s[3 * 33]); o.z = pk2(s[4 * 33], s[5 * 33]); o.w = pk2(s[6 * 33], s[7 * 33]);
        *(GAS v4u*)(WT + (size_t)(dst_row0 + n) * K + k0 + 8 * c) = o; }
    LDS_WAIT(); asm volatile("" ::: "memory");
}
__device__ __forceinline__ void transpose_load(const float* W, int N, int src_col0, int k0, int lane, f32x4 (&x)[8]) {
    const int r8 = lane >> 3, c4 = (lane & 7) * 4;
#pragma unroll
    for (int i = 0; i < 8; ++i) x[i] = *(const f32x4*)(W + (size_t)(k0 + 8 * i + r8) * N + src_col0 + c4);
}
__device__ __forceinline__ void transpose_finish(const f32x4 (&x)[8], int K, bf16* WT, int dst_row0, int k0, LAS float* scr, int lane) {
    { const int r8 = lane >> 3, c4 = (lane & 7) * 4;
#pragma unroll
      for (int i = 0; i < 8; ++i) { LAS float* d = scr + (8 * i + r8) * 33 + c4; d[0] = x[i].x; d[1] = x[i].y; d[2] = x[i].z; d[3] = x[i].w; } }
    LDS_WAIT(); asm volatile("" ::: "memory");
    const int c = lane & 7;
#pragma unroll
    for (int j = 0; j < 4; ++j) { const int n = (lane >> 3) + 8 * j; const LAS float* s = scr + (8 * c) * 33 + n;
        v4u o; o.x = pk2(s[0 * 33], s[1 * 33]); o.y = pk2(s[2 * 33], s[3 * 33]); o.z = pk2(s[4 * 33], s[5 * 33]); o.w = pk2(s[6 * 33], s[7 * 33]);
        *(GAS v4u*)(WT + (size_t)(dst_row0 + n) * K + k0 + 8 * c) = o; }
    LDS_WAIT(); asm volatile("" ::: "memory");
}
__device__ __forceinline__ int qkv_slot_to_col(int slot) {
    const int part = slot >> 10, cc = slot & 1023, pnl = cc >> 8, s = cc & 255, bj = s >> 7, wc = (s & 127) >> 5, j = s & 31;
    return part * 1024 + (4 * pnl + wc) * 64 + 32 * bj + j;
}
__device__ __forceinline__ int up_slot_to_col(int slot) { const int pn = slot >> 8, bj = (slot >> 7) & 1, cc = slot & 127; return bj * FF + pn * 128 + cc; }
__device__ __forceinline__ void cvt_weight_item(const float* W, int K, int N, bf16* WT, int item, LAS float* scr, int lane, int perm) {
    const int nblk = N / 32, kb = item / nblk, nb = item % nblk;
    const int dst = 32 * nb, src = perm == 1 ? qkv_slot_to_col(dst) : (perm == 2 ? up_slot_to_col(dst) : dst);
    transpose_item(W, K, N, WT, src, dst, 64 * kb, scr, lane);
}

template <int R, class VF>
__device__ __forceinline__ void gemv_det_item(const float* W, int N, int n0, float* out, int ostride, const float* addbias, const VF& vf, int tid, LAS float* scr) {
    const int col = tid & 63, ks = tid >> 6;
    float acc[R];
#pragma unroll
    for (int r = 0; r < R; ++r) acc[r] = 0.f;
    const float* wp = W + (size_t)(ks * 128) * N + n0 + col;
#pragma unroll 32
    for (int k = 0; k < 128; ++k) { const float w = wp[(size_t)k * N];
#pragma unroll
        for (int r = 0; r < R; ++r) acc[r] += vf(r, ks * 128 + k) * w; }
    __syncthreads();
#pragma unroll
    for (int r = 0; r < R; ++r) scr[(ks * R + r) * 64 + col] = acc[r];
    __syncthreads();
    if (tid < R * 64) { const int r = tid >> 6; float s = 0.f;
#pragma unroll
        for (int k2 = 0; k2 < 8; ++k2) s += scr[(k2 * R + r) * 64 + col];
        if (addbias) s += addbias[n0 + col];
        out[(size_t)r * ostride + n0 + col] = s; }
}

template <int R, class VF>
__device__ __forceinline__ void gemv_det_item16(const float* W, int N, int n0, float* out, int ostride, const float* addbias, const VF& vf, int tid, LAS float* scr) {
    const int col = tid & 15, ks = tid >> 4;
    float acc[R];
#pragma unroll
    for (int r = 0; r < R; ++r) acc[r] = 0.f;
    const float* wp = W + (size_t)(ks * 32) * N + n0 + col;
#pragma unroll 8
    for (int k = 0; k < 32; ++k) { const float w = wp[(size_t)k * N];
#pragma unroll
        for (int r = 0; r < R; ++r) acc[r] += vf(r, ks * 32 + k) * w; }
    __syncthreads();
#pragma unroll
    for (int r = 0; r < R; ++r) scr[(ks * R + r) * 16 + col] = acc[r];
    __syncthreads();
    if (tid < R * 16) { const int r = tid >> 4; float s = 0.f;
#pragma unroll
        for (int k2 = 0; k2 < 32; ++k2) s += scr[(k2 * R + r) * 16 + col];
        if (addbias) s += addbias[n0 + col];
        out[(size_t)r * ostride + n0 + col] = s; }
}

__device__ __forceinline__ void phase0a(Frame& F) {
    const float* const* in = F.in;
    float* mods = (float*)(F.ws + CT_MODS);
    {
        const float* c = in[1]; const float* cctx = in[3];
        LAS float* sl = (LAS float*)(F.lds + 65536);
        for (int e = F.tid; e < 5 * DM; e += 512) { const float v = (e < 4 * DM) ? c[e] : cctx[e - 4 * DM]; sl[e] = silu_f(v); }
        __syncthreads();
        auto vf = [&](int r, int k) -> float { return sl[r * DM + k]; };
        const int nitems = 2 * 96;
        for (int it = F.vcu; it < nitems; it += F.G) {
            const int l = it / 96, cg = it % 96;
            gemv_det_item<5>(in[l ? 17 : 4], 6144, cg * 64, mods + l * 5 * 6144, 6144, in[l ? 18 : 5], vf, F.tid, (LAS float*)F.lds);
        }
        __syncthreads();
    }
    for (int e = F.vcu * 512 + F.tid; e < 16384; e += F.G * 512) {
        const int k = e & 8191; const bool isn = e >= 8192;
        float sn, cs; sincospif(isn ? (float)k * (1.0f / 8192.0f) : (float)k * (1.0f / 4096.0f), &sn, &cs);
        cf t; t.x = cs; t.y = -sn;
        ((cf*)(F.ws + (isn ? SM_TWN : SM_TWM)))[k] = t;
    }
    LAS float* scr = (LAS float*)(F.lds + F.wave * 16384);
    const int gw = F.vcu * NWAVES + F.wave, NGW = F.G * NWAVES;
    constexpr int I_QKV = 16 * 96, I_O = 16 * 32, I_UP = 16 * 176, I_DN = 44 * 32;
    constexpr int NITEMS = 2 * I_QKV + 2 * I_O + 2 * I_UP + 2 * I_DN;
    struct CvtD { const float* W; bf16* WT; int K, N, src, dst, k0; };
    auto desc = [&](int it) -> CvtD {
        int r = it; const float* W; bf16* WT; int K, N, perm = 0;
        if (r < I_QKV) { W = in[8]; K = DM; N = 3 * DM; WT = (bf16*)(F.ws + WS_WQKV); perm = 1; }
        else if ((r -= I_QKV) < I_O) { W = in[12]; K = DM; N = DM; WT = (bf16*)(F.ws + WS_WO); }
        else if ((r -= I_O) < I_UP) { W = in[13]; K = DM; N = 2 * FF; WT = (bf16*)(F.ws + WS_WUP0); perm = 2; }
        else if ((r -= I_UP) < I_DN) { W = in[16]; K = FF; N = DM; WT = (bf16*)(F.ws + WS_WDN0); }
        else if ((r -= I_DN) < I_QKV) { W = in[21]; K = DM; N = 3 * DM; WT = (bf16*)(F.ws + WS_WIN); }
        else if ((r -= I_QKV) < I_O) { W = in[34]; K = DM; N = DM; WT = (bf16*)(F.ws + WS_WOUT); }
        else if ((r -= I_O) < I_UP) { W = in[36]; K = DM; N = 2 * FF; WT = (bf16*)(F.ws + WS_WUP1); perm = 2; }
        else { r -= I_UP; W = in[39]; K = FF; N = DM; WT = (bf16*)(F.ws + WS_WDN1); }
        const int nblk = N / 32, kb = r / nblk, nb = r % nblk, dst = 32 * nb;
        const int src = perm == 1 ? qkv_slot_to_col(dst) : (perm == 2 ? up_slot_to_col(dst) : dst);
        return CvtD{W, WT, K, N, src, dst, 64 * kb};
    };
    if (gw < NITEMS) {
        f32x4 xc[8], xn[8];
        CvtD dc = desc(gw);
        transpose_load(dc.W, dc.N, dc.src, dc.k0, F.lane, xc);
        for (int it = gw; it < NITEMS; it += NGW) {
            const CvtD dn = desc(min(it + NGW, NITEMS - 1));
            transpose_load(dn.W, dn.N, dn.src, dn.k0, F.lane, xn);
            transpose_finish(xc, dc.K, dc.WT, dc.dst, dc.k0, scr, F.lane);
#pragma unroll
            for (int i = 0; i < 8; ++i) xc[i] = xn[i];
            dc = dn;
        }
    }
}

__device__ __forceinline__ void row_prescale(const float* xrow, const float* gain, const float* sc, bf16* orow, float* ssq_out, int lane) {
    const GAS f32x4* xr = (const GAS f32x4*)xrow + lane;
    const GAS f32x4* gr = (const GAS f32x4*)gain + lane;
    const GAS f32x4* sr = (const GAS f32x4*)sc + lane;
    f32x4 v[4]; float s = 0.f;
#pragma unroll
    for (int j = 0; j < 4; ++j) { v[j] = xr[64 * j]; s += (v[j].x * v[j].x + v[j].y * v[j].y) + (v[j].z * v[j].z + v[j].w * v[j].w); }
    s = wave_sum(s);
    if (lane == 0) *ssq_out = s;
    GAS unsigned long long* o8 = (GAS unsigned long long*)orow + lane;
#pragma unroll
    for (int j = 0; j < 4; ++j) { const f32x4 g = gr[64 * j], c = sr[64 * j]; const f32x4 w = v[j] * g * (c + 1.0f);
        o8[64 * j] = (unsigned long long)pk2(w.x, w.y) | ((unsigned long long)pk2(w.z, w.w) << 32); }
}
__device__ __forceinline__ void phase0b(Frame& F) {
    const float* const* in = F.in;
    const float* mods = (const float*)(F.ws + CT_MODS);
    const int gw = F.vcu * NWAVES + F.wave, NGW = F.G * NWAVES;
    for (int m = gw; m < TT + TC; m += NGW) {
        if (m < TT) { const int b = m / SEQ; row_prescale(in[0] + (size_t)m * DM, in[6], mods + b * 6144 + 1024, (bf16*)(F.ws + WS_XS) + (size_t)m * DM, (float*)(F.ws + SM_SSQ0) + m, F.lane); }
        else { const int mc = m - TT; row_prescale(in[2] + (size_t)mc * DM, in[6], mods + 4 * 6144 + 1024, (bf16*)(F.ws + WS_XSC) + (size_t)mc * DM, (float*)(F.ws + SM_SSQC) + mc, F.lane); }
    }
    {
        float* gn = (float*)(F.ws + SM_GN);
        for (int e = F.vcu * 512 + F.tid; e < 3 * 4 * 1024; e += F.G * 512) {
            const int i = e / 4096, b = (e / 1024) & 3, k = e & 1023;
            const float* g = in[i == 0 ? 7 : (i == 1 ? 19 : 20)];
            const float sc = mods[(i == 0 ? 0 : 1) * 5 * 6144 + b * 6144 + (i == 1 ? 1024 : 4096) + k];
            gn[e] = g[k] * (1.f + sc);
        }
    }
    {
        LAS float* gs = (LAS float*)F.lds;
        for (int it = F.vcu; it < 192; it += F.G) { auto vf = [&](int r, int k) -> float { return mods[r * 6144 + k]; };
            gemv_det_item16<5>(in[8], 3072, it * 16, (float*)(F.ws + CT_BQKV), 3072, nullptr, vf, F.tid, gs); }
        __syncthreads();
    }
}
__device__ __forceinline__ void bias_gemv_late(Frame& F, int it) {
    const float* const* in = F.in;
    const float* mods = (const float*)(F.ws + CT_MODS);
    const int n_up = 88, n_in = 48;
    LAS float* gs = (LAS float*)F.lds;
    if (it < n_up) { auto vf = [&](int r, int k) -> float { return mods[r * 6144 + 3072 + k]; };
        gemv_det_item<4>(in[13], 5632, it * 64, (float*)(F.ws + CT_BUP0), 5632, nullptr, vf, F.tid, gs); }
    else if (it < n_up + n_in) { it -= n_up; auto vf = [&](int r, int k) -> float { return mods[5 * 6144 + r * 6144 + k]; };
        gemv_det_item<4>(in[21], 3072, it * 64, (float*)(F.ws + CT_BIN), 3072, in[22], vf, F.tid, gs); }
    else if (it < 2 * n_up + n_in) { it -= n_up + n_in; auto vf = [&](int r, int k) -> float { return mods[5 * 6144 + r * 6144 + 3072 + k]; };
        gemv_det_item<4>(in[36], 5632, it * 64, (float*)(F.ws + CT_BUP1), 5632, nullptr, vf, F.tid, gs); }
    __syncthreads();
}

using pg8::f32x4; using pg8::Unit;
__device__ __forceinline__ float row_rs(const float* ssq, int np, int row) {
    float s = 0.f;
    for (int i = 0; i < np; ++i) s += ssq[(size_t)i * TT + row];
    return 1.0f / sqrtf(s * (1.0f / 1024.0f) + EPS);
}
constexpr float QSCALE = 0.125f * 1.4426950408889634f;
template <int PART>
struct EpiQK {
    static constexpr bool PERM = true;
    bf16* dst; const float* ssq; int np; const float* bias; int bias_bstride; const float* gain; int seqlen;
    __device__ __forceinline__ void operator()(const f32x4 (&acc)[2][2][4][2], const Unit& u, int wr, int wc, int fr, int fq) const {
        const int head = 4 * u.pn + wc;
        const int b = (u.pm * 256) / seqlen;
        const float* bp = bias + (size_t)b * bias_bstride + PART * 1024 + head * 64 + 8 * fq;
        const float* gp = gain + 8 * fq;
        const float osc = PART == 0 ? QSCALE : 1.0f;
#pragma unroll
        for (int ai = 0; ai < 2; ++ai)
#pragma unroll
            for (int m = 0; m < 4; ++m) {
                const int row = u.pm * 256 + ai * 128 + wr * 64 + m * 16 + fr;
                const float rs = row_rs(ssq, np, row);
                f32x4 v[2][2]; float ss = 0.f;
#pragma unroll
                for (int bj = 0; bj < 2; ++bj)
#pragma unroll
                    for (int n = 0; n < 2; ++n) { v[bj][n] = acc[ai][bj][m][n] * rs + *(const f32x4*)(bp + 32 * bj + 4 * n); const f32x4 t = v[bj][n]; ss += (t.x * t.x + t.y * t.y) + (t.z * t.z + t.w * t.w); }
                ss += __shfl_xor(ss, 16); ss += __shfl_xor(ss, 32);
                const float rn = osc / sqrtf(ss * (1.0f / 64.0f) + EPS);
                const int tl = row - b * seqlen;
                bf16* rowp = (PART == 0) ? dst + (size_t)row * DM + head * 64 + 8 * fq
                                         : dst + ((((size_t)(b * NH + head) * (seqlen / 16) + (tl >> 4)) * 8 + fq) * 16 + (tl & 15)) * 8;
                constexpr int bjstep = (PART == 0) ? 32 : 4 * 16 * 8;
#pragma unroll
                for (int bj = 0; bj < 2; ++bj) { const f32x4 a0 = v[bj][0] * rn * *(const f32x4*)(gp + 32 * bj), a1 = v[bj][1] * rn * *(const f32x4*)(gp + 32 * bj + 4);
                    v4u w; w.x = pk2(a0.x, a0.y); w.y = pk2(a0.z, a0.w); w.z = pk2(a1.x, a1.y); w.w = pk2(a1.z, a1.w);
                    *(v4u*)(rowp + bjstep * bj) = w; }
                asm volatile("" ::: "memory");
            }
    }
};
struct EpiVT {
    static constexpr bool PERM = true;
    bf16* VTp; const float* ssq; int np; const float* bias; int bias_bstride; int seqlen;
    __device__ __forceinline__ void operator()(const f32x4 (&acc)[2][2][4][2], const Unit& u, int wr, int wc, int fr, int fq) const {
        const int head = 4 * u.pn + wc;
        const int b = (u.pm * 256) / seqlen;
        const float* bp = bias + (size_t)b * bias_bstride + 2048 + head * 64 + 8 * fq;
        const int odd = fr & 1;
        f32x4 bv[2][2];
#pragma unroll
        for (int bj = 0; bj < 2; ++bj)
#pragma unroll
            for (int n = 0; n < 2; ++n) bv[bj][n] = *(const f32x4*)(bp + 32 * bj + 4 * n);
#pragma unroll
        for (int ai = 0; ai < 2; ++ai)
#pragma unroll
            for (int m = 0; m < 4; ++m) {
                const int row = u.pm * 256 + ai * 128 + wr * 64 + m * 16 + fr;
                const float rs = row_rs(ssq, np, row);
                const int tl = row - b * seqlen;
                const int c16 = tl & 14, cpos = (c16 & 3) | ((c16 & 8) >> 1) | ((c16 & 4) << 1);
                bf16* vb = VTp + (((size_t)(b * NH + head) * (seqlen / 16) + (tl >> 4)) * 64 + 8 * fq + odd) * 16 + cpos;
#pragma unroll
                for (int bj = 0; bj < 2; ++bj)
#pragma unroll
                    for (int n = 0; n < 2; ++n) {
                        const f32x4 v = acc[ai][bj][m][n] * rs + bv[bj][n];
                        const unsigned w01 = pk2(v.x, v.y), w23 = pk2(v.z, v.w);
                        const unsigned p01 = (unsigned)__shfl_xor((int)w01, 1), p23 = (unsigned)__shfl_xor((int)w23, 1);
                        const unsigned o0 = odd ? ((w01 & 0xffff0000u) | (p01 >> 16)) : ((p01 << 16) | (w01 & 0xffffu));
                        const unsigned o1 = odd ? ((w23 & 0xffff0000u) | (p23 >> 16)) : ((p23 << 16) | (w23 & 0xffffu));
                        bf16* p = vb + (32 * bj + 4 * n) * 16;
                        *(unsigned*)p = o0; *(unsigned*)(p + 2 * 16) = o1;
                    }
            }
    }
};
template <bool BASE_F32, bool OUT_F32>
struct EpiRes {
    static constexpr bool PERM = true;
    const void* base; void* out; const float* gate; const float* bias; const float* gn; bf16* xs; float* ssq; float* hs;
    __device__ __forceinline__ void operator()(const f32x4 (&acc)[2][2][4][2], const Unit& u, int wr, int wc, int fr, int fq) const {
        const int b = (u.pm * 256) / SEQ;
        const int col0 = u.pn * 256 + wc * 32 + 8 * fq;
        constexpr int MB = BASE_F32 ? 2 : 4;
#pragma unroll
        for (int ai = 0; ai < 2; ++ai)
#pragma unroll
        for (int mb = 0; mb < 4; mb += MB) {
            f32x4 bf[MB][2][2]; v4u bh[MB][2];
#pragma unroll
            for (int mi = 0; mi < MB; ++mi) { const size_t off = (size_t)(u.pm * 256 + ai * 128 + wr * 64 + (mb + mi) * 16 + fr) * DM + col0;
#pragma unroll
                for (int bj = 0; bj < 2; ++bj) {
                    if (BASE_F32) { bf[mi][bj][0] = *(const f32x4*)((const float*)base + off + 128 * bj); bf[mi][bj][1] = *(const f32x4*)((const float*)base + off + 128 * bj + 4); }
                    else bh[mi][bj] = *(const v4u*)((const bf16*)base + off + 128 * bj); } }
#pragma unroll
            for (int mi = 0; mi < MB; ++mi) {
                const int m = mb + mi;
                const int rowl = ai * 128 + wr * 64 + m * 16 + fr;
                const size_t off = (size_t)(u.pm * 256 + rowl) * DM + col0;
                float ss = 0.f;
#pragma unroll
                for (int bj = 0; bj < 2; ++bj) {
                    const int c = col0 + 128 * bj;
                    f32x4 b0, b1;
                    if (BASE_F32) { b0 = bf[mi][bj][0]; b1 = bf[mi][bj][1]; }
                    else { const v4u w = bh[mi][bj]; b0 = (f32x4){bflo(w.x), bfhi(w.x), bflo(w.y), bfhi(w.y)}; b1 = (f32x4){bflo(w.z), bfhi(w.z), bflo(w.w), bfhi(w.w)}; }
                    f32x4 a0 = acc[ai][bj][m][0], a1 = acc[ai][bj][m][1];
                    if (bias) { a0 += *(const f32x4*)(bias + c); a1 += *(const f32x4*)(bias + c + 4); }
                    const f32x4 x0 = b0 + *(const f32x4*)(gate + (size_t)b * 6144 + c) * a0, x1 = b1 + *(const f32x4*)(gate + (size_t)b * 6144 + c + 4) * a1;
                    if (OUT_F32) { *(f32x4*)((float*)out + off + 128 * bj) = x0; *(f32x4*)((float*)out + off + 128 * bj + 4) = x1; }
                    else {
                        v4u w; w.x = pk2(x0.x, x0.y); w.y = pk2(x0.z, x0.w); w.z = pk2(x1.x, x1.y); w.w = pk2(x1.z, x1.w);
                        *(v4u*)((bf16*)out + off + 128 * bj) = w;
                        const f32x4 r0 = (f32x4){bflo(w.x), bfhi(w.x), bflo(w.y), bfhi(w.y)}, r1 = (f32x4){bflo(w.z), bfhi(w.z), bflo(w.w), bfhi(w.w)};
                        ss += (r0.x * r0.x + r0.y * r0.y) + (r0.z * r0.z + r0.w * r0.w) + (r1.x * r1.x + r1.y * r1.y) + (r1.z * r1.z + r1.w * r1.w);
                        const f32x4 q0 = r0 * *(const f32x4*)(gn + (size_t)b * 1024 + c), q1 = r1 * *(const f32x4*)(gn + (size_t)b * 1024 + c + 4);
                        v4u ws2; ws2.x = pk2(q0.x, q0.y); ws2.y = pk2(q0.z, q0.w); ws2.z = pk2(q1.x, q1.y); ws2.w = pk2(q1.z, q1.w);
                        *(v4u*)(xs + off + 128 * bj) = ws2;
                    }
                }
                if (!OUT_F32) { ss += __shfl_xor(ss, 16); ss += __shfl_xor(ss, 32); if (fq == 0) hs[rowl * 4 + wc] = ss; }
            }
            asm volatile("" ::: "memory");
        }
        if (!OUT_F32) {
            asm volatile("s_waitcnt lgkmcnt(0)" ::: "memory"); __builtin_amdgcn_s_barrier(); asm volatile("" ::: "memory");
            const int tid = threadIdx.x;
            if (tid < 256) { const f32x4 p = *(const f32x4*)(hs + tid * 4); ssq[(size_t)u.pn * TT + u.pm * 256 + tid] = ((p.x + p.y) + p.z) + p.w; }
        }
    }
};
struct EpiScaleBias {
    static constexpr bool PERM = true;
    bf16* O; int ldc; const float* ssq; int np; const float* bias; int bias_bstride;
    __device__ __forceinline__ void operator()(const f32x4 (&acc)[2][2][4][2], const Unit& u, int wr, int wc, int fr, int fq) const {
        const int b = (u.pm * 256) / SEQ;
        const int col0 = u.pn * 256 + wc * 32 + 8 * fq;
        f32x4 bv[2][2];
#pragma unroll
        for (int bj = 0; bj < 2; ++bj)
#pragma unroll
            for (int n = 0; n < 2; ++n) bv[bj][n] = *(const f32x4*)(bias + (size_t)b * bias_bstride + col0 + 128 * bj + 4 * n);
#pragma unroll
        for (int ai = 0; ai < 2; ++ai)
#pragma unroll
            for (int m = 0; m < 4; ++m) {
                const int row = u.pm * 256 + ai * 128 + wr * 64 + m * 16 + fr;
                const float rs = row_rs(ssq, np, row);
                bf16* rowp = O + (size_t)row * ldc + col0;
#pragma unroll
                for (int bj = 0; bj < 2; ++bj) { const f32x4 v0 = acc[ai][bj][m][0] * rs + bv[bj][0], v1 = acc[ai][bj][m][1] * rs + bv[bj][1];
                    v4u w; w.x = pk2(v0.x, v0.y); w.y = pk2(v0.z, v0.w); w.z = pk2(v1.x, v1.y); w.w = pk2(v1.z, v1.w);
                    *(v4u*)(rowp + 128 * bj) = w; }
            }
    }
};
__device__ __forceinline__ float gelu_as(float v) {
    const float av = fabsf(v), t = __builtin_amdgcn_rcpf(av * 0.2316418882f + 1.0f);
    float q = t * 0.5307027145f + (-0.7265760135f); q = q * t + 0.7107068705f; q = q * t + (-0.142248368f); q = q * t + 0.127414796f; q = q * t;
    const float e = __builtin_amdgcn_exp2f((v * v) * (-0.72134752044f));
    const float m = v * (q * e);
    return v < 0.f ? m : v - m;
}
template <int CTRL> __device__ __forceinline__ float dpp_f(float old, float src) {
    return __builtin_bit_cast(float, __builtin_amdgcn_update_dpp(__builtin_bit_cast(int, old), __builtin_bit_cast(int, src), CTRL, 0xf, 0xf, false));
}
struct EpiUpGlu {
    static constexpr bool PERM = true;
    bf16* act; const float* ssq; int np; const float* bias; const float* cw; const float* cb; float* Hg; float* Ha; float* hl;
    __device__ __forceinline__ void prefetch(const Unit& u) const {
        int tid = threadIdx.x; asm volatile("" : "+v"(tid));
        const int wv = __builtin_amdgcn_readfirstlane(tid >> 6), ln = tid & 63;
        if (wv < 7) {
            const int b = (u.pm * 256) / SEQ, hf = ln >> 5, c4 = u.pn * 128 + (ln & 31) * 4;
            const float* src;
            if (wv == 0) src = bias + (size_t)b * 5632 + hf * FF + c4;
            else if (wv == 1) src = cw + hf * FF + c4;
            else if (wv == 2) src = (hf ? cb : cw + 2 * FF) + c4;
            else src = ssq + (size_t)(wv - 3) * TT + u.pm * 256 + ln * 4;
            __builtin_amdgcn_global_load_lds((const unsigned*)src, (LAS unsigned*)((unsigned char*)hl + (CB_LDS_OFF - RING_BYTES) + wv * 1024), 16, 0, 0);
        }
    }
    __device__ __forceinline__ void operator()(f32x4 (&acc)[2][2][4][2], const Unit& u, int wr, int wc, int fr_, int fq_) const {
        int ln_ = threadIdx.x & 63; asm volatile("" : "+v"(ln_));
        const int fr = ln_ & 15, fq = ln_ >> 4;
        const int j0 = u.pn * 128 + wc * 32 + 8 * fq;
        const float* ct = (const float*)((const unsigned char*)hl + (CB_LDS_OFF - RING_BYTES));
        const int jl = wc * 32 + 8 * fq;
        {
            f32x4 ba[2], bg[2];
#pragma unroll
            for (int n = 0; n < 2; ++n) { ba[n] = *(const f32x4*)(ct + jl + 4 * n); bg[n] = *(const f32x4*)(ct + 128 + jl + 4 * n); }
#pragma unroll
            for (int ai = 0; ai < 2; ++ai)
#pragma unroll
                for (int m = 0; m < 4; ++m) { const int rl_ = ai * 128 + wr * 64 + m * 16 + fr;
                    const float rs = 1.0f / sqrtf((((ct[768 + rl_] + ct[1024 + rl_]) + ct[1280 + rl_]) + ct[1536 + rl_]) * (1.0f / 1024.0f) + EPS);
#pragma unroll
                    for (int n = 0; n < 2; ++n) { acc[ai][0][m][n] = acc[ai][0][m][n] * rs + ba[n]; acc[ai][1][m][n] = acc[ai][1][m][n] * rs + bg[n]; }
                    if (m == 3) asm volatile("" ::: "memory"); }
        }
#pragma unroll
        for (int ai = 0; ai < 2; ++ai) { float* hp = hl + ((2 * ai + wr) * 2) * 128 + wc * 32 + 8 * fq;
            if (fr == 0) { *(f32x4*)(hp) = acc[ai][1][0][0]; *(f32x4*)(hp + 4) = acc[ai][1][0][1]; }
            if (fr == 15) { *(f32x4*)(hp + 128) = acc[ai][1][3][0]; *(f32x4*)(hp + 132) = acc[ai][1][3][1]; } }
        asm volatile("s_waitcnt lgkmcnt(0)" ::: "memory"); __builtin_amdgcn_s_barrier(); asm volatile("" ::: "memory");
        if (wr == 0 && fr < 2) { float* p = Hg + ((size_t)u.pm * 4 + fr) * FF + j0; *(f32x4*)p = acc[0][1][0][0]; *(f32x4*)(p + 4) = acc[0][1][0][1];
            if (fr == 0) { float* q = Ha + ((size_t)u.pm * 2) * FF + j0; *(f32x4*)q = acc[0][0][0][0]; *(f32x4*)(q + 4) = acc[0][0][0][1]; } }
        if (wr == 1 && fr >= 14) { float* p = Hg + ((size_t)u.pm * 4 + 2 + (fr - 14)) * FF + j0; *(f32x4*)p = acc[1][1][3][0]; *(f32x4*)(p + 4) = acc[1][1][3][1];
            if (fr == 15) { float* q = Ha + ((size_t)u.pm * 2 + 1) * FF + j0; *(f32x4*)q = acc[1][0][3][0]; *(f32x4*)(q + 4) = acc[1][0][3][1]; } }
#pragma unroll
        for (int n = 0; n < 2; ++n) {
            const f32x4 w0 = *(const f32x4*)(ct + 256 + jl + 4 * n), w1 = *(const f32x4*)(ct + 384 + jl + 4 * n), w2 = *(const f32x4*)(ct + 512 + jl + 4 * n), cbv = *(const f32x4*)(ct + 640 + jl + 4 * n);
#pragma unroll
            for (int ai = 0; ai < 2; ++ai) {
                const int gi = 2 * ai + wr;
                const f32x4 uph = *(const f32x4*)(hl + (((gi + 3) & 3) * 2 + 1) * 128 + wc * 32 + 8 * fq + 4 * n);
                const f32x4 dnh = *(const f32x4*)(hl + (((gi + 1) & 3) * 2) * 128 + wc * 32 + 8 * fq + 4 * n);
#pragma unroll
                for (int m = 0; m < 4; ++m) {
                    const int rowl = ai * 128 + wr * 64 + m * 16 + fr;
                    f32x4 r;
#pragma unroll
                    for (int e = 0; e < 4; ++e) {
                        const float g = acc[ai][1][m][n][e];
                        const float pu = (m > 0) ? dpp_f<0x121>(g, acc[ai][1][m > 0 ? m - 1 : 0][n][e]) : uph[e];
                        const float up = dpp_f<0x111>(pu, g);
                        const float pd = (m < 3) ? dpp_f<0x12f>(g, acc[ai][1][m < 3 ? m + 1 : 3][n][e]) : dnh[e];
                        const float dn = dpp_f<0x101>(pd, g);
                        const float cv = w0[e] * up + w1[e] * g + w2[e] * dn + cbv[e];
                        r[e] = acc[ai][0][m][n][e] * gelu_as(cv);
                    }
                    if (rowl != 0 && rowl != 255) { v2u w; w.x = pk2(r.x, r.y); w.y = pk2(r.z, r.w); *(v2u*)(act + (size_t)(u.pm * 256 + rowl) * FF + j0 + 4 * n) = w; }
                }
            }
        }
        asm volatile("s_waitcnt lgkmcnt(0)" ::: "memory"); __builtin_amdgcn_s_barrier(); asm volatile("" ::: "memory");
    }
};
__device__ __forceinline__ void glu_fix_tile(Frame& F, int pm, const float* cw, const float* cb) {
    const float* Hg = (const float*)(F.ws + WS_HG); const float* Ha = (const float*)(F.ws + WS_HA); bf16* act = (bf16*)(F.ws + WS_AG);
#pragma unroll 1
    for (int it = 0; it < 3; ++it) {
        const int e = F.tid + 512 * it;
        if (e < 2 * (FF / 4)) {
            const int which = e >= FF / 4 ? 1 : 0, j = (e - which * (FF / 4)) * 4;
            const int t = pm * 256 + (which ? 255 : 0), tl = t % SEQ;
            const int rm = which ? pm * 4 + 2 : max(pm - 1, 0) * 4 + 3, r0 = pm * 4 + (which ? 3 : 0), rp = which ? min(pm + 1, TT / 256 - 1) * 4 : pm * 4 + 1;
            f32x4 gm = *(const f32x4*)(Hg + (size_t)rm * FF + j), gp = *(const f32x4*)(Hg + (size_t)rp * FF + j);
            const f32x4 g0 = *(const f32x4*)(Hg + (size_t)r0 * FF + j), a = *(const f32x4*)(Ha + ((size_t)pm * 2 + which) * FF + j);
            const f32x4 w0 = *(const f32x4*)(cw + j), w1 = *(const f32x4*)(cw + FF + j), w2 = *(const f32x4*)(cw + 2 * FF + j), cbv = *(const f32x4*)(cb + j);
            if (!which && tl == 0) gm = (f32x4){0.f, 0.f, 0.f, 0.f};
            if (which && tl == SEQ - 1) gp = (f32x4){0.f, 0.f, 0.f, 0.f};
            const f32x4 cv = w0 * gm + w1 * g0 + w2 * gp + cbv;
            v2u w; w.x = pk2(a.x * gelu_as(cv.x), a.y * gelu_as(cv.y)); w.y = pk2(a.z * gelu_as(cv.z), a.w * gelu_as(cv.w));
            *(v2u*)(act + (size_t)t * FF + j) = w;
        }
    }
}
__device__ __forceinline__ void glu_fix_phase(Frame& F, const float* cw, const float* cb) {
    const float* Hg = (const float*)(F.ws + WS_HG); const float* Ha = (const float*)(F.ws + WS_HA); bf16* act = (bf16*)(F.ws + WS_AG);
    const int total = (TT / 256) * 2 * FF;
    for (int e = F.vcu * 512 + F.tid; e < total; e += F.G * 512) {
        const int j = e % FF, which = (e / FF) & 1, pm = e / (2 * FF);
        const int t = pm * 256 + (which ? 255 : 0), tl = t % SEQ;
        float gm, g0, gp;
        if (which == 0) { gm = (tl == 0) ? 0.f : Hg[((size_t)(pm - 1) * 4 + 3) * FF + j]; g0 = Hg[((size_t)pm * 4 + 0) * FF + j]; gp = Hg[((size_t)pm * 4 + 1) * FF + j]; }
        else { gm = Hg[((size_t)pm * 4 + 2) * FF + j]; g0 = Hg[((size_t)pm * 4 + 3) * FF + j]; gp = (tl == SEQ - 1) ? 0.f : Hg[((size_t)(pm + 1) * 4 + 0) * FF + j]; }
        const float a = Ha[((size_t)pm * 2 + which) * FF + j];
        const float cv = cw[j] * gm + cw[FF + j] * g0 + cw[2 * FF + j] * gp + cb[j];
        act[(size_t)t * FF + j] = (bf16)f2bf(a * gelu_as(cv));
    }
}
struct EpiNull {
    static constexpr bool PERM = true;
    float* sink;
    __device__ __forceinline__ void operator()(const f32x4 (&acc)[2][2][4][2], const Unit& u, int wr, int wc, int fr, int fq) const {
        f32x4 s = {0.f, 0.f, 0.f, 0.f};
#pragma unroll
        for (int ai = 0; ai < 2; ++ai)
#pragma unroll
            for (int bj = 0; bj < 2; ++bj)
#pragma unroll
                for (int m = 0; m < 4; ++m)
#pragma unroll
                    for (int n = 0; n < 2; ++n) s += acc[ai][bj][m][n];
        if (u.pm == 100000) *(f32x4*)(sink + fr) = s;
    }
};
struct EpiInT {
    static constexpr bool PERM = true;
    bf16* UT; const float* ssq; int np; const float* bias;
    __device__ __forceinline__ void operator()(const f32x4 (&acc)[2][2][4][2], const Unit& u, int wr, int wc, int fr, int fq) const {
        const int b = (u.pm * 256) / SEQ;
        const int col0 = u.pn * 256 + wc * 32 + 8 * fq;
        const int odd = fr & 1;
        f32x4 bv[2][2];
#pragma unroll
        for (int bj = 0; bj < 2; ++bj)
#pragma unroll
            for (int n = 0; n < 2; ++n) bv[bj][n] = *(const f32x4*)(bias + (size_t)b * 3072 + col0 + 128 * bj + 4 * n);
#pragma unroll
        for (int ai = 0; ai < 2; ++ai)
#pragma unroll
            for (int m = 0; m < 4; ++m) {
                const int row = u.pm * 256 + ai * 128 + wr * 64 + m * 16 + fr;
                const int t = row - b * SEQ;
                const float rs = row_rs(ssq, np, row);
#pragma unroll
                for (int bj = 0; bj < 2; ++bj)
#pragma unroll
                    for (int n = 0; n < 2; ++n) { const f32x4 v = acc[ai][bj][m][n] * rs + bv[bj][n];
                        const unsigned w01 = pk2(v.x, v.y), w23 = pk2(v.z, v.w);
                        const unsigned p01 = (unsigned)__shfl_xor((int)w01, 1), p23 = (unsigned)__shfl_xor((int)w23, 1);
                        const unsigned o0 = odd ? ((w01 & 0xffff0000u) | (p01 >> 16)) : ((p01 << 16) | (w01 & 0xffffu));
                        const unsigned o1 = odd ? ((w23 & 0xffff0000u) | (p23 >> 16)) : ((p23 << 16) | (w23 & 0xffffu));
                        bf16* p = UT + ((size_t)b * 3072 + col0 + 128 * bj + 4 * n + odd) * SEQ + (t & ~1);
                        *(unsigned*)p = o0; *(unsigned*)(p + 2 * (size_t)SEQ) = o1; }
            }
    }
};

struct EpiCtxKV {
    static constexpr bool PERM = true;
    EpiQK<1> ek; EpiVT ev;
    __device__ __forceinline__ void operator()(const f32x4 (&acc)[2][2][4][2], const Unit& u, int wr, int wc, int fr, int fq) const {
        if (u.pn < 4) ek(acc, u, wr, wc, fr, fq);
        else { Unit v = u; v.pn = u.pn - 4; ev(acc, v, wr, wc, fr, fq); }
    }
};

typedef short bf16x8 __attribute__((ext_vector_type(8)));
typedef float f32x16 __attribute__((ext_vector_type(16)));
typedef short s16x4 __attribute__((ext_vector_type(4)));
__device__ __forceinline__ unsigned cvtpk(float lo, float hi) { typedef float f2 __attribute__((ext_vector_type(2))); typedef __bf16 b2 __attribute__((ext_vector_type(2)));
    f2 v = {lo, hi}; b2 r = __builtin_convertvector(v, b2); return __builtin_bit_cast(unsigned, r); }
constexpr int BT_OFF = 64, BT_HEAD = 15 * 31;
__device__ __forceinline__ void attn_mfma_phase(Frame& F) {
    const bf16* Q = (const bf16*)(F.ws + WS_Q); const bf16* Kb = (const bf16*)(F.ws + WS_K); const bf16* VT = (const bf16*)(F.ws + WS_V);
    const bf16* Kc = (const bf16*)(F.ws + WS_KC); const bf16* VcT = (const bf16*)(F.ws + WS_VC);
    bf16* O = (bf16*)(F.ws + WS_O);
    const float* rpb = F.in[11];
    constexpr int AL_KC = 15 * 8192, AL_BT = AL_KC + 32768;
    const unsigned char* lk = (const unsigned char*)F.lds;
    float* bt = (float*)(F.lds + AL_BT);
    int th = -1;
    const int lane = F.lane, q = lane & 31, hi = lane >> 5;
    for (int g = F.vcu; g < NB * (GROWS / 8) * NH; g += F.G) {
        const int rg = g & 15, h = (g >> 4) & 15, b = g >> 8;
        const int r = rg * 8 + F.wave;
        const int r0 = min(max(r - WH / 2, 0), GROWS - WH);
        const int U0 = min(max(rg * 8 - WH / 2, 0), GROWS - WH), Ue = min(max(rg * 8 + 7 - WH / 2, 0), GROWS - WH) + WH;
        __syncthreads();
        if (h != th) { for (int e = F.tid; e < BT_HEAD; e += 512) bt[BT_OFF + e] = rpb[h * BT_HEAD + e] * 1.4426950408889634f; th = h; }
        {
            int tv = F.tid; FC_OPAQUE(tv);
            const bf16* ksrc = Kb + ((size_t)(b * NH + h) * (SEQ / 16) + (size_t)U0 * 4) * (8 * 16 * 8) + tv * 8;
            const bf16* csrc = Kc + ((size_t)(b * NH + h) * (CTXL / 16)) * (8 * 16 * 8) + tv * 8;
            const int nrow = Ue - U0;
#pragma unroll 1
            for (int rr0 = 0; rr0 < nrow + 4; rr0 += 4) {
                v4u x[4];
#pragma unroll
                for (int k = 0; k < 4; ++k) { const int rr = rr0 + k; if (rr < nrow + 4) x[k] = (rr < nrow) ? *(const v4u*)(ksrc + (size_t)rr * 4096) : *(const v4u*)(csrc + (size_t)(rr - nrow) * 4096); }
#pragma unroll
                for (int k = 0; k < 4; ++k) { const int rr = rr0 + k; if (rr < nrow + 4) *(v4u*)(F.lds + (rr < nrow ? rr * 8192 : AL_KC + (rr - nrow) * 8192) + tv * 16) = x[k]; }
            }
            asm volatile("" ::: "memory");
        }
        __syncthreads();
        const size_t tok = (size_t)b * SEQ + r * GW + q;
        bf16x8 qf[2][4];
#pragma unroll
        for (int hf = 0; hf < 2; ++hf)
#pragma unroll
            for (int s4 = 0; s4 < 4; ++s4) qf[hf][s4] = *(const bf16x8*)(Q + (tok + 32 * hf) * DM + h * HD + 16 * s4 + 8 * hi);
        const f32x16 zero16 = {0.f, 0.f, 0.f, 0.f, 0.f, 0.f, 0.f, 0.f, 0.f, 0.f, 0.f, 0.f, 0.f, 0.f, 0.f, 0.f};
        f32x16 o[2][2] = {{zero16, zero16}, {zero16, zero16}};
        float lsum[2] = {0.f, 0.f};
#define ATT_LOAD(i, kf, va) do { \
            const bf16* kp_; const bf16* vp_; int sstr_; \
            if ((i) < 16) { const int rp_ = (i) >> 2, cb_ = (i) & 3, krow_ = r0 + 2 * rp_; \
                kp_ = (const bf16*)(lk + (krow_ + (q >> 4) - U0) * 8192 + cb_ * 2048 + hi * 256 + (q & 15) * 16); \
                vp_ = VT + (((size_t)(b * NH + h) * (SEQ / 16) + krow_ * 4 + cb_) * 64 + q) * 16 + 8 * hi; sstr_ = 4 * 64 * 16; } \
            else { const int j_ = (i) - 16; \
                kp_ = (const bf16*)(lk + AL_KC + (2 * j_ + (q >> 4)) * 2048 + hi * 256 + (q & 15) * 16); \
                vp_ = VcT + (((size_t)(b * NH + h) * (CTXL / 16) + 2 * j_) * 64 + q) * 16 + 8 * hi; sstr_ = 64 * 16; } \
            _Pragma("unroll") for (int s4 = 0; s4 < 4; ++s4) kf[s4] = *(const bf16x8*)(kp_ + s4 * (2 * 16 * 8)); \
            _Pragma("unroll") for (int dh = 0; dh < 2; ++dh) _Pragma("unroll") for (int s2 = 0; s2 < 2; ++s2) { const bf16* v_ = vp_ + dh * (32 * 16) + s2 * sstr_; \
                va[dh][s2] = *(const bf16x8*)v_; } } while (0)
#define ATT_HALF(i, kf, va, HF) do { \
            f32x16 sacc = zero16; \
            _Pragma("unroll") for (int s4 = 0; s4 < 4; ++s4) sacc = __builtin_amdgcn_mfma_f32_32x32x16_bf16(kf[s4], qf[HF][s4], sacc, 0, 0, 0); \
            float p[16]; \
            if ((i) < 16) { const int rp_ = (i) >> 2, cb_ = (i) & 3, krow_ = r0 + 2 * rp_; \
                const int c_ = 32 * HF + q, c0_ = min(max(c_ - WW / 2, 0), GW - WW), lo_ = c0_ - c_ + (WW - 1); \
                const int dcb = cb_ * 16 + 4 * hi - c_ + (WW - 1), dcl = dcb - lo_; \
                const float* btp = bt + BT_OFF + (krow_ - r + (WH - 1)) * 31 + dcb; \
                _Pragma("unroll") for (int rr = 0; rr < 16; ++rr) { const int kc = (rr & 3) + 8 * ((rr >> 2) & 1); \
                    const float e_ = __builtin_amdgcn_exp2f(sacc[rr] + btp[(rr >> 3) * 31 + kc]); \
                    p[rr] = ((unsigned)(dcl + kc) < (unsigned)WW) ? e_ : 0.f; lsum[HF] += p[rr]; } } \
            else { _Pragma("unroll") for (int rr = 0; rr < 16; ++rr) { p[rr] = __builtin_amdgcn_exp2f(sacc[rr]); lsum[HF] += p[rr]; } } \
            unsigned pw[8]; \
            _Pragma("unroll") for (int ii = 0; ii < 8; ++ii) pw[ii] = cvtpk(p[2 * ii], p[2 * ii + 1]); \
            _Pragma("unroll") for (int s2 = 0; s2 < 2; ++s2) { \
                const bf16x8 pb = __builtin_bit_cast(bf16x8, (v4u){pw[4 * s2], pw[4 * s2 + 1], pw[4 * s2 + 2], pw[4 * s2 + 3]}); \
                o[HF][0] = __builtin_amdgcn_mfma_f32_32x32x16_bf16(va[0][s2], pb, o[HF][0], 0, 0, 0); \
                o[HF][1] = __builtin_amdgcn_mfma_f32_32x32x16_bf16(va[1][s2], pb, o[HF][1], 0, 0, 0); } } while (0)
#define ATT_COMPUTE(i, kf, va) do { const int cbq_ = ((i) < 16) ? ((i) & 3) : 1; \
            if (cbq_ != 3) ATT_HALF(i, kf, va, 0); \
            if (cbq_ != 0) ATT_HALF(i, kf, va, 1); } while (0)
        bf16x8 kfA[4], kfB[4], vaA[2][2], vaB[2][2];
        ATT_LOAD(0, kfA, vaA);
#pragma unroll 1
        for (int i = 0; i < 24; i += 2) {
            ATT_LOAD(i + 1, kfB, vaB);
            ATT_COMPUTE(i, kfA, vaA);
            { const int i2 = (i + 2 < 24) ? i + 2 : 23; ATT_LOAD(i2, kfA, vaA); }
            ATT_COMPUTE(i + 1, kfB, vaB);
        }
#undef ATT_LOAD
#undef ATT_HALF
#undef ATT_COMPUTE
#pragma unroll
        for (int hf = 0; hf < 2; ++hf) {
            float l = lsum[hf]; l += __shfl_xor(l, 32);
            const float inv = 1.0f / l;
            bf16* op = O + (tok + 32 * hf) * DM + h * HD + 4 * hi;
#pragma unroll
            for (int gq = 0; gq < 4; ++gq) {
                v2u w0; w0.x = pk2(o[hf][0][4 * gq] * inv, o[hf][0][4 * gq + 1] * inv); w0.y = pk2(o[hf][0][4 * gq + 2] * inv, o[hf][0][4 * gq + 3] * inv);
                v2u w1; w1.x = pk2(o[hf][1][4 * gq] * inv, o[hf][1][4 * gq + 1] * inv); w1.y = pk2(o[hf][1][4 * gq + 2] * inv, o[hf][1][4 * gq + 3] * inv);
                *(v2u*)(op + 8 * gq) = w0; *(v2u*)(op + 32 + 8 * gq) = w1;
            }
        }
    }
    __syncthreads();
}

__device__ __forceinline__ void convglu_phase(Frame& F, const float* cw, const float* cb) {
    bf16* ag = (bf16*)(F.ws + WS_AG);
    const long nvec = (long)TT * (FF / 8);
    for (long e = (long)F.vcu * 512 + F.tid; e < nvec; e += (long)F.G * 512) {
        const int t = (int)(e / (FF / 8)), j0 = (int)(e % (FF / 8)) * 8;
        const int tl = t % SEQ;
        const bf16* rowp = ag + (size_t)t * (2 * FF);
        const v4u a = *(const v4u*)(rowp + j0);
        const v4u g0 = *(const v4u*)(rowp + FF + j0);
        v4u gm = (v4u){0u, 0u, 0u, 0u}, gp = (v4u){0u, 0u, 0u, 0u};
        if (tl > 0) gm = *(const v4u*)(rowp - 2 * FF + FF + j0);
        if (tl < SEQ - 1) gp = *(const v4u*)(rowp + 2 * FF + FF + j0);
        float av[8], g0v[8], gmv[8], gpv[8];
        av[0] = bflo(a.x); av[1] = bfhi(a.x); av[2] = bflo(a.y); av[3] = bfhi(a.y); av[4] = bflo(a.z); av[5] = bfhi(a.z); av[6] = bflo(a.w); av[7] = bfhi(a.w);
        g0v[0] = bflo(g0.x); g0v[1] = bfhi(g0.x); g0v[2] = bflo(g0.y); g0v[3] = bfhi(g0.y); g0v[4] = bflo(g0.z); g0v[5] = bfhi(g0.z); g0v[6] = bflo(g0.w); g0v[7] = bfhi(g0.w);
        gmv[0] = bflo(gm.x); gmv[1] = bfhi(gm.x); gmv[2] = bflo(gm.y); gmv[3] = bfhi(gm.y); gmv[4] = bflo(gm.z); gmv[5] = bfhi(gm.z); gmv[6] = bflo(gm.w); gmv[7] = bfhi(gm.w);
        gpv[0] = bflo(gp.x); gpv[1] = bfhi(gp.x); gpv[2] = bflo(gp.y); gpv[3] = bfhi(gp.y); gpv[4] = bflo(gp.z); gpv[5] = bfhi(gp.z); gpv[6] = bflo(gp.w); gpv[7] = bfhi(gp.w);
        float r[8];
#pragma unroll
        for (int i = 0; i < 8; ++i) { const int j = j0 + i; const float cv = cw[j] * gmv[i] + cw[FF + j] * g0v[i] + cw[2 * FF + j] * gpv[i] + cb[j]; r[i] = av[i] * gelu_f(cv); }
        v4u w; w.x = pk2(r[0], r[1]); w.y = pk2(r[2], r[3]); w.z = pk2(r[4], r[5]); w.w = pk2(r[6], r[7]);
        *(v4u*)(ag + (size_t)t * (2 * FF) + j0) = w;
    }
}

__device__ __forceinline__ void filtgen_phase(Frame& F) {
    const float* const* in = F.in;
    const float *w1 = in[25], *b1 = in[26], *w2 = in[27], *b2 = in[28], *w3 = in[29], *b3 = in[30], *freq = in[32];
    const float* __restrict__ wout = in[31];
    float* __restrict__ hT = (float*)(F.ws + WS_HT); float* __restrict__ fsqp = (float*)(F.ws + WS_FSQP);
    LAS float* zf = (LAS float*)(F.lds);
    LAS float* ha = zf + 32 * 36;
    LAS float* hb = ha + 32 * 64;
    const int tid = F.tid;
    for (int item = F.vcu; item < SEQ / 32; item += F.G) {
        const int l0 = item * 32;
        const float bj1 = b1[tid & 63], bj2 = b2[tid & 63], bj3 = b3[tid & 63], fj = freq[tid & 63];
        __syncthreads();
        for (int e = tid; e < 32 * 33; e += 512) {
            const int p = e / 33, i = e % 33, l = l0 + p;
            float v;
            if (i == 0) v = (float)l / 8191.0f;
            else { const int bi = (i - 1) & 15; const float band = 1e-4f + (float)bi * ((15.0f - 1e-4f) / 15.0f);
                const float w = (float)(2.0 * 3.14159265358979323846 / 8192.0) * (float)l; const float arg = band * w;
                v = (i <= 16) ? cosf(arg) : -sinf(arg); }
            zf[p * 36 + i] = v;
        }
        __syncthreads();
        { const int j = tid & 63, p = tid >> 6; float a[4] = {bj1, bj1, bj1, bj1};
#pragma unroll 11
          for (int i = 0; i < 33; ++i) { const float w = w1[i * 64 + j];
#pragma unroll
            for (int k = 0; k < 4; ++k) a[k] += zf[(p + 8 * k) * 36 + i] * w; }
#pragma unroll
          for (int k = 0; k < 4; ++k) ha[(p + 8 * k) * 64 + j] = sinf(fj * a[k]); }
        __syncthreads();
        { const int j = tid & 63, p = tid >> 6; float a[4] = {bj2, bj2, bj2, bj2};
#pragma unroll 16
          for (int i = 0; i < 64; ++i) { const float w = w2[i * 64 + j];
#pragma unroll
            for (int k = 0; k < 4; ++k) a[k] += ha[(p + 8 * k) * 64 + i] * w; }
#pragma unroll
          for (int k = 0; k < 4; ++k) hb[(p + 8 * k) * 64 + j] = sinf(fj * a[k]); }
        __syncthreads();
        { const int j = tid & 63, p = tid >> 6; float a[4] = {bj3, bj3, bj3, bj3};
#pragma unroll 16
          for (int i = 0; i < 64; ++i) { const float w = w3[i * 64 + j];
#pragma unroll
            for (int k = 0; k < 4; ++k) a[k] += hb[(p + 8 * k) * 64 + i] * w; }
#pragma unroll
          for (int k = 0; k < 4; ++k) ha[(p + 8 * k) * 64 + j] = sinf(fj * a[k]); }
        __syncthreads();
        {
            const int lane = F.lane, li = lane & 15, lk = lane >> 4;
            pg8::bf16x8 afr[2][2];
#pragma unroll
            for (int mt = 0; mt < 2; ++mt)
#pragma unroll
                for (int ks = 0; ks < 2; ++ks) { const LAS float* hp = ha + (16 * mt + li) * 64 + 32 * ks + 8 * lk;
                    v4u w; w.x = pk2(hp[0], hp[1]); w.y = pk2(hp[2], hp[3]); w.z = pk2(hp[4], hp[5]); w.w = pk2(hp[6], hp[7]);
                    afr[mt][ks] = __builtin_bit_cast(pg8::bf16x8, w); }
            const float la = -15.350567286626973f, lb = -3.0701134573253946f;
#pragma unroll 1
            for (int nt = 0; nt < 16; nt += 2) {
                const int n0 = F.wave * 256 + nt * 16 + li;
                const float* wp = wout + (size_t)(8 * lk) * 2048 + n0;
                float bv[2][2][8];
#pragma unroll
                for (int ks = 0; ks < 2; ++ks)
#pragma unroll
                    for (int j = 0; j < 8; ++j) { bv[0][ks][j] = wp[(size_t)(32 * ks + j) * 2048]; bv[1][ks][j] = wp[(size_t)(32 * ks + j) * 2048 + 16]; }
                f32x4 acc[2][2];
#pragma unroll
                for (int t2 = 0; t2 < 2; ++t2) { acc[t2][0] = (f32x4){0.f, 0.f, 0.f, 0.f}; acc[t2][1] = acc[t2][0]; }
#pragma unroll
                for (int t2 = 0; t2 < 2; ++t2)
#pragma unroll
                    for (int ks = 0; ks < 2; ++ks) {
                        v4u w; w.x = pk2(bv[t2][ks][0], bv[t2][ks][1]); w.y = pk2(bv[t2][ks][2], bv[t2][ks][3]); w.z = pk2(bv[t2][ks][4], bv[t2][ks][5]); w.w = pk2(bv[t2][ks][6], bv[t2][ks][7]);
                        const pg8::bf16x8 bfr = __builtin_bit_cast(pg8::bf16x8, w);
                        acc[t2][0] = __builtin_amdgcn_mfma_f32_16x16x32_bf16(afr[0][ks], bfr, acc[t2][0], 0, 0, 0);
                        acc[t2][1] = __builtin_amdgcn_mfma_f32_16x16x32_bf16(afr[1][ks], bfr, acc[t2][1], 0, 0, 0);
                    }
#pragma unroll
                for (int t2 = 0; t2 < 2; ++t2) {
                    const int n = n0 + 16 * t2;
                    const int dir = n >> 10, c = n & 1023;
                    const float delta = fabsf(la + (float)c * ((lb - la) / 1023.0f)) * 1.4426950408889634f;
                    float sq = 0.f;
#pragma unroll
                    for (int mt = 0; mt < 2; ++mt) { f32x4 ov; const f32x4 ac = acc[t2][mt];
#pragma unroll
                        for (int r = 0; r < 4; ++r) { const float tpos = (float)(l0 + 16 * mt + 4 * lk + r) / 8191.0f; const float v = ac[r] * __builtin_amdgcn_exp2f(-tpos * delta); ov[r] = v; sq += v * v; }
                        *(f32x4*)(hT + ((size_t)dir * 1024 + c) * SEQ + l0 + 16 * mt + 4 * lk) = ov; }
                    sq += __shfl_xor(sq, 16); sq += __shfl_xor(sq, 32);
                    if (lk == 0) fsqp[(size_t)item * 2048 + n] = sq;
                }
            }
        }
    }
    __syncthreads();
}

constexpr int F2_AO = 67584, F2_TW = 135168, F2_RED = 140 * 1024, F2_PF = 144 * 1024, F2_TN = 146 * 1024;
__device__ __forceinline__ void f2_load_tw(Frame& F, const cf* TWM, const cf* TWN) {
    cf* tw1 = (cf*)(F.lds + F2_TW);
    for (int e = F.tid; e < 544; e += 512) tw1[e] = e < 512 ? TWM[e] : TWM[16 * (e - 512)];
    ((cf*)(F.lds + F2_TN))[F.tid] = TWN[F.tid];
    __syncthreads();
}
__device__ __forceinline__ cf tn_pow(cf base, int r) {
    const float c[16] = {1.0f, 0.98078528040323043f, 0.92387953251128674f, 0.83146961230254524f, 0.70710678118654752f, 0.55557023301960218f, 0.38268343236508977f, 0.19509032201612825f,
                         0.0f, -0.19509032201612825f, -0.38268343236508977f, -0.55557023301960218f, -0.70710678118654752f, -0.83146961230254524f, -0.92387953251128674f, -0.98078528040323043f};
    const float sn[16] = {0.0f, 0.19509032201612825f, 0.38268343236508977f, 0.55557023301960218f, 0.70710678118654752f, 0.83146961230254524f, 0.92387953251128674f, 0.98078528040323043f,
                          1.0f, 0.98078528040323043f, 0.92387953251128674f, 0.83146961230254524f, 0.70710678118654752f, 0.55557023301960218f, 0.38268343236508977f, 0.19509032201612825f};
    if (r == 0) return base;
    if (r == 8) return cmulnegi(base);
    cf w; w.x = c[r]; w.y = -sn[r]; return cmul(base, w);
}
__device__ __forceinline__ void filtfft_phase(Frame& F) {
    const float* hT = (const float*)(F.ws + WS_HT); const float* fsqp = (const float*)(F.ws + WS_FSQP);
    const cf* TWM = (const cf*)(F.ws + SM_TWM); const cf* TWN = (const cf*)(F.ws + SM_TWN);
    cf* Fsp = (cf*)(F.ws + WS_F);
    cf* aE = (cf*)F.lds; cf* aO = (cf*)(F.lds + F2_AO);
    const cf* tw1 = (const cf*)(F.lds + F2_TW); const cf* tw32 = tw1 + 512;
    float* red = (float*)(F.lds + F2_RED);
    f2_load_tw(F, TWM, TWN);
    float* nrmt = (float*)(F.lds + F2_RED + 2048);
    { int kk = 0;
      for (int c0 = F.vcu; c0 < DM; c0 += 4 * F.G, kk += 4) {
        const int tl = min(F.tid, SEQ / 32 - 1);
        float pv[4];
#pragma unroll
        for (int j = 0; j < 4; ++j) { const int cc = min(c0 + j * F.G, DM - 1); pv[j] = fsqp[(size_t)tl * 2048 + cc] + fsqp[(size_t)tl * 2048 + 1024 + cc]; }
#pragma unroll
        for (int j = 0; j < 4; ++j) { float p = (F.tid < SEQ / 32) ? pv[j] : 0.f; p = wave_sum(p); if (F.lane == 0) red[j * 8 + F.wave] = p; }
        __syncthreads();
        if (F.tid < 4) { const float* rp = red + F.tid * 8; const float sm = ((((((rp[0] + rp[1]) + rp[2]) + rp[3]) + rp[4]) + rp[5]) + rp[6]) + rp[7]; nrmt[kk + F.tid] = 1.0f / sqrtf(sm + EPS); }
        __syncthreads();
      } }
    int kc = 0;
    for (int c = F.vcu; c < DM; c += F.G, ++kc) {
        int tid = F.tid; FC_OPAQUE(tid);
        __syncthreads();
        const float nrm = nrmt[kc];
        const float* hf = hT + (size_t)c * SEQ; const float* hb = hT + ((size_t)1024 + c) * SEQ;
        if (c + F.G < DM) { const float* pr = hT + ((size_t)(tid >> 8) * 1024 + c + F.G) * SEQ + (size_t)(tid & 255) * 32;
            __builtin_amdgcn_global_load_lds((const unsigned*)pr, (LAS unsigned*)(F.lds + F2_PF + F.wave * 256), 4, 0, 0); }
        {
            cf v[16], w[16];
            const cf tnb = ((const cf*)(F.lds + F2_TN))[tid];
#pragma unroll
            for (int r = 0; r < 16; ++r) { const int n = tid + 512 * r; const float hbv = hb[SEQ - max(n, 1)];
                const float fa = hf[n] * nrm, fb = (n == 0) ? 0.f : hbv * nrm;
                v[r].x = fa + fb; v[r].y = 0.f; const cf tnr = tn_pow(tnb, r); w[r].x = (fa - fb) * tnr.x; w[r].y = (fa - fb) * tnr.y; }
            f2_fwd_p1(v, tid, aE, tw1);
            f2_fwd_p1(w, tid, aO, tw1);
        }
        __syncthreads();
        f2_fwd_p2_dual(tid, aE, aO, tw32);
        __syncthreads();
        { const int path = tid >> 8, bf = tid & 255;
          f2_mid_store16(bf, path ? aO : aE, (v2u*)Fsp + ((size_t)c * 2 + path) * (FC_M / 2)); }
    }
    __syncthreads();
}

__device__ __forceinline__ void conv3_8(const v4u raw, float prev, float next, float w0, float w1, float w2, float bb, float* out) {
    float x[10]; x[0] = prev; x[9] = next;
    x[1] = bflo(raw.x); x[2] = bfhi(raw.x); x[3] = bflo(raw.y); x[4] = bfhi(raw.y); x[5] = bflo(raw.z); x[6] = bfhi(raw.z); x[7] = bflo(raw.w); x[8] = bfhi(raw.w);
#pragma unroll
    for (int i = 0; i < 8; ++i) out[i] = w0 * x[i] + w1 * x[i + 1] + w2 * x[i + 2] + bb;
}
#ifdef PROBE_SEC
#define SEC_MARK(k) do { const unsigned long long t_ = __builtin_amdgcn_s_memrealtime(); if ((k) > 0 && (k) - 1 == PROBE_SEC) F.sec += t_ - sec_t0; sec_t0 = t_; } while (0)
#else
#define SEC_MARK(k) do { } while (0)
#endif
__device__ __forceinline__ void hyena_fft_phase(Frame& F) {
#ifdef PROBE_SEC
    unsigned long long sec_t0 = 0;
#endif
    const float* const* in = F.in;
    const float* sw = in[23]; const float* sb = in[24]; const float* dbias = in[33];
    const bf16* UT = (const bf16*)(F.ws + WS_UT);
    const cf* TWM = (const cf*)(F.ws + SM_TWM); const cf* TWN = (const cf*)(F.ws + SM_TWN);
    const cf* Fsp = (const cf*)(F.ws + WS_F);
    cf* aE = (cf*)F.lds; cf* aO = (cf*)(F.lds + F2_AO);
    const cf* tw1 = (const cf*)(F.lds + F2_TW); const cf* tw32 = tw1 + 512;
    f2_load_tw(F, TWM, TWN);
    for (int unit = F.vcu; unit < 2 * DM; unit += F.G) {
        const int c = unit >> 1, b0 = (unit & 1) * 2;
        int tid = F.tid; FC_OPAQUE(tid);
        SEC_MARK(0);
        __syncthreads();
        {
            const float w10 = sw[1024 + c], w11 = sw[3072 + 1024 + c], w12 = sw[6144 + 1024 + c], bb1 = sb[1024 + c];
            const float wv0 = sw[2048 + c], wv1 = sw[3072 + 2048 + c], wv2 = sw[6144 + 2048 + c], bbv = sb[2048 + c];
            v4u x1raw[2][2], vraw[2][2]; unsigned short hh[2][2][4];
            FC_OPAQUE(tid);
#pragma unroll
            for (int h = 0; h < 2; ++h) {
                const int t0 = (tid + 512 * h) * 8;
                const int ipv = max(t0 - 1, 0), inx = min(t0 + 8, SEQ - 1);
#pragma unroll
                for (int bb = 0; bb < 2; ++bb) {
                    const bf16* x1r = UT + ((size_t)(b0 + bb) * 3072 + 1024 + c) * SEQ;
                    const bf16* vr = UT + ((size_t)(b0 + bb) * 3072 + 2048 + c) * SEQ;
                    x1raw[h][bb] = *(const v4u*)(x1r + t0); vraw[h][bb] = *(const v4u*)(vr + t0);
                    hh[h][bb][0] = x1r[ipv]; hh[h][bb][1] = x1r[inx]; hh[h][bb][2] = vr[ipv]; hh[h][bb][3] = vr[inx];
                }
            }
#pragma unroll
            for (int h = 0; h < 2; ++h) {
                const int t0 = (tid + 512 * h) * 8;
                float z[2][8];
#pragma unroll
                for (int bb = 0; bb < 2; ++bb) {
                    const float x1p = t0 > 0 ? bf2f(hh[h][bb][0]) : 0.f, x1n = t0 + 8 < SEQ ? bf2f(hh[h][bb][1]) : 0.f;
                    const float vp = t0 > 0 ? bf2f(hh[h][bb][2]) : 0.f, vn = t0 + 8 < SEQ ? bf2f(hh[h][bb][3]) : 0.f;
                    float x1c[8], vc[8];
                    conv3_8(x1raw[h][bb], x1p, x1n, w10, w11, w12, bb1, x1c);
                    conv3_8(vraw[h][bb], vp, vn, wv0, wv1, wv2, bbv, vc);
#pragma unroll
                    for (int i = 0; i < 8; ++i) z[bb][i] = x1c[i] * vc[i];
                }
                const int pb = F2_PIDX(t0);
#pragma unroll
                for (int i = 0; i < 8; ++i) { cf t; t.x = z[0][i]; t.y = z[1][i]; aE[pb + i] = t; }
            }
        }
        __syncthreads();
        SEC_MARK(1);
        cf wreg[16];
        FC_OPAQUE(tid);
        { const int pt = F2_PIDX(tid);
#pragma unroll
          for (int r = 0; r < 16; ++r) wreg[r] = aE[pt + 528 * r]; }
        const int path = tid >> 8, bf = tid & 255;
        const cf tnb = ((const cf*)(F.lds + F2_TN))[tid];
        cf tn[16];
#pragma unroll
        for (int r = 0; r < 16; ++r) tn[r] = tn_pow(tnb, r);
        {
            cf v[16];
#pragma unroll
            for (int r = 0; r < 16; ++r) v[r] = cmul(wreg[r], tn[r]);
            f2_fwd_p1(v, tid, aO, tw1);
            FC_OPAQUE(tid);
#pragma unroll
            for (int r = 0; r < 16; ++r) v[r] = wreg[r];
            f2_fwd_p1(v, tid, aE, tw1);
        }
        __syncthreads();
        SEC_MARK(2);
        f2_fwd_p2_dual(tid, aE, aO, tw32);
        __syncthreads();
        SEC_MARK(3);
        v2u freg[16];
        { const v2u* fp = (const v2u*)Fsp + ((size_t)c * 2 + path) * (FC_M / 2) + bf;
#pragma unroll
          for (int i = 0; i < 16; ++i) freg[i] = fp[i * 256]; }
        f2_mid16(bf, path ? aO : aE, freg);
        __syncthreads();
        SEC_MARK(4);
        if (tid < 256) { const bf16* pr = UT + ((size_t)(b0 + (tid >> 7)) * 3072 + c) * SEQ + (size_t)(tid & 127) * 64;
            __builtin_amdgcn_global_load_lds((const unsigned*)pr, (LAS unsigned*)(F.lds + F2_PF + F.wave * 256), 4, 0, 0); }
        if (unit + F.G < 2 * DM) { const int nu = unit + F.G, nc = nu >> 1, nb = (nu & 1) * 2 + (tid >> 8), wh = 1 + ((tid >> 7) & 1);
            const bf16* pr = UT + ((size_t)nb * 3072 + wh * 1024 + nc) * SEQ + (size_t)(tid & 127) * 64;
            __builtin_amdgcn_global_load_lds((const unsigned*)pr, (LAS unsigned*)(F.lds + F2_PF + F.wave * 256), 4, 0, 0); }
        f2_inv_p2_dual(tid, aE, aO, tw32);
        __syncthreads();
        SEC_MARK(5);
        {
            cf ve[16], vo[16];
            f2_inv_p1(ve, tid, aE, tw1);
            f2_inv_p1(vo, tid, aO, tw1);
            const float db = dbias[c];
            FC_OPAQUE(tid);
            const int pt = F2_PIDX(tid);
            const cf tnb2 = ((const cf*)(F.lds + F2_TN))[tid];
#pragma unroll
            for (int r = 0; r < 16; ++r) { const int n = tid + 512 * r;
                const cf y = cadd(cconj(ve[r]), cmul(cconj(tn_pow(tnb2, r)), cconj(vo[r])));
                cf o; o.x = y.x * (1.0f / 16384.0f) + wreg[r].x * db; o.y = y.y * (1.0f / 16384.0f) + wreg[r].y * db; aE[pt + 528 * r] = o; }
        }
        __syncthreads();
        SEC_MARK(6);
        {
            const float w00 = sw[c], w01 = sw[3072 + c], w02 = sw[6144 + c], bb0 = sb[c];
            v4u xraw[2][2]; unsigned short hx[2][2][2];
            FC_OPAQUE(tid);
#pragma unroll
            for (int h = 0; h < 2; ++h) {
                const int t0 = (tid + 512 * h) * 8;
#pragma unroll
                for (int bb = 0; bb < 2; ++bb) { const bf16* x0r = UT + ((size_t)(b0 + bb) * 3072 + c) * SEQ;
                    xraw[h][bb] = *(const v4u*)(x0r + t0); hx[h][bb][0] = x0r[max(t0 - 1, 0)]; hx[h][bb][1] = x0r[min(t0 + 8, SEQ - 1)]; }
            }
#pragma unroll
            for (int h = 0; h < 2; ++h) {
                const int t0 = (tid + 512 * h) * 8;
                cf val[8];
                const int pb = F2_PIDX(t0);
#pragma unroll
                for (int i = 0; i < 8; ++i) val[i] = aE[pb + i];
#pragma unroll
                for (int bb = 0; bb < 2; ++bb) {
                    const float xp = t0 > 0 ? bf2f(hx[h][bb][0]) : 0.f, xn = t0 + 8 < SEQ ? bf2f(hx[h][bb][1]) : 0.f;
                    float x0c[8]; conv3_8(xraw[h][bb], xp, xn, w00, w01, w02, bb0, x0c);
                    float p[8];
#pragma unroll
                    for (int i = 0; i < 8; ++i) p[i] = x0c[i] * (bb == 0 ? val[i].x : val[i].y);
                    v4u o; o.x = pk2(p[0], p[1]); o.y = pk2(p[2], p[3]); o.z = pk2(p[4], p[5]); o.w = pk2(p[6], p[7]);
                    *(v4u*)((bf16*)(F.ws + WS_XS) + ((size_t)(b0 + bb) * 1024 + c) * SEQ + t0) = o;
                }
            }
        }
        SEC_MARK(7);
    }
    __syncthreads();
}
__device__ __forceinline__ void transpose_p_phase(Frame& F) {
    const bf16* PT = (const bf16*)(F.ws + WS_XS); bf16* P = (bf16*)(F.ws + WS_P);
    LAS unsigned short* scr = (LAS unsigned short*)(F.lds + F.wave * 16384);
    const int gw = F.vcu * NWAVES + F.wave, NGW = F.G * NWAVES, lane = F.lane;
    const int ntile = NB * (DM / 64) * (SEQ / 64);
    const int l8 = lane >> 3, ch = (lane & 7) * 8;
    for (int it = gw; it < ntile; it += NGW) {
        const int tb = it % (SEQ / 64), cb = (it / (SEQ / 64)) % (DM / 64), b = it / ((SEQ / 64) * (DM / 64));
        v4u x[8];
#pragma unroll
        for (int k = 0; k < 8; ++k) x[k] = *(const v4u*)(PT + ((size_t)b * 1024 + cb * 64 + 8 * k + l8) * SEQ + tb * 64 + ch);
#pragma unroll
        for (int k = 0; k < 8; ++k) { LAS unsigned* d = (LAS unsigned*)(scr + (8 * k + l8) * 66 + ch); d[0] = x[k].x; d[1] = x[k].y; d[2] = x[k].z; d[3] = x[k].w; }
        LDS_WAIT(); asm volatile("" ::: "memory");
#pragma unroll
        for (int k = 0; k < 8; ++k) { const int t = 8 * k + l8; const LAS unsigned short* sp = scr + ch * 66 + t;
            v4u o; o.x = sp[0] | ((unsigned)sp[66] << 16); o.y = sp[2 * 66] | ((unsigned)sp[3 * 66] << 16); o.z = sp[4 * 66] | ((unsigned)sp[5 * 66] << 16); o.w = sp[6 * 66] | ((unsigned)sp[7 * 66] << 16);
            *(v4u*)(P + ((size_t)b * SEQ + tb * 64 + t) * DM + cb * 64 + ch) = o; }
        LDS_WAIT(); asm volatile("" ::: "memory");
    }
}

constexpr int NPH = 13;
__global__ void __launch_bounds__(NWAVES * 64, 2) hybrid_fwd(Args args) {
    extern __shared__ __attribute__((aligned(16))) unsigned char lds[];
    Frame F;
    F.lds = (LAS unsigned char*)lds;
    F.tid = threadIdx.x; F.lane = F.tid & 63; F.wave = __builtin_amdgcn_readfirstlane(F.tid >> 6);
    F.G = gridDim.x; { const int bx = blockIdx.x; F.vcu = (F.G % 8 == 0) ? (bx % 8) * (F.G / 8) + bx / 8 : bx; }
    F.in = args.in; F.out = args.out; F.ws = args.ws;
#ifdef PROBE_SEC
    F.sec = 0;
#endif
    unsigned char* ws = args.ws;
    volatile LAS unsigned* MISC = (volatile LAS unsigned*)(F.lds + MISC_OFF);
    for (int u = F.tid; u < (LDS_BYTES - LDSCTL_OFF) / 4; u += NWAVES * 64) ((LAS unsigned*)(F.lds + LDSCTL_OFF))[u] = 0u;
    __syncthreads();
    XcdBarrier bar; bar.bar = (unsigned*)(ws + CT_BAR) + args.li * XCD_BAR_WORDS; bar.x = 0; bar.st = nullptr;
    const int lo = args.ph_lo, hi = args.ph_hi;
    if (hi - lo > 1) bar = xcd_barrier_post((unsigned*)(ws + CT_BAR) + args.li * XCD_BAR_WORDS, MISC + 8);
#ifndef EXP_PAIR
#define EXP_PAIR 0
#endif
#ifndef REP_MASK
#define REP_MASK 0
#endif
#define REPS(k) ((((REP_MASK) >> (k)) & 1) ? 2 : 1)
#ifndef PH_MASK
#define PH_MASK 0xFFFFFF
#endif
#define IN(k) ((((PH_MASK) >> (k)) & 1) && lo <= (k) && (k) < hi)
#ifdef PROBE_TS
    unsigned long long ts_a = 0, ts_b = 0;
#define TS_MARK(k) do { if (blockIdx.x == 0 && F.tid == 0) { const unsigned long long t_ = __builtin_amdgcn_s_memrealtime(); if ((k) == PROBE_TS) ts_a = t_; if ((k) == PROBE_TS + 1) ts_b = t_; } } while (0)
#else
#define TS_MARK(k) do { } while (0)
#endif
#define SEAM(k) do { if (IN(k) && IN((k) + 1)) xcd_barrier(bar); TS_MARK((k) + 1); } while (0)
    const float* mods = (const float*)(ws + CT_MODS);
    const float* gnt = (const float*)(ws + SM_GN);
    float* ssqa = (float*)(ws + WS_SSQP);
    bf16* XS = (bf16*)(ws + WS_XS);

    TS_MARK(0);
    if (IN(0)) { for (int rep = 0; rep < REPS(0); ++rep) { phase0a(F); filtgen_phase(F); } } SEAM(0);
    if (IN(1)) { for (int rep = 0; rep < REPS(1); ++rep) { phase0b(F); filtfft_phase(F); } } SEAM(1);
    if (IN(2)) for (int rep = 0; rep < REPS(2); ++rep) {
        { pg8::Gemm g{XS, (const bf16*)(ws + WS_WQKV), TT, DM, DM, DM}; pg8::StaticOrder S; S.init(TT, DM, F.G, (int)blockIdx.x);
          EpiQK<0> E{(bf16*)(ws + WS_Q), (const float*)(ws + SM_SSQ0), 1, (const float*)(ws + CT_BQKV), 3072, args.in[9], SEQ};
          pg8::gemm_phase<EpiQK<0>, pg8::StaticOrder, true, true>(F.lds, g, S, E); }
        { pg8::Gemm g{XS, (const bf16*)(ws + WS_WQKV) + (size_t)1024 * DM, TT, DM, DM, DM}; pg8::StaticOrder S; S.init(TT, DM, F.G, (int)blockIdx.x);
          EpiQK<1> E{(bf16*)(ws + WS_K), (const float*)(ws + SM_SSQ0), 1, (const float*)(ws + CT_BQKV), 3072, args.in[10], SEQ};
          pg8::gemm_phase<EpiQK<1>, pg8::StaticOrder, true, true>(F.lds, g, S, E); }
        { pg8::Gemm g{XS, (const bf16*)(ws + WS_WQKV) + (size_t)2048 * DM, TT, DM, DM, DM}; pg8::StaticOrder S; S.init(TT, DM, F.G, (int)blockIdx.x);
          EpiVT E{(bf16*)(ws + WS_V), (const float*)(ws + SM_SSQ0), 1, (const float*)(ws + CT_BQKV), 3072, SEQ};
          pg8::gemm_phase<EpiVT, pg8::StaticOrder, true, true>(F.lds, g, S, E); }
        { pg8::Gemm g{(const bf16*)(ws + WS_XSC), (const bf16*)(ws + WS_WQKV) + (size_t)1024 * DM, TC, 2 * DM, DM, DM}; pg8::StaticOrder S; S.init(TC, 2 * DM, F.G, (int)blockIdx.x);
          EpiCtxKV E{ EpiQK<1>{(bf16*)(ws + WS_KC), (const float*)(ws + SM_SSQC), 1, (const float*)(ws + CT_BQKV) + 4 * 3072, 0, args.in[10], CTXL},
                      EpiVT{(bf16*)(ws + WS_VC), (const float*)(ws + SM_SSQC), 1, (const float*)(ws + CT_BQKV) + 4 * 3072, 0, CTXL} };
          pg8::gemm_phase<EpiCtxKV, pg8::StaticOrder, true, true>(F.lds, g, S, E); }
        { const int nct = (TC / 256) * (2 * DM / 256); const int idle = (int)F.G - nct;
          if (idle >= 184) { if ((int)blockIdx.x >= nct) bias_gemv_late(F, (int)blockIdx.x - nct); }
          else for (int it = (int)blockIdx.x; it < 184; it += (int)F.G) bias_gemv_late(F, it); }
    } SEAM(2);
    if (IN(3)) { for (int rep = 0; rep < REPS(3); ++rep) attn_mfma_phase(F); } SEAM(3);
    if (IN(4)) for (int rep = 0; rep < REPS(4); ++rep) {
        pg8::Gemm g{(const bf16*)(ws + WS_O), (const bf16*)(ws + WS_WO), TT, DM, DM, DM}; pg8::StaticOrder S; S.init(TT, DM, F.G, (int)blockIdx.x);
        EpiRes<true, false> E{args.in[0], ws + WS_XB, mods + 2048, nullptr, gnt, XS, ssqa, (float*)(lds + RING_BYTES + 8192)};
        pg8::gemm_phase<EpiRes<true, false>, pg8::StaticOrder, true, true>(F.lds, g, S, E);
    } SEAM(4);
    if (IN(5)) for (int rep = 0; rep < REPS(5); ++rep) {
        pg8::Gemm g{XS, (const bf16*)(ws + WS_WUP0), TT, 2 * FF, DM, DM}; pg8::StaticOrder S; S.init(TT, 2 * FF, F.G, (int)blockIdx.x);
        EpiUpGlu E{(bf16*)(ws + WS_AG), ssqa, 4, (const float*)(ws + CT_BUP0), args.in[14], args.in[15], (float*)(ws + WS_HG), (float*)(ws + WS_HA), (float*)(lds + RING_BYTES)};
        pg8::gemm_phase<EpiUpGlu, pg8::StaticOrder, true, true>(F.lds, g, S, E);
    } SEAM(5);

    if (IN(6)) {
        { pg8::StaticOrder S0; S0.init(TT, DM, F.G, (int)blockIdx.x); pg8::Unit fu;
#pragma unroll 1
          for (int i = 0; S0.next(i, fu); ++i) glu_fix_tile(F, fu.pm, args.in[14], args.in[15]);
          VM_WAIT(); __syncthreads(); asm volatile("" ::: "memory"); }
        pg8::Gemm g{(const bf16*)(ws + WS_AG), (const bf16*)(ws + WS_WDN0), TT, DM, FF, FF}; pg8::StaticOrder S; S.init(TT, DM, F.G, (int)blockIdx.x);
        EpiRes<false, false> E{ws + WS_XB, ws + WS_XB, mods + 5120, nullptr, gnt + 4096, XS, ssqa + 4 * TT, (float*)(lds + RING_BYTES + 8192)};
        pg8::gemm_phase<EpiRes<false, false>, pg8::StaticOrder, true, true>(F.lds, g, S, E);
    } SEAM(6);
    if (IN(7)) for (int rep = 0; rep < REPS(7); ++rep) {
        pg8::Gemm g{XS, (const bf16*)(ws + WS_WIN), TT, 3 * DM, DM, DM}; pg8::StaticOrder S; S.init(TT, 3 * DM, F.G, (int)blockIdx.x);
#ifdef EXP_P9
        EpiScaleBias E{(bf16*)(ws + WS_UT), 3 * DM, ssqa + 4 * TT, 4, (const float*)(ws + CT_BIN), 3072};
        pg8::gemm_phase<EpiScaleBias, pg8::StaticOrder, true, true>(F.lds, g, S, E);
#else
        EpiInT E{(bf16*)(ws + WS_UT), ssqa + 4 * TT, 4, (const float*)(ws + CT_BIN)};
        pg8::gemm_phase<EpiInT, pg8::StaticOrder, true, true>(F.lds, g, S, E);
#endif
    } SEAM(7);
    if (IN(8)) { for (int rep = 0; rep < REPS(8); ++rep) hyena_fft_phase(F); } SEAM(8);

    if (IN(9)) { for (int rep = 0; rep < REPS(9); ++rep) transpose_p_phase(F); } SEAM(9);
    if (IN(10)) {
        pg8::Gemm g{(const bf16*)(ws + WS_P), (const bf16*)(ws + WS_WOUT), TT, DM, DM, DM}; pg8::StaticOrder S; S.init(TT, DM, F.G, (int)blockIdx.x);
        EpiRes<false, false> E{ws + WS_XB, ws + WS_XB, mods + 5 * 6144 + 2048, args.in[35], gnt + 2 * 4096, XS, ssqa + 8 * TT, (float*)(lds + RING_BYTES + 8192)};
        pg8::gemm_phase<EpiRes<false, false>, pg8::StaticOrder, true, true>(F.lds, g, S, E);
    } SEAM(10);
    if (IN(11)) for (int rep = 0; rep < REPS(11); ++rep) {
        pg8::Gemm g{XS, (const bf16*)(ws + WS_WUP1), TT, 2 * FF, DM, DM}; pg8::StaticOrder S; S.init(TT, 2 * FF, F.G, (int)blockIdx.x);
        EpiUpGlu E{(bf16*)(ws + WS_AG), ssqa + 8 * TT, 4, (const float*)(ws + CT_BUP1), args.in[37], args.in[38], (float*)(ws + WS_HG), (float*)(ws + WS_HA), (float*)(lds + RING_BYTES)};
        pg8::gemm_phase<EpiUpGlu, pg8::StaticOrder, true, true>(F.lds, g, S, E);
    } SEAM(11);
    if (IN(12)) {
        { pg8::StaticOrder S0; S0.init(TT, DM, F.G, (int)blockIdx.x); pg8::Unit fu;
#pragma unroll 1
          for (int i = 0; S0.next(i, fu); ++i) glu_fix_tile(F, fu.pm, args.in[37], args.in[38]);
          VM_WAIT(); __syncthreads(); asm volatile("" ::: "memory"); }
        pg8::Gemm g{(const bf16*)(ws + WS_AG), (const bf16*)(ws + WS_WDN1), TT, DM, FF, FF}; pg8::StaticOrder S; S.init(TT, DM, F.G, (int)blockIdx.x);
        EpiRes<false, true> E{ws + WS_XB, args.out, mods + 5 * 6144 + 5120, nullptr, nullptr, nullptr, nullptr, nullptr};
        pg8::gemm_phase<EpiRes<false, true>, pg8::StaticOrder, true, true>(F.lds, g, S, E);
    }
#ifdef PROBE_SEC
    if (blockIdx.x == 0 && F.tid == 0) { asm volatile("s_waitcnt vmcnt(0)" ::: "memory"); args.out[0] = args.out[0] + (float)F.sec * 0.01f; }
#endif
#ifdef PROBE_TS
    TS_MARK(NPH);
    if (blockIdx.x == 0 && F.tid == 0) { asm volatile("s_waitcnt vmcnt(0)" ::: "memory"); args.out[0] = args.out[0] + (float)(ts_b - ts_a) * 0.01f; }
#endif
#ifdef PROBE_NULL
    if (lo == 98) {
#if PROBE_NULL == 5
        pg8::Gemm g{XS, (const bf16*)(ws + WS_WUP0), TT, 2 * FF, DM, DM}; pg8::StaticOrder S; S.init(TT, 2 * FF, F.G, (int)blockIdx.x);
#elif PROBE_NULL == 4
        pg8::Gemm g{(const bf16*)(ws + WS_O), (const bf16*)(ws + WS_WO), TT, DM, DM, DM}; pg8::StaticOrder S; S.init(TT, DM, F.G, (int)blockIdx.x);
#elif PROBE_NULL == 7
        pg8::Gemm g{(const bf16*)(ws + WS_AG), (const bf16*)(ws + WS_WDN0), TT, DM, FF, FF}; pg8::StaticOrder S; S.init(TT, DM, F.G, (int)blockIdx.x);
        { pg8::Unit fu; for (int i = 0; S.next(i, fu); ++i) glu_fix_tile(F, fu.pm, args.in[14], args.in[15]); VM_WAIT(); __syncthreads(); }
#else
        pg8::Gemm g{XS, (const bf16*)(ws + WS_WQKV), TT, 3 * DM, DM, DM}; pg8::StaticOrder S; S.init(TT, 3 * DM, F.G, (int)blockIdx.x);
#endif
        EpiNull E{(float*)(ws + WS_FSQP)};
        pg8::gemm_phase<EpiNull, pg8::StaticOrder, true, true>(F.lds, g, S, E);
    }
#endif
#ifdef DUMP_SEL
    if (lo == 99) {
        float* o = args.out; const size_t n = (size_t)TT * DM;
        for (size_t e = (size_t)blockIdx.x * 512 + F.tid; e < n; e += (size_t)F.G * 512) {
            float v;
            if (DUMP_SEL == 1) { const float* h = (const float*)(ws + WS_HT); v = (e < (size_t)2 * 1024 * SEQ) ? h[e] : ((const float*)(ws + WS_FSQP))[e & 1023]; }
            else if (DUMP_SEL == 2) { const bf16* u = (const bf16*)(ws + WS_UT); v = bf2f(u[e]); }
            else if (DUMP_SEL == 3) { const bf16* u = (const bf16*)(ws + WS_UT); v = bf2f(u[e + (size_t)TT * DM]); }
            else if (DUMP_SEL == 4) { const bf16* u = (const bf16*)(ws + WS_UT); v = bf2f(u[e + (size_t)2 * TT * DM]); }
            else { const bf16* u = (const bf16*)(ws + WS_P); v = bf2f(u[e]); }
            o[e] = v;
        }
    }
#endif
#undef IN
#undef SEAM
}

extern "C" void kernel_launch(void* const* d_in, const int* in_sizes, int n_in, void* d_out, int out_size, void* d_ws, size_t ws_size, hipStream_t stream) {
    static int grid = 0;
    if (grid == 0) {
        if (n_in != 40 || out_size != TT * DM || ws_size < WS_END) { fprintf(stderr, "kernel_launch: unexpected shapes n_in %d out %d ws %zu\n", n_in, out_size, ws_size); grid = -1; return; }
        int dev = 0, cus = 0;
        if (hipGetDevice(&dev) != hipSuccess || hipDeviceGetAttribute(&cus, hipDeviceAttributeMultiprocessorCount, dev) != hipSuccess) { grid = -1; return; }
        if (hipFuncSetAttribute((const void*)hybrid_fwd, hipFuncAttributeMaxDynamicSharedMemorySize, LDS_BYTES) != hipSuccess) { fprintf(stderr, "kernel_launch: hipFuncSetAttribute failed\n"); grid = -1; return; }
        int per_cu = 0;
        if (hipOccupancyMaxActiveBlocksPerMultiprocessor(&per_cu, (const void*)hybrid_fwd, NWAVES * 64, LDS_BYTES) != hipSuccess || per_cu < 1) { fprintf(stderr, "kernel_launch: occupancy query says %d\n", per_cu); }
        (void)hipGetLastError();
        grid = cus;
    }
    if (grid < 0) return;
    (void)hipMemsetAsync((char*)d_ws + WS_CTL, 0, CTL_ZERO_BYTES, stream);
    Args a{};
    for (int i = 0; i < 40; ++i) a.in[i] = (const float*)d_in[i];
    a.out = (float*)d_out; a.ws = (unsigned char*)d_ws; a.repmask = REP_MASK;
#if defined(PROBE_NULL)
    {   const int k = PROBE_NULL; const int lo[3] = {0, 98, k}, hi[3] = {k, 99, NPH};
        for (int i = 0; i < 3; ++i) { a.ph_lo = lo[i]; a.ph_hi = hi[i]; a.li = i;
            hipLaunchKernelGGL(hybrid_fwd, dim3(grid), dim3(NWAVES * 64), LDS_BYTES, stream, a); } }
#elif defined(PROBE_PHASE)
    {   const int k = PROBE_PHASE; const int lo[4] = {0, k, k, k + 1}, hi[4] = {k, k + 1, k + 1, NPH};
        for (int i = 0; i < 4; ++i) { if (lo[i] >= hi[i]) continue; a.ph_lo = lo[i]; a.ph_hi = hi[i]; a.li = i;
            hipLaunchKernelGGL(hybrid_fwd, dim3(grid), dim3(NWAVES * 64), LDS_BYTES, stream, a); } }
#elif MK_ONE_LAUNCH
    a.ph_lo = 0; a.ph_hi = NPH;
    hipLaunchKernelGGL(hybrid_fwd, dim3(grid), dim3(NWAVES * 64), LDS_BYTES, stream, a);
#else
    for (int p = 0; p < PH_END; ++p) { a.ph_lo = p; a.ph_hi = p + 1; hipLaunchKernelGGL(hybrid_fwd, dim3(grid), dim3(NWAVES * 64), LDS_BYTES, stream, a); }
#ifdef DUMP_SEL
    a.ph_lo = 99; a.ph_hi = 100; hipLaunchKernelGGL(hybrid_fwd, dim3(grid), dim3(NWAVES * 64), LDS_BYTES, stream, a);
#endif
#endif
}
```

```cpp
#include <hip/hip_runtime.h>
#include <cstdio>
#include <cstdint>

#ifndef PH_END
#define PH_END 13
#endif
#ifndef MK_ONE_LAUNCH
#define MK_ONE_LAUNCH 1
#endif

namespace pg8 {
#define PG8_LAS __attribute__((address_space(3)))
typedef unsigned short bf16_t;
typedef short bf16x8 __attribute__((ext_vector_type(8)));
typedef float f32x4 __attribute__((ext_vector_type(4)));
typedef unsigned u32x4 __attribute__((ext_vector_type(4)));
constexpr int BM = 256, BK = 64, HALF = 128, HTB = HALF * BK * 2, STAGE_BYTES = 8 * HTB, NXCD = 8, WGM = 8;

__host__ __device__ __forceinline__ int lds_byte(int r, int c) { const int st = (r >> 4) * 2 + (c >> 5), rr = r & 15, cc = c & 31, ob = rr * 64 + cc * 2; return st * 1024 + (ob ^ (((ob >> 9) & 1) << 5)); }
__host__ __device__ __forceinline__ void stage_rc(int b, int& R, int& C) { const int st = b / 1024, sb = b % 1024, swz = sb ^ (((sb >> 9) & 1) << 5); R = (st >> 1) * 16 + swz / 64; C = (st & 1) * 32 + (swz % 64) / 2; }
__host__ __device__ __forceinline__ int perm32(int rho) { const int n = rho >> 4, i = rho & 15; return 8 * (i >> 2) + 4 * n + (i & 3); }

struct Unit { int pm, pn; };
struct Gemm { const bf16_t* A; const bf16_t* Bt; int M, N, K, lda; };

struct StaticOrder {
    int nM, nN, nwg, G, c;
    __host__ __device__ __forceinline__ void init(int M, int N, int G_, int c_) { nM = M / BM; nN = N / BM; nwg = nM * nN; G = G_; c = c_; }
    __host__ __device__ __forceinline__ bool next(int i, Unit& u) const {
        const long L = (long)i * G + c; if (L >= nwg) return false;
        int wgid = (int)L; { const int q = nwg / NXCD, r = nwg % NXCD, xcd = wgid % NXCD, off = wgid / NXCD; wgid = (xcd < r ? xcd * (q + 1) : r * (q + 1) + (xcd - r) * q) + off; }
        const int nig = WGM * nN, gid = wgid / nig, fm = gid * WGM, gsz = (nM - fm) < WGM ? (nM - fm) : WGM;
        u.pm = fm + ((wgid % nig) % gsz); u.pn = (wgid % nig) / gsz; return true;
    }
    __device__ __forceinline__ void a_ready(const Unit&) const {}
    __device__ __forceinline__ void done(const Unit&) const {}
};

__device__ __forceinline__ unsigned cvt_pk_bf16(float lo, float hi) { unsigned r; asm volatile("v_cvt_pk_bf16_f32 %0, %1, %2" : "=v"(r) : "v"(lo), "v"(hi)); return r; }

template <class E> __device__ __forceinline__ auto epi_prefetch(const E& e, const Unit& u, int) -> decltype(e.prefetch(u), void()) { e.prefetch(u); }
template <class E> __device__ __forceinline__ void epi_prefetch(const E&, const Unit&, long) {}
template <class Epi, class Sched, bool ALIGN_EPI = false, bool SP2 = false>
__device__ __forceinline__ void gemm_phase(PG8_LAS unsigned char* lds, const Gemm g, const Sched& S, const Epi& E) {
    const int tid = threadIdx.x, wid = __builtin_amdgcn_readfirstlane(tid >> 6), lane = tid & 63, wr = wid >> 2, wc = wid & 3, fr = lane & 15, fq = lane >> 4;
    const int K = g.K, nt = K / BK, lda = g.lda;
    unsigned voffA[2], voffB[2];
#pragma unroll
    for (int i = 0; i < 2; ++i) { int R, C; stage_rc(tid * 16 + i * 8192, R, C); const int Rb = Epi::PERM ? ((R & ~31) + perm32(R & 31)) : R;
        voffA[i] = (unsigned)(R * lda + C) * 2u; voffB[i] = (unsigned)(Rb * K + C) * 2u; }
    const size_t kstep = (size_t)(BK * 2);
    const size_t hstepA = (size_t)HALF * lda * 2, hstepB = (size_t)HALF * K * 2;
    const size_t tstepA = 2 * hstepA, tstepB = 2 * hstepB;
    const unsigned ldsw = (unsigned)wid * 1024u;
    const int aoff = lds_byte(wr * 64 + fr, fq * 8), boff = lds_byte(wc * 32 + fr, fq * 8);
#define PG8_SA(b, h) (((b) * 2 + (h)) * HTB)
#define PG8_SB(b, h) ((4 + (b) * 2 + (h)) * HTB)
#define PG8_STAGE(bufoff, gbase, voff) do { _Pragma("unroll") for (int _i = 0; _i < 2; ++_i) \
        __builtin_amdgcn_global_load_lds((const unsigned*)((const char*)(gbase) + (voff)[_i]), (PG8_LAS unsigned*)(lds + (bufoff) + ldsw + _i * 8192), 16, 0, 0); } while (0)
#define PG8_LDA(dst, b, h) do { _Pragma("unroll") for (int m = 0; m < 4; ++m) _Pragma("unroll") for (int k = 0; k < 2; ++k) dst[m][k] = *(const PG8_LAS bf16x8*)(lds + PG8_SA(b, h) + aoff + m * 2048 + k * 1024); } while (0)
#define PG8_LDB(dst, b, h) do { _Pragma("unroll") for (int n = 0; n < 2; ++n) _Pragma("unroll") for (int k = 0; k < 2; ++k) dst[n][k] = *(const PG8_LAS bf16x8*)(lds + PG8_SB(b, h) + boff + n * 2048 + k * 1024); } while (0)
#define PG8_MMA(ai, bj, At, Bt) do { __builtin_amdgcn_s_setprio(1); _Pragma("unroll") for (int m = 0; m < 4; ++m) _Pragma("unroll") for (int n = 0; n < 2; ++n) _Pragma("unroll") for (int k = 0; k < 2; ++k) \
        acc[ai][bj][m][n] = __builtin_amdgcn_mfma_f32_16x16x32_bf16(Bt[n][k], At[m][k], acc[ai][bj][m][n], 0, 0, 0); __builtin_amdgcn_s_setprio(0); } while (0)
#define PG8_WAIT_V(n) asm volatile("s_waitcnt vmcnt(" #n ")" ::: "memory")
#define PG8_WAIT_L(n) asm volatile("s_waitcnt lgkmcnt(" #n ")" ::: "memory")
#define PG8_BAR __builtin_amdgcn_s_barrier()
#define PG8_SCHED __builtin_amdgcn_sched_barrier(0)
    Unit cur, nxt; int ui = 0;
    if (!S.next(0, cur)) return;
    f32x4 acc[2][2][4][2];
#pragma unroll
    for (int a = 0; a < 2; ++a)
#pragma unroll
        for (int b = 0; b < 2; ++b)
#pragma unroll
            for (int m = 0; m < 4; ++m)
#pragma unroll
                for (int n = 0; n < 2; ++n) acc[a][b][m][n] = (f32x4){0.f, 0.f, 0.f, 0.f};
    bf16x8 At[4][2], B0[2][2], B1[2][2];
    const char* cA = (const char*)g.A + (size_t)cur.pm * tstepA; const char* cB = (const char*)g.Bt + (size_t)cur.pn * tstepB;
    S.a_ready(cur);
    epi_prefetch(E, cur, 0);
    if constexpr (SP2) {
        PG8_STAGE(PG8_SB(0, 0), cB, voffB); PG8_STAGE(PG8_SB(0, 1), cB + hstepB, voffB); PG8_STAGE(PG8_SA(0, 0), cA, voffA); PG8_STAGE(PG8_SA(0, 1), cA + hstepA, voffA);
        if (wr == 1) PG8_BAR;
        PG8_WAIT_V(2); PG8_BAR;
        PG8_STAGE(PG8_SB(1, 0), cB + kstep, voffB); PG8_STAGE(PG8_SA(1, 0), cA + kstep, voffA); PG8_STAGE(PG8_SB(1, 1), cB + hstepB + kstep, voffB);
        PG8_WAIT_V(6); PG8_BAR;
    } else {
        PG8_STAGE(PG8_SB(0, 0), cB, voffB); PG8_STAGE(PG8_SA(0, 0), cA, voffA); PG8_STAGE(PG8_SB(0, 1), cB + hstepB, voffB); PG8_STAGE(PG8_SA(0, 1), cA + hstepA, voffA);
        if (wr == 1) PG8_BAR;
        PG8_WAIT_V(4); PG8_BAR;
        PG8_STAGE(PG8_SB(1, 0), cB + kstep, voffB); PG8_STAGE(PG8_SA(1, 0), cA + kstep, voffA); PG8_STAGE(PG8_SB(1, 1), cB + hstepB + kstep, voffB);
        PG8_WAIT_V(6); PG8_BAR;
    }
    for (;;) {
        const bool has_next = S.next(ui + 1, nxt);
        const char* nA = has_next ? (const char*)g.A + (size_t)nxt.pm * tstepA : cA; const char* nB = has_next ? (const char*)g.Bt + (size_t)nxt.pn * tstepB : cB;
        for (int t = 0; t < nt; t += 2) {
            const bool last = (t == nt - 2);
            const char* a1 = cA + (size_t)(t + 1) * kstep;
            const char* a2 = last ? nA : cA + (size_t)(t + 2) * kstep; const char* b2 = last ? nB : cB + (size_t)(t + 2) * kstep;
            const char* a3 = a2 + kstep; const char* b3 = b2 + kstep;
            if (last && has_next) S.a_ready(nxt);
            if constexpr (SP2) {
            PG8_LDB(B0, 0, 0); PG8_LDB(B1, 0, 1); PG8_SCHED; PG8_LDA(At, 0, 0); PG8_STAGE(PG8_SA(1, 1), a1 + hstepA, voffA);
            PG8_WAIT_V(8); PG8_WAIT_L(0); PG8_BAR; PG8_MMA(0, 0, At, B0); PG8_MMA(0, 1, At, B1); PG8_BAR; PG8_SCHED;
            PG8_LDA(At, 0, 1); PG8_STAGE(PG8_SB(0, 0), b2, voffB); PG8_STAGE(PG8_SB(0, 1), b2 + hstepB, voffB); PG8_STAGE(PG8_SA(0, 0), a2, voffA);
            PG8_WAIT_V(8); PG8_WAIT_L(0); PG8_BAR; PG8_MMA(1, 0, At, B0); PG8_MMA(1, 1, At, B1); PG8_BAR; PG8_SCHED;
            PG8_LDB(B0, 1, 0); PG8_LDB(B1, 1, 1); PG8_SCHED; PG8_LDA(At, 1, 0); PG8_STAGE(PG8_SA(0, 1), a2 + hstepA, voffA);
            PG8_WAIT_V(8); PG8_WAIT_L(0); PG8_BAR; PG8_MMA(0, 0, At, B0); PG8_MMA(0, 1, At, B1); PG8_BAR; PG8_SCHED;
            PG8_LDA(At, 1, 1); PG8_STAGE(PG8_SB(1, 0), b3, voffB); PG8_STAGE(PG8_SB(1, 1), b3 + hstepB, voffB); PG8_STAGE(PG8_SA(1, 0), a3, voffA);
            PG8_WAIT_V(8); PG8_WAIT_L(0); PG8_BAR; PG8_MMA(1, 0, At, B0); PG8_MMA(1, 1, At, B1); PG8_BAR; PG8_SCHED;
            } else {
            PG8_LDB(B0, 0, 0); PG8_SCHED; PG8_LDA(At, 0, 0); PG8_STAGE(PG8_SA(1, 1), a1 + hstepA, voffA);
            PG8_WAIT_L(8); PG8_BAR; PG8_WAIT_L(0); PG8_MMA(0, 0, At, B0); PG8_BAR; PG8_SCHED;
            PG8_LDB(B1, 0, 1); PG8_STAGE(PG8_SB(0, 0), b2, voffB);
            PG8_BAR; PG8_WAIT_L(0); PG8_MMA(0, 1, At, B1); PG8_BAR;
            PG8_LDA(At, 0, 1); PG8_STAGE(PG8_SA(0, 0), a2, voffA);
            PG8_BAR; PG8_WAIT_L(0); PG8_MMA(1, 0, At, B0); PG8_BAR; PG8_SCHED;
            PG8_STAGE(PG8_SB(0, 1), b2 + hstepB, voffB);
            PG8_WAIT_V(6); PG8_BAR; PG8_MMA(1, 1, At, B1); PG8_BAR;
            PG8_LDB(B0, 1, 0); PG8_SCHED; PG8_LDA(At, 1, 0); PG8_STAGE(PG8_SA(0, 1), a2 + hstepA, voffA);
            PG8_WAIT_L(8); PG8_BAR; PG8_WAIT_L(0); PG8_MMA(0, 0, At, B0); PG8_BAR; PG8_SCHED;
            PG8_LDB(B1, 1, 1); PG8_STAGE(PG8_SB(1, 0), b3, voffB);
            PG8_BAR; PG8_WAIT_L(0); PG8_MMA(0, 1, At, B1); PG8_BAR;
            PG8_LDA(At, 1, 1); PG8_STAGE(PG8_SA(1, 0), a3, voffA);
            PG8_BAR; PG8_WAIT_L(0); PG8_MMA(1, 0, At, B0); PG8_BAR; PG8_SCHED;
            PG8_STAGE(PG8_SB(1, 1), b3 + hstepB, voffB);
            PG8_WAIT_V(6); PG8_BAR; PG8_MMA(1, 1, At, B1); PG8_BAR;
            }
        }
        if constexpr (ALIGN_EPI) { if (wr == 0) PG8_BAR; }
        E(acc, cur, wr, wc, fr, fq); S.done(cur);
        if (!has_next) break;
#pragma unroll
        for (int a = 0; a < 2; ++a)
#pragma unroll
            for (int b = 0; b < 2; ++b)
#pragma unroll
                for (int m = 0; m < 4; ++m)
#pragma unroll
                    for (int n = 0; n < 2; ++n) acc[a][b][m][n] = (f32x4){0.f, 0.f, 0.f, 0.f};
        cur = nxt; cA = nA; cB = nB; ++ui;
        epi_prefetch(E, cur, 0);
        if constexpr (ALIGN_EPI) { if (wr == 1) PG8_BAR; }
    }
    PG8_WAIT_V(0);
    if constexpr (!ALIGN_EPI) { if (wr == 0) PG8_BAR; }
    PG8_BAR;
#undef PG8_SA
#undef PG8_SB
#undef PG8_STAGE
#undef PG8_LDA
#undef PG8_LDB
#undef PG8_MMA
#undef PG8_WAIT_V
#undef PG8_WAIT_L
#undef PG8_BAR
#undef PG8_SCHED
}
}

constexpr int NB = 4, SEQ = 8192, DM = 1024, TT = NB * SEQ, CTXL = 256, TC = NB * CTXL, FF = 2816, NH = 16, HD = 64, GW = 64, GROWS = SEQ / GW;
constexpr int WH = 8, WW = 16;
constexpr float EPS = 1e-6f;
constexpr int NWAVES = 8;

constexpr size_t MiB = 1u << 20;
constexpr size_t WS_CTL = 0, CTL_ZERO_BYTES = 64 * 1024;
constexpr size_t CT_BAR = 4096;
constexpr size_t CT_MODS = 64 * 1024;
constexpr size_t CT_BQKV = CT_MODS + 2 * 5 * 6144 * 4;
constexpr size_t CT_BUP0 = CT_BQKV + 5 * 3072 * 4;
constexpr size_t CT_BIN  = CT_BUP0 + 4 * 5632 * 4;
constexpr size_t CT_BUP1 = CT_BIN + 4 * 3072 * 4;
constexpr size_t CT_END  = CT_BUP1 + 4 * 5632 * 4;
static_assert(CT_END <= 1 * MiB, "ctl region");
constexpr size_t SM_SSQ0 = 1 * MiB, SM_SSQC = SM_SSQ0 + 32768 * 4, SM_GN = SM_SSQC + 1024 * 4;
constexpr size_t WS_SSQP = 2 * MiB;
constexpr size_t WS_FSQP = 4 * MiB;
constexpr size_t WS_XB = 448 * MiB;
constexpr size_t WS_WQKV = 8 * MiB, WS_WO = 14 * MiB, WS_WUP0 = 16 * MiB, WS_WDN0 = 27 * MiB, WS_WIN = 33 * MiB, WS_WOUT = 39 * MiB, WS_WUP1 = 41 * MiB, WS_WDN1 = 52 * MiB;
constexpr size_t WS_XSC = 58 * MiB, WS_KC = 60 * MiB, WS_VC = 62 * MiB;
constexpr size_t WS_XS = 64 * MiB;
constexpr size_t WS_Q = 128 * MiB, WS_K = 192 * MiB, WS_V = 256 * MiB, WS_O = WS_Q;
constexpr size_t WS_AG = 128 * MiB;
constexpr size_t WS_HG = 308 * MiB, WS_HA = 314 * MiB;
constexpr size_t WS_UT = 128 * MiB;
constexpr size_t WS_HT = 128 * MiB;
constexpr size_t WS_F = 320 * MiB;
constexpr size_t SM_TWM = 1536 * 1024, SM_TWN = SM_TWM + 65536;
constexpr size_t WS_P = 384 * MiB;
constexpr size_t WS_END = 512 * MiB;

constexpr int RING_BYTES = 131072;
constexpr int LDS_BYTES = 163840;
constexpr int CB_LDS_OFF = 136 * 1024;
constexpr int LDSCTL_OFF = LDS_BYTES - 1024, MISC_OFF = LDSCTL_OFF + 320;

#define GAS __attribute__((address_space(1)))
#define LAS __attribute__((address_space(3)))
typedef unsigned short bf16;
typedef unsigned v4u __attribute__((ext_vector_type(4)));
typedef unsigned v2u __attribute__((ext_vector_type(2)));
typedef float f32x4 __attribute__((ext_vector_type(4)));
typedef GAS unsigned gu32;
#define RLX_AGENT __ATOMIC_RELAXED, __HIP_MEMORY_SCOPE_AGENT
#define LDS_WAIT() asm volatile("s_waitcnt lgkmcnt(0)" ::: "memory")
#define VM_WAIT() asm volatile("s_waitcnt vmcnt(0)" ::: "memory")
__device__ __forceinline__ unsigned f2bf(float f) { unsigned u = __builtin_bit_cast(unsigned, f); return (u + 0x7fffu + ((u >> 16) & 1u)) >> 16; }
__device__ __forceinline__ unsigned pk2(float lo, float hi) { unsigned r; asm("v_cvt_pk_bf16_f32 %0, %1, %2" : "=v"(r) : "v"(lo), "v"(hi)); return r; }
__device__ __forceinline__ float bf2f(unsigned short h) { return __builtin_bit_cast(float, (unsigned)h << 16); }
__device__ __forceinline__ float bflo(unsigned w) { return __builtin_bit_cast(float, w << 16); }
__device__ __forceinline__ float bfhi(unsigned w) { return __builtin_bit_cast(float, w & 0xffff0000u); }

#define FC_HD __device__ __forceinline__
typedef float cf __attribute__((ext_vector_type(2)));
FC_HD cf cmul(cf a, cf b) { const cf t = {-b.y, b.x}; return a.xx * b + a.yy * t; }
FC_HD cf cadd(cf a, cf b) { return a + b; }
FC_HD cf csub(cf a, cf b) { return a - b; }
FC_HD cf cconj(cf a) { cf r; r.x = a.x; r.y = -a.y; return r; }
FC_HD cf cmulnegi(cf a) { cf r; r.x = a.y; r.y = -a.x; return r; }
#define FC_OPAQUE(x) asm volatile("" : "+v"(x))
#define FC_PIDX(i) ((i) + (((i) >> 6) << 3))
#define FC_M 8192
#define FC_PADM (FC_M + FC_M / 8)
#define FC_S2 0.70710678118654752f
FC_HD void dft4(cf& a0, cf& a1, cf& a2, cf& a3) {
    const cf c0 = cadd(a0, a2), c1 = cadd(a1, a3), d0 = csub(a0, a2), d1 = cmulnegi(csub(a1, a3));
    a0 = cadd(c0, c1); a1 = cadd(d0, d1); a2 = csub(c0, c1); a3 = csub(d0, d1);
}
FC_HD void dft8(cf* v) {
    cf a0 = cadd(v[0], v[4]), a1 = cadd(v[1], v[5]), a2 = cadd(v[2], v[6]), a3 = cadd(v[3], v[7]);
    cf b0 = csub(v[0], v[4]), b1 = csub(v[1], v[5]), b2 = csub(v[2], v[6]), b3 = csub(v[3], v[7]);
    { cf t; t.x = (b1.x + b1.y) * FC_S2; t.y = (b1.y - b1.x) * FC_S2; b1 = t; }
    b2 = cmulnegi(b2);
    { cf t; t.x = (b3.y - b3.x) * FC_S2; t.y = (-b3.x - b3.y) * FC_S2; b3 = t; }
    dft4(a0, a1, a2, a3); dft4(b0, b1, b2, b3);
    v[0] = a0; v[2] = a1; v[4] = a2; v[6] = a3; v[1] = b0; v[3] = b1; v[5] = b2; v[7] = b3;
}
FC_HD void dft16(cf* v) {
    cf a[8], b[8];
    const float c1 = 0.92387953251128674f, s1 = 0.38268343236508977f;
#ifdef __HIP_DEVICE_COMPILE__
#pragma unroll
#endif
    for (int i = 0; i < 8; ++i) { a[i] = cadd(v[i], v[i + 8]); b[i] = csub(v[i], v[i + 8]); }
    { cf w; w.x = c1; w.y = -s1; b[1] = cmul(b[1], w); }
    { cf w; w.x = FC_S2; w.y = -FC_S2; b[2] = cmul(b[2], w); }
    { cf w; w.x = s1; w.y = -c1; b[3] = cmul(b[3], w); }
    b[4] = cmulnegi(b[4]);
    { cf w; w.x = -s1; w.y = -c1; b[5] = cmul(b[5], w); }
    { cf w; w.x = -FC_S2; w.y = -FC_S2; b[6] = cmul(b[6], w); }
    { cf w; w.x = -c1; w.y = -s1; b[7] = cmul(b[7], w); }
    dft8(a); dft8(b);
#ifdef __HIP_DEVICE_COMPILE__
#pragma unroll
#endif
    for (int i = 0; i < 8; ++i) { v[2 * i] = a[i]; v[2 * i + 1] = b[i]; }
}
template <int R> FC_HD void cpowers(cf w1, cf* w) {
    w[0].x = 1.f; w[0].y = 0.f; w[1] = w1;
#ifdef __HIP_DEVICE_COMPILE__
#pragma unroll
#endif
    for (int q = 2; q < R; ++q) w[q] = (q & 1) ? cmul(w[q - 1], w1) : cmul(w[q >> 1], w[q >> 1]);
}
template <class LP> FC_HD void fwd_pass1(cf* v, int tid, LP a, const cf* TWM) {
    dft16(v);
    FC_OPAQUE(tid);
    const cf w1 = TWM[tid]; cf cur = w1;
    const int pt = FC_PIDX(tid);
    a[pt] = v[0];
#ifdef __HIP_DEVICE_COMPILE__
#pragma unroll
#endif
    for (int q = 1; q < 16; ++q) { a[pt + 576 * q] = cmul(v[q], cur); cur = cmul(cur, w1); }
}
template <class LP> FC_HD void fwd_pass8(int tid, LP a, const cf* TWM, int s, int lgs) {
#pragma unroll 1
    for (int h = 0; h < 2; ++h) {
        FC_OPAQUE(tid);
        const int bf = tid + 512 * h, j = bf & (s - 1), base = (bf >> lgs) * 8 * s;
        const int pb = FC_PIDX(base + j), ps = (s == 64) ? 72 : 8;
        cf v[8];
#ifdef __HIP_DEVICE_COMPILE__
#pragma unroll
#endif
        for (int r = 0; r < 8; ++r) v[r] = a[pb + ps * r];
        dft8(v);
        const cf w1 = TWM[j]; cf cur = w1;
        a[pb] = v[0];
#ifdef __HIP_DEVICE_COMPILE__
#pragma unroll
#endif
        for (int q = 1; q < 8; ++q) { a[pb + ps * q] = cmul(v[q], cur); cur = cmul(cur, w1); }
    }
}
template <class LP> FC_HD void mid_pass(int tid, LP a, const cf* F, cf* Fout, float fscale) {
#pragma unroll 1
    for (int h = 0; h < 2; ++h) {
        FC_OPAQUE(tid);
        const int bf = tid + 512 * h, base = bf * 8, pb = FC_PIDX(base);
        cf v[8];
#ifdef __HIP_DEVICE_COMPILE__
#pragma unroll
#endif
        for (int r = 0; r < 8; ++r) v[r] = a[pb + r];
        dft8(v);
        if (F) {
#ifdef __HIP_DEVICE_COMPILE__
#pragma unroll
#endif
            for (int r = 0; r < 8; ++r) v[r] = cconj(cmul(v[r], F[base + r]));
            dft8(v);
#ifdef __HIP_DEVICE_COMPILE__
#pragma unroll
#endif
            for (int r = 0; r < 8; ++r) a[pb + r] = v[r];
        } else {
#ifdef __HIP_DEVICE_COMPILE__
#pragma unroll
#endif
            for (int r = 0; r < 8; ++r) { cf o; o.x = v[r].x * fscale; o.y = v[r].y * fscale; Fout[base + r] = o; }
        }
    }
}
template <class LP> FC_HD void mid_pass_reg(int tid, LP a, const cf* fr) {
#ifdef __HIP_DEVICE_COMPILE__
#pragma unroll
#endif
    for (int h = 0; h < 2; ++h) {
        FC_OPAQUE(tid);
        const int bf = tid + 512 * h, base = bf * 8, pb = FC_PIDX(base);
        cf v[8];
#ifdef __HIP_DEVICE_COMPILE__
#pragma unroll
#endif
        for (int r = 0; r < 8; ++r) v[r] = a[pb + r];
        dft8(v);
#ifdef __HIP_DEVICE_COMPILE__
#pragma unroll
#endif
        for (int r = 0; r < 8; ++r) v[r] = cconj(cmul(v[r], fr[h * 8 + r]));
        dft8(v);
#ifdef __HIP_DEVICE_COMPILE__
#pragma unroll
#endif
        for (int r = 0; r < 8; ++r) a[pb + r] = v[r];
    }
}
template <class LP> FC_HD void inv_pass8(int tid, LP a, const cf* TWM, int s, int lgs) {
#pragma unroll 1
    for (int h = 0; h < 2; ++h) {
        FC_OPAQUE(tid);
        const int bf = tid + 512 * h, j = bf & (s - 1), base = (bf >> lgs) * 8 * s;
        const int pb = FC_PIDX(base + j), ps = (s == 64) ? 72 : 8;
        cf v[8]; const cf w1 = TWM[j]; cf cur = w1;
        v[0] = a[FC_PIDX(base + j)];
#ifdef __HIP_DEVICE_COMPILE__
#pragma unroll
#endif
        for (int q = 1; q < 8; ++q) { v[q] = cmul(a[pb + ps * q], cur); cur = cmul(cur, w1); }
        dft8(v);
#ifdef __HIP_DEVICE_COMPILE__
#pragma unroll
#endif
        for (int r = 0; r < 8; ++r) a[pb + ps * r] = v[r];
    }
}
template <class LP> FC_HD void inv_pass1(cf* v, int tid, LP a, const cf* TWM) {
    FC_OPAQUE(tid);
    const cf w1 = TWM[tid]; cf cur = w1;
    const int pt = FC_PIDX(tid);
    v[0] = a[pt];
#ifdef __HIP_DEVICE_COMPILE__
#pragma unroll
#endif
    for (int q = 1; q < 16; ++q) { v[q] = cmul(a[pt + 576 * q], cur); cur = cmul(cur, w1); }
    dft16(v);
}

#define F2_PIDX(i) ((i) + ((i) >> 5))
#define F2_PADM (8192 + 256)
FC_HD void dft32(cf* v) {
    const float c[16] = {1.0f, 0.98078528040323043f, 0.92387953251128674f, 0.83146961230254524f, 0.70710678118654752f, 0.55557023301960218f, 0.38268343236508977f, 0.19509032201612825f,
                         0.0f, -0.19509032201612825f, -0.38268343236508977f, -0.55557023301960218f, -0.70710678118654752f, -0.83146961230254524f, -0.92387953251128674f, -0.98078528040323043f};
    const float s[16] = {0.0f, 0.19509032201612825f, 0.38268343236508977f, 0.55557023301960218f, 0.70710678118654752f, 0.83146961230254524f, 0.92387953251128674f, 0.98078528040323043f,
                         1.0f, 0.98078528040323043f, 0.92387953251128674f, 0.83146961230254524f, 0.70710678118654752f, 0.55557023301960218f, 0.38268343236508977f, 0.19509032201612825f};
#ifdef __HIP_DEVICE_COMPILE__
#pragma unroll
#endif
    for (int i = 0; i < 16; ++i) { const cf a = cadd(v[i], v[i + 16]); cf b = csub(v[i], v[i + 16]);
        if (i == 8) b = cmulnegi(b); else if (i != 0) { cf w; w.x = c[i]; w.y = -s[i]; b = cmul(b, w); }
        v[i] = a; v[i + 16] = b; }
    dft16(v); dft16(v + 16);
}
#define F2_Q(k) (2 * ((k) & 15) + ((k) >> 4))
template <class LP> FC_HD void f2_fwd_p1(cf* v, int tid, LP a, const cf* tw1) {
    dft16(v);
    FC_OPAQUE(tid);
    const cf w1 = tw1[tid]; cf cur = w1;
    const int pt = F2_PIDX(tid);
    a[pt] = v[0];
#ifdef __HIP_DEVICE_COMPILE__
#pragma unroll
#endif
    for (int q = 1; q < 16; ++q) { a[pt + 528 * q] = cmul(v[q], cur); cur = cmul(cur, w1); }
}
template <class LP> FC_HD void f2_fwd_p2(int tid, LP a, const cf* tw32) {
    FC_OPAQUE(tid);
    const int j = tid & 31, pb = F2_PIDX((tid >> 5) * 512 + j);
    cf v[16];
#ifdef __HIP_DEVICE_COMPILE__
#pragma unroll
#endif
    for (int r = 0; r < 16; ++r) v[r] = a[pb + 33 * r];
    dft16(v);
    const cf w1 = tw32[j]; cf cur = w1;
    a[pb] = v[0];
#ifdef __HIP_DEVICE_COMPILE__
#pragma unroll
#endif
    for (int q = 1; q < 16; ++q) { a[pb + 33 * q] = cmul(v[q], cur); cur = cmul(cur, w1); }
}
template <class LP> FC_HD void f2_fwd_p2_dual(int tid, LP a, LP b, const cf* tw32) {
    FC_OPAQUE(tid);
    const int j = tid & 31, pb = F2_PIDX((tid >> 5) * 512 + j);
    cf v[16], w[16];
#ifdef __HIP_DEVICE_COMPILE__
#pragma unroll
#endif
    for (int r = 0; r < 16; ++r) v[r] = a[pb + 33 * r];
#ifdef __HIP_DEVICE_COMPILE__
#pragma unroll
#endif
    for (int r = 0; r < 16; ++r) w[r] = b[pb + 33 * r];
    const cf w1 = tw32[j];
    dft16(v);
    { cf cur = w1; a[pb] = v[0];
#ifdef __HIP_DEVICE_COMPILE__
#pragma unroll
#endif
      for (int q = 1; q < 16; ++q) { a[pb + 33 * q] = cmul(v[q], cur); cur = cmul(cur, w1); } }
    dft16(w);
    { cf cur = w1; b[pb] = w[0];
#ifdef __HIP_DEVICE_COMPILE__
#pragma unroll
#endif
      for (int q = 1; q < 16; ++q) { b[pb + 33 * q] = cmul(w[q], cur); cur = cmul(cur, w1); } }
}
template <class LP> FC_HD void f2_inv_p2_dual(int tid, LP a, LP b, const cf* tw32) {
    FC_OPAQUE(tid);
    const int j = tid & 31, pb = F2_PIDX((tid >> 5) * 512 + j);
    cf v[16], w[16]; const cf w1 = tw32[j];
#ifdef __HIP_DEVICE_COMPILE__
#pragma unroll
#endif
    for (int r = 0; r < 16; ++r) v[r] = a[pb + 33 * r];
#ifdef __HIP_DEVICE_COMPILE__
#pragma unroll
#endif
    for (int r = 0; r < 16; ++r) w[r] = b[pb + 33 * r];
    { cf cur = w1;
#ifdef __HIP_DEVICE_COMPILE__
#pragma unroll
#endif
      for (int q = 1; q < 16; ++q) { v[q] = cmul(v[q], cur); cur = cmul(cur, w1); } }
    dft16(v);
#ifdef __HIP_DEVICE_COMPILE__
#pragma unroll
#endif
    for (int r = 0; r < 16; ++r) a[pb + 33 * r] = v[r];
    { cf cur = w1;
#ifdef __HIP_DEVICE_COMPILE__
#pragma unroll
#endif
      for (int q = 1; q < 16; ++q) { w[q] = cmul(w[q], cur); cur = cmul(cur, w1); } }
    dft16(w);
#ifdef __HIP_DEVICE_COMPILE__
#pragma unroll
#endif
    for (int r = 0; r < 16; ++r) b[pb + 33 * r] = w[r];
}
template <class LP> FC_HD void f2_mid(int bf, LP a, const cf* fr, cf* Fout, float fscale) {
    FC_OPAQUE(bf);
    const int pb = 33 * bf;
    cf v[32];
#ifdef __HIP_DEVICE_COMPILE__
#pragma unroll
#endif
    for (int i = 0; i < 32; ++i) v[i] = a[pb + i];
    dft32(v);
    if (fr) {
        cf w[32];
#ifdef __HIP_DEVICE_COMPILE__
#pragma unroll
#endif
        for (int k = 0; k < 32; ++k) w[F2_Q(k)] = cconj(cmul(v[k], fr[F2_Q(k)]));
        dft32(w);
#ifdef __HIP_DEVICE_COMPILE__
#pragma unroll
#endif
        for (int k = 0; k < 32; ++k) a[pb + F2_Q(k)] = w[k];
    } else {
#ifdef __HIP_DEVICE_COMPILE__
#pragma unroll
#endif
        for (int k = 0; k < 32; ++k) { cf o; o.x = v[k].x * fscale; o.y = v[k].y * fscale; Fout[F2_Q(k) * 256 + bf] = o; }
    }
}
typedef _Float16 h2v __attribute__((ext_vector_type(2)));
FC_HD unsigned pkh2(cf a) { h2v v; v.x = (_Float16)a.x; v.y = (_Float16)a.y; return __builtin_bit_cast(unsigned, v); }
FC_HD cf unh2(unsigned u) { const h2v v = __builtin_bit_cast(h2v, u); cf r; r.x = (float)v.x; r.y = (float)v.y; return r; }
template <class LP> FC_HD void f2_mid_store16(int bf, LP a, v2u* Fout) {
    FC_OPAQUE(bf);
    const int pb = 33 * bf;
    cf v[32];
#pragma unroll
    for (int i = 0; i < 32; ++i) v[i] = a[pb + i];
    dft32(v);
#pragma unroll
    for (int k = 0; k < 16; ++k) { v2u o; o.x = pkh2(v[k]); o.y = pkh2(v[k + 16]); Fout[k * 256 + bf] = o; }
}
template <class LP> FC_HD void f2_mid16(int bf, LP a, const v2u* fr16) {
    FC_OPAQUE(bf);
    const int pb = 33 * bf;
    cf v[32];
#pragma unroll
    for (int i = 0; i < 32; ++i) v[i] = a[pb + i];
    dft32(v);
    cf w[32];
#pragma unroll
    for (int k = 0; k < 32; ++k) w[F2_Q(k)] = cconj(cmul(v[k], unh2(k < 16 ? fr16[k & 15].x : fr16[k & 15].y)));
    dft32(w);
#pragma unroll
    for (int k = 0; k < 32; ++k) a[pb + F2_Q(k)] = w[k];
}
template <class LP> FC_HD void f2_inv_p2(int tid, LP a, const cf* tw32) {
    FC_OPAQUE(tid);
    const int j = tid & 31, pb = F2_PIDX((tid >> 5) * 512 + j);
    cf v[16]; const cf w1 = tw32[j]; cf cur = w1;
    v[0] = a[pb];
#ifdef __HIP_DEVICE_COMPILE__
#pragma unroll
#endif
    for (int q = 1; q < 16; ++q) { v[q] = cmul(a[pb + 33 * q], cur); cur = cmul(cur, w1); }
    dft16(v);
#ifdef __HIP_DEVICE_COMPILE__
#pragma unroll
#endif
    for (int r = 0; r < 16; ++r) a[pb + 33 * r] = v[r];
}
template <class LP> FC_HD void f2_inv_p1(cf* v, int tid, LP a, const cf* tw1) {
    FC_OPAQUE(tid);
    const cf w1 = tw1[tid]; cf cur = w1;
    const int pt = F2_PIDX(tid);
    v[0] = a[pt];
#ifdef __HIP_DEVICE_COMPILE__
#pragma unroll
#endif
    for (int q = 1; q < 16; ++q) { v[q] = cmul(a[pt + 528 * q], cur); cur = cmul(cur, w1); }
    dft16(v);
}

#define XB_TMO      128
#define XB_XCNT(j)  (256  + 64 * (j))
#define XB_XSUB(j)  (1280 + 64 * (j))
#define XB_XGEN(j)  (2304 + 64 * (j))
#define XB_TOP      3328
#define XB_TOPGEN   3392
#define XCD_BAR_WORDS 3456
#define XB_SPIN_CAP (1u << 18)
__device__ __forceinline__ unsigned xb_ld(unsigned* p)              { return __hip_atomic_load(p, __ATOMIC_RELAXED, __HIP_MEMORY_SCOPE_AGENT); }
__device__ __forceinline__ unsigned xb_add(unsigned* p, unsigned v) { return __hip_atomic_fetch_add(p, v, __ATOMIC_RELAXED, __HIP_MEMORY_SCOPE_AGENT); }
__device__ __forceinline__ unsigned xb_xcc_id() { return (unsigned)__builtin_amdgcn_s_getreg((3 << 11) | 20) & 0xFu; }
#define XB_SPIN(cond, bar) do { unsigned _sp = 0; while (cond) { __builtin_amdgcn_s_sleep(1); \
    if ((++_sp & 255u) == 0u) { if (xb_ld(&(bar)[XB_TMO])) break; if (_sp > XB_SPIN_CAP) { atomicAdd(&(bar)[XB_TMO], 1u); break; } } } } while (0)
struct XcdBarrier { unsigned* bar; unsigned x; volatile LAS unsigned* st; };
__device__ __forceinline__ XcdBarrier xcd_barrier_post(unsigned* bar, volatile LAS unsigned* st) {
    XcdBarrier b; b.bar = bar; b.x = xb_xcc_id(); b.st = st;
    if (threadIdx.x == 0) (void)xb_add(&bar[XB_XCNT(b.x)], 1u);
    return b;
}
__device__ __forceinline__ void xcd_barrier_complete(unsigned* bar, unsigned x, unsigned& nloc, unsigned& nx) {
    const unsigned G = gridDim.x * gridDim.y * gridDim.z;
    unsigned sum, cnt, mine, sp = 0u;
    for (;;) {
        sum = 0u; cnt = 0u; mine = 0u;
#pragma unroll
        for (unsigned j = 0; j < 16; ++j) { const unsigned c = xb_ld(&bar[XB_XCNT(j)]); sum += c; cnt += (c > 0u) ? 1u : 0u; mine = (j == x) ? c : mine; }
        if (sum == G) break;
        __builtin_amdgcn_s_sleep(1);
        if ((++sp & 255u) == 0u) { if (xb_ld(&bar[XB_TMO])) break; if (sp > XB_SPIN_CAP) { atomicAdd(&bar[XB_TMO], 1u); break; } }
    }
    nloc = mine > 0u ? mine : 1u; nx = cnt > 0u ? cnt : 1u;
}
__device__ __forceinline__ void xcd_barrier(const XcdBarrier& b) {
    asm volatile("s_waitcnt vmcnt(0)" ::: "memory");
    __syncthreads();
    if (threadIdx.x == 0) {
        unsigned* bar = b.bar;
        __builtin_amdgcn_s_waitcnt(0);
        unsigned nloc = b.st[0], nx = b.st[1];
        if (nloc == 0u) { xcd_barrier_complete(bar, b.x, nloc, nx); b.st[0] = nloc; b.st[1] = nx; }
        const unsigned old = xb_add(&bar[XB_XSUB(b.x)], 1u);
        const unsigned gen = old / nloc;
        if (old + 1u == (gen + 1u) * nloc) {
            __builtin_amdgcn_fence(__ATOMIC_RELEASE, "agent");
            asm volatile("s_waitcnt vmcnt(0)" ::: "memory");
            const unsigned og = xb_add(&bar[XB_TOP], 1u);
            const unsigned tg = og / nx;
            if (og + 1u == (tg + 1u) * nx) xb_add(&bar[XB_TOPGEN], 1u);
            else XB_SPIN(xb_ld(&bar[XB_TOPGEN]) == tg, bar);
            __builtin_amdgcn_fence(__ATOMIC_ACQUIRE, "agent");
            xb_add(&bar[XB_XGEN(b.x)], 1u);
            asm volatile("s_waitcnt vmcnt(0)" ::: "memory");
        } else {
            XB_SPIN(xb_ld(&bar[XB_XGEN(b.x)]) == gen, bar);
            __builtin_amdgcn_fence(__ATOMIC_ACQUIRE, "agent");
            asm volatile("s_waitcnt vmcnt(0)" ::: "memory");
        }
    }
    __syncthreads();
}

struct Args { const float* in[40]; float* out; unsigned char* ws; int ph_lo, ph_hi, repmask, li; };
struct Frame {
    LAS unsigned char* lds;
    int tid, lane, wave, vcu, G;
    const float* const* in; float* out; unsigned char* ws;
#ifdef PROBE_SEC
    unsigned long long sec;
#endif
};
__device__ __forceinline__ float wave_sum(float v) {
#pragma unroll
    for (int o = 1; o < 64; o <<= 1) v += __shfl_xor(v, o);
    return v;
}
__device__ __forceinline__ float silu_f(float x) { return x / (1.f + __expf(-x)); }

__device__ __forceinline__ float gelu_f(float v) { return 0.5f * v * (1.f + erff(v * 0.70710678118654752f)); }

__device__ __forceinline__ void transpose_item(const float* W, int K, int N, bf16* WT, int src_col0, int dst_row0, int k0, LAS float* scr, int lane) {
    {
        const int r8 = lane >> 3, c4 = (lane & 7) * 4;
        f32x4 x[8];
#pragma unroll
        for (int i = 0; i < 8; ++i) x[i] = *(const f32x4*)(W + (size_t)(k0 + 8 * i + r8) * N + src_col0 + c4);
#pragma unroll
        for (int i = 0; i < 8; ++i) { LAS float* d = scr + (8 * i + r8) * 33 + c4; d[0] = x[i].x; d[1] = x[i].y; d[2] = x[i].z; d[3] = x[i].w; }
    }
    LDS_WAIT(); asm volatile("" ::: "memory");
    const int c = lane & 7;
#pragma unroll
    for (int j = 0; j < 4; ++j) { const int n = (lane >> 3) + 8 * j; const LAS float* s = scr + (8 * c) * 33 + n;
        v4u o; o.x = pk2(s[0 * 33], s[1 * 33]); o.y = pk2(s[2 * 33], s[3 * 33]); o.z = pk2(s[4 * 33], s[5 * 33]); o.w = pk2(s[6 * 33], s[7 * 33]);
        *(GAS v4u*)(WT + (size_t)(dst_row0 + n) * K + k0 + 8 * c) = o; }
    LDS_WAIT(); asm volatile("" ::: "memory");
}
__device__ __forceinline__ void transpose_load(const float* W, int N, int src_col0, int k0, int lane, f32x4 (&x)[8]) {
    const int r8 = lane >> 3, c4 = (lane & 7) * 4;
#pragma unroll
    for (int i = 0; i < 8; ++i) x[i] = *(const f32x4*)(W + (size_t)(k0 + 8 * i + r8) * N + src_col0 + c4);
}
__device__ __forceinline__ void transpose_finish(const f32x4 (&x)[8], int K, bf16* WT, int dst_row0, int k0, LAS float* scr, int lane) {
    { const int r8 = lane >> 3, c4 = (lane & 7) * 4;
#pragma unroll
      for (int i = 0; i < 8; ++i) { LAS float* d = scr + (8 * i + r8) * 33 + c4; d[0] = x[i].x; d[1] = x[i].y; d[2] = x[i].z; d[3] = x[i].w; } }
    LDS_WAIT(); asm volatile("" ::: "memory");
    const int c = lane & 7;
#pragma unroll
    for (int j = 0; j < 4; ++j) { const int n = (lane >> 3) + 8 * j; const LAS float* s = scr + (8 * c) * 33 + n;
        v4u o; o.x = pk2(s[0 * 33], s[1 * 33]); o.y = pk2(s[2 * 33], s[3 * 33]); o.z = pk2(s[4 * 33], s[5 * 33]); o.w = pk2(s[6 * 33], s[7 * 33]);
        *(GAS v4u*)(WT + (size_t)(dst_row0 + n) * K + k0 + 8 * c) = o; }
    LDS_WAIT(); asm volatile("" ::: "memory");
}
__device__ __forceinline__ int qkv_slot_to_col(int slot) {
    const int part = slot >> 10, cc = slot & 1023, pnl = cc >> 8, s = cc & 255, bj = s >> 7, wc = (s & 127) >> 5, j = s & 31;
    return part * 1024 + (4 * pnl + wc) * 64 + 32 * bj + j;
}
__device__ __forceinline__ int up_slot_to_col(int slot) { const int pn = slot >> 8, bj = (slot >> 7) & 1, cc = slot & 127; return bj * FF + pn * 128 + cc; }
__device__ __forceinline__ void cvt_weight_item(const float* W, int K, int N, bf16* WT, int item, LAS float* scr, int lane, int perm) {
    const int nblk = N / 32, kb = item / nblk, nb = item % nblk;
    const int dst = 32 * nb, src = perm == 1 ? qkv_slot_to_col(dst) : (perm == 2 ? up_slot_to_col(dst) : dst);
    transpose_item(W, K, N, WT, src, dst, 64 * kb, scr, lane);
}

template <int R, class VF>
__device__ __forceinline__ void gemv_det_item(const float* W, int N, int n0, float* out, int ostride, const float* addbias, const VF& vf, int tid, LAS float* scr) {
    const int col = tid & 63, ks = tid >> 6;
    float acc[R];
#pragma unroll
    for (int r = 0; r < R; ++r) acc[r] = 0.f;
    const float* wp = W + (size_t)(ks * 128) * N + n0 + col;
#pragma unroll 32
    for (int k = 0; k < 128; ++k) { const float w = wp[(size_t)k * N];
#pragma unroll
        for (int r = 0; r < R; ++r) acc[r] += vf(r, ks * 128 + k) * w; }
    __syncthreads();
#pragma unroll
    for (int r = 0; r < R; ++r) scr[(ks * R + r) * 64 + col] = acc[r];
    __syncthreads();
    if (tid < R * 64) { const int r = tid >> 6; float s = 0.f;
#pragma unroll
        for (int k2 = 0; k2 < 8; ++k2) s += scr[(k2 * R + r) * 64 + col];
        if (addbias) s += addbias[n0 + col];
        out[(size_t)r * ostride + n0 + col] = s; }
}

template <int R, class VF>
__device__ __forceinline__ void gemv_det_item16(const float* W, int N, int n0, float* out, int ostride, const float* addbias, const VF& vf, int tid, LAS float* scr) {
    const int col = tid & 15, ks = tid >> 4;
    float acc[R];
#pragma unroll
    for (int r = 0; r < R; ++r) acc[r] = 0.f;
    const float* wp = W + (size_t)(ks * 32) * N + n0 + col;
#pragma unroll 8
    for (int k = 0; k < 32; ++k) { const float w = wp[(size_t)k * N];
#pragma unroll
        for (int r = 0; r < R; ++r) acc[r] += vf(r, ks * 32 + k) * w; }
    __syncthreads();
#pragma unroll
    for (int r = 0; r < R; ++r) scr[(ks * R + r) * 16 + col] = acc[r];
    __syncthreads();
    if (tid < R * 16) { const int r = tid >> 4; float s = 0.f;
#pragma unroll
        for (int k2 = 0; k2 < 32; ++k2) s += scr[(k2 * R + r) * 16 + col];
        if (addbias) s += addbias[n0 + col];
        out[(size_t)r * ostride + n0 + col] = s; }
}

__device__ __forceinline__ void phase0a(Frame& F) {
    const float* const* in = F.in;
    float* mods = (float*)(F.ws + CT_MODS);
    {
        const float* c = in[1]; const float* cctx = in[3];
        LAS float* sl = (LAS float*)(F.lds + 65536);
        for (int e = F.tid; e < 5 * DM; e += 512) { const float v = (e < 4 * DM) ? c[e] : cctx[e - 4 * DM]; sl[e] = silu_f(v); }
        __syncthreads();
        auto vf = [&](int r, int k) -> float { return sl[r * DM + k]; };
        const int nitems = 2 * 96;
        for (int it = F.vcu; it < nitems; it += F.G) {
            const int l = it / 96, cg = it % 96;
            gemv_det_item<5>(in[l ? 17 : 4], 6144, cg * 64, mods + l * 5 * 6144, 6144, in[l ? 18 : 5], vf, F.tid, (LAS float*)F.lds);
        }
        __syncthreads();
    }
    for (int e = F.vcu * 512 + F.tid; e < 16384; e += F.G * 512) {
        const int k = e & 8191; const bool isn = e >= 8192;
        float sn, cs; sincospif(isn ? (float)k * (1.0f / 8192.0f) : (float)k * (1.0f / 4096.0f), &sn, &cs);
        cf t; t.x = cs; t.y = -sn;
        ((cf*)(F.ws + (isn ? SM_TWN : SM_TWM)))[k] = t;
    }
    LAS float* scr = (LAS float*)(F.lds + F.wave * 16384);
    const int gw = F.vcu * NWAVES + F.wave, NGW = F.G * NWAVES;
    constexpr int I_QKV = 16 * 96, I_O = 16 * 32, I_UP = 16 * 176, I_DN = 44 * 32;
    constexpr int NITEMS = 2 * I_QKV + 2 * I_O + 2 * I_UP + 2 * I_DN;
    struct CvtD { const float* W; bf16* WT; int K, N, src, dst, k0; };
    auto desc = [&](int it) -> CvtD {
        int r = it; const float* W; bf16* WT; int K, N, perm = 0;
        if (r < I_QKV) { W = in[8]; K = DM; N = 3 * DM; WT = (bf16*)(F.ws + WS_WQKV); perm = 1; }
        else if ((r -= I_QKV) < I_O) { W = in[12]; K = DM; N = DM; WT = (bf16*)(F.ws + WS_WO); }
        else if ((r -= I_O) < I_UP) { W = in[13]; K = DM; N = 2 * FF; WT = (bf16*)(F.ws + WS_WUP0); perm = 2; }
        else if ((r -= I_UP) < I_DN) { W = in[16]; K = FF; N = DM; WT = (bf16*)(F.ws + WS_WDN0); }
        else if ((r -= I_DN) < I_QKV) { W = in[21]; K = DM; N = 3 * DM; WT = (bf16*)(F.ws + WS_WIN); }
        else if ((r -= I_QKV) < I_O) { W = in[34]; K = DM; N = DM; WT = (bf16*)(F.ws + WS_WOUT); }
        else if ((r -= I_O) < I_UP) { W = in[36]; K = DM; N = 2 * FF; WT = (bf16*)(F.ws + WS_WUP1); perm = 2; }
        else { r -= I_UP; W = in[39]; K = FF; N = DM; WT = (bf16*)(F.ws + WS_WDN1); }
        const int nblk = N / 32, kb = r / nblk, nb = r % nblk, dst = 32 * nb;
        const int src = perm == 1 ? qkv_slot_to_col(dst) : (perm == 2 ? up_slot_to_col(dst) : dst);
        return CvtD{W, WT, K, N, src, dst, 64 * kb};
    };
    if (gw < NITEMS) {
        f32x4 xc[8], xn[8];
        CvtD dc = desc(gw);
        transpose_load(dc.W, dc.N, dc.src, dc.k0, F.lane, xc);
        for (int it = gw; it < NITEMS; it += NGW) {
            const CvtD dn = desc(min(it + NGW, NITEMS - 1));
            transpose_load(dn.W, dn.N, dn.src, dn.k0, F.lane, xn);
            transpose_finish(xc, dc.K, dc.WT, dc.dst, dc.k0, scr, F.lane);
#pragma unroll
            for (int i = 0; i < 8; ++i) xc[i] = xn[i];
            dc = dn;
        }
    }
}

__device__ __forceinline__ void row_prescale(const float* xrow, const float* gain, const float* sc, bf16* orow, float* ssq_out, int lane) {
    const GAS f32x4* xr = (const GAS f32x4*)xrow + lane;
    const GAS f32x4* gr = (const GAS f32x4*)gain + lane;
    const GAS f32x4* sr = (const GAS f32x4*)sc + lane;
    f32x4 v[4]; float s = 0.f;
#pragma unroll
    for (int j = 0; j < 4; ++j) { v[j] = xr[64 * j]; s += (v[j].x * v[j].x + v[j].y * v[j].y) + (v[j].z * v[j].z + v[j].w * v[j].w); }
    s = wave_sum(s);
    if (lane == 0) *ssq_out = s;
    GAS unsigned long long* o8 = (GAS unsigned long long*)orow + lane;
#pragma unroll
    for (int j = 0; j < 4; ++j) { const f32x4 g = gr[64 * j], c = sr[64 * j]; const f32x4 w = v[j] * g * (c + 1.0f);
        o8[64 * j] = (unsigned long long)pk2(w.x, w.y) | ((unsigned long long)pk2(w.z, w.w) << 32); }
}
__device__ __forceinline__ void phase0b(Frame& F) {
    const float* const* in = F.in;
    const float* mods = (const float*)(F.ws + CT_MODS);
    const int gw = F.vcu * NWAVES + F.wave, NGW = F.G * NWAVES;
    for (int m = gw; m < TT + TC; m += NGW) {
        if (m < TT) { const int b = m / SEQ; row_prescale(in[0] + (size_t)m * DM, in[6], mods + b * 6144 + 1024, (bf16*)(F.ws + WS_XS) + (size_t)m * DM, (float*)(F.ws + SM_SSQ0) + m, F.lane); }
        else { const int mc = m - TT; row_prescale(in[2] + (size_t)mc * DM, in[6], mods + 4 * 6144 + 1024, (bf16*)(F.ws + WS_XSC) + (size_t)mc * DM, (float*)(F.ws + SM_SSQC) + mc, F.lane); }
    }
    {
        float* gn = (float*)(F.ws + SM_GN);
        for (int e = F.vcu * 512 + F.tid; e < 3 * 4 * 1024; e += F.G * 512) {
            const int i = e / 4096, b = (e / 1024) & 3, k = e & 1023;
            const float* g = in[i == 0 ? 7 : (i == 1 ? 19 : 20)];
            const float sc = mods[(i == 0 ? 0 : 1) * 5 * 6144 + b * 6144 + (i == 1 ? 1024 : 4096) + k];
            gn[e] = g[k] * (1.f + sc);
        }
    }
    {
        LAS float* gs = (LAS float*)F.lds;
        for (int it = F.vcu; it < 192; it += F.G) { auto vf = [&](int r, int k) -> float { return mods[r * 6144 + k]; };
            gemv_det_item16<5>(in[8], 3072, it * 16, (float*)(F.ws + CT_BQKV), 3072, nullptr, vf, F.tid, gs); }
        __syncthreads();
    }
}
__device__ __forceinline__ void bias_gemv_late(Frame& F, int it) {
    const float* const* in = F.in;
    const float* mods = (const float*)(F.ws + CT_MODS);
    const int n_up = 88, n_in = 48;
    LAS float* gs = (LAS float*)F.lds;
    if (it < n_up) { auto vf = [&](int r, int k) -> float { return mods[r * 6144 + 3072 + k]; };
        gemv_det_item<4>(in[13], 5632, it * 64, (float*)(F.ws + CT_BUP0), 5632, nullptr, vf, F.tid, gs); }
    else if (it < n_up + n_in) { it -= n_up; auto vf = [&](int r, int k) -> float { return mods[5 * 6144 + r * 6144 + k]; };
        gemv_det_item<4>(in[21], 3072, it * 64, (float*)(F.ws + CT_BIN), 3072, in[22], vf, F.tid, gs); }
    else if (it < 2 * n_up + n_in) { it -= n_up + n_in; auto vf = [&](int r, int k) -> float { return mods[5 * 6144 + r * 6144 + 3072 + k]; };
        gemv_det_item<4>(in[36], 5632, it * 64, (float*)(F.ws + CT_BUP1), 5632, nullptr, vf, F.tid, gs); }
    __syncthreads();
}

using pg8::f32x4; using pg8::Unit;
__device__ __forceinline__ float row_rs(const float* ssq, int np, int row) {
    float s = 0.f;
    for (int i = 0; i < np; ++i) s += ssq[(size_t)i * TT + row];
    return 1.0f / sqrtf(s * (1.0f / 1024.0f) + EPS);
}
constexpr float QSCALE = 0.125f * 1.4426950408889634f;
template <int PART>
struct EpiQK {
    static constexpr bool PERM = true;
    bf16* dst; const float* ssq; int np; const float* bias; int bias_bstride; const float* gain; int seqlen;
    __device__ __forceinline__ void operator()(const f32x4 (&acc)[2][2][4][2], const Unit& u, int wr, int wc, int fr, int fq) const {
        const int head = 4 * u.pn + wc;
        const int b = (u.pm * 256) / seqlen;
        const float* bp = bias + (size_t)b * bias_bstride + PART * 1024 + head * 64 + 8 * fq;
        const float* gp = gain + 8 * fq;
        const float osc = PART == 0 ? QSCALE : 1.0f;
#pragma unroll
        for (int ai = 0; ai < 2; ++ai)
#pragma unroll
            for (int m = 0; m < 4; ++m) {
                const int row = u.pm * 256 + ai * 128 + wr * 64 + m * 16 + fr;
                const float rs = row_rs(ssq, np, row);
                f32x4 v[2][2]; float ss = 0.f;
#pragma unroll
                for (int bj = 0; bj < 2; ++bj)
#pragma unroll
                    for (int n = 0; n < 2; ++n) { v[bj][n] = acc[ai][bj][m][n] * rs + *(const f32x4*)(bp + 32 * bj + 4 * n); const f32x4 t = v[bj][n]; ss += (t.x * t.x + t.y * t.y) + (t.z * t.z + t.w * t.w); }
                ss += __shfl_xor(ss, 16); ss += __shfl_xor(ss, 32);
                const float rn = osc / sqrtf(ss * (1.0f / 64.0f) + EPS);
                const int tl = row - b * seqlen;
                bf16* rowp = (PART == 0) ? dst + (size_t)row * DM + head * 64 + 8 * fq
                                         : dst + ((((size_t)(b * NH + head) * (seqlen / 16) + (tl >> 4)) * 8 + fq) * 16 + (tl & 15)) * 8;
                constexpr int bjstep = (PART == 0) ? 32 : 4 * 16 * 8;
#pragma unroll
                for (int bj = 0; bj < 2; ++bj) { const f32x4 a0 = v[bj][0] * rn * *(const f32x4*)(gp + 32 * bj), a1 = v[bj][1] * rn * *(const f32x4*)(gp + 32 * bj + 4);
                    v4u w; w.x = pk2(a0.x, a0.y); w.y = pk2(a0.z, a0.w); w.z = pk2(a1.x, a1.y); w.w = pk2(a1.z, a1.w);
                    *(v4u*)(rowp + bjstep * bj) = w; }
                asm volatile("" ::: "memory");
            }
    }
};
struct EpiVT {
    static constexpr bool PERM = true;
    bf16* VTp; const float* ssq; int np; const float* bias; int bias_bstride; int seqlen;
    __device__ __forceinline__ void operator()(const f32x4 (&acc)[2][2][4][2], const Unit& u, int wr, int wc, int fr, int fq) const {
        const int head = 4 * u.pn + wc;
        const int b = (u.pm * 256) / seqlen;
        const float* bp = bias + (size_t)b * bias_bstride + 2048 + head * 64 + 8 * fq;
        const int odd = fr & 1;
        f32x4 bv[2][2];
#pragma unroll
        for (int bj = 0; bj < 2; ++bj)
#pragma unroll
            for (int n = 0; n < 2; ++n) bv[bj][n] = *(const f32x4*)(bp + 32 * bj + 4 * n);
#pragma unroll
        for (int ai = 0; ai < 2; ++ai)
#pragma unroll
            for (int m = 0; m < 4; ++m) {
                const int row = u.pm * 256 + ai * 128 + wr * 64 + m * 16 + fr;
                const float rs = row_rs(ssq, np, row);
                const int tl = row - b * seqlen;
                const int c16 = tl & 14, cpos = (c16 & 3) | ((c16 & 8) >> 1) | ((c16 & 4) << 1);
                bf16* vb = VTp + (((size_t)(b * NH + head) * (seqlen / 16) + (tl >> 4)) * 64 + 8 * fq + odd) * 16 + cpos;
#pragma unroll
                for (int bj = 0; bj < 2; ++bj)
#pragma unroll
                    for (int n = 0; n < 2; ++n) {
                        const f32x4 v = acc[ai][bj][m][n] * rs + bv[bj][n];
                        const unsigned w01 = pk2(v.x, v.y), w23 = pk2(v.z, v.w);
                        const unsigned p01 = (unsigned)__shfl_xor((int)w01, 1), p23 = (unsigned)__shfl_xor((int)w23, 1);
                        const unsigned o0 = odd ? ((w01 & 0xffff0000u) | (p01 >> 16)) : ((p01 << 16) | (w01 & 0xffffu));
                        const unsigned o1 = odd ? ((w23 & 0xffff0000u) | (p23 >> 16)) : ((p23 << 16) | (w23 & 0xffffu));
                        bf16* p = vb + (32 * bj + 4 * n) * 16;
                        *(unsigned*)p = o0; *(unsigned*)(p + 2 * 16) = o1;
                    }
            }
    }
};
template <bool BASE_F32, bool OUT_F32>
struct EpiRes {
    static constexpr bool PERM = true;
    const void* base; void* out; const float* gate; const float* bias; const float* gn; bf16* xs; float* ssq; float* hs;
    __device__ __forceinline__ void operator()(const f32x4 (&acc)[2][2][4][2], const Unit& u, int wr, int wc, int fr, int fq) const {
        const int b = (u.pm * 256) / SEQ;
        const int col0 = u.pn * 256 + wc * 32 + 8 * fq;
        constexpr int MB = BASE_F32 ? 2 : 4;
#pragma unroll
        for (int ai = 0; ai < 2; ++ai)
#pragma unroll
        for (int mb = 0; mb < 4; mb += MB) {
            f32x4 bf[MB][2][2]; v4u bh[MB][2];
#pragma unroll
            for (int mi = 0; mi < MB; ++mi) { const size_t off = (size_t)(u.pm * 256 + ai * 128 + wr * 64 + (mb + mi) * 16 + fr) * DM + col0;
#pragma unroll
                for (int bj = 0; bj < 2; ++bj) {
                    if (BASE_F32) { bf[mi][bj][0] = *(const f32x4*)((const float*)base + off + 128 * bj); bf[mi][bj][1] = *(const f32x4*)((const float*)base + off + 128 * bj + 4); }
                    else bh[mi][bj] = *(const v4u*)((const bf16*)base + off + 128 * bj); } }
#pragma unroll
            for (int mi = 0; mi < MB; ++mi) {
                const int m = mb + mi;
                const int rowl = ai * 128 + wr * 64 + m * 16 + fr;
                const size_t off = (size_t)(u.pm * 256 + rowl) * DM + col0;
                float ss = 0.f;
#pragma unroll
                for (int bj = 0; bj < 2; ++bj) {
                    const int c = col0 + 128 * bj;
                    f32x4 b0, b1;
                    if (BASE_F32) { b0 = bf[mi][bj][0]; b1 = bf[mi][bj][1]; }
                    else { const v4u w = bh[mi][bj]; b0 = (f32x4){bflo(w.x), bfhi(w.x), bflo(w.y), bfhi(w.y)}; b1 = (f32x4){bflo(w.z), bfhi(w.z), bflo(w.w), bfhi(w.w)}; }
                    f32x4 a0 = acc[ai][bj][m][0], a1 = acc[ai][bj][m][1];
                    if (bias) { a0 += *(const f32x4*)(bias + c); a1 += *(const f32x4*)(bias + c + 4); }
                    const f32x4 x0 = b0 + *(const f32x4*)(gate + (size_t)b * 6144 + c) * a0, x1 = b1 + *(const f32x4*)(gate + (size_t)b * 6144 + c + 4) * a1;
                    if (OUT_F32) { *(f32x4*)((float*)out + off + 128 * bj) = x0; *(f32x4*)((float*)out + off + 128 * bj + 4) = x1; }
                    else {
                        v4u w; w.x = pk2(x0.x, x0.y); w.y = pk2(x0.z, x0.w); w.z = pk2(x1.x, x1.y); w.w = pk2(x1.z, x1.w);
                        *(v4u*)((bf16*)out + off + 128 * bj) = w;
                        const f32x4 r0 = (f32x4){bflo(w.x), bfhi(w.x), bflo(w.y), bfhi(w.y)}, r1 = (f32x4){bflo(w.z), bfhi(w.z), bflo(w.w), bfhi(w.w)};
                        ss += (r0.x * r0.x + r0.y * r0.y) + (r0.z * r0.z + r0.w * r0.w) + (r1.x * r1.x + r1.y * r1.y) + (r1.z * r1.z + r1.w * r1.w);
                        const f32x4 q0 = r0 * *(const f32x4*)(gn + (size_t)b * 1024 + c), q1 = r1 * *(const f32x4*)(gn + (size_t)b * 1024 + c + 4);
                        v4u ws2; ws2.x = pk2(q0.x, q0.y); ws2.y = pk2(q0.z, q0.w); ws2.z = pk2(q1.x, q1.y); ws2.w = pk2(q1.z, q1.w);
                        *(v4u*)(xs + off + 128 * bj) = ws2;
                    }
                }
                if (!OUT_F32) { ss += __shfl_xor(ss, 16); ss += __shfl_xor(ss, 32); if (fq == 0) hs[rowl * 4 + wc] = ss; }
            }
            asm volatile("" ::: "memory");
        }
        if (!OUT_F32) {
            asm volatile("s_waitcnt lgkmcnt(0)" ::: "memory"); __builtin_amdgcn_s_barrier(); asm volatile("" ::: "memory");
            const int tid = threadIdx.x;
            if (tid < 256) { const f32x4 p = *(const f32x4*)(hs + tid * 4); ssq[(size_t)u.pn * TT + u.pm * 256 + tid] = ((p.x + p.y) + p.z) + p.w; }
        }
    }
};
struct EpiScaleBias {
    static constexpr bool PERM = true;
    bf16* O; int ldc; const float* ssq; int np; const float* bias; int bias_bstride;
    __device__ __forceinline__ void operator()(const f32x4 (&acc)[2][2][4][2], const Unit& u, int wr, int wc, int fr, int fq) const {
        const int b = (u.pm * 256) / SEQ;
        const int col0 = u.pn * 256 + wc * 32 + 8 * fq;
        f32x4 bv[2][2];
#pragma unroll
        for (int bj = 0; bj < 2; ++bj)
#pragma unroll
            for (int n = 0; n < 2; ++n) bv[bj][n] = *(const f32x4*)(bias + (size_t)b * bias_bstride + col0 + 128 * bj + 4 * n);
#pragma unroll
        for (int ai = 0; ai < 2; ++ai)
#pragma unroll
            for (int m = 0; m < 4; ++m) {
                const int row = u.pm * 256 + ai * 128 + wr * 64 + m * 16 + fr;
                const float rs = row_rs(ssq, np, row);
                bf16* rowp = O + (size_t)row * ldc + col0;
#pragma unroll
                for (int bj = 0; bj < 2; ++bj) { const f32x4 v0 = acc[ai][bj][m][0] * rs + bv[bj][0], v1 = acc[ai][bj][m][1] * rs + bv[bj][1];
                    v4u w; w.x = pk2(v0.x, v0.y); w.y = pk2(v0.z, v0.w); w.z = pk2(v1.x, v1.y); w.w = pk2(v1.z, v1.w);
                    *(v4u*)(rowp + 128 * bj) = w; }
            }
    }
};
__device__ __forceinline__ float gelu_as(float v) {
    const float av = fabsf(v), t = __builtin_amdgcn_rcpf(av * 0.2316418882f + 1.0f);
    float q = t * 0.5307027145f + (-0.7265760135f); q = q * t + 0.7107068705f; q = q * t + (-0.142248368f); q = q * t + 0.127414796f; q = q * t;
    const float e = __builtin_amdgcn_exp2f((v * v) * (-0.72134752044f));
    return __builtin_fmaf(-av, q * e, __builtin_fmaxf(v, 0.f));
}
template <int CTRL> __device__ __forceinline__ float dpp_f(float old, float src) {
    return __builtin_bit_cast(float, __builtin_amdgcn_update_dpp(__builtin_bit_cast(int, old), __builtin_bit_cast(int, src), CTRL, 0xf, 0xf, false));
}
struct EpiUpGlu {
    static constexpr bool PERM = true;
    bf16* act; const float* ssq; int np; const float* bias; const float* cw; const float* cb; float* Hg; float* Ha; float* hl;
    __device__ __forceinline__ void prefetch(const Unit& u) const {
        int tid = threadIdx.x; asm volatile("" : "+v"(tid));
        const int wv = __builtin_amdgcn_readfirstlane(tid >> 6), ln = tid & 63;
        if (wv < 7) {
            const int b = (u.pm * 256) / SEQ, hf = ln >> 5, c4 = u.pn * 128 + (ln & 31) * 4;
            const float* src;
            if (wv == 0) src = bias + (size_t)b * 5632 + hf * FF + c4;
            else if (wv == 1) src = cw + hf * FF + c4;
            else if (wv == 2) src = (hf ? cb : cw + 2 * FF) + c4;
            else src = ssq + (size_t)(wv - 3) * TT + u.pm * 256 + ln * 4;
            __builtin_amdgcn_global_load_lds((const unsigned*)src, (LAS unsigned*)((unsigned char*)hl + (CB_LDS_OFF - RING_BYTES) + wv * 1024), 16, 0, 0);
        }
    }
    __device__ __forceinline__ void operator()(f32x4 (&acc)[2][2][4][2], const Unit& u, int wr, int wc, int fr_, int fq_) const {
        int ln_ = threadIdx.x & 63; asm volatile("" : "+v"(ln_));
        const int fr = ln_ & 15, fq = ln_ >> 4;
        const int j0 = u.pn * 128 + wc * 32 + 8 * fq;
        const float* ct = (const float*)((const unsigned char*)hl + (CB_LDS_OFF - RING_BYTES));
        const int jl = wc * 32 + 8 * fq;
        {
            f32x4 ba[2], bg[2];
#pragma unroll
            for (int n = 0; n < 2; ++n) { ba[n] = *(const f32x4*)(ct + jl + 4 * n); bg[n] = *(const f32x4*)(ct + 128 + jl + 4 * n); }
#pragma unroll
            for (int ai = 0; ai < 2; ++ai)
#pragma unroll
                for (int m = 0; m < 4; ++m) { const int rl_ = ai * 128 + wr * 64 + m * 16 + fr;
                    const float rs = 1.0f / sqrtf((((ct[768 + rl_] + ct[1024 + rl_]) + ct[1280 + rl_]) + ct[1536 + rl_]) * (1.0f / 1024.0f) + EPS);
#pragma unroll
                    for (int n = 0; n < 2; ++n) { acc[ai][0][m][n] = acc[ai][0][m][n] * rs + ba[n]; acc[ai][1][m][n] = acc[ai][1][m][n] * rs + bg[n]; }
                    if (m == 3) asm volatile("" ::: "memory"); }
        }
#pragma unroll
        for (int ai = 0; ai < 2; ++ai) { float* hp = hl + ((2 * ai + wr) * 2) * 128 + wc * 32 + 8 * fq;
            if (fr == 0) { *(f32x4*)(hp) = acc[ai][1][0][0]; *(f32x4*)(hp + 4) = acc[ai][1][0][1]; }
            if (fr == 15) { *(f32x4*)(hp + 128) = acc[ai][1][3][0]; *(f32x4*)(hp + 132) = acc[ai][1][3][1]; } }
        asm volatile("s_waitcnt lgkmcnt(0)" ::: "memory"); __builtin_amdgcn_s_barrier(); asm volatile("" ::: "memory");
        if (wr == 0 && fr < 2) { float* p = Hg + ((size_t)u.pm * 4 + fr) * FF + j0; *(f32x4*)p = acc[0][1][0][0]; *(f32x4*)(p + 4) = acc[0][1][0][1];
            if (fr == 0) { float* q = Ha + ((size_t)u.pm * 2) * FF + j0; *(f32x4*)q = acc[0][0][0][0]; *(f32x4*)(q + 4) = acc[0][0][0][1]; } }
        if (wr == 1 && fr >= 14) { float* p = Hg + ((size_t)u.pm * 4 + 2 + (fr - 14)) * FF + j0; *(f32x4*)p = acc[1][1][3][0]; *(f32x4*)(p + 4) = acc[1][1][3][1];
            if (fr == 15) { float* q = Ha + ((size_t)u.pm * 2 + 1) * FF + j0; *(f32x4*)q = acc[1][0][3][0]; *(f32x4*)(q + 4) = acc[1][0][3][1]; } }
#pragma unroll
        for (int n = 0; n < 2; ++n) {
            const f32x4 w0 = *(const f32x4*)(ct + 256 + jl + 4 * n), w1 = *(const f32x4*)(ct + 384 + jl + 4 * n), w2 = *(const f32x4*)(ct + 512 + jl + 4 * n), cbv = *(const f32x4*)(ct + 640 + jl + 4 * n);
#pragma unroll
            for (int ai = 0; ai < 2; ++ai) {
                const int gi = 2 * ai + wr;
                const f32x4 uph = *(const f32x4*)(hl + (((gi + 3) & 3) * 2 + 1) * 128 + wc * 32 + 8 * fq + 4 * n);
                const f32x4 dnh = *(const f32x4*)(hl + (((gi + 1) & 3) * 2) * 128 + wc * 32 + 8 * fq + 4 * n);
#pragma unroll
                for (int m = 0; m < 4; ++m) {
                    const int rowl = ai * 128 + wr * 64 + m * 16 + fr;
                    f32x4 r;
#pragma unroll
                    for (int e = 0; e < 4; ++e) {
                        const float g = acc[ai][1][m][n][e];
                        const float pu = (m > 0) ? dpp_f<0x121>(g, acc[ai][1][m > 0 ? m - 1 : 0][n][e]) : uph[e];
                        const float up = dpp_f<0x111>(pu, g);
                        const float pd = (m < 3) ? dpp_f<0x12f>(g, acc[ai][1][m < 3 ? m + 1 : 3][n][e]) : dnh[e];
                        const float dn = dpp_f<0x101>(pd, g);
                        const float cv = w0[e] * up + w1[e] * g + w2[e] * dn + cbv[e];
                        r[e] = acc[ai][0][m][n][e] * gelu_as(cv);
                    }
                    if (rowl != 0 && rowl != 255) { v2u w; w.x = pk2(r.x, r.y); w.y = pk2(r.z, r.w); *(v2u*)(act + (size_t)(u.pm * 256 + rowl) * FF + j0 + 4 * n) = w; }
                }
            }
        }
        asm volatile("s_waitcnt lgkmcnt(0)" ::: "memory"); __builtin_amdgcn_s_barrier(); asm volatile("" ::: "memory");
    }
};
__device__ __forceinline__ void glu_fix_tile(Frame& F, int pm, const float* cw, const float* cb) {
    const float* Hg = (const float*)(F.ws + WS_HG); const float* Ha = (const float*)(F.ws + WS_HA); bf16* act = (bf16*)(F.ws + WS_AG);
#pragma unroll 1
    for (int it = 0; it < 3; ++it) {
        const int e = F.tid + 512 * it;
        if (e < 2 * (FF / 4)) {
            const int which = e >= FF / 4 ? 1 : 0, j = (e - which * (FF / 4)) * 4;
            const int t = pm * 256 + (which ? 255 : 0), tl = t % SEQ;
            const int rm = which ? pm * 4 + 2 : max(pm - 1, 0) * 4 + 3, r0 = pm * 4 + (which ? 3 : 0), rp = which ? min(pm + 1, TT / 256 - 1) * 4 : pm * 4 + 1;
            f32x4 gm = *(const f32x4*)(Hg + (size_t)rm * FF + j), gp = *(const f32x4*)(Hg + (size_t)rp * FF + j);
            const f32x4 g0 = *(const f32x4*)(Hg + (size_t)r0 * FF + j), a = *(const f32x4*)(Ha + ((size_t)pm * 2 + which) * FF + j);
            const f32x4 w0 = *(const f32x4*)(cw + j), w1 = *(const f32x4*)(cw + FF + j), w2 = *(const f32x4*)(cw + 2 * FF + j), cbv = *(const f32x4*)(cb + j);
            if (!which && tl == 0) gm = (f32x4){0.f, 0.f, 0.f, 0.f};
            if (which && tl == SEQ - 1) gp = (f32x4){0.f, 0.f, 0.f, 0.f};
            const f32x4 cv = w0 * gm + w1 * g0 + w2 * gp + cbv;
            v2u w; w.x = pk2(a.x * gelu_as(cv.x), a.y * gelu_as(cv.y)); w.y = pk2(a.z * gelu_as(cv.z), a.w * gelu_as(cv.w));
            *(v2u*)(act + (size_t)t * FF + j) = w;
        }
    }
}
__device__ __forceinline__ void glu_fix_phase(Frame& F, const float* cw, const float* cb) {
    const float* Hg = (const float*)(F.ws + WS_HG); const float* Ha = (const float*)(F.ws + WS_HA); bf16* act = (bf16*)(F.ws + WS_AG);
    const int total = (TT / 256) * 2 * FF;
    for (int e = F.vcu * 512 + F.tid; e < total; e += F.G * 512) {
        const int j = e % FF, which = (e / FF) & 1, pm = e / (2 * FF);
        const int t = pm * 256 + (which ? 255 : 0), tl = t % SEQ;
        float gm, g0, gp;
        if (which == 0) { gm = (tl == 0) ? 0.f : Hg[((size_t)(pm - 1) * 4 + 3) * FF + j]; g0 = Hg[((size_t)pm * 4 + 0) * FF + j]; gp = Hg[((size_t)pm * 4 + 1) * FF + j]; }
        else { gm = Hg[((size_t)pm * 4 + 2) * FF + j]; g0 = Hg[((size_t)pm * 4 + 3) * FF + j]; gp = (tl == SEQ - 1) ? 0.f : Hg[((size_t)(pm + 1) * 4 + 0) * FF + j]; }
        const float a = Ha[((size_t)pm * 2 + which) * FF + j];
        const float cv = cw[j] * gm + cw[FF + j] * g0 + cw[2 * FF + j] * gp + cb[j];
        act[(size_t)t * FF + j] = (bf16)f2bf(a * gelu_as(cv));
    }
}
struct EpiNull {
    static constexpr bool PERM = true;
    float* sink;
    __device__ __forceinline__ void operator()(const f32x4 (&acc)[2][2][4][2], const Unit& u, int wr, int wc, int fr, int fq) const {
        f32x4 s = {0.f, 0.f, 0.f, 0.f};
#pragma unroll
        for (int ai = 0; ai < 2; ++ai)
#pragma unroll
            for (int bj = 0; bj < 2; ++bj)
#pragma unroll
                for (int m = 0; m < 4; ++m)
#pragma unroll
                    for (int n = 0; n < 2; ++n) s += acc[ai][bj][m][n];
        if (u.pm == 100000) *(f32x4*)(sink + fr) = s;
    }
};
struct EpiInT {
    static constexpr bool PERM = true;
    bf16* UT; const float* ssq; int np; const float* bias;
    __device__ __forceinline__ void operator()(const f32x4 (&acc)[2][2][4][2], const Unit& u, int wr, int wc, int fr, int fq) const {
        const int b = (u.pm * 256) / SEQ;
        const int col0 = u.pn * 256 + wc * 32 + 8 * fq;
        const int odd = fr & 1;
        f32x4 bv[2][2];
#pragma unroll
        for (int bj = 0; bj < 2; ++bj)
#pragma unroll
            for (int n = 0; n < 2; ++n) bv[bj][n] = *(const f32x4*)(bias + (size_t)b * 3072 + col0 + 128 * bj + 4 * n);
#pragma unroll
        for (int ai = 0; ai < 2; ++ai)
#pragma unroll
            for (int m = 0; m < 4; ++m) {
                const int row = u.pm * 256 + ai * 128 + wr * 64 + m * 16 + fr;
                const int t = row - b * SEQ;
                const float rs = row_rs(ssq, np, row);
#pragma unroll
                for (int bj = 0; bj < 2; ++bj)
#pragma unroll
                    for (int n = 0; n < 2; ++n) { const f32x4 v = acc[ai][bj][m][n] * rs + bv[bj][n];
                        const unsigned w01 = pk2(v.x, v.y), w23 = pk2(v.z, v.w);
                        const unsigned p01 = (unsigned)__shfl_xor((int)w01, 1), p23 = (unsigned)__shfl_xor((int)w23, 1);
                        const unsigned o0 = odd ? ((w01 & 0xffff0000u) | (p01 >> 16)) : ((p01 << 16) | (w01 & 0xffffu));
                        const unsigned o1 = odd ? ((w23 & 0xffff0000u) | (p23 >> 16)) : ((p23 << 16) | (w23 & 0xffffu));
                        bf16* p = UT + ((size_t)b * 3072 + col0 + 128 * bj + 4 * n + odd) * SEQ + (t & ~1);
                        *(unsigned*)p = o0; *(unsigned*)(p + 2 * (size_t)SEQ) = o1; }
            }
    }
};

struct EpiCtxKV {
    static constexpr bool PERM = true;
    EpiQK<1> ek; EpiVT ev;
    __device__ __forceinline__ void operator()(const f32x4 (&acc)[2][2][4][2], const Unit& u, int wr, int wc, int fr, int fq) const {
        if (u.pn < 4) ek(acc, u, wr, wc, fr, fq);
        else { Unit v = u; v.pn = u.pn - 4; ev(acc, v, wr, wc, fr, fq); }
    }
};

typedef short bf16x8 __attribute__((ext_vector_type(8)));
typedef float f32x16 __attribute__((ext_vector_type(16)));
typedef short s16x4 __attribute__((ext_vector_type(4)));
__device__ __forceinline__ unsigned cvtpk(float lo, float hi) { typedef float f2 __attribute__((ext_vector_type(2))); typedef __bf16 b2 __attribute__((ext_vector_type(2)));
    f2 v = {lo, hi}; b2 r = __builtin_convertvector(v, b2); return __builtin_bit_cast(unsigned, r); }
constexpr int BT_OFF = 64, BT_HEAD = 15 * 31;
__device__ __forceinline__ void attn_mfma_phase(Frame& F) {
    const bf16* Q = (const bf16*)(F.ws + WS_Q); const bf16* Kb = (const bf16*)(F.ws + WS_K); const bf16* VT = (const bf16*)(F.ws + WS_V);
    const bf16* Kc = (const bf16*)(F.ws + WS_KC); const bf16* VcT = (const bf16*)(F.ws + WS_VC);
    bf16* O = (bf16*)(F.ws + WS_O);
    const float* rpb = F.in[11];
    constexpr int AL_KC = 15 * 8192, AL_BT = AL_KC + 32768;
    const unsigned char* lk = (const unsigned char*)F.lds;
    float* bt = (float*)(F.lds + AL_BT);
    int th = -1;
    const int lane = F.lane, q = lane & 31, hi = lane >> 5;
    for (int g = F.vcu; g < NB * (GROWS / 8) * NH; g += F.G) {
        const int rg = g & 15, h = (g >> 4) & 15, b = g >> 8;
        const int r = rg * 8 + F.wave;
        const int r0 = min(max(r - WH / 2, 0), GROWS - WH);
        const int U0 = min(max(rg * 8 - WH / 2, 0), GROWS - WH), Ue = min(max(rg * 8 + 7 - WH / 2, 0), GROWS - WH) + WH;
        __syncthreads();
        if (h != th) { for (int e = F.tid; e < BT_HEAD; e += 512) bt[BT_OFF + e] = rpb[h * BT_HEAD + e] * 1.4426950408889634f; th = h; }
        {
            int tv = F.tid; FC_OPAQUE(tv);
            const bf16* ksrc = Kb + ((size_t)(b * NH + h) * (SEQ / 16) + (size_t)U0 * 4) * (8 * 16 * 8) + tv * 8;
            const bf16* csrc = Kc + ((size_t)(b * NH + h) * (CTXL / 16)) * (8 * 16 * 8) + tv * 8;
            const int nrow = Ue - U0;
#pragma unroll 1
            for (int rr0 = 0; rr0 < nrow + 4; rr0 += 4) {
                v4u x[4];
#pragma unroll
                for (int k = 0; k < 4; ++k) { const int rr = rr0 + k; if (rr < nrow + 4) x[k] = (rr < nrow) ? *(const v4u*)(ksrc + (size_t)rr * 4096) : *(const v4u*)(csrc + (size_t)(rr - nrow) * 4096); }
#pragma unroll
                for (int k = 0; k < 4; ++k) { const int rr = rr0 + k; if (rr < nrow + 4) *(v4u*)(F.lds + (rr < nrow ? rr * 8192 : AL_KC + (rr - nrow) * 8192) + tv * 16) = x[k]; }
            }
            asm volatile("" ::: "memory");
        }
        __syncthreads();
        const size_t tok = (size_t)b * SEQ + r * GW + q;
        bf16x8 qf[2][4];
#pragma unroll
        for (int hf = 0; hf < 2; ++hf)
#pragma unroll
            for (int s4 = 0; s4 < 4; ++s4) qf[hf][s4] = *(const bf16x8*)(Q + (tok + 32 * hf) * DM + h * HD + 16 * s4 + 8 * hi);
        const f32x16 zero16 = {0.f, 0.f, 0.f, 0.f, 0.f, 0.f, 0.f, 0.f, 0.f, 0.f, 0.f, 0.f, 0.f, 0.f, 0.f, 0.f};
        f32x16 o[2][2] = {{zero16, zero16}, {zero16, zero16}};
        float lsum[2] = {0.f, 0.f};
#define ATT_LOAD(i, kf, va) do { \
            const bf16* kp_; const bf16* vp_; int sstr_; \
            if ((i) < 16) { const int rp_ = (i) >> 2, cb_ = (i) & 3, krow_ = r0 + 2 * rp_; \
                kp_ = (const bf16*)(lk + (krow_ + (q >> 4) - U0) * 8192 + cb_ * 2048 + hi * 256 + (q & 15) * 16); \
                vp_ = VT + (((size_t)(b * NH + h) * (SEQ / 16) + krow_ * 4 + cb_) * 64 + q) * 16 + 8 * hi; sstr_ = 4 * 64 * 16; } \
            else { const int j_ = (i) - 16; \
                kp_ = (const bf16*)(lk + AL_KC + (2 * j_ + (q >> 4)) * 2048 + hi * 256 + (q & 15) * 16); \
                vp_ = VcT + (((size_t)(b * NH + h) * (CTXL / 16) + 2 * j_) * 64 + q) * 16 + 8 * hi; sstr_ = 64 * 16; } \
            _Pragma("unroll") for (int s4 = 0; s4 < 4; ++s4) kf[s4] = *(const bf16x8*)(kp_ + s4 * (2 * 16 * 8)); \
            _Pragma("unroll") for (int dh = 0; dh < 2; ++dh) _Pragma("unroll") for (int s2 = 0; s2 < 2; ++s2) { const bf16* v_ = vp_ + dh * (32 * 16) + s2 * sstr_; \
                va[dh][s2] = *(const bf16x8*)v_; } } while (0)
#define ATT_HALF(i, kf, va, HF) do { \
            f32x16 sacc = zero16; \
            _Pragma("unroll") for (int s4 = 0; s4 < 4; ++s4) sacc = __builtin_amdgcn_mfma_f32_32x32x16_bf16(kf[s4], qf[HF][s4], sacc, 0, 0, 0); \
            float p[16]; \
            if ((i) < 16) { const int rp_ = (i) >> 2, cb_ = (i) & 3, krow_ = r0 + 2 * rp_; \
                const int c_ = 32 * HF + q, c0_ = min(max(c_ - WW / 2, 0), GW - WW), lo_ = c0_ - c_ + (WW - 1); \
                const int dcb = cb_ * 16 + 4 * hi - c_ + (WW - 1), dcl = dcb - lo_; \
                const float* btp = bt + BT_OFF + (krow_ - r + (WH - 1)) * 31 + dcb; \
                _Pragma("unroll") for (int rr = 0; rr < 16; ++rr) { const int kc = (rr & 3) + 8 * ((rr >> 2) & 1); \
                    const float e_ = __builtin_amdgcn_exp2f(sacc[rr] + btp[(rr >> 3) * 31 + kc]); \
                    p[rr] = ((unsigned)(dcl + kc) < (unsigned)WW) ? e_ : 0.f; lsum[HF] += p[rr]; } } \
            else { _Pragma("unroll") for (int rr = 0; rr < 16; ++rr) { p[rr] = __builtin_amdgcn_exp2f(sacc[rr]); lsum[HF] += p[rr]; } } \
            unsigned pw[8]; \
            _Pragma("unroll") for (int ii = 0; ii < 8; ++ii) pw[ii] = cvtpk(p[2 * ii], p[2 * ii + 1]); \
            _Pragma("unroll") for (int s2 = 0; s2 < 2; ++s2) { \
                const bf16x8 pb = __builtin_bit_cast(bf16x8, (v4u){pw[4 * s2], pw[4 * s2 + 1], pw[4 * s2 + 2], pw[4 * s2 + 3]}); \
                o[HF][0] = __builtin_amdgcn_mfma_f32_32x32x16_bf16(va[0][s2], pb, o[HF][0], 0, 0, 0); \
                o[HF][1] = __builtin_amdgcn_mfma_f32_32x32x16_bf16(va[1][s2], pb, o[HF][1], 0, 0, 0); } } while (0)
#define ATT_COMPUTE(i, kf, va) do { const int cbq_ = ((i) < 16) ? ((i) & 3) : 1; \
            if (cbq_ != 3) ATT_HALF(i, kf, va, 0); \
            if (cbq_ != 0) ATT_HALF(i, kf, va, 1); } while (0)
        bf16x8 kfA[4], kfB[4], vaA[2][2], vaB[2][2];
        ATT_LOAD(0, kfA, vaA);
#pragma unroll 1
        for (int i = 0; i < 24; i += 2) {
            ATT_LOAD(i + 1, kfB, vaB);
            ATT_COMPUTE(i, kfA, vaA);
            { const int i2 = (i + 2 < 24) ? i + 2 : 23; ATT_LOAD(i2, kfA, vaA); }
            ATT_COMPUTE(i + 1, kfB, vaB);
        }
#undef ATT_LOAD
#undef ATT_HALF
#undef ATT_COMPUTE
#pragma unroll
        for (int hf = 0; hf < 2; ++hf) {
            float l = lsum[hf]; l += __shfl_xor(l, 32);
            const float inv = 1.0f / l;
            bf16* op = O + (tok + 32 * hf) * DM + h * HD + 4 * hi;
#pragma unroll
            for (int gq = 0; gq < 4; ++gq) {
                v2u w0; w0.x = pk2(o[hf][0][4 * gq] * inv, o[hf][0][4 * gq + 1] * inv); w0.y = pk2(o[hf][0][4 * gq + 2] * inv, o[hf][0][4 * gq + 3] * inv);
                v2u w1; w1.x = pk2(o[hf][1][4 * gq] * inv, o[hf][1][4 * gq + 1] * inv); w1.y = pk2(o[hf][1][4 * gq + 2] * inv, o[hf][1][4 * gq + 3] * inv);
                *(v2u*)(op + 8 * gq) = w0; *(v2u*)(op + 32 + 8 * gq) = w1;
            }
        }
    }
    __syncthreads();
}

__device__ __forceinline__ void convglu_phase(Frame& F, const float* cw, const float* cb) {
    bf16* ag = (bf16*)(F.ws + WS_AG);
    const long nvec = (long)TT * (FF / 8);
    for (long e = (long)F.vcu * 512 + F.tid; e < nvec; e += (long)F.G * 512) {
        const int t = (int)(e / (FF / 8)), j0 = (int)(e % (FF / 8)) * 8;
        const int tl = t % SEQ;
        const bf16* rowp = ag + (size_t)t * (2 * FF);
        const v4u a = *(const v4u*)(rowp + j0);
        const v4u g0 = *(const v4u*)(rowp + FF + j0);
        v4u gm = (v4u){0u, 0u, 0u, 0u}, gp = (v4u){0u, 0u, 0u, 0u};
        if (tl > 0) gm = *(const v4u*)(rowp - 2 * FF + FF + j0);
        if (tl < SEQ - 1) gp = *(const v4u*)(rowp + 2 * FF + FF + j0);
        float av[8], g0v[8], gmv[8], gpv[8];
        av[0] = bflo(a.x); av[1] = bfhi(a.x); av[2] = bflo(a.y); av[3] = bfhi(a.y); av[4] = bflo(a.z); av[5] = bfhi(a.z); av[6] = bflo(a.w); av[7] = bfhi(a.w);
        g0v[0] = bflo(g0.x); g0v[1] = bfhi(g0.x); g0v[2] = bflo(g0.y); g0v[3] = bfhi(g0.y); g0v[4] = bflo(g0.z); g0v[5] = bfhi(g0.z); g0v[6] = bflo(g0.w); g0v[7] = bfhi(g0.w);
        gmv[0] = bflo(gm.x); gmv[1] = bfhi(gm.x); gmv[2] = bflo(gm.y); gmv[3] = bfhi(gm.y); gmv[4] = bflo(gm.z); gmv[5] = bfhi(gm.z); gmv[6] = bflo(gm.w); gmv[7] = bfhi(gm.w);
        gpv[0] = bflo(gp.x); gpv[1] = bfhi(gp.x); gpv[2] = bflo(gp.y); gpv[3] = bfhi(gp.y); gpv[4] = bflo(gp.z); gpv[5] = bfhi(gp.z); gpv[6] = bflo(gp.w); gpv[7] = bfhi(gp.w);
        float r[8];
#pragma unroll
        for (int i = 0; i < 8; ++i) { const int j = j0 + i; const float cv = cw[j] * gmv[i] + cw[FF + j] * g0v[i] + cw[2 * FF + j] * gpv[i] + cb[j]; r[i] = av[i] * gelu_f(cv); }
        v4u w; w.x = pk2(r[0], r[1]); w.y = pk2(r[2], r[3]); w.z = pk2(r[4], r[5]); w.w = pk2(r[6], r[7]);
        *(v4u*)(ag + (size_t)t * (2 * FF) + j0) = w;
    }
}

__device__ __forceinline__ void filtgen_phase(Frame& F) {
    const float* const* in = F.in;
    const float *w1 = in[25], *b1 = in[26], *w2 = in[27], *b2 = in[28], *w3 = in[29], *b3 = in[30], *freq = in[32];
    const float* __restrict__ wout = in[31];
    float* __restrict__ hT = (float*)(F.ws + WS_HT); float* __restrict__ fsqp = (float*)(F.ws + WS_FSQP);
    LAS float* zf = (LAS float*)(F.lds);
    LAS float* ha = zf + 32 * 36;
    LAS float* hb = ha + 32 * 64;
    const int tid = F.tid;
    for (int item = F.vcu; item < SEQ / 32; item += F.G) {
        const int l0 = item * 32;
        const float bj1 = b1[tid & 63], bj2 = b2[tid & 63], bj3 = b3[tid & 63], fj = freq[tid & 63];
        __syncthreads();
        for (int e = tid; e < 32 * 33; e += 512) {
            const int p = e / 33, i = e % 33, l = l0 + p;
            float v;
            if (i == 0) v = (float)l / 8191.0f;
            else { const int bi = (i - 1) & 15; const float band = 1e-4f + (float)bi * ((15.0f - 1e-4f) / 15.0f);
                const float w = (float)(2.0 * 3.14159265358979323846 / 8192.0) * (float)l; const float arg = band * w;
                v = (i <= 16) ? cosf(arg) : -sinf(arg); }
            zf[p * 36 + i] = v;
        }
        __syncthreads();
        { const int j = tid & 63, p = tid >> 6; float a[4] = {bj1, bj1, bj1, bj1};
#pragma unroll 11
          for (int i = 0; i < 33; ++i) { const float w = w1[i * 64 + j];
#pragma unroll
            for (int k = 0; k < 4; ++k) a[k] += zf[(p + 8 * k) * 36 + i] * w; }
#pragma unroll
          for (int k = 0; k < 4; ++k) ha[(p + 8 * k) * 64 + j] = sinf(fj * a[k]); }
        __syncthreads();
        { const int j = tid & 63, p = tid >> 6; float a[4] = {bj2, bj2, bj2, bj2};
#pragma unroll 16
          for (int i = 0; i < 64; ++i) { const float w = w2[i * 64 + j];
#pragma unroll
            for (int k = 0; k < 4; ++k) a[k] += ha[(p + 8 * k) * 64 + i] * w; }
#pragma unroll
          for (int k = 0; k < 4; ++k) hb[(p + 8 * k) * 64 + j] = sinf(fj * a[k]); }
        __syncthreads();
        { const int j = tid & 63, p = tid >> 6; float a[4] = {bj3, bj3, bj3, bj3};
#pragma unroll 16
          for (int i = 0; i < 64; ++i) { const float w = w3[i * 64 + j];
#pragma unroll
            for (int k = 0; k < 4; ++k) a[k] += hb[(p + 8 * k) * 64 + i] * w; }
#pragma unroll
          for (int k = 0; k < 4; ++k) ha[(p + 8 * k) * 64 + j] = sinf(fj * a[k]); }
        __syncthreads();
        {
            const int lane = F.lane, li = lane & 15, lk = lane >> 4;
            pg8::bf16x8 afr[2][2];
#pragma unroll
            for (int mt = 0; mt < 2; ++mt)
#pragma unroll
                for (int ks = 0; ks < 2; ++ks) { const LAS float* hp = ha + (16 * mt + li) * 64 + 32 * ks + 8 * lk;
                    v4u w; w.x = pk2(hp[0], hp[1]); w.y = pk2(hp[2], hp[3]); w.z = pk2(hp[4], hp[5]); w.w = pk2(hp[6], hp[7]);
                    afr[mt][ks] = __builtin_bit_cast(pg8::bf16x8, w); }
            const float la = -15.350567286626973f, lb = -3.0701134573253946f;
#pragma unroll 1
            for (int nt = 0; nt < 16; nt += 2) {
                const int n0 = F.wave * 256 + nt * 16 + li;
                const float* wp = wout + (size_t)(8 * lk) * 2048 + n0;
                float bv[2][2][8];
#pragma unroll
                for (int ks = 0; ks < 2; ++ks)
#pragma unroll
                    for (int j = 0; j < 8; ++j) { bv[0][ks][j] = wp[(size_t)(32 * ks + j) * 2048]; bv[1][ks][j] = wp[(size_t)(32 * ks + j) * 2048 + 16]; }
                f32x4 acc[2][2];
#pragma unroll
                for (int t2 = 0; t2 < 2; ++t2) { acc[t2][0] = (f32x4){0.f, 0.f, 0.f, 0.f}; acc[t2][1] = acc[t2][0]; }
#pragma unroll
                for (int t2 = 0; t2 < 2; ++t2)
#pragma unroll
                    for (int ks = 0; ks < 2; ++ks) {
                        v4u w; w.x = pk2(bv[t2][ks][0], bv[t2][ks][1]); w.y = pk2(bv[t2][ks][2], bv[t2][ks][3]); w.z = pk2(bv[t2][ks][4], bv[t2][ks][5]); w.w = pk2(bv[t2][ks][6], bv[t2][ks][7]);
                        const pg8::bf16x8 bfr = __builtin_bit_cast(pg8::bf16x8, w);
                        acc[t2][0] = __builtin_amdgcn_mfma_f32_16x16x32_bf16(afr[0][ks], bfr, acc[t2][0], 0, 0, 0);
                        acc[t2][1] = __builtin_amdgcn_mfma_f32_16x16x32_bf16(afr[1][ks], bfr, acc[t2][1], 0, 0, 0);
                    }
#pragma unroll
                for (int t2 = 0; t2 < 2; ++t2) {
                    const int n = n0 + 16 * t2;
                    const int dir = n >> 10, c = n & 1023;
                    const float delta = fabsf(la + (float)c * ((lb - la) / 1023.0f)) * 1.4426950408889634f;
                    float sq = 0.f;
#pragma unroll
                    for (int mt = 0; mt < 2; ++mt) { f32x4 ov; const f32x4 ac = acc[t2][mt];
#pragma unroll
                        for (int r = 0; r < 4; ++r) { const float tpos = (float)(l0 + 16 * mt + 4 * lk + r) / 8191.0f; const float v = ac[r] * __builtin_amdgcn_exp2f(-tpos * delta); ov[r] = v; sq += v * v; }
                        *(f32x4*)(hT + ((size_t)dir * 1024 + c) * SEQ + l0 + 16 * mt + 4 * lk) = ov; }
                    sq += __shfl_xor(sq, 16); sq += __shfl_xor(sq, 32);
                    if (lk == 0) fsqp[(size_t)item * 2048 + n] = sq;
                }
            }
        }
    }
    __syncthreads();
}

constexpr int F2_AO = 67584, F2_TW = 135168, F2_RED = 140 * 1024, F2_PF = 144 * 1024, F2_TN = 146 * 1024;
__device__ __forceinline__ void f2_load_tw(Frame& F, const cf* TWM, const cf* TWN) {
    cf* tw1 = (cf*)(F.lds + F2_TW);
    for (int e = F.tid; e < 544; e += 512) tw1[e] = e < 512 ? TWM[e] : TWM[16 * (e - 512)];
    ((cf*)(F.lds + F2_TN))[F.tid] = TWN[F.tid];
    __syncthreads();
}
__device__ __forceinline__ cf tn_pow(cf base, int r) {
    const float c[16] = {1.0f, 0.98078528040323043f, 0.92387953251128674f, 0.83146961230254524f, 0.70710678118654752f, 0.55557023301960218f, 0.38268343236508977f, 0.19509032201612825f,
                         0.0f, -0.19509032201612825f, -0.38268343236508977f, -0.55557023301960218f, -0.70710678118654752f, -0.83146961230254524f, -0.92387953251128674f, -0.98078528040323043f};
    const float sn[16] = {0.0f, 0.19509032201612825f, 0.38268343236508977f, 0.55557023301960218f, 0.70710678118654752f, 0.83146961230254524f, 0.92387953251128674f, 0.98078528040323043f,
                          1.0f, 0.98078528040323043f, 0.92387953251128674f, 0.83146961230254524f, 0.70710678118654752f, 0.55557023301960218f, 0.38268343236508977f, 0.19509032201612825f};
    if (r == 0) return base;
    if (r == 8) return cmulnegi(base);
    cf w; w.x = c[r]; w.y = -sn[r]; return cmul(base, w);
}
__device__ __forceinline__ void filtfft_phase(Frame& F) {
    const float* hT = (const float*)(F.ws + WS_HT); const float* fsqp = (const float*)(F.ws + WS_FSQP);
    const cf* TWM = (const cf*)(F.ws + SM_TWM); const cf* TWN = (const cf*)(F.ws + SM_TWN);
    cf* Fsp = (cf*)(F.ws + WS_F);
    cf* aE = (cf*)F.lds; cf* aO = (cf*)(F.lds + F2_AO);
    const cf* tw1 = (const cf*)(F.lds + F2_TW); const cf* tw32 = tw1 + 512;
    float* red = (float*)(F.lds + F2_RED);
    f2_load_tw(F, TWM, TWN);
    float* nrmt = (float*)(F.lds + F2_RED + 2048);
    { int kk = 0;
      for (int c0 = F.vcu; c0 < DM; c0 += 4 * F.G, kk += 4) {
        const int tl = min(F.tid, SEQ / 32 - 1);
        float pv[4];
#pragma unroll
        for (int j = 0; j < 4; ++j) { const int cc = min(c0 + j * F.G, DM - 1); pv[j] = fsqp[(size_t)tl * 2048 + cc] + fsqp[(size_t)tl * 2048 + 1024 + cc]; }
#pragma unroll
        for (int j = 0; j < 4; ++j) { float p = (F.tid < SEQ / 32) ? pv[j] : 0.f; p = wave_sum(p); if (F.lane == 0) red[j * 8 + F.wave] = p; }
        __syncthreads();
        if (F.tid < 4) { const float* rp = red + F.tid * 8; const float sm = ((((((rp[0] + rp[1]) + rp[2]) + rp[3]) + rp[4]) + rp[5]) + rp[6]) + rp[7]; nrmt[kk + F.tid] = 1.0f / sqrtf(sm + EPS); }
        __syncthreads();
      } }
    int kc = 0;
    for (int c = F.vcu; c < DM; c += F.G, ++kc) {
        int tid = F.tid; FC_OPAQUE(tid);
        __syncthreads();
        const float nrm = nrmt[kc];
        const float* hf = hT + (size_t)c * SEQ; const float* hb = hT + ((size_t)1024 + c) * SEQ;
        if (c + F.G < DM) { const float* pr = hT + ((size_t)(tid >> 8) * 1024 + c + F.G) * SEQ + (size_t)(tid & 255) * 32;
            __builtin_amdgcn_global_load_lds((const unsigned*)pr, (LAS unsigned*)(F.lds + F2_PF + F.wave * 256), 4, 0, 0); }
        {
            cf v[16], w[16];
            const cf tnb = ((const cf*)(F.lds + F2_TN))[tid];
#pragma unroll
            for (int r = 0; r < 16; ++r) { const int n = tid + 512 * r; const float hbv = hb[SEQ - max(n, 1)];
                const float fa = hf[n] * nrm, fb = (n == 0) ? 0.f : hbv * nrm;
                v[r].x = fa + fb; v[r].y = 0.f; const cf tnr = tn_pow(tnb, r); w[r].x = (fa - fb) * tnr.x; w[r].y = (fa - fb) * tnr.y; }
            f2_fwd_p1(v, tid, aE, tw1);
            f2_fwd_p1(w, tid, aO, tw1);
        }
        __syncthreads();
        f2_fwd_p2_dual(tid, aE, aO, tw32);
        __syncthreads();
        { const int path = tid >> 8, bf = tid & 255;
          f2_mid_store16(bf, path ? aO : aE, (v2u*)Fsp + ((size_t)c * 2 + path) * (FC_M / 2)); }
    }
    __syncthreads();
}

__device__ __forceinline__ void conv3_8(const v4u raw, float prev, float next, float w0, float w1, float w2, float bb, float* out) {
    float x[10]; x[0] = prev; x[9] = next;
    x[1] = bflo(raw.x); x[2] = bfhi(raw.x); x[3] = bflo(raw.y); x[4] = bfhi(raw.y); x[5] = bflo(raw.z); x[6] = bfhi(raw.z); x[7] = bflo(raw.w); x[8] = bfhi(raw.w);
#pragma unroll
    for (int i = 0; i < 8; ++i) out[i] = w0 * x[i] + w1 * x[i + 1] + w2 * x[i + 2] + bb;
}
#ifdef PROBE_SEC
#define SEC_MARK(k) do { const unsigned long long t_ = __builtin_amdgcn_s_memrealtime(); if ((k) > 0 && (k) - 1 == PROBE_SEC) F.sec += t_ - sec_t0; sec_t0 = t_; } while (0)
#else
#define SEC_MARK(k) do { } while (0)
#endif
__device__ __forceinline__ void hyena_fft_phase(Frame& F) {
#ifdef PROBE_SEC
    unsigned long long sec_t0 = 0;
#endif
    const float* const* in = F.in;
    const float* sw = in[23]; const float* sb = in[24]; const float* dbias = in[33];
    const bf16* UT = (const bf16*)(F.ws + WS_UT);
    const cf* TWM = (const cf*)(F.ws + SM_TWM); const cf* TWN = (const cf*)(F.ws + SM_TWN);
    const cf* Fsp = (const cf*)(F.ws + WS_F);
    cf* aE = (cf*)F.lds; cf* aO = (cf*)(F.lds + F2_AO);
    const cf* tw1 = (const cf*)(F.lds + F2_TW); const cf* tw32 = tw1 + 512;
    f2_load_tw(F, TWM, TWN);
    for (int unit = F.vcu; unit < 2 * DM; unit += F.G) {
        const int c = unit >> 1, b0 = (unit & 1) * 2;
        int tid = F.tid; FC_OPAQUE(tid);
        SEC_MARK(0);
        __syncthreads();
        {
            const float w10 = sw[1024 + c], w11 = sw[3072 + 1024 + c], w12 = sw[6144 + 1024 + c], bb1 = sb[1024 + c];
            const float wv0 = sw[2048 + c], wv1 = sw[3072 + 2048 + c], wv2 = sw[6144 + 2048 + c], bbv = sb[2048 + c];
            v4u x1raw[2][2], vraw[2][2]; unsigned short hh[2][2][4];
            FC_OPAQUE(tid);
#pragma unroll
            for (int h = 0; h < 2; ++h) {
                const int t0 = (tid + 512 * h) * 8;
                const int ipv = max(t0 - 1, 0), inx = min(t0 + 8, SEQ - 1);
#pragma unroll
                for (int bb = 0; bb < 2; ++bb) {
                    const bf16* x1r = UT + ((size_t)(b0 + bb) * 3072 + 1024 + c) * SEQ;
                    const bf16* vr = UT + ((size_t)(b0 + bb) * 3072 + 2048 + c) * SEQ;
                    x1raw[h][bb] = *(const v4u*)(x1r + t0); vraw[h][bb] = *(const v4u*)(vr + t0);
                    hh[h][bb][0] = x1r[ipv]; hh[h][bb][1] = x1r[inx]; hh[h][bb][2] = vr[ipv]; hh[h][bb][3] = vr[inx];
                }
            }
#pragma unroll
            for (int h = 0; h < 2; ++h) {
                const int t0 = (tid + 512 * h) * 8;
                float z[2][8];
#pragma unroll
                for (int bb = 0; bb < 2; ++bb) {
                    const float x1p = t0 > 0 ? bf2f(hh[h][bb][0]) : 0.f, x1n = t0 + 8 < SEQ ? bf2f(hh[h][bb][1]) : 0.f;
                    const float vp = t0 > 0 ? bf2f(hh[h][bb][2]) : 0.f, vn = t0 + 8 < SEQ ? bf2f(hh[h][bb][3]) : 0.f;
                    float x1c[8], vc[8];
                    conv3_8(x1raw[h][bb], x1p, x1n, w10, w11, w12, bb1, x1c);
                    conv3_8(vraw[h][bb], vp, vn, wv0, wv1, wv2, bbv, vc);
#pragma unroll
                    for (int i = 0; i < 8; ++i) z[bb][i] = x1c[i] * vc[i];
                }
                const int pb = F2_PIDX(t0);
#pragma unroll
                for (int i = 0; i < 8; ++i) { cf t; t.x = z[0][i]; t.y = z[1][i]; aE[pb + i] = t; }
            }
        }
        __syncthreads();
        SEC_MARK(1);
        cf wreg[16];
        FC_OPAQUE(tid);
        { const int pt = F2_PIDX(tid);
#pragma unroll
          for (int r = 0; r < 16; ++r) wreg[r] = aE[pt + 528 * r]; }
        const int path = tid >> 8, bf = tid & 255;
        const cf tnb = ((const cf*)(F.lds + F2_TN))[tid];
        cf tn[16];
#pragma unroll
        for (int r = 0; r < 16; ++r) tn[r] = tn_pow(tnb, r);
        {
            cf v[16];
#pragma unroll
            for (int r = 0; r < 16; ++r) v[r] = cmul(wreg[r], tn[r]);
            f2_fwd_p1(v, tid, aO, tw1);
            FC_OPAQUE(tid);
#pragma unroll
            for (int r = 0; r < 16; ++r) v[r] = wreg[r];
            f2_fwd_p1(v, tid, aE, tw1);
        }
        __syncthreads();
        SEC_MARK(2);
        f2_fwd_p2_dual(tid, aE, aO, tw32);
        __syncthreads();
        SEC_MARK(3);
        v2u freg[16];
        { const v2u* fp = (const v2u*)Fsp + ((size_t)c * 2 + path) * (FC_M / 2) + bf;
#pragma unroll
          for (int i = 0; i < 16; ++i) freg[i] = fp[i * 256]; }
        f2_mid16(bf, path ? aO : aE, freg);
        __syncthreads();
        SEC_MARK(4);
        if (tid < 256) { const bf16* pr = UT + ((size_t)(b0 + (tid >> 7)) * 3072 + c) * SEQ + (size_t)(tid & 127) * 64;
            __builtin_amdgcn_global_load_lds((const unsigned*)pr, (LAS unsigned*)(F.lds + F2_PF + F.wave * 256), 4, 0, 0); }
        if (unit + F.G < 2 * DM) { const int nu = unit + F.G, nc = nu >> 1, nb = (nu & 1) * 2 + (tid >> 8), wh = 1 + ((tid >> 7) & 1);
            const bf16* pr = UT + ((size_t)nb * 3072 + wh * 1024 + nc) * SEQ + (size_t)(tid & 127) * 64;
            __builtin_amdgcn_global_load_lds((const unsigned*)pr, (LAS unsigned*)(F.lds + F2_PF + F.wave * 256), 4, 0, 0); }
        f2_inv_p2_dual(tid, aE, aO, tw32);
        __syncthreads();
        SEC_MARK(5);
        {
            cf ve[16], vo[16];
            f2_inv_p1(ve, tid, aE, tw1);
            f2_inv_p1(vo, tid, aO, tw1);
            const float db = dbias[c];
            FC_OPAQUE(tid);
            const int pt = F2_PIDX(tid);
            const cf tnb2 = ((const cf*)(F.lds + F2_TN))[tid];
#pragma unroll
            for (int r = 0; r < 16; ++r) { const int n = tid + 512 * r;
                const cf y = cadd(cconj(ve[r]), cmul(cconj(tn_pow(tnb2, r)), cconj(vo[r])));
                cf o; o.x = y.x * (1.0f / 16384.0f) + wreg[r].x * db; o.y = y.y * (1.0f / 16384.0f) + wreg[r].y * db; aE[pt + 528 * r] = o; }
        }
        __syncthreads();
        SEC_MARK(6);
        {
            const float w00 = sw[c], w01 = sw[3072 + c], w02 = sw[6144 + c], bb0 = sb[c];
            v4u xraw[2][2]; unsigned short hx[2][2][2];
            FC_OPAQUE(tid);
#pragma unroll
            for (int h = 0; h < 2; ++h) {
                const int t0 = (tid + 512 * h) * 8;
#pragma unroll
                for (int bb = 0; bb < 2; ++bb) { const bf16* x0r = UT + ((size_t)(b0 + bb) * 3072 + c) * SEQ;
                    xraw[h][bb] = *(const v4u*)(x0r + t0); hx[h][bb][0] = x0r[max(t0 - 1, 0)]; hx[h][bb][1] = x0r[min(t0 + 8, SEQ - 1)]; }
            }
#pragma unroll
            for (int h = 0; h < 2; ++h) {
                const int t0 = (tid + 512 * h) * 8;
                cf val[8];
                const int pb = F2_PIDX(t0);
#pragma unroll
                for (int i = 0; i < 8; ++i) val[i] = aE[pb + i];
#pragma unroll
                for (int bb = 0; bb < 2; ++bb) {
                    const float xp = t0 > 0 ? bf2f(hx[h][bb][0]) : 0.f, xn = t0 + 8 < SEQ ? bf2f(hx[h][bb][1]) : 0.f;
                    float x0c[8]; conv3_8(xraw[h][bb], xp, xn, w00, w01, w02, bb0, x0c);
                    float p[8];
#pragma unroll
                    for (int i = 0; i < 8; ++i) p[i] = x0c[i] * (bb == 0 ? val[i].x : val[i].y);
                    v4u o; o.x = pk2(p[0], p[1]); o.y = pk2(p[2], p[3]); o.z = pk2(p[4], p[5]); o.w = pk2(p[6], p[7]);
                    *(v4u*)((bf16*)(F.ws + WS_XS) + ((size_t)(b0 + bb) * 1024 + c) * SEQ + t0) = o;
                }
            }
        }
        SEC_MARK(7);
    }
    __syncthreads();
}
__device__ __forceinline__ void transpose_p_phase(Frame& F) {
    const bf16* PT = (const bf16*)(F.ws + WS_XS); bf16* P = (bf16*)(F.ws + WS_P);
    LAS unsigned short* scr = (LAS unsigned short*)(F.lds + F.wave * 16384);
    const int gw = F.vcu * NWAVES + F.wave, NGW = F.G * NWAVES, lane = F.lane;
    const int ntile = NB * (DM / 64) * (SEQ / 64);
    const int l8 = lane >> 3, ch = (lane & 7) * 8;
    for (int it = gw; it < ntile; it += NGW) {
        const int tb = it % (SEQ / 64), cb = (it / (SEQ / 64)) % (DM / 64), b = it / ((SEQ / 64) * (DM / 64));
        v4u x[8];
#pragma unroll
        for (int k = 0; k < 8; ++k) x[k] = *(const v4u*)(PT + ((size_t)b * 1024 + cb * 64 + 8 * k + l8) * SEQ + tb * 64 + ch);
#pragma unroll
        for (int k = 0; k < 8; ++k) { LAS unsigned* d = (LAS unsigned*)(scr + (8 * k + l8) * 66 + ch); d[0] = x[k].x; d[1] = x[k].y; d[2] = x[k].z; d[3] = x[k].w; }
        LDS_WAIT(); asm volatile("" ::: "memory");
#pragma unroll
        for (int k = 0; k < 8; ++k) { const int t = 8 * k + l8; const LAS unsigned short* sp = scr + ch * 66 + t;
            v4u o; o.x = sp[0] | ((unsigned)sp[66] << 16); o.y = sp[2 * 66] | ((unsigned)sp[3 * 66] << 16); o.z = sp[4 * 66] | ((unsigned)sp[5 * 66] << 16); o.w = sp[6 * 66] | ((unsigned)sp[7 * 66] << 16);
            *(v4u*)(P + ((size_t)b * SEQ + tb * 64 + t) * DM + cb * 64 + ch) = o; }
        LDS_WAIT(); asm volatile("" ::: "memory");
    }
}

constexpr int NPH = 13;
__global__ void __launch_bounds__(NWAVES * 64, 2) hybrid_fwd(Args args) {
    extern __shared__ __attribute__((aligned(16))) unsigned char lds[];
    Frame F;
    F.lds = (LAS unsigned char*)lds;
    F.tid = threadIdx.x; F.lane = F.tid & 63; F.wave = __builtin_amdgcn_readfirstlane(F.tid >> 6);
    F.G = gridDim.x; { const int bx = blockIdx.x; F.vcu = (F.G % 8 == 0) ? (bx % 8) * (F.G / 8) + bx / 8 : bx; }
    F.in = args.in; F.out = args.out; F.ws = args.ws;
#ifdef PROBE_SEC
    F.sec = 0;
#endif
    unsigned char* ws = args.ws;
    volatile LAS unsigned* MISC = (volatile LAS unsigned*)(F.lds + MISC_OFF);
    for (int u = F.tid; u < (LDS_BYTES - LDSCTL_OFF) / 4; u += NWAVES * 64) ((LAS unsigned*)(F.lds + LDSCTL_OFF))[u] = 0u;
    __syncthreads();
    XcdBarrier bar; bar.bar = (unsigned*)(ws + CT_BAR) + args.li * XCD_BAR_WORDS; bar.x = 0; bar.st = nullptr;
    const int lo = args.ph_lo, hi = args.ph_hi;
    if (hi - lo > 1) bar = xcd_barrier_post((unsigned*)(ws + CT_BAR) + args.li * XCD_BAR_WORDS, MISC + 8);
#ifndef EXP_PAIR
#define EXP_PAIR 0
#endif
#ifndef REP_MASK
#define REP_MASK 0
#endif
#define REPS(k) ((((REP_MASK) >> (k)) & 1) ? 2 : 1)
#ifndef PH_MASK
#define PH_MASK 0xFFFFFF
#endif
#define IN(k) ((((PH_MASK) >> (k)) & 1) && lo <= (k) && (k) < hi)
#ifdef PROBE_TS
    unsigned long long ts_a = 0, ts_b = 0;
#define TS_MARK(k) do { if (blockIdx.x == 0 && F.tid == 0) { const unsigned long long t_ = __builtin_amdgcn_s_memrealtime(); if ((k) == PROBE_TS) ts_a = t_; if ((k) == PROBE_TS + 1) ts_b = t_; } } while (0)
#else
#define TS_MARK(k) do { } while (0)
#endif
#define SEAM(k) do { if (IN(k) && IN((k) + 1)) xcd_barrier(bar); TS_MARK((k) + 1); } while (0)
    const float* mods = (const float*)(ws + CT_MODS);
    const float* gnt = (const float*)(ws + SM_GN);
    float* ssqa = (float*)(ws + WS_SSQP);
    bf16* XS = (bf16*)(ws + WS_XS);

    TS_MARK(0);
    if (IN(0)) { for (int rep = 0; rep < REPS(0); ++rep) { phase0a(F); filtgen_phase(F); } } SEAM(0);
    if (IN(1)) { for (int rep = 0; rep < REPS(1); ++rep) { phase0b(F); filtfft_phase(F); } } SEAM(1);
    if (IN(2)) for (int rep = 0; rep < REPS(2); ++rep) {
        { pg8::Gemm g{XS, (const bf16*)(ws + WS_WQKV), TT, DM, DM, DM}; pg8::StaticOrder S; S.init(TT, DM, F.G, (int)blockIdx.x);
          EpiQK<0> E{(bf16*)(ws + WS_Q), (const float*)(ws + SM_SSQ0), 1, (const float*)(ws + CT_BQKV), 3072, args.in[9], SEQ};
          pg8::gemm_phase<EpiQK<0>, pg8::StaticOrder, true, true>(F.lds, g, S, E); }
        { pg8::Gemm g{XS, (const bf16*)(ws + WS_WQKV) + (size_t)1024 * DM, TT, DM, DM, DM}; pg8::StaticOrder S; S.init(TT, DM, F.G, (int)blockIdx.x);
          EpiQK<1> E{(bf16*)(ws + WS_K), (const float*)(ws + SM_SSQ0), 1, (const float*)(ws + CT_BQKV), 3072, args.in[10], SEQ};
          pg8::gemm_phase<EpiQK<1>, pg8::StaticOrder, true, true>(F.lds, g, S, E); }
        { pg8::Gemm g{XS, (const bf16*)(ws + WS_WQKV) + (size_t)2048 * DM, TT, DM, DM, DM}; pg8::StaticOrder S; S.init(TT, DM, F.G, (int)blockIdx.x);
          EpiVT E{(bf16*)(ws + WS_V), (const float*)(ws + SM_SSQ0), 1, (const float*)(ws + CT_BQKV), 3072, SEQ};
          pg8::gemm_phase<EpiVT, pg8::StaticOrder, true, true>(F.lds, g, S, E); }
        { pg8::Gemm g{(const bf16*)(ws + WS_XSC), (const bf16*)(ws + WS_WQKV) + (size_t)1024 * DM, TC, 2 * DM, DM, DM}; pg8::StaticOrder S; S.init(TC, 2 * DM, F.G, (int)blockIdx.x);
          EpiCtxKV E{ EpiQK<1>{(bf16*)(ws + WS_KC), (const float*)(ws + SM_SSQC), 1, (const float*)(ws + CT_BQKV) + 4 * 3072, 0, args.in[10], CTXL},
                      EpiVT{(bf16*)(ws + WS_VC), (const float*)(ws + SM_SSQC), 1, (const float*)(ws + CT_BQKV) + 4 * 3072, 0, CTXL} };
          pg8::gemm_phase<EpiCtxKV, pg8::StaticOrder, true, true>(F.lds, g, S, E); }
        { const int nct = (TC / 256) * (2 * DM / 256); const int idle = (int)F.G - nct;
          if (idle >= 184) { if ((int)blockIdx.x >= nct) bias_gemv_late(F, (int)blockIdx.x - nct); }
          else for (int it = (int)blockIdx.x; it < 184; it += (int)F.G) bias_gemv_late(F, it); }
    } SEAM(2);
    if (IN(3)) { for (int rep = 0; rep < REPS(3); ++rep) attn_mfma_phase(F); } SEAM(3);
    if (IN(4)) for (int rep = 0; rep < REPS(4); ++rep) {
        pg8::Gemm g{(const bf16*)(ws + WS_O), (const bf16*)(ws + WS_WO), TT, DM, DM, DM}; pg8::StaticOrder S; S.init(TT, DM, F.G, (int)blockIdx.x);
        EpiRes<true, false> E{args.in[0], ws + WS_XB, mods + 2048, nullptr, gnt, XS, ssqa, (float*)(lds + RING_BYTES + 8192)};
        pg8::gemm_phase<EpiRes<true, false>, pg8::StaticOrder, true, true>(F.lds, g, S, E);
    } SEAM(4);
    if (IN(5)) for (int rep = 0; rep < REPS(5); ++rep) {
        pg8::Gemm g{XS, (const bf16*)(ws + WS_WUP0), TT, 2 * FF, DM, DM}; pg8::StaticOrder S; S.init(TT, 2 * FF, F.G, (int)blockIdx.x);
        EpiUpGlu E{(bf16*)(ws + WS_AG), ssqa, 4, (const float*)(ws + CT_BUP0), args.in[14], args.in[15], (float*)(ws + WS_HG), (float*)(ws + WS_HA), (float*)(lds + RING_BYTES)};
        pg8::gemm_phase<EpiUpGlu, pg8::StaticOrder, true, true>(F.lds, g, S, E);
    } SEAM(5);

    if (IN(6)) {
        { pg8::StaticOrder S0; S0.init(TT, DM, F.G, (int)blockIdx.x); pg8::Unit fu;
#pragma unroll 1
          for (int i = 0; S0.next(i, fu); ++i) glu_fix_tile(F, fu.pm, args.in[14], args.in[15]);
          VM_WAIT(); __syncthreads(); asm volatile("" ::: "memory"); }
        pg8::Gemm g{(const bf16*)(ws + WS_AG), (const bf16*)(ws + WS_WDN0), TT, DM, FF, FF}; pg8::StaticOrder S; S.init(TT, DM, F.G, (int)blockIdx.x);
        EpiRes<false, false> E{ws + WS_XB, ws + WS_XB, mods + 5120, nullptr, gnt + 4096, XS, ssqa + 4 * TT, (float*)(lds + RING_BYTES + 8192)};
        pg8::gemm_phase<EpiRes<false, false>, pg8::StaticOrder, true, true>(F.lds, g, S, E);
    } SEAM(6);
    if (IN(7)) for (int rep = 0; rep < REPS(7); ++rep) {
        pg8::Gemm g{XS, (const bf16*)(ws + WS_WIN), TT, 3 * DM, DM, DM}; pg8::StaticOrder S; S.init(TT, 3 * DM, F.G, (int)blockIdx.x);
#ifdef EXP_P9
        EpiScaleBias E{(bf16*)(ws + WS_UT), 3 * DM, ssqa + 4 * TT, 4, (const float*)(ws + CT_BIN), 3072};
        pg8::gemm_phase<EpiScaleBias, pg8::StaticOrder, true, true>(F.lds, g, S, E);
#else
        EpiInT E{(bf16*)(ws + WS_UT), ssqa + 4 * TT, 4, (const float*)(ws + CT_BIN)};
        pg8::gemm_phase<EpiInT, pg8::StaticOrder, true, true>(F.lds, g, S, E);
#endif
    } SEAM(7);
    if (IN(8)) { for (int rep = 0; rep < REPS(8); ++rep) hyena_fft_phase(F); } SEAM(8);

    if (IN(9)) { for (int rep = 0; rep < REPS(9); ++rep) transpose_p_phase(F); } SEAM(9);
    if (IN(10)) {
        pg8::Gemm g{(const bf16*)(ws + WS_P), (const bf16*)(ws + WS_WOUT), TT, DM, DM, DM}; pg8::StaticOrder S; S.init(TT, DM, F.G, (int)blockIdx.x);
        EpiRes<false, false> E{ws + WS_XB, ws + WS_XB, mods + 5 * 6144 + 2048, args.in[35], gnt + 2 * 4096, XS, ssqa + 8 * TT, (float*)(lds + RING_BYTES + 8192)};
        pg8::gemm_phase<EpiRes<false, false>, pg8::StaticOrder, true, true>(F.lds, g, S, E);
    } SEAM(10);
    if (IN(11)) for (int rep = 0; rep < REPS(11); ++rep) {
        pg8::Gemm g{XS, (const bf16*)(ws + WS_WUP1), TT, 2 * FF, DM, DM}; pg8::StaticOrder S; S.init(TT, 2 * FF, F.G, (int)blockIdx.x);
        EpiUpGlu E{(bf16*)(ws + WS_AG), ssqa + 8 * TT, 4, (const float*)(ws + CT_BUP1), args.in[37], args.in[38], (float*)(ws + WS_HG), (float*)(ws + WS_HA), (float*)(lds + RING_BYTES)};
        pg8::gemm_phase<EpiUpGlu, pg8::StaticOrder, true, true>(F.lds, g, S, E);
    } SEAM(11);
    if (IN(12)) {
        { pg8::StaticOrder S0; S0.init(TT, DM, F.G, (int)blockIdx.x); pg8::Unit fu;
#pragma unroll 1
          for (int i = 0; S0.next(i, fu); ++i) glu_fix_tile(F, fu.pm, args.in[37], args.in[38]);
          VM_WAIT(); __syncthreads(); asm volatile("" ::: "memory"); }
        pg8::Gemm g{(const bf16*)(ws + WS_AG), (const bf16*)(ws + WS_WDN1), TT, DM, FF, FF}; pg8::StaticOrder S; S.init(TT, DM, F.G, (int)blockIdx.x);
        EpiRes<false, true> E{ws + WS_XB, args.out, mods + 5 * 6144 + 5120, nullptr, nullptr, nullptr, nullptr, nullptr};
        pg8::gemm_phase<EpiRes<false, true>, pg8::StaticOrder, true, true>(F.lds, g, S, E);
    }
#ifdef PROBE_SEC
    if (blockIdx.x == 0 && F.tid == 0) { asm volatile("s_waitcnt vmcnt(0)" ::: "memory"); args.out[0] = args.out[0] + (float)F.sec * 0.01f; }
#endif
#ifdef PROBE_TS
    TS_MARK(NPH);
    if (blockIdx.x == 0 && F.tid == 0) { asm volatile("s_waitcnt vmcnt(0)" ::: "memory"); args.out[0] = args.out[0] + (float)(ts_b - ts_a) * 0.01f; }
#endif
#ifdef PROBE_NULL
    if (lo == 98) {
#if PROBE_NULL == 5
        pg8::Gemm g{XS, (const bf16*)(ws + WS_WUP0), TT, 2 * FF, DM, DM}; pg8::StaticOrder S; S.init(TT, 2 * FF, F.G, (int)blockIdx.x);
#elif PROBE_NULL == 4
        pg8::Gemm g{(const bf16*)(ws + WS_O), (const bf16*)(ws + WS_WO), TT, DM, DM, DM}; pg8::StaticOrder S; S.init(TT, DM, F.G, (int)blockIdx.x);
#elif PROBE_NULL == 7
        pg8::Gemm g{(const bf16*)(ws + WS_AG), (const bf16*)(ws + WS_WDN0), TT, DM, FF, FF}; pg8::StaticOrder S; S.init(TT, DM, F.G, (int)blockIdx.x);
        { pg8::Unit fu; for (int i = 0; S.next(i, fu); ++i) glu_fix_tile(F, fu.pm, args.in[14], args.in[15]); VM_WAIT(); __syncthreads(); }
#else
        pg8::Gemm g{XS, (const bf16*)(ws + WS_WQKV), TT, 3 * DM, DM, DM}; pg8::StaticOrder S; S.init(TT, 3 * DM, F.G, (int)blockIdx.x);
#endif
        EpiNull E{(float*)(ws + WS_FSQP)};
        pg8::gemm_phase<EpiNull, pg8::StaticOrder, true, true>(F.lds, g, S, E);
    }
#endif
#ifdef DUMP_SEL
    if (lo == 99) {
        float* o = args.out; const size_t n = (size_t)TT * DM;
        for (size_t e = (size_t)blockIdx.x * 512 + F.tid; e < n; e += (size_t)F.G * 512) {
            float v;
            if (DUMP_SEL == 1) { const float* h = (const float*)(ws + WS_HT); v = (e < (size_t)2 * 1024 * SEQ) ? h[e] : ((const float*)(ws + WS_FSQP))[e & 1023]; }
            else if (DUMP_SEL == 2) { const bf16* u = (const bf16*)(ws + WS_UT); v = bf2f(u[e]); }
            else if (DUMP_SEL == 3) { const bf16* u = (const bf16*)(ws + WS_UT); v = bf2f(u[e + (size_t)TT * DM]); }
            else if (DUMP_SEL == 4) { const bf16* u = (const bf16*)(ws + WS_UT); v = bf2f(u[e + (size_t)2 * TT * DM]); }
            else { const bf16* u = (const bf16*)(ws + WS_P); v = bf2f(u[e]); }
            o[e] = v;
        }
    }
#endif
#undef IN
#undef SEAM
}

extern "C" void kernel_launch(void* const* d_in, const int* in_sizes, int n_in, void* d_out, int out_size, void* d_ws, size_t ws_size, hipStream_t stream) {
    static int grid = 0;
    if (grid == 0) {
        if (n_in != 40 || out_size != TT * DM || ws_size < WS_END) { fprintf(stderr, "kernel_launch: unexpected shapes n_in %d out %d ws %zu\n", n_in, out_size, ws_size); grid = -1; return; }
        int dev = 0, cus = 0;
        if (hipGetDevice(&dev) != hipSuccess || hipDeviceGetAttribute(&cus, hipDeviceAttributeMultiprocessorCount, dev) != hipSuccess) { grid = -1; return; }
        if (hipFuncSetAttribute((const void*)hybrid_fwd, hipFuncAttributeMaxDynamicSharedMemorySize, LDS_BYTES) != hipSuccess) { fprintf(stderr, "kernel_launch: hipFuncSetAttribute failed\n"); grid = -1; return; }
        int per_cu = 0;
        if (hipOccupancyMaxActiveBlocksPerMultiprocessor(&per_cu, (const void*)hybrid_fwd, NWAVES * 64, LDS_BYTES) != hipSuccess || per_cu < 1) { fprintf(stderr, "kernel_launch: occupancy query says %d\n", per_cu); }
        (void)hipGetLastError();
        grid = cus;
    }
    if (grid < 0) return;
    (void)hipMemsetAsync((char*)d_ws + WS_CTL, 0, CTL_ZERO_BYTES, stream);
    Args a{};
    for (int i = 0; i < 40; ++i) a.in[i] = (const float*)d_in[i];
    a.out = (float*)d_out; a.ws = (unsigned char*)d_ws; a.repmask = REP_MASK;
#if defined(PROBE_NULL)
    {   const int k = PROBE_NULL; const int lo[3] = {0, 98, k}, hi[3] = {k, 99, NPH};
        for (int i = 0; i < 3; ++i) { a.ph_lo = lo[i]; a.ph_hi = hi[i]; a.li = i;
            hipLaunchKernelGGL(hybrid_fwd, dim3(grid), dim3(NWAVES * 64), LDS_BYTES, stream, a); } }
#elif defined(PROBE_PHASE)
    {   const int k = PROBE_PHASE; const int lo[4] = {0, k, k, k + 1}, hi[4] = {k, k + 1, k + 1, NPH};
        for (int i = 0; i < 4; ++i) { if (lo[i] >= hi[i]) continue; a.ph_lo = lo[i]; a.ph_hi = hi[i]; a.li = i;
            hipLaunchKernelGGL(hybrid_fwd, dim3(grid), dim3(NWAVES * 64), LDS_BYTES, stream, a); } }
#elif MK_ONE_LAUNCH
    a.ph_lo = 0; a.ph_hi = NPH;
    hipLaunchKernelGGL(hybrid_fwd, dim3(grid), dim3(NWAVES * 64), LDS_BYTES, stream, a);
#else
    for (int p = 0; p < PH_END; ++p) { a.ph_lo = p; a.ph_hi = p + 1; hipLaunchKernelGGL(hybrid_fwd, dim3(grid), dim3(NWAVES * 64), LDS_BYTES, stream, a); }
#ifdef DUMP_SEL
    a.ph_lo = 99; a.ph_hi = 100; hipLaunchKernelGGL(hybrid_fwd, dim3(grid), dim3(NWAVES * 64), LDS_BYTES, stream, a);
#endif
#endif
}
```

```cpp
#include <hip/hip_runtime.h>
#include <cstdio>
#include <cstdint>

#ifndef PH_END
#define PH_END 13
#endif
#ifndef MK_ONE_LAUNCH
#define MK_ONE_LAUNCH 1
#endif

namespace pg8 {
#define PG8_LAS __attribute__((address_space(3)))
typedef unsigned short bf16_t;
typedef short bf16x8 __attribute__((ext_vector_type(8)));
typedef float f32x4 __attribute__((ext_vector_type(4)));
typedef unsigned u32x4 __attribute__((ext_vector_type(4)));
constexpr int BM = 256, BK = 64, HALF = 128, HTB = HALF * BK * 2, STAGE_BYTES = 8 * HTB, NXCD = 8, WGM = 8;

__host__ __device__ __forceinline__ int lds_byte(int r, int c) { const int st = (r >> 4) * 2 + (c >> 5), rr = r & 15, cc = c & 31, ob = rr * 64 + cc * 2; return st * 1024 + (ob ^ (((ob >> 9) & 1) << 5)); }
__host__ __device__ __forceinline__ void stage_rc(int b, int& R, int& C) { const int st = b / 1024, sb = b % 1024, swz = sb ^ (((sb >> 9) & 1) << 5); R = (st >> 1) * 16 + swz / 64; C = (st & 1) * 32 + (swz % 64) / 2; }
__host__ __device__ __forceinline__ int perm32(int rho) { const int n = rho >> 4, i = rho & 15; return 8 * (i >> 2) + 4 * n + (i & 3); }

struct Unit { int pm, pn; };
struct Gemm { const bf16_t* A; const bf16_t* Bt; int M, N, K, lda; };

struct StaticOrder {
    int nM, nN, nwg, G, c;
    __host__ __device__ __forceinline__ void init(int M, int N, int G_, int c_) { nM = M / BM; nN = N / BM; nwg = nM * nN; G = G_; c = c_; }
    __host__ __device__ __forceinline__ bool next(int i, Unit& u) const {
        const long L = (long)i * G + c; if (L >= nwg) return false;
        int wgid = (int)L; { const int q = nwg / NXCD, r = nwg % NXCD, xcd = wgid % NXCD, off = wgid / NXCD; wgid = (xcd < r ? xcd * (q + 1) : r * (q + 1) + (xcd - r) * q) + off; }
        const int nig = WGM * nN, gid = wgid / nig, fm = gid * WGM, gsz = (nM - fm) < WGM ? (nM - fm) : WGM;
        u.pm = fm + ((wgid % nig) % gsz); u.pn = (wgid % nig) / gsz; return true;
    }
    __device__ __forceinline__ void a_ready(const Unit&) const {}
    __device__ __forceinline__ void done(const Unit&) const {}
};

__device__ __forceinline__ unsigned cvt_pk_bf16(float lo, float hi) { unsigned r; asm volatile("v_cvt_pk_bf16_f32 %0, %1, %2" : "=v"(r) : "v"(lo), "v"(hi)); return r; }

template <class E> __device__ __forceinline__ auto epi_prefetch(const E& e, const Unit& u, int) -> decltype(e.prefetch(u), void()) { e.prefetch(u); }
template <class E> __device__ __forceinline__ void epi_prefetch(const E&, const Unit&, long) {}
template <class E, class = void> struct aperm_of { static constexpr bool v = false; };
template <class E> struct aperm_of<E, decltype((void)E::APERM)> { static constexpr bool v = E::APERM; };
template <class Epi, class Sched, bool ALIGN_EPI = false, bool SP2 = false>
__device__ __forceinline__ void gemm_phase(PG8_LAS unsigned char* lds, const Gemm g, const Sched& S, const Epi& E) {
    const int tid = threadIdx.x, wid = __builtin_amdgcn_readfirstlane(tid >> 6), lane = tid & 63, wr = wid >> 2, wc = wid & 3, fr = lane & 15, fq = lane >> 4;
    const int K = g.K, nt = K / BK, lda = g.lda;
    unsigned voffA[2], voffB[2];
#pragma unroll
    for (int i = 0; i < 2; ++i) { int R, C; stage_rc(tid * 16 + i * 8192, R, C); const int Rb = Epi::PERM ? ((R & ~31) + perm32(R & 31)) : R;
        const int Ra = aperm_of<Epi>::v ? ((R & ~63) + 4 * (R & 15) + ((R >> 4) & 3)) : R;
        voffA[i] = (unsigned)(Ra * lda + C) * 2u; voffB[i] = (unsigned)(Rb * K + C) * 2u; }
    const size_t kstep = (size_t)(BK * 2);
    const size_t hstepA = (size_t)HALF * lda * 2, hstepB = (size_t)HALF * K * 2;
    const size_t tstepA = 2 * hstepA, tstepB = 2 * hstepB;
    const unsigned ldsw = (unsigned)wid * 1024u;
    const int aoff = lds_byte(wr * 64 + fr, fq * 8), boff = lds_byte(wc * 32 + fr, fq * 8);
#define PG8_SA(b, h) (((b) * 2 + (h)) * HTB)
#define PG8_SB(b, h) ((4 + (b) * 2 + (h)) * HTB)
#define PG8_STAGE(bufoff, gbase, voff) do { _Pragma("unroll") for (int _i = 0; _i < 2; ++_i) \
        __builtin_amdgcn_global_load_lds((const unsigned*)((const char*)(gbase) + (voff)[_i]), (PG8_LAS unsigned*)(lds + (bufoff) + ldsw + _i * 8192), 16, 0, 0); } while (0)
#define PG8_LDA(dst, b, h) do { _Pragma("unroll") for (int m = 0; m < 4; ++m) _Pragma("unroll") for (int k = 0; k < 2; ++k) dst[m][k] = *(const PG8_LAS bf16x8*)(lds + PG8_SA(b, h) + aoff + m * 2048 + k * 1024); } while (0)
#define PG8_LDB(dst, b, h) do { _Pragma("unroll") for (int n = 0; n < 2; ++n) _Pragma("unroll") for (int k = 0; k < 2; ++k) dst[n][k] = *(const PG8_LAS bf16x8*)(lds + PG8_SB(b, h) + boff + n * 2048 + k * 1024); } while (0)
#define PG8_MMA(ai, bj, At, Bt) do { __builtin_amdgcn_s_setprio(1); _Pragma("unroll") for (int m = 0; m < 4; ++m) _Pragma("unroll") for (int n = 0; n < 2; ++n) _Pragma("unroll") for (int k = 0; k < 2; ++k) \
        acc[ai][bj][m][n] = __builtin_amdgcn_mfma_f32_16x16x32_bf16(Bt[n][k], At[m][k], acc[ai][bj][m][n], 0, 0, 0); __builtin_amdgcn_s_setprio(0); } while (0)
#define PG8_WAIT_V(n) asm volatile("s_waitcnt vmcnt(" #n ")" ::: "memory")
#define PG8_WAIT_L(n) asm volatile("s_waitcnt lgkmcnt(" #n ")" ::: "memory")
#define PG8_BAR __builtin_amdgcn_s_barrier()
#define PG8_SCHED __builtin_amdgcn_sched_barrier(0)
    Unit cur, nxt; int ui = 0;
    if (!S.next(0, cur)) return;
    f32x4 acc[2][2][4][2];
#pragma unroll
    for (int a = 0; a < 2; ++a)
#pragma unroll
        for (int b = 0; b < 2; ++b)
#pragma unroll
            for (int m = 0; m < 4; ++m)
#pragma unroll
                for (int n = 0; n < 2; ++n) acc[a][b][m][n] = (f32x4){0.f, 0.f, 0.f, 0.f};
    bf16x8 At[4][2], B0[2][2], B1[2][2];
    const char* cA = (const char*)g.A + (size_t)cur.pm * tstepA; const char* cB = (const char*)g.Bt + (size_t)cur.pn * tstepB;
    S.a_ready(cur);
    epi_prefetch(E, cur, 0);
    if constexpr (SP2) {
        PG8_STAGE(PG8_SB(0, 0), cB, voffB); PG8_STAGE(PG8_SB(0, 1), cB + hstepB, voffB); PG8_STAGE(PG8_SA(0, 0), cA, voffA); PG8_STAGE(PG8_SA(0, 1), cA + hstepA, voffA);
        if (wr == 1) PG8_BAR;
        PG8_WAIT_V(2); PG8_BAR;
        PG8_STAGE(PG8_SB(1, 0), cB + kstep, voffB); PG8_STAGE(PG8_SA(1, 0), cA + kstep, voffA); PG8_STAGE(PG8_SB(1, 1), cB + hstepB + kstep, voffB);
        PG8_WAIT_V(6); PG8_BAR;
    } else {
        PG8_STAGE(PG8_SB(0, 0), cB, voffB); PG8_STAGE(PG8_SA(0, 0), cA, voffA); PG8_STAGE(PG8_SB(0, 1), cB + hstepB, voffB); PG8_STAGE(PG8_SA(0, 1), cA + hstepA, voffA);
        if (wr == 1) PG8_BAR;
        PG8_WAIT_V(4); PG8_BAR;
        PG8_STAGE(PG8_SB(1, 0), cB + kstep, voffB); PG8_STAGE(PG8_SA(1, 0), cA + kstep, voffA); PG8_STAGE(PG8_SB(1, 1), cB + hstepB + kstep, voffB);
        PG8_WAIT_V(6); PG8_BAR;
    }
    for (;;) {
        const bool has_next = S.next(ui + 1, nxt);
        const char* nA = has_next ? (const char*)g.A + (size_t)nxt.pm * tstepA : cA; const char* nB = has_next ? (const char*)g.Bt + (size_t)nxt.pn * tstepB : cB;
        for (int t = 0; t < nt; t += 2) {
            const bool last = (t == nt - 2);
            const char* a1 = cA + (size_t)(t + 1) * kstep;
            const char* a2 = last ? nA : cA + (size_t)(t + 2) * kstep; const char* b2 = last ? nB : cB + (size_t)(t + 2) * kstep;
            const char* a3 = a2 + kstep; const char* b3 = b2 + kstep;
            if (last && has_next) S.a_ready(nxt);
            if constexpr (SP2) {
            PG8_LDB(B0, 0, 0); PG8_LDB(B1, 0, 1); PG8_SCHED; PG8_LDA(At, 0, 0); PG8_STAGE(PG8_SA(1, 1), a1 + hstepA, voffA);
            PG8_WAIT_V(8); PG8_WAIT_L(0); PG8_BAR; PG8_MMA(0, 0, At, B0); PG8_MMA(0, 1, At, B1); PG8_BAR; PG8_SCHED;
            PG8_LDA(At, 0, 1); PG8_STAGE(PG8_SB(0, 0), b2, voffB); PG8_STAGE(PG8_SB(0, 1), b2 + hstepB, voffB); PG8_STAGE(PG8_SA(0, 0), a2, voffA);
            PG8_WAIT_V(8); PG8_WAIT_L(0); PG8_BAR; PG8_MMA(1, 0, At, B0); PG8_MMA(1, 1, At, B1); PG8_BAR; PG8_SCHED;
            PG8_LDB(B0, 1, 0); PG8_LDB(B1, 1, 1); PG8_SCHED; PG8_LDA(At, 1, 0); PG8_STAGE(PG8_SA(0, 1), a2 + hstepA, voffA);
            PG8_WAIT_V(8); PG8_WAIT_L(0); PG8_BAR; PG8_MMA(0, 0, At, B0); PG8_MMA(0, 1, At, B1); PG8_BAR; PG8_SCHED;
            PG8_LDA(At, 1, 1); PG8_STAGE(PG8_SB(1, 0), b3, voffB); PG8_STAGE(PG8_SB(1, 1), b3 + hstepB, voffB); PG8_STAGE(PG8_SA(1, 0), a3, voffA);
            PG8_WAIT_V(8); PG8_WAIT_L(0); PG8_BAR; PG8_MMA(1, 0, At, B0); PG8_MMA(1, 1, At, B1); PG8_BAR; PG8_SCHED;
            } else {
            PG8_LDB(B0, 0, 0); PG8_SCHED; PG8_LDA(At, 0, 0); PG8_STAGE(PG8_SA(1, 1), a1 + hstepA, voffA);
            PG8_WAIT_L(8); PG8_BAR; PG8_WAIT_L(0); PG8_MMA(0, 0, At, B0); PG8_BAR; PG8_SCHED;
            PG8_LDB(B1, 0, 1); PG8_STAGE(PG8_SB(0, 0), b2, voffB);
            PG8_BAR; PG8_WAIT_L(0); PG8_MMA(0, 1, At, B1); PG8_BAR;
            PG8_LDA(At, 0, 1); PG8_STAGE(PG8_SA(0, 0), a2, voffA);
            PG8_BAR; PG8_WAIT_L(0); PG8_MMA(1, 0, At, B0); PG8_BAR; PG8_SCHED;
            PG8_STAGE(PG8_SB(0, 1), b2 + hstepB, voffB);
            PG8_WAIT_V(6); PG8_BAR; PG8_MMA(1, 1, At, B1); PG8_BAR;
            PG8_LDB(B0, 1, 0); PG8_SCHED; PG8_LDA(At, 1, 0); PG8_STAGE(PG8_SA(0, 1), a2 + hstepA, voffA);
            PG8_WAIT_L(8); PG8_BAR; PG8_WAIT_L(0); PG8_MMA(0, 0, At, B0); PG8_BAR; PG8_SCHED;
            PG8_LDB(B1, 1, 1); PG8_STAGE(PG8_SB(1, 0), b3, voffB);
            PG8_BAR; PG8_WAIT_L(0); PG8_MMA(0, 1, At, B1); PG8_BAR;
            PG8_LDA(At, 1, 1); PG8_STAGE(PG8_SA(1, 0), a3, voffA);
            PG8_BAR; PG8_WAIT_L(0); PG8_MMA(1, 0, At, B0); PG8_BAR; PG8_SCHED;
            PG8_STAGE(PG8_SB(1, 1), b3 + hstepB, voffB);
            PG8_WAIT_V(6); PG8_BAR; PG8_MMA(1, 1, At, B1); PG8_BAR;
            }
        }
        if constexpr (ALIGN_EPI) { if (wr == 0) PG8_BAR; }
        E(acc, cur, wr, wc, fr, fq); S.done(cur);
        if (!has_next) break;
#pragma unroll
        for (int a = 0; a < 2; ++a)
#pragma unroll
            for (int b = 0; b < 2; ++b)
#pragma unroll
                for (int m = 0; m < 4; ++m)
#pragma unroll
                    for (int n = 0; n < 2; ++n) acc[a][b][m][n] = (f32x4){0.f, 0.f, 0.f, 0.f};
        cur = nxt; cA = nA; cB = nB; ++ui;
        epi_prefetch(E, cur, 0);
        if constexpr (ALIGN_EPI) { if (wr == 1) PG8_BAR; }
    }
    PG8_WAIT_V(0);
    if constexpr (!ALIGN_EPI) { if (wr == 0) PG8_BAR; }
    PG8_BAR;
#undef PG8_SA
#undef PG8_SB
#undef PG8_STAGE
#undef PG8_LDA
#undef PG8_LDB
#undef PG8_MMA
#undef PG8_WAIT_V
#undef PG8_WAIT_L
#undef PG8_BAR
#undef PG8_SCHED
}
}

constexpr int NB = 4, SEQ = 8192, DM = 1024, TT = NB * SEQ, CTXL = 256, TC = NB * CTXL, FF = 2816, NH = 16, HD = 64, GW = 64, GROWS = SEQ / GW;
constexpr int WH = 8, WW = 16;
constexpr float EPS = 1e-6f;
constexpr int NWAVES = 8;

constexpr size_t MiB = 1u << 20;
constexpr size_t WS_CTL = 0, CTL_ZERO_BYTES = 64 * 1024;
constexpr size_t CT_BAR = 4096;
constexpr size_t CT_MODS = 64 * 1024;
constexpr size_t CT_BQKV = CT_MODS + 2 * 5 * 6144 * 4;
constexpr size_t CT_BUP0 = CT_BQKV + 5 * 3072 * 4;
constexpr size_t CT_BIN  = CT_BUP0 + 4 * 5632 * 4;
constexpr size_t CT_BUP1 = CT_BIN + 4 * 3072 * 4;
constexpr size_t CT_END  = CT_BUP1 + 4 * 5632 * 4;
static_assert(CT_END <= 1 * MiB, "ctl region");
constexpr size_t SM_SSQ0 = 1 * MiB, SM_SSQC = SM_SSQ0 + 32768 * 4, SM_GN = SM_SSQC + 1024 * 4;
constexpr size_t WS_SSQP = 2 * MiB;
constexpr size_t WS_FSQP = 4 * MiB;
constexpr size_t WS_XB = 448 * MiB;
constexpr size_t WS_WQKV = 8 * MiB, WS_WO = 14 * MiB, WS_WUP0 = 16 * MiB, WS_WDN0 = 27 * MiB, WS_WIN = 33 * MiB, WS_WOUT = 39 * MiB, WS_WUP1 = 41 * MiB, WS_WDN1 = 52 * MiB;
constexpr size_t WS_XSC = 58 * MiB, WS_KC = 60 * MiB, WS_VC = 62 * MiB;
constexpr size_t WS_XS = 64 * MiB;
constexpr size_t WS_Q = 128 * MiB, WS_K = 192 * MiB, WS_V = 256 * MiB, WS_O = WS_Q;
constexpr size_t WS_AG = 128 * MiB;
constexpr size_t WS_HG = 308 * MiB, WS_HA = 314 * MiB;
constexpr size_t WS_UT = 128 * MiB;
constexpr size_t WS_HT = 128 * MiB;
constexpr size_t WS_F = 320 * MiB;
constexpr size_t SM_TWM = 1536 * 1024, SM_TWN = SM_TWM + 65536;
constexpr size_t WS_P = 384 * MiB;
constexpr size_t WS_END = 512 * MiB;

constexpr int RING_BYTES = 131072;
constexpr int LDS_BYTES = 163840;
constexpr int CB_LDS_OFF = 136 * 1024;
constexpr int LDSCTL_OFF = LDS_BYTES - 1024, MISC_OFF = LDSCTL_OFF + 320;

#define GAS __attribute__((address_space(1)))
#define LAS __attribute__((address_space(3)))
typedef unsigned short bf16;
typedef unsigned v4u __attribute__((ext_vector_type(4)));
typedef unsigned v2u __attribute__((ext_vector_type(2)));
typedef float f32x4 __attribute__((ext_vector_type(4)));
typedef GAS unsigned gu32;
#define RLX_AGENT __ATOMIC_RELAXED, __HIP_MEMORY_SCOPE_AGENT
#define LDS_WAIT() asm volatile("s_waitcnt lgkmcnt(0)" ::: "memory")
#define VM_WAIT() asm volatile("s_waitcnt vmcnt(0)" ::: "memory")
__device__ __forceinline__ unsigned f2bf(float f) { unsigned u = __builtin_bit_cast(unsigned, f); return (u + 0x7fffu + ((u >> 16) & 1u)) >> 16; }
__device__ __forceinline__ unsigned pk2(float lo, float hi) { unsigned r; asm("v_cvt_pk_bf16_f32 %0, %1, %2" : "=v"(r) : "v"(lo), "v"(hi)); return r; }
__device__ __forceinline__ float bf2f(unsigned short h) { return __builtin_bit_cast(float, (unsigned)h << 16); }
__device__ __forceinline__ float bflo(unsigned w) { return __builtin_bit_cast(float, w << 16); }
__device__ __forceinline__ float bfhi(unsigned w) { return __builtin_bit_cast(float, w & 0xffff0000u); }

#define FC_HD __device__ __forceinline__
typedef float cf __attribute__((ext_vector_type(2)));
FC_HD cf cmul(cf a, cf b) { const cf t = {-b.y, b.x}; return a.xx * b + a.yy * t; }
FC_HD cf cmulv(cf a, cf b) { cf r;
    asm("v_pk_mul_f32 %0, %1, %2 op_sel:[0,0] op_sel_hi:[0,1]" : "=v"(r) : "v"(a), "v"(b));
    asm("v_pk_fma_f32 %0, %1, %2, %0 op_sel:[1,1,0] op_sel_hi:[1,0,1] neg_lo:[0,1,0]" : "+v"(r) : "v"(a), "v"(b));
    return r; }
FC_HD cf cmulv_cj(cf a, cf b) { cf r;
    asm("v_pk_mul_f32 %0, %1, %2 op_sel:[0,0] op_sel_hi:[0,1] neg_hi:[1,0]" : "=v"(r) : "v"(a), "v"(b));
    asm("v_pk_fma_f32 %0, %1, %2, %0 op_sel:[1,1,0] op_sel_hi:[1,0,1] neg_lo:[0,1,0] neg_hi:[1,0,0]" : "+v"(r) : "v"(a), "v"(b));
    return r; }
FC_HD cf cadd(cf a, cf b) { return a + b; }
FC_HD cf csub(cf a, cf b) { return a - b; }
FC_HD cf cconj(cf a) { cf r; r.x = a.x; r.y = -a.y; return r; }
FC_HD cf cmulnegi(cf a) { cf r; asm("v_pk_mul_f32 %0, %1, 1.0 op_sel:[1,0] op_sel_hi:[0,0] neg_hi:[1,0]" : "=v"(r) : "v"(a)); return r; }
#define FC_OPAQUE(x) asm volatile("" : "+v"(x))
#define FC_PIDX(i) ((i) + (((i) >> 6) << 3))
#define FC_M 8192
#define FC_PADM (FC_M + FC_M / 8)
#define FC_S2 0.70710678118654752f
FC_HD cf cadd_mnegi(cf x, cf y) { cf r; asm("v_pk_add_f32 %0, %1, %2 op_sel:[0,1] op_sel_hi:[1,0] neg_hi:[0,1]" : "=v"(r) : "v"(x), "v"(y)); return r; }
FC_HD cf csub_mnegi(cf x, cf y) { cf r; asm("v_pk_add_f32 %0, %1, %2 op_sel:[0,1] op_sel_hi:[1,0] neg_lo:[0,1]" : "=v"(r) : "v"(x), "v"(y)); return r; }
template <bool R2> FC_HD void dft4r(cf& a0, cf& a1, cf& a2, cf& a3) {
    const cf c0 = R2 ? cadd_mnegi(a0, a2) : cadd(a0, a2), d0 = R2 ? csub_mnegi(a0, a2) : csub(a0, a2), c1 = cadd(a1, a3), t = csub(a1, a3);
    a0 = cadd(c0, c1); a1 = cadd_mnegi(d0, t); a2 = csub(c0, c1); a3 = csub_mnegi(d0, t);
}
FC_HD void dft4(cf& a0, cf& a1, cf& a2, cf& a3) {
    const cf c0 = cadd(a0, a2), c1 = cadd(a1, a3), d0 = csub(a0, a2), t = csub(a1, a3);
    a0 = cadd(c0, c1); a1 = cadd_mnegi(d0, t); a2 = csub(c0, c1); a3 = csub_mnegi(d0, t);
}
template <bool R4> FC_HD void dft8r(cf* v) {
    cf a0 = R4 ? cadd_mnegi(v[0], v[4]) : cadd(v[0], v[4]), a1 = cadd(v[1], v[5]), a2 = cadd(v[2], v[6]), a3 = cadd(v[3], v[7]);
    cf b0 = R4 ? csub_mnegi(v[0], v[4]) : csub(v[0], v[4]), b1 = csub(v[1], v[5]), b2 = csub(v[2], v[6]), b3 = csub(v[3], v[7]);
    { const cf w = {FC_S2, -FC_S2}; b1 = cmul(b1, w); }
    { const cf w = {-FC_S2, -FC_S2}; b3 = cmul(b3, w); }
    dft4(a0, a1, a2, a3); dft4r<true>(b0, b1, b2, b3);
    v[0] = a0; v[2] = a1; v[4] = a2; v[6] = a3; v[1] = b0; v[3] = b1; v[5] = b2; v[7] = b3;
}
FC_HD void dft8(cf* v) { dft8r<false>(v); }
template <bool R8> FC_HD void dft16r(cf* v) {
    cf a[8], b[8];
    const float c1 = 0.92387953251128674f, s1 = 0.38268343236508977f;
#ifdef __HIP_DEVICE_COMPILE__
#pragma unroll
#endif
    for (int i = 0; i < 8; ++i) { a[i] = (R8 && i == 0) ? cadd_mnegi(v[0], v[8]) : cadd(v[i], v[i + 8]); b[i] = (R8 && i == 0) ? csub_mnegi(v[0], v[8]) : csub(v[i], v[i + 8]); }
    { cf w; w.x = c1; w.y = -s1; b[1] = cmul(b[1], w); }
    { cf w; w.x = FC_S2; w.y = -FC_S2; b[2] = cmul(b[2], w); }
    { cf w; w.x = s1; w.y = -c1; b[3] = cmul(b[3], w); }
    { cf w; w.x = -s1; w.y = -c1; b[5] = cmul(b[5], w); }
    { cf w; w.x = -FC_S2; w.y = -FC_S2; b[6] = cmul(b[6], w); }
    { cf w; w.x = -c1; w.y = -s1; b[7] = cmul(b[7], w); }
    dft8(a); dft8r<true>(b);
#ifdef __HIP_DEVICE_COMPILE__
#pragma unroll
#endif
    for (int i = 0; i < 8; ++i) { v[2 * i] = a[i]; v[2 * i + 1] = b[i]; }
}
FC_HD void dft16(cf* v) { dft16r<false>(v); }
template <int R> FC_HD void cpowers(cf w1, cf* w) {
    w[0].x = 1.f; w[0].y = 0.f; w[1] = w1;
#ifdef __HIP_DEVICE_COMPILE__
#pragma unroll
#endif
    for (int q = 2; q < R; ++q) w[q] = (q & 1) ? cmul(w[q - 1], w1) : cmul(w[q >> 1], w[q >> 1]);
}
template <class LP> FC_HD void fwd_pass1(cf* v, int tid, LP a, const cf* TWM) {
    dft16(v);
    FC_OPAQUE(tid);
    const cf w1 = TWM[tid]; cf cur = w1;
    const int pt = FC_PIDX(tid);
    a[pt] = v[0];
#ifdef __HIP_DEVICE_COMPILE__
#pragma unroll
#endif
    for (int q = 1; q < 16; ++q) { a[pt + 576 * q] = cmul(v[q], cur); cur = cmul(cur, w1); }
}
template <class LP> FC_HD void fwd_pass8(int tid, LP a, const cf* TWM, int s, int lgs) {
#pragma unroll 1
    for (int h = 0; h < 2; ++h) {
        FC_OPAQUE(tid);
        const int bf = tid + 512 * h, j = bf & (s - 1), base = (bf >> lgs) * 8 * s;
        const int pb = FC_PIDX(base + j), ps = (s == 64) ? 72 : 8;
        cf v[8];
#ifdef __HIP_DEVICE_COMPILE__
#pragma unroll
#endif
        for (int r = 0; r < 8; ++r) v[r] = a[pb + ps * r];
        dft8(v);
        const cf w1 = TWM[j]; cf cur = w1;
        a[pb] = v[0];
#ifdef __HIP_DEVICE_COMPILE__
#pragma unroll
#endif
        for (int q = 1; q < 8; ++q) { a[pb + ps * q] = cmul(v[q], cur); cur = cmul(cur, w1); }
    }
}
template <class LP> FC_HD void mid_pass(int tid, LP a, const cf* F, cf* Fout, float fscale) {
#pragma unroll 1
    for (int h = 0; h < 2; ++h) {
        FC_OPAQUE(tid);
        const int bf = tid + 512 * h, base = bf * 8, pb = FC_PIDX(base);
        cf v[8];
#ifdef __HIP_DEVICE_COMPILE__
#pragma unroll
#endif
        for (int r = 0; r < 8; ++r) v[r] = a[pb + r];
        dft8(v);
        if (F) {
#ifdef __HIP_DEVICE_COMPILE__
#pragma unroll
#endif
            for (int r = 0; r < 8; ++r) v[r] = cconj(cmul(v[r], F[base + r]));
            dft8(v);
#ifdef __HIP_DEVICE_COMPILE__
#pragma unroll
#endif
            for (int r = 0; r < 8; ++r) a[pb + r] = v[r];
        } else {
#ifdef __HIP_DEVICE_COMPILE__
#pragma unroll
#endif
            for (int r = 0; r < 8; ++r) { cf o; o.x = v[r].x * fscale; o.y = v[r].y * fscale; Fout[base + r] = o; }
        }
    }
}
template <class LP> FC_HD void mid_pass_reg(int tid, LP a, const cf* fr) {
#ifdef __HIP_DEVICE_COMPILE__
#pragma unroll
#endif
    for (int h = 0; h < 2; ++h) {
        FC_OPAQUE(tid);
        const int bf = tid + 512 * h, base = bf * 8, pb = FC_PIDX(base);
        cf v[8];
#ifdef __HIP_DEVICE_COMPILE__
#pragma unroll
#endif
        for (int r = 0; r < 8; ++r) v[r] = a[pb + r];
        dft8(v);
#ifdef __HIP_DEVICE_COMPILE__
#pragma unroll
#endif
        for (int r = 0; r < 8; ++r) v[r] = cconj(cmul(v[r], fr[h * 8 + r]));
        dft8(v);
#ifdef __HIP_DEVICE_COMPILE__
#pragma unroll
#endif
        for (int r = 0; r < 8; ++r) a[pb + r] = v[r];
    }
}
template <class LP> FC_HD void inv_pass8(int tid, LP a, const cf* TWM, int s, int lgs) {
#pragma unroll 1
    for (int h = 0; h < 2; ++h) {
        FC_OPAQUE(tid);
        const int bf = tid + 512 * h, j = bf & (s - 1), base = (bf >> lgs) * 8 * s;
        const int pb = FC_PIDX(base + j), ps = (s == 64) ? 72 : 8;
        cf v[8]; const cf w1 = TWM[j]; cf cur = w1;
        v[0] = a[FC_PIDX(base + j)];
#ifdef __HIP_DEVICE_COMPILE__
#pragma unroll
#endif
        for (int q = 1; q < 8; ++q) { v[q] = cmul(a[pb + ps * q], cur); cur = cmul(cur, w1); }
        dft8(v);
#ifdef __HIP_DEVICE_COMPILE__
#pragma unroll
#endif
        for (int r = 0; r < 8; ++r) a[pb + ps * r] = v[r];
    }
}
template <class LP> FC_HD void inv_pass1(cf* v, int tid, LP a, const cf* TWM) {
    FC_OPAQUE(tid);
    const cf w1 = TWM[tid]; cf cur = w1;
    const int pt = FC_PIDX(tid);
    v[0] = a[pt];
#ifdef __HIP_DEVICE_COMPILE__
#pragma unroll
#endif
    for (int q = 1; q < 16; ++q) { v[q] = cmul(a[pt + 576 * q], cur); cur = cmul(cur, w1); }
    dft16(v);
}

#define F2_PIDX(i) ((i) + ((i) >> 5))
#define F2_PADM (8192 + 256)
FC_HD void dft32(cf* v) {
    const float c[16] = {1.0f, 0.98078528040323043f, 0.92387953251128674f, 0.83146961230254524f, 0.70710678118654752f, 0.55557023301960218f, 0.38268343236508977f, 0.19509032201612825f,
                         0.0f, -0.19509032201612825f, -0.38268343236508977f, -0.55557023301960218f, -0.70710678118654752f, -0.83146961230254524f, -0.92387953251128674f, -0.98078528040323043f};
    const float s[16] = {0.0f, 0.19509032201612825f, 0.38268343236508977f, 0.55557023301960218f, 0.70710678118654752f, 0.83146961230254524f, 0.92387953251128674f, 0.98078528040323043f,
                         1.0f, 0.98078528040323043f, 0.92387953251128674f, 0.83146961230254524f, 0.70710678118654752f, 0.55557023301960218f, 0.38268343236508977f, 0.19509032201612825f};
#ifdef __HIP_DEVICE_COMPILE__
#pragma unroll
#endif
    for (int i = 0; i < 16; ++i) { const cf a = cadd(v[i], v[i + 16]); cf b = csub(v[i], v[i + 16]);
        if (i != 0 && i != 8) { cf w; w.x = c[i]; w.y = -s[i]; b = cmul(b, w); }
        v[i] = a; v[i + 16] = b; }
    dft16(v); dft16r<true>(v + 16);
}
#define F2_Q(k) (2 * ((k) & 15) + ((k) >> 4))
template <class LP> FC_HD void f2_fwd_p1(cf* v, int tid, LP a, const cf* tw1) {
    dft16(v);
    FC_OPAQUE(tid);
    const cf w1 = tw1[tid]; cf cur = w1;
    const int pt = F2_PIDX(tid);
    a[pt] = v[0];
#ifdef __HIP_DEVICE_COMPILE__
#pragma unroll
#endif
    for (int q = 1; q < 16; ++q) { a[pt + 528 * q] = cmulv(v[q], cur); cur = cmulv(cur, w1); }
}
template <class LP> FC_HD void f2_fwd_p2(int tid, LP a, const cf* tw32) {
    FC_OPAQUE(tid);
    const int j = tid & 31, pb = F2_PIDX((tid >> 5) * 512 + j);
    cf v[16];
#ifdef __HIP_DEVICE_COMPILE__
#pragma unroll
#endif
    for (int r = 0; r < 16; ++r) v[r] = a[pb + 33 * r];
    dft16(v);
    const cf w1 = tw32[j]; cf cur = w1;
    a[pb] = v[0];
#ifdef __HIP_DEVICE_COMPILE__
#pragma unroll
#endif
    for (int q = 1; q < 16; ++q) { a[pb + 33 * q] = cmulv(v[q], cur); cur = cmulv(cur, w1); }
}
template <class LP> FC_HD void f2_fwd_p2_dual(int tid, LP a, LP b, const cf* tw32) {
    FC_OPAQUE(tid);
    const int j = tid & 31, pb = F2_PIDX((tid >> 5) * 512 + j);
    cf v[16], w[16];
#ifdef __HIP_DEVICE_COMPILE__
#pragma unroll
#endif
    for (int r = 0; r < 16; ++r) v[r] = a[pb + 33 * r];
#ifdef __HIP_DEVICE_COMPILE__
#pragma unroll
#endif
    for (int r = 0; r < 16; ++r) w[r] = b[pb + 33 * r];
    const cf w1 = tw32[j];
    dft16(v);
    { cf cur = w1; a[pb] = v[0];
#ifdef __HIP_DEVICE_COMPILE__
#pragma unroll
#endif
      for (int q = 1; q < 16; ++q) { a[pb + 33 * q] = cmulv(v[q], cur); cur = cmulv(cur, w1); } }
    dft16(w);
    { cf cur = w1; b[pb] = w[0];
#ifdef __HIP_DEVICE_COMPILE__
#pragma unroll
#endif
      for (int q = 1; q < 16; ++q) { b[pb + 33 * q] = cmulv(w[q], cur); cur = cmulv(cur, w1); } }
}
template <class LP> FC_HD void f2_inv_p2_dual(int tid, LP a, LP b, const cf* tw32) {
    FC_OPAQUE(tid);
    const int j = tid & 31, pb = F2_PIDX((tid >> 5) * 512 + j);
    cf v[16], w[16]; const cf w1 = tw32[j];
#ifdef __HIP_DEVICE_COMPILE__
#pragma unroll
#endif
    for (int r = 0; r < 16; ++r) v[r] = a[pb + 33 * r];
#ifdef __HIP_DEVICE_COMPILE__
#pragma unroll
#endif
    for (int r = 0; r < 16; ++r) w[r] = b[pb + 33 * r];
    { cf cur = w1;
#ifdef __HIP_DEVICE_COMPILE__
#pragma unroll
#endif
      for (int q = 1; q < 16; ++q) { v[q] = cmulv(v[q], cur); cur = cmulv(cur, w1); } }
    dft16(v);
#ifdef __HIP_DEVICE_COMPILE__
#pragma unroll
#endif
    for (int r = 0; r < 16; ++r) a[pb + 33 * r] = v[r];
    { cf cur = w1;
#ifdef __HIP_DEVICE_COMPILE__
#pragma unroll
#endif
      for (int q = 1; q < 16; ++q) { w[q] = cmulv(w[q], cur); cur = cmulv(cur, w1); } }
    dft16(w);
#ifdef __HIP_DEVICE_COMPILE__
#pragma unroll
#endif
    for (int r = 0; r < 16; ++r) b[pb + 33 * r] = w[r];
}
template <class LP> FC_HD void f2_mid(int bf, LP a, const cf* fr, cf* Fout, float fscale) {
    FC_OPAQUE(bf);
    const int pb = 33 * bf;
    cf v[32];
#ifdef __HIP_DEVICE_COMPILE__
#pragma unroll
#endif
    for (int i = 0; i < 32; ++i) v[i] = a[pb + i];
    dft32(v);
    if (fr) {
        cf w[32];
#ifdef __HIP_DEVICE_COMPILE__
#pragma unroll
#endif
        for (int k = 0; k < 32; ++k) w[F2_Q(k)] = cconj(cmul(v[k], fr[F2_Q(k)]));
        dft32(w);
#ifdef __HIP_DEVICE_COMPILE__
#pragma unroll
#endif
        for (int k = 0; k < 32; ++k) a[pb + F2_Q(k)] = w[k];
    } else {
#ifdef __HIP_DEVICE_COMPILE__
#pragma unroll
#endif
        for (int k = 0; k < 32; ++k) { cf o; o.x = v[k].x * fscale; o.y = v[k].y * fscale; Fout[F2_Q(k) * 256 + bf] = o; }
    }
}
typedef _Float16 h2v __attribute__((ext_vector_type(2)));
FC_HD unsigned pkh2(cf a) { h2v v; v.x = (_Float16)a.x; v.y = (_Float16)a.y; return __builtin_bit_cast(unsigned, v); }
FC_HD cf unh2(unsigned u) { const h2v v = __builtin_bit_cast(h2v, u); cf r; r.x = (float)v.x; r.y = (float)v.y; return r; }
template <class LP> FC_HD void f2_mid_store16(int bf, LP a, v2u* Fout) {
    FC_OPAQUE(bf);
    const int pb = 33 * bf;
    cf v[32];
#pragma unroll
    for (int i = 0; i < 32; ++i) v[i] = a[pb + i];
    dft32(v);
#pragma unroll
    for (int k = 0; k < 16; ++k) { v2u o; o.x = pkh2(v[k]); o.y = pkh2(v[k + 16]); Fout[k * 256 + bf] = o; }
}
template <class LP> FC_HD void f2_mid16(int bf, LP a, const v2u* fr16) {
    FC_OPAQUE(bf);
    const int pb = 33 * bf;
    cf v[32];
#pragma unroll
    for (int i = 0; i < 32; ++i) v[i] = a[pb + i];
    dft32(v);
    cf w[32];
#pragma unroll
    for (int k = 0; k < 32; ++k) w[F2_Q(k)] = cmulv_cj(v[k], unh2(k < 16 ? fr16[k & 15].x : fr16[k & 15].y));
    dft32(w);
#pragma unroll
    for (int k = 0; k < 32; ++k) a[pb + F2_Q(k)] = w[k];
}
template <class LP> FC_HD void f2_inv_p2(int tid, LP a, const cf* tw32) {
    FC_OPAQUE(tid);
    const int j = tid & 31, pb = F2_PIDX((tid >> 5) * 512 + j);
    cf v[16]; const cf w1 = tw32[j]; cf cur = w1;
    v[0] = a[pb];
#ifdef __HIP_DEVICE_COMPILE__
#pragma unroll
#endif
    for (int q = 1; q < 16; ++q) { v[q] = cmulv(a[pb + 33 * q], cur); cur = cmulv(cur, w1); }
    dft16(v);
#ifdef __HIP_DEVICE_COMPILE__
#pragma unroll
#endif
    for (int r = 0; r < 16; ++r) a[pb + 33 * r] = v[r];
}
template <class LP> FC_HD void f2_inv_p1(cf* v, int tid, LP a, const cf* tw1) {
    FC_OPAQUE(tid);
    const cf w1 = tw1[tid]; cf cur = w1;
    const int pt = F2_PIDX(tid);
    v[0] = a[pt];
#ifdef __HIP_DEVICE_COMPILE__
#pragma unroll
#endif
    for (int q = 1; q < 16; ++q) { v[q] = cmulv(a[pt + 528 * q], cur); cur = cmulv(cur, w1); }
    dft16(v);
}

#define XB_TMO      128
#define XB_XCNT(j)  (256  + 64 * (j))
#define XB_XSUB(j)  (1280 + 64 * (j))
#define XB_XGEN(j)  (2304 + 64 * (j))
#define XB_TOP      3328
#define XB_TOPGEN   3392
#define XCD_BAR_WORDS 3456
#define XB_SPIN_CAP (1u << 18)
__device__ __forceinline__ unsigned xb_ld(unsigned* p)              { return __hip_atomic_load(p, __ATOMIC_RELAXED, __HIP_MEMORY_SCOPE_AGENT); }
__device__ __forceinline__ unsigned xb_add(unsigned* p, unsigned v) { return __hip_atomic_fetch_add(p, v, __ATOMIC_RELAXED, __HIP_MEMORY_SCOPE_AGENT); }
__device__ __forceinline__ unsigned xb_xcc_id() { return (unsigned)__builtin_amdgcn_s_getreg((3 << 11) | 20) & 0xFu; }
#define XB_SPIN(cond, bar) do { unsigned _sp = 0; while (cond) { __builtin_amdgcn_s_sleep(1); \
    if ((++_sp & 255u) == 0u) { if (xb_ld(&(bar)[XB_TMO])) break; if (_sp > XB_SPIN_CAP) { atomicAdd(&(bar)[XB_TMO], 1u); break; } } } } while (0)
struct XcdBarrier { unsigned* bar; unsigned x; volatile LAS unsigned* st; };
__device__ __forceinline__ XcdBarrier xcd_barrier_post(unsigned* bar, volatile LAS unsigned* st) {
    XcdBarrier b; b.bar = bar; b.x = xb_xcc_id(); b.st = st;
    if (threadIdx.x == 0) (void)xb_add(&bar[XB_XCNT(b.x)], 1u);
    return b;
}
__device__ __forceinline__ void xcd_barrier_complete(unsigned* bar, unsigned x, unsigned& nloc, unsigned& nx) {
    const unsigned G = gridDim.x * gridDim.y * gridDim.z;
    unsigned sum, cnt, mine, sp = 0u;
    for (;;) {
        sum = 0u; cnt = 0u; mine = 0u;
#pragma unroll
        for (unsigned j = 0; j < 16; ++j) { const unsigned c = xb_ld(&bar[XB_XCNT(j)]); sum += c; cnt += (c > 0u) ? 1u : 0u; mine = (j == x) ? c : mine; }
        if (sum == G) break;
        __builtin_amdgcn_s_sleep(1);
        if ((++sp & 255u) == 0u) { if (xb_ld(&bar[XB_TMO])) break; if (sp > XB_SPIN_CAP) { atomicAdd(&bar[XB_TMO], 1u); break; } }
    }
    nloc = mine > 0u ? mine : 1u; nx = cnt > 0u ? cnt : 1u;
}
__device__ __forceinline__ void xcd_barrier(const XcdBarrier& b) {
    asm volatile("s_waitcnt vmcnt(0)" ::: "memory");
    __syncthreads();
    if (threadIdx.x == 0) {
        unsigned* bar = b.bar;
        __builtin_amdgcn_s_waitcnt(0);
        unsigned nloc = b.st[0], nx = b.st[1];
        if (nloc == 0u) { xcd_barrier_complete(bar, b.x, nloc, nx); b.st[0] = nloc; b.st[1] = nx; }
        const unsigned old = xb_add(&bar[XB_XSUB(b.x)], 1u);
        const unsigned gen = old / nloc;
        if (old + 1u == (gen + 1u) * nloc) {
            __builtin_amdgcn_fence(__ATOMIC_RELEASE, "agent");
            asm volatile("s_waitcnt vmcnt(0)" ::: "memory");
            const unsigned og = xb_add(&bar[XB_TOP], 1u);
            const unsigned tg = og / nx;
            if (og + 1u == (tg + 1u) * nx) xb_add(&bar[XB_TOPGEN], 1u);
            else XB_SPIN(xb_ld(&bar[XB_TOPGEN]) == tg, bar);
            __builtin_amdgcn_fence(__ATOMIC_ACQUIRE, "agent");
            xb_add(&bar[XB_XGEN(b.x)], 1u);
            asm volatile("s_waitcnt vmcnt(0)" ::: "memory");
        } else {
            XB_SPIN(xb_ld(&bar[XB_XGEN(b.x)]) == gen, bar);
            __builtin_amdgcn_fence(__ATOMIC_ACQUIRE, "agent");
            asm volatile("s_waitcnt vmcnt(0)" ::: "memory");
        }
    }
    __syncthreads();
}

struct Args { const float* in[40]; float* out; unsigned char* ws; int ph_lo, ph_hi, repmask, li; };
struct Frame {
    LAS unsigned char* lds;
    int tid, lane, wave, vcu, G;
    const float* const* in; float* out; unsigned char* ws;
#ifdef PROBE_SEC
    unsigned long long sec;
#endif
};
__device__ __forceinline__ float wave_sum(float v) {
#pragma unroll
    for (int o = 1; o < 64; o <<= 1) v += __shfl_xor(v, o);
    return v;
}
__device__ __forceinline__ float silu_f(float x) { return x / (1.f + __expf(-x)); }

__device__ __forceinline__ float gelu_f(float v) { return 0.5f * v * (1.f + erff(v * 0.70710678118654752f)); }

__device__ __forceinline__ void transpose_item(const float* W, int K, int N, bf16* WT, int src_col0, int dst_row0, int k0, LAS float* scr, int lane) {
    {
        const int r8 = lane >> 3, c4 = (lane & 7) * 4;
        f32x4 x[8];
#pragma unroll
        for (int i = 0; i < 8; ++i) x[i] = *(const f32x4*)(W + (size_t)(k0 + 8 * i + r8) * N + src_col0 + c4);
#pragma unroll
        for (int i = 0; i < 8; ++i) { LAS float* d = scr + (8 * i + r8) * 33 + c4; d[0] = x[i].x; d[1] = x[i].y; d[2] = x[i].z; d[3] = x[i].w; }
    }
    LDS_WAIT(); asm volatile("" ::: "memory");
    const int c = lane & 7;
#pragma unroll
    for (int j = 0; j < 4; ++j) { const int n = (lane >> 3) + 8 * j; const LAS float* s = scr + (8 * c) * 33 + n;
        v4u o; o.x = pk2(s[0 * 33], s[1 * 33]); o.y = pk2(s[2 * 33], s[3 * 33]); o.z = pk2(s[4 * 33], s[5 * 33]); o.w = pk2(s[6 * 33], s[7 * 33]);
        *(GAS v4u*)(WT + (size_t)(dst_row0 + n) * K + k0 + 8 * c) = o; }
    LDS_WAIT(); asm volatile("" ::: "memory");
}
__device__ __forceinline__ void transpose_load(const float* W, int N, int src_col0, int k0, int lane, f32x4 (&x)[8]) {
    const int r8 = lane >> 3, c4 = (lane & 7) * 4;
#pragma unroll
    for (int i = 0; i < 8; ++i) x[i] = *(const f32x4*)(W + (size_t)(k0 + 8 * i + r8) * N + src_col0 + c4);
}
__device__ __forceinline__ void transpose_finish(const f32x4 (&x)[8], int K, bf16* WT, int dst_row0, int k0, LAS float* scr, int lane) {
    { const int r8 = lane >> 3, c4 = (lane & 7) * 4;
#pragma unroll
      for (int i = 0; i < 8; ++i) { LAS float* d = scr + (8 * i + r8) * 33 + c4; d[0] = x[i].x; d[1] = x[i].y; d[2] = x[i].z; d[3] = x[i].w; } }
    LDS_WAIT(); asm volatile("" ::: "memory");
    const int c = lane & 7;
#pragma unroll
    for (int j = 0; j < 4; ++j) { const int n = (lane >> 3) + 8 * j; const LAS float* s = scr + (8 * c) * 33 + n;
        v4u o; o.x = pk2(s[0 * 33], s[1 * 33]); o.y = pk2(s[2 * 33], s[3 * 33]); o.z = pk2(s[4 * 33], s[5 * 33]); o.w = pk2(s[6 * 33], s[7 * 33]);
        *(GAS v4u*)(WT + (size_t)(dst_row0 + n) * K + k0 + 8 * c) = o; }
    LDS_WAIT(); asm volatile("" ::: "memory");
}
__device__ __forceinline__ int qkv_slot_to_col(int slot) {
    const int part = slot >> 10, cc = slot & 1023, pnl = cc >> 8, s = cc & 255, bj = s >> 7, wc = (s & 127) >> 5, j = s & 31;
    return part * 1024 + (4 * pnl + wc) * 64 + 32 * bj + j;
}
__device__ __forceinline__ int up_slot_to_col(int slot) { const int pn = slot >> 8, bj = (slot >> 7) & 1, cc = slot & 127; return bj * FF + pn * 128 + cc; }
__device__ __forceinline__ void cvt_weight_item(const float* W, int K, int N, bf16* WT, int item, LAS float* scr, int lane, int perm) {
    const int nblk = N / 32, kb = item / nblk, nb = item % nblk;
    const int dst = 32 * nb, src = perm == 1 ? qkv_slot_to_col(dst) : (perm == 2 ? up_slot_to_col(dst) : dst);
    transpose_item(W, K, N, WT, src, dst, 64 * kb, scr, lane);
}

template <int R, class VF>
__device__ __forceinline__ void gemv_det_item(const float* W, int N, int n0, float* out, int ostride, const float* addbias, const VF& vf, int tid, LAS float* scr) {
    const int col = tid & 63, ks = tid >> 6;
    float acc[R];
#pragma unroll
    for (int r = 0; r < R; ++r) acc[r] = 0.f;
    const float* wp = W + (size_t)(ks * 128) * N + n0 + col;
#pragma unroll 32
    for (int k = 0; k < 128; ++k) { const float w = wp[(size_t)k * N];
#pragma unroll
        for (int r = 0; r < R; ++r) acc[r] += vf(r, ks * 128 + k) * w; }
    __syncthreads();
#pragma unroll
    for (int r = 0; r < R; ++r) scr[(ks * R + r) * 64 + col] = acc[r];
    __syncthreads();
    if (tid < R * 64) { const int r = tid >> 6; float s = 0.f;
#pragma unroll
        for (int k2 = 0; k2 < 8; ++k2) s += scr[(k2 * R + r) * 64 + col];
        if (addbias) s += addbias[n0 + col];
        out[(size_t)r * ostride + n0 + col] = s; }
}

template <int R, class VF>
__device__ __forceinline__ void gemv_det_item16(const float* W, int N, int n0, float* out, int ostride, const float* addbias, const VF& vf, int tid, LAS float* scr) {
    const int col = tid & 15, ks = tid >> 4;
    float acc[R];
#pragma unroll
    for (int r = 0; r < R; ++r) acc[r] = 0.f;
    const float* wp = W + (size_t)(ks * 32) * N + n0 + col;
#pragma unroll 8
    for (int k = 0; k < 32; ++k) { const float w = wp[(size_t)k * N];
#pragma unroll
        for (int r = 0; r < R; ++r) acc[r] += vf(r, ks * 32 + k) * w; }
    __syncthreads();
#pragma unroll
    for (int r = 0; r < R; ++r) scr[(ks * R + r) * 16 + col] = acc[r];
    __syncthreads();
    if (tid < R * 16) { const int r = tid >> 4; float s = 0.f;
#pragma unroll
        for (int k2 = 0; k2 < 32; ++k2) s += scr[(k2 * R + r) * 16 + col];
        if (addbias) s += addbias[n0 + col];
        out[(size_t)r * ostride + n0 + col] = s; }
}

__device__ __forceinline__ void phase0a(Frame& F) {
    const float* const* in = F.in;
    float* mods = (float*)(F.ws + CT_MODS);
    {
        const float* c = in[1]; const float* cctx = in[3];
        LAS float* sl = (LAS float*)(F.lds + 65536);
        for (int e = F.tid; e < 5 * DM; e += 512) { const float v = (e < 4 * DM) ? c[e] : cctx[e - 4 * DM]; sl[e] = silu_f(v); }
        __syncthreads();
        auto vf = [&](int r, int k) -> float { return sl[r * DM + k]; };
        const int nitems = 2 * 96;
        for (int it = F.vcu; it < nitems; it += F.G) {
            const int l = it / 96, cg = it % 96;
            gemv_det_item<5>(in[l ? 17 : 4], 6144, cg * 64, mods + l * 5 * 6144, 6144, in[l ? 18 : 5], vf, F.tid, (LAS float*)F.lds);
        }
        __syncthreads();
    }
    for (int e = F.vcu * 512 + F.tid; e < 16384; e += F.G * 512) {
        const int k = e & 8191; const bool isn = e >= 8192;
        float sn, cs; sincospif(isn ? (float)k * (1.0f / 8192.0f) : (float)k * (1.0f / 4096.0f), &sn, &cs);
        cf t; t.x = cs; t.y = -sn;
        ((cf*)(F.ws + (isn ? SM_TWN : SM_TWM)))[k] = t;
    }
    LAS float* scr = (LAS float*)(F.lds + F.wave * 16384);
    const int gw = F.vcu * NWAVES + F.wave, NGW = F.G * NWAVES;
    constexpr int I_QKV = 16 * 96, I_O = 16 * 32, I_UP = 16 * 176, I_DN = 44 * 32;
    constexpr int NITEMS = 2 * I_QKV + 2 * I_O + 2 * I_UP + 2 * I_DN;
    struct CvtD { const float* W; bf16* WT; int K, N, src, dst, k0; };
    auto desc = [&](int it) -> CvtD {
        int r = it; const float* W; bf16* WT; int K, N, perm = 0;
        if (r < I_QKV) { W = in[8]; K = DM; N = 3 * DM; WT = (bf16*)(F.ws + WS_WQKV); perm = 1; }
        else if ((r -= I_QKV) < I_O) { W = in[12]; K = DM; N = DM; WT = (bf16*)(F.ws + WS_WO); }
        else if ((r -= I_O) < I_UP) { W = in[13]; K = DM; N = 2 * FF; WT = (bf16*)(F.ws + WS_WUP0); perm = 2; }
        else if ((r -= I_UP) < I_DN) { W = in[16]; K = FF; N = DM; WT = (bf16*)(F.ws + WS_WDN0); }
        else if ((r -= I_DN) < I_QKV) { W = in[21]; K = DM; N = 3 * DM; WT = (bf16*)(F.ws + WS_WIN); }
        else if ((r -= I_QKV) < I_O) { W = in[34]; K = DM; N = DM; WT = (bf16*)(F.ws + WS_WOUT); }
        else if ((r -= I_O) < I_UP) { W = in[36]; K = DM; N = 2 * FF; WT = (bf16*)(F.ws + WS_WUP1); perm = 2; }
        else { r -= I_UP; W = in[39]; K = FF; N = DM; WT = (bf16*)(F.ws + WS_WDN1); }
        const int nblk = N / 32, kb = r / nblk, nb = r % nblk, dst = 32 * nb;
        const int src = perm == 1 ? qkv_slot_to_col(dst) : (perm == 2 ? up_slot_to_col(dst) : dst);
        return CvtD{W, WT, K, N, src, dst, 64 * kb};
    };
    if (gw < NITEMS) {
        f32x4 xc[8], xn[8];
        CvtD dc = desc(gw);
        transpose_load(dc.W, dc.N, dc.src, dc.k0, F.lane, xc);
        for (int it = gw; it < NITEMS; it += NGW) {
            const CvtD dn = desc(min(it + NGW, NITEMS - 1));
            transpose_load(dn.W, dn.N, dn.src, dn.k0, F.lane, xn);
            transpose_finish(xc, dc.K, dc.WT, dc.dst, dc.k0, scr, F.lane);
#pragma unroll
            for (int i = 0; i < 8; ++i) xc[i] = xn[i];
            dc = dn;
        }
    }
}

__device__ __forceinline__ void row_prescale(const float* xrow, const float* gain, const float* sc, bf16* orow, float* ssq_out, int lane) {
    const GAS f32x4* xr = (const GAS f32x4*)xrow + lane;
    const GAS f32x4* gr = (const GAS f32x4*)gain + lane;
    const GAS f32x4* sr = (const GAS f32x4*)sc + lane;
    f32x4 v[4]; float s = 0.f;
#pragma unroll
    for (int j = 0; j < 4; ++j) { v[j] = xr[64 * j]; s += (v[j].x * v[j].x + v[j].y * v[j].y) + (v[j].z * v[j].z + v[j].w * v[j].w); }
    s = wave_sum(s);
    if (lane == 0) *ssq_out = s;
    GAS unsigned long long* o8 = (GAS unsigned long long*)orow + lane;
#pragma unroll
    for (int j = 0; j < 4; ++j) { const f32x4 g = gr[64 * j], c = sr[64 * j]; const f32x4 w = v[j] * g * (c + 1.0f);
        o8[64 * j] = (unsigned long long)pk2(w.x, w.y) | ((unsigned long long)pk2(w.z, w.w) << 32); }
}
__device__ __forceinline__ void row_prescale2(const float* xrow0, const float* xrow1, const float* gain, const float* sc0, const float* sc1, bf16* orow0, bf16* orow1,
                                              float* ssq_out0, float* ssq_out1, int lane) {
    const GAS f32x4* xr0 = (const GAS f32x4*)xrow0 + lane; const GAS f32x4* xr1 = (const GAS f32x4*)xrow1 + lane;
    const GAS f32x4* gr = (const GAS f32x4*)gain + lane;
    const GAS f32x4* sr0 = (const GAS f32x4*)sc0 + lane; const GAS f32x4* sr1 = (const GAS f32x4*)sc1 + lane;
    f32x4 v0[4], v1[4], g[4], c0[4], c1[4];
#pragma unroll
    for (int j = 0; j < 4; ++j) { v0[j] = xr0[64 * j]; v1[j] = xr1[64 * j]; }
#pragma unroll
    for (int j = 0; j < 4; ++j) { g[j] = gr[64 * j]; c0[j] = sr0[64 * j]; c1[j] = sr1[64 * j]; }
    float s0 = 0.f, s1 = 0.f;
#pragma unroll
    for (int j = 0; j < 4; ++j) { s0 += (v0[j].x * v0[j].x + v0[j].y * v0[j].y) + (v0[j].z * v0[j].z + v0[j].w * v0[j].w);
                                  s1 += (v1[j].x * v1[j].x + v1[j].y * v1[j].y) + (v1[j].z * v1[j].z + v1[j].w * v1[j].w); }
    s0 = wave_sum(s0); s1 = wave_sum(s1);
    if (lane == 0) { *ssq_out0 = s0; *ssq_out1 = s1; }
    GAS unsigned long long* o0 = (GAS unsigned long long*)orow0 + lane; GAS unsigned long long* o1 = (GAS unsigned long long*)orow1 + lane;
#pragma unroll
    for (int j = 0; j < 4; ++j) { const f32x4 w0 = v0[j] * g[j] * (c0[j] + 1.0f), w1 = v1[j] * g[j] * (c1[j] + 1.0f);
        o0[64 * j] = (unsigned long long)pk2(w0.x, w0.y) | ((unsigned long long)pk2(w0.z, w0.w) << 32);
        o1[64 * j] = (unsigned long long)pk2(w1.x, w1.y) | ((unsigned long long)pk2(w1.z, w1.w) << 32); }
}
__device__ __forceinline__ void phase0b(Frame& F) {
    const float* const* in = F.in;
    const float* mods = (const float*)(F.ws + CT_MODS);
    const int gw = F.vcu * NWAVES + F.wave, NGW = F.G * NWAVES;
    for (int m = 2 * gw; m + 1 < TT; m += 2 * NGW) { const int b = m / SEQ;
        row_prescale2(in[0] + (size_t)m * DM, in[0] + (size_t)(m + 1) * DM, in[6], mods + b * 6144 + 1024, mods + b * 6144 + 1024,
                      (bf16*)(F.ws + WS_XS) + (size_t)m * DM, (bf16*)(F.ws + WS_XS) + (size_t)(m + 1) * DM, (float*)(F.ws + SM_SSQ0) + m, (float*)(F.ws + SM_SSQ0) + m + 1, F.lane); }
    for (int mc = gw; mc < TC; mc += NGW)
        row_prescale(in[2] + (size_t)mc * DM, in[6], mods + 4 * 6144 + 1024, (bf16*)(F.ws + WS_XSC) + (size_t)mc * DM, (float*)(F.ws + SM_SSQC) + mc, F.lane);
    {
        float* gn = (float*)(F.ws + SM_GN);
        for (int e = F.vcu * 512 + F.tid; e < 3 * 4 * 1024; e += F.G * 512) {
            const int i = e / 4096, b = (e / 1024) & 3, k = e & 1023;
            const float* g = in[i == 0 ? 7 : (i == 1 ? 19 : 20)];
            const float sc = mods[(i == 0 ? 0 : 1) * 5 * 6144 + b * 6144 + (i == 1 ? 1024 : 4096) + k];
            gn[e] = g[k] * (1.f + sc);
        }
    }
    {
        LAS float* gs = (LAS float*)F.lds;
        for (int it = F.vcu; it < 192; it += F.G) { auto vf = [&](int r, int k) -> float { return mods[r * 6144 + k]; };
            gemv_det_item16<5>(in[8], 3072, it * 16, (float*)(F.ws + CT_BQKV), 3072, nullptr, vf, F.tid, gs); }
        __syncthreads();
    }
}
__device__ __forceinline__ void bias_gemv_late(Frame& F, int it) {
    const float* const* in = F.in;
    const float* mods = (const float*)(F.ws + CT_MODS);
    const int n_up = 88, n_in = 48;
    LAS float* gs = (LAS float*)F.lds;
    if (it < n_up) { auto vf = [&](int r, int k) -> float { return mods[r * 6144 + 3072 + k]; };
        gemv_det_item<4>(in[13], 5632, it * 64, (float*)(F.ws + CT_BUP0), 5632, nullptr, vf, F.tid, gs); }
    else if (it < n_up + n_in) { it -= n_up; auto vf = [&](int r, int k) -> float { return mods[5 * 6144 + r * 6144 + k]; };
        gemv_det_item<4>(in[21], 3072, it * 64, (float*)(F.ws + CT_BIN), 3072, in[22], vf, F.tid, gs); }
    else if (it < 2 * n_up + n_in) { it -= n_up + n_in; auto vf = [&](int r, int k) -> float { return mods[5 * 6144 + r * 6144 + 3072 + k]; };
        gemv_det_item<4>(in[36], 5632, it * 64, (float*)(F.ws + CT_BUP1), 5632, nullptr, vf, F.tid, gs); }
    __syncthreads();
}

using pg8::f32x4; using pg8::Unit;
__device__ __forceinline__ float row_rs(const float* ssq, int np, int row) {
    float s = 0.f;
    for (int i = 0; i < np; ++i) s += ssq[(size_t)i * TT + row];
    return __builtin_amdgcn_rsqf(s * (1.0f / 1024.0f) + EPS);
}
constexpr float QSCALE = 0.125f * 1.4426950408889634f;
template <int PART>
struct EpiQK {
    static constexpr bool PERM = true;
    bf16* dst; const float* ssq; int np; const float* bias; int bias_bstride; const float* gain; int seqlen;
    __device__ __forceinline__ void operator()(const f32x4 (&acc)[2][2][4][2], const Unit& u, int wr, int wc, int fr, int fq) const {
        const int head = 4 * u.pn + wc;
        const int b = (u.pm * 256) / seqlen;
        const float* bp = bias + (size_t)b * bias_bstride + PART * 1024 + head * 64 + 8 * fq;
        const float* gp = gain + 8 * fq;
        const float osc = PART == 0 ? QSCALE : 1.0f;
#pragma unroll
        for (int ai = 0; ai < 2; ++ai)
#pragma unroll
            for (int m = 0; m < 4; ++m) {
                const int row = u.pm * 256 + ai * 128 + wr * 64 + m * 16 + fr;
                const float rs = row_rs(ssq, np, row);
                f32x4 v[2][2]; float ss = 0.f;
#pragma unroll
                for (int bj = 0; bj < 2; ++bj)
#pragma unroll
                    for (int n = 0; n < 2; ++n) { v[bj][n] = acc[ai][bj][m][n] * rs + *(const f32x4*)(bp + 32 * bj + 4 * n); const f32x4 t = v[bj][n]; ss += (t.x * t.x + t.y * t.y) + (t.z * t.z + t.w * t.w); }
                ss += __shfl_xor(ss, 16); ss += __shfl_xor(ss, 32);
                const float rn = osc * __builtin_amdgcn_rsqf(ss * (1.0f / 64.0f) + EPS);
                const int tl = row - b * seqlen;
                bf16* rowp = (PART == 0) ? dst + (size_t)row * DM + head * 64 + 8 * fq
                                         : dst + ((((size_t)(b * NH + head) * (seqlen / 16) + (tl >> 4)) * 8 + fq) * 16 + (tl & 15)) * 8;
                constexpr int bjstep = (PART == 0) ? 32 : 4 * 16 * 8;
#pragma unroll
                for (int bj = 0; bj < 2; ++bj) { const f32x4 a0 = v[bj][0] * rn * *(const f32x4*)(gp + 32 * bj), a1 = v[bj][1] * rn * *(const f32x4*)(gp + 32 * bj + 4);
                    v4u w; w.x = pk2(a0.x, a0.y); w.y = pk2(a0.z, a0.w); w.z = pk2(a1.x, a1.y); w.w = pk2(a1.z, a1.w);
                    *(v4u*)(rowp + bjstep * bj) = w; }
                asm volatile("" ::: "memory");
            }
    }
};
struct EpiVT {
    static constexpr bool PERM = true;
    bf16* VTp; const float* ssq; int np; const float* bias; int bias_bstride; int seqlen;
    __device__ __forceinline__ void operator()(const f32x4 (&acc)[2][2][4][2], const Unit& u, int wr, int wc, int fr, int fq) const {
        const int head = 4 * u.pn + wc;
        const int b = (u.pm * 256) / seqlen;
        const float* bp = bias + (size_t)b * bias_bstride + 2048 + head * 64 + 8 * fq;
        const int odd = fr & 1;
        f32x4 bv[2][2];
#pragma unroll
        for (int bj = 0; bj < 2; ++bj)
#pragma unroll
            for (int n = 0; n < 2; ++n) bv[bj][n] = *(const f32x4*)(bp + 32 * bj + 4 * n);
#pragma unroll
        for (int ai = 0; ai < 2; ++ai)
#pragma unroll
            for (int m = 0; m < 4; ++m) {
                const int row = u.pm * 256 + ai * 128 + wr * 64 + m * 16 + fr;
                const float rs = row_rs(ssq, np, row);
                const int tl = row - b * seqlen;
                const int c16 = tl & 14, cpos = (c16 & 3) | ((c16 & 8) >> 1) | ((c16 & 4) << 1);
                bf16* vb = VTp + (((size_t)(b * NH + head) * (seqlen / 16) + (tl >> 4)) * 64 + 8 * fq + odd) * 16 + cpos;
#pragma unroll
                for (int bj = 0; bj < 2; ++bj)
#pragma unroll
                    for (int n = 0; n < 2; ++n) {
                        const f32x4 v = acc[ai][bj][m][n] * rs + bv[bj][n];
                        const unsigned w01 = pk2(v.x, v.y), w23 = pk2(v.z, v.w);
                        const unsigned p01 = (unsigned)__shfl_xor((int)w01, 1), p23 = (unsigned)__shfl_xor((int)w23, 1);
                        const unsigned o0 = odd ? ((w01 & 0xffff0000u) | (p01 >> 16)) : ((p01 << 16) | (w01 & 0xffffu));
                        const unsigned o1 = odd ? ((w23 & 0xffff0000u) | (p23 >> 16)) : ((p23 << 16) | (w23 & 0xffffu));
                        bf16* p = vb + (32 * bj + 4 * n) * 16;
                        *(unsigned*)p = o0; *(unsigned*)(p + 2 * 16) = o1;
                    }
            }
    }
};
struct EpiVT4 {
    static constexpr bool PERM = true;
    static constexpr bool APERM = true;
    bf16* VTp; const float* ssq; int np; const float* bias; int bias_bstride; int seqlen;
    __device__ __forceinline__ void operator()(const f32x4 (&acc)[2][2][4][2], const Unit& u, int wr, int wc, int fr, int fq) const {
        const int head = 4 * u.pn + wc;
        const int b = (u.pm * 256) / seqlen;
        const float* bp = bias + (size_t)b * bias_bstride + 2048 + head * 64 + 8 * fq;
        f32x4 bv[2][2];
#pragma unroll
        for (int bj = 0; bj < 2; ++bj)
#pragma unroll
            for (int n = 0; n < 2; ++n) bv[bj][n] = *(const f32x4*)(bp + 32 * bj + 4 * n);
#pragma unroll
        for (int ai = 0; ai < 2; ++ai) {
            const int row0 = u.pm * 256 + ai * 128 + wr * 64 + 4 * fr;
            float rs[4];
#pragma unroll
            for (int m = 0; m < 4; ++m) rs[m] = row_rs(ssq, np, row0 + m);
            const int tl0 = row0 - b * seqlen, c16 = tl0 & 15, cpos0 = ((c16 & 8) >> 1) | ((c16 & 4) << 1);
            bf16* vb = VTp + (((size_t)(b * NH + head) * (seqlen / 16) + (tl0 >> 4)) * 64 + 8 * fq) * 16 + cpos0;
#pragma unroll
            for (int bj = 0; bj < 2; ++bj)
#pragma unroll
                for (int n = 0; n < 2; ++n) {
                    f32x4 v[4];
#pragma unroll
                    for (int m = 0; m < 4; ++m) v[m] = acc[ai][bj][m][n] * rs[m] + bv[bj][n];
#pragma unroll
                    for (int e = 0; e < 4; ++e) { v2u w; w.x = pk2(v[0][e], v[1][e]); w.y = pk2(v[2][e], v[3][e]); *(v2u*)(vb + (32 * bj + 4 * n + e) * 16) = w; }
                }
        }
    }
};
template <bool BASE_F32, bool OUT_F32>
struct EpiRes {
    static constexpr bool PERM = true;
    const void* base; void* out; const float* gate; const float* bias; const float* gn; bf16* xs; float* ssq; float* hs;
    __device__ __forceinline__ void operator()(const f32x4 (&acc)[2][2][4][2], const Unit& u, int wr, int wc, int fr, int fq) const {
        const int b = (u.pm * 256) / SEQ;
        const int col0 = u.pn * 256 + wc * 32 + 8 * fq;
        constexpr int MB = BASE_F32 ? 2 : 4;
#pragma unroll
        for (int ai = 0; ai < 2; ++ai)
#pragma unroll
        for (int mb = 0; mb < 4; mb += MB) {
            f32x4 bf[MB][2][2]; v4u bh[MB][2];
#pragma unroll
            for (int mi = 0; mi < MB; ++mi) { const size_t off = (size_t)(u.pm * 256 + ai * 128 + wr * 64 + (mb + mi) * 16 + fr) * DM + col0;
#pragma unroll
                for (int bj = 0; bj < 2; ++bj) {
                    if (BASE_F32) { bf[mi][bj][0] = *(const f32x4*)((const float*)base + off + 128 * bj); bf[mi][bj][1] = *(const f32x4*)((const float*)base + off + 128 * bj + 4); }
                    else bh[mi][bj] = *(const v4u*)((const bf16*)base + off + 128 * bj); } }
#pragma unroll
            for (int mi = 0; mi < MB; ++mi) {
                const int m = mb + mi;
                const int rowl = ai * 128 + wr * 64 + m * 16 + fr;
                const size_t off = (size_t)(u.pm * 256 + rowl) * DM + col0;
                float ss = 0.f;
#pragma unroll
                for (int bj = 0; bj < 2; ++bj) {
                    const int c = col0 + 128 * bj;
                    f32x4 b0, b1;
                    if (BASE_F32) { b0 = bf[mi][bj][0]; b1 = bf[mi][bj][1]; }
                    else { const v4u w = bh[mi][bj]; b0 = (f32x4){bflo(w.x), bfhi(w.x), bflo(w.y), bfhi(w.y)}; b1 = (f32x4){bflo(w.z), bfhi(w.z), bflo(w.w), bfhi(w.w)}; }
                    f32x4 a0 = acc[ai][bj][m][0], a1 = acc[ai][bj][m][1];
                    if (bias) { a0 += *(const f32x4*)(bias + c); a1 += *(const f32x4*)(bias + c + 4); }
                    const f32x4 x0 = b0 + *(const f32x4*)(gate + (size_t)b * 6144 + c) * a0, x1 = b1 + *(const f32x4*)(gate + (size_t)b * 6144 + c + 4) * a1;
                    if (OUT_F32) { *(f32x4*)((float*)out + off + 128 * bj) = x0; *(f32x4*)((float*)out + off + 128 * bj + 4) = x1; }
                    else {
                        v4u w; w.x = pk2(x0.x, x0.y); w.y = pk2(x0.z, x0.w); w.z = pk2(x1.x, x1.y); w.w = pk2(x1.z, x1.w);
                        *(v4u*)((bf16*)out + off + 128 * bj) = w;
                        const f32x4 r0 = (f32x4){bflo(w.x), bfhi(w.x), bflo(w.y), bfhi(w.y)}, r1 = (f32x4){bflo(w.z), bfhi(w.z), bflo(w.w), bfhi(w.w)};
                        ss += (r0.x * r0.x + r0.y * r0.y) + (r0.z * r0.z + r0.w * r0.w) + (r1.x * r1.x + r1.y * r1.y) + (r1.z * r1.z + r1.w * r1.w);
                        const f32x4 q0 = r0 * *(const f32x4*)(gn + (size_t)b * 1024 + c), q1 = r1 * *(const f32x4*)(gn + (size_t)b * 1024 + c + 4);
                        v4u ws2; ws2.x = pk2(q0.x, q0.y); ws2.y = pk2(q0.z, q0.w); ws2.z = pk2(q1.x, q1.y); ws2.w = pk2(q1.z, q1.w);
                        *(v4u*)(xs + off + 128 * bj) = ws2;
                    }
                }
                if (!OUT_F32) { ss += __shfl_xor(ss, 16); ss += __shfl_xor(ss, 32); if (fq == 0) hs[rowl * 4 + wc] = ss; }
            }
            asm volatile("" ::: "memory");
        }
        if (!OUT_F32) {
            asm volatile("s_waitcnt lgkmcnt(0)" ::: "memory"); __builtin_amdgcn_s_barrier(); asm volatile("" ::: "memory");
            const int tid = threadIdx.x;
            if (tid < 256) { const f32x4 p = *(const f32x4*)(hs + tid * 4); ssq[(size_t)u.pn * TT + u.pm * 256 + tid] = ((p.x + p.y) + p.z) + p.w; }
        }
    }
};
struct EpiScaleBias {
    static constexpr bool PERM = true;
    bf16* O; int ldc; const float* ssq; int np; const float* bias; int bias_bstride;
    __device__ __forceinline__ void operator()(const f32x4 (&acc)[2][2][4][2], const Unit& u, int wr, int wc, int fr, int fq) const {
        const int b = (u.pm * 256) / SEQ;
        const int col0 = u.pn * 256 + wc * 32 + 8 * fq;
        f32x4 bv[2][2];
#pragma unroll
        for (int bj = 0; bj < 2; ++bj)
#pragma unroll
            for (int n = 0; n < 2; ++n) bv[bj][n] = *(const f32x4*)(bias + (size_t)b * bias_bstride + col0 + 128 * bj + 4 * n);
#pragma unroll
        for (int ai = 0; ai < 2; ++ai)
#pragma unroll
            for (int m = 0; m < 4; ++m) {
                const int row = u.pm * 256 + ai * 128 + wr * 64 + m * 16 + fr;
                const float rs = row_rs(ssq, np, row);
                bf16* rowp = O + (size_t)row * ldc + col0;
#pragma unroll
                for (int bj = 0; bj < 2; ++bj) { const f32x4 v0 = acc[ai][bj][m][0] * rs + bv[bj][0], v1 = acc[ai][bj][m][1] * rs + bv[bj][1];
                    v4u w; w.x = pk2(v0.x, v0.y); w.y = pk2(v0.z, v0.w); w.z = pk2(v1.x, v1.y); w.w = pk2(v1.z, v1.w);
                    *(v4u*)(rowp + 128 * bj) = w; }
            }
    }
};
__device__ __forceinline__ float gelu_as(float v) {
    const float av = fabsf(v), t = __builtin_amdgcn_rcpf(av * 0.2316418882f + 1.0f);
    float q = t * 0.5307027145f + (-0.7265760135f); q = q * t + 0.7107068705f; q = q * t + (-0.142248368f); q = q * t + 0.127414796f; q = q * t;
    const float e = __builtin_amdgcn_exp2f((v * v) * (-0.72134752044f));
    return __builtin_fmaf(-av, q * e, __builtin_fmaxf(v, 0.f));
}
typedef float f32x2 __attribute__((ext_vector_type(2)));
__device__ __forceinline__ f32x2 gelu_as2(f32x2 v) {
    f32x2 nav; nav.x = -__builtin_fabsf(v.x); nav.y = -__builtin_fabsf(v.y);
    const f32x2 d = nav * (-0.2316418882f) + 1.0f;
    const float rdd = __builtin_amdgcn_rcpf(d.x * d.y);
    const f32x2 t = (f32x2){d.y, d.x} * rdd;
    f32x2 q = t * 0.5307027145f + (-0.7265760135f); q = q * t + 0.7107068705f; q = q * t + (-0.142248368f); q = q * t + 0.127414796f; q = q * t;
    const f32x2 x2 = (v * v) * (-0.72134752044f);
    f32x2 e; e.x = __builtin_amdgcn_exp2f(x2.x); e.y = __builtin_amdgcn_exp2f(x2.y);
    f32x2 mx; mx.x = __builtin_fmaxf(v.x, 0.f); mx.y = __builtin_fmaxf(v.y, 0.f);
    return nav * (q * e) + mx;
}
template <int CTRL> __device__ __forceinline__ float dpp_mov(float src) {
    return __builtin_bit_cast(float, __builtin_amdgcn_mov_dpp(__builtin_bit_cast(int, src), CTRL, 0xf, 0xf, true));
}
template <int CTRL> __device__ __forceinline__ float dpp_f(float old, float src) {
    return __builtin_bit_cast(float, __builtin_amdgcn_update_dpp(__builtin_bit_cast(int, old), __builtin_bit_cast(int, src), CTRL, 0xf, 0xf, false));
}
struct EpiUpGlu {
    static constexpr bool PERM = true;
    static constexpr bool APERM = true;
    bf16* act; const float* ssq; int np; const float* bias; const float* cw; const float* cb; float* Hg; float* Ha; float* hl;
    __device__ __forceinline__ void prefetch(const Unit& u) const {
        int tid = threadIdx.x; asm volatile("" : "+v"(tid));
        const int wv = __builtin_amdgcn_readfirstlane(tid >> 6), ln = tid & 63;
        if (wv < 7) {
            const int b = (u.pm * 256) / SEQ, hf = ln >> 5, c4 = u.pn * 128 + (ln & 31) * 4;
            const float* src;
            if (wv == 0) src = bias + (size_t)b * 5632 + hf * FF + c4;
            else if (wv == 1) src = cw + hf * FF + c4;
            else if (wv == 2) src = (hf ? cb : cw + 2 * FF) + c4;
            else src = ssq + (size_t)(wv - 3) * TT + u.pm * 256 + ln * 4;
            __builtin_amdgcn_global_load_lds((const unsigned*)src, (LAS unsigned*)((unsigned char*)hl + (CB_LDS_OFF - RING_BYTES) + wv * 1024), 16, 0, 0);
        }
    }
    __device__ __forceinline__ void operator()(f32x4 (&acc)[2][2][4][2], const Unit& u, int wr, int wc, int fr_, int fq_) const {
        int ln_ = threadIdx.x & 63; asm volatile("" : "+v"(ln_));
        const int fr = ln_ & 15, fq = ln_ >> 4;
        const int j0 = u.pn * 128 + wc * 32 + 8 * fq;
        const float* ct = (const float*)((const unsigned char*)hl + (CB_LDS_OFF - RING_BYTES));
        const int jl = wc * 32 + 8 * fq;
        {
            f32x4 ba[2], bg[2];
#pragma unroll
            for (int n = 0; n < 2; ++n) { ba[n] = *(const f32x4*)(ct + jl + 4 * n); bg[n] = *(const f32x4*)(ct + 128 + jl + 4 * n); }
#pragma unroll
            for (int ai = 0; ai < 2; ++ai)
#pragma unroll
                for (int m = 0; m < 4; ++m) { const int rl_ = ai * 128 + wr * 64 + 4 * fr + m;
                    const float rs = __builtin_amdgcn_rsqf((((ct[768 + rl_] + ct[1024 + rl_]) + ct[1280 + rl_]) + ct[1536 + rl_]) * (1.0f / 1024.0f) + EPS);
#pragma unroll
                    for (int n = 0; n < 2; ++n) { acc[ai][0][m][n] = acc[ai][0][m][n] * rs + ba[n]; acc[ai][1][m][n] = acc[ai][1][m][n] * rs + bg[n]; }
                    if (m == 3) asm volatile("" ::: "memory"); }
        }
#pragma unroll
        for (int ai = 0; ai < 2; ++ai) { float* hp = hl + ((2 * ai + wr) * 2) * 128 + wc * 32 + 8 * fq;
            if (fr == 0) { *(f32x4*)(hp) = acc[ai][1][0][0]; *(f32x4*)(hp + 4) = acc[ai][1][0][1]; }
            if (fr == 15) { *(f32x4*)(hp + 128) = acc[ai][1][3][0]; *(f32x4*)(hp + 132) = acc[ai][1][3][1]; } }
        asm volatile("s_waitcnt lgkmcnt(0)" ::: "memory"); __builtin_amdgcn_s_barrier(); asm volatile("" ::: "memory");
        if (wr == 0 && fr == 0) { float* p = Hg + ((size_t)u.pm * 4) * FF + j0;
            *(f32x4*)p = acc[0][1][0][0]; *(f32x4*)(p + 4) = acc[0][1][0][1]; *(f32x4*)(p + FF) = acc[0][1][1][0]; *(f32x4*)(p + FF + 4) = acc[0][1][1][1];
            float* q = Ha + ((size_t)u.pm * 2) * FF + j0; *(f32x4*)q = acc[0][0][0][0]; *(f32x4*)(q + 4) = acc[0][0][0][1]; }
        if (wr == 1 && fr == 15) { float* p = Hg + ((size_t)u.pm * 4 + 2) * FF + j0;
            *(f32x4*)p = acc[1][1][2][0]; *(f32x4*)(p + 4) = acc[1][1][2][1]; *(f32x4*)(p + FF) = acc[1][1][3][0]; *(f32x4*)(p + FF + 4) = acc[1][1][3][1];
            float* q = Ha + ((size_t)u.pm * 2 + 1) * FF + j0; *(f32x4*)q = acc[1][0][3][0]; *(f32x4*)(q + 4) = acc[1][0][3][1]; }
        char* const act_tile = (char*)(act + (size_t)u.pm * 256 * FF);
        const unsigned act_lane_off = (unsigned)((4 * fr) * FF + 8 * fq) * 2u;
#pragma unroll
        for (int n = 0; n < 2; ++n) {
            const f32x4 w0 = *(const f32x4*)(ct + 256 + jl + 4 * n), w1 = *(const f32x4*)(ct + 384 + jl + 4 * n), w2 = *(const f32x4*)(ct + 512 + jl + 4 * n), cbv = *(const f32x4*)(ct + 640 + jl + 4 * n);
#pragma unroll
            for (int ai = 0; ai < 2; ++ai) {
                const int gi = 2 * ai + wr;
                const f32x4 uph = *(const f32x4*)(hl + (((gi + 3) & 3) * 2 + 1) * 128 + wc * 32 + 8 * fq + 4 * n);
                const f32x4 dnh = *(const f32x4*)(hl + (((gi + 1) & 3) * 2) * 128 + wc * 32 + 8 * fq + 4 * n);
#pragma unroll
                for (int m = 0; m < 4; ++m) {
                    const int rowl = ai * 128 + wr * 64 + 4 * fr + m;
                    f32x4 r, up4, dn4;
#pragma unroll
                    for (int e = 0; e < 4; ++e) {
                        up4[e] = (m > 0) ? acc[ai][1][m > 0 ? m - 1 : 0][n][e] : dpp_f<0x111>(uph[e], acc[ai][1][3][n][e]);
                        dn4[e] = (m < 3) ? acc[ai][1][m < 3 ? m + 1 : 3][n][e] : dpp_f<0x101>(dnh[e], acc[ai][1][0][n][e]);
                    }
                    { const f32x4 cv4 = w0 * up4 + (w1 * acc[ai][1][m][n] + (w2 * dn4 + cbv));
                      const f32x2 g01 = gelu_as2((f32x2){cv4[0], cv4[1]}), g23 = gelu_as2((f32x2){cv4[2], cv4[3]});
                      r = acc[ai][0][m][n] * (f32x4){g01.x, g01.y, g23.x, g23.y}; }
                    if (rowl != 0 && rowl != 255) { v2u w; w.x = pk2(r.x, r.y); w.y = pk2(r.z, r.w);
                        *(v2u*)(act_tile + (size_t)(((ai * 128 + wr * 64 + m) * FF + u.pn * 128 + wc * 32 + 4 * n) * 2) + act_lane_off) = w; }
                }
            }
        }
        asm volatile("s_waitcnt lgkmcnt(0)" ::: "memory"); __builtin_amdgcn_s_barrier(); asm volatile("" ::: "memory");
    }
};
struct GluFixV { f32x4 gm, g0, gp, a; int t; };
__device__ __forceinline__ void glu_fix_ld(const float* Hg, const float* Ha, int pm, int which, int j, GluFixV& v) {
    const int t = pm * 256 + (which ? 255 : 0), tl = t % SEQ;
    const int rm = which ? pm * 4 + 2 : max(pm - 1, 0) * 4 + 3, r0 = pm * 4 + (which ? 3 : 0), rp = which ? min(pm + 1, TT / 256 - 1) * 4 : pm * 4 + 1;
    v.gm = *(const f32x4*)(Hg + (size_t)rm * FF + j); v.gp = *(const f32x4*)(Hg + (size_t)rp * FF + j);
    v.g0 = *(const f32x4*)(Hg + (size_t)r0 * FF + j); v.a = *(const f32x4*)(Ha + ((size_t)pm * 2 + which) * FF + j);
    if (!which && tl == 0) v.gm = (f32x4){0.f, 0.f, 0.f, 0.f};
    if (which && tl == SEQ - 1) v.gp = (f32x4){0.f, 0.f, 0.f, 0.f};
    v.t = t;
}
__device__ __forceinline__ void glu_fix_st(bf16* act, const GluFixV& v, int j, f32x4 w0, f32x4 w1, f32x4 w2, f32x4 cbv) {
    const f32x4 cv = w0 * v.gm + w1 * v.g0 + w2 * v.gp + cbv;
    const f32x2 g01 = gelu_as2((f32x2){cv[0], cv[1]}), g23 = gelu_as2((f32x2){cv[2], cv[3]});
    const f32x4 r = v.a * (f32x4){g01.x, g01.y, g23.x, g23.y};
    v2u w; w.x = pk2(r.x, r.y); w.y = pk2(r.z, r.w);
    *(v2u*)(act + (size_t)v.t * FF + j) = w;
}
__device__ __forceinline__ void glu_fix_tile2(Frame& F, int pmA, int pmB, const float* cw, const float* cb) {
    const float* Hg = (const float*)(F.ws + WS_HG); const float* Ha = (const float*)(F.ws + WS_HA); bf16* act = (bf16*)(F.ws + WS_AG);
    const int pmB2 = pmB < 0 ? pmA : pmB;
#pragma unroll 1
    for (int it = 0; it < 3; ++it) {
        const int e = F.tid + 512 * it;
        if (e < 2 * (FF / 4)) {
            const int which = e >= FF / 4 ? 1 : 0, j = (e - which * (FF / 4)) * 4;
            GluFixV va, vb;
            glu_fix_ld(Hg, Ha, pmA, which, j, va); glu_fix_ld(Hg, Ha, pmB2, which, j, vb);
            const f32x4 w0 = *(const f32x4*)(cw + j), w1 = *(const f32x4*)(cw + FF + j), w2 = *(const f32x4*)(cw + 2 * FF + j), cbv = *(const f32x4*)(cb + j);
            glu_fix_st(act, va, j, w0, w1, w2, cbv); glu_fix_st(act, vb, j, w0, w1, w2, cbv);
        }
    }
}
__device__ __forceinline__ void glu_fix_tile(Frame& F, int pm, const float* cw, const float* cb) { glu_fix_tile2(F, pm, -1, cw, cb); }
__device__ __forceinline__ void glu_fix_phase(Frame& F, const float* cw, const float* cb) {
    const float* Hg = (const float*)(F.ws + WS_HG); const float* Ha = (const float*)(F.ws + WS_HA); bf16* act = (bf16*)(F.ws + WS_AG);
    const int total = (TT / 256) * 2 * FF;
    for (int e = F.vcu * 512 + F.tid; e < total; e += F.G * 512) {
        const int j = e % FF, which = (e / FF) & 1, pm = e / (2 * FF);
        const int t = pm * 256 + (which ? 255 : 0), tl = t % SEQ;
        float gm, g0, gp;
        if (which == 0) { gm = (tl == 0) ? 0.f : Hg[((size_t)(pm - 1) * 4 + 3) * FF + j]; g0 = Hg[((size_t)pm * 4 + 0) * FF + j]; gp = Hg[((size_t)pm * 4 + 1) * FF + j]; }
        else { gm = Hg[((size_t)pm * 4 + 2) * FF + j]; g0 = Hg[((size_t)pm * 4 + 3) * FF + j]; gp = (tl == SEQ - 1) ? 0.f : Hg[((size_t)(pm + 1) * 4 + 0) * FF + j]; }
        const float a = Ha[((size_t)pm * 2 + which) * FF + j];
        const float cv = cw[j] * gm + cw[FF + j] * g0 + cw[2 * FF + j] * gp + cb[j];
        act[(size_t)t * FF + j] = (bf16)f2bf(a * gelu_as(cv));
    }
}
struct EpiNull {
    static constexpr bool PERM = true;
    float* sink;
    __device__ __forceinline__ void operator()(const f32x4 (&acc)[2][2][4][2], const Unit& u, int wr, int wc, int fr, int fq) const {
        f32x4 s = {0.f, 0.f, 0.f, 0.f};
#pragma unroll
        for (int ai = 0; ai < 2; ++ai)
#pragma unroll
            for (int bj = 0; bj < 2; ++bj)
#pragma unroll
                for (int m = 0; m < 4; ++m)
#pragma unroll
                    for (int n = 0; n < 2; ++n) s += acc[ai][bj][m][n];
        if (u.pm == 100000) *(f32x4*)(sink + fr) = s;
    }
};
struct EpiInT {
    static constexpr bool PERM = true;
    static constexpr bool APERM = true;
    bf16* UT; const float* ssq; int np; const float* bias;
    __device__ __forceinline__ void operator()(const f32x4 (&acc)[2][2][4][2], const Unit& u, int wr, int wc, int fr, int fq) const {
        const int b = (u.pm * 256) / SEQ;
        const int col0 = u.pn * 256 + wc * 32 + 8 * fq;
        f32x4 bv[2][2];
#pragma unroll
        for (int bj = 0; bj < 2; ++bj)
#pragma unroll
            for (int n = 0; n < 2; ++n) bv[bj][n] = *(const f32x4*)(bias + (size_t)b * 3072 + col0 + 128 * bj + 4 * n);
#pragma unroll
        for (int ai = 0; ai < 2; ++ai) {
            const int row0 = u.pm * 256 + ai * 128 + wr * 64 + 4 * fr;
            float rs[4];
#pragma unroll
            for (int m = 0; m < 4; ++m) rs[m] = row_rs(ssq, np, row0 + m);
            const int t0 = row0 - b * SEQ;
#pragma unroll
            for (int bj = 0; bj < 2; ++bj)
#pragma unroll
                for (int n = 0; n < 2; ++n) {
                    f32x4 v[4];
#pragma unroll
                    for (int m = 0; m < 4; ++m) v[m] = acc[ai][bj][m][n] * rs[m] + bv[bj][n];
                    bf16* p = UT + ((size_t)b * 3072 + col0 + 128 * bj + 4 * n) * SEQ + t0;
#pragma unroll
                    for (int e = 0; e < 4; ++e) { v2u w; w.x = pk2(v[0][e], v[1][e]); w.y = pk2(v[2][e], v[3][e]); *(v2u*)(p + (size_t)e * SEQ) = w; }
                }
        }
    }
};

struct EpiCtxKV {
    static constexpr bool PERM = true;
    EpiQK<1> ek; EpiVT ev;
    __device__ __forceinline__ void operator()(const f32x4 (&acc)[2][2][4][2], const Unit& u, int wr, int wc, int fr, int fq) const {
        if (u.pn < 4) ek(acc, u, wr, wc, fr, fq);
        else { Unit v = u; v.pn = u.pn - 4; ev(acc, v, wr, wc, fr, fq); }
    }
};

typedef short bf16x8 __attribute__((ext_vector_type(8)));
typedef float f32x16 __attribute__((ext_vector_type(16)));
typedef short s16x4 __attribute__((ext_vector_type(4)));
__device__ __forceinline__ unsigned cvtpk(float lo, float hi) { typedef float f2 __attribute__((ext_vector_type(2))); typedef __bf16 b2 __attribute__((ext_vector_type(2)));
    f2 v = {lo, hi}; b2 r = __builtin_convertvector(v, b2); return __builtin_bit_cast(unsigned, r); }
constexpr int BT_OFF = 64, BT_HEAD = 15 * 31;
__device__ __forceinline__ void attn_mfma_phase(Frame& F) {
    const bf16* Q = (const bf16*)(F.ws + WS_Q); const bf16* Kb = (const bf16*)(F.ws + WS_K); const bf16* VT = (const bf16*)(F.ws + WS_V);
    const bf16* Kc = (const bf16*)(F.ws + WS_KC); const bf16* VcT = (const bf16*)(F.ws + WS_VC);
    bf16* O = (bf16*)(F.ws + WS_O);
    const float* rpb = F.in[11];
    constexpr int AL_KC = 15 * 8192, AL_BT = AL_KC + 32768;
    const unsigned char* lk = (const unsigned char*)F.lds;
    float* bt = (float*)(F.lds + AL_BT);
    int th = -1;
    const int lane = F.lane, q = lane & 31, hi = lane >> 5;
    for (int g = F.vcu; g < NB * (GROWS / 8) * NH; g += F.G) {
        const int rg = g & 15, h = (g >> 4) & 15, b = g >> 8;
        const int r = rg * 8 + F.wave;
        const int r0 = min(max(r - WH / 2, 0), GROWS - WH);
        const int U0 = min(max(rg * 8 - WH / 2, 0), GROWS - WH), Ue = min(max(rg * 8 + 7 - WH / 2, 0), GROWS - WH) + WH;
        __syncthreads();
        if (h != th) { for (int e = F.tid; e < BT_HEAD; e += 512) bt[BT_OFF + e] = rpb[h * BT_HEAD + e] * 1.4426950408889634f; th = h; }
        {
            int tv = F.tid; FC_OPAQUE(tv);
            const bf16* ksrc = Kb + ((size_t)(b * NH + h) * (SEQ / 16) + (size_t)U0 * 4) * (8 * 16 * 8) + tv * 8;
            const bf16* csrc = Kc + ((size_t)(b * NH + h) * (CTXL / 16)) * (8 * 16 * 8) + tv * 8;
            const int nrow = Ue - U0;
#pragma unroll 1
            for (int rr0 = 0; rr0 < nrow + 4; rr0 += 4) {
                v4u x[4];
#pragma unroll
                for (int k = 0; k < 4; ++k) { const int rr = rr0 + k; if (rr < nrow + 4) x[k] = (rr < nrow) ? *(const v4u*)(ksrc + (size_t)rr * 4096) : *(const v4u*)(csrc + (size_t)(rr - nrow) * 4096); }
#pragma unroll
                for (int k = 0; k < 4; ++k) { const int rr = rr0 + k; if (rr < nrow + 4) *(v4u*)(F.lds + (rr < nrow ? rr * 8192 : AL_KC + (rr - nrow) * 8192) + tv * 16) = x[k]; }
            }
            asm volatile("" ::: "memory");
        }
        __syncthreads();
        const size_t tok = (size_t)b * SEQ + r * GW + q;
        bf16x8 qf[2][4];
#pragma unroll
        for (int hf = 0; hf < 2; ++hf)
#pragma unroll
            for (int s4 = 0; s4 < 4; ++s4) qf[hf][s4] = *(const bf16x8*)(Q + (tok + 32 * hf) * DM + h * HD + 16 * s4 + 8 * hi);
        const f32x16 zero16 = {0.f, 0.f, 0.f, 0.f, 0.f, 0.f, 0.f, 0.f, 0.f, 0.f, 0.f, 0.f, 0.f, 0.f, 0.f, 0.f};
        f32x16 o[2][2] = {{zero16, zero16}, {zero16, zero16}};
        f32x2 lsum2[2] = {(f32x2){0.f, 0.f}, (f32x2){0.f, 0.f}};
#define ATT_PTRS(i) \
            const bf16* kp_; const bf16* vp_; int sstr_; \
            if ((i) < 16) { const int rp_ = (i) >> 2, cb_ = (i) & 3, krow_ = r0 + 2 * rp_; \
                kp_ = (const bf16*)(lk + (krow_ + (q >> 4) - U0) * 8192 + cb_ * 2048 + hi * 256 + (q & 15) * 16); \
                vp_ = VT + (((size_t)(b * NH + h) * (SEQ / 16) + krow_ * 4 + cb_) * 64 + q) * 16 + 8 * hi; sstr_ = 4 * 64 * 16; } \
            else { const int j_ = (i) - 16; \
                kp_ = (const bf16*)(lk + AL_KC + (2 * j_ + (q >> 4)) * 2048 + hi * 256 + (q & 15) * 16); \
                vp_ = VcT + (((size_t)(b * NH + h) * (CTXL / 16) + 2 * j_) * 64 + q) * 16 + 8 * hi; sstr_ = 64 * 16; }
#define ATT_LOADK(i, kf) do { ATT_PTRS(i) (void)vp_; (void)sstr_; \
            _Pragma("unroll") for (int s4 = 0; s4 < 4; ++s4) kf[s4] = *(const bf16x8*)(kp_ + s4 * (2 * 16 * 8)); } while (0)
#define ATT_LOADV(i, va) do { ATT_PTRS(i) (void)kp_; \
            _Pragma("unroll") for (int dh = 0; dh < 2; ++dh) _Pragma("unroll") for (int s2 = 0; s2 < 2; ++s2) { const bf16* v_ = vp_ + dh * (32 * 16) + s2 * sstr_; \
                va[dh][s2] = *(const bf16x8*)v_; } } while (0)
#define ATT_HALF(i, inext, kf, va, HF, LOADNEXT) do { \
            f32x16 sacc = zero16; \
            _Pragma("unroll") for (int s4 = 0; s4 < 4; ++s4) sacc = __builtin_amdgcn_mfma_f32_32x32x16_bf16(kf[s4], qf[HF][s4], sacc, 0, 0, 0); \
            if (LOADNEXT) ATT_LOADK(inext, kf); \
            float p[16]; \
            if ((i) < 16) { const int rp_ = (i) >> 2, cb_ = (i) & 3, krow_ = r0 + 2 * rp_; \
                const int c_ = 32 * HF + q, c0_ = min(max(c_ - WW / 2, 0), GW - WW), lo_ = c0_ - c_ + (WW - 1); \
                const int dcb = cb_ * 16 + 4 * hi - c_ + (WW - 1), dcl = dcb - lo_; \
                const float* btp = bt + BT_OFF + (krow_ - r + (WH - 1)) * 31 + dcb; \
                _Pragma("unroll") for (int rr = 0; rr < 16; rr += 2) { const int kc = (rr & 3) + 8 * ((rr >> 2) & 1); \
                    const f32x2 s2_ = (f32x2){sacc[rr], sacc[rr + 1]} + (f32x2){btp[(rr >> 3) * 31 + kc], btp[(rr >> 3) * 31 + kc + 1]}; \
                    const float e0_ = __builtin_amdgcn_exp2f(s2_.x), e1_ = __builtin_amdgcn_exp2f(s2_.y); \
                    p[rr] = ((unsigned)(dcl + kc) < (unsigned)WW) ? e0_ : 0.f; p[rr + 1] = ((unsigned)(dcl + kc + 1) < (unsigned)WW) ? e1_ : 0.f; \
                    lsum2[HF] += (f32x2){p[rr], p[rr + 1]}; } } \
            else { _Pragma("unroll") for (int rr = 0; rr < 16; rr += 2) { p[rr] = __builtin_amdgcn_exp2f(sacc[rr]); p[rr + 1] = __builtin_amdgcn_exp2f(sacc[rr + 1]); lsum2[HF] += (f32x2){p[rr], p[rr + 1]}; } } \
            unsigned pw[8]; \
            _Pragma("unroll") for (int ii = 0; ii < 8; ++ii) pw[ii] = cvtpk(p[2 * ii], p[2 * ii + 1]); \
            _Pragma("unroll") for (int s2 = 0; s2 < 2; ++s2) { \
                const bf16x8 pb = __builtin_bit_cast(bf16x8, (v4u){pw[4 * s2], pw[4 * s2 + 1], pw[4 * s2 + 2], pw[4 * s2 + 3]}); \
                o[HF][0] = __builtin_amdgcn_mfma_f32_32x32x16_bf16(va[0][s2], pb, o[HF][0], 0, 0, 0); \
                o[HF][1] = __builtin_amdgcn_mfma_f32_32x32x16_bf16(va[1][s2], pb, o[HF][1], 0, 0, 0); } } while (0)
#define ATT_COMPUTE(i, inext, kf, va) do { const int cbq_ = ((i) < 16) ? ((i) & 3) : 1; \
            if (cbq_ != 3) ATT_HALF(i, inext, kf, va, 0, (cbq_ == 0)); \
            if (cbq_ != 0) ATT_HALF(i, inext, kf, va, 1, true); } while (0)
        bf16x8 kf1[4], vaA[2][2], vaB[2][2];
        ATT_LOADK(0, kf1); ATT_LOADV(0, vaA);
#pragma unroll 1
        for (int i = 0; i < 24; i += 2) {
            ATT_LOADV(i + 1, vaB);
            ATT_COMPUTE(i, i + 1, kf1, vaA);
            const int i2 = (i + 2 < 24) ? i + 2 : 23;
            ATT_LOADV(i2, vaA);
            ATT_COMPUTE(i + 1, i2, kf1, vaB);
        }
#undef ATT_PTRS
#undef ATT_LOADK
#undef ATT_LOADV
#undef ATT_HALF
#undef ATT_COMPUTE
#pragma unroll
        for (int hf = 0; hf < 2; ++hf) {
            float l = lsum2[hf].x + lsum2[hf].y; l += __shfl_xor(l, 32);
            const float inv = __builtin_amdgcn_rcpf(l);
            bf16* op = O + (tok + 32 * hf) * DM + h * HD + 4 * hi;
#pragma unroll
            for (int gq = 0; gq < 4; ++gq) {
                v2u w0; w0.x = pk2(o[hf][0][4 * gq] * inv, o[hf][0][4 * gq + 1] * inv); w0.y = pk2(o[hf][0][4 * gq + 2] * inv, o[hf][0][4 * gq + 3] * inv);
                v2u w1; w1.x = pk2(o[hf][1][4 * gq] * inv, o[hf][1][4 * gq + 1] * inv); w1.y = pk2(o[hf][1][4 * gq + 2] * inv, o[hf][1][4 * gq + 3] * inv);
                *(v2u*)(op + 8 * gq) = w0; *(v2u*)(op + 32 + 8 * gq) = w1;
            }
        }
    }
    __syncthreads();
}

__device__ __forceinline__ void convglu_phase(Frame& F, const float* cw, const float* cb) {
    bf16* ag = (bf16*)(F.ws + WS_AG);
    const long nvec = (long)TT * (FF / 8);
    for (long e = (long)F.vcu * 512 + F.tid; e < nvec; e += (long)F.G * 512) {
        const int t = (int)(e / (FF / 8)), j0 = (int)(e % (FF / 8)) * 8;
        const int tl = t % SEQ;
        const bf16* rowp = ag + (size_t)t * (2 * FF);
        const v4u a = *(const v4u*)(rowp + j0);
        const v4u g0 = *(const v4u*)(rowp + FF + j0);
        v4u gm = (v4u){0u, 0u, 0u, 0u}, gp = (v4u){0u, 0u, 0u, 0u};
        if (tl > 0) gm = *(const v4u*)(rowp - 2 * FF + FF + j0);
        if (tl < SEQ - 1) gp = *(const v4u*)(rowp + 2 * FF + FF + j0);
        float av[8], g0v[8], gmv[8], gpv[8];
        av[0] = bflo(a.x); av[1] = bfhi(a.x); av[2] = bflo(a.y); av[3] = bfhi(a.y); av[4] = bflo(a.z); av[5] = bfhi(a.z); av[6] = bflo(a.w); av[7] = bfhi(a.w);
        g0v[0] = bflo(g0.x); g0v[1] = bfhi(g0.x); g0v[2] = bflo(g0.y); g0v[3] = bfhi(g0.y); g0v[4] = bflo(g0.z); g0v[5] = bfhi(g0.z); g0v[6] = bflo(g0.w); g0v[7] = bfhi(g0.w);
        gmv[0] = bflo(gm.x); gmv[1] = bfhi(gm.x); gmv[2] = bflo(gm.y); gmv[3] = bfhi(gm.y); gmv[4] = bflo(gm.z); gmv[5] = bfhi(gm.z); gmv[6] = bflo(gm.w); gmv[7] = bfhi(gm.w);
        gpv[0] = bflo(gp.x); gpv[1] = bfhi(gp.x); gpv[2] = bflo(gp.y); gpv[3] = bfhi(gp.y); gpv[4] = bflo(gp.z); gpv[5] = bfhi(gp.z); gpv[6] = bflo(gp.w); gpv[7] = bfhi(gp.w);
        float r[8];
#pragma unroll
        for (int i = 0; i < 8; ++i) { const int j = j0 + i; const float cv = cw[j] * gmv[i] + cw[FF + j] * g0v[i] + cw[2 * FF + j] * gpv[i] + cb[j]; r[i] = av[i] * gelu_f(cv); }
        v4u w; w.x = pk2(r[0], r[1]); w.y = pk2(r[2], r[3]); w.z = pk2(r[4], r[5]); w.w = pk2(r[6], r[7]);
        *(v4u*)(ag + (size_t)t * (2 * FF) + j0) = w;
    }
}

__device__ __forceinline__ void filtgen_phase(Frame& F) {
    const float* const* in = F.in;
    const float *w1 = in[25], *b1 = in[26], *w2 = in[27], *b2 = in[28], *w3 = in[29], *b3 = in[30], *freq = in[32];
    const float* __restrict__ wout = in[31];
    float* __restrict__ hT = (float*)(F.ws + WS_HT); float* __restrict__ fsqp = (float*)(F.ws + WS_FSQP);
    LAS float* zf = (LAS float*)(F.lds);
    LAS float* ha = zf + 32 * 36;
    LAS float* hb = ha + 32 * 64;
    const int tid = F.tid;
    for (int item = F.vcu; item < SEQ / 32; item += F.G) {
        const int l0 = item * 32;
        const float bj1 = b1[tid & 63], bj2 = b2[tid & 63], bj3 = b3[tid & 63], fj = freq[tid & 63];
        __syncthreads();
        for (int e = tid; e < 32 * 33; e += 512) {
            const int p = e / 33, i = e % 33, l = l0 + p;
            float v;
            if (i == 0) v = (float)l / 8191.0f;
            else { const int bi = (i - 1) & 15; const float band = 1e-4f + (float)bi * ((15.0f - 1e-4f) / 15.0f);
                const float w = (float)(2.0 * 3.14159265358979323846 / 8192.0) * (float)l; const float arg = band * w;
                v = (i <= 16) ? cosf(arg) : -sinf(arg); }
            zf[p * 36 + i] = v;
        }
        __syncthreads();
        { const int j = tid & 63, p = tid >> 6; float a[4] = {bj1, bj1, bj1, bj1};
#pragma unroll 11
          for (int i = 0; i < 33; ++i) { const float w = w1[i * 64 + j];
#pragma unroll
            for (int k = 0; k < 4; ++k) a[k] += zf[(p + 8 * k) * 36 + i] * w; }
#pragma unroll
          for (int k = 0; k < 4; ++k) ha[(p + 8 * k) * 64 + j] = sinf(fj * a[k]); }
        __syncthreads();
        { const int j = tid & 63, p = tid >> 6; float a[4] = {bj2, bj2, bj2, bj2};
#pragma unroll 16
          for (int i = 0; i < 64; ++i) { const float w = w2[i * 64 + j];
#pragma unroll
            for (int k = 0; k < 4; ++k) a[k] += ha[(p + 8 * k) * 64 + i] * w; }
#pragma unroll
          for (int k = 0; k < 4; ++k) hb[(p + 8 * k) * 64 + j] = sinf(fj * a[k]); }
        __syncthreads();
        { const int j = tid & 63, p = tid >> 6; float a[4] = {bj3, bj3, bj3, bj3};
#pragma unroll 16
          for (int i = 0; i < 64; ++i) { const float w = w3[i * 64 + j];
#pragma unroll
            for (int k = 0; k < 4; ++k) a[k] += hb[(p + 8 * k) * 64 + i] * w; }
#pragma unroll
          for (int k = 0; k < 4; ++k) ha[(p + 8 * k) * 64 + j] = sinf(fj * a[k]); }
        __syncthreads();
        {
            const int lane = F.lane, li = lane & 15, lk = lane >> 4;
            pg8::bf16x8 afr[2][2];
#pragma unroll
            for (int mt = 0; mt < 2; ++mt)
#pragma unroll
                for (int ks = 0; ks < 2; ++ks) { const LAS float* hp = ha + (16 * mt + li) * 64 + 32 * ks + 8 * lk;
                    v4u w; w.x = pk2(hp[0], hp[1]); w.y = pk2(hp[2], hp[3]); w.z = pk2(hp[4], hp[5]); w.w = pk2(hp[6], hp[7]);
                    afr[mt][ks] = __builtin_bit_cast(pg8::bf16x8, w); }
            const float la = -15.350567286626973f, lb = -3.0701134573253946f;
#pragma unroll 1
            for (int nt = 0; nt < 16; nt += 2) {
                const int n0 = F.wave * 256 + nt * 16 + li;
                const float* wp = wout + (size_t)(8 * lk) * 2048 + n0;
                float bv[2][2][8];
#pragma unroll
                for (int ks = 0; ks < 2; ++ks)
#pragma unroll
                    for (int j = 0; j < 8; ++j) { bv[0][ks][j] = wp[(size_t)(32 * ks + j) * 2048]; bv[1][ks][j] = wp[(size_t)(32 * ks + j) * 2048 + 16]; }
                f32x4 acc[2][2];
#pragma unroll
                for (int t2 = 0; t2 < 2; ++t2) { acc[t2][0] = (f32x4){0.f, 0.f, 0.f, 0.f}; acc[t2][1] = acc[t2][0]; }
#pragma unroll
                for (int t2 = 0; t2 < 2; ++t2)
#pragma unroll
                    for (int ks = 0; ks < 2; ++ks) {
                        v4u w; w.x = pk2(bv[t2][ks][0], bv[t2][ks][1]); w.y = pk2(bv[t2][ks][2], bv[t2][ks][3]); w.z = pk2(bv[t2][ks][4], bv[t2][ks][5]); w.w = pk2(bv[t2][ks][6], bv[t2][ks][7]);
                        const pg8::bf16x8 bfr = __builtin_bit_cast(pg8::bf16x8, w);
                        acc[t2][0] = __builtin_amdgcn_mfma_f32_16x16x32_bf16(afr[0][ks], bfr, acc[t2][0], 0, 0, 0);
                        acc[t2][1] = __builtin_amdgcn_mfma_f32_16x16x32_bf16(afr[1][ks], bfr, acc[t2][1], 0, 0, 0);
                    }
#pragma unroll
                for (int t2 = 0; t2 < 2; ++t2) {
                    const int n = n0 + 16 * t2;
                    const int dir = n >> 10, c = n & 1023;
                    const float delta = fabsf(la + (float)c * ((lb - la) / 1023.0f)) * 1.4426950408889634f;
                    float sq = 0.f;
#pragma unroll
                    for (int mt = 0; mt < 2; ++mt) { f32x4 ov; const f32x4 ac = acc[t2][mt];
#pragma unroll
                        for (int r = 0; r < 4; ++r) { const float tpos = (float)(l0 + 16 * mt + 4 * lk + r) / 8191.0f; const float v = ac[r] * __builtin_amdgcn_exp2f(-tpos * delta); ov[r] = v; sq += v * v; }
                        *(f32x4*)(hT + ((size_t)dir * 1024 + c) * SEQ + l0 + 16 * mt + 4 * lk) = ov; }
                    sq += __shfl_xor(sq, 16); sq += __shfl_xor(sq, 32);
                    if (lk == 0) fsqp[(size_t)item * 2048 + n] = sq;
                }
            }
        }
    }
    __syncthreads();
}

constexpr int F2_AO = 67584, F2_TW = 135168, F2_RED = 140 * 1024, F2_PF = 144 * 1024, F2_TN = 146 * 1024;
__device__ __forceinline__ void f2_load_tw(Frame& F, const cf* TWM, const cf* TWN) {
    cf* tw1 = (cf*)(F.lds + F2_TW);
    for (int e = F.tid; e < 544; e += 512) tw1[e] = e < 512 ? TWM[e] : TWM[16 * (e - 512)];
    ((cf*)(F.lds + F2_TN))[F.tid] = TWN[F.tid];
    __syncthreads();
}
__device__ __forceinline__ cf tn_pow(cf base, int r) {
    const float c[16] = {1.0f, 0.98078528040323043f, 0.92387953251128674f, 0.83146961230254524f, 0.70710678118654752f, 0.55557023301960218f, 0.38268343236508977f, 0.19509032201612825f,
                         0.0f, -0.19509032201612825f, -0.38268343236508977f, -0.55557023301960218f, -0.70710678118654752f, -0.83146961230254524f, -0.92387953251128674f, -0.98078528040323043f};
    const float sn[16] = {0.0f, 0.19509032201612825f, 0.38268343236508977f, 0.55557023301960218f, 0.70710678118654752f, 0.83146961230254524f, 0.92387953251128674f, 0.98078528040323043f,
                          1.0f, 0.98078528040323043f, 0.92387953251128674f, 0.83146961230254524f, 0.70710678118654752f, 0.55557023301960218f, 0.38268343236508977f, 0.19509032201612825f};
    if (r == 0) return base;
    if (r == 8) return cmulnegi(base);
    cf w; w.x = c[r]; w.y = -sn[r]; return cmul(base, w);
}
__device__ __forceinline__ void filtfft_phase(Frame& F) {
    const float* hT = (const float*)(F.ws + WS_HT); const float* fsqp = (const float*)(F.ws + WS_FSQP);
    const cf* TWM = (const cf*)(F.ws + SM_TWM); const cf* TWN = (const cf*)(F.ws + SM_TWN);
    cf* Fsp = (cf*)(F.ws + WS_F);
    cf* aE = (cf*)F.lds; cf* aO = (cf*)(F.lds + F2_AO);
    const cf* tw1 = (const cf*)(F.lds + F2_TW); const cf* tw32 = tw1 + 512;
    float* red = (float*)(F.lds + F2_RED);
    f2_load_tw(F, TWM, TWN);
    float* nrmt = (float*)(F.lds + F2_RED + 2048);
    { int kk = 0;
      for (int c0 = F.vcu; c0 < DM; c0 += 4 * F.G, kk += 4) {
        const int tl = min(F.tid, SEQ / 32 - 1);
        float pv[4];
#pragma unroll
        for (int j = 0; j < 4; ++j) { const int cc = min(c0 + j * F.G, DM - 1); pv[j] = fsqp[(size_t)tl * 2048 + cc] + fsqp[(size_t)tl * 2048 + 1024 + cc]; }
#pragma unroll
        for (int j = 0; j < 4; ++j) { float p = (F.tid < SEQ / 32) ? pv[j] : 0.f; p = wave_sum(p); if (F.lane == 0) red[j * 8 + F.wave] = p; }
        __syncthreads();
        if (F.tid < 4) { const float* rp = red + F.tid * 8; const float sm = ((((((rp[0] + rp[1]) + rp[2]) + rp[3]) + rp[4]) + rp[5]) + rp[6]) + rp[7]; nrmt[kk + F.tid] = 1.0f / sqrtf(sm + EPS); }
        __syncthreads();
      } }
    int kc = 0;
    for (int c = F.vcu; c < DM; c += F.G, ++kc) {
        int tid = F.tid; FC_OPAQUE(tid);
        __syncthreads();
        const float nrm = nrmt[kc];
        const float* hf = hT + (size_t)c * SEQ; const float* hb = hT + ((size_t)1024 + c) * SEQ;
        if (c + F.G < DM) { const float* pr = hT + ((size_t)(tid >> 8) * 1024 + c + F.G) * SEQ + (size_t)(tid & 255) * 32;
            __builtin_amdgcn_global_load_lds((const unsigned*)pr, (LAS unsigned*)(F.lds + F2_PF + F.wave * 256), 4, 0, 0); }
        {
            cf v[16], w[16];
            const cf tnb = ((const cf*)(F.lds + F2_TN))[tid];
#pragma unroll
            for (int r = 0; r < 16; ++r) { const int n = tid + 512 * r; const float hbv = hb[SEQ - max(n, 1)];
                const float fa = hf[n] * nrm, fb = (n == 0) ? 0.f : hbv * nrm;
                v[r].x = fa + fb; v[r].y = 0.f; const cf tnr = tn_pow(tnb, r); w[r].x = (fa - fb) * tnr.x; w[r].y = (fa - fb) * tnr.y; }
            f2_fwd_p1(v, tid, aE, tw1);
            f2_fwd_p1(w, tid, aO, tw1);
        }
        __syncthreads();
        f2_fwd_p2_dual(tid, aE, aO, tw32);
        __syncthreads();
        { const int path = tid >> 8, bf = tid & 255;
          f2_mid_store16(bf, path ? aO : aE, (v2u*)Fsp + ((size_t)c * 2 + path) * (FC_M / 2)); }
    }
    __syncthreads();
}

__device__ __forceinline__ void conv3_8(const v4u raw, float prev, float next, float w0, float w1, float w2, float bb, float* out) {
    float x[10]; x[0] = prev; x[9] = next;
    x[1] = bflo(raw.x); x[2] = bfhi(raw.x); x[3] = bflo(raw.y); x[4] = bfhi(raw.y); x[5] = bflo(raw.z); x[6] = bfhi(raw.z); x[7] = bflo(raw.w); x[8] = bfhi(raw.w);
#pragma unroll
    for (int i = 0; i < 8; ++i) out[i] = w0 * x[i] + w1 * x[i + 1] + w2 * x[i + 2] + bb;
}
#ifdef PROBE_SEC
#define SEC_MARK(k) do { const unsigned long long t_ = __builtin_amdgcn_s_memrealtime(); if ((k) > 0 && (k) - 1 == PROBE_SEC) F.sec += t_ - sec_t0; sec_t0 = t_; } while (0)
#else
#define SEC_MARK(k) do { } while (0)
#endif
__device__ __forceinline__ void hyena_fft_phase(Frame& F) {
#ifdef PROBE_SEC
    unsigned long long sec_t0 = 0;
#endif
    const float* const* in = F.in;
    const float* sw = in[23]; const float* sb = in[24]; const float* dbias = in[33];
    const bf16* UT = (const bf16*)(F.ws + WS_UT);
    const cf* TWM = (const cf*)(F.ws + SM_TWM); const cf* TWN = (const cf*)(F.ws + SM_TWN);
    const cf* Fsp = (const cf*)(F.ws + WS_F);
    cf* aE = (cf*)F.lds; cf* aO = (cf*)(F.lds + F2_AO);
    const cf* tw1 = (const cf*)(F.lds + F2_TW); const cf* tw32 = tw1 + 512;
    f2_load_tw(F, TWM, TWN);
    for (int unit = F.vcu; unit < 2 * DM; unit += F.G) {
        const int c = unit >> 1, b0 = (unit & 1) * 2;
        int tid = F.tid; FC_OPAQUE(tid);
        SEC_MARK(0);
        __syncthreads();
        {
            const float w10 = sw[1024 + c], w11 = sw[3072 + 1024 + c], w12 = sw[6144 + 1024 + c], bb1 = sb[1024 + c];
            const float wv0 = sw[2048 + c], wv1 = sw[3072 + 2048 + c], wv2 = sw[6144 + 2048 + c], bbv = sb[2048 + c];
            v4u x1raw[2][2], vraw[2][2]; unsigned short hh[2][2][4];
            FC_OPAQUE(tid);
#pragma unroll
            for (int h = 0; h < 2; ++h) {
                const int t0 = (tid + 512 * h) * 8;
                const int ipv = max(t0 - 1, 0), inx = min(t0 + 8, SEQ - 1);
#pragma unroll
                for (int bb = 0; bb < 2; ++bb) {
                    const bf16* x1r = UT + ((size_t)(b0 + bb) * 3072 + 1024 + c) * SEQ;
                    const bf16* vr = UT + ((size_t)(b0 + bb) * 3072 + 2048 + c) * SEQ;
                    x1raw[h][bb] = *(const v4u*)(x1r + t0); vraw[h][bb] = *(const v4u*)(vr + t0);
                    hh[h][bb][0] = x1r[ipv]; hh[h][bb][1] = x1r[inx]; hh[h][bb][2] = vr[ipv]; hh[h][bb][3] = vr[inx];
                }
            }
#pragma unroll
            for (int h = 0; h < 2; ++h) {
                const int t0 = (tid + 512 * h) * 8;
                float z[2][8];
#pragma unroll
                for (int bb = 0; bb < 2; ++bb) {
                    const float x1p = t0 > 0 ? bf2f(hh[h][bb][0]) : 0.f, x1n = t0 + 8 < SEQ ? bf2f(hh[h][bb][1]) : 0.f;
                    const float vp = t0 > 0 ? bf2f(hh[h][bb][2]) : 0.f, vn = t0 + 8 < SEQ ? bf2f(hh[h][bb][3]) : 0.f;
                    float x1c[8], vc[8];
                    conv3_8(x1raw[h][bb], x1p, x1n, w10, w11, w12, bb1, x1c);
                    conv3_8(vraw[h][bb], vp, vn, wv0, wv1, wv2, bbv, vc);
#pragma unroll
                    for (int i = 0; i < 8; ++i) z[bb][i] = x1c[i] * vc[i];
                }
                const int pb = F2_PIDX(t0);
#pragma unroll
                for (int i = 0; i < 8; ++i) { cf t; t.x = z[0][i]; t.y = z[1][i]; aE[pb + i] = t; }
            }
        }
        __syncthreads();
        SEC_MARK(1);
        cf wreg[16];
        FC_OPAQUE(tid);
        { const int pt = F2_PIDX(tid);
#pragma unroll
          for (int r = 0; r < 16; ++r) wreg[r] = aE[pt + 528 * r]; }
        const int path = tid >> 8, bf = tid & 255;
        const cf tnb = ((const cf*)(F.lds + F2_TN))[tid];
        cf tn[16];
#pragma unroll
        for (int r = 0; r < 16; ++r) tn[r] = tn_pow(tnb, r);
        {
            cf v[16];
#pragma unroll
            for (int r = 0; r < 16; ++r) v[r] = cmulv(wreg[r], tn[r]);
            f2_fwd_p1(v, tid, aO, tw1);
            FC_OPAQUE(tid);
#pragma unroll
            for (int r = 0; r < 16; ++r) v[r] = wreg[r];
            f2_fwd_p1(v, tid, aE, tw1);
        }
        __syncthreads();
        SEC_MARK(2);
        f2_fwd_p2_dual(tid, aE, aO, tw32);
        __syncthreads();
        SEC_MARK(3);
        v2u freg[16];
        { const v2u* fp = (const v2u*)Fsp + ((size_t)c * 2 + path) * (FC_M / 2) + bf;
#pragma unroll
          for (int i = 0; i < 16; ++i) freg[i] = fp[i * 256]; }
        f2_mid16(bf, path ? aO : aE, freg);
        __syncthreads();
        SEC_MARK(4);
        if (tid < 256) { const bf16* pr = UT + ((size_t)(b0 + (tid >> 7)) * 3072 + c) * SEQ + (size_t)(tid & 127) * 64;
            __builtin_amdgcn_global_load_lds((const unsigned*)pr, (LAS unsigned*)(F.lds + F2_PF + F.wave * 256), 4, 0, 0); }
        if (unit + F.G < 2 * DM) { const int nu = unit + F.G, nc = nu >> 1, nb = (nu & 1) * 2 + (tid >> 8), wh = 1 + ((tid >> 7) & 1);
            const bf16* pr = UT + ((size_t)nb * 3072 + wh * 1024 + nc) * SEQ + (size_t)(tid & 127) * 64;
            __builtin_amdgcn_global_load_lds((const unsigned*)pr, (LAS unsigned*)(F.lds + F2_PF + F.wave * 256), 4, 0, 0); }
        f2_inv_p2_dual(tid, aE, aO, tw32);
        __syncthreads();
        SEC_MARK(5);
        {
            cf ve[16], vo[16];
            f2_inv_p1(ve, tid, aE, tw1);
            f2_inv_p1(vo, tid, aO, tw1);
            const float db = dbias[c];
            FC_OPAQUE(tid);
            const int pt = F2_PIDX(tid);
            const cf tnb2 = ((const cf*)(F.lds + F2_TN))[tid];
#pragma unroll
            for (int r = 0; r < 16; ++r) { const int n = tid + 512 * r;
                const cf z = cadd(ve[r], cmulv(tn_pow(tnb2, r), vo[r]));
                const cf o = z * (cf){1.0f / 16384.0f, -1.0f / 16384.0f} + wreg[r] * db; aE[pt + 528 * r] = o; }
        }
        __syncthreads();
        SEC_MARK(6);
        {
            const float w00 = sw[c], w01 = sw[3072 + c], w02 = sw[6144 + c], bb0 = sb[c];
            v4u xraw[2][2]; unsigned short hx[2][2][2];
            FC_OPAQUE(tid);
#pragma unroll
            for (int h = 0; h < 2; ++h) {
                const int t0 = (tid + 512 * h) * 8;
#pragma unroll
                for (int bb = 0; bb < 2; ++bb) { const bf16* x0r = UT + ((size_t)(b0 + bb) * 3072 + c) * SEQ;
                    xraw[h][bb] = *(const v4u*)(x0r + t0); hx[h][bb][0] = x0r[max(t0 - 1, 0)]; hx[h][bb][1] = x0r[min(t0 + 8, SEQ - 1)]; }
            }
#pragma unroll
            for (int h = 0; h < 2; ++h) {
                const int t0 = (tid + 512 * h) * 8;
                cf val[8];
                const int pb = F2_PIDX(t0);
#pragma unroll
                for (int i = 0; i < 8; ++i) val[i] = aE[pb + i];
#pragma unroll
                for (int bb = 0; bb < 2; ++bb) {
                    const float xp = t0 > 0 ? bf2f(hx[h][bb][0]) : 0.f, xn = t0 + 8 < SEQ ? bf2f(hx[h][bb][1]) : 0.f;
                    float x0c[8]; conv3_8(xraw[h][bb], xp, xn, w00, w01, w02, bb0, x0c);
                    float p[8];
#pragma unroll
                    for (int i = 0; i < 8; ++i) p[i] = x0c[i] * (bb == 0 ? val[i].x : val[i].y);
                    v4u o; o.x = pk2(p[0], p[1]); o.y = pk2(p[2], p[3]); o.z = pk2(p[4], p[5]); o.w = pk2(p[6], p[7]);
                    *(v4u*)((bf16*)(F.ws + WS_XS) + ((size_t)(b0 + bb) * 1024 + c) * SEQ + t0) = o;
                }
            }
        }
        SEC_MARK(7);
    }
    __syncthreads();
}
__device__ __forceinline__ void transpose_p_phase(Frame& F) {
    const bf16* PT = (const bf16*)(F.ws + WS_XS); bf16* P = (bf16*)(F.ws + WS_P);
    LAS unsigned short* scr = (LAS unsigned short*)(F.lds + F.wave * 16384);
    const int gw = F.vcu * NWAVES + F.wave, NGW = F.G * NWAVES, lane = F.lane;
    const int ntile = NB * (DM / 64) * (SEQ / 64);
    const int l8 = lane >> 3, ch = (lane & 7) * 8;
    for (int it = gw; it < ntile; it += NGW) {
        const int tb = it % (SEQ / 64), cb = (it / (SEQ / 64)) % (DM / 64), b = it / ((SEQ / 64) * (DM / 64));
        v4u x[8];
#pragma unroll
        for (int k = 0; k < 8; ++k) x[k] = *(const v4u*)(PT + ((size_t)b * 1024 + cb * 64 + 8 * k + l8) * SEQ + tb * 64 + ch);
#pragma unroll
        for (int k = 0; k < 8; ++k) { LAS unsigned* d = (LAS unsigned*)(scr + (8 * k + l8) * 66 + ch); d[0] = x[k].x; d[1] = x[k].y; d[2] = x[k].z; d[3] = x[k].w; }
        LDS_WAIT(); asm volatile("" ::: "memory");
#pragma unroll
        for (int k = 0; k < 8; ++k) { const int t = 8 * k + l8; const LAS unsigned short* sp = scr + ch * 66 + t;
            v4u o; o.x = sp[0] | ((unsigned)sp[66] << 16); o.y = sp[2 * 66] | ((unsigned)sp[3 * 66] << 16); o.z = sp[4 * 66] | ((unsigned)sp[5 * 66] << 16); o.w = sp[6 * 66] | ((unsigned)sp[7 * 66] << 16);
            *(v4u*)(P + ((size_t)b * SEQ + tb * 64 + t) * DM + cb * 64 + ch) = o; }
        LDS_WAIT(); asm volatile("" ::: "memory");
    }
}

constexpr int NPH = 13;
__global__ void __launch_bounds__(NWAVES * 64, 2) hybrid_fwd(Args args) {
    extern __shared__ __attribute__((aligned(16))) unsigned char lds[];
    Frame F;
    F.lds = (LAS unsigned char*)lds;
    F.tid = threadIdx.x; F.lane = F.tid & 63; F.wave = __builtin_amdgcn_readfirstlane(F.tid >> 6);
    F.G = gridDim.x; { const int bx = blockIdx.x; F.vcu = (F.G % 8 == 0) ? (bx % 8) * (F.G / 8) + bx / 8 : bx; }
    F.in = args.in; F.out = args.out; F.ws = args.ws;
#ifdef PROBE_SEC
    F.sec = 0;
#endif
    unsigned char* ws = args.ws;
    volatile LAS unsigned* MISC = (volatile LAS unsigned*)(F.lds + MISC_OFF);
    for (int u = F.tid; u < (LDS_BYTES - LDSCTL_OFF) / 4; u += NWAVES * 64) ((LAS unsigned*)(F.lds + LDSCTL_OFF))[u] = 0u;
    __syncthreads();
    XcdBarrier bar; bar.bar = (unsigned*)(ws + CT_BAR) + args.li * XCD_BAR_WORDS; bar.x = 0; bar.st = nullptr;
    const int lo = args.ph_lo, hi = args.ph_hi;
    if (hi - lo > 1) bar = xcd_barrier_post((unsigned*)(ws + CT_BAR) + args.li * XCD_BAR_WORDS, MISC + 8);
#ifndef EXP_PAIR
#define EXP_PAIR 0
#endif
#ifndef REP_MASK
#define REP_MASK 0
#endif
#define REPS(k) ((((REP_MASK) >> (k)) & 1) ? 2 : 1)
#ifndef PH_MASK
#define PH_MASK 0xFFFFFF
#endif
#define IN(k) ((((PH_MASK) >> (k)) & 1) && lo <= (k) && (k) < hi)
#ifdef PROBE_TS
    unsigned long long ts_a = 0, ts_b = 0;
#define TS_MARK(k) do { if (blockIdx.x == 0 && F.tid == 0) { const unsigned long long t_ = __builtin_amdgcn_s_memrealtime(); if ((k) == PROBE_TS) ts_a = t_; if ((k) == PROBE_TS + 1) ts_b = t_; } } while (0)
#else
#define TS_MARK(k) do { } while (0)
#endif
#define SEAM(k) do { if (IN(k) && IN((k) + 1)) xcd_barrier(bar); TS_MARK((k) + 1); } while (0)
    const float* mods = (const float*)(ws + CT_MODS);
    const float* gnt = (const float*)(ws + SM_GN);
    float* ssqa = (float*)(ws + WS_SSQP);
    bf16* XS = (bf16*)(ws + WS_XS);

    TS_MARK(0);
    if (IN(0)) { for (int rep = 0; rep < REPS(0); ++rep) { phase0a(F); filtgen_phase(F); } } SEAM(0);
    if (IN(1)) { for (int rep = 0; rep < REPS(1); ++rep) { phase0b(F); filtfft_phase(F); } } SEAM(1);
    if (IN(2)) for (int rep = 0; rep < REPS(2); ++rep) {
        { pg8::Gemm g{XS, (const bf16*)(ws + WS_WQKV), TT, DM, DM, DM}; pg8::StaticOrder S; S.init(TT, DM, F.G, (int)blockIdx.x);
          EpiQK<0> E{(bf16*)(ws + WS_Q), (const float*)(ws + SM_SSQ0), 1, (const float*)(ws + CT_BQKV), 3072, args.in[9], SEQ};
          pg8::gemm_phase<EpiQK<0>, pg8::StaticOrder, true, true>(F.lds, g, S, E); }
        { pg8::Gemm g{XS, (const bf16*)(ws + WS_WQKV) + (size_t)1024 * DM, TT, DM, DM, DM}; pg8::StaticOrder S; S.init(TT, DM, F.G, (int)blockIdx.x);
          EpiQK<1> E{(bf16*)(ws + WS_K), (const float*)(ws + SM_SSQ0), 1, (const float*)(ws + CT_BQKV), 3072, args.in[10], SEQ};
          pg8::gemm_phase<EpiQK<1>, pg8::StaticOrder, true, true>(F.lds, g, S, E); }
        { pg8::Gemm g{XS, (const bf16*)(ws + WS_WQKV) + (size_t)2048 * DM, TT, DM, DM, DM}; pg8::StaticOrder S; S.init(TT, DM, F.G, (int)blockIdx.x);
          EpiVT4 E{(bf16*)(ws + WS_V), (const float*)(ws + SM_SSQ0), 1, (const float*)(ws + CT_BQKV), 3072, SEQ};
          pg8::gemm_phase<EpiVT4, pg8::StaticOrder, true, true>(F.lds, g, S, E); }
        { pg8::Gemm g{(const bf16*)(ws + WS_XSC), (const bf16*)(ws + WS_WQKV) + (size_t)1024 * DM, TC, 2 * DM, DM, DM}; pg8::StaticOrder S; S.init(TC, 2 * DM, F.G, (int)blockIdx.x);
          EpiCtxKV E{ EpiQK<1>{(bf16*)(ws + WS_KC), (const float*)(ws + SM_SSQC), 1, (const float*)(ws + CT_BQKV) + 4 * 3072, 0, args.in[10], CTXL},
                      EpiVT{(bf16*)(ws + WS_VC), (const float*)(ws + SM_SSQC), 1, (const float*)(ws + CT_BQKV) + 4 * 3072, 0, CTXL} };
          pg8::gemm_phase<EpiCtxKV, pg8::StaticOrder, true, true>(F.lds, g, S, E); }
        { const int nct = (TC / 256) * (2 * DM / 256); const int idle = (int)F.G - nct;
          if (idle >= 184) { if ((int)blockIdx.x >= nct) bias_gemv_late(F, (int)blockIdx.x - nct); }
          else for (int it = (int)blockIdx.x; it < 184; it += (int)F.G) bias_gemv_late(F, it); }
    } SEAM(2);
    if (IN(3)) { for (int rep = 0; rep < REPS(3); ++rep) attn_mfma_phase(F); } SEAM(3);
    if (IN(4)) for (int rep = 0; rep < REPS(4); ++rep) {
        pg8::Gemm g{(const bf16*)(ws + WS_O), (const bf16*)(ws + WS_WO), TT, DM, DM, DM}; pg8::StaticOrder S; S.init(TT, DM, F.G, (int)blockIdx.x);
        EpiRes<true, false> E{args.in[0], ws + WS_XB, mods + 2048, nullptr, gnt, XS, ssqa, (float*)(lds + RING_BYTES + 8192)};
        pg8::gemm_phase<EpiRes<true, false>, pg8::StaticOrder, true, true>(F.lds, g, S, E);
    } SEAM(4);
    if (IN(5)) for (int rep = 0; rep < REPS(5); ++rep) {
        pg8::Gemm g{XS, (const bf16*)(ws + WS_WUP0), TT, 2 * FF, DM, DM}; pg8::StaticOrder S; S.init(TT, 2 * FF, F.G, (int)blockIdx.x);
        EpiUpGlu E{(bf16*)(ws + WS_AG), ssqa, 4, (const float*)(ws + CT_BUP0), args.in[14], args.in[15], (float*)(ws + WS_HG), (float*)(ws + WS_HA), (float*)(lds + RING_BYTES)};
        pg8::gemm_phase<EpiUpGlu, pg8::StaticOrder, true, true>(F.lds, g, S, E);
    } SEAM(5);

    if (IN(6)) {
        { pg8::StaticOrder S0; S0.init(TT, DM, F.G, (int)blockIdx.x); pg8::Unit fu;
#pragma unroll 1
          for (int i = 0; S0.next(i, fu); i += 2) { pg8::Unit fv; const int pmB = S0.next(i + 1, fv) ? fv.pm : -1; glu_fix_tile2(F, fu.pm, pmB, args.in[14], args.in[15]); }
          VM_WAIT(); __syncthreads(); asm volatile("" ::: "memory"); }
        pg8::Gemm g{(const bf16*)(ws + WS_AG), (const bf16*)(ws + WS_WDN0), TT, DM, FF, FF}; pg8::StaticOrder S; S.init(TT, DM, F.G, (int)blockIdx.x);
        EpiRes<false, false> E{ws + WS_XB, ws + WS_XB, mods + 5120, nullptr, gnt + 4096, XS, ssqa + 4 * TT, (float*)(lds + RING_BYTES + 8192)};
        pg8::gemm_phase<EpiRes<false, false>, pg8::StaticOrder, true, true>(F.lds, g, S, E);
    } SEAM(6);
    if (IN(7)) for (int rep = 0; rep < REPS(7); ++rep) {
        pg8::Gemm g{XS, (const bf16*)(ws + WS_WIN), TT, 3 * DM, DM, DM}; pg8::StaticOrder S; S.init(TT, 3 * DM, F.G, (int)blockIdx.x);
#ifdef EXP_P9
        EpiScaleBias E{(bf16*)(ws + WS_UT), 3 * DM, ssqa + 4 * TT, 4, (const float*)(ws + CT_BIN), 3072};
        pg8::gemm_phase<EpiScaleBias, pg8::StaticOrder, true, true>(F.lds, g, S, E);
#else
        EpiInT E{(bf16*)(ws + WS_UT), ssqa + 4 * TT, 4, (const float*)(ws + CT_BIN)};
        pg8::gemm_phase<EpiInT, pg8::StaticOrder, true, true>(F.lds, g, S, E);
#endif
    } SEAM(7);
    if (IN(8)) { for (int rep = 0; rep < REPS(8); ++rep) hyena_fft_phase(F); } SEAM(8);

    if (IN(9)) { for (int rep = 0; rep < REPS(9); ++rep) transpose_p_phase(F); } SEAM(9);
    if (IN(10)) {
        pg8::Gemm g{(const bf16*)(ws + WS_P), (const bf16*)(ws + WS_WOUT), TT, DM, DM, DM}; pg8::StaticOrder S; S.init(TT, DM, F.G, (int)blockIdx.x);
        EpiRes<false, false> E{ws + WS_XB, ws + WS_XB, mods + 5 * 6144 + 2048, args.in[35], gnt + 2 * 4096, XS, ssqa + 8 * TT, (float*)(lds + RING_BYTES + 8192)};
        pg8::gemm_phase<EpiRes<false, false>, pg8::StaticOrder, true, true>(F.lds, g, S, E);
    } SEAM(10);
    if (IN(11)) for (int rep = 0; rep < REPS(11); ++rep) {
        pg8::Gemm g{XS, (const bf16*)(ws + WS_WUP1), TT, 2 * FF, DM, DM}; pg8::StaticOrder S; S.init(TT, 2 * FF, F.G, (int)blockIdx.x);
        EpiUpGlu E{(bf16*)(ws + WS_AG), ssqa + 8 * TT, 4, (const float*)(ws + CT_BUP1), args.in[37], args.in[38], (float*)(ws + WS_HG), (float*)(ws + WS_HA), (float*)(lds + RING_BYTES)};
        pg8::gemm_phase<EpiUpGlu, pg8::StaticOrder, true, true>(F.lds, g, S, E);
    } SEAM(11);
    if (IN(12)) {
        { pg8::StaticOrder S0; S0.init(TT, DM, F.G, (int)blockIdx.x); pg8::Unit fu;
#pragma unroll 1
          for (int i = 0; S0.next(i, fu); i += 2) { pg8::Unit fv; const int pmB = S0.next(i + 1, fv) ? fv.pm : -1; glu_fix_tile2(F, fu.pm, pmB, args.in[37], args.in[38]); }
          VM_WAIT(); __syncthreads(); asm volatile("" ::: "memory"); }
        pg8::Gemm g{(const bf16*)(ws + WS_AG), (const bf16*)(ws + WS_WDN1), TT, DM, FF, FF}; pg8::StaticOrder S; S.init(TT, DM, F.G, (int)blockIdx.x);
        EpiRes<false, true> E{ws + WS_XB, args.out, mods + 5 * 6144 + 5120, nullptr, nullptr, nullptr, nullptr, nullptr};
        pg8::gemm_phase<EpiRes<false, true>, pg8::StaticOrder, true, true>(F.lds, g, S, E);
    }
#ifdef PROBE_SEC
    if (blockIdx.x == 0 && F.tid == 0) { asm volatile("s_waitcnt vmcnt(0)" ::: "memory"); args.out[0] = args.out[0] + (float)F.sec * 0.01f; }
#endif
#ifdef PROBE_TS
    TS_MARK(NPH);
    if (blockIdx.x == 0 && F.tid == 0) { asm volatile("s_waitcnt vmcnt(0)" ::: "memory"); args.out[0] = args.out[0] + (float)(ts_b - ts_a) * 0.01f; }
#endif
#ifdef PROBE_NULL
    if (lo == 98) {
#if PROBE_NULL == 5
        pg8::Gemm g{XS, (const bf16*)(ws + WS_WUP0), TT, 2 * FF, DM, DM}; pg8::StaticOrder S; S.init(TT, 2 * FF, F.G, (int)blockIdx.x);
#elif PROBE_NULL == 4
        pg8::Gemm g{(const bf16*)(ws + WS_O), (const bf16*)(ws + WS_WO), TT, DM, DM, DM}; pg8::StaticOrder S; S.init(TT, DM, F.G, (int)blockIdx.x);
#elif PROBE_NULL == 7
        pg8::Gemm g{(const bf16*)(ws + WS_AG), (const bf16*)(ws + WS_WDN0), TT, DM, FF, FF}; pg8::StaticOrder S; S.init(TT, DM, F.G, (int)blockIdx.x);
        { pg8::Unit fu; for (int i = 0; S.next(i, fu); ++i) glu_fix_tile(F, fu.pm, args.in[14], args.in[15]); VM_WAIT(); __syncthreads(); }
#else
        pg8::Gemm g{XS, (const bf16*)(ws + WS_WQKV), TT, 3 * DM, DM, DM}; pg8::StaticOrder S; S.init(TT, 3 * DM, F.G, (int)blockIdx.x);
#endif
        EpiNull E{(float*)(ws + WS_FSQP)};
        pg8::gemm_phase<EpiNull, pg8::StaticOrder, true, true>(F.lds, g, S, E);
    }
#endif
#ifdef DUMP_SEL
    if (lo == 99) {
        float* o = args.out; const size_t n = (size_t)TT * DM;
        for (size_t e = (size_t)blockIdx.x * 512 + F.tid; e < n; e += (size_t)F.G * 512) {
            float v;
            if (DUMP_SEL == 1) { const float* h = (const float*)(ws + WS_HT); v = (e < (size_t)2 * 1024 * SEQ) ? h[e] : ((const float*)(ws + WS_FSQP))[e & 1023]; }
            else if (DUMP_SEL == 2) { const bf16* u = (const bf16*)(ws + WS_UT); v = bf2f(u[e]); }
            else if (DUMP_SEL == 3) { const bf16* u = (const bf16*)(ws + WS_UT); v = bf2f(u[e + (size_t)TT * DM]); }
            else if (DUMP_SEL == 4) { const bf16* u = (const bf16*)(ws + WS_UT); v = bf2f(u[e + (size_t)2 * TT * DM]); }
            else { const bf16* u = (const bf16*)(ws + WS_P); v = bf2f(u[e]); }
            o[e] = v;
        }
    }
#endif
#undef IN
#undef SEAM
}

extern "C" void kernel_launch(void* const* d_in, const int* in_sizes, int n_in, void* d_out, int out_size, void* d_ws, size_t ws_size, hipStream_t stream) {
    static int grid = 0;
    if (grid == 0) {
        if (n_in != 40 || out_size != TT * DM || ws_size < WS_END) { fprintf(stderr, "kernel_launch: unexpected shapes n_in %d out %d ws %zu\n", n_in, out_size, ws_size); grid = -1; return; }
        int dev = 0, cus = 0;
        if (hipGetDevice(&dev) != hipSuccess || hipDeviceGetAttribute(&cus, hipDeviceAttributeMultiprocessorCount, dev) != hipSuccess) { grid = -1; return; }
        if (hipFuncSetAttribute((const void*)hybrid_fwd, hipFuncAttributeMaxDynamicSharedMemorySize, LDS_BYTES) != hipSuccess) { fprintf(stderr, "kernel_launch: hipFuncSetAttribute failed\n"); grid = -1; return; }
        int per_cu = 0;
        if (hipOccupancyMaxActiveBlocksPerMultiprocessor(&per_cu, (const void*)hybrid_fwd, NWAVES * 64, LDS_BYTES) != hipSuccess || per_cu < 1) { fprintf(stderr, "kernel_launch: occupancy query says %d\n", per_cu); }
        (void)hipGetLastError();
        grid = cus;
    }
    if (grid < 0) return;
    (void)hipMemsetAsync((char*)d_ws + WS_CTL, 0, CTL_ZERO_BYTES, stream);
    Args a{};
    for (int i = 0; i < 40; ++i) a.in[i] = (const float*)d_in[i];
    a.out = (float*)d_out; a.ws = (unsigned char*)d_ws; a.repmask = REP_MASK;
#if defined(PROBE_NULL)
    {   const int k = PROBE_NULL; const int lo[3] = {0, 98, k}, hi[3] = {k, 99, NPH};
        for (int i = 0; i < 3; ++i) { a.ph_lo = lo[i]; a.ph_hi = hi[i]; a.li = i;
            hipLaunchKernelGGL(hybrid_fwd, dim3(grid), dim3(NWAVES * 64), LDS_BYTES, stream, a); } }
#elif defined(PROBE_PHASE)
    {   const int k = PROBE_PHASE; const int lo[4] = {0, k, k, k + 1}, hi[4] = {k, k + 1, k + 1, NPH};
        for (int i = 0; i < 4; ++i) { if (lo[i] >= hi[i]) continue; a.ph_lo = lo[i]; a.ph_hi = hi[i]; a.li = i;
            hipLaunchKernelGGL(hybrid_fwd, dim3(grid), dim3(NWAVES * 64), LDS_BYTES, stream, a); } }
#elif MK_ONE_LAUNCH
    a.ph_lo = 0; a.ph_hi = NPH;
    hipLaunchKernelGGL(hybrid_fwd, dim3(grid), dim3(NWAVES * 64), LDS_BYTES, stream, a);
#else
    for (int p = 0; p < PH_END; ++p) { a.ph_lo = p; a.ph_hi = p + 1; hipLaunchKernelGGL(hybrid_fwd, dim3(grid), dim3(NWAVES * 64), LDS_BYTES, stream, a); }
#ifdef DUMP_SEL
    a.ph_lo = 99; a.ph_hi = 100; hipLaunchKernelGGL(hybrid_fwd, dim3(grid), dim3(NWAVES * 64), LDS_BYTES, stream, a);
#endif
#endif
}
```
